# Optimizing an MI355X kernel written in HIP

```python
import math
import jax, jax.numpy as jnp
from jax import lax
import numpy as np

D_MODEL = 1024
BATCH = 8
SEQ = 2048
DEPTH = 2
DEC_BATCH = 32
DEC_SEQ = 4
PAST_LEN = 8192
PAGE_SIZE = 128

N_EVEN = (DEPTH + 1) // 2
N_ODD = DEPTH // 2
CONV_CH_A = D_MODEL // 2
CONV_CH_B = D_MODEL // 2
IN_AB = 2 * CONV_CH_A + 3 * CONV_CH_B
KA = 31
KB = 3
KF = 3
HEAD_DIM = 64
N_HEADS = D_MODEL // HEAD_DIM
D_FF = ((8 * D_MODEL // 3 + 255) // 256) * 256
BRANCHES = ((128, 1), (512, 4), (2048, 16))
MAX_WINDOW = 2048
Q_BLOCK = 128
RMS_EPS = 1e-6
LN_EPS = 1e-5

kernel_name = "hybrid_conformerconv_shortconv_dilatedswa_convffn_step"


def rms_norm(x, g):
    xf = x.astype(jnp.float32)
    y = xf * lax.rsqrt(jnp.mean(xf * xf, axis=-1, keepdims=True) + RMS_EPS)
    return (y * g.astype(jnp.float32)).astype(x.dtype)


def causal_dwconv(x, state, w):
    k = w.shape[0]
    xp = jnp.concatenate([state.astype(x.dtype), x], axis=1)
    y = lax.conv_general_dilated(xp, w.astype(x.dtype)[:, None, :], (1,), 'VALID',
                                 dimension_numbers=('NWC', 'WIO', 'NWC'),
                                 feature_group_count=x.shape[-1])
    return y, xp[:, xp.shape[1] - (k - 1):]


def conv_mixers(h, st_a, st_b, w_in, wa, ba, lg, lb, wb, w_out):
    z = h @ w_in
    ca, cb = CONV_CH_A, CONV_CH_B
    glu = z[..., :ca] * jax.nn.sigmoid(z[..., ca:2 * ca])
    a, st_a_new = causal_dwconv(glu, st_a, wa)
    af = (a + ba.astype(a.dtype)).astype(jnp.float32)
    mu = jnp.mean(af, axis=-1, keepdims=True)
    var = jnp.mean(jnp.square(af - mu), axis=-1, keepdims=True)
    an = (af - mu) * lax.rsqrt(var + LN_EPS) * lg.astype(jnp.float32) + lb.astype(jnp.float32)
    a_out = (an * jax.nn.sigmoid(an)).astype(h.dtype)
    o = 2 * ca
    gate_b = z[..., o:o + cb]
    gate_c = z[..., o + cb:o + 2 * cb]
    x_t = z[..., o + 2 * cb:o + 3 * cb]
    cbo, st_b_new = causal_dwconv(gate_c * x_t, st_b, wb)
    b_out = gate_b * cbo
    y = jnp.concatenate([a_out, b_out], axis=-1) @ w_out
    return y, st_a_new, st_b_new


def conv_ffn(h, st, w_in, wc, w_down):
    z = h @ w_in
    g, st_new = causal_dwconv(z[..., :D_FF], st, wc)
    return (jax.nn.silu(g) * z[..., D_FF:]) @ w_down, st_new


def alibi_slopes():
    return jnp.asarray(2.0 ** (-8.0 * np.arange(1, N_HEADS + 1) / N_HEADS), dtype=jnp.float32)


def qkv_split(h, w_qkv):
    b, t, _ = h.shape
    z = (h @ w_qkv).reshape(b, t, 3, N_HEADS, HEAD_DIM)
    return z[:, :, 0], z[:, :, 1], z[:, :, 2]


def dilated_branch_prompt(q, k, v, steps, dil, slopes):
    bsz, s_len, nh, hd = q.shape
    sd = s_len // dil
    qb = math.gcd(sd, Q_BLOCK)
    nb = sd // qb
    qf = q.astype(jnp.float32).reshape(bsz, nb, qb, dil, nh, hd)
    pad = ((0, 0), (steps, 0), (0, 0), (0, 0), (0, 0))
    kp = jnp.pad(k.astype(jnp.float32).reshape(bsz, sd, dil, nh, hd), pad)
    vp = jnp.pad(v.astype(jnp.float32).reshape(bsz, sd, dil, nh, hd), pad)
    start = jnp.arange(nb) * qb
    idx = start[:, None] + jnp.arange(qb + steps)[None, :]
    kb = kp[:, idx]
    vb = vp[:, idx]
    s = jnp.einsum('bnirhc,bnjrhc->bnrhij', qf, kb) * (1.0 / math.sqrt(hd))
    ii = jnp.arange(qb)[:, None]
    jj = jnp.arange(qb + steps)[None, :]
    rel = ii + steps - jj
    valid = (rel >= 0) & (rel <= steps) & ((start[:, None, None] + jj - steps) >= 0)[:, :, :]
    bias = -slopes[:, None, None] * (dil * rel).astype(jnp.float32)[None]
    s = jnp.where(valid[None, :, None, None], s + bias, -jnp.inf)
    m = jnp.max(s, axis=-1, keepdims=True)
    p = jnp.exp(s - m)
    l = jnp.sum(p, axis=-1)
    o = jnp.einsum('bnrhij,bnjrhc->bnirhc', p, vb)
    lt = jnp.transpose(l, (0, 1, 4, 2, 3))
    o = (o / lt[..., None]).reshape(bsz, s_len, nh, hd)
    lse = (jnp.transpose(m[..., 0], (0, 1, 4, 2, 3)) + jnp.log(lt)).reshape(bsz, s_len, nh)
    return o, lse


def dilated_branch_sample(q, kc, vc, buf_len, steps, dil, slopes):
    t = q.shape[1]
    hd = q.shape[-1]
    msteps = jnp.arange(steps + 1)
    idx = buf_len + jnp.arange(t)[:, None] - dil * msteps[None, :]
    valid = idx >= 0
    idxc = jnp.maximum(idx, 0)
    kg = kc.astype(jnp.float32)[:, idxc]
    vg = vc.astype(jnp.float32)[:, idxc]
    s = jnp.einsum('bthc,btmhc->bhtm', q.astype(jnp.float32), kg) * (1.0 / math.sqrt(hd))
    s = s - slopes[:, None, None] * (dil * msteps).astype(jnp.float32)[None, None, :]
    s = jnp.where(valid[None, None], s, -jnp.inf)
    m = jnp.max(s, axis=-1, keepdims=True)
    p = jnp.exp(s - m)
    l = jnp.sum(p, axis=-1)
    lt = jnp.transpose(l, (0, 2, 1))
    o = jnp.einsum('bhtm,btmhc->bthc', p, vg) / lt[..., None]
    lse = jnp.transpose(m[..., 0], (0, 2, 1)) + jnp.log(lt)
    return o, lse


def merge_branches(outs, lses):
    w = jax.nn.softmax(jnp.stack(lses, axis=0), axis=0)
    return jnp.sum(w[..., None] * jnp.stack(outs, axis=0), axis=0)


def dilated_attention_prompt(q, k, v, slopes):
    outs, lses = [], []
    for window, dil in BRANCHES:
        o, l = dilated_branch_prompt(q, k, v, window // dil, dil, slopes)
        outs.append(o)
        lses.append(l)
    return merge_branches(outs, lses)


def dilated_attention_sample(q, kc, vc, buf_len, slopes):
    outs, lses = [], []
    for window, dil in BRANCHES:
        o, l = dilated_branch_sample(q, kc, vc, buf_len, window // dil, dil, slopes)
        outs.append(o)
        lses.append(l)
    return merge_branches(outs, lses)


def setup_inputs(seed: int = 0) -> dict:
    key = jax.random.key(seed)
    ks = jax.random.split(key, 24)
    win_len = min(MAX_WINDOW, PAST_LEN)
    f32 = jnp.float32
    nrm = lambda k, shape, scale: jax.random.normal(k, shape, f32) * scale
    return {
        "x_prompt": nrm(ks[0], (BATCH, SEQ, D_MODEL), 1.0),
        "x_sample": nrm(ks[1], (DEC_BATCH, DEC_SEQ, D_MODEL), 1.0),
        "state_conv_a": nrm(ks[2], (N_EVEN, DEC_BATCH, KA - 1, CONV_CH_A), 0.5),
        "state_conv_b": nrm(ks[3], (N_EVEN, DEC_BATCH, KB - 1, CONV_CH_B), 1.0),
        "cache_k": nrm(ks[4], (N_ODD, DEC_BATCH, win_len, N_HEADS, HEAD_DIM), 1.0),
        "cache_v": nrm(ks[5], (N_ODD, DEC_BATCH, win_len, N_HEADS, HEAD_DIM), 1.0),
        "state_ffn": nrm(ks[6], (DEPTH, DEC_BATCH, KF - 1, D_FF), 1.0),
        "g_mix": 1.0 + nrm(ks[7], (DEPTH, D_MODEL), 0.02),
        "g_ffn": 1.0 + nrm(ks[8], (DEPTH, D_MODEL), 0.02),
        "g_final": 1.0 + nrm(ks[9], (D_MODEL,), 0.02),
        "w_in_ab": nrm(ks[10], (N_EVEN, D_MODEL, IN_AB), D_MODEL ** -0.5),
        "conv_a_w": nrm(ks[11], (N_EVEN, KA, CONV_CH_A), KA ** -0.5),
        "conv_a_b": nrm(ks[12], (N_EVEN, CONV_CH_A), 0.02),
        "ln_a_g": 1.0 + nrm(ks[13], (N_EVEN, CONV_CH_A), 0.02),
        "ln_a_b": nrm(ks[14], (N_EVEN, CONV_CH_A), 0.02),
        "conv_b_w": nrm(ks[15], (N_EVEN, KB, CONV_CH_B), KB ** -0.5),
        "w_out_ab": nrm(ks[16], (N_EVEN, CONV_CH_A + CONV_CH_B, D_MODEL), (CONV_CH_A + CONV_CH_B) ** -0.5),
        "w_qkv": nrm(ks[17], (N_ODD, D_MODEL, 3 * N_HEADS * HEAD_DIM), D_MODEL ** -0.5),
        "w_o": nrm(ks[18], (N_ODD, N_HEADS * HEAD_DIM, D_MODEL), (N_HEADS * HEAD_DIM) ** -0.5),
        "w_ffn_in": nrm(ks[19], (DEPTH, D_MODEL, 2 * D_FF), D_MODEL ** -0.5),
        "conv_f_w": nrm(ks[20], (DEPTH, KF, D_FF), KF ** -0.5),
        "w_down": nrm(ks[21], (DEPTH, D_FF, D_MODEL), D_FF ** -0.5),
    }


def reference(x_prompt, x_sample, state_conv_a, state_conv_b, cache_k, cache_v, state_ffn,
              g_mix, g_ffn, g_final, w_in_ab, conv_a_w, conv_a_b, ln_a_g, ln_a_b, conv_b_w, w_out_ab,
              w_qkv, w_o, w_ffn_in, conv_f_w, w_down):
    slopes = alibi_slopes()
    bp, bs = x_prompt.shape[0], x_sample.shape[0]
    buf_len = cache_k.shape[2]
    hp, hs = x_prompt, x_sample
    pa, sa, pb, sb, pk, sk, pv, sv, pf, sf = [], [], [], [], [], [], [], [], [], []
    for layer in range(DEPTH):
        i = layer // 2
        xn_p = rms_norm(hp, g_mix[layer])
        xn_s = rms_norm(hs, g_mix[layer])
        if layer % 2 == 0:
            za = jnp.zeros((bp, KA - 1, CONV_CH_A), hp.dtype)
            zb = jnp.zeros((bp, KB - 1, CONV_CH_B), hp.dtype)
            yp, na, nb_ = conv_mixers(xn_p, za, zb, w_in_ab[i], conv_a_w[i], conv_a_b[i],
                                      ln_a_g[i], ln_a_b[i], conv_b_w[i], w_out_ab[i])
            ys, ma, mb = conv_mixers(xn_s, state_conv_a[i], state_conv_b[i], w_in_ab[i], conv_a_w[i],
                                     conv_a_b[i], ln_a_g[i], ln_a_b[i], conv_b_w[i], w_out_ab[i])
            pa.append(na)
            pb.append(nb_)
            sa.append(ma)
            sb.append(mb)
        else:
            q, k, v = qkv_split(xn_p, w_qkv[i])
            att = dilated_attention_prompt(q, k, v, slopes)
            yp = att.reshape(bp, hp.shape[1], N_HEADS * HEAD_DIM).astype(hp.dtype) @ w_o[i]
            keep = min(MAX_WINDOW, k.shape[1])
            pk.append(k[:, k.shape[1] - keep:])
            pv.append(v[:, v.shape[1] - keep:])
            qs, ks_, vs_ = qkv_split(xn_s, w_qkv[i])
            kc = jnp.concatenate([cache_k[i].astype(ks_.dtype), ks_], axis=1)
            vc = jnp.concatenate([cache_v[i].astype(vs_.dtype), vs_], axis=1)
            att_s = dilated_attention_sample(qs, kc, vc, buf_len, slopes)
            ys = att_s.reshape(bs, hs.shape[1], N_HEADS * HEAD_DIM).astype(hs.dtype) @ w_o[i]
            sk.append(kc[:, kc.shape[1] - buf_len:])
            sv.append(vc[:, vc.shape[1] - buf_len:])
        hp = hp + yp
        hs = hs + ys
        zf = jnp.zeros((bp, KF - 1, D_FF), hp.dtype)
        fp, nfp = conv_ffn(rms_norm(hp, g_ffn[layer]), zf, w_ffn_in[layer], conv_f_w[layer], w_down[layer])
        fs, nfs = conv_ffn(rms_norm(hs, g_ffn[layer]), state_ffn[layer], w_ffn_in[layer], conv_f_w[layer], w_down[layer])
        hp = hp + fp
        hs = hs + fs
        pf.append(nfp)
        sf.append(nfs)
    y_prompt = rms_norm(hp, g_final)
    y_sample = rms_norm(hs, g_final)
    p_conv_a = jnp.stack(pa)
    s_conv_a = jnp.stack(sa)
    p_conv_b = jnp.stack(pb)
    s_conv_b = jnp.stack(sb)
    p_k = jnp.stack(pk)
    s_k = jnp.stack(sk)
    p_v = jnp.stack(pv)
    s_v = jnp.stack(sv)
    p_ffn = jnp.stack(pf)
    s_ffn = jnp.stack(sf)
    return (y_prompt, y_sample, p_conv_a, s_conv_a, p_conv_b, s_conv_b, p_k, s_k, p_v, s_v, p_ffn, s_ffn)
```

```cpp
#include <hip/hip_runtime.h>
#include <hip/hip_cooperative_groups.h>
#include <cstdio>
#include <cstdint>
namespace cg = cooperative_groups;

#define LAS __attribute__((address_space(3)))
typedef unsigned short bf16_t;
typedef short bf16x8 __attribute__((ext_vector_type(8)));
typedef float f32x4 __attribute__((ext_vector_type(4)));
typedef float f32x2 __attribute__((ext_vector_type(2)));
typedef float f32x16 __attribute__((ext_vector_type(16)));
typedef unsigned u32x4 __attribute__((ext_vector_type(4)));
typedef unsigned u32x2 __attribute__((ext_vector_type(2)));
typedef short s16x4 __attribute__((ext_vector_type(4)));

constexpr int D = 1024, SEQ = 2048, NB = 8, MPR = NB * SEQ, NSB = 32, NST = 4, MSA = NSB * NST, MTOT = MPR + MSA, MPAD = 16640;
constexpr int DFF = 2816, NIN = 2560, CH = 512, NH = 16, HD = 64, LBUF = 2048, KA = 31;
constexpr int GAW = 1536;
constexpr float RMS_EPS = 1e-6f, LN_EPS = 1e-5f;
constexpr float LOG2E = 1.4426950408889634f;
constexpr float QSCALE = 0.125f * LOG2E;

constexpr size_t O_YP = 0;
constexpr size_t O_YS = O_YP + (size_t)MPR * D;
constexpr size_t O_PCA = O_YS + (size_t)MSA * D;
constexpr size_t O_SCA = O_PCA + (size_t)NB * 30 * CH;
constexpr size_t O_PCB = O_SCA + (size_t)NSB * 30 * CH;
constexpr size_t O_SCB = O_PCB + (size_t)NB * 2 * CH;
constexpr size_t O_PK = O_SCB + (size_t)NSB * 2 * CH;
constexpr size_t O_SK = O_PK + (size_t)MPR * D;
constexpr size_t O_PV = O_SK + (size_t)NSB * LBUF * D;
constexpr size_t O_SV = O_PV + (size_t)MPR * D;
constexpr size_t O_PF = O_SV + (size_t)NSB * LBUF * D;
constexpr size_t O_SF = O_PF + (size_t)2 * NB * 2 * DFF;
constexpr size_t O_END = O_SF + (size_t)2 * NSB * 2 * DFF;

constexpr size_t al(size_t x) { return (x + 4095) & ~(size_t)4095; }
constexpr size_t WS_WIN = 0;
constexpr size_t WS_WOUT = WS_WIN + al((size_t)NIN * D * 2);
constexpr size_t WS_WQKV = WS_WOUT + al((size_t)D * D * 2);
constexpr size_t WS_WO = WS_WQKV + al((size_t)3 * D * D * 2);
constexpr size_t WS_WF0 = WS_WO + al((size_t)D * D * 2);
constexpr size_t WS_WF1 = WS_WF0 + al((size_t)2 * DFF * D * 2);
constexpr size_t WS_WD0 = WS_WF1 + al((size_t)2 * DFF * D * 2);
constexpr size_t WS_WD1 = WS_WD0 + al((size_t)D * DFF * 2);
constexpr size_t WS_HB = WS_WD1 + al((size_t)D * DFF * 2);
constexpr size_t WS_H = WS_HB + al((size_t)MPAD * D * 2);
constexpr size_t WS_SSQ = WS_H + al((size_t)MPAD * D * 4);
constexpr size_t WS_GA = WS_SSQ + al((size_t)MPAD * 16 * 4);
constexpr size_t WS_AB = WS_GA + al((size_t)MPAD * GAW * 2);
constexpr size_t WS_ZG = WS_AB + al((size_t)MPAD * D * 2);
constexpr size_t WS_ZU = WS_ZG + al((size_t)MPAD * DFF * 2);
constexpr size_t WS_U = WS_ZU + al((size_t)MPAD * DFF * 2);
constexpr size_t WS_Q = WS_U + al((size_t)MPAD * DFF * 2);
constexpr size_t WS_K = WS_Q + al((size_t)MPAD * D * 2);
constexpr size_t WS_V = WS_K + al((size_t)MPAD * D * 2);
constexpr size_t WS_QS = WS_V + al((size_t)MPAD * D * 2);
constexpr size_t WS_END = WS_QS + al((size_t)MSA * D * 4);
static_assert(WS_V - WS_K == WS_K - WS_Q, "Q|K|V equally spaced");

constexpr int NWAVES = 8, NTHREADS = 512;
constexpr int LDS_BYTES = 147456;

__device__ __forceinline__ unsigned cvt_pk_bf16(float lo, float hi) { unsigned r; asm volatile("v_cvt_pk_bf16_f32 %0, %1, %2" : "=v"(r) : "v"(lo), "v"(hi)); return r; }
__device__ __forceinline__ float bf2f(unsigned short b) { return __uint_as_float((unsigned)b << 16); }
__device__ __forceinline__ float bflo(unsigned w) { return __uint_as_float(w << 16); }
__device__ __forceinline__ float bfhi(unsigned w) { return __uint_as_float(w & 0xffff0000u); }
__device__ __forceinline__ float sigmoidf_(float x) { return __builtin_amdgcn_rcpf(1.0f + __expf(-x)); }
__device__ __forceinline__ int launder_v(int x) { asm volatile("" : "+v"(x)); return x; }
__device__ __forceinline__ float wave_sum(float v) {
#pragma unroll
    for (int o = 1; o < 64; o <<= 1) v += __shfl_xor(v, o);
    return v;
}
__device__ __forceinline__ float wave_max(float v) {
#pragma unroll
    for (int o = 1; o < 64; o <<= 1) v = fmaxf(v, __shfl_xor(v, o));
    return v;
}

namespace pg8 {
constexpr int BM = 256, BK = 64, HALF = 128, HTB = HALF * BK * 2, STAGE_BYTES = 8 * HTB, NXCD = 8, WGM = 8;
__host__ __device__ __forceinline__ int lds_byte(int r, int c) { const int st = (r >> 4) * 2 + (c >> 5), rr = r & 15, cc = c & 31, ob = rr * 64 + cc * 2; return st * 1024 + (ob ^ (((ob >> 9) & 1) << 5)); }
__host__ __device__ __forceinline__ void stage_rc(int b, int& R, int& C) { const int st = b / 1024, sb = b % 1024, swz = sb ^ (((sb >> 9) & 1) << 5); R = (st >> 1) * 16 + swz / 64; C = (st & 1) * 32 + (swz % 64) / 2; }
__host__ __device__ __forceinline__ int perm32(int rho) { const int n = rho >> 4, i = rho & 15; return 8 * (i >> 2) + 4 * n + (i & 3); }

struct Unit { int pm, pn; };
struct Gemm { const bf16_t* A; const bf16_t* Bt; int M, N, K; };

struct StaticOrder {
    int nM, nN, nwg, G, c;
    __host__ __device__ void init(int M, int N, int G_, int c_) { nM = M / BM; nN = N / BM; nwg = nM * nN; G = G_; c = c_; }
    __host__ __device__ bool next(int i, Unit& u) const {
        const long L = (long)i * G + c; if (L >= nwg) return false;
        int wgid = (int)L; { const int q = nwg / NXCD, r = nwg % NXCD, xcd = wgid % NXCD, off = wgid / NXCD; wgid = (xcd < r ? xcd * (q + 1) : r * (q + 1) + (xcd - r) * q) + off; }
        const int nig = WGM * nN, gid = wgid / nig, fm = gid * WGM, gsz = (nM - fm) < WGM ? (nM - fm) : WGM;
        u.pm = fm + ((wgid % nig) % gsz); u.pn = (wgid % nig) / gsz; return true;
    }
    __device__ __forceinline__ void a_ready(const Unit&) const {}
    __device__ __forceinline__ void done(const Unit&) const {}
};

__device__ __forceinline__ float row_rstd(const float* ssq, int r, int fq) {
    const f32x4 p = *(const f32x4*)(ssq + (size_t)r * 16 + 4 * fq);
    float s = (p.x + p.y) + (p.z + p.w);
    s += __shfl_xor(s, 16); s += __shfl_xor(s, 32);
    return rsqrtf(s * (1.0f / D) + RMS_EPS);
}

struct EpiInAB {
    static constexpr bool PERM = true, AFTER_DRAIN = false;
    bf16_t* GA; const float* ssq; float* out;
    __device__ __forceinline__ void operator()(const f32x4 (&acc)[2][2][4][2], const Unit& u, int wr, int wc, int fr, int fq) const {
        const int pn = u.pn, colw = wc * 32 + 8 * fq;
#pragma unroll
        for (int ai = 0; ai < 2; ++ai)
#pragma unroll
            for (int m = 0; m < 4; ++m) {
                const int r = u.pm * BM + ai * HALF + wr * 64 + m * 16 + fr;
                const float rs = row_rstd(ssq, r, fq);
                const f32x4 a0 = acc[ai][0][m][0] * rs, a1 = acc[ai][0][m][1] * rs, g0 = acc[ai][1][m][0] * rs, g1 = acc[ai][1][m][1] * rs;
                bf16_t* rowp = GA + (size_t)r * GAW;
                if (pn < 8) {
                    f32x4 v0, v1;
                    if (pn < 4) {
#pragma unroll
                        for (int i = 0; i < 4; ++i) { v0[i] = a0[i] * sigmoidf_(g0[i]); v1[i] = a1[i] * sigmoidf_(g1[i]); }
                    } else { v0 = a0 * g0; v1 = a1 * g1; }
                    const int cl = 128 * (pn & 3) + colw;
                    u32x4 w; w.x = cvt_pk_bf16(v0[0], v0[1]); w.y = cvt_pk_bf16(v0[2], v0[3]); w.z = cvt_pk_bf16(v1[0], v1[1]); w.w = cvt_pk_bf16(v1[2], v1[3]);
                    *(u32x4*)(rowp + (pn < 4 ? 0 : 512) + cl) = w;
                    const int keep = pn < 4 ? 30 : 2;
                    float* sp = nullptr;
                    if (r < MPR) { const int t = r & (SEQ - 1), b = r >> 11; if (t >= SEQ - keep) sp = out + (pn < 4 ? O_PCA : O_PCB) + ((size_t)(b * keep + (t - (SEQ - keep)))) * CH + cl; }
                    else if (r < MTOT) { const int rs_ = r - MPR, sb = rs_ >> 2, j = rs_ & 3; if (j >= NST - keep || keep == 30) sp = out + (pn < 4 ? O_SCA : O_SCB) + ((size_t)(sb * keep + (keep - NST + j))) * CH + cl; }
                    if (sp) { *(f32x4*)sp = v0; *(f32x4*)(sp + 4) = v1; }
                } else {
                    const int c = 1024 + 256 * (pn - 8) + colw;
                    u32x4 w; w.x = cvt_pk_bf16(a0[0], a0[1]); w.y = cvt_pk_bf16(a0[2], a0[3]); w.z = cvt_pk_bf16(a1[0], a1[1]); w.w = cvt_pk_bf16(a1[2], a1[3]);
                    *(u32x4*)(rowp + c) = w;
                    w.x = cvt_pk_bf16(g0[0], g0[1]); w.y = cvt_pk_bf16(g0[2], g0[3]); w.z = cvt_pk_bf16(g1[0], g1[1]); w.w = cvt_pk_bf16(g1[2], g1[3]);
                    *(u32x4*)(rowp + c + 128) = w;
                }
            }
    }
};
struct EpiResid {
    static constexpr bool PERM = false, AFTER_DRAIN = false;
    const float* baseP; const float* baseS; float* H; bf16_t* HB; float* ssq;
    __device__ __forceinline__ void operator()(const f32x4 (&acc)[2][2][4][2], const Unit& u, int wr, int wc, int fr, int fq) const {
        const int col0 = u.pn * BM + wc * 32 + 4 * fq;
#pragma unroll
        for (int ai = 0; ai < 2; ++ai)
#pragma unroll
            for (int m = 0; m < 4; ++m) {
                const int r = u.pm * BM + ai * HALF + wr * 64 + m * 16 + fr;
                float s = 0.f;
                if (r < MTOT) {
                    const float* bp = (r < MPR) ? baseP + (size_t)r * D : baseS + (size_t)(r - MPR) * D;
#pragma unroll
                    for (int bj = 0; bj < 2; ++bj)
#pragma unroll
                        for (int n = 0; n < 2; ++n) {
                            const int c = col0 + bj * HALF + n * 16;
                            const f32x4 v = *(const f32x4*)(bp + c) + acc[ai][bj][m][n];
                            *(f32x4*)(H + (size_t)r * D + c) = v;
                            s += (v[0] * v[0] + v[1] * v[1]) + (v[2] * v[2] + v[3] * v[3]);
                            u32x2 w; w.x = cvt_pk_bf16(v[0], v[1]); w.y = cvt_pk_bf16(v[2], v[3]);
                            *(u32x2*)(HB + (size_t)r * D + c) = w;
                        }
                }
                s += __shfl_xor(s, 16); s += __shfl_xor(s, 32);
                if (fq == 0 && r < MTOT) ssq[(size_t)r * 16 + u.pn * 4 + wc] = s;
            }
    }
};
struct EpiFfn {
    static constexpr bool PERM = true, AFTER_DRAIN = false;
    bf16_t* ZG; bf16_t* ZU; const float* ssq; float* out; int layer;
    __device__ __forceinline__ void operator()(const f32x4 (&acc)[2][2][4][2], const Unit& u, int wr, int wc, int fr, int fq) const {
        const int col = u.pn * 128 + wc * 32 + 8 * fq;
#pragma unroll
        for (int ai = 0; ai < 2; ++ai)
#pragma unroll
            for (int m = 0; m < 4; ++m) {
                const int r = u.pm * BM + ai * HALF + wr * 64 + m * 16 + fr;
                const float rs = row_rstd(ssq, r, fq);
                const f32x4 g0 = acc[ai][0][m][0] * rs, g1 = acc[ai][0][m][1] * rs, u0 = acc[ai][1][m][0] * rs, u1 = acc[ai][1][m][1] * rs;
                u32x4 w; w.x = cvt_pk_bf16(g0[0], g0[1]); w.y = cvt_pk_bf16(g0[2], g0[3]); w.z = cvt_pk_bf16(g1[0], g1[1]); w.w = cvt_pk_bf16(g1[2], g1[3]);
                *(u32x4*)(ZG + (size_t)r * DFF + col) = w;
                w.x = cvt_pk_bf16(u0[0], u0[1]); w.y = cvt_pk_bf16(u0[2], u0[3]); w.z = cvt_pk_bf16(u1[0], u1[1]); w.w = cvt_pk_bf16(u1[2], u1[3]);
                *(u32x4*)(ZU + (size_t)r * DFF + col) = w;
                float* sp = nullptr;
                if (r < MPR) { const int t = r & (SEQ - 1), b = r >> 11; if (t >= SEQ - 2) sp = out + O_PF + ((size_t)((layer * NB + b) * 2 + (t - (SEQ - 2)))) * DFF + col; }
                else if (r < MTOT) { const int rs_ = r - MPR, sb = rs_ >> 2, j = rs_ & 3; if (j >= 2) sp = out + O_SF + ((size_t)((layer * NSB + sb) * 2 + (j - 2))) * DFF + col; }
                if (sp) { *(f32x4*)sp = g0; *(f32x4*)(sp + 4) = g1; }
            }
    }
};
struct EpiQkv {
    static constexpr bool PERM = true, AFTER_DRAIN = false;
    bf16_t* QKV; float* QS; const float* ssq; float* out;
    __device__ __forceinline__ void operator()(const f32x4 (&acc)[2][2][4][2], const Unit& u, int wr, int wc, int fr, int fq) const {
        const int which = u.pn >> 2, cb = 256 * (u.pn & 3) + wc * 32 + 8 * fq;
        bf16_t* dst = QKV + (size_t)which * ((WS_K - WS_Q) / 2);
#pragma unroll
        for (int ai = 0; ai < 2; ++ai)
#pragma unroll
            for (int m = 0; m < 4; ++m) {
                const int r = u.pm * BM + ai * HALF + wr * 64 + m * 16 + fr;
                const float rs = row_rstd(ssq, r, fq) * (which == 0 ? QSCALE : 1.0f);
                float* fp = nullptr;
                if (which == 0) { if (r >= MPR && r < MTOT) fp = QS + (size_t)(r - MPR) * D; }
                else if (r < MPR) fp = out + (which == 1 ? O_PK : O_PV) + (size_t)r * D;
                else if (r < MTOT) { const int rs_ = r - MPR, sb = rs_ >> 2, j = rs_ & 3; fp = out + (which == 1 ? O_SK : O_SV) + ((size_t)sb * LBUF + (LBUF - NST) + j) * D; }
#pragma unroll
                for (int bj = 0; bj < 2; ++bj) {
                    const f32x4 v0 = acc[ai][bj][m][0] * rs, v1 = acc[ai][bj][m][1] * rs;
                    const int c = cb + bj * HALF;
                    u32x4 w; w.x = cvt_pk_bf16(v0[0], v0[1]); w.y = cvt_pk_bf16(v0[2], v0[3]); w.z = cvt_pk_bf16(v1[0], v1[1]); w.w = cvt_pk_bf16(v1[2], v1[3]);
                    *(u32x4*)(dst + (size_t)r * D + c) = w;
                    if (fp) { *(f32x4*)(fp + c) = v0; *(f32x4*)(fp + c + 4) = v1; }
                }
            }
    }
};

template <class Epi, class Sched, bool ALIGN_EPI = false, bool SP2 = false>
__device__ __forceinline__ void gemm_phase(LAS unsigned char* lds, const Gemm g, const Sched& S, const Epi& E) {
    const int tid = launder_v(threadIdx.x), wid = __builtin_amdgcn_readfirstlane(tid >> 6), lane = tid & 63, wr = wid >> 2, wc = wid & 3, fr = lane & 15, fq = lane >> 4;
    const int K = g.K, nt = K / BK;
    unsigned voffA[2], voffB[2];
#pragma unroll
    for (int i = 0; i < 2; ++i) { int R, C; stage_rc(tid * 16 + i * 8192, R, C); const int Rb = Epi::PERM ? ((R & ~31) + perm32(R & 31)) : R;
        voffA[i] = (unsigned)(R * K + C) * 2u; voffB[i] = (unsigned)(Rb * K + C) * 2u; }
    const size_t kstep = (size_t)(BK * 2);
    const size_t hstep = (size_t)HALF * K * 2;
    const size_t tstep = 2 * hstep;
    const unsigned ldsw = (unsigned)wid * 1024u;
    const int aoff = lds_byte(wr * 64 + fr, fq * 8), boff = lds_byte(wc * 32 + fr, fq * 8);
#define PG8_SA(b, h) (((b) * 2 + (h)) * HTB)
#define PG8_SB(b, h) ((4 + (b) * 2 + (h)) * HTB)
#define PG8_STAGE(bufoff, gbase, voff) do { _Pragma("unroll") for (int _i = 0; _i < 2; ++_i) \
        __builtin_amdgcn_global_load_lds((const unsigned*)((const char*)(gbase) + (voff)[_i]), (LAS unsigned*)(lds + (bufoff) + ldsw + _i * 8192), 16, 0, 0); } while (0)
#define PG8_LDA(dst, b, h) do { _Pragma("unroll") for (int m = 0; m < 4; ++m) _Pragma("unroll") for (int k = 0; k < 2; ++k) dst[m][k] = *(const LAS bf16x8*)(lds + PG8_SA(b, h) + aoff + m * 2048 + k * 1024); } while (0)
#define PG8_LDB(dst, b, h) do { _Pragma("unroll") for (int n = 0; n < 2; ++n) _Pragma("unroll") for (int k = 0; k < 2; ++k) dst[n][k] = *(const LAS bf16x8*)(lds + PG8_SB(b, h) + boff + n * 2048 + k * 1024); } while (0)
#define PG8_MMA(ai, bj, At, Bt) do { __builtin_amdgcn_s_setprio(1); _Pragma("unroll") for (int m = 0; m < 4; ++m) _Pragma("unroll") for (int n = 0; n < 2; ++n) _Pragma("unroll") for (int k = 0; k < 2; ++k) \
        acc[ai][bj][m][n] = __builtin_amdgcn_mfma_f32_16x16x32_bf16(Bt[n][k], At[m][k], acc[ai][bj][m][n], 0, 0, 0); __builtin_amdgcn_s_setprio(0); } while (0)
#define PG8_WAIT_V(n) asm volatile("s_waitcnt vmcnt(" #n ")" ::: "memory")
#define PG8_WAIT_L(n) asm volatile("s_waitcnt lgkmcnt(" #n ")" ::: "memory")
#define PG8_BAR __builtin_amdgcn_s_barrier()
#define PG8_SCHED __builtin_amdgcn_sched_barrier(0)
    Unit cur, nxt; int ui = 0;
    if (!S.next(0, cur)) return;
    f32x4 acc[2][2][4][2];
#pragma unroll
    for (int a = 0; a < 2; ++a)
#pragma unroll
        for (int b = 0; b < 2; ++b)
#pragma unroll
            for (int m = 0; m < 4; ++m)
#pragma unroll
                for (int n = 0; n < 2; ++n) acc[a][b][m][n] = (f32x4){0.f, 0.f, 0.f, 0.f};
    bf16x8 At[4][2], B0[2][2], B1[2][2];
    const char* cA = (const char*)g.A + (size_t)cur.pm * tstep; const char* cB = (const char*)g.Bt + (size_t)cur.pn * tstep;
    S.a_ready(cur);
    if constexpr (SP2) {
        PG8_STAGE(PG8_SB(0, 0), cB, voffB); PG8_STAGE(PG8_SB(0, 1), cB + hstep, voffB); PG8_STAGE(PG8_SA(0, 0), cA, voffA); PG8_STAGE(PG8_SA(0, 1), cA + hstep, voffA);
        if (wr == 1) PG8_BAR;
        PG8_WAIT_V(2); PG8_BAR;
        PG8_STAGE(PG8_SB(1, 0), cB + kstep, voffB); PG8_STAGE(PG8_SA(1, 0), cA + kstep, voffA); PG8_STAGE(PG8_SB(1, 1), cB + hstep + kstep, voffB);
        PG8_WAIT_V(6); PG8_BAR;
    } else {
        PG8_STAGE(PG8_SB(0, 0), cB, voffB); PG8_STAGE(PG8_SA(0, 0), cA, voffA); PG8_STAGE(PG8_SB(0, 1), cB + hstep, voffB); PG8_STAGE(PG8_SA(0, 1), cA + hstep, voffA);
        if (wr == 1) PG8_BAR;
        PG8_WAIT_V(4); PG8_BAR;
        PG8_STAGE(PG8_SB(1, 0), cB + kstep, voffB); PG8_STAGE(PG8_SA(1, 0), cA + kstep, voffA); PG8_STAGE(PG8_SB(1, 1), cB + hstep + kstep, voffB);
        PG8_WAIT_V(6); PG8_BAR;
    }
    for (;;) {
        const bool has_next = S.next(ui + 1, nxt);
        const char* nA = has_next ? (const char*)g.A + (size_t)nxt.pm * tstep : cA; const char* nB = has_next ? (const char*)g.Bt + (size_t)nxt.pn * tstep : cB;
        for (int t = 0; t < nt; t += 2) {
            const bool last = (t == nt - 2);
            const char* a1 = cA + (size_t)(t + 1) * kstep;
            const char* a2 = last ? nA : cA + (size_t)(t + 2) * kstep; const char* b2 = last ? nB : cB + (size_t)(t + 2) * kstep;
            const char* a3 = a2 + kstep; const char* b3 = b2 + kstep;
            if (last && has_next) S.a_ready(nxt);
            if constexpr (SP2) {
            PG8_LDB(B0, 0, 0); PG8_LDB(B1, 0, 1); PG8_SCHED; PG8_LDA(At, 0, 0); PG8_STAGE(PG8_SA(1, 1), a1 + hstep, voffA);
            PG8_WAIT_V(8); PG8_WAIT_L(0); PG8_BAR; PG8_MMA(0, 0, At, B0); PG8_MMA(0, 1, At, B1); PG8_BAR; PG8_SCHED;
            PG8_LDA(At, 0, 1); PG8_STAGE(PG8_SB(0, 0), b2, voffB); PG8_STAGE(PG8_SB(0, 1), b2 + hstep, voffB); PG8_STAGE(PG8_SA(0, 0), a2, voffA);
            PG8_WAIT_V(8); PG8_WAIT_L(0); PG8_BAR; PG8_MMA(1, 0, At, B0); PG8_MMA(1, 1, At, B1); PG8_BAR; PG8_SCHED;
            PG8_LDB(B0, 1, 0); PG8_LDB(B1, 1, 1); PG8_SCHED; PG8_LDA(At, 1, 0); PG8_STAGE(PG8_SA(0, 1), a2 + hstep, voffA);
            PG8_WAIT_V(8); PG8_WAIT_L(0); PG8_BAR; PG8_MMA(0, 0, At, B0); PG8_MMA(0, 1, At, B1); PG8_BAR; PG8_SCHED;
            PG8_LDA(At, 1, 1); PG8_STAGE(PG8_SB(1, 0), b3, voffB); PG8_STAGE(PG8_SB(1, 1), b3 + hstep, voffB); PG8_STAGE(PG8_SA(1, 0), a3, voffA);
            PG8_WAIT_V(8); PG8_WAIT_L(0); PG8_BAR; PG8_MMA(1, 0, At, B0); PG8_MMA(1, 1, At, B1); PG8_BAR; PG8_SCHED;
            } else {
            PG8_LDB(B0, 0, 0); PG8_SCHED; PG8_LDA(At, 0, 0); PG8_STAGE(PG8_SA(1, 1), a1 + hstep, voffA);
            PG8_WAIT_L(8); PG8_BAR; PG8_WAIT_L(0); PG8_MMA(0, 0, At, B0); PG8_BAR; PG8_SCHED;
            PG8_LDB(B1, 0, 1); PG8_STAGE(PG8_SB(0, 0), b2, voffB);
            PG8_BAR; PG8_WAIT_L(0); PG8_MMA(0, 1, At, B1); PG8_BAR;
            PG8_LDA(At, 0, 1); PG8_STAGE(PG8_SA(0, 0), a2, voffA);
            PG8_BAR; PG8_WAIT_L(0); PG8_MMA(1, 0, At, B0); PG8_BAR; PG8_SCHED;
            PG8_STAGE(PG8_SB(0, 1), b2 + hstep, voffB);
            PG8_WAIT_V(6); PG8_BAR; PG8_MMA(1, 1, At, B1); PG8_BAR;
            PG8_LDB(B0, 1, 0); PG8_SCHED; PG8_LDA(At, 1, 0); PG8_STAGE(PG8_SA(0, 1), a2 + hstep, voffA);
            PG8_WAIT_L(8); PG8_BAR; PG8_WAIT_L(0); PG8_MMA(0, 0, At, B0); PG8_BAR; PG8_SCHED;
            PG8_LDB(B1, 1, 1); PG8_STAGE(PG8_SB(1, 0), b3, voffB);
            PG8_BAR; PG8_WAIT_L(0); PG8_MMA(0, 1, At, B1); PG8_BAR;
            PG8_LDA(At, 1, 1); PG8_STAGE(PG8_SA(1, 0), a3, voffA);
            PG8_BAR; PG8_WAIT_L(0); PG8_MMA(1, 0, At, B0); PG8_BAR; PG8_SCHED;
            PG8_STAGE(PG8_SB(1, 1), b3 + hstep, voffB);
            PG8_WAIT_V(6); PG8_BAR; PG8_MMA(1, 1, At, B1); PG8_BAR;
            }
        }
        if constexpr (ALIGN_EPI) { if (wr == 0) PG8_BAR; }
        if constexpr (!Epi::AFTER_DRAIN) { E(acc, cur, wr, wc, fr, fq); S.done(cur); }
        if (!has_next) break;
#pragma unroll
        for (int a = 0; a < 2; ++a)
#pragma unroll
            for (int b = 0; b < 2; ++b)
#pragma unroll
                for (int m = 0; m < 4; ++m)
#pragma unroll
                    for (int n = 0; n < 2; ++n) acc[a][b][m][n] = (f32x4){0.f, 0.f, 0.f, 0.f};
        cur = nxt; cA = nA; cB = nB; ++ui;
        if constexpr (ALIGN_EPI) { if (wr == 1) PG8_BAR; }
    }
    PG8_WAIT_V(0);
    if constexpr (!ALIGN_EPI) { if (wr == 0) PG8_BAR; }
    PG8_BAR;
#undef PG8_SA
#undef PG8_SB
#undef PG8_STAGE
#undef PG8_LDA
#undef PG8_LDB
#undef PG8_MMA
#undef PG8_WAIT_V
#undef PG8_WAIT_L
#undef PG8_BAR
#undef PG8_SCHED
}
}

__device__ __forceinline__ void transpose_item(const float* W, int K, int N, bf16_t* WT, int k0, int np0, int srcn0, const float* g, LAS float* scr, int lane) {
#pragma unroll 8
    for (int i = 0; i < 32; ++i) { const int kk = 2 * i + (lane >> 5); float v = W[(size_t)(k0 + kk) * N + srcn0 + (lane & 31)]; if (g) v *= g[k0 + kk]; scr[kk * 33 + (lane & 31)] = v; }
    asm volatile("s_waitcnt lgkmcnt(0)" ::: "memory");
    const int c = lane & 7;
#pragma unroll
    for (int j = 0; j < 4; ++j) { const int n = (lane >> 3) + 8 * j; const LAS float* s = scr + (8 * c) * 33 + n;
        u32x4 o; o.x = cvt_pk_bf16(s[0 * 33], s[1 * 33]); o.y = cvt_pk_bf16(s[2 * 33], s[3 * 33]); o.z = cvt_pk_bf16(s[4 * 33], s[5 * 33]); o.w = cvt_pk_bf16(s[6 * 33], s[7 * 33]);
        *(u32x4*)(WT + (size_t)(np0 + n) * K + k0 + 8 * c) = o; }
    asm volatile("s_waitcnt lgkmcnt(0)" ::: "memory");
}
__device__ __forceinline__ int src_in_ab(int np) {
    const int pn = np >> 8, cc = np & 255, bj = cc >> 7, off = cc & 127;
    if (pn < 4) return (bj ? 512 : 0) + 128 * pn + off;
    if (pn < 8) return (bj ? 2048 : 1536) + 128 * (pn - 4) + off;
    return 1024 + 256 * (pn - 8) + cc;
}
__device__ __forceinline__ int src_ffn(int np) { const int pn = np >> 8, cc = np & 255, bj = cc >> 7, off = cc & 127; return (bj ? DFF : 0) + 128 * pn + off; }

struct Args { const float* in[22]; float* out; unsigned char* ws; };

__device__ __forceinline__ void p0_prologue(const Args& a, LAS unsigned char* lds, int gw, int NGW, int lane, int wave) {
    LAS float* scr = (LAS float*)(lds + wave * 16384);
    unsigned char* ws = a.ws;
    constexpr int I_IN = (D / 64) * (NIN / 32), I_SQ = (D / 64) * (D / 32), I_QKV = (D / 64) * (3 * D / 32), I_F = (D / 64) * (2 * DFF / 32), I_DN = (DFF / 64) * (D / 32);
    constexpr int NITEMS = I_IN + 2 * I_SQ + I_QKV + 2 * I_F + 2 * I_DN;
    for (int it = gw; it < NITEMS; it += NGW) {
        int r = it;
        if (r < I_IN) { const int nb = NIN / 32, kb = r / nb, n0 = 32 * (r % nb); transpose_item(a.in[10], D, NIN, (bf16_t*)(ws + WS_WIN), 64 * kb, n0, src_in_ab(n0), a.in[7], scr, lane); continue; } r -= I_IN;
        if (r < I_SQ) { const int nb = D / 32, kb = r / nb, n0 = 32 * (r % nb); transpose_item(a.in[16], D, D, (bf16_t*)(ws + WS_WOUT), 64 * kb, n0, n0, nullptr, scr, lane); continue; } r -= I_SQ;
        if (r < I_QKV) { const int nb = 3 * D / 32, kb = r / nb, n0 = 32 * (r % nb); transpose_item(a.in[17], D, 3 * D, (bf16_t*)(ws + WS_WQKV), 64 * kb, n0, n0, a.in[7] + D, scr, lane); continue; } r -= I_QKV;
        if (r < I_SQ) { const int nb = D / 32, kb = r / nb, n0 = 32 * (r % nb); transpose_item(a.in[18], D, D, (bf16_t*)(ws + WS_WO), 64 * kb, n0, n0, nullptr, scr, lane); continue; } r -= I_SQ;
        if (r < 2 * I_F) { const int l = r / I_F; r -= l * I_F; const int nb = 2 * DFF / 32, kb = r / nb, n0 = 32 * (r % nb);
            transpose_item(a.in[19] + (size_t)l * D * 2 * DFF, D, 2 * DFF, (bf16_t*)(ws + (l ? WS_WF1 : WS_WF0)), 64 * kb, n0, src_ffn(n0), a.in[8] + l * D, scr, lane); continue; } r -= 2 * I_F;
        { const int l = r / I_DN; r -= l * I_DN; const int nb = D / 32, kb = r / nb, n0 = 32 * (r % nb);
            transpose_item(a.in[21] + (size_t)l * DFF * D, DFF, D, (bf16_t*)(ws + (l ? WS_WD1 : WS_WD0)), 64 * kb, n0, n0, nullptr, scr, lane); }
    }
    bf16_t* HB = (bf16_t*)(ws + WS_HB); float* ssq = (float*)(ws + WS_SSQ);
    for (int r = gw; r < MPAD; r += NGW) {
        f32x4 v[4]; float s = 0.f;
        if (r < MTOT) {
            const f32x4* xr = (const f32x4*)((r < MPR) ? a.in[0] + (size_t)r * D : a.in[1] + (size_t)(r - MPR) * D) + lane;
#pragma unroll
            for (int j = 0; j < 4; ++j) { v[j] = xr[64 * j]; s += (v[j].x * v[j].x + v[j].y * v[j].y) + (v[j].z * v[j].z + v[j].w * v[j].w); }
        } else {
#pragma unroll
            for (int j = 0; j < 4; ++j) v[j] = (f32x4){0.f, 0.f, 0.f, 0.f};
        }
        s = wave_sum(s);
        u32x2* o8 = (u32x2*)(HB + (size_t)r * D) + lane;
#pragma unroll
        for (int j = 0; j < 4; ++j) { u32x2 w; w.x = cvt_pk_bf16(v[j].x, v[j].y); w.y = cvt_pk_bf16(v[j].z, v[j].w); o8[64 * j] = w; }
        if (lane < 16) ssq[(size_t)r * 16 + lane] = (lane == 0) ? s : 0.f;
    }
    {
        const int tot = NSB * 26 * (CH / 4);
        for (int i = gw * 64 + lane; i < tot; i += NGW * 64) { const int sb = i / (26 * (CH / 4)), rem = i % (26 * (CH / 4));
            ((f32x4*)(a.out + O_SCA + (size_t)sb * 30 * CH))[rem] = ((const f32x4*)(a.in[2] + (size_t)sb * 30 * CH + 4 * CH))[rem]; }
    }
    {
        const size_t per = (size_t)(LBUF - NST) * D / 4;
        const size_t tot = per * NSB;
        for (size_t i = (size_t)gw * 64 + lane; i < tot; i += (size_t)NGW * 64) {
            const size_t sb = i / per, rem = i % per;
            const f32x4 kv = __builtin_nontemporal_load((const f32x4*)(a.in[4] + (sb * LBUF + NST) * D) + rem);
            const f32x4 vv = __builtin_nontemporal_load((const f32x4*)(a.in[5] + (sb * LBUF + NST) * D) + rem);
            __builtin_nontemporal_store(kv, (f32x4*)(a.out + O_SK + sb * LBUF * D) + rem);
            __builtin_nontemporal_store(vv, (f32x4*)(a.out + O_SV + sb * LBUF * D) + rem);
        }
    }
}

__device__ __forceinline__ void p2_conv(const Args& a, LAS unsigned char* lds, int tid, int lane, int wave) {
    unsigned char* ws = a.ws;
    const bf16_t* GA = (const bf16_t*)(ws + WS_GA); bf16_t* AB = (bf16_t*)(ws + WS_AB);
    LAS float* T = (LAS float*)lds;
    const float* wa = a.in[11]; const float* ba = a.in[12]; const float* lg = a.in[13]; const float* lb = a.in[14]; const float* wb = a.in[15];
    for (int u = blockIdx.x; u < 512 + NSB; u += gridDim.x) {
        const bool samp = u >= 512; const int sb = u - 512;
        const int row0 = samp ? MPR + sb * NST : u * 32, nrows = samp ? NST : 32;
        const int t0 = samp ? 0 : (row0 & (SEQ - 1));
        const int nvec = (nrows + 30) * (CH / 8);
        for (int i = tid; i < nvec; i += NTHREADS) {
            const int e = i >> 6, c = (i & 63) * 8; const int p = t0 - 30 + e;
            f32x4 v0 = (f32x4){0.f, 0.f, 0.f, 0.f}, v1 = v0;
            if (p >= 0) { const u32x4 w = *(const u32x4*)(GA + (size_t)(row0 - t0 + p) * GAW + c);
                v0 = (f32x4){bflo(w.x), bfhi(w.x), bflo(w.y), bfhi(w.y)}; v1 = (f32x4){bflo(w.z), bfhi(w.z), bflo(w.w), bfhi(w.w)}; }
            else if (samp) { const float* sp = a.in[2] + ((size_t)sb * 30 + e) * CH + c; v0 = *(const f32x4*)sp; v1 = *(const f32x4*)(sp + 4); }
            *(LAS f32x4*)(T + e * CH + c) = v0; *(LAS f32x4*)(T + e * CH + c + 4) = v1;
        }
        __syncthreads();
        if (tid < 256) {
            const int c = 2 * tid; f32x2 w[KA];
#pragma unroll
            for (int k = 0; k < KA; ++k) w[k] = *(const f32x2*)(wa + k * CH + c);
            const f32x2 bias = *(const f32x2*)(ba + c);
            for (int i = 0; i < nrows; ++i) {
                f32x2 s = bias;
#pragma unroll
                for (int k = 0; k < KA; ++k) { const f32x2 x = *(const LAS f32x2*)(T + (i + k) * CH + c); s += w[k] * x; }
                *(LAS f32x2*)(T + i * CH + c) = s;
            }
        } else {
            const int t2 = tid - 256;
            for (int i = t2; i < nrows * 64; i += 256) {
                const int rr = i >> 6, c = (i & 63) * 8; const int r = row0 + rr, p = t0 + rr;
                float x[3][8];
#pragma unroll
                for (int k = 0; k < 3; ++k) { const int pp = p - 2 + k;
                    if (pp >= 0) { const u32x4 wv = *(const u32x4*)(GA + (size_t)(r - 2 + k) * GAW + 512 + c);
                        x[k][0] = bflo(wv.x); x[k][1] = bfhi(wv.x); x[k][2] = bflo(wv.y); x[k][3] = bfhi(wv.y); x[k][4] = bflo(wv.z); x[k][5] = bfhi(wv.z); x[k][6] = bflo(wv.w); x[k][7] = bfhi(wv.w); }
                    else if (samp) { const float* sp = a.in[3] + ((size_t)sb * 2 + (pp + 2)) * CH + c;
#pragma unroll
                        for (int e = 0; e < 8; ++e) x[k][e] = sp[e]; }
                    else {
#pragma unroll
                        for (int e = 0; e < 8; ++e) x[k][e] = 0.f; } }
                const u32x4 gv = *(const u32x4*)(GA + (size_t)r * GAW + 1024 + c);
                float gb[8] = {bflo(gv.x), bfhi(gv.x), bflo(gv.y), bfhi(gv.y), bflo(gv.z), bfhi(gv.z), bflo(gv.w), bfhi(gv.w)};
                float o[8];
#pragma unroll
                for (int e = 0; e < 8; ++e) o[e] = gb[e] * (wb[0 * CH + c + e] * x[0][e] + wb[1 * CH + c + e] * x[1][e] + wb[2 * CH + c + e] * x[2][e]);
                u32x4 w4; w4.x = cvt_pk_bf16(o[0], o[1]); w4.y = cvt_pk_bf16(o[2], o[3]); w4.z = cvt_pk_bf16(o[4], o[5]); w4.w = cvt_pk_bf16(o[6], o[7]);
                *(u32x4*)(AB + (size_t)r * D + 512 + c) = w4;
            }
        }
        __syncthreads();
        for (int rr = wave; rr < nrows; rr += NWAVES) {
            const int c = lane * 8;
            const f32x4 v0 = *(const LAS f32x4*)(T + rr * CH + c), v1 = *(const LAS f32x4*)(T + rr * CH + c + 4);
            float s = (v0.x + v0.y) + (v0.z + v0.w) + (v1.x + v1.y) + (v1.z + v1.w);
            const float mu = wave_sum(s) * (1.0f / CH);
            const f32x4 d0 = v0 - mu, d1 = v1 - mu;
            float q = (d0.x * d0.x + d0.y * d0.y) + (d0.z * d0.z + d0.w * d0.w) + (d1.x * d1.x + d1.y * d1.y) + (d1.z * d1.z + d1.w * d1.w);
            const float rstd = rsqrtf(wave_sum(q) * (1.0f / CH) + LN_EPS);
            const f32x4 g0 = *(const f32x4*)(lg + c), g1 = *(const f32x4*)(lg + c + 4), b0 = *(const f32x4*)(lb + c), b1 = *(const f32x4*)(lb + c + 4);
            f32x4 a0 = d0 * rstd * g0 + b0, a1 = d1 * rstd * g1 + b1;
#pragma unroll
            for (int e = 0; e < 4; ++e) { a0[e] = a0[e] * sigmoidf_(a0[e]); a1[e] = a1[e] * sigmoidf_(a1[e]); }
            u32x4 w4; w4.x = cvt_pk_bf16(a0[0], a0[1]); w4.y = cvt_pk_bf16(a0[2], a0[3]); w4.z = cvt_pk_bf16(a1[0], a1[1]); w4.w = cvt_pk_bf16(a1[2], a1[3]);
            *(u32x4*)(AB + (size_t)(row0 + rr) * D + c) = w4;
        }
        __syncthreads();
    }
}

__device__ __forceinline__ void p5_combine(const Args& a, int layer, int gtid, int GT) {
    unsigned char* ws = a.ws;
    const bf16_t* ZG = (const bf16_t*)(ws + WS_ZG); const bf16_t* ZU = (const bf16_t*)(ws + WS_ZU); bf16_t* U = (bf16_t*)(ws + WS_U);
    const float* wc = a.in[20] + (size_t)layer * 3 * DFF;
    constexpr int NCV = DFF / 8, NCH = MPR / 16;
    const int nit = NCH * NCV + NSB * NCV;
    for (int it = gtid; it < nit; it += GT) {
        const bool samp = it >= NCH * NCV;
        int r0, nrows, cv, sb = 0;
        if (!samp) { const int ch = it / NCV; cv = it % NCV; r0 = ch * 16; nrows = 16; } else { const int j = it - NCH * NCV; sb = j / NCV; cv = j % NCV; r0 = MPR + sb * NST; nrows = NST; }
        const int c = cv * 8;
        float w0[8], w1[8], w2[8], gm2[8], gm1[8];
#pragma unroll
        for (int e = 0; e < 8; ++e) { w0[e] = wc[c + e]; w1[e] = wc[DFF + c + e]; w2[e] = wc[2 * DFF + c + e]; }
        if (samp) { const float* sp = a.in[6] + ((size_t)(layer * NSB + sb) * 2) * DFF + c;
#pragma unroll
            for (int e = 0; e < 8; ++e) { gm2[e] = sp[e]; gm1[e] = sp[DFF + e]; } }
        else if ((r0 & (SEQ - 1)) == 0) {
#pragma unroll
            for (int e = 0; e < 8; ++e) { gm2[e] = 0.f; gm1[e] = 0.f; } }
        else { const u32x4 p2 = *(const u32x4*)(ZG + (size_t)(r0 - 2) * DFF + c), p1 = *(const u32x4*)(ZG + (size_t)(r0 - 1) * DFF + c);
            gm2[0] = bflo(p2.x); gm2[1] = bfhi(p2.x); gm2[2] = bflo(p2.y); gm2[3] = bfhi(p2.y); gm2[4] = bflo(p2.z); gm2[5] = bfhi(p2.z); gm2[6] = bflo(p2.w); gm2[7] = bfhi(p2.w);
            gm1[0] = bflo(p1.x); gm1[1] = bfhi(p1.x); gm1[2] = bflo(p1.y); gm1[3] = bfhi(p1.y); gm1[4] = bflo(p1.z); gm1[5] = bfhi(p1.z); gm1[6] = bflo(p1.w); gm1[7] = bfhi(p1.w); }
        for (int i = 0; i < nrows; ++i) {
            const size_t off = (size_t)(r0 + i) * DFF + c;
            const u32x4 gv = *(const u32x4*)(ZG + off), uv = *(const u32x4*)(ZU + off);
            float g[8] = {bflo(gv.x), bfhi(gv.x), bflo(gv.y), bfhi(gv.y), bflo(gv.z), bfhi(gv.z), bflo(gv.w), bfhi(gv.w)};
            float up[8] = {bflo(uv.x), bfhi(uv.x), bflo(uv.y), bfhi(uv.y), bflo(uv.z), bfhi(uv.z), bflo(uv.w), bfhi(uv.w)};
            float o[8];
#pragma unroll
            for (int e = 0; e < 8; ++e) { const float y = w0[e] * gm2[e] + w1[e] * gm1[e] + w2[e] * g[e]; o[e] = y * sigmoidf_(y) * up[e]; gm2[e] = gm1[e]; gm1[e] = g[e]; }
            u32x4 w4; w4.x = cvt_pk_bf16(o[0], o[1]); w4.y = cvt_pk_bf16(o[2], o[3]); w4.z = cvt_pk_bf16(o[4], o[5]); w4.w = cvt_pk_bf16(o[6], o[7]);
            *(u32x4*)(U + off) = w4;
        }
    }
}

constexpr int AT_OACC = 0, AT_OSTR = 65, AT_ML = 256 * AT_OSTR * 4, AT_VST = AT_ML + 2048, AT_PSC = AT_VST + NWAVES * 4096;
static_assert(AT_PSC + NWAVES * 2048 <= 131072, "attention LDS");
__device__ __forceinline__ int crow(int r, int hi) { return (r & 3) + 8 * (r >> 2) + 4 * hi; }

__device__ __forceinline__ void attn_task(const bf16_t* Qh, const bf16_t* Kh, const bf16_t* Vh, int dil, int cls, int s0, int nq, float slope2, int qlbase, int qlstep, bool first,
                                          LAS unsigned char* lds, int wave, int lane) {
    const int r32 = lane & 31, hi = lane >> 5;
    const int qi = r32 < nq ? r32 : nq - 1;
    const bf16_t* qp = Qh + (size_t)(cls + dil * (s0 + qi)) * D + hi * 8;
    bf16x8 qr[4];
#pragma unroll
    for (int d0 = 0; d0 < 4; ++d0) qr[d0] = *(const bf16x8*)(qp + d0 * 16);
    float m_run = -INFINITY, l_run = 0.f; f32x16 o[2]; o[0] = f32x16{}; o[1] = f32x16{};
    LAS unsigned char* vst = lds + AT_VST + wave * 4096;
    const int sq = s0 + r32;
    const float sdil = slope2 * (float)dil;
    for (int i = 0; i < 5; ++i) {
        const int kb = s0 - 128 + 32 * i;
        if (kb + 31 < 0) continue;
        const int skv = kb + r32 < 0 ? 0 : kb + r32;
        const bf16_t* kp = Kh + (size_t)(cls + dil * skv) * D + hi * 8;
        bf16x8 kf[4];
#pragma unroll
        for (int d0 = 0; d0 < 4; ++d0) kf[d0] = *(const bf16x8*)(kp + d0 * 16);
        u32x4 vv[4];
#pragma unroll
        for (int j = 0; j < 4; ++j) { const int kv = (lane >> 3) + 8 * j; const int sv = kb + kv < 0 ? 0 : kb + kv;
            vv[j] = *(const u32x4*)(Vh + (size_t)(cls + dil * sv) * D + (lane & 7) * 8); }
        f32x16 st = f32x16{};
#pragma unroll
        for (int d0 = 0; d0 < 4; ++d0) st = __builtin_amdgcn_mfma_f32_32x32x16_bf16(kf[d0], qr[d0], st, 0, 0, 0);
        asm volatile("" ::: "memory");
#pragma unroll
        for (int j = 0; j < 4; ++j) { const int kv = (lane >> 3) + 8 * j, part = lane & 7;
            *(LAS u32x4*)(vst + (part >> 2) * 2048 + (kv >> 3) * 512 + (kv & 7) * 64 + (part & 3) * 16) = vv[j]; }
        float mx = -INFINITY;
#pragma unroll
        for (int r = 0; r < 16; ++r) { const int sk = kb + crow(r, hi); const int ds = sq - sk; const bool ok = (sk >= 0) && (ds >= 0) && (ds <= 128);
            const float x = ok ? st[r] - sdil * (float)ds : -INFINITY; st[r] = x; mx = fmaxf(mx, x); }
        mx = fmaxf(mx, __shfl_xor(mx, 32));
        const float m_new = fmaxf(m_run, mx);
        const float m_use = (m_new == -INFINITY) ? 0.f : m_new;
        const float alpha = __builtin_amdgcn_exp2f(m_run - m_use);
        float ps = 0.f;
#pragma unroll
        for (int r = 0; r < 16; ++r) { const float p = __builtin_amdgcn_exp2f(st[r] - m_use); st[r] = p; ps += p; }
        l_run = l_run * alpha + ps; m_run = m_new;
#pragma unroll
        for (int r = 0; r < 16; ++r) { o[0][r] *= alpha; o[1][r] *= alpha; }
        bf16x8 pa[2];
#pragma unroll
        for (int s = 0; s < 2; ++s) { u32x4 w; w.x = cvt_pk_bf16(st[8 * s + 0], st[8 * s + 1]); w.y = cvt_pk_bf16(st[8 * s + 2], st[8 * s + 3]); w.z = cvt_pk_bf16(st[8 * s + 4], st[8 * s + 5]); w.w = cvt_pk_bf16(st[8 * s + 6], st[8 * s + 7]);
            pa[s] = __builtin_bit_cast(bf16x8, w); }
        asm volatile("s_waitcnt lgkmcnt(0)" ::: "memory");
        const int vb = ((lane >> 4) & 1) * 32 + (lane & 3) * 8 + (4 * hi + ((lane & 15) >> 2)) * 64;
#pragma unroll
        for (int d0 = 0; d0 < 2; ++d0)
#pragma unroll
            for (int s = 0; s < 2; ++s) {
                const s16x4 lo = __builtin_bit_cast(s16x4, __builtin_amdgcn_ds_read_tr16_b64_v4i16((LAS s16x4*)(vst + vb + d0 * 2048 + s * 1024)));
                const s16x4 hh = __builtin_bit_cast(s16x4, __builtin_amdgcn_ds_read_tr16_b64_v4i16((LAS s16x4*)(vst + vb + d0 * 2048 + s * 1024 + 512)));
                const bf16x8 vf = (bf16x8){lo[0], lo[1], lo[2], lo[3], hh[0], hh[1], hh[2], hh[3]};
                o[d0] = __builtin_amdgcn_mfma_f32_32x32x16_bf16(vf, pa[s], o[d0], 0, 0, 0);
            }
        asm volatile("s_waitcnt lgkmcnt(0)" ::: "memory");
    }
    l_run += __shfl_xor(l_run, 32);
    if (r32 < nq) {
        const int ql = qlbase + qlstep * r32;
        LAS float* oa = (LAS float*)(lds + AT_OACC) + ql * AT_OSTR;
        LAS float* ml = (LAS float*)(lds + AT_ML) + ql * 2;
        float a_old = 0.f, a_new = 1.f, m_new = m_run, l_new = l_run;
        if (!first) { const float m_old = ml[0], l_old = ml[1]; m_new = fmaxf(m_old, m_run); const float mu = (m_new == -INFINITY) ? 0.f : m_new;
            a_old = __builtin_amdgcn_exp2f(m_old - mu); a_new = __builtin_amdgcn_exp2f(m_run - mu); l_new = l_old * a_old + l_run * a_new; }
#pragma unroll
        for (int d0 = 0; d0 < 2; ++d0)
#pragma unroll
            for (int r = 0; r < 16; ++r) { const int d = 32 * d0 + crow(r, hi); float v = o[d0][r] * a_new; if (!first) v += oa[d] * a_old; oa[d] = v; }
        asm volatile("s_waitcnt lgkmcnt(0)" ::: "memory");
        if (hi == 0) { ml[0] = m_new; ml[1] = l_new; }
    }
}

__device__ __forceinline__ void p8_attention(const Args& a, LAS unsigned char* lds, int tid, int lane, int wave) {
    unsigned char* ws = a.ws;
    const bf16_t* Q = (const bf16_t*)(ws + WS_Q); const bf16_t* K = (const bf16_t*)(ws + WS_K); const bf16_t* V = (const bf16_t*)(ws + WS_V); bf16_t* O = (bf16_t*)(ws + WS_AB);
#ifndef NO_SAMPLE
    {
        const float* QS = (const float*)(ws + WS_QS);
        LAS float* psc = (LAS float*)(lds + AT_PSC + wave * 2048);
        for (int task = blockIdx.x * NWAVES + wave; task < NSB * NH * NST; task += gridDim.x * NWAVES) {
            const int sb = task / (NH * NST), h = (task / NST) % NH, j = task % NST;
            const float slope2 = exp2f(-0.5f * (float)(h + 1)) * LOG2E;
            const float* kc = a.in[4] + (size_t)sb * LBUF * D + h * HD; const float* vc = a.in[5] + (size_t)sb * LBUF * D + h * HD;
            const float* kn = a.out + O_SK + ((size_t)sb * LBUF + (LBUF - NST)) * D + h * HD; const float* vn = a.out + O_SV + ((size_t)sb * LBUF + (LBUF - NST)) * D + h * HD;
            const float* qrow = QS + (size_t)(sb * NST + j) * D + h * HD;
            f32x4 qv[16];
#pragma unroll
            for (int e = 0; e < 16; ++e) qv[e] = *(const f32x4*)(qrow + 4 * e);
            float mx = -INFINITY;
#pragma clang loop unroll(disable)
            for (int rd = 0; rd < 7; ++rd) {
                const int kk = rd * 64 + lane; float s = -INFINITY;
                if (kk < 387) { const int g = kk / 129, mm = kk % 129, dil = (g == 0) ? 1 : (g == 1 ? 4 : 16); const int idx = LBUF + j - mm * dil;
                    const float* kr = (idx >= LBUF) ? kn + (size_t)(idx - LBUF) * D : kc + (size_t)idx * D;
                    float acc = 0.f;
#pragma unroll
                    for (int e = 0; e < 16; ++e) { const f32x4 kx = *(const f32x4*)(kr + 4 * e); acc += (qv[e].x * kx.x + qv[e].y * kx.y) + (qv[e].z * kx.z + qv[e].w * kx.w); }
                    s = acc - slope2 * (float)(mm * dil); }
                psc[kk] = s; mx = fmaxf(mx, s);
            }
            mx = wave_max(mx);
            asm volatile("s_waitcnt lgkmcnt(0)" ::: "memory");
            float l = 0.f;
#pragma clang loop unroll(disable)
            for (int rd = 0; rd < 7; ++rd) { const float p = __builtin_amdgcn_exp2f(psc[rd * 64 + lane] - mx); l += p; psc[rd * 64 + lane] = p; }
            l = wave_sum(l);
            asm volatile("s_waitcnt lgkmcnt(0)" ::: "memory");
            float acc = 0.f;
            for (int kk = 0; kk < 387; ++kk) { const int g = kk / 129, mm = kk % 129, dil = (g == 0) ? 1 : (g == 1 ? 4 : 16); const int idx = LBUF + j - mm * dil;
                const float* vr = (idx >= LBUF) ? vn + (size_t)(idx - LBUF) * D : vc + (size_t)idx * D;
                acc += psc[kk] * vr[lane]; }
            acc *= __builtin_amdgcn_rcpf(l);
            const float hi_ = __shfl_down(acc, 1);
            if ((lane & 1) == 0) *(unsigned*)(O + (size_t)(MPR + sb * NST + j) * D + h * HD + lane) = cvt_pk_bf16(acc, hi_);
            asm volatile("s_waitcnt lgkmcnt(0)" ::: "memory");
        }
    }
#endif
    __syncthreads();
#ifndef NO_PROMPT
    for (int u = blockIdx.x; u < NB * NH * 8; u += gridDim.x) {
        const int qblk = u & 7, h = (u >> 3) & 15, b = u >> 7;
        const float slope2 = exp2f(-0.5f * (float)(h + 1)) * LOG2E;
        const bf16_t* Qh = Q + (size_t)b * SEQ * D + h * HD; const bf16_t* Kh = K + (size_t)b * SEQ * D + h * HD; const bf16_t* Vh = V + (size_t)b * SEQ * D + h * HD;
#pragma clang loop unroll(disable)
        for (int tk = 0; tk < 4; ++tk) {
            int dil, cls, s0, nq, qlb, qls;
            if (tk == 0) { dil = 1; cls = 0; s0 = 256 * qblk + 32 * wave; nq = 32; qlb = 32 * wave; qls = 1; }
            else if (tk == 1) { dil = 4; cls = wave & 3; s0 = 64 * qblk + 32 * (wave >> 2); nq = 32; qlb = (wave & 3) + 128 * (wave >> 2); qls = 4; }
            else { dil = 16; cls = 2 * wave + (tk - 2); s0 = 16 * qblk; nq = 16; qlb = cls; qls = 16; }
            attn_task(Qh, Kh, Vh, dil, cls, s0, nq, slope2, qlb, qls, tk == 0, lds, wave, lane);
            if (tk != 2) __syncthreads();
        }
        {
            const int ql = tid >> 1, dh = (tid & 1) * 32;
            const LAS float* oa = (const LAS float*)(lds + AT_OACC) + ql * AT_OSTR + dh;
            const float inv = __builtin_amdgcn_rcpf(((const LAS float*)(lds + AT_ML))[ql * 2 + 1]);
            bf16_t* op = O + (size_t)(b * SEQ + 256 * qblk + ql) * D + h * HD + dh;
#pragma unroll
            for (int e = 0; e < 4; ++e) { u32x4 w; w.x = cvt_pk_bf16(oa[8 * e + 0] * inv, oa[8 * e + 1] * inv); w.y = cvt_pk_bf16(oa[8 * e + 2] * inv, oa[8 * e + 3] * inv);
                w.z = cvt_pk_bf16(oa[8 * e + 4] * inv, oa[8 * e + 5] * inv); w.w = cvt_pk_bf16(oa[8 * e + 6] * inv, oa[8 * e + 7] * inv); *(u32x4*)(op + 8 * e) = w; }
        }
        __syncthreads();
    }
#endif
}

__device__ __forceinline__ void p13_final(const Args& a, int gw, int NGW, int lane) {
    const float* H = (const float*)(a.ws + WS_H); const float* g = a.in[9];
    for (int r = gw; r < MTOT; r += NGW) {
        const f32x4* xr = (const f32x4*)(H + (size_t)r * D) + lane; f32x4 v[4]; float s = 0.f;
#pragma unroll
        for (int j = 0; j < 4; ++j) { v[j] = xr[64 * j]; s += (v[j].x * v[j].x + v[j].y * v[j].y) + (v[j].z * v[j].z + v[j].w * v[j].w); }
        const float rstd = rsqrtf(wave_sum(s) * (1.0f / D) + RMS_EPS);
        f32x4* o = (f32x4*)(a.out + (size_t)r * D) + lane;
#pragma unroll
        for (int j = 0; j < 4; ++j) o[64 * j] = v[j] * rstd * ((const f32x4*)g)[64 * j + lane];
    }
}

typedef const __attribute__((address_space(4))) Args* kargp_t;
__device__ __forceinline__ Args kargs() {
    Args a;
#if defined(__HIP_DEVICE_COMPILE__)
    kargp_t p = (kargp_t)__builtin_amdgcn_kernarg_segment_ptr(); asm volatile("" : "+s"(p));
#pragma unroll
    for (int i = 0; i < 22; ++i) a.in[i] = p->in[i];
    a.out = p->out; a.ws = p->ws;
#else
    for (int i = 0; i < 22; ++i) a.in[i] = nullptr;
    a.out = nullptr; a.ws = nullptr;
#endif
    return a;
}
#define PHASE_BEGIN const Args a = kargs(); unsigned char* ws = a.ws; const int tid = launder_v(threadIdx.x), lane = tid & 63, wave = __builtin_amdgcn_readfirstlane(tid >> 6); \
    const int G = gridDim.x, gw = blockIdx.x * NWAVES + wave, NGW = G * NWAVES; (void)ws; (void)lane; (void)gw; (void)NGW; (void)G;
__global__ void __launch_bounds__(NTHREADS, 2) mega_fwd(Args a_unused) {
    extern __shared__ __attribute__((aligned(16))) unsigned char lds_raw[];
    LAS unsigned char* lds = (LAS unsigned char*)lds_raw;
    cg::grid_group grid = cg::this_grid();
#define GRID_BAR() grid.sync()
#ifndef PHASES
#define PHASES 0xFFFF
#endif
#define PH(k) if constexpr (((PHASES) >> (k)) & 1)

    PH(0) { PHASE_BEGIN p0_prologue(a, lds, gw, NGW, lane, wave); }
    GRID_BAR();
    PH(1) {
        PHASE_BEGIN
        pg8::Gemm g{(const bf16_t*)(ws + WS_HB), (const bf16_t*)(ws + WS_WIN), MPAD, NIN, D}; pg8::StaticOrder S; S.init(MPAD, NIN, G, (int)blockIdx.x);
        pg8::EpiInAB E{(bf16_t*)(ws + WS_GA), (const float*)(ws + WS_SSQ), a.out};
        pg8::gemm_phase<pg8::EpiInAB, pg8::StaticOrder, true, true>(lds, g, S, E);
    }
    GRID_BAR();
    PH(2) { PHASE_BEGIN p2_conv(a, lds, tid, lane, wave); }
    GRID_BAR();
    PH(3) {
        PHASE_BEGIN
        pg8::Gemm g{(const bf16_t*)(ws + WS_AB), (const bf16_t*)(ws + WS_WOUT), MPAD, D, D}; pg8::StaticOrder S; S.init(MPAD, D, G, (int)blockIdx.x);
        pg8::EpiResid E{a.in[0], a.in[1], (float*)(ws + WS_H), (bf16_t*)(ws + WS_HB), (float*)(ws + WS_SSQ)};
        pg8::gemm_phase<pg8::EpiResid, pg8::StaticOrder, true, true>(lds, g, S, E);
    }
    GRID_BAR();
#pragma clang loop unroll(disable)
    for (int layer = 0; layer < 2; ++layer) {
        if (layer == 1) {
            PH(7) {
                PHASE_BEGIN
                pg8::Gemm g{(const bf16_t*)(ws + WS_HB), (const bf16_t*)(ws + WS_WQKV), MPAD, 3 * D, D}; pg8::StaticOrder S; S.init(MPAD, 3 * D, G, (int)blockIdx.x);
                pg8::EpiQkv E{(bf16_t*)(ws + WS_Q), (float*)(ws + WS_QS), (const float*)(ws + WS_SSQ), a.out};
                pg8::gemm_phase<pg8::EpiQkv, pg8::StaticOrder, true, true>(lds, g, S, E);
            }
            GRID_BAR();
            PH(8) { PHASE_BEGIN p8_attention(a, lds, tid, lane, wave); }
            GRID_BAR();
            PH(9) {
                PHASE_BEGIN
                float* H = (float*)(ws + WS_H);
                pg8::Gemm g{(const bf16_t*)(ws + WS_AB), (const bf16_t*)(ws + WS_WO), MPAD, D, D}; pg8::StaticOrder S; S.init(MPAD, D, G, (int)blockIdx.x);
                pg8::EpiResid E{H, H + (size_t)MPR * D, H, (bf16_t*)(ws + WS_HB), (float*)(ws + WS_SSQ)};
                pg8::gemm_phase<pg8::EpiResid, pg8::StaticOrder, true, true>(lds, g, S, E);
            }
            GRID_BAR();
        }
        PH(4) {
            PHASE_BEGIN
            pg8::Gemm g{(const bf16_t*)(ws + WS_HB), (const bf16_t*)(ws + (layer ? WS_WF1 : WS_WF0)), MPAD, 2 * DFF, D}; pg8::StaticOrder S; S.init(MPAD, 2 * DFF, G, (int)blockIdx.x);
            pg8::EpiFfn E{(bf16_t*)(ws + WS_ZG), (bf16_t*)(ws + WS_ZU), (const float*)(ws + WS_SSQ), a.out, layer};
            pg8::gemm_phase<pg8::EpiFfn, pg8::StaticOrder, true, true>(lds, g, S, E);
        }
        GRID_BAR();
        PH(5) { PHASE_BEGIN p5_combine(a, layer, blockIdx.x * NTHREADS + tid, G * NTHREADS); }
        GRID_BAR();
        PH(6) {
            PHASE_BEGIN
            float* H = (float*)(ws + WS_H);
            pg8::Gemm g{(const bf16_t*)(ws + WS_U), (const bf16_t*)(ws + (layer ? WS_WD1 : WS_WD0)), MPAD, D, DFF}; pg8::StaticOrder S; S.init(MPAD, D, G, (int)blockIdx.x);
            pg8::EpiResid E{H, H + (size_t)MPR * D, H, (bf16_t*)(ws + WS_HB), (float*)(ws + WS_SSQ)};
            pg8::gemm_phase<pg8::EpiResid, pg8::StaticOrder, true, true>(lds, g, S, E);
        }
        GRID_BAR();
    }
    PH(13) { PHASE_BEGIN p13_final(a, gw, NGW, lane); }
}

extern "C" void kernel_launch(void* const* d_in, const int* in_sizes, int n_in, void* d_out, int out_size, void* d_ws, size_t ws_size, hipStream_t stream) {
    static int grid = 0;
    if (grid == 0) {
        if (n_in != 22 || (size_t)out_size != O_END || ws_size < WS_END) { fprintf(stderr, "kernel_launch: unexpected shapes (n_in %d, out %d, ws %zu, need %zu)\n", n_in, out_size, ws_size, (size_t)WS_END); grid = -1; return; }
        int dev = 0, cus = 0, per_cu = 0;
        if (hipGetDevice(&dev) != hipSuccess || hipDeviceGetAttribute(&cus, hipDeviceAttributeMultiprocessorCount, dev) != hipSuccess) { grid = -1; return; }
        if (hipFuncSetAttribute((const void*)mega_fwd, hipFuncAttributeMaxDynamicSharedMemorySize, LDS_BYTES) != hipSuccess) { fprintf(stderr, "kernel_launch: hipFuncSetAttribute failed\n"); grid = -1; return; }
        if (hipOccupancyMaxActiveBlocksPerMultiprocessor(&per_cu, (const void*)mega_fwd, NTHREADS, LDS_BYTES) != hipSuccess || per_cu < 1) { fprintf(stderr, "kernel_launch: occupancy query failed (%d)\n", per_cu); (void)hipGetLastError(); grid = -1; return; }
        grid = cus * 1;
    }
    if (grid < 0) return;
    Args a{};
    for (int i = 0; i < 22; ++i) a.in[i] = (const float*)d_in[i];
    a.out = (float*)d_out; a.ws = (unsigned char*)d_ws;
    void* args[] = {&a};
    hipError_t e = hipLaunchCooperativeKernel((const void*)mega_fwd, dim3(grid), dim3(NTHREADS), args, LDS_BYTES, stream);
    if (e != hipSuccess) fprintf(stderr, "cooperative launch failed: %s (grid %d)\n", hipGetErrorString(e), grid);
}
```

```cpp
#include <hip/hip_runtime.h>
#include <hip/hip_cooperative_groups.h>
#include <cstdio>
#include <cstdint>
namespace cg = cooperative_groups;

#define LAS __attribute__((address_space(3)))
typedef unsigned short bf16_t;
typedef short bf16x8 __attribute__((ext_vector_type(8)));
typedef float f32x4 __attribute__((ext_vector_type(4)));
typedef float f32x2 __attribute__((ext_vector_type(2)));
typedef float f32x16 __attribute__((ext_vector_type(16)));
typedef unsigned u32x4 __attribute__((ext_vector_type(4)));
typedef unsigned u32x2 __attribute__((ext_vector_type(2)));
typedef short s16x4 __attribute__((ext_vector_type(4)));

constexpr int D = 1024, SEQ = 2048, NB = 8, MPR = NB * SEQ, NSB = 32, NST = 4, MSA = NSB * NST, MTOT = MPR + MSA, MPAD = 16640;
constexpr int DFF = 2816, NIN = 2560, CH = 512, NH = 16, HD = 64, LBUF = 2048, KA = 31;
constexpr int GAW = 1536;
constexpr float RMS_EPS = 1e-6f, LN_EPS = 1e-5f;
constexpr float LOG2E = 1.4426950408889634f;
constexpr float QSCALE = 0.125f * LOG2E;

constexpr size_t O_YP = 0;
constexpr size_t O_YS = O_YP + (size_t)MPR * D;
constexpr size_t O_PCA = O_YS + (size_t)MSA * D;
constexpr size_t O_SCA = O_PCA + (size_t)NB * 30 * CH;
constexpr size_t O_PCB = O_SCA + (size_t)NSB * 30 * CH;
constexpr size_t O_SCB = O_PCB + (size_t)NB * 2 * CH;
constexpr size_t O_PK = O_SCB + (size_t)NSB * 2 * CH;
constexpr size_t O_SK = O_PK + (size_t)MPR * D;
constexpr size_t O_PV = O_SK + (size_t)NSB * LBUF * D;
constexpr size_t O_SV = O_PV + (size_t)MPR * D;
constexpr size_t O_PF = O_SV + (size_t)NSB * LBUF * D;
constexpr size_t O_SF = O_PF + (size_t)2 * NB * 2 * DFF;
constexpr size_t O_END = O_SF + (size_t)2 * NSB * 2 * DFF;

constexpr size_t al(size_t x) { return (x + 4095) & ~(size_t)4095; }
constexpr size_t WS_CTL = 0, CTL_BYTES = 65536;
constexpr size_t WS_WIN = WS_CTL + CTL_BYTES;
constexpr size_t WS_WOUT = WS_WIN + al((size_t)NIN * D * 2);
constexpr size_t WS_WQKV = WS_WOUT + al((size_t)D * D * 2);
constexpr size_t WS_WO = WS_WQKV + al((size_t)3 * D * D * 2);
constexpr size_t WS_WF0 = WS_WO + al((size_t)D * D * 2);
constexpr size_t WS_WF1 = WS_WF0 + al((size_t)2 * DFF * D * 2);
constexpr size_t WS_WD0 = WS_WF1 + al((size_t)2 * DFF * D * 2);
constexpr size_t WS_WD1 = WS_WD0 + al((size_t)D * DFF * 2);
constexpr size_t WS_HB = WS_WD1 + al((size_t)D * DFF * 2);
constexpr size_t WS_H = WS_HB + al((size_t)MPAD * D * 2);
constexpr size_t WS_SSQ = WS_H + al((size_t)MPAD * D * 4);
constexpr size_t WS_GA = WS_SSQ + al((size_t)MPAD * 16 * 4);
constexpr size_t WS_AB = WS_GA + al((size_t)MPAD * GAW * 2);
constexpr size_t WS_ZG = WS_AB + al((size_t)MPAD * D * 2);
constexpr size_t WS_ZU = WS_ZG + al((size_t)MPAD * DFF * 2);
constexpr size_t WS_U = WS_ZU + al((size_t)MPAD * DFF * 2);
constexpr size_t WS_Q = WS_U + al((size_t)MPAD * DFF * 2);
constexpr size_t WS_K = WS_Q + al((size_t)MPAD * D * 2);
constexpr size_t WS_V = WS_K + al((size_t)MPAD * D * 2);
constexpr size_t WS_QS = WS_V + al((size_t)MPAD * D * 2);
constexpr size_t WS_END = WS_QS + al((size_t)MSA * D * 4);
static_assert(WS_V - WS_K == WS_K - WS_Q, "Q|K|V equally spaced");

constexpr int NWAVES = 8, NTHREADS = 512;
constexpr int LDS_BYTES = 147456;

__device__ __forceinline__ unsigned cvt_pk_bf16(float lo, float hi) { unsigned r; asm volatile("v_cvt_pk_bf16_f32 %0, %1, %2" : "=v"(r) : "v"(lo), "v"(hi)); return r; }
__device__ __forceinline__ float bf2f(unsigned short b) { return __uint_as_float((unsigned)b << 16); }
__device__ __forceinline__ float bflo(unsigned w) { return __uint_as_float(w << 16); }
__device__ __forceinline__ float bfhi(unsigned w) { return __uint_as_float(w & 0xffff0000u); }
__device__ __forceinline__ float sigmoidf_(float x) { return __builtin_amdgcn_rcpf(1.0f + __expf(-x)); }
__device__ __forceinline__ int launder_v(int x) { asm volatile("" : "+v"(x)); return x; }
__device__ __forceinline__ float wave_sum(float v) {
#pragma unroll
    for (int o = 1; o < 64; o <<= 1) v += __shfl_xor(v, o);
    return v;
}
__device__ __forceinline__ float wave_max(float v) {
#pragma unroll
    for (int o = 1; o < 64; o <<= 1) v = fmaxf(v, __shfl_xor(v, o));
    return v;
}

namespace pg8 {
constexpr int BM = 256, BK = 64, HALF = 128, HTB = HALF * BK * 2, STAGE_BYTES = 8 * HTB, NXCD = 8, WGM = 8;
__host__ __device__ __forceinline__ int lds_byte(int r, int c) { const int st = (r >> 4) * 2 + (c >> 5), rr = r & 15, cc = c & 31, ob = rr * 64 + cc * 2; return st * 1024 + (ob ^ (((ob >> 9) & 1) << 5)); }
__host__ __device__ __forceinline__ void stage_rc(int b, int& R, int& C) { const int st = b / 1024, sb = b % 1024, swz = sb ^ (((sb >> 9) & 1) << 5); R = (st >> 1) * 16 + swz / 64; C = (st & 1) * 32 + (swz % 64) / 2; }
__host__ __device__ __forceinline__ int perm32(int rho) { const int n = rho >> 4, i = rho & 15; return 8 * (i >> 2) + 4 * n + (i & 3); }

struct Unit { int pm, pn; };
struct Gemm { const bf16_t* A; const bf16_t* Bt; int M, N, K; };

struct StaticOrder {
    int nM, nN, nwg, G, c;
    __host__ __device__ void init(int M, int N, int G_, int c_) { nM = M / BM; nN = N / BM; nwg = nM * nN; G = G_; c = c_; }
    __host__ __device__ bool next(int i, Unit& u) const {
        const long L = (long)i * G + c; if (L >= nwg) return false;
        int wgid = (int)L; { const int q = nwg / NXCD, r = nwg % NXCD, xcd = wgid % NXCD, off = wgid / NXCD; wgid = (xcd < r ? xcd * (q + 1) : r * (q + 1) + (xcd - r) * q) + off; }
        const int nig = WGM * nN, gid = wgid / nig, fm = gid * WGM, gsz = (nM - fm) < WGM ? (nM - fm) : WGM;
        u.pm = fm + ((wgid % nig) % gsz); u.pn = (wgid % nig) / gsz; return true;
    }
    __device__ __forceinline__ void a_ready(const Unit&) const {}
    __device__ __forceinline__ void done(const Unit&) const {}
};

__device__ __forceinline__ float row_rstd(const float* ssq, int r, int fq) {
    const f32x4 p = *(const f32x4*)(ssq + (size_t)r * 16 + 4 * fq);
    float s = (p.x + p.y) + (p.z + p.w);
    s += __shfl_xor(s, 16); s += __shfl_xor(s, 32);
    return rsqrtf(s * (1.0f / D) + RMS_EPS);
}

struct EpiInAB {
    static constexpr bool PERM = true, AFTER_DRAIN = false;
    bf16_t* GA; const float* ssq; float* out;
    __device__ __forceinline__ void operator()(const f32x4 (&acc)[2][2][4][2], const Unit& u, int wr, int wc, int fr, int fq) const {
        const int pn = u.pn, colw = wc * 32 + 8 * fq;
#pragma unroll
        for (int ai = 0; ai < 2; ++ai)
#pragma unroll
            for (int m = 0; m < 4; ++m) {
                const int r = u.pm * BM + ai * HALF + wr * 64 + m * 16 + fr;
                const float rs = row_rstd(ssq, r, fq);
                const f32x4 a0 = acc[ai][0][m][0] * rs, a1 = acc[ai][0][m][1] * rs, g0 = acc[ai][1][m][0] * rs, g1 = acc[ai][1][m][1] * rs;
                bf16_t* rowp = GA + (size_t)r * GAW;
                if (pn < 8) {
                    f32x4 v0, v1;
                    if (pn < 4) {
#pragma unroll
                        for (int i = 0; i < 4; ++i) { v0[i] = a0[i] * sigmoidf_(g0[i]); v1[i] = a1[i] * sigmoidf_(g1[i]); }
                    } else { v0 = a0 * g0; v1 = a1 * g1; }
                    const int cl = 128 * (pn & 3) + colw;
                    u32x4 w; w.x = cvt_pk_bf16(v0[0], v0[1]); w.y = cvt_pk_bf16(v0[2], v0[3]); w.z = cvt_pk_bf16(v1[0], v1[1]); w.w = cvt_pk_bf16(v1[2], v1[3]);
                    *(u32x4*)(rowp + (pn < 4 ? 0 : 512) + cl) = w;
                    const int keep = pn < 4 ? 30 : 2;
                    float* sp = nullptr;
                    if (r < MPR) { const int t = r & (SEQ - 1), b = r >> 11; if (t >= SEQ - keep) sp = out + (pn < 4 ? O_PCA : O_PCB) + ((size_t)(b * keep + (t - (SEQ - keep)))) * CH + cl; }
                    else if (r < MTOT) { const int rs_ = r - MPR, sb = rs_ >> 2, j = rs_ & 3; if (j >= NST - keep || keep == 30) sp = out + (pn < 4 ? O_SCA : O_SCB) + ((size_t)(sb * keep + (keep - NST + j))) * CH + cl; }
                    if (sp) { *(f32x4*)sp = v0; *(f32x4*)(sp + 4) = v1; }
                } else {
                    const int c = 1024 + 256 * (pn - 8) + colw;
                    u32x4 w; w.x = cvt_pk_bf16(a0[0], a0[1]); w.y = cvt_pk_bf16(a0[2], a0[3]); w.z = cvt_pk_bf16(a1[0], a1[1]); w.w = cvt_pk_bf16(a1[2], a1[3]);
                    *(u32x4*)(rowp + c) = w;
                    w.x = cvt_pk_bf16(g0[0], g0[1]); w.y = cvt_pk_bf16(g0[2], g0[3]); w.z = cvt_pk_bf16(g1[0], g1[1]); w.w = cvt_pk_bf16(g1[2], g1[3]);
                    *(u32x4*)(rowp + c + 128) = w;
                }
            }
    }
};
struct EpiResid {
    static constexpr bool PERM = false, AFTER_DRAIN = false;
    const float* baseP; const float* baseS; float* H; bf16_t* HB; float* ssq;
    __device__ __forceinline__ void operator()(const f32x4 (&acc)[2][2][4][2], const Unit& u, int wr, int wc, int fr, int fq) const {
        const int col0 = u.pn * BM + wc * 32 + 4 * fq;
#pragma unroll
        for (int ai = 0; ai < 2; ++ai)
#pragma unroll
            for (int m = 0; m < 4; ++m) {
                const int r = u.pm * BM + ai * HALF + wr * 64 + m * 16 + fr;
                float s = 0.f;
                if (r < MTOT) {
                    const float* bp = (r < MPR) ? baseP + (size_t)r * D : baseS + (size_t)(r - MPR) * D;
#pragma unroll
                    for (int bj = 0; bj < 2; ++bj)
#pragma unroll
                        for (int n = 0; n < 2; ++n) {
                            const int c = col0 + bj * HALF + n * 16;
                            const f32x4 v = *(const f32x4*)(bp + c) + acc[ai][bj][m][n];
                            *(f32x4*)(H + (size_t)r * D + c) = v;
                            s += (v[0] * v[0] + v[1] * v[1]) + (v[2] * v[2] + v[3] * v[3]);
                            u32x2 w; w.x = cvt_pk_bf16(v[0], v[1]); w.y = cvt_pk_bf16(v[2], v[3]);
                            *(u32x2*)(HB + (size_t)r * D + c) = w;
                        }
                }
                s += __shfl_xor(s, 16); s += __shfl_xor(s, 32);
                if (fq == 0 && r < MTOT) ssq[(size_t)r * 16 + u.pn * 4 + wc] = s;
            }
    }
};
struct EpiFfn {
    static constexpr bool PERM = true, AFTER_DRAIN = false;
    bf16_t* ZG; bf16_t* ZU; const float* ssq; float* out; int layer;
    __device__ __forceinline__ void operator()(const f32x4 (&acc)[2][2][4][2], const Unit& u, int wr, int wc, int fr, int fq) const {
        const int col = u.pn * 128 + wc * 32 + 8 * fq;
#pragma unroll
        for (int ai = 0; ai < 2; ++ai)
#pragma unroll
            for (int m = 0; m < 4; ++m) {
                const int r = u.pm * BM + ai * HALF + wr * 64 + m * 16 + fr;
                const float rs = row_rstd(ssq, r, fq);
                const f32x4 g0 = acc[ai][0][m][0] * rs, g1 = acc[ai][0][m][1] * rs, u0 = acc[ai][1][m][0] * rs, u1 = acc[ai][1][m][1] * rs;
                u32x4 w; w.x = cvt_pk_bf16(g0[0], g0[1]); w.y = cvt_pk_bf16(g0[2], g0[3]); w.z = cvt_pk_bf16(g1[0], g1[1]); w.w = cvt_pk_bf16(g1[2], g1[3]);
                *(u32x4*)(ZG + (size_t)r * DFF + col) = w;
                w.x = cvt_pk_bf16(u0[0], u0[1]); w.y = cvt_pk_bf16(u0[2], u0[3]); w.z = cvt_pk_bf16(u1[0], u1[1]); w.w = cvt_pk_bf16(u1[2], u1[3]);
                *(u32x4*)(ZU + (size_t)r * DFF + col) = w;
                float* sp = nullptr;
                if (r < MPR) { const int t = r & (SEQ - 1), b = r >> 11; if (t >= SEQ - 2) sp = out + O_PF + ((size_t)((layer * NB + b) * 2 + (t - (SEQ - 2)))) * DFF + col; }
                else if (r < MTOT) { const int rs_ = r - MPR, sb = rs_ >> 2, j = rs_ & 3; if (j >= 2) sp = out + O_SF + ((size_t)((layer * NSB + sb) * 2 + (j - 2))) * DFF + col; }
                if (sp) { *(f32x4*)sp = g0; *(f32x4*)(sp + 4) = g1; }
            }
    }
};
struct EpiQkv {
    static constexpr bool PERM = true, AFTER_DRAIN = false;
    bf16_t* QKV; float* QS; const float* ssq; float* out;
    __device__ __forceinline__ void operator()(const f32x4 (&acc)[2][2][4][2], const Unit& u, int wr, int wc, int fr, int fq) const {
        const int which = u.pn >> 2, cb = 256 * (u.pn & 3) + wc * 32 + 8 * fq;
        bf16_t* dst = QKV + (size_t)which * ((WS_K - WS_Q) / 2);
#pragma unroll
        for (int ai = 0; ai < 2; ++ai)
#pragma unroll
            for (int m = 0; m < 4; ++m) {
                const int r = u.pm * BM + ai * HALF + wr * 64 + m * 16 + fr;
                const float rs = row_rstd(ssq, r, fq) * (which == 0 ? QSCALE : 1.0f);
                float* fp = nullptr;
                if (which == 0) { if (r >= MPR && r < MTOT) fp = QS + (size_t)(r - MPR) * D; }
                else if (r < MPR) fp = out + (which == 1 ? O_PK : O_PV) + (size_t)r * D;
                else if (r < MTOT) { const int rs_ = r - MPR, sb = rs_ >> 2, j = rs_ & 3; fp = out + (which == 1 ? O_SK : O_SV) + ((size_t)sb * LBUF + (LBUF - NST) + j) * D; }
#pragma unroll
                for (int bj = 0; bj < 2; ++bj) {
                    const f32x4 v0 = acc[ai][bj][m][0] * rs, v1 = acc[ai][bj][m][1] * rs;
                    const int c = cb + bj * HALF;
                    u32x4 w; w.x = cvt_pk_bf16(v0[0], v0[1]); w.y = cvt_pk_bf16(v0[2], v0[3]); w.z = cvt_pk_bf16(v1[0], v1[1]); w.w = cvt_pk_bf16(v1[2], v1[3]);
                    *(u32x4*)(dst + (size_t)r * D + c) = w;
                    if (fp) { *(f32x4*)(fp + c) = v0; *(f32x4*)(fp + c + 4) = v1; }
                }
            }
    }
};

template <class Epi, class Sched, bool ALIGN_EPI = false, bool SP2 = false>
__device__ __forceinline__ void gemm_phase(LAS unsigned char* lds, const Gemm g, const Sched& S, const Epi& E) {
    const int tid = launder_v(threadIdx.x), wid = __builtin_amdgcn_readfirstlane(tid >> 6), lane = tid & 63, wr = wid >> 2, wc = wid & 3, fr = lane & 15, fq = lane >> 4;
    const int K = g.K, nt = K / BK;
    unsigned voffA[2], voffB[2];
#pragma unroll
    for (int i = 0; i < 2; ++i) { int R, C; stage_rc(tid * 16 + i * 8192, R, C); const int Rb = Epi::PERM ? ((R & ~31) + perm32(R & 31)) : R;
        voffA[i] = (unsigned)(R * K + C) * 2u; voffB[i] = (unsigned)(Rb * K + C) * 2u; }
    const size_t kstep = (size_t)(BK * 2);
    const size_t hstep = (size_t)HALF * K * 2;
    const size_t tstep = 2 * hstep;
    const unsigned ldsw = (unsigned)wid * 1024u;
    const int aoff = lds_byte(wr * 64 + fr, fq * 8), boff = lds_byte(wc * 32 + fr, fq * 8);
#define PG8_SA(b, h) (((b) * 2 + (h)) * HTB)
#define PG8_SB(b, h) ((4 + (b) * 2 + (h)) * HTB)
#define PG8_STAGE(bufoff, gbase, voff) do { _Pragma("unroll") for (int _i = 0; _i < 2; ++_i) \
        __builtin_amdgcn_global_load_lds((const unsigned*)((const char*)(gbase) + (voff)[_i]), (LAS unsigned*)(lds + (bufoff) + ldsw + _i * 8192), 16, 0, 0); } while (0)
#define PG8_LDA(dst, b, h) do { _Pragma("unroll") for (int m = 0; m < 4; ++m) _Pragma("unroll") for (int k = 0; k < 2; ++k) dst[m][k] = *(const LAS bf16x8*)(lds + PG8_SA(b, h) + aoff + m * 2048 + k * 1024); } while (0)
#define PG8_LDB(dst, b, h) do { _Pragma("unroll") for (int n = 0; n < 2; ++n) _Pragma("unroll") for (int k = 0; k < 2; ++k) dst[n][k] = *(const LAS bf16x8*)(lds + PG8_SB(b, h) + boff + n * 2048 + k * 1024); } while (0)
#define PG8_MMA(ai, bj, At, Bt) do { __builtin_amdgcn_s_setprio(1); _Pragma("unroll") for (int m = 0; m < 4; ++m) _Pragma("unroll") for (int n = 0; n < 2; ++n) _Pragma("unroll") for (int k = 0; k < 2; ++k) \
        acc[ai][bj][m][n] = __builtin_amdgcn_mfma_f32_16x16x32_bf16(Bt[n][k], At[m][k], acc[ai][bj][m][n], 0, 0, 0); __builtin_amdgcn_s_setprio(0); } while (0)
#define PG8_WAIT_V(n) asm volatile("s_waitcnt vmcnt(" #n ")" ::: "memory")
#define PG8_WAIT_L(n) asm volatile("s_waitcnt lgkmcnt(" #n ")" ::: "memory")
#define PG8_BAR __builtin_amdgcn_s_barrier()
#define PG8_SCHED __builtin_amdgcn_sched_barrier(0)
    Unit cur, nxt; int ui = 0;
    if (!S.next(0, cur)) return;
    f32x4 acc[2][2][4][2];
#pragma unroll
    for (int a = 0; a < 2; ++a)
#pragma unroll
        for (int b = 0; b < 2; ++b)
#pragma unroll
            for (int m = 0; m < 4; ++m)
#pragma unroll
                for (int n = 0; n < 2; ++n) acc[a][b][m][n] = (f32x4){0.f, 0.f, 0.f, 0.f};
    bf16x8 At[4][2], B0[2][2], B1[2][2];
    const char* cA = (const char*)g.A + (size_t)cur.pm * tstep; const char* cB = (const char*)g.Bt + (size_t)cur.pn * tstep;
    S.a_ready(cur);
    if constexpr (SP2) {
        PG8_STAGE(PG8_SB(0, 0), cB, voffB); PG8_STAGE(PG8_SB(0, 1), cB + hstep, voffB); PG8_STAGE(PG8_SA(0, 0), cA, voffA); PG8_STAGE(PG8_SA(0, 1), cA + hstep, voffA);
        if (wr == 1) PG8_BAR;
        PG8_WAIT_V(2); PG8_BAR;
        PG8_STAGE(PG8_SB(1, 0), cB + kstep, voffB); PG8_STAGE(PG8_SA(1, 0), cA + kstep, voffA); PG8_STAGE(PG8_SB(1, 1), cB + hstep + kstep, voffB);
        PG8_WAIT_V(6); PG8_BAR;
    } else {
        PG8_STAGE(PG8_SB(0, 0), cB, voffB); PG8_STAGE(PG8_SA(0, 0), cA, voffA); PG8_STAGE(PG8_SB(0, 1), cB + hstep, voffB); PG8_STAGE(PG8_SA(0, 1), cA + hstep, voffA);
        if (wr == 1) PG8_BAR;
        PG8_WAIT_V(4); PG8_BAR;
        PG8_STAGE(PG8_SB(1, 0), cB + kstep, voffB); PG8_STAGE(PG8_SA(1, 0), cA + kstep, voffA); PG8_STAGE(PG8_SB(1, 1), cB + hstep + kstep, voffB);
        PG8_WAIT_V(6); PG8_BAR;
    }
    for (;;) {
        const bool has_next = S.next(ui + 1, nxt);
        const char* nA = has_next ? (const char*)g.A + (size_t)nxt.pm * tstep : cA; const char* nB = has_next ? (const char*)g.Bt + (size_t)nxt.pn * tstep : cB;
        for (int t = 0; t < nt; t += 2) {
            const bool last = (t == nt - 2);
            const char* a1 = cA + (size_t)(t + 1) * kstep;
            const char* a2 = last ? nA : cA + (size_t)(t + 2) * kstep; const char* b2 = last ? nB : cB + (size_t)(t + 2) * kstep;
            const char* a3 = a2 + kstep; const char* b3 = b2 + kstep;
            if (last && has_next) S.a_ready(nxt);
            if constexpr (SP2) {
            PG8_LDB(B0, 0, 0); PG8_LDB(B1, 0, 1); PG8_SCHED; PG8_LDA(At, 0, 0); PG8_STAGE(PG8_SA(1, 1), a1 + hstep, voffA);
            PG8_WAIT_V(8); PG8_WAIT_L(0); PG8_BAR; PG8_MMA(0, 0, At, B0); PG8_MMA(0, 1, At, B1); PG8_BAR; PG8_SCHED;
            PG8_LDA(At, 0, 1); PG8_STAGE(PG8_SB(0, 0), b2, voffB); PG8_STAGE(PG8_SB(0, 1), b2 + hstep, voffB); PG8_STAGE(PG8_SA(0, 0), a2, voffA);
            PG8_WAIT_V(8); PG8_WAIT_L(0); PG8_BAR; PG8_MMA(1, 0, At, B0); PG8_MMA(1, 1, At, B1); PG8_BAR; PG8_SCHED;
            PG8_LDB(B0, 1, 0); PG8_LDB(B1, 1, 1); PG8_SCHED; PG8_LDA(At, 1, 0); PG8_STAGE(PG8_SA(0, 1), a2 + hstep, voffA);
            PG8_WAIT_V(8); PG8_WAIT_L(0); PG8_BAR; PG8_MMA(0, 0, At, B0); PG8_MMA(0, 1, At, B1); PG8_BAR; PG8_SCHED;
            PG8_LDA(At, 1, 1); PG8_STAGE(PG8_SB(1, 0), b3, voffB); PG8_STAGE(PG8_SB(1, 1), b3 + hstep, voffB); PG8_STAGE(PG8_SA(1, 0), a3, voffA);
            PG8_WAIT_V(8); PG8_WAIT_L(0); PG8_BAR; PG8_MMA(1, 0, At, B0); PG8_MMA(1, 1, At, B1); PG8_BAR; PG8_SCHED;
            } else {
            PG8_LDB(B0, 0, 0); PG8_SCHED; PG8_LDA(At, 0, 0); PG8_STAGE(PG8_SA(1, 1), a1 + hstep, voffA);
            PG8_WAIT_L(8); PG8_BAR; PG8_WAIT_L(0); PG8_MMA(0, 0, At, B0); PG8_BAR; PG8_SCHED;
            PG8_LDB(B1, 0, 1); PG8_STAGE(PG8_SB(0, 0), b2, voffB);
            PG8_BAR; PG8_WAIT_L(0); PG8_MMA(0, 1, At, B1); PG8_BAR;
            PG8_LDA(At, 0, 1); PG8_STAGE(PG8_SA(0, 0), a2, voffA);
            PG8_BAR; PG8_WAIT_L(0); PG8_MMA(1, 0, At, B0); PG8_BAR; PG8_SCHED;
            PG8_STAGE(PG8_SB(0, 1), b2 + hstep, voffB);
            PG8_WAIT_V(6); PG8_BAR; PG8_MMA(1, 1, At, B1); PG8_BAR;
            PG8_LDB(B0, 1, 0); PG8_SCHED; PG8_LDA(At, 1, 0); PG8_STAGE(PG8_SA(0, 1), a2 + hstep, voffA);
            PG8_WAIT_L(8); PG8_BAR; PG8_WAIT_L(0); PG8_MMA(0, 0, At, B0); PG8_BAR; PG8_SCHED;
            PG8_LDB(B1, 1, 1); PG8_STAGE(PG8_SB(1, 0), b3, voffB);
            PG8_BAR; PG8_WAIT_L(0); PG8_MMA(0, 1, At, B1); PG8_BAR;
            PG8_LDA(At, 1, 1); PG8_STAGE(PG8_SA(1, 0), a3, voffA);
            PG8_BAR; PG8_WAIT_L(0); PG8_MMA(1, 0, At, B0); PG8_BAR; PG8_SCHED;
            PG8_STAGE(PG8_SB(1, 1), b3 + hstep, voffB);
            PG8_WAIT_V(6); PG8_BAR; PG8_MMA(1, 1, At, B1); PG8_BAR;
            }
        }
        if constexpr (ALIGN_EPI) { if (wr == 0) PG8_BAR; }
        if constexpr (!Epi::AFTER_DRAIN) { E(acc, cur, wr, wc, fr, fq); S.done(cur); }
        if (!has_next) break;
#pragma unroll
        for (int a = 0; a < 2; ++a)
#pragma unroll
            for (int b = 0; b < 2; ++b)
#pragma unroll
                for (int m = 0; m < 4; ++m)
#pragma unroll
                    for (int n = 0; n < 2; ++n) acc[a][b][m][n] = (f32x4){0.f, 0.f, 0.f, 0.f};
        cur = nxt; cA = nA; cB = nB; ++ui;
        if constexpr (ALIGN_EPI) { if (wr == 1) PG8_BAR; }
    }
    PG8_WAIT_V(0);
    if constexpr (!ALIGN_EPI) { if (wr == 0) PG8_BAR; }
    PG8_BAR;
#undef PG8_SA
#undef PG8_SB
#undef PG8_STAGE
#undef PG8_LDA
#undef PG8_LDB
#undef PG8_MMA
#undef PG8_WAIT_V
#undef PG8_WAIT_L
#undef PG8_BAR
#undef PG8_SCHED
}
}

__device__ __forceinline__ void transpose_item(const float* W, int K, int N, bf16_t* WT, int k0, int np0, int srcn0, const float* g, LAS float* scr, int lane) {
#pragma unroll 8
    for (int i = 0; i < 32; ++i) { const int kk = 2 * i + (lane >> 5); float v = W[(size_t)(k0 + kk) * N + srcn0 + (lane & 31)]; if (g) v *= g[k0 + kk]; scr[kk * 33 + (lane & 31)] = v; }
    asm volatile("s_waitcnt lgkmcnt(0)" ::: "memory");
    const int c = lane & 7;
#pragma unroll
    for (int j = 0; j < 4; ++j) { const int n = (lane >> 3) + 8 * j; const LAS float* s = scr + (8 * c) * 33 + n;
        u32x4 o; o.x = cvt_pk_bf16(s[0 * 33], s[1 * 33]); o.y = cvt_pk_bf16(s[2 * 33], s[3 * 33]); o.z = cvt_pk_bf16(s[4 * 33], s[5 * 33]); o.w = cvt_pk_bf16(s[6 * 33], s[7 * 33]);
        *(u32x4*)(WT + (size_t)(np0 + n) * K + k0 + 8 * c) = o; }
    asm volatile("s_waitcnt lgkmcnt(0)" ::: "memory");
}
__device__ __forceinline__ int src_in_ab(int np) {
    const int pn = np >> 8, cc = np & 255, bj = cc >> 7, off = cc & 127;
    if (pn < 4) return (bj ? 512 : 0) + 128 * pn + off;
    if (pn < 8) return (bj ? 2048 : 1536) + 128 * (pn - 4) + off;
    return 1024 + 256 * (pn - 8) + cc;
}
__device__ __forceinline__ int src_ffn(int np) { const int pn = np >> 8, cc = np & 255, bj = cc >> 7, off = cc & 127; return (bj ? DFF : 0) + 128 * pn + off; }

struct Args { const float* in[22]; float* out; unsigned char* ws; };

__device__ __forceinline__ void p0_prologue(const Args& a, LAS unsigned char* lds, int gw, int NGW, int lane, int wave) {
    LAS float* scr = (LAS float*)(lds + wave * 16384);
    unsigned char* ws = a.ws;
    constexpr int I_IN = (D / 64) * (NIN / 32), I_SQ = (D / 64) * (D / 32), I_QKV = (D / 64) * (3 * D / 32), I_F = (D / 64) * (2 * DFF / 32), I_DN = (DFF / 64) * (D / 32);
    constexpr int NITEMS = I_IN + 2 * I_SQ + I_QKV + 2 * I_F + 2 * I_DN;
    for (int it = gw; it < NITEMS; it += NGW) {
        int r = it;
        if (r < I_IN) { const int nb = NIN / 32, kb = r / nb, n0 = 32 * (r % nb); transpose_item(a.in[10], D, NIN, (bf16_t*)(ws + WS_WIN), 64 * kb, n0, src_in_ab(n0), a.in[7], scr, lane); continue; } r -= I_IN;
        if (r < I_SQ) { const int nb = D / 32, kb = r / nb, n0 = 32 * (r % nb); transpose_item(a.in[16], D, D, (bf16_t*)(ws + WS_WOUT), 64 * kb, n0, n0, nullptr, scr, lane); continue; } r -= I_SQ;
        if (r < I_QKV) { const int nb = 3 * D / 32, kb = r / nb, n0 = 32 * (r % nb); transpose_item(a.in[17], D, 3 * D, (bf16_t*)(ws + WS_WQKV), 64 * kb, n0, n0, a.in[7] + D, scr, lane); continue; } r -= I_QKV;
        if (r < I_SQ) { const int nb = D / 32, kb = r / nb, n0 = 32 * (r % nb); transpose_item(a.in[18], D, D, (bf16_t*)(ws + WS_WO), 64 * kb, n0, n0, nullptr, scr, lane); continue; } r -= I_SQ;
        if (r < 2 * I_F) { const int l = r / I_F; r -= l * I_F; const int nb = 2 * DFF / 32, kb = r / nb, n0 = 32 * (r % nb);
            transpose_item(a.in[19] + (size_t)l * D * 2 * DFF, D, 2 * DFF, (bf16_t*)(ws + (l ? WS_WF1 : WS_WF0)), 64 * kb, n0, src_ffn(n0), a.in[8] + l * D, scr, lane); continue; } r -= 2 * I_F;
        { const int l = r / I_DN; r -= l * I_DN; const int nb = D / 32, kb = r / nb, n0 = 32 * (r % nb);
            transpose_item(a.in[21] + (size_t)l * DFF * D, DFF, D, (bf16_t*)(ws + (l ? WS_WD1 : WS_WD0)), 64 * kb, n0, n0, nullptr, scr, lane); }
    }
    bf16_t* HB = (bf16_t*)(ws + WS_HB); float* ssq = (float*)(ws + WS_SSQ);
    for (int r = gw; r < MPAD; r += NGW) {
        f32x4 v[4]; float s = 0.f;
        if (r < MTOT) {
            const f32x4* xr = (const f32x4*)((r < MPR) ? a.in[0] + (size_t)r * D : a.in[1] + (size_t)(r - MPR) * D) + lane;
#pragma unroll
            for (int j = 0; j < 4; ++j) { v[j] = xr[64 * j]; s += (v[j].x * v[j].x + v[j].y * v[j].y) + (v[j].z * v[j].z + v[j].w * v[j].w); }
        } else {
#pragma unroll
            for (int j = 0; j < 4; ++j) v[j] = (f32x4){0.f, 0.f, 0.f, 0.f};
        }
        s = wave_sum(s);
        u32x2* o8 = (u32x2*)(HB + (size_t)r * D) + lane;
#pragma unroll
        for (int j = 0; j < 4; ++j) { u32x2 w; w.x = cvt_pk_bf16(v[j].x, v[j].y); w.y = cvt_pk_bf16(v[j].z, v[j].w); o8[64 * j] = w; }
        if (lane < 16) ssq[(size_t)r * 16 + lane] = (lane == 0) ? s : 0.f;
    }
    {
        const int tot = NSB * 26 * (CH / 4);
        for (int i = gw * 64 + lane; i < tot; i += NGW * 64) { const int sb = i / (26 * (CH / 4)), rem = i % (26 * (CH / 4));
            ((f32x4*)(a.out + O_SCA + (size_t)sb * 30 * CH))[rem] = ((const f32x4*)(a.in[2] + (size_t)sb * 30 * CH + 4 * CH))[rem]; }
    }
    {
        const size_t per = (size_t)(LBUF - NST) * D / 4;
        const size_t tot = per * NSB, stride = (size_t)NGW * 64;
        for (size_t i0 = (size_t)gw * 64 + lane; i0 < tot; i0 += 4 * stride) {
            f32x4 kv[4], vv[4];
#pragma unroll
            for (int u = 0; u < 4; ++u) { const size_t i = i0 + u * stride; if (i < tot) { const size_t sb = i / per, rem = i % per;
                kv[u] = __builtin_nontemporal_load((const f32x4*)(a.in[4] + (sb * LBUF + NST) * D) + rem); vv[u] = __builtin_nontemporal_load((const f32x4*)(a.in[5] + (sb * LBUF + NST) * D) + rem); } }
#pragma unroll
            for (int u = 0; u < 4; ++u) { const size_t i = i0 + u * stride; if (i < tot) { const size_t sb = i / per, rem = i % per;
                __builtin_nontemporal_store(kv[u], (f32x4*)(a.out + O_SK + sb * LBUF * D) + rem); __builtin_nontemporal_store(vv[u], (f32x4*)(a.out + O_SV + sb * LBUF * D) + rem); } }
        }
    }
}

__device__ __forceinline__ void p2_conv(const Args& a, LAS unsigned char* lds, int tid, int lane, int wave) {
    unsigned char* ws = a.ws;
    const bf16_t* GA = (const bf16_t*)(ws + WS_GA); bf16_t* AB = (bf16_t*)(ws + WS_AB);
    LAS float* T = (LAS float*)lds;
    const float* wa = a.in[11]; const float* ba = a.in[12]; const float* lg = a.in[13]; const float* lb = a.in[14]; const float* wb = a.in[15];
    for (int u = blockIdx.x; u < 512 + NSB; u += gridDim.x) {
        const bool samp = u >= 512; const int sb = u - 512;
        const int row0 = samp ? MPR + sb * NST : u * 32, nrows = samp ? NST : 32;
        const int t0 = samp ? 0 : (row0 & (SEQ - 1));
        const int nvec = (nrows + 30) * (CH / 8);
        for (int i = tid; i < nvec; i += NTHREADS) {
            const int e = i >> 6, c = (i & 63) * 8; const int p = t0 - 30 + e;
            f32x4 v0 = (f32x4){0.f, 0.f, 0.f, 0.f}, v1 = v0;
            if (p >= 0) { const u32x4 w = *(const u32x4*)(GA + (size_t)(row0 - t0 + p) * GAW + c);
                v0 = (f32x4){bflo(w.x), bfhi(w.x), bflo(w.y), bfhi(w.y)}; v1 = (f32x4){bflo(w.z), bfhi(w.z), bflo(w.w), bfhi(w.w)}; }
            else if (samp) { const float* sp = a.in[2] + ((size_t)sb * 30 + e) * CH + c; v0 = *(const f32x4*)sp; v1 = *(const f32x4*)(sp + 4); }
            *(LAS f32x4*)(T + e * CH + c) = v0; *(LAS f32x4*)(T + e * CH + c + 4) = v1;
        }
        __syncthreads();
        if (tid < 256) {
            const int c = 2 * tid; f32x2 w[KA];
#pragma unroll
            for (int k = 0; k < KA; ++k) w[k] = *(const f32x2*)(wa + k * CH + c);
            const f32x2 bias = *(const f32x2*)(ba + c);
            for (int i = 0; i < nrows; ++i) {
                f32x2 s = bias;
#pragma unroll
                for (int k = 0; k < KA; ++k) { const f32x2 x = *(const LAS f32x2*)(T + (i + k) * CH + c); s += w[k] * x; }
                *(LAS f32x2*)(T + i * CH + c) = s;
            }
        } else {
            const int t2 = tid - 256;
            for (int i = t2; i < nrows * 64; i += 256) {
                const int rr = i >> 6, c = (i & 63) * 8; const int r = row0 + rr, p = t0 + rr;
                float x[3][8];
#pragma unroll
                for (int k = 0; k < 3; ++k) { const int pp = p - 2 + k;
                    if (pp >= 0) { const u32x4 wv = *(const u32x4*)(GA + (size_t)(r - 2 + k) * GAW + 512 + c);
                        x[k][0] = bflo(wv.x); x[k][1] = bfhi(wv.x); x[k][2] = bflo(wv.y); x[k][3] = bfhi(wv.y); x[k][4] = bflo(wv.z); x[k][5] = bfhi(wv.z); x[k][6] = bflo(wv.w); x[k][7] = bfhi(wv.w); }
                    else if (samp) { const float* sp = a.in[3] + ((size_t)sb * 2 + (pp + 2)) * CH + c;
#pragma unroll
                        for (int e = 0; e < 8; ++e) x[k][e] = sp[e]; }
                    else {
#pragma unroll
                        for (int e = 0; e < 8; ++e) x[k][e] = 0.f; } }
                const u32x4 gv = *(const u32x4*)(GA + (size_t)r * GAW + 1024 + c);
                float gb[8] = {bflo(gv.x), bfhi(gv.x), bflo(gv.y), bfhi(gv.y), bflo(gv.z), bfhi(gv.z), bflo(gv.w), bfhi(gv.w)};
                float o[8];
#pragma unroll
                for (int e = 0; e < 8; ++e) o[e] = gb[e] * (wb[0 * CH + c + e] * x[0][e] + wb[1 * CH + c + e] * x[1][e] + wb[2 * CH + c + e] * x[2][e]);
                u32x4 w4; w4.x = cvt_pk_bf16(o[0], o[1]); w4.y = cvt_pk_bf16(o[2], o[3]); w4.z = cvt_pk_bf16(o[4], o[5]); w4.w = cvt_pk_bf16(o[6], o[7]);
                *(u32x4*)(AB + (size_t)r * D + 512 + c) = w4;
            }
        }
        __syncthreads();
        for (int rr = wave; rr < nrows; rr += NWAVES) {
            const int c = lane * 8;
            const f32x4 v0 = *(const LAS f32x4*)(T + rr * CH + c), v1 = *(const LAS f32x4*)(T + rr * CH + c + 4);
            float s = (v0.x + v0.y) + (v0.z + v0.w) + (v1.x + v1.y) + (v1.z + v1.w);
            const float mu = wave_sum(s) * (1.0f / CH);
            const f32x4 d0 = v0 - mu, d1 = v1 - mu;
            float q = (d0.x * d0.x + d0.y * d0.y) + (d0.z * d0.z + d0.w * d0.w) + (d1.x * d1.x + d1.y * d1.y) + (d1.z * d1.z + d1.w * d1.w);
            const float rstd = rsqrtf(wave_sum(q) * (1.0f / CH) + LN_EPS);
            const f32x4 g0 = *(const f32x4*)(lg + c), g1 = *(const f32x4*)(lg + c + 4), b0 = *(const f32x4*)(lb + c), b1 = *(const f32x4*)(lb + c + 4);
            f32x4 a0 = d0 * rstd * g0 + b0, a1 = d1 * rstd * g1 + b1;
#pragma unroll
            for (int e = 0; e < 4; ++e) { a0[e] = a0[e] * sigmoidf_(a0[e]); a1[e] = a1[e] * sigmoidf_(a1[e]); }
            u32x4 w4; w4.x = cvt_pk_bf16(a0[0], a0[1]); w4.y = cvt_pk_bf16(a0[2], a0[3]); w4.z = cvt_pk_bf16(a1[0], a1[1]); w4.w = cvt_pk_bf16(a1[2], a1[3]);
            *(u32x4*)(AB + (size_t)(row0 + rr) * D + c) = w4;
        }
        __syncthreads();
    }
}

__device__ __forceinline__ void p5_combine(const Args& a, int layer, int gtid, int GT) {
    unsigned char* ws = a.ws;
    const bf16_t* ZG = (const bf16_t*)(ws + WS_ZG); const bf16_t* ZU = (const bf16_t*)(ws + WS_ZU); bf16_t* U = (bf16_t*)(ws + WS_U);
    const float* wc = a.in[20] + (size_t)layer * 3 * DFF;
    constexpr int NCV = DFF / 8, NCH = MPR / 16;
    const int nit = NCH * NCV + NSB * NCV;
    for (int it = gtid; it < nit; it += GT) {
        const bool samp = it >= NCH * NCV;
        int r0, nrows, cv, sb = 0;
        if (!samp) { const int ch = it / NCV; cv = it % NCV; r0 = ch * 16; nrows = 16; } else { const int j = it - NCH * NCV; sb = j / NCV; cv = j % NCV; r0 = MPR + sb * NST; nrows = NST; }
        const int c = cv * 8;
        float w0[8], w1[8], w2[8], gm2[8], gm1[8];
#pragma unroll
        for (int e = 0; e < 8; ++e) { w0[e] = wc[c + e]; w1[e] = wc[DFF + c + e]; w2[e] = wc[2 * DFF + c + e]; }
        if (samp) { const float* sp = a.in[6] + ((size_t)(layer * NSB + sb) * 2) * DFF + c;
#pragma unroll
            for (int e = 0; e < 8; ++e) { gm2[e] = sp[e]; gm1[e] = sp[DFF + e]; } }
        else if ((r0 & (SEQ - 1)) == 0) {
#pragma unroll
            for (int e = 0; e < 8; ++e) { gm2[e] = 0.f; gm1[e] = 0.f; } }
        else { const u32x4 p2 = *(const u32x4*)(ZG + (size_t)(r0 - 2) * DFF + c), p1 = *(const u32x4*)(ZG + (size_t)(r0 - 1) * DFF + c);
            gm2[0] = bflo(p2.x); gm2[1] = bfhi(p2.x); gm2[2] = bflo(p2.y); gm2[3] = bfhi(p2.y); gm2[4] = bflo(p2.z); gm2[5] = bfhi(p2.z); gm2[6] = bflo(p2.w); gm2[7] = bfhi(p2.w);
            gm1[0] = bflo(p1.x); gm1[1] = bfhi(p1.x); gm1[2] = bflo(p1.y); gm1[3] = bfhi(p1.y); gm1[4] = bflo(p1.z); gm1[5] = bfhi(p1.z); gm1[6] = bflo(p1.w); gm1[7] = bfhi(p1.w); }
        for (int i = 0; i < nrows; ++i) {
            const size_t off = (size_t)(r0 + i) * DFF + c;
            const u32x4 gv = *(const u32x4*)(ZG + off), uv = *(const u32x4*)(ZU + off);
            float g[8] = {bflo(gv.x), bfhi(gv.x), bflo(gv.y), bfhi(gv.y), bflo(gv.z), bfhi(gv.z), bflo(gv.w), bfhi(gv.w)};
            float up[8] = {bflo(uv.x), bfhi(uv.x), bflo(uv.y), bfhi(uv.y), bflo(uv.z), bfhi(uv.z), bflo(uv.w), bfhi(uv.w)};
            float o[8];
#pragma unroll
            for (int e = 0; e < 8; ++e) { const float y = w0[e] * gm2[e] + w1[e] * gm1[e] + w2[e] * g[e]; o[e] = y * sigmoidf_(y) * up[e]; gm2[e] = gm1[e]; gm1[e] = g[e]; }
            u32x4 w4; w4.x = cvt_pk_bf16(o[0], o[1]); w4.y = cvt_pk_bf16(o[2], o[3]); w4.z = cvt_pk_bf16(o[4], o[5]); w4.w = cvt_pk_bf16(o[6], o[7]);
            *(u32x4*)(U + off) = w4;
        }
    }
}

constexpr int AT_OACC = 0, AT_OSTR = 65, AT_ML = 256 * AT_OSTR * 4, AT_VST = AT_ML + 2048, AT_PSC = AT_VST + NWAVES * 4096;
static_assert(AT_PSC + NWAVES * 2048 <= 131072, "attention LDS");
__device__ __forceinline__ int crow(int r, int hi) { return (r & 3) + 8 * (r >> 2) + 4 * hi; }

__device__ __forceinline__ void attn_task(const bf16_t* Qh, const bf16_t* Kh, const bf16_t* Vh, int dil, int cls, int s0, int nq, float slope2, int qlbase, int qlstep, bool first,
                                          LAS unsigned char* lds, int wave, int lane) {
    const int r32 = lane & 31, hi = lane >> 5;
    const int qi = r32 < nq ? r32 : nq - 1;
    const bf16_t* qp = Qh + (size_t)(cls + dil * (s0 + qi)) * D + hi * 8;
    bf16x8 qr[4];
#pragma unroll
    for (int d0 = 0; d0 < 4; ++d0) qr[d0] = *(const bf16x8*)(qp + d0 * 16);
    float m_run = -INFINITY, l_run = 0.f; f32x16 o[2]; o[0] = f32x16{}; o[1] = f32x16{};
    LAS unsigned char* vst = lds + AT_VST + wave * 4096;
    const int sq = s0 + r32;
    const float sdil = slope2 * (float)dil;
    for (int i = 0; i < 5; ++i) {
        const int kb = s0 - 128 + 32 * i;
        if (kb + 31 < 0) continue;
        const int skv = kb + r32 < 0 ? 0 : kb + r32;
        const bf16_t* kp = Kh + (size_t)(cls + dil * skv) * D + hi * 8;
        bf16x8 kf[4];
#pragma unroll
        for (int d0 = 0; d0 < 4; ++d0) kf[d0] = *(const bf16x8*)(kp + d0 * 16);
        u32x4 vv[4];
#pragma unroll
        for (int j = 0; j < 4; ++j) { const int kv = (lane >> 3) + 8 * j; const int sv = kb + kv < 0 ? 0 : kb + kv;
            vv[j] = *(const u32x4*)(Vh + (size_t)(cls + dil * sv) * D + (lane & 7) * 8); }
        f32x16 st = f32x16{};
#pragma unroll
        for (int d0 = 0; d0 < 4; ++d0) st = __builtin_amdgcn_mfma_f32_32x32x16_bf16(kf[d0], qr[d0], st, 0, 0, 0);
        asm volatile("" ::: "memory");
#pragma unroll
        for (int j = 0; j < 4; ++j) { const int kv = (lane >> 3) + 8 * j, part = lane & 7;
            *(LAS u32x4*)(vst + (part >> 2) * 2048 + (kv >> 3) * 512 + (kv & 7) * 64 + (part & 3) * 16) = vv[j]; }
        float mx = -INFINITY;
#pragma unroll
        for (int r = 0; r < 16; ++r) { const int sk = kb + crow(r, hi); const int ds = sq - sk; const bool ok = (sk >= 0) && (ds >= 0) && (ds <= 128);
            const float x = ok ? st[r] - sdil * (float)ds : -INFINITY; st[r] = x; mx = fmaxf(mx, x); }
        mx = fmaxf(mx, __shfl_xor(mx, 32));
        const float m_new = fmaxf(m_run, mx);
        const float m_use = (m_new == -INFINITY) ? 0.f : m_new;
        const float alpha = __builtin_amdgcn_exp2f(m_run - m_use);
        float ps = 0.f;
#pragma unroll
        for (int r = 0; r < 16; ++r) { const float p = __builtin_amdgcn_exp2f(st[r] - m_use); st[r] = p; ps += p; }
        l_run = l_run * alpha + ps; m_run = m_new;
#pragma unroll
        for (int r = 0; r < 16; ++r) { o[0][r] *= alpha; o[1][r] *= alpha; }
        bf16x8 pa[2];
#pragma unroll
        for (int s = 0; s < 2; ++s) { u32x4 w; w.x = cvt_pk_bf16(st[8 * s + 0], st[8 * s + 1]); w.y = cvt_pk_bf16(st[8 * s + 2], st[8 * s + 3]); w.z = cvt_pk_bf16(st[8 * s + 4], st[8 * s + 5]); w.w = cvt_pk_bf16(st[8 * s + 6], st[8 * s + 7]);
            pa[s] = __builtin_bit_cast(bf16x8, w); }
        asm volatile("s_waitcnt lgkmcnt(0)" ::: "memory");
        const int vb = ((lane >> 4) & 1) * 32 + (lane & 3) * 8 + (4 * hi + ((lane & 15) >> 2)) * 64;
#pragma unroll
        for (int d0 = 0; d0 < 2; ++d0)
#pragma unroll
            for (int s = 0; s < 2; ++s) {
                const s16x4 lo = __builtin_bit_cast(s16x4, __builtin_amdgcn_ds_read_tr16_b64_v4i16((LAS s16x4*)(vst + vb + d0 * 2048 + s * 1024)));
                const s16x4 hh = __builtin_bit_cast(s16x4, __builtin_amdgcn_ds_read_tr16_b64_v4i16((LAS s16x4*)(vst + vb + d0 * 2048 + s * 1024 + 512)));
                const bf16x8 vf = (bf16x8){lo[0], lo[1], lo[2], lo[3], hh[0], hh[1], hh[2], hh[3]};
                o[d0] = __builtin_amdgcn_mfma_f32_32x32x16_bf16(vf, pa[s], o[d0], 0, 0, 0);
            }
        asm volatile("s_waitcnt lgkmcnt(0)" ::: "memory");
    }
    l_run += __shfl_xor(l_run, 32);
    if (r32 < nq) {
        const int ql = qlbase + qlstep * r32;
        LAS float* oa = (LAS float*)(lds + AT_OACC) + ql * AT_OSTR;
        LAS float* ml = (LAS float*)(lds + AT_ML) + ql * 2;
        float a_old = 0.f, a_new = 1.f, m_new = m_run, l_new = l_run;
        if (!first) { const float m_old = ml[0], l_old = ml[1]; m_new = fmaxf(m_old, m_run); const float mu = (m_new == -INFINITY) ? 0.f : m_new;
            a_old = __builtin_amdgcn_exp2f(m_old - mu); a_new = __builtin_amdgcn_exp2f(m_run - mu); l_new = l_old * a_old + l_run * a_new; }
#pragma unroll
        for (int d0 = 0; d0 < 2; ++d0)
#pragma unroll
            for (int r = 0; r < 16; ++r) { const int d = 32 * d0 + crow(r, hi); float v = o[d0][r] * a_new; if (!first) v += oa[d] * a_old; oa[d] = v; }
        asm volatile("s_waitcnt lgkmcnt(0)" ::: "memory");
        if (hi == 0) { ml[0] = m_new; ml[1] = l_new; }
    }
}

__device__ __forceinline__ void p8_attention(const Args& a, LAS unsigned char* lds, int tid, int lane, int wave) {
    unsigned char* ws = a.ws;
    const bf16_t* Q = (const bf16_t*)(ws + WS_Q); const bf16_t* K = (const bf16_t*)(ws + WS_K); const bf16_t* V = (const bf16_t*)(ws + WS_V); bf16_t* O = (bf16_t*)(ws + WS_AB);
#ifndef NO_SAMPLE
    {
        const float* QS = (const float*)(ws + WS_QS);
        LAS float* psc = (LAS float*)(lds + AT_PSC + wave * 2048);
        for (int task = blockIdx.x * NWAVES + wave; task < NSB * NH * NST; task += gridDim.x * NWAVES) {
            const int sb = task / (NH * NST), h = (task / NST) % NH, j = task % NST;
            const float slope2 = exp2f(-0.5f * (float)(h + 1)) * LOG2E;
            const float* kc = a.in[4] + (size_t)sb * LBUF * D + h * HD; const float* vc = a.in[5] + (size_t)sb * LBUF * D + h * HD;
            const float* kn = a.out + O_SK + ((size_t)sb * LBUF + (LBUF - NST)) * D + h * HD; const float* vn = a.out + O_SV + ((size_t)sb * LBUF + (LBUF - NST)) * D + h * HD;
            const float* qrow = QS + (size_t)(sb * NST + j) * D + h * HD;
            f32x4 qv[16];
#pragma unroll
            for (int e = 0; e < 16; ++e) qv[e] = *(const f32x4*)(qrow + 4 * e);
            float mx = -INFINITY;
#pragma clang loop unroll(disable)
            for (int rd = 0; rd < 7; ++rd) {
                const int kk = rd * 64 + lane; float s = -INFINITY;
                if (kk < 387) { const int g = kk / 129, mm = kk % 129, dil = (g == 0) ? 1 : (g == 1 ? 4 : 16); const int idx = LBUF + j - mm * dil;
                    const float* kr = (idx >= LBUF) ? kn + (size_t)(idx - LBUF) * D : kc + (size_t)idx * D;
                    float acc = 0.f;
#pragma unroll
                    for (int e = 0; e < 16; ++e) { const f32x4 kx = *(const f32x4*)(kr + 4 * e); acc += (qv[e].x * kx.x + qv[e].y * kx.y) + (qv[e].z * kx.z + qv[e].w * kx.w); }
                    s = acc - slope2 * (float)(mm * dil); }
                psc[kk] = s; mx = fmaxf(mx, s);
            }
            mx = wave_max(mx);
            asm volatile("s_waitcnt lgkmcnt(0)" ::: "memory");
            float l = 0.f;
#pragma clang loop unroll(disable)
            for (int rd = 0; rd < 7; ++rd) { const float p = __builtin_amdgcn_exp2f(psc[rd * 64 + lane] - mx); l += p; psc[rd * 64 + lane] = p; }
            l = wave_sum(l);
            asm volatile("s_waitcnt lgkmcnt(0)" ::: "memory");
            float acc = 0.f;
            for (int kk = 0; kk < 387; ++kk) { const int g = kk / 129, mm = kk % 129, dil = (g == 0) ? 1 : (g == 1 ? 4 : 16); const int idx = LBUF + j - mm * dil;
                const float* vr = (idx >= LBUF) ? vn + (size_t)(idx - LBUF) * D : vc + (size_t)idx * D;
                acc += psc[kk] * vr[lane]; }
            acc *= __builtin_amdgcn_rcpf(l);
            const float hi_ = __shfl_down(acc, 1);
            if ((lane & 1) == 0) *(unsigned*)(O + (size_t)(MPR + sb * NST + j) * D + h * HD + lane) = cvt_pk_bf16(acc, hi_);
            asm volatile("s_waitcnt lgkmcnt(0)" ::: "memory");
        }
    }
#endif
    __syncthreads();
#ifndef NO_PROMPT
    for (int u = blockIdx.x; u < NB * NH * 8; u += gridDim.x) {
        const int qblk = u & 7, h = (u >> 3) & 15, b = u >> 7;
        const float slope2 = exp2f(-0.5f * (float)(h + 1)) * LOG2E;
        const bf16_t* Qh = Q + (size_t)b * SEQ * D + h * HD; const bf16_t* Kh = K + (size_t)b * SEQ * D + h * HD; const bf16_t* Vh = V + (size_t)b * SEQ * D + h * HD;
#pragma clang loop unroll(disable)
        for (int tk = 0; tk < 4; ++tk) {
            int dil, cls, s0, nq, qlb, qls;
            if (tk == 0) { dil = 1; cls = 0; s0 = 256 * qblk + 32 * wave; nq = 32; qlb = 32 * wave; qls = 1; }
            else if (tk == 1) { dil = 4; cls = wave & 3; s0 = 64 * qblk + 32 * (wave >> 2); nq = 32; qlb = (wave & 3) + 128 * (wave >> 2); qls = 4; }
            else { dil = 16; cls = 2 * wave + (tk - 2); s0 = 16 * qblk; nq = 16; qlb = cls; qls = 16; }
            attn_task(Qh, Kh, Vh, dil, cls, s0, nq, slope2, qlb, qls, tk == 0, lds, wave, lane);
            if (tk != 2) __syncthreads();
        }
        {
            const int ql = tid >> 1, dh = (tid & 1) * 32;
            const LAS float* oa = (const LAS float*)(lds + AT_OACC) + ql * AT_OSTR + dh;
            const float inv = __builtin_amdgcn_rcpf(((const LAS float*)(lds + AT_ML))[ql * 2 + 1]);
            bf16_t* op = O + (size_t)(b * SEQ + 256 * qblk + ql) * D + h * HD + dh;
#pragma unroll
            for (int e = 0; e < 4; ++e) { u32x4 w; w.x = cvt_pk_bf16(oa[8 * e + 0] * inv, oa[8 * e + 1] * inv); w.y = cvt_pk_bf16(oa[8 * e + 2] * inv, oa[8 * e + 3] * inv);
                w.z = cvt_pk_bf16(oa[8 * e + 4] * inv, oa[8 * e + 5] * inv); w.w = cvt_pk_bf16(oa[8 * e + 6] * inv, oa[8 * e + 7] * inv); *(u32x4*)(op + 8 * e) = w; }
        }
        __syncthreads();
    }
#endif
}

__device__ __forceinline__ void p13_final(const Args& a, int gw, int NGW, int lane) {
    const float* H = (const float*)(a.ws + WS_H); const float* g = a.in[9];
    for (int r = gw; r < MTOT; r += NGW) {
        const f32x4* xr = (const f32x4*)(H + (size_t)r * D) + lane; f32x4 v[4]; float s = 0.f;
#pragma unroll
        for (int j = 0; j < 4; ++j) { v[j] = xr[64 * j]; s += (v[j].x * v[j].x + v[j].y * v[j].y) + (v[j].z * v[j].z + v[j].w * v[j].w); }
        const float rstd = rsqrtf(wave_sum(s) * (1.0f / D) + RMS_EPS);
        f32x4* o = (f32x4*)(a.out + (size_t)r * D) + lane;
#pragma unroll
        for (int j = 0; j < 4; ++j) o[64 * j] = v[j] * rstd * ((const f32x4*)g)[64 * j + lane];
    }
}

#define XB_TMO      128
#define XB_XCNT(j)  (256  + 64 * (j))
#define XB_XSUB(j)  (1280 + 64 * (j))
#define XB_XGEN(j)  (2304 + 64 * (j))
#define XB_TOP      3328
#define XB_TOPGEN   3392
#define XCD_BAR_WORDS 3456
#define XB_SPIN_CAP (1u << 18)
__device__ __forceinline__ unsigned xb_ld(unsigned* p)              { return __hip_atomic_load(p, __ATOMIC_RELAXED, __HIP_MEMORY_SCOPE_AGENT); }
__device__ __forceinline__ unsigned xb_add(unsigned* p, unsigned v) { return __hip_atomic_fetch_add(p, v, __ATOMIC_RELAXED, __HIP_MEMORY_SCOPE_AGENT); }
__device__ __forceinline__ unsigned xb_xcc_id() { return (unsigned)__builtin_amdgcn_s_getreg((3 << 11) | 20) & 0xFu; }
#define XB_SPIN(cond, bar) do { unsigned _sp = 0; while (cond) { __builtin_amdgcn_s_sleep(1); \
    if ((++_sp & 255u) == 0u) { if (xb_ld(&(bar)[XB_TMO])) break; if (_sp > XB_SPIN_CAP) { atomicAdd(&(bar)[XB_TMO], 1u); break; } } } } while (0)
__device__ __forceinline__ void xcd_barrier_complete(unsigned* bar, unsigned x, unsigned& nloc, unsigned& nx) {
    const unsigned G = gridDim.x * gridDim.y * gridDim.z;
    unsigned sum, cnt, mine, sp = 0u;
    for (;;) {
        sum = 0u; cnt = 0u; mine = 0u;
#pragma unroll
        for (unsigned j = 0; j < 16; ++j) { const unsigned c = xb_ld(&bar[XB_XCNT(j)]); sum += c; cnt += (c > 0u) ? 1u : 0u; mine = (j == x) ? c : mine; }
        if (sum == G) break;
        __builtin_amdgcn_s_sleep(1);
        if ((++sp & 255u) == 0u) { if (xb_ld(&bar[XB_TMO])) break; if (sp > XB_SPIN_CAP) { atomicAdd(&bar[XB_TMO], 1u); break; } }
    }
    nloc = mine > 0u ? mine : 1u; nx = cnt > 0u ? cnt : 1u;
}
__device__ __forceinline__ void xcd_barrier(unsigned* bar, volatile LAS unsigned* st) {
    asm volatile("s_waitcnt vmcnt(0)" ::: "memory");
    __syncthreads();
    if (threadIdx.x == 0) {
        const unsigned x = xb_xcc_id();
        __builtin_amdgcn_s_waitcnt(0);
        unsigned nloc = st[0], nx = st[1];
        if (nloc == 0u) { xcd_barrier_complete(bar, x, nloc, nx); st[0] = nloc; st[1] = nx; }
        const unsigned old = xb_add(&bar[XB_XSUB(x)], 1u);
        const unsigned gen = old / nloc;
        if (old + 1u == (gen + 1u) * nloc) {
            __builtin_amdgcn_fence(__ATOMIC_RELEASE, "agent");
            asm volatile("s_waitcnt vmcnt(0)" ::: "memory");
            const unsigned og = xb_add(&bar[XB_TOP], 1u);
            const unsigned tg = og / nx;
            if (og + 1u == (tg + 1u) * nx) xb_add(&bar[XB_TOPGEN], 1u);
            else XB_SPIN(xb_ld(&bar[XB_TOPGEN]) == tg, bar);
            __builtin_amdgcn_fence(__ATOMIC_ACQUIRE, "agent");
            xb_add(&bar[XB_XGEN(x)], 1u);
            asm volatile("s_waitcnt vmcnt(0)" ::: "memory");
        } else {
            XB_SPIN(xb_ld(&bar[XB_XGEN(x)]) == gen, bar);
            __builtin_amdgcn_fence(__ATOMIC_ACQUIRE, "agent");
            asm volatile("s_waitcnt vmcnt(0)" ::: "memory");
        }
    }
    __syncthreads();
}

typedef const __attribute__((address_space(4))) Args* kargp_t;
__device__ __forceinline__ Args kargs() {
    Args a;
#if defined(__HIP_DEVICE_COMPILE__)
    kargp_t p = (kargp_t)__builtin_amdgcn_kernarg_segment_ptr(); asm volatile("" : "+s"(p));
#pragma unroll
    for (int i = 0; i < 22; ++i) a.in[i] = p->in[i];
    a.out = p->out; a.ws = p->ws;
#else
    for (int i = 0; i < 22; ++i) a.in[i] = nullptr;
    a.out = nullptr; a.ws = nullptr;
#endif
    return a;
}
#define PHASE_BEGIN const Args a = kargs(); unsigned char* ws = a.ws; const int tid = launder_v(threadIdx.x), lane = tid & 63, wave = __builtin_amdgcn_readfirstlane(tid >> 6); \
    const int G = gridDim.x, gw = blockIdx.x * NWAVES + wave, NGW = G * NWAVES; (void)ws; (void)lane; (void)gw; (void)NGW; (void)G;
__global__ void __launch_bounds__(NTHREADS, 2) mega_fwd(Args a_unused) {
    extern __shared__ __attribute__((aligned(16))) unsigned char lds_raw[];
    LAS unsigned char* lds = (LAS unsigned char*)lds_raw;
    cg::grid_group grid = cg::this_grid();
    volatile LAS unsigned* bst = (volatile LAS unsigned*)(lds + 131072 + 64);
    { unsigned* ctl0 = (unsigned*)kargs().ws; if (threadIdx.x == 0) { bst[0] = 0u; bst[1] = 0u; (void)xb_add(&ctl0[XB_XCNT(xb_xcc_id())], 1u); } }
    __syncthreads();
#define GRID_BAR() do { unsigned* ctl_ = (unsigned*)kargs().ws; xcd_barrier(ctl_, bst); } while (0)
#ifndef PHASES
#define PHASES 0xFFFF
#endif
#define PH(k) if constexpr (((PHASES) >> (k)) & 1)

    PH(0) { PHASE_BEGIN p0_prologue(a, lds, gw, NGW, lane, wave); }
    grid.sync();
    PH(1) {
        PHASE_BEGIN
        pg8::Gemm g{(const bf16_t*)(ws + WS_HB), (const bf16_t*)(ws + WS_WIN), MPAD, NIN, D}; pg8::StaticOrder S; S.init(MPAD, NIN, G, (int)blockIdx.x);
        pg8::EpiInAB E{(bf16_t*)(ws + WS_GA), (const float*)(ws + WS_SSQ), a.out};
        pg8::gemm_phase<pg8::EpiInAB, pg8::StaticOrder, true, true>(lds, g, S, E);
    }
    GRID_BAR();
    PH(2) { PHASE_BEGIN p2_conv(a, lds, tid, lane, wave); }
    GRID_BAR();
    PH(3) {
        PHASE_BEGIN
        pg8::Gemm g{(const bf16_t*)(ws + WS_AB), (const bf16_t*)(ws + WS_WOUT), MPAD, D, D}; pg8::StaticOrder S; S.init(MPAD, D, G, (int)blockIdx.x);
        pg8::EpiResid E{a.in[0], a.in[1], (float*)(ws + WS_H), (bf16_t*)(ws + WS_HB), (float*)(ws + WS_SSQ)};
        pg8::gemm_phase<pg8::EpiResid, pg8::StaticOrder, true, true>(lds, g, S, E);
    }
    GRID_BAR();
#pragma clang loop unroll(disable)
    for (int layer = 0; layer < 2; ++layer) {
        if (layer == 1) {
            PH(7) {
                PHASE_BEGIN
                pg8::Gemm g{(const bf16_t*)(ws + WS_HB), (const bf16_t*)(ws + WS_WQKV), MPAD, 3 * D, D}; pg8::StaticOrder S; S.init(MPAD, 3 * D, G, (int)blockIdx.x);
                pg8::EpiQkv E{(bf16_t*)(ws + WS_Q), (float*)(ws + WS_QS), (const float*)(ws + WS_SSQ), a.out};
                pg8::gemm_phase<pg8::EpiQkv, pg8::StaticOrder, true, true>(lds, g, S, E);
            }
            GRID_BAR();
            PH(8) { PHASE_BEGIN p8_attention(a, lds, tid, lane, wave); }
            GRID_BAR();
            PH(9) {
                PHASE_BEGIN
                float* H = (float*)(ws + WS_H);
                pg8::Gemm g{(const bf16_t*)(ws + WS_AB), (const bf16_t*)(ws + WS_WO), MPAD, D, D}; pg8::StaticOrder S; S.init(MPAD, D, G, (int)blockIdx.x);
                pg8::EpiResid E{H, H + (size_t)MPR * D, H, (bf16_t*)(ws + WS_HB), (float*)(ws + WS_SSQ)};
                pg8::gemm_phase<pg8::EpiResid, pg8::StaticOrder, true, true>(lds, g, S, E);
            }
            GRID_BAR();
        }
        PH(4) {
            PHASE_BEGIN
            pg8::Gemm g{(const bf16_t*)(ws + WS_HB), (const bf16_t*)(ws + (layer ? WS_WF1 : WS_WF0)), MPAD, 2 * DFF, D}; pg8::StaticOrder S; S.init(MPAD, 2 * DFF, G, (int)blockIdx.x);
            pg8::EpiFfn E{(bf16_t*)(ws + WS_ZG), (bf16_t*)(ws + WS_ZU), (const float*)(ws + WS_SSQ), a.out, layer};
            pg8::gemm_phase<pg8::EpiFfn, pg8::StaticOrder, true, true>(lds, g, S, E);
        }
        GRID_BAR();
        PH(5) { PHASE_BEGIN p5_combine(a, layer, blockIdx.x * NTHREADS + tid, G * NTHREADS); }
        GRID_BAR();
        PH(6) {
            PHASE_BEGIN
            float* H = (float*)(ws + WS_H);
            pg8::Gemm g{(const bf16_t*)(ws + WS_U), (const bf16_t*)(ws + (layer ? WS_WD1 : WS_WD0)), MPAD, D, DFF}; pg8::StaticOrder S; S.init(MPAD, D, G, (int)blockIdx.x);
            pg8::EpiResid E{H, H + (size_t)MPR * D, H, (bf16_t*)(ws + WS_HB), (float*)(ws + WS_SSQ)};
            pg8::gemm_phase<pg8::EpiResid, pg8::StaticOrder, true, true>(lds, g, S, E);
        }
        GRID_BAR();
    }
    PH(13) { PHASE_BEGIN p13_final(a, gw, NGW, lane); }
}

extern "C" void kernel_launch(void* const* d_in, const int* in_sizes, int n_in, void* d_out, int out_size, void* d_ws, size_t ws_size, hipStream_t stream) {
    static int grid = 0;
    if (grid == 0) {
        if (n_in != 22 || (size_t)out_size != O_END || ws_size < WS_END) { fprintf(stderr, "kernel_launch: unexpected shapes (n_in %d, out %d, ws %zu, need %zu)\n", n_in, out_size, ws_size, (size_t)WS_END); grid = -1; return; }
        int dev = 0, cus = 0, per_cu = 0;
        if (hipGetDevice(&dev) != hipSuccess || hipDeviceGetAttribute(&cus, hipDeviceAttributeMultiprocessorCount, dev) != hipSuccess) { grid = -1; return; }
        if (hipFuncSetAttribute((const void*)mega_fwd, hipFuncAttributeMaxDynamicSharedMemorySize, LDS_BYTES) != hipSuccess) { fprintf(stderr, "kernel_launch: hipFuncSetAttribute failed\n"); grid = -1; return; }
        if (hipOccupancyMaxActiveBlocksPerMultiprocessor(&per_cu, (const void*)mega_fwd, NTHREADS, LDS_BYTES) != hipSuccess || per_cu < 1) { fprintf(stderr, "kernel_launch: occupancy query failed (%d)\n", per_cu); (void)hipGetLastError(); grid = -1; return; }
        grid = cus * 1;
    }
    if (grid < 0) return;
    if (hipMemsetAsync((char*)d_ws + WS_CTL, 0, CTL_BYTES, stream) != hipSuccess) { fprintf(stderr, "kernel_launch: memset failed\n"); return; }
    Args a{};
    for (int i = 0; i < 22; ++i) a.in[i] = (const float*)d_in[i];
    a.out = (float*)d_out; a.ws = (unsigned char*)d_ws;
    void* args[] = {&a};
    hipError_t e = hipLaunchCooperativeKernel((const void*)mega_fwd, dim3(grid), dim3(NTHREADS), args, LDS_BYTES, stream);
    if (e != hipSuccess) fprintf(stderr, "cooperative launch failed: %s (grid %d)\n", hipGetErrorString(e), grid);
}
```

```cpp
#include <hip/hip_runtime.h>
#include <hip/hip_cooperative_groups.h>
#include <cstdio>
#include <cstdint>
namespace cg = cooperative_groups;

#define LAS __attribute__((address_space(3)))
typedef unsigned short bf16_t;
typedef short bf16x8 __attribute__((ext_vector_type(8)));
typedef float f32x4 __attribute__((ext_vector_type(4)));
typedef float f32x2 __attribute__((ext_vector_type(2)));
typedef float f32x16 __attribute__((ext_vector_type(16)));
typedef unsigned u32x4 __attribute__((ext_vector_type(4)));
typedef unsigned u32x2 __attribute__((ext_vector_type(2)));
typedef short s16x4 __attribute__((ext_vector_type(4)));

constexpr int D = 1024, SEQ = 2048, NB = 8, MPR = NB * SEQ, NSB = 32, NST = 4, MSA = NSB * NST, MTOT = MPR + MSA, MPAD = 16640;
constexpr int DFF = 2816, NIN = 2560, CH = 512, NH = 16, HD = 64, LBUF = 2048, KA = 31;
constexpr int GAW = 1536;
constexpr float RMS_EPS = 1e-6f, LN_EPS = 1e-5f;
constexpr float LOG2E = 1.4426950408889634f;
constexpr float QSCALE = 0.125f * LOG2E;

constexpr size_t O_YP = 0;
constexpr size_t O_YS = O_YP + (size_t)MPR * D;
constexpr size_t O_PCA = O_YS + (size_t)MSA * D;
constexpr size_t O_SCA = O_PCA + (size_t)NB * 30 * CH;
constexpr size_t O_PCB = O_SCA + (size_t)NSB * 30 * CH;
constexpr size_t O_SCB = O_PCB + (size_t)NB * 2 * CH;
constexpr size_t O_PK = O_SCB + (size_t)NSB * 2 * CH;
constexpr size_t O_SK = O_PK + (size_t)MPR * D;
constexpr size_t O_PV = O_SK + (size_t)NSB * LBUF * D;
constexpr size_t O_SV = O_PV + (size_t)MPR * D;
constexpr size_t O_PF = O_SV + (size_t)NSB * LBUF * D;
constexpr size_t O_SF = O_PF + (size_t)2 * NB * 2 * DFF;
constexpr size_t O_END = O_SF + (size_t)2 * NSB * 2 * DFF;

constexpr size_t al(size_t x) { return (x + 4095) & ~(size_t)4095; }
constexpr size_t WS_CTL = 0, CTL_BYTES = 65536;
constexpr size_t WS_WIN = WS_CTL + CTL_BYTES;
constexpr size_t WS_WOUT = WS_WIN + al((size_t)NIN * D * 2);
constexpr size_t WS_WQKV = WS_WOUT + al((size_t)D * D * 2);
constexpr size_t WS_WO = WS_WQKV + al((size_t)3 * D * D * 2);
constexpr size_t WS_WF0 = WS_WO + al((size_t)D * D * 2);
constexpr size_t WS_WF1 = WS_WF0 + al((size_t)2 * DFF * D * 2);
constexpr size_t WS_WD0 = WS_WF1 + al((size_t)2 * DFF * D * 2);
constexpr size_t WS_WD1 = WS_WD0 + al((size_t)D * DFF * 2);
constexpr size_t WS_HB = WS_WD1 + al((size_t)D * DFF * 2);
constexpr size_t WS_H = WS_HB + al((size_t)MPAD * D * 2);
constexpr size_t WS_SSQ = WS_H + al((size_t)MPAD * D * 4);
constexpr size_t WS_GA = WS_SSQ + al((size_t)MPAD * 16 * 4);
constexpr size_t WS_AB = WS_GA + al((size_t)MPAD * GAW * 2);
constexpr size_t WS_ZG = WS_AB + al((size_t)MPAD * D * 2);
constexpr size_t WS_ZU = WS_ZG + al((size_t)MPAD * DFF * 2);
constexpr size_t WS_U = WS_ZU + al((size_t)MPAD * DFF * 2);
constexpr size_t WS_Q = WS_U + al((size_t)MPAD * DFF * 2);
constexpr size_t WS_K = WS_Q + al((size_t)MPAD * D * 2);
constexpr size_t WS_V = WS_K + al((size_t)MPAD * D * 2);
constexpr size_t WS_QS = WS_V + al((size_t)MPAD * D * 2);
constexpr size_t WS_END = WS_QS + al((size_t)MSA * D * 4);
static_assert(WS_V - WS_K == WS_K - WS_Q, "Q|K|V equally spaced");

constexpr int NWAVES = 8, NTHREADS = 512;
constexpr int LDS_BYTES = 147456;

__device__ __forceinline__ unsigned cvt_pk_bf16(float lo, float hi) { unsigned r; asm volatile("v_cvt_pk_bf16_f32 %0, %1, %2" : "=v"(r) : "v"(lo), "v"(hi)); return r; }
__device__ __forceinline__ float bf2f(unsigned short b) { return __uint_as_float((unsigned)b << 16); }
__device__ __forceinline__ float bflo(unsigned w) { return __uint_as_float(w << 16); }
__device__ __forceinline__ float bfhi(unsigned w) { return __uint_as_float(w & 0xffff0000u); }
__device__ __forceinline__ float sigmoidf_(float x) { return __builtin_amdgcn_rcpf(1.0f + __expf(-x)); }
__device__ __forceinline__ int launder_v(int x) { asm volatile("" : "+v"(x)); return x; }
__device__ __forceinline__ float wave_sum(float v) {
#pragma unroll
    for (int o = 1; o < 64; o <<= 1) v += __shfl_xor(v, o);
    return v;
}
__device__ __forceinline__ float wave_max(float v) {
#pragma unroll
    for (int o = 1; o < 64; o <<= 1) v = fmaxf(v, __shfl_xor(v, o));
    return v;
}

namespace pg8 {
constexpr int BM = 256, BK = 64, HALF = 128, HTB = HALF * BK * 2, STAGE_BYTES = 8 * HTB, NXCD = 8, WGM = 8;
__host__ __device__ __forceinline__ int lds_byte(int r, int c) { const int st = (r >> 4) * 2 + (c >> 5), rr = r & 15, cc = c & 31, ob = rr * 64 + cc * 2; return st * 1024 + (ob ^ (((ob >> 9) & 1) << 5)); }
__host__ __device__ __forceinline__ void stage_rc(int b, int& R, int& C) { const int st = b / 1024, sb = b % 1024, swz = sb ^ (((sb >> 9) & 1) << 5); R = (st >> 1) * 16 + swz / 64; C = (st & 1) * 32 + (swz % 64) / 2; }
__host__ __device__ __forceinline__ int perm32(int rho) { const int n = rho >> 4, i = rho & 15; return 8 * (i >> 2) + 4 * n + (i & 3); }

struct Unit { int pm, pn; };
struct Gemm { const bf16_t* A; const bf16_t* Bt; int M, N, K; };

struct StaticOrder {
    int nM, nN, nwg, G, c;
    __host__ __device__ void init(int M, int N, int G_, int c_) { nM = M / BM; nN = N / BM; nwg = nM * nN; G = G_; c = c_; }
    __host__ __device__ bool next(int i, Unit& u) const {
        const long L = (long)i * G + c; if (L >= nwg) return false;
        int wgid = (int)L; { const int q = nwg / NXCD, r = nwg % NXCD, xcd = wgid % NXCD, off = wgid / NXCD; wgid = (xcd < r ? xcd * (q + 1) : r * (q + 1) + (xcd - r) * q) + off; }
        const int nig = WGM * nN, gid = wgid / nig, fm = gid * WGM, gsz = (nM - fm) < WGM ? (nM - fm) : WGM;
        u.pm = fm + ((wgid % nig) % gsz); u.pn = (wgid % nig) / gsz; return true;
    }
    __device__ __forceinline__ void a_ready(const Unit&) const {}
    __device__ __forceinline__ void done(const Unit&) const {}
};

__device__ __forceinline__ float row_rstd(const float* ssq, int r, int fq) {
    const f32x4 p = *(const f32x4*)(ssq + (size_t)r * 16 + 4 * fq);
    float s = (p.x + p.y) + (p.z + p.w);
    s += __shfl_xor(s, 16); s += __shfl_xor(s, 32);
    return rsqrtf(s * (1.0f / D) + RMS_EPS);
}

struct EpiInAB {
    static constexpr bool PERM = true, AFTER_DRAIN = false;
    bf16_t* GA; const float* ssq; float* out;
    __device__ __forceinline__ void operator()(const f32x4 (&acc)[2][2][4][2], const Unit& u, int wr, int wc, int fr, int fq) const {
        const int pn = u.pn, colw = wc * 32 + 8 * fq;
#pragma unroll
        for (int ai = 0; ai < 2; ++ai)
#pragma unroll
            for (int m = 0; m < 4; ++m) {
                const int r = u.pm * BM + ai * HALF + wr * 64 + m * 16 + fr;
                const float rs = row_rstd(ssq, r, fq);
                const f32x4 a0 = acc[ai][0][m][0] * rs, a1 = acc[ai][0][m][1] * rs, g0 = acc[ai][1][m][0] * rs, g1 = acc[ai][1][m][1] * rs;
                bf16_t* rowp = GA + (size_t)r * GAW;
                if (pn < 8) {
                    f32x4 v0, v1;
                    if (pn < 4) {
#pragma unroll
                        for (int i = 0; i < 4; ++i) { v0[i] = a0[i] * sigmoidf_(g0[i]); v1[i] = a1[i] * sigmoidf_(g1[i]); }
                    } else { v0 = a0 * g0; v1 = a1 * g1; }
                    const int cl = 128 * (pn & 3) + colw;
                    u32x4 w; w.x = cvt_pk_bf16(v0[0], v0[1]); w.y = cvt_pk_bf16(v0[2], v0[3]); w.z = cvt_pk_bf16(v1[0], v1[1]); w.w = cvt_pk_bf16(v1[2], v1[3]);
                    *(u32x4*)(rowp + (pn < 4 ? 0 : 512) + cl) = w;
                    const int keep = pn < 4 ? 30 : 2;
                    float* sp = nullptr;
                    if (r < MPR) { const int t = r & (SEQ - 1), b = r >> 11; if (t >= SEQ - keep) sp = out + (pn < 4 ? O_PCA : O_PCB) + ((size_t)(b * keep + (t - (SEQ - keep)))) * CH + cl; }
                    else if (r < MTOT) { const int rs_ = r - MPR, sb = rs_ >> 2, j = rs_ & 3; if (j >= NST - keep || keep == 30) sp = out + (pn < 4 ? O_SCA : O_SCB) + ((size_t)(sb * keep + (keep - NST + j))) * CH + cl; }
                    if (sp) { *(f32x4*)sp = v0; *(f32x4*)(sp + 4) = v1; }
                } else {
                    const int c = 1024 + 256 * (pn - 8) + colw;
                    u32x4 w; w.x = cvt_pk_bf16(a0[0], a0[1]); w.y = cvt_pk_bf16(a0[2], a0[3]); w.z = cvt_pk_bf16(a1[0], a1[1]); w.w = cvt_pk_bf16(a1[2], a1[3]);
                    *(u32x4*)(rowp + c) = w;
                    w.x = cvt_pk_bf16(g0[0], g0[1]); w.y = cvt_pk_bf16(g0[2], g0[3]); w.z = cvt_pk_bf16(g1[0], g1[1]); w.w = cvt_pk_bf16(g1[2], g1[3]);
                    *(u32x4*)(rowp + c + 128) = w;
                }
            }
    }
};
struct EpiResid {
    static constexpr bool PERM = false, AFTER_DRAIN = false;
    const float* baseP; const float* baseS; float* H; bf16_t* HB; float* ssq;
    __device__ __forceinline__ void operator()(const f32x4 (&acc)[2][2][4][2], const Unit& u, int wr, int wc, int fr, int fq) const {
        const int col0 = u.pn * BM + wc * 32 + 4 * fq;
#pragma unroll
        for (int ai = 0; ai < 2; ++ai)
#pragma unroll
            for (int m = 0; m < 4; ++m) {
                const int r = u.pm * BM + ai * HALF + wr * 64 + m * 16 + fr;
                float s = 0.f;
                if (r < MTOT) {
                    const float* bp = (r < MPR) ? baseP + (size_t)r * D : baseS + (size_t)(r - MPR) * D;
#pragma unroll
                    for (int bj = 0; bj < 2; ++bj)
#pragma unroll
                        for (int n = 0; n < 2; ++n) {
                            const int c = col0 + bj * HALF + n * 16;
                            const f32x4 v = *(const f32x4*)(bp + c) + acc[ai][bj][m][n];
                            *(f32x4*)(H + (size_t)r * D + c) = v;
                            s += (v[0] * v[0] + v[1] * v[1]) + (v[2] * v[2] + v[3] * v[3]);
                            u32x2 w; w.x = cvt_pk_bf16(v[0], v[1]); w.y = cvt_pk_bf16(v[2], v[3]);
                            *(u32x2*)(HB + (size_t)r * D + c) = w;
                        }
                }
                s += __shfl_xor(s, 16); s += __shfl_xor(s, 32);
                if (fq == 0 && r < MTOT) ssq[(size_t)r * 16 + u.pn * 4 + wc] = s;
            }
    }
};
struct EpiFfn {
    static constexpr bool PERM = true, AFTER_DRAIN = false;
    bf16_t* ZG; bf16_t* ZU; const float* ssq; float* out; int layer;
    __device__ __forceinline__ void operator()(const f32x4 (&acc)[2][2][4][2], const Unit& u, int wr, int wc, int fr, int fq) const {
        const int col = u.pn * 128 + wc * 32 + 8 * fq;
#pragma unroll
        for (int ai = 0; ai < 2; ++ai)
#pragma unroll
            for (int m = 0; m < 4; ++m) {
                const int r = u.pm * BM + ai * HALF + wr * 64 + m * 16 + fr;
                const float rs = row_rstd(ssq, r, fq);
                const f32x4 g0 = acc[ai][0][m][0] * rs, g1 = acc[ai][0][m][1] * rs, u0 = acc[ai][1][m][0] * rs, u1 = acc[ai][1][m][1] * rs;
                u32x4 w; w.x = cvt_pk_bf16(g0[0], g0[1]); w.y = cvt_pk_bf16(g0[2], g0[3]); w.z = cvt_pk_bf16(g1[0], g1[1]); w.w = cvt_pk_bf16(g1[2], g1[3]);
                *(u32x4*)(ZG + (size_t)r * DFF + col) = w;
                w.x = cvt_pk_bf16(u0[0], u0[1]); w.y = cvt_pk_bf16(u0[2], u0[3]); w.z = cvt_pk_bf16(u1[0], u1[1]); w.w = cvt_pk_bf16(u1[2], u1[3]);
                *(u32x4*)(ZU + (size_t)r * DFF + col) = w;
                float* sp = nullptr;
                if (r < MPR) { const int t = r & (SEQ - 1), b = r >> 11; if (t >= SEQ - 2) sp = out + O_PF + ((size_t)((layer * NB + b) * 2 + (t - (SEQ - 2)))) * DFF + col; }
                else if (r < MTOT) { const int rs_ = r - MPR, sb = rs_ >> 2, j = rs_ & 3; if (j >= 2) sp = out + O_SF + ((size_t)((layer * NSB + sb) * 2 + (j - 2))) * DFF + col; }
                if (sp) { *(f32x4*)sp = g0; *(f32x4*)(sp + 4) = g1; }
            }
    }
};
struct EpiQkv {
    static constexpr bool PERM = true, AFTER_DRAIN = false;
    bf16_t* QKV; float* QS; const float* ssq; float* out;
    __device__ __forceinline__ void operator()(const f32x4 (&acc)[2][2][4][2], const Unit& u, int wr, int wc, int fr, int fq) const {
        const int which = u.pn >> 2, cb = 256 * (u.pn & 3) + wc * 32 + 8 * fq;
        bf16_t* dst = QKV + (size_t)which * ((WS_K - WS_Q) / 2);
#pragma unroll
        for (int ai = 0; ai < 2; ++ai)
#pragma unroll
            for (int m = 0; m < 4; ++m) {
                const int r = u.pm * BM + ai * HALF + wr * 64 + m * 16 + fr;
                const float rs = row_rstd(ssq, r, fq) * (which == 0 ? QSCALE : 1.0f);
                float* fp = nullptr;
                if (which == 0) { if (r >= MPR && r < MTOT) fp = QS + (size_t)(r - MPR) * D; }
                else if (r < MPR) fp = out + (which == 1 ? O_PK : O_PV) + (size_t)r * D;
                else if (r < MTOT) { const int rs_ = r - MPR, sb = rs_ >> 2, j = rs_ & 3; fp = out + (which == 1 ? O_SK : O_SV) + ((size_t)sb * LBUF + (LBUF - NST) + j) * D; }
#pragma unroll
                for (int bj = 0; bj < 2; ++bj) {
                    const f32x4 v0 = acc[ai][bj][m][0] * rs, v1 = acc[ai][bj][m][1] * rs;
                    const int c = cb + bj * HALF;
                    u32x4 w; w.x = cvt_pk_bf16(v0[0], v0[1]); w.y = cvt_pk_bf16(v0[2], v0[3]); w.z = cvt_pk_bf16(v1[0], v1[1]); w.w = cvt_pk_bf16(v1[2], v1[3]);
                    *(u32x4*)(dst + (size_t)r * D + c) = w;
                    if (fp) { *(f32x4*)(fp + c) = v0; *(f32x4*)(fp + c + 4) = v1; }
                }
            }
    }
};

template <class Epi, class Sched, bool ALIGN_EPI = false, bool SP2 = false>
__device__ __forceinline__ void gemm_phase(LAS unsigned char* lds, const Gemm g, const Sched& S, const Epi& E) {
    const int tid = launder_v(threadIdx.x), wid = __builtin_amdgcn_readfirstlane(tid >> 6), lane = tid & 63, wr = wid >> 2, wc = wid & 3, fr = lane & 15, fq = lane >> 4;
    const int K = g.K, nt = K / BK;
    unsigned voffA[2], voffB[2];
#pragma unroll
    for (int i = 0; i < 2; ++i) { int R, C; stage_rc(tid * 16 + i * 8192, R, C); const int Rb = Epi::PERM ? ((R & ~31) + perm32(R & 31)) : R;
        voffA[i] = (unsigned)(R * K + C) * 2u; voffB[i] = (unsigned)(Rb * K + C) * 2u; }
    const size_t kstep = (size_t)(BK * 2);
    const size_t hstep = (size_t)HALF * K * 2;
    const size_t tstep = 2 * hstep;
    const unsigned ldsw = (unsigned)wid * 1024u;
    const int aoff = lds_byte(wr * 64 + fr, fq * 8), boff = lds_byte(wc * 32 + fr, fq * 8);
#define PG8_SA(b, h) (((b) * 2 + (h)) * HTB)
#define PG8_SB(b, h) ((4 + (b) * 2 + (h)) * HTB)
#define PG8_STAGE(bufoff, gbase, voff) do { _Pragma("unroll") for (int _i = 0; _i < 2; ++_i) \
        __builtin_amdgcn_global_load_lds((const unsigned*)((const char*)(gbase) + (voff)[_i]), (LAS unsigned*)(lds + (bufoff) + ldsw + _i * 8192), 16, 0, 0); } while (0)
#define PG8_LDA(dst, b, h) do { _Pragma("unroll") for (int m = 0; m < 4; ++m) _Pragma("unroll") for (int k = 0; k < 2; ++k) dst[m][k] = *(const LAS bf16x8*)(lds + PG8_SA(b, h) + aoff + m * 2048 + k * 1024); } while (0)
#define PG8_LDB(dst, b, h) do { _Pragma("unroll") for (int n = 0; n < 2; ++n) _Pragma("unroll") for (int k = 0; k < 2; ++k) dst[n][k] = *(const LAS bf16x8*)(lds + PG8_SB(b, h) + boff + n * 2048 + k * 1024); } while (0)
#define PG8_MMA(ai, bj, At, Bt) do { __builtin_amdgcn_s_setprio(1); _Pragma("unroll") for (int m = 0; m < 4; ++m) _Pragma("unroll") for (int n = 0; n < 2; ++n) _Pragma("unroll") for (int k = 0; k < 2; ++k) \
        acc[ai][bj][m][n] = __builtin_amdgcn_mfma_f32_16x16x32_bf16(Bt[n][k], At[m][k], acc[ai][bj][m][n], 0, 0, 0); __builtin_amdgcn_s_setprio(0); } while (0)
#define PG8_WAIT_V(n) asm volatile("s_waitcnt vmcnt(" #n ")" ::: "memory")
#define PG8_WAIT_L(n) asm volatile("s_waitcnt lgkmcnt(" #n ")" ::: "memory")
#define PG8_BAR __builtin_amdgcn_s_barrier()
#define PG8_SCHED __builtin_amdgcn_sched_barrier(0)
    Unit cur, nxt; int ui = 0;
    if (!S.next(0, cur)) return;
    f32x4 acc[2][2][4][2];
#pragma unroll
    for (int a = 0; a < 2; ++a)
#pragma unroll
        for (int b = 0; b < 2; ++b)
#pragma unroll
            for (int m = 0; m < 4; ++m)
#pragma unroll
                for (int n = 0; n < 2; ++n) acc[a][b][m][n] = (f32x4){0.f, 0.f, 0.f, 0.f};
    bf16x8 At[4][2], B0[2][2], B1[2][2];
    const char* cA = (const char*)g.A + (size_t)cur.pm * tstep; const char* cB = (const char*)g.Bt + (size_t)cur.pn * tstep;
    S.a_ready(cur);
    if constexpr (SP2) {
        PG8_STAGE(PG8_SB(0, 0), cB, voffB); PG8_STAGE(PG8_SB(0, 1), cB + hstep, voffB); PG8_STAGE(PG8_SA(0, 0), cA, voffA); PG8_STAGE(PG8_SA(0, 1), cA + hstep, voffA);
        if (wr == 1) PG8_BAR;
        PG8_WAIT_V(2); PG8_BAR;
        PG8_STAGE(PG8_SB(1, 0), cB + kstep, voffB); PG8_STAGE(PG8_SA(1, 0), cA + kstep, voffA); PG8_STAGE(PG8_SB(1, 1), cB + hstep + kstep, voffB);
        PG8_WAIT_V(6); PG8_BAR;
    } else {
        PG8_STAGE(PG8_SB(0, 0), cB, voffB); PG8_STAGE(PG8_SA(0, 0), cA, voffA); PG8_STAGE(PG8_SB(0, 1), cB + hstep, voffB); PG8_STAGE(PG8_SA(0, 1), cA + hstep, voffA);
        if (wr == 1) PG8_BAR;
        PG8_WAIT_V(4); PG8_BAR;
        PG8_STAGE(PG8_SB(1, 0), cB + kstep, voffB); PG8_STAGE(PG8_SA(1, 0), cA + kstep, voffA); PG8_STAGE(PG8_SB(1, 1), cB + hstep + kstep, voffB);
        PG8_WAIT_V(6); PG8_BAR;
    }
    for (;;) {
        const bool has_next = S.next(ui + 1, nxt);
        const char* nA = has_next ? (const char*)g.A + (size_t)nxt.pm * tstep : cA; const char* nB = has_next ? (const char*)g.Bt + (size_t)nxt.pn * tstep : cB;
        for (int t = 0; t < nt; t += 2) {
            const bool last = (t == nt - 2);
            const char* a1 = cA + (size_t)(t + 1) * kstep;
            const char* a2 = last ? nA : cA + (size_t)(t + 2) * kstep; const char* b2 = last ? nB : cB + (size_t)(t + 2) * kstep;
            const char* a3 = a2 + kstep; const char* b3 = b2 + kstep;
            if (last && has_next) S.a_ready(nxt);
            if constexpr (SP2) {
            PG8_LDB(B0, 0, 0); PG8_LDB(B1, 0, 1); PG8_SCHED; PG8_LDA(At, 0, 0); PG8_STAGE(PG8_SA(1, 1), a1 + hstep, voffA);
            PG8_WAIT_V(8); PG8_WAIT_L(0); PG8_BAR; PG8_MMA(0, 0, At, B0); PG8_MMA(0, 1, At, B1); PG8_BAR; PG8_SCHED;
            PG8_LDA(At, 0, 1); PG8_STAGE(PG8_SB(0, 0), b2, voffB); PG8_STAGE(PG8_SB(0, 1), b2 + hstep, voffB); PG8_STAGE(PG8_SA(0, 0), a2, voffA);
            PG8_WAIT_V(8); PG8_WAIT_L(0); PG8_BAR; PG8_MMA(1, 0, At, B0); PG8_MMA(1, 1, At, B1); PG8_BAR; PG8_SCHED;
            PG8_LDB(B0, 1, 0); PG8_LDB(B1, 1, 1); PG8_SCHED; PG8_LDA(At, 1, 0); PG8_STAGE(PG8_SA(0, 1), a2 + hstep, voffA);
            PG8_WAIT_V(8); PG8_WAIT_L(0); PG8_BAR; PG8_MMA(0, 0, At, B0); PG8_MMA(0, 1, At, B1); PG8_BAR; PG8_SCHED;
            PG8_LDA(At, 1, 1); PG8_STAGE(PG8_SB(1, 0), b3, voffB); PG8_STAGE(PG8_SB(1, 1), b3 + hstep, voffB); PG8_STAGE(PG8_SA(1, 0), a3, voffA);
            PG8_WAIT_V(8); PG8_WAIT_L(0); PG8_BAR; PG8_MMA(1, 0, At, B0); PG8_MMA(1, 1, At, B1); PG8_BAR; PG8_SCHED;
            } else {
            PG8_LDB(B0, 0, 0); PG8_SCHED; PG8_LDA(At, 0, 0); PG8_STAGE(PG8_SA(1, 1), a1 + hstep, voffA);
            PG8_WAIT_L(8); PG8_BAR; PG8_WAIT_L(0); PG8_MMA(0, 0, At, B0); PG8_BAR; PG8_SCHED;
            PG8_LDB(B1, 0, 1); PG8_STAGE(PG8_SB(0, 0), b2, voffB);
            PG8_BAR; PG8_WAIT_L(0); PG8_MMA(0, 1, At, B1); PG8_BAR;
            PG8_LDA(At, 0, 1); PG8_STAGE(PG8_SA(0, 0), a2, voffA);
            PG8_BAR; PG8_WAIT_L(0); PG8_MMA(1, 0, At, B0); PG8_BAR; PG8_SCHED;
            PG8_STAGE(PG8_SB(0, 1), b2 + hstep, voffB);
            PG8_WAIT_V(6); PG8_BAR; PG8_MMA(1, 1, At, B1); PG8_BAR;
            PG8_LDB(B0, 1, 0); PG8_SCHED; PG8_LDA(At, 1, 0); PG8_STAGE(PG8_SA(0, 1), a2 + hstep, voffA);
            PG8_WAIT_L(8); PG8_BAR; PG8_WAIT_L(0); PG8_MMA(0, 0, At, B0); PG8_BAR; PG8_SCHED;
            PG8_LDB(B1, 1, 1); PG8_STAGE(PG8_SB(1, 0), b3, voffB);
            PG8_BAR; PG8_WAIT_L(0); PG8_MMA(0, 1, At, B1); PG8_BAR;
            PG8_LDA(At, 1, 1); PG8_STAGE(PG8_SA(1, 0), a3, voffA);
            PG8_BAR; PG8_WAIT_L(0); PG8_MMA(1, 0, At, B0); PG8_BAR; PG8_SCHED;
            PG8_STAGE(PG8_SB(1, 1), b3 + hstep, voffB);
            PG8_WAIT_V(6); PG8_BAR; PG8_MMA(1, 1, At, B1); PG8_BAR;
            }
        }
        if constexpr (ALIGN_EPI) { if (wr == 0) PG8_BAR; }
        if constexpr (!Epi::AFTER_DRAIN) { E(acc, cur, wr, wc, fr, fq); S.done(cur); }
        if (!has_next) break;
#pragma unroll
        for (int a = 0; a < 2; ++a)
#pragma unroll
            for (int b = 0; b < 2; ++b)
#pragma unroll
                for (int m = 0; m < 4; ++m)
#pragma unroll
                    for (int n = 0; n < 2; ++n) acc[a][b][m][n] = (f32x4){0.f, 0.f, 0.f, 0.f};
        cur = nxt; cA = nA; cB = nB; ++ui;
        if constexpr (ALIGN_EPI) { if (wr == 1) PG8_BAR; }
    }
    PG8_WAIT_V(0);
    if constexpr (!ALIGN_EPI) { if (wr == 0) PG8_BAR; }
    PG8_BAR;
#undef PG8_SA
#undef PG8_SB
#undef PG8_STAGE
#undef PG8_LDA
#undef PG8_LDB
#undef PG8_MMA
#undef PG8_WAIT_V
#undef PG8_WAIT_L
#undef PG8_BAR
#undef PG8_SCHED
}
}

__device__ __forceinline__ void transpose_item(const float* W, int K, int N, bf16_t* WT, int k0, int np0, int srcn0, const float* g, LAS float* scr, int lane) {
#pragma unroll 8
    for (int i = 0; i < 32; ++i) { const int kk = 2 * i + (lane >> 5); float v = W[(size_t)(k0 + kk) * N + srcn0 + (lane & 31)]; if (g) v *= g[k0 + kk]; scr[kk * 33 + (lane & 31)] = v; }
    asm volatile("s_waitcnt lgkmcnt(0)" ::: "memory");
    const int c = lane & 7;
#pragma unroll
    for (int j = 0; j < 4; ++j) { const int n = (lane >> 3) + 8 * j; const LAS float* s = scr + (8 * c) * 33 + n;
        u32x4 o; o.x = cvt_pk_bf16(s[0 * 33], s[1 * 33]); o.y = cvt_pk_bf16(s[2 * 33], s[3 * 33]); o.z = cvt_pk_bf16(s[4 * 33], s[5 * 33]); o.w = cvt_pk_bf16(s[6 * 33], s[7 * 33]);
        *(u32x4*)(WT + (size_t)(np0 + n) * K + k0 + 8 * c) = o; }
    asm volatile("s_waitcnt lgkmcnt(0)" ::: "memory");
}
__device__ __forceinline__ int src_in_ab(int np) {
    const int pn = np >> 8, cc = np & 255, bj = cc >> 7, off = cc & 127;
    if (pn < 4) return (bj ? 512 : 0) + 128 * pn + off;
    if (pn < 8) return (bj ? 2048 : 1536) + 128 * (pn - 4) + off;
    return 1024 + 256 * (pn - 8) + cc;
}
__device__ __forceinline__ int src_ffn(int np) { const int pn = np >> 8, cc = np & 255, bj = cc >> 7, off = cc & 127; return (bj ? DFF : 0) + 128 * pn + off; }

struct Args { const float* in[22]; float* out; unsigned char* ws; };

__device__ __forceinline__ void p0_prologue(const Args& a, LAS unsigned char* lds, int gw, int NGW, int lane, int wave) {
    LAS float* scr = (LAS float*)(lds + wave * 16384);
    unsigned char* ws = a.ws;
    constexpr int I_IN = (D / 64) * (NIN / 32), I_SQ = (D / 64) * (D / 32), I_QKV = (D / 64) * (3 * D / 32), I_F = (D / 64) * (2 * DFF / 32), I_DN = (DFF / 64) * (D / 32);
    constexpr int NITEMS = I_IN + 2 * I_SQ + I_QKV + 2 * I_F + 2 * I_DN;
    for (int it = gw; it < NITEMS; it += NGW) {
        int r = it;
        if (r < I_IN) { const int nb = NIN / 32, kb = r / nb, n0 = 32 * (r % nb); transpose_item(a.in[10], D, NIN, (bf16_t*)(ws + WS_WIN), 64 * kb, n0, src_in_ab(n0), a.in[7], scr, lane); continue; } r -= I_IN;
        if (r < I_SQ) { const int nb = D / 32, kb = r / nb, n0 = 32 * (r % nb); transpose_item(a.in[16], D, D, (bf16_t*)(ws + WS_WOUT), 64 * kb, n0, n0, nullptr, scr, lane); continue; } r -= I_SQ;
        if (r < I_QKV) { const int nb = 3 * D / 32, kb = r / nb, n0 = 32 * (r % nb); transpose_item(a.in[17], D, 3 * D, (bf16_t*)(ws + WS_WQKV), 64 * kb, n0, n0, a.in[7] + D, scr, lane); continue; } r -= I_QKV;
        if (r < I_SQ) { const int nb = D / 32, kb = r / nb, n0 = 32 * (r % nb); transpose_item(a.in[18], D, D, (bf16_t*)(ws + WS_WO), 64 * kb, n0, n0, nullptr, scr, lane); continue; } r -= I_SQ;
        if (r < 2 * I_F) { const int l = r / I_F; r -= l * I_F; const int nb = 2 * DFF / 32, kb = r / nb, n0 = 32 * (r % nb);
            transpose_item(a.in[19] + (size_t)l * D * 2 * DFF, D, 2 * DFF, (bf16_t*)(ws + (l ? WS_WF1 : WS_WF0)), 64 * kb, n0, src_ffn(n0), a.in[8] + l * D, scr, lane); continue; } r -= 2 * I_F;
        { const int l = r / I_DN; r -= l * I_DN; const int nb = D / 32, kb = r / nb, n0 = 32 * (r % nb);
            transpose_item(a.in[21] + (size_t)l * DFF * D, DFF, D, (bf16_t*)(ws + (l ? WS_WD1 : WS_WD0)), 64 * kb, n0, n0, nullptr, scr, lane); }
    }
    bf16_t* HB = (bf16_t*)(ws + WS_HB); float* ssq = (float*)(ws + WS_SSQ);
    for (int r = gw; r < MPAD; r += NGW) {
        f32x4 v[4]; float s = 0.f;
        if (r < MTOT) {
            const f32x4* xr = (const f32x4*)((r < MPR) ? a.in[0] + (size_t)r * D : a.in[1] + (size_t)(r - MPR) * D) + lane;
#pragma unroll
            for (int j = 0; j < 4; ++j) { v[j] = xr[64 * j]; s += (v[j].x * v[j].x + v[j].y * v[j].y) + (v[j].z * v[j].z + v[j].w * v[j].w); }
        } else {
#pragma unroll
            for (int j = 0; j < 4; ++j) v[j] = (f32x4){0.f, 0.f, 0.f, 0.f};
        }
        s = wave_sum(s);
        u32x2* o8 = (u32x2*)(HB + (size_t)r * D) + lane;
#pragma unroll
        for (int j = 0; j < 4; ++j) { u32x2 w; w.x = cvt_pk_bf16(v[j].x, v[j].y); w.y = cvt_pk_bf16(v[j].z, v[j].w); o8[64 * j] = w; }
        if (lane < 16) ssq[(size_t)r * 16 + lane] = (lane == 0) ? s : 0.f;
    }
    {
        const int tot = NSB * 26 * (CH / 4);
        for (int i = gw * 64 + lane; i < tot; i += NGW * 64) { const int sb = i / (26 * (CH / 4)), rem = i % (26 * (CH / 4));
            ((f32x4*)(a.out + O_SCA + (size_t)sb * 30 * CH))[rem] = ((const f32x4*)(a.in[2] + (size_t)sb * 30 * CH + 4 * CH))[rem]; }
    }
    {
        const size_t per = (size_t)(LBUF - NST) * D / 4;
        const size_t tot = per * NSB, stride = (size_t)NGW * 64;
        for (size_t i0 = (size_t)gw * 64 + lane; i0 < tot; i0 += 4 * stride) {
            f32x4 kv[4], vv[4];
#pragma unroll
            for (int u = 0; u < 4; ++u) { const size_t i = i0 + u * stride; if (i < tot) { const size_t sb = i / per, rem = i % per;
                kv[u] = __builtin_nontemporal_load((const f32x4*)(a.in[4] + (sb * LBUF + NST) * D) + rem); vv[u] = __builtin_nontemporal_load((const f32x4*)(a.in[5] + (sb * LBUF + NST) * D) + rem); } }
#pragma unroll
            for (int u = 0; u < 4; ++u) { const size_t i = i0 + u * stride; if (i < tot) { const size_t sb = i / per, rem = i % per;
                __builtin_nontemporal_store(kv[u], (f32x4*)(a.out + O_SK + sb * LBUF * D) + rem); __builtin_nontemporal_store(vv[u], (f32x4*)(a.out + O_SV + sb * LBUF * D) + rem); } }
        }
    }
}

__device__ __forceinline__ void p2_conv(const Args& a, LAS unsigned char* lds, int tid, int lane, int wave) {
    unsigned char* ws = a.ws;
    const bf16_t* GA = (const bf16_t*)(ws + WS_GA); bf16_t* AB = (bf16_t*)(ws + WS_AB);
    LAS float* T = (LAS float*)lds;
    const float* wa = a.in[11]; const float* ba = a.in[12]; const float* lg = a.in[13]; const float* lb = a.in[14]; const float* wb = a.in[15];
    for (int u = blockIdx.x; u < 512 + NSB; u += gridDim.x) {
        const bool samp = u >= 512; const int sb = u - 512;
        const int row0 = samp ? MPR + sb * NST : u * 32, nrows = samp ? NST : 32;
        const int t0 = samp ? 0 : (row0 & (SEQ - 1));
        const int nvec = (nrows + 30) * (CH / 8);
        for (int i = tid; i < nvec; i += NTHREADS) {
            const int e = i >> 6, c = (i & 63) * 8; const int p = t0 - 30 + e;
            f32x4 v0 = (f32x4){0.f, 0.f, 0.f, 0.f}, v1 = v0;
            if (p >= 0) { const u32x4 w = *(const u32x4*)(GA + (size_t)(row0 - t0 + p) * GAW + c);
                v0 = (f32x4){bflo(w.x), bfhi(w.x), bflo(w.y), bfhi(w.y)}; v1 = (f32x4){bflo(w.z), bfhi(w.z), bflo(w.w), bfhi(w.w)}; }
            else if (samp) { const float* sp = a.in[2] + ((size_t)sb * 30 + e) * CH + c; v0 = *(const f32x4*)sp; v1 = *(const f32x4*)(sp + 4); }
            *(LAS f32x4*)(T + e * CH + c) = v0; *(LAS f32x4*)(T + e * CH + c + 4) = v1;
        }
        __syncthreads();
        if (tid < 256) {
            const int c = 2 * tid; f32x2 w[KA];
#pragma unroll
            for (int k = 0; k < KA; ++k) w[k] = *(const f32x2*)(wa + k * CH + c);
            const f32x2 bias = *(const f32x2*)(ba + c);
            for (int i = 0; i < nrows; ++i) {
                f32x2 s = bias;
#pragma unroll
                for (int k = 0; k < KA; ++k) { const f32x2 x = *(const LAS f32x2*)(T + (i + k) * CH + c); s += w[k] * x; }
                *(LAS f32x2*)(T + i * CH + c) = s;
            }
        } else {
            const int t2 = tid - 256;
            for (int i = t2; i < nrows * 64; i += 256) {
                const int rr = i >> 6, c = (i & 63) * 8; const int r = row0 + rr, p = t0 + rr;
                float x[3][8];
#pragma unroll
                for (int k = 0; k < 3; ++k) { const int pp = p - 2 + k;
                    if (pp >= 0) { const u32x4 wv = *(const u32x4*)(GA + (size_t)(r - 2 + k) * GAW + 512 + c);
                        x[k][0] = bflo(wv.x); x[k][1] = bfhi(wv.x); x[k][2] = bflo(wv.y); x[k][3] = bfhi(wv.y); x[k][4] = bflo(wv.z); x[k][5] = bfhi(wv.z); x[k][6] = bflo(wv.w); x[k][7] = bfhi(wv.w); }
                    else if (samp) { const float* sp = a.in[3] + ((size_t)sb * 2 + (pp + 2)) * CH + c;
#pragma unroll
                        for (int e = 0; e < 8; ++e) x[k][e] = sp[e]; }
                    else {
#pragma unroll
                        for (int e = 0; e < 8; ++e) x[k][e] = 0.f; } }
                const u32x4 gv = *(const u32x4*)(GA + (size_t)r * GAW + 1024 + c);
                float gb[8] = {bflo(gv.x), bfhi(gv.x), bflo(gv.y), bfhi(gv.y), bflo(gv.z), bfhi(gv.z), bflo(gv.w), bfhi(gv.w)};
                float o[8];
#pragma unroll
                for (int e = 0; e < 8; ++e) o[e] = gb[e] * (wb[0 * CH + c + e] * x[0][e] + wb[1 * CH + c + e] * x[1][e] + wb[2 * CH + c + e] * x[2][e]);
                u32x4 w4; w4.x = cvt_pk_bf16(o[0], o[1]); w4.y = cvt_pk_bf16(o[2], o[3]); w4.z = cvt_pk_bf16(o[4], o[5]); w4.w = cvt_pk_bf16(o[6], o[7]);
                *(u32x4*)(AB + (size_t)r * D + 512 + c) = w4;
            }
        }
        __syncthreads();
        for (int rr = wave; rr < nrows; rr += NWAVES) {
            const int c = lane * 8;
            const f32x4 v0 = *(const LAS f32x4*)(T + rr * CH + c), v1 = *(const LAS f32x4*)(T + rr * CH + c + 4);
            float s = (v0.x + v0.y) + (v0.z + v0.w) + (v1.x + v1.y) + (v1.z + v1.w);
            const float mu = wave_sum(s) * (1.0f / CH);
            const f32x4 d0 = v0 - mu, d1 = v1 - mu;
            float q = (d0.x * d0.x + d0.y * d0.y) + (d0.z * d0.z + d0.w * d0.w) + (d1.x * d1.x + d1.y * d1.y) + (d1.z * d1.z + d1.w * d1.w);
            const float rstd = rsqrtf(wave_sum(q) * (1.0f / CH) + LN_EPS);
            const f32x4 g0 = *(const f32x4*)(lg + c), g1 = *(const f32x4*)(lg + c + 4), b0 = *(const f32x4*)(lb + c), b1 = *(const f32x4*)(lb + c + 4);
            f32x4 a0 = d0 * rstd * g0 + b0, a1 = d1 * rstd * g1 + b1;
#pragma unroll
            for (int e = 0; e < 4; ++e) { a0[e] = a0[e] * sigmoidf_(a0[e]); a1[e] = a1[e] * sigmoidf_(a1[e]); }
            u32x4 w4; w4.x = cvt_pk_bf16(a0[0], a0[1]); w4.y = cvt_pk_bf16(a0[2], a0[3]); w4.z = cvt_pk_bf16(a1[0], a1[1]); w4.w = cvt_pk_bf16(a1[2], a1[3]);
            *(u32x4*)(AB + (size_t)(row0 + rr) * D + c) = w4;
        }
        __syncthreads();
    }
}

__device__ __forceinline__ void p5_combine(const Args& a, int layer, int gtid, int GT) {
    unsigned char* ws = a.ws;
    const bf16_t* ZG = (const bf16_t*)(ws + WS_ZG); const bf16_t* ZU = (const bf16_t*)(ws + WS_ZU); bf16_t* U = (bf16_t*)(ws + WS_U);
    const float* wc = a.in[20] + (size_t)layer * 3 * DFF;
    constexpr int NCV = DFF / 8, NCH = MPR / 16;
    const int nit = NCH * NCV + NSB * NCV;
    for (int it = gtid; it < nit; it += GT) {
        const bool samp = it >= NCH * NCV;
        int r0, nrows, cv, sb = 0;
        if (!samp) { const int ch = it / NCV; cv = it % NCV; r0 = ch * 16; nrows = 16; } else { const int j = it - NCH * NCV; sb = j / NCV; cv = j % NCV; r0 = MPR + sb * NST; nrows = NST; }
        const int c = cv * 8;
        float w0[8], w1[8], w2[8], gm2[8], gm1[8];
#pragma unroll
        for (int e = 0; e < 8; ++e) { w0[e] = wc[c + e]; w1[e] = wc[DFF + c + e]; w2[e] = wc[2 * DFF + c + e]; }
        if (samp) { const float* sp = a.in[6] + ((size_t)(layer * NSB + sb) * 2) * DFF + c;
#pragma unroll
            for (int e = 0; e < 8; ++e) { gm2[e] = sp[e]; gm1[e] = sp[DFF + e]; } }
        else if ((r0 & (SEQ - 1)) == 0) {
#pragma unroll
            for (int e = 0; e < 8; ++e) { gm2[e] = 0.f; gm1[e] = 0.f; } }
        else { const u32x4 p2 = *(const u32x4*)(ZG + (size_t)(r0 - 2) * DFF + c), p1 = *(const u32x4*)(ZG + (size_t)(r0 - 1) * DFF + c);
            gm2[0] = bflo(p2.x); gm2[1] = bfhi(p2.x); gm2[2] = bflo(p2.y); gm2[3] = bfhi(p2.y); gm2[4] = bflo(p2.z); gm2[5] = bfhi(p2.z); gm2[6] = bflo(p2.w); gm2[7] = bfhi(p2.w);
            gm1[0] = bflo(p1.x); gm1[1] = bfhi(p1.x); gm1[2] = bflo(p1.y); gm1[3] = bfhi(p1.y); gm1[4] = bflo(p1.z); gm1[5] = bfhi(p1.z); gm1[6] = bflo(p1.w); gm1[7] = bfhi(p1.w); }
        for (int i = 0; i < nrows; ++i) {
            const size_t off = (size_t)(r0 + i) * DFF + c;
            const u32x4 gv = *(const u32x4*)(ZG + off), uv = *(const u32x4*)(ZU + off);
            float g[8] = {bflo(gv.x), bfhi(gv.x), bflo(gv.y), bfhi(gv.y), bflo(gv.z), bfhi(gv.z), bflo(gv.w), bfhi(gv.w)};
            float up[8] = {bflo(uv.x), bfhi(uv.x), bflo(uv.y), bfhi(uv.y), bflo(uv.z), bfhi(uv.z), bflo(uv.w), bfhi(uv.w)};
            float o[8];
#pragma unroll
            for (int e = 0; e < 8; ++e) { const float y = w0[e] * gm2[e] + w1[e] * gm1[e] + w2[e] * g[e]; o[e] = y * sigmoidf_(y) * up[e]; gm2[e] = gm1[e]; gm1[e] = g[e]; }
            u32x4 w4; w4.x = cvt_pk_bf16(o[0], o[1]); w4.y = cvt_pk_bf16(o[2], o[3]); w4.z = cvt_pk_bf16(o[4], o[5]); w4.w = cvt_pk_bf16(o[6], o[7]);
            *(u32x4*)(U + off) = w4;
        }
    }
}

constexpr int AT_OACC = 0, AT_OSTR = 65, AT_ML = 256 * AT_OSTR * 4, AT_VST = AT_ML + 2048, AT_PSC = AT_VST + NWAVES * 4096;
static_assert(AT_PSC + NWAVES * 2048 <= 131072, "attention LDS");
__device__ __forceinline__ int crow(int r, int hi) { return (r & 3) + 8 * (r >> 2) + 4 * hi; }

__device__ __forceinline__ void attn_task(const bf16_t* Qh, const bf16_t* Kh, const bf16_t* Vh, int dil, int cls, int s0, int nq, float slope2, int qlbase, int qlstep, bool first,
                                          LAS unsigned char* lds, int wave, int lane) {
    const int r32 = lane & 31, hi = lane >> 5;
    const int qi = r32 < nq ? r32 : nq - 1;
    const bf16_t* qp = Qh + (size_t)(cls + dil * (s0 + qi)) * D + hi * 8;
    bf16x8 qr[4];
#pragma unroll
    for (int d0 = 0; d0 < 4; ++d0) qr[d0] = *(const bf16x8*)(qp + d0 * 16);
    float m_run = -INFINITY, l_run = 0.f; f32x16 o[2]; o[0] = f32x16{}; o[1] = f32x16{};
    LAS unsigned char* vst = lds + AT_VST + wave * 4096;
    const int sq = s0 + r32;
    const float sdil = slope2 * (float)dil;
    for (int i = 0; i < 5; ++i) {
        const int kb = s0 - 128 + 32 * i;
        if (kb + 31 < 0) continue;
        const int skv = kb + r32 < 0 ? 0 : kb + r32;
        const bf16_t* kp = Kh + (size_t)(cls + dil * skv) * D + hi * 8;
        bf16x8 kf[4];
#pragma unroll
        for (int d0 = 0; d0 < 4; ++d0) kf[d0] = *(const bf16x8*)(kp + d0 * 16);
        u32x4 vv[4];
#pragma unroll
        for (int j = 0; j < 4; ++j) { const int kv = (lane >> 3) + 8 * j; const int sv = kb + kv < 0 ? 0 : kb + kv;
            vv[j] = *(const u32x4*)(Vh + (size_t)(cls + dil * sv) * D + (lane & 7) * 8); }
        f32x16 st = f32x16{};
#pragma unroll
        for (int d0 = 0; d0 < 4; ++d0) st = __builtin_amdgcn_mfma_f32_32x32x16_bf16(kf[d0], qr[d0], st, 0, 0, 0);
        asm volatile("" ::: "memory");
#pragma unroll
        for (int j = 0; j < 4; ++j) { const int kv = (lane >> 3) + 8 * j, part = lane & 7;
            *(LAS u32x4*)(vst + (part >> 2) * 2048 + (kv >> 3) * 512 + (kv & 7) * 64 + (part & 3) * 16) = vv[j]; }
        float mx = -INFINITY;
#pragma unroll
        for (int r = 0; r < 16; ++r) { const int sk = kb + crow(r, hi); const int ds = sq - sk; const bool ok = (sk >= 0) && (ds >= 0) && (ds <= 128);
            const float x = ok ? st[r] - sdil * (float)ds : -INFINITY; st[r] = x; mx = fmaxf(mx, x); }
        mx = fmaxf(mx, __shfl_xor(mx, 32));
        const float m_new = fmaxf(m_run, mx);
        const float m_use = (m_new == -INFINITY) ? 0.f : m_new;
        const float alpha = __builtin_amdgcn_exp2f(m_run - m_use);
        float ps = 0.f;
#pragma unroll
        for (int r = 0; r < 16; ++r) { const float p = __builtin_amdgcn_exp2f(st[r] - m_use); st[r] = p; ps += p; }
        l_run = l_run * alpha + ps; m_run = m_new;
#pragma unroll
        for (int r = 0; r < 16; ++r) { o[0][r] *= alpha; o[1][r] *= alpha; }
        bf16x8 pa[2];
#pragma unroll
        for (int s = 0; s < 2; ++s) { u32x4 w; w.x = cvt_pk_bf16(st[8 * s + 0], st[8 * s + 1]); w.y = cvt_pk_bf16(st[8 * s + 2], st[8 * s + 3]); w.z = cvt_pk_bf16(st[8 * s + 4], st[8 * s + 5]); w.w = cvt_pk_bf16(st[8 * s + 6], st[8 * s + 7]);
            pa[s] = __builtin_bit_cast(bf16x8, w); }
        asm volatile("s_waitcnt lgkmcnt(0)" ::: "memory");
        const int vb = ((lane >> 4) & 1) * 32 + (lane & 3) * 8 + (4 * hi + ((lane & 15) >> 2)) * 64;
#pragma unroll
        for (int d0 = 0; d0 < 2; ++d0)
#pragma unroll
            for (int s = 0; s < 2; ++s) {
                const s16x4 lo = __builtin_bit_cast(s16x4, __builtin_amdgcn_ds_read_tr16_b64_v4i16((LAS s16x4*)(vst + vb + d0 * 2048 + s * 1024)));
                const s16x4 hh = __builtin_bit_cast(s16x4, __builtin_amdgcn_ds_read_tr16_b64_v4i16((LAS s16x4*)(vst + vb + d0 * 2048 + s * 1024 + 512)));
                const bf16x8 vf = (bf16x8){lo[0], lo[1], lo[2], lo[3], hh[0], hh[1], hh[2], hh[3]};
                o[d0] = __builtin_amdgcn_mfma_f32_32x32x16_bf16(vf, pa[s], o[d0], 0, 0, 0);
            }
        asm volatile("s_waitcnt lgkmcnt(0)" ::: "memory");
    }
    l_run += __shfl_xor(l_run, 32);
    if (r32 < nq) {
        const int ql = qlbase + qlstep * r32;
        LAS float* oa = (LAS float*)(lds + AT_OACC) + ql * AT_OSTR;
        LAS float* ml = (LAS float*)(lds + AT_ML) + ql * 2;
        float a_old = 0.f, a_new = 1.f, m_new = m_run, l_new = l_run;
        if (!first) { const float m_old = ml[0], l_old = ml[1]; m_new = fmaxf(m_old, m_run); const float mu = (m_new == -INFINITY) ? 0.f : m_new;
            a_old = __builtin_amdgcn_exp2f(m_old - mu); a_new = __builtin_amdgcn_exp2f(m_run - mu); l_new = l_old * a_old + l_run * a_new; }
#pragma unroll
        for (int d0 = 0; d0 < 2; ++d0)
#pragma unroll
            for (int r = 0; r < 16; ++r) { const int d = 32 * d0 + crow(r, hi); float v = o[d0][r] * a_new; if (!first) v += oa[d] * a_old; oa[d] = v; }
        asm volatile("s_waitcnt lgkmcnt(0)" ::: "memory");
        if (hi == 0) { ml[0] = m_new; ml[1] = l_new; }
    }
}

__device__ __forceinline__ void p8_attention(const Args& a, LAS unsigned char* lds, int tid, int lane, int wave) {
    unsigned char* ws = a.ws;
    const bf16_t* Q = (const bf16_t*)(ws + WS_Q); const bf16_t* K = (const bf16_t*)(ws + WS_K); const bf16_t* V = (const bf16_t*)(ws + WS_V); bf16_t* O = (bf16_t*)(ws + WS_AB);
#ifndef NO_SAMPLE
    {
        const float* QS = (const float*)(ws + WS_QS);
        LAS float* psc = (LAS float*)(lds + AT_PSC + wave * 2048);
        for (int task = blockIdx.x * NWAVES + wave; task < NSB * NH * NST; task += gridDim.x * NWAVES) {
            const int sb = task / (NH * NST), h = (task / NST) % NH, j = task % NST;
            const float slope2 = exp2f(-0.5f * (float)(h + 1)) * LOG2E;
            const float* kc = a.in[4] + (size_t)sb * LBUF * D + h * HD; const float* vc = a.in[5] + (size_t)sb * LBUF * D + h * HD;
            const float* kn = a.out + O_SK + ((size_t)sb * LBUF + (LBUF - NST)) * D + h * HD; const float* vn = a.out + O_SV + ((size_t)sb * LBUF + (LBUF - NST)) * D + h * HD;
            const float* qrow = QS + (size_t)(sb * NST + j) * D + h * HD;
            f32x4 qv[16];
#pragma unroll
            for (int e = 0; e < 16; ++e) qv[e] = *(const f32x4*)(qrow + 4 * e);
            float mx = -INFINITY;
#pragma clang loop unroll(disable)
            for (int rd = 0; rd < 7; ++rd) {
                const int kk = rd * 64 + lane; float s = -INFINITY;
                if (kk < 387) { const int g = kk / 129, mm = kk % 129, dil = (g == 0) ? 1 : (g == 1 ? 4 : 16); const int idx = LBUF + j - mm * dil;
                    const float* kr = (idx >= LBUF) ? kn + (size_t)(idx - LBUF) * D : kc + (size_t)idx * D;
                    float acc = 0.f;
#pragma unroll
                    for (int e = 0; e < 16; ++e) { const f32x4 kx = *(const f32x4*)(kr + 4 * e); acc += (qv[e].x * kx.x + qv[e].y * kx.y) + (qv[e].z * kx.z + qv[e].w * kx.w); }
                    s = acc - slope2 * (float)(mm * dil); }
                psc[kk] = s; mx = fmaxf(mx, s);
            }
            mx = wave_max(mx);
            asm volatile("s_waitcnt lgkmcnt(0)" ::: "memory");
            float l = 0.f;
#pragma clang loop unroll(disable)
            for (int rd = 0; rd < 7; ++rd) { const float p = __builtin_amdgcn_exp2f(psc[rd * 64 + lane] - mx); l += p; psc[rd * 64 + lane] = p; }
            l = wave_sum(l);
            asm volatile("s_waitcnt lgkmcnt(0)" ::: "memory");
            const int kg = lane >> 4, dc = lane & 15;
            f32x4 acc4 = (f32x4){0.f, 0.f, 0.f, 0.f};
#pragma clang loop unroll(disable)
            for (int k0 = 0; k0 < 387; k0 += 64) {
                f32x4 vr4[16]; float pk[16];
#pragma unroll
                for (int u = 0; u < 16; ++u) { const int kk = k0 + 4 * u + kg; const int kc_ = kk < 387 ? kk : 386;
                    const int g = kc_ / 129, mm = kc_ % 129, dil = (g == 0) ? 1 : (g == 1 ? 4 : 16); const int idx = LBUF + j - mm * dil;
                    const float* vr = (idx >= LBUF) ? vn + (size_t)(idx - LBUF) * D : vc + (size_t)idx * D;
                    vr4[u] = *(const f32x4*)(vr + 4 * dc); pk[u] = kk < 387 ? psc[kc_] : 0.f; }
#pragma unroll
                for (int u = 0; u < 16; ++u) acc4 += vr4[u] * pk[u];
            }
#pragma unroll
            for (int e = 0; e < 4; ++e) { acc4[e] += __shfl_xor(acc4[e], 16); acc4[e] += __shfl_xor(acc4[e], 32); }
            const float il = __builtin_amdgcn_rcpf(l);
            if (lane < 16) { u32x2 w; w.x = cvt_pk_bf16(acc4[0] * il, acc4[1] * il); w.y = cvt_pk_bf16(acc4[2] * il, acc4[3] * il);
                *(u32x2*)(O + (size_t)(MPR + sb * NST + j) * D + h * HD + 4 * dc) = w; }
            asm volatile("s_waitcnt lgkmcnt(0)" ::: "memory");
        }
    }
#endif
    __syncthreads();
#ifndef NO_PROMPT
    for (int u = blockIdx.x; u < NB * NH * 8; u += gridDim.x) {
        const int qblk = u & 7, h = (u >> 3) & 15, b = u >> 7;
        const float slope2 = exp2f(-0.5f * (float)(h + 1)) * LOG2E;
        const bf16_t* Qh = Q + (size_t)b * SEQ * D + h * HD; const bf16_t* Kh = K + (size_t)b * SEQ * D + h * HD; const bf16_t* Vh = V + (size_t)b * SEQ * D + h * HD;
#pragma clang loop unroll(disable)
        for (int tk = 0; tk < 4; ++tk) {
            int dil, cls, s0, nq, qlb, qls;
            if (tk == 0) { dil = 1; cls = 0; s0 = 256 * qblk + 32 * wave; nq = 32; qlb = 32 * wave; qls = 1; }
            else if (tk == 1) { dil = 4; cls = wave & 3; s0 = 64 * qblk + 32 * (wave >> 2); nq = 32; qlb = (wave & 3) + 128 * (wave >> 2); qls = 4; }
            else { dil = 16; cls = 2 * wave + (tk - 2); s0 = 16 * qblk; nq = 16; qlb = cls; qls = 16; }
            attn_task(Qh, Kh, Vh, dil, cls, s0, nq, slope2, qlb, qls, tk == 0, lds, wave, lane);
            if (tk != 2) __syncthreads();
        }
        {
            const int ql = tid >> 1, dh = (tid & 1) * 32;
            const LAS float* oa = (const LAS float*)(lds + AT_OACC) + ql * AT_OSTR + dh;
            const float inv = __builtin_amdgcn_rcpf(((const LAS float*)(lds + AT_ML))[ql * 2 + 1]);
            bf16_t* op = O + (size_t)(b * SEQ + 256 * qblk + ql) * D + h * HD + dh;
#pragma unroll
            for (int e = 0; e < 4; ++e) { u32x4 w; w.x = cvt_pk_bf16(oa[8 * e + 0] * inv, oa[8 * e + 1] * inv); w.y = cvt_pk_bf16(oa[8 * e + 2] * inv, oa[8 * e + 3] * inv);
                w.z = cvt_pk_bf16(oa[8 * e + 4] * inv, oa[8 * e + 5] * inv); w.w = cvt_pk_bf16(oa[8 * e + 6] * inv, oa[8 * e + 7] * inv); *(u32x4*)(op + 8 * e) = w; }
        }
        __syncthreads();
    }
#endif
}

__device__ __forceinline__ void p13_final(const Args& a, int gw, int NGW, int lane) {
    const float* H = (const float*)(a.ws + WS_H); const float* g = a.in[9];
    for (int r = gw; r < MTOT; r += NGW) {
        const f32x4* xr = (const f32x4*)(H + (size_t)r * D) + lane; f32x4 v[4]; float s = 0.f;
#pragma unroll
        for (int j = 0; j < 4; ++j) { v[j] = xr[64 * j]; s += (v[j].x * v[j].x + v[j].y * v[j].y) + (v[j].z * v[j].z + v[j].w * v[j].w); }
        const float rstd = rsqrtf(wave_sum(s) * (1.0f / D) + RMS_EPS);
        f32x4* o = (f32x4*)(a.out + (size_t)r * D) + lane;
#pragma unroll
        for (int j = 0; j < 4; ++j) o[64 * j] = v[j] * rstd * ((const f32x4*)g)[64 * j + lane];
    }
}

#define XB_TMO      128
#define XB_XCNT(j)  (256  + 64 * (j))
#define XB_XSUB(j)  (1280 + 64 * (j))
#define XB_XGEN(j)  (2304 + 64 * (j))
#define XB_TOP      3328
#define XB_TOPGEN   3392
#define XCD_BAR_WORDS 3456
#define XB_SPIN_CAP (1u << 18)
__device__ __forceinline__ unsigned xb_ld(unsigned* p)              { return __hip_atomic_load(p, __ATOMIC_RELAXED, __HIP_MEMORY_SCOPE_AGENT); }
__device__ __forceinline__ unsigned xb_add(unsigned* p, unsigned v) { return __hip_atomic_fetch_add(p, v, __ATOMIC_RELAXED, __HIP_MEMORY_SCOPE_AGENT); }
__device__ __forceinline__ unsigned xb_xcc_id() { return (unsigned)__builtin_amdgcn_s_getreg((3 << 11) | 20) & 0xFu; }
#define XB_SPIN(cond, bar) do { unsigned _sp = 0; while (cond) { __builtin_amdgcn_s_sleep(1); \
    if ((++_sp & 255u) == 0u) { if (xb_ld(&(bar)[XB_TMO])) break; if (_sp > XB_SPIN_CAP) { atomicAdd(&(bar)[XB_TMO], 1u); break; } } } } while (0)
__device__ __forceinline__ void xcd_barrier_complete(unsigned* bar, unsigned x, unsigned& nloc, unsigned& nx) {
    const unsigned G = gridDim.x * gridDim.y * gridDim.z;
    unsigned sum, cnt, mine, sp = 0u;
    for (;;) {
        sum = 0u; cnt = 0u; mine = 0u;
#pragma unroll
        for (unsigned j = 0; j < 16; ++j) { const unsigned c = xb_ld(&bar[XB_XCNT(j)]); sum += c; cnt += (c > 0u) ? 1u : 0u; mine = (j == x) ? c : mine; }
        if (sum == G) break;
        __builtin_amdgcn_s_sleep(1);
        if ((++sp & 255u) == 0u) { if (xb_ld(&bar[XB_TMO])) break; if (sp > XB_SPIN_CAP) { atomicAdd(&bar[XB_TMO], 1u); break; } }
    }
    nloc = mine > 0u ? mine : 1u; nx = cnt > 0u ? cnt : 1u;
}
__device__ __forceinline__ void xcd_barrier(unsigned* bar, volatile LAS unsigned* st) {
    asm volatile("s_waitcnt vmcnt(0)" ::: "memory");
    __syncthreads();
    if (threadIdx.x == 0) {
        const unsigned x = xb_xcc_id();
        __builtin_amdgcn_s_waitcnt(0);
        unsigned nloc = st[0], nx = st[1];
        if (nloc == 0u) { xcd_barrier_complete(bar, x, nloc, nx); st[0] = nloc; st[1] = nx; }
        const unsigned old = xb_add(&bar[XB_XSUB(x)], 1u);
        const unsigned gen = old / nloc;
        if (old + 1u == (gen + 1u) * nloc) {
            __builtin_amdgcn_fence(__ATOMIC_RELEASE, "agent");
            asm volatile("s_waitcnt vmcnt(0)" ::: "memory");
            const unsigned og = xb_add(&bar[XB_TOP], 1u);
            const unsigned tg = og / nx;
            if (og + 1u == (tg + 1u) * nx) xb_add(&bar[XB_TOPGEN], 1u);
            else XB_SPIN(xb_ld(&bar[XB_TOPGEN]) == tg, bar);
            __builtin_amdgcn_fence(__ATOMIC_ACQUIRE, "agent");
            xb_add(&bar[XB_XGEN(x)], 1u);
            asm volatile("s_waitcnt vmcnt(0)" ::: "memory");
        } else {
            XB_SPIN(xb_ld(&bar[XB_XGEN(x)]) == gen, bar);
            __builtin_amdgcn_fence(__ATOMIC_ACQUIRE, "agent");
            asm volatile("s_waitcnt vmcnt(0)" ::: "memory");
        }
    }
    __syncthreads();
}

typedef const __attribute__((address_space(4))) Args* kargp_t;
__device__ __forceinline__ Args kargs() {
    Args a;
#if defined(__HIP_DEVICE_COMPILE__)
    kargp_t p = (kargp_t)__builtin_amdgcn_kernarg_segment_ptr(); asm volatile("" : "+s"(p));
#pragma unroll
    for (int i = 0; i < 22; ++i) a.in[i] = p->in[i];
    a.out = p->out; a.ws = p->ws;
#else
    for (int i = 0; i < 22; ++i) a.in[i] = nullptr;
    a.out = nullptr; a.ws = nullptr;
#endif
    return a;
}
#define PHASE_BEGIN const Args a = kargs(); unsigned char* ws = a.ws; const int tid = launder_v(threadIdx.x), lane = tid & 63, wave = __builtin_amdgcn_readfirstlane(tid >> 6); \
    const int G = gridDim.x, gw = blockIdx.x * NWAVES + wave, NGW = G * NWAVES; (void)ws; (void)lane; (void)gw; (void)NGW; (void)G;
__global__ void __launch_bounds__(NTHREADS, 2) mega_fwd(Args a_unused) {
    extern __shared__ __attribute__((aligned(16))) unsigned char lds_raw[];
    LAS unsigned char* lds = (LAS unsigned char*)lds_raw;
    cg::grid_group grid = cg::this_grid();
    volatile LAS unsigned* bst = (volatile LAS unsigned*)(lds + 131072 + 64);
    { unsigned* ctl0 = (unsigned*)kargs().ws; if (threadIdx.x == 0) { bst[0] = 0u; bst[1] = 0u; (void)xb_add(&ctl0[XB_XCNT(xb_xcc_id())], 1u); } }
    __syncthreads();
#define GRID_BAR() do { unsigned* ctl_ = (unsigned*)kargs().ws; xcd_barrier(ctl_, bst); } while (0)
#ifndef PHASES
#define PHASES 0xFFFF
#endif
#define PH(k) if constexpr (((PHASES) >> (k)) & 1)
#define REP_P0 1
#define REP_P1 1
#define REP_P2 1
#define REP_P3 1
#define REP_P4 1
#define REP_P5 1
#define REP_P7 1
#define REP_P8 1
#define REP_P13 1
#define REPEAT(n) for (int rep_ = 0; rep_ < (n); ++rep_)

    REPEAT(REP_P0) { PH(0) { PHASE_BEGIN p0_prologue(a, lds, gw, NGW, lane, wave); } if (rep_ + 1 < REP_P0) { GRID_BAR(); } }
    grid.sync();
    REPEAT(REP_P1) { if (rep_) { GRID_BAR(); } PH(1) {
        PHASE_BEGIN
        pg8::Gemm g{(const bf16_t*)(ws + WS_HB), (const bf16_t*)(ws + WS_WIN), MPAD, NIN, D}; pg8::StaticOrder S; S.init(MPAD, NIN, G, (int)blockIdx.x);
        pg8::EpiInAB E{(bf16_t*)(ws + WS_GA), (const float*)(ws + WS_SSQ), a.out};
        pg8::gemm_phase<pg8::EpiInAB, pg8::StaticOrder, true, true>(lds, g, S, E);
    } }
    GRID_BAR();
    REPEAT(REP_P2) { if (rep_) { GRID_BAR(); } PH(2) { PHASE_BEGIN p2_conv(a, lds, tid, lane, wave); } }
    GRID_BAR();
    REPEAT(REP_P3) { if (rep_) { GRID_BAR(); } PH(3) {
        PHASE_BEGIN
        pg8::Gemm g{(const bf16_t*)(ws + WS_AB), (const bf16_t*)(ws + WS_WOUT), MPAD, D, D}; pg8::StaticOrder S; S.init(MPAD, D, G, (int)blockIdx.x);
        pg8::EpiResid E{a.in[0], a.in[1], (float*)(ws + WS_H), (bf16_t*)(ws + WS_HB), (float*)(ws + WS_SSQ)};
        pg8::gemm_phase<pg8::EpiResid, pg8::StaticOrder, true, true>(lds, g, S, E);
    } }
    GRID_BAR();
#pragma clang loop unroll(disable)
    for (int layer = 0; layer < 2; ++layer) {
        if (layer == 1) {
            REPEAT(REP_P7) { if (rep_) { GRID_BAR(); } PH(7) {
                PHASE_BEGIN
                pg8::Gemm g{(const bf16_t*)(ws + WS_HB), (const bf16_t*)(ws + WS_WQKV), MPAD, 3 * D, D}; pg8::StaticOrder S; S.init(MPAD, 3 * D, G, (int)blockIdx.x);
                pg8::EpiQkv E{(bf16_t*)(ws + WS_Q), (float*)(ws + WS_QS), (const float*)(ws + WS_SSQ), a.out};
                pg8::gemm_phase<pg8::EpiQkv, pg8::StaticOrder, true, true>(lds, g, S, E);
            } }
            GRID_BAR();
            REPEAT(REP_P8) { if (rep_) { GRID_BAR(); } PH(8) { PHASE_BEGIN p8_attention(a, lds, tid, lane, wave); } }
            GRID_BAR();
            PH(9) {
                PHASE_BEGIN
                float* H = (float*)(ws + WS_H);
                pg8::Gemm g{(const bf16_t*)(ws + WS_AB), (const bf16_t*)(ws + WS_WO), MPAD, D, D}; pg8::StaticOrder S; S.init(MPAD, D, G, (int)blockIdx.x);
                pg8::EpiResid E{H, H + (size_t)MPR * D, H, (bf16_t*)(ws + WS_HB), (float*)(ws + WS_SSQ)};
                pg8::gemm_phase<pg8::EpiResid, pg8::StaticOrder, true, true>(lds, g, S, E);
            }
            GRID_BAR();
        }
        REPEAT(REP_P4) { if (rep_) { GRID_BAR(); } PH(4) {
            PHASE_BEGIN
            pg8::Gemm g{(const bf16_t*)(ws + WS_HB), (const bf16_t*)(ws + (layer ? WS_WF1 : WS_WF0)), MPAD, 2 * DFF, D}; pg8::StaticOrder S; S.init(MPAD, 2 * DFF, G, (int)blockIdx.x);
            pg8::EpiFfn E{(bf16_t*)(ws + WS_ZG), (bf16_t*)(ws + WS_ZU), (const float*)(ws + WS_SSQ), a.out, layer};
            pg8::gemm_phase<pg8::EpiFfn, pg8::StaticOrder, true, true>(lds, g, S, E);
        } }
        GRID_BAR();
        REPEAT(REP_P5) { if (rep_) { GRID_BAR(); } PH(5) { PHASE_BEGIN p5_combine(a, layer, blockIdx.x * NTHREADS + tid, G * NTHREADS); } }
        GRID_BAR();
        PH(6) {
            PHASE_BEGIN
            float* H = (float*)(ws + WS_H);
            pg8::Gemm g{(const bf16_t*)(ws + WS_U), (const bf16_t*)(ws + (layer ? WS_WD1 : WS_WD0)), MPAD, D, DFF}; pg8::StaticOrder S; S.init(MPAD, D, G, (int)blockIdx.x);
            pg8::EpiResid E{H, H + (size_t)MPR * D, H, (bf16_t*)(ws + WS_HB), (float*)(ws + WS_SSQ)};
            pg8::gemm_phase<pg8::EpiResid, pg8::StaticOrder, true, true>(lds, g, S, E);
        }
        GRID_BAR();
    }
    REPEAT(REP_P13) { if (rep_) { GRID_BAR(); } PH(13) { PHASE_BEGIN p13_final(a, gw, NGW, lane); } }
}

extern "C" void kernel_launch(void* const* d_in, const int* in_sizes, int n_in, void* d_out, int out_size, void* d_ws, size_t ws_size, hipStream_t stream) {
    static int grid = 0;
    if (grid == 0) {
        if (n_in != 22 || (size_t)out_size != O_END || ws_size < WS_END) { fprintf(stderr, "kernel_launch: unexpected shapes (n_in %d, out %d, ws %zu, need %zu)\n", n_in, out_size, ws_size, (size_t)WS_END); grid = -1; return; }
        int dev = 0, cus = 0, per_cu = 0;
        if (hipGetDevice(&dev) != hipSuccess || hipDeviceGetAttribute(&cus, hipDeviceAttributeMultiprocessorCount, dev) != hipSuccess) { grid = -1; return; }
        if (hipFuncSetAttribute((const void*)mega_fwd, hipFuncAttributeMaxDynamicSharedMemorySize, LDS_BYTES) != hipSuccess) { fprintf(stderr, "kernel_launch: hipFuncSetAttribute failed\n"); grid = -1; return; }
        if (hipOccupancyMaxActiveBlocksPerMultiprocessor(&per_cu, (const void*)mega_fwd, NTHREADS, LDS_BYTES) != hipSuccess || per_cu < 1) { fprintf(stderr, "kernel_launch: occupancy query failed (%d)\n", per_cu); (void)hipGetLastError(); grid = -1; return; }
        grid = cus * 1;
    }
    if (grid < 0) return;
    if (hipMemsetAsync((char*)d_ws + WS_CTL, 0, CTL_BYTES, stream) != hipSuccess) { fprintf(stderr, "kernel_launch: memset failed\n"); return; }
    Args a{};
    for (int i = 0; i < 22; ++i) a.in[i] = (const float*)d_in[i];
    a.out = (float*)d_out; a.ws = (unsigned char*)d_ws;
    void* args[] = {&a};
    hipError_t e = hipLaunchCooperativeKernel((const void*)mega_fwd, dim3(grid), dim3(NTHREADS), args, LDS_BYTES, stream);
    if (e != hipSuccess) fprintf(stderr, "cooperative launch failed: %s (grid %d)\n", hipGetErrorString(e), grid);
}
```

```cpp
#include <hip/hip_runtime.h>
#include <hip/hip_cooperative_groups.h>
#include <cstdio>
#include <cstdint>
namespace cg = cooperative_groups;

#define LAS __attribute__((address_space(3)))
typedef unsigned short bf16_t;
typedef short bf16x8 __attribute__((ext_vector_type(8)));
typedef float f32x4 __attribute__((ext_vector_type(4)));
typedef float f32x2 __attribute__((ext_vector_type(2)));
typedef float f32x16 __attribute__((ext_vector_type(16)));
typedef unsigned u32x4 __attribute__((ext_vector_type(4)));
typedef unsigned u32x2 __attribute__((ext_vector_type(2)));
typedef short s16x4 __attribute__((ext_vector_type(4)));

constexpr int D = 1024, SEQ = 2048, NB = 8, MPR = NB * SEQ, NSB = 32, NST = 4, MSA = NSB * NST, MTOT = MPR + MSA, MPAD = 16640;
constexpr int DFF = 2816, NIN = 2560, CH = 512, NH = 16, HD = 64, LBUF = 2048, KA = 31;
constexpr int GAW = 1536;
constexpr float RMS_EPS = 1e-6f, LN_EPS = 1e-5f;
constexpr float LOG2E = 1.4426950408889634f;
constexpr float QSCALE = 0.125f * LOG2E;

constexpr size_t O_YP = 0;
constexpr size_t O_YS = O_YP + (size_t)MPR * D;
constexpr size_t O_PCA = O_YS + (size_t)MSA * D;
constexpr size_t O_SCA = O_PCA + (size_t)NB * 30 * CH;
constexpr size_t O_PCB = O_SCA + (size_t)NSB * 30 * CH;
constexpr size_t O_SCB = O_PCB + (size_t)NB * 2 * CH;
constexpr size_t O_PK = O_SCB + (size_t)NSB * 2 * CH;
constexpr size_t O_SK = O_PK + (size_t)MPR * D;
constexpr size_t O_PV = O_SK + (size_t)NSB * LBUF * D;
constexpr size_t O_SV = O_PV + (size_t)MPR * D;
constexpr size_t O_PF = O_SV + (size_t)NSB * LBUF * D;
constexpr size_t O_SF = O_PF + (size_t)2 * NB * 2 * DFF;
constexpr size_t O_END = O_SF + (size_t)2 * NSB * 2 * DFF;

constexpr size_t al(size_t x) { return (x + 4095) & ~(size_t)4095; }
constexpr size_t WS_CTL = 0, CTL_BYTES = 65536;
constexpr size_t WS_WIN = WS_CTL + CTL_BYTES;
constexpr size_t WS_WOUT = WS_WIN + al((size_t)NIN * D * 2);
constexpr size_t WS_WQKV = WS_WOUT + al((size_t)D * D * 2);
constexpr size_t WS_WO = WS_WQKV + al((size_t)3 * D * D * 2);
constexpr size_t WS_WF0 = WS_WO + al((size_t)D * D * 2);
constexpr size_t WS_WF1 = WS_WF0 + al((size_t)2 * DFF * D * 2);
constexpr size_t WS_WD0 = WS_WF1 + al((size_t)2 * DFF * D * 2);
constexpr size_t WS_WD1 = WS_WD0 + al((size_t)D * DFF * 2);
constexpr size_t WS_HB = WS_WD1 + al((size_t)D * DFF * 2);
constexpr size_t WS_H = WS_HB + al((size_t)MPAD * D * 2);
constexpr size_t WS_SSQ = WS_H + al((size_t)MPAD * D * 4);
constexpr size_t WS_GA = WS_SSQ + al((size_t)MPAD * 64 * 4);
constexpr size_t WS_AB = WS_GA + al((size_t)MPAD * GAW * 2);
constexpr size_t WS_ZG = WS_AB + al((size_t)MPAD * D * 2);
constexpr size_t WS_ZU = WS_ZG + al((size_t)MPAD * DFF * 2);
constexpr size_t WS_U = WS_ZU + al((size_t)MPAD * DFF * 2);
constexpr size_t WS_Q = WS_U + al((size_t)MPAD * DFF * 2);
constexpr size_t WS_K = WS_Q + al((size_t)MPAD * D * 2);
constexpr size_t WS_V = WS_K + al((size_t)MPAD * D * 2);
constexpr size_t WS_QS = WS_V + al((size_t)MPAD * D * 2);
constexpr size_t WS_END = WS_QS + al((size_t)MSA * D * 4);
static_assert(WS_V - WS_K == WS_K - WS_Q, "Q|K|V equally spaced");

constexpr int NWAVES = 8, NTHREADS = 512;
constexpr int LDS_BYTES = 147456;

__device__ __forceinline__ unsigned cvt_pk_bf16(float lo, float hi) { unsigned r; asm volatile("v_cvt_pk_bf16_f32 %0, %1, %2" : "=v"(r) : "v"(lo), "v"(hi)); return r; }
__device__ __forceinline__ float bf2f(unsigned short b) { return __uint_as_float((unsigned)b << 16); }
__device__ __forceinline__ float bflo(unsigned w) { return __uint_as_float(w << 16); }
__device__ __forceinline__ float bfhi(unsigned w) { return __uint_as_float(w & 0xffff0000u); }
__device__ __forceinline__ float sigmoidf_(float x) { return __builtin_amdgcn_rcpf(1.0f + __expf(-x)); }
__device__ __forceinline__ int launder_v(int x) { asm volatile("" : "+v"(x)); return x; }
__device__ __forceinline__ float wave_sum(float v) {
#pragma unroll
    for (int o = 1; o < 64; o <<= 1) v += __shfl_xor(v, o);
    return v;
}
__device__ __forceinline__ float wave_max(float v) {
#pragma unroll
    for (int o = 1; o < 64; o <<= 1) v = fmaxf(v, __shfl_xor(v, o));
    return v;
}

namespace pg8 {
constexpr int BM = 256, BK = 64, HALF = 128, HTB = HALF * BK * 2, STAGE_BYTES = 8 * HTB, NXCD = 8, WGM = 8;
__host__ __device__ __forceinline__ int lds_byte(int r, int c) { const int st = (r >> 4) * 2 + (c >> 5), rr = r & 15, cc = c & 31, ob = rr * 64 + cc * 2; return st * 1024 + (ob ^ (((ob >> 9) & 1) << 5)); }
__host__ __device__ __forceinline__ void stage_rc(int b, int& R, int& C) { const int st = b / 1024, sb = b % 1024, swz = sb ^ (((sb >> 9) & 1) << 5); R = (st >> 1) * 16 + swz / 64; C = (st & 1) * 32 + (swz % 64) / 2; }
__host__ __device__ __forceinline__ int perm32(int rho) { const int n = rho >> 4, i = rho & 15; return 8 * (i >> 2) + 4 * n + (i & 3); }

struct Unit { int pm, pn; };
struct Gemm { const bf16_t* A; const bf16_t* Bt; int M, N, K; };

struct StaticOrder {
    int nM, nN, nwg, G, c;
    __host__ __device__ void init(int M, int N, int G_, int c_) { nM = M / BM; nN = N / BM; nwg = nM * nN; G = G_; c = c_; }
    __host__ __device__ bool next(int i, Unit& u) const {
        const long L = (long)i * G + c; if (L >= nwg) return false;
        int wgid = (int)L; { const int q = nwg / NXCD, r = nwg % NXCD, xcd = wgid % NXCD, off = wgid / NXCD; wgid = (xcd < r ? xcd * (q + 1) : r * (q + 1) + (xcd - r) * q) + off; }
        const int nig = WGM * nN, gid = wgid / nig, fm = gid * WGM, gsz = (nM - fm) < WGM ? (nM - fm) : WGM;
        u.pm = fm + ((wgid % nig) % gsz); u.pn = (wgid % nig) / gsz; return true;
    }
    __device__ __forceinline__ void a_ready(const Unit&) const {}
    __device__ __forceinline__ void done(const Unit&) const {}
};

__device__ __forceinline__ float row_rstd(const float* ssq, int r, int fq) {
    float s;
    if (r < MPR) { const f32x4 p = *(const f32x4*)(ssq + (size_t)r * 64 + 4 * fq); s = (p.x + p.y) + (p.z + p.w); }
    else { const f32x4* pp = (const f32x4*)(ssq + (size_t)r * 64 + 16 * fq); const f32x4 p = (pp[0] + pp[1]) + (pp[2] + pp[3]); s = (p.x + p.y) + (p.z + p.w); }
    s += __shfl_xor(s, 16); s += __shfl_xor(s, 32);
    return rsqrtf(s * (1.0f / D) + RMS_EPS);
}

struct EpiInAB {
    static constexpr bool PERM = true, AFTER_DRAIN = false;
    bf16_t* GA; const float* ssq; float* out;
    __device__ __forceinline__ void operator()(const f32x4 (&acc)[2][2][4][2], const Unit& u, int wr, int wc, int fr, int fq) const {
        const int pn = u.pn, colw = wc * 32 + 8 * fq;
#pragma unroll
        for (int ai = 0; ai < 2; ++ai)
#pragma unroll
            for (int m = 0; m < 4; ++m) {
                const int r = u.pm * BM + ai * HALF + wr * 64 + m * 16 + fr;
                const float rs = row_rstd(ssq, r, fq);
                const f32x4 a0 = acc[ai][0][m][0] * rs, a1 = acc[ai][0][m][1] * rs, g0 = acc[ai][1][m][0] * rs, g1 = acc[ai][1][m][1] * rs;
                bf16_t* rowp = GA + (size_t)r * GAW;
                if (pn < 8) {
                    f32x4 v0, v1;
                    if (pn < 4) {
#pragma unroll
                        for (int i = 0; i < 4; ++i) { v0[i] = a0[i] * sigmoidf_(g0[i]); v1[i] = a1[i] * sigmoidf_(g1[i]); }
                    } else { v0 = a0 * g0; v1 = a1 * g1; }
                    const int cl = 128 * (pn & 3) + colw;
                    u32x4 w; w.x = cvt_pk_bf16(v0[0], v0[1]); w.y = cvt_pk_bf16(v0[2], v0[3]); w.z = cvt_pk_bf16(v1[0], v1[1]); w.w = cvt_pk_bf16(v1[2], v1[3]);
                    *(u32x4*)(rowp + (pn < 4 ? 0 : 512) + cl) = w;
                    const int keep = pn < 4 ? 30 : 2;
                    float* sp = nullptr;
                    if (r < MPR) { const int t = r & (SEQ - 1), b = r >> 11; if (t >= SEQ - keep) sp = out + (pn < 4 ? O_PCA : O_PCB) + ((size_t)(b * keep + (t - (SEQ - keep)))) * CH + cl; }
                    else if (r < MTOT) { const int rs_ = r - MPR, sb = rs_ >> 2, j = rs_ & 3; if (j >= NST - keep || keep == 30) sp = out + (pn < 4 ? O_SCA : O_SCB) + ((size_t)(sb * keep + (keep - NST + j))) * CH + cl; }
                    if (sp) { *(f32x4*)sp = v0; *(f32x4*)(sp + 4) = v1; }
                } else {
                    const int c = 1024 + 256 * (pn - 8) + colw;
                    u32x4 w; w.x = cvt_pk_bf16(a0[0], a0[1]); w.y = cvt_pk_bf16(a0[2], a0[3]); w.z = cvt_pk_bf16(a1[0], a1[1]); w.w = cvt_pk_bf16(a1[2], a1[3]);
                    *(u32x4*)(rowp + c) = w;
                    w.x = cvt_pk_bf16(g0[0], g0[1]); w.y = cvt_pk_bf16(g0[2], g0[3]); w.z = cvt_pk_bf16(g1[0], g1[1]); w.w = cvt_pk_bf16(g1[2], g1[3]);
                    *(u32x4*)(rowp + c + 128) = w;
                }
            }
    }
};
struct EpiResid {
    static constexpr bool PERM = false, AFTER_DRAIN = false;
    const float* baseP; const float* baseS; float* H; bf16_t* HB; float* ssq;
    __device__ __forceinline__ void operator()(const f32x4 (&acc)[2][2][4][2], const Unit& u, int wr, int wc, int fr, int fq) const {
        const int col0 = u.pn * BM + wc * 32 + 4 * fq;
#pragma unroll
        for (int ai = 0; ai < 2; ++ai)
#pragma unroll
            for (int m = 0; m < 4; ++m) {
                const int r = u.pm * BM + ai * HALF + wr * 64 + m * 16 + fr;
                float s = 0.f;
                if (r < MTOT) {
                    const float* bp = (r < MPR) ? baseP + (size_t)r * D : baseS + (size_t)(r - MPR) * D;
#pragma unroll
                    for (int bj = 0; bj < 2; ++bj)
#pragma unroll
                        for (int n = 0; n < 2; ++n) {
                            const int c = col0 + bj * HALF + n * 16;
                            const f32x4 v = *(const f32x4*)(bp + c) + acc[ai][bj][m][n];
                            *(f32x4*)(H + (size_t)r * D + c) = v;
                            s += (v[0] * v[0] + v[1] * v[1]) + (v[2] * v[2] + v[3] * v[3]);
                            u32x2 w; w.x = cvt_pk_bf16(v[0], v[1]); w.y = cvt_pk_bf16(v[2], v[3]);
                            *(u32x2*)(HB + (size_t)r * D + c) = w;
                        }
                }
                s += __shfl_xor(s, 16); s += __shfl_xor(s, 32);
                if (fq == 0 && r < MTOT) ssq[(size_t)r * 64 + u.pn * 4 + wc] = s;
            }
    }
};
struct EpiFfn {
    static constexpr bool PERM = true, AFTER_DRAIN = false;
    bf16_t* ZG; bf16_t* ZU; const float* ssq; float* out; int layer;
    __device__ __forceinline__ void operator()(const f32x4 (&acc)[2][2][4][2], const Unit& u, int wr, int wc, int fr, int fq) const {
        const int col = u.pn * 128 + wc * 32 + 8 * fq;
#pragma unroll
        for (int ai = 0; ai < 2; ++ai)
#pragma unroll
            for (int m = 0; m < 4; ++m) {
                const int r = u.pm * BM + ai * HALF + wr * 64 + m * 16 + fr;
                const float rs = row_rstd(ssq, r, fq);
                const f32x4 g0 = acc[ai][0][m][0] * rs, g1 = acc[ai][0][m][1] * rs, u0 = acc[ai][1][m][0] * rs, u1 = acc[ai][1][m][1] * rs;
                u32x4 w; w.x = cvt_pk_bf16(g0[0], g0[1]); w.y = cvt_pk_bf16(g0[2], g0[3]); w.z = cvt_pk_bf16(g1[0], g1[1]); w.w = cvt_pk_bf16(g1[2], g1[3]);
                *(u32x4*)(ZG + (size_t)r * DFF + col) = w;
                w.x = cvt_pk_bf16(u0[0], u0[1]); w.y = cvt_pk_bf16(u0[2], u0[3]); w.z = cvt_pk_bf16(u1[0], u1[1]); w.w = cvt_pk_bf16(u1[2], u1[3]);
                *(u32x4*)(ZU + (size_t)r * DFF + col) = w;
                float* sp = nullptr;
                if (r < MPR) { const int t = r & (SEQ - 1), b = r >> 11; if (t >= SEQ - 2) sp = out + O_PF + ((size_t)((layer * NB + b) * 2 + (t - (SEQ - 2)))) * DFF + col; }
                else if (r < MTOT) { const int rs_ = r - MPR, sb = rs_ >> 2, j = rs_ & 3; if (j >= 2) sp = out + O_SF + ((size_t)((layer * NSB + sb) * 2 + (j - 2))) * DFF + col; }
                if (sp) { *(f32x4*)sp = g0; *(f32x4*)(sp + 4) = g1; }
            }
    }
};
struct EpiQkv {
    static constexpr bool PERM = true, AFTER_DRAIN = false;
    bf16_t* QKV; float* QS; const float* ssq; float* out;
    __device__ __forceinline__ void operator()(const f32x4 (&acc)[2][2][4][2], const Unit& u, int wr, int wc, int fr, int fq) const {
        const int which = u.pn >> 2, cb = 256 * (u.pn & 3) + wc * 32 + 8 * fq;
        bf16_t* dst = QKV + (size_t)which * ((WS_K - WS_Q) / 2);
#pragma unroll
        for (int ai = 0; ai < 2; ++ai)
#pragma unroll
            for (int m = 0; m < 4; ++m) {
                const int r = u.pm * BM + ai * HALF + wr * 64 + m * 16 + fr;
                const float rs = row_rstd(ssq, r, fq) * (which == 0 ? QSCALE : 1.0f);
                float* fp = nullptr;
                if (which == 0) { if (r >= MPR && r < MTOT) fp = QS + (size_t)(r - MPR) * D; }
                else if (r < MPR) fp = out + (which == 1 ? O_PK : O_PV) + (size_t)r * D;
                else if (r < MTOT) { const int rs_ = r - MPR, sb = rs_ >> 2, j = rs_ & 3; fp = out + (which == 1 ? O_SK : O_SV) + ((size_t)sb * LBUF + (LBUF - NST) + j) * D; }
#pragma unroll
                for (int bj = 0; bj < 2; ++bj) {
                    const f32x4 v0 = acc[ai][bj][m][0] * rs, v1 = acc[ai][bj][m][1] * rs;
                    const int c = cb + bj * HALF;
                    u32x4 w; w.x = cvt_pk_bf16(v0[0], v0[1]); w.y = cvt_pk_bf16(v0[2], v0[3]); w.z = cvt_pk_bf16(v1[0], v1[1]); w.w = cvt_pk_bf16(v1[2], v1[3]);
                    *(u32x4*)(dst + (size_t)r * D + c) = w;
                    if (fp) { *(f32x4*)(fp + c) = v0; *(f32x4*)(fp + c + 4) = v1; }
                }
            }
    }
};

template <class Epi, class Sched, bool ALIGN_EPI = false, bool SP2 = false>
__device__ __forceinline__ void gemm_phase(LAS unsigned char* lds, const Gemm g, const Sched& S, const Epi& E) {
    const int tid = launder_v(threadIdx.x), wid = __builtin_amdgcn_readfirstlane(tid >> 6), lane = tid & 63, wr = wid >> 2, wc = wid & 3, fr = lane & 15, fq = lane >> 4;
    const int K = g.K, nt = K / BK;
    unsigned voffA[2], voffB[2];
#pragma unroll
    for (int i = 0; i < 2; ++i) { int R, C; stage_rc(tid * 16 + i * 8192, R, C); const int Rb = Epi::PERM ? ((R & ~31) + perm32(R & 31)) : R;
        voffA[i] = (unsigned)(R * K + C) * 2u; voffB[i] = (unsigned)(Rb * K + C) * 2u; }
    const size_t kstep = (size_t)(BK * 2);
    const size_t hstep = (size_t)HALF * K * 2;
    const size_t tstep = 2 * hstep;
    const unsigned ldsw = (unsigned)wid * 1024u;
    const int aoff = lds_byte(wr * 64 + fr, fq * 8), boff = lds_byte(wc * 32 + fr, fq * 8);
#define PG8_SA(b, h) (((b) * 2 + (h)) * HTB)
#define PG8_SB(b, h) ((4 + (b) * 2 + (h)) * HTB)
#define PG8_STAGE(bufoff, gbase, voff) do { _Pragma("unroll") for (int _i = 0; _i < 2; ++_i) \
        __builtin_amdgcn_global_load_lds((const unsigned*)((const char*)(gbase) + (voff)[_i]), (LAS unsigned*)(lds + (bufoff) + ldsw + _i * 8192), 16, 0, 0); } while (0)
#define PG8_LDA(dst, b, h) do { _Pragma("unroll") for (int m = 0; m < 4; ++m) _Pragma("unroll") for (int k = 0; k < 2; ++k) dst[m][k] = *(const LAS bf16x8*)(lds + PG8_SA(b, h) + aoff + m * 2048 + k * 1024); } while (0)
#define PG8_LDB(dst, b, h) do { _Pragma("unroll") for (int n = 0; n < 2; ++n) _Pragma("unroll") for (int k = 0; k < 2; ++k) dst[n][k] = *(const LAS bf16x8*)(lds + PG8_SB(b, h) + boff + n * 2048 + k * 1024); } while (0)
#define PG8_MMA(ai, bj, At, Bt) do { __builtin_amdgcn_s_setprio(1); _Pragma("unroll") for (int m = 0; m < 4; ++m) _Pragma("unroll") for (int n = 0; n < 2; ++n) _Pragma("unroll") for (int k = 0; k < 2; ++k) \
        acc[ai][bj][m][n] = __builtin_amdgcn_mfma_f32_16x16x32_bf16(Bt[n][k], At[m][k], acc[ai][bj][m][n], 0, 0, 0); __builtin_amdgcn_s_setprio(0); } while (0)
#define PG8_WAIT_V(n) asm volatile("s_waitcnt vmcnt(" #n ")" ::: "memory")
#define PG8_WAIT_L(n) asm volatile("s_waitcnt lgkmcnt(" #n ")" ::: "memory")
#define PG8_BAR __builtin_amdgcn_s_barrier()
#define PG8_SCHED __builtin_amdgcn_sched_barrier(0)
    Unit cur, nxt; int ui = 0;
    if (!S.next(0, cur)) return;
    f32x4 acc[2][2][4][2];
#pragma unroll
    for (int a = 0; a < 2; ++a)
#pragma unroll
        for (int b = 0; b < 2; ++b)
#pragma unroll
            for (int m = 0; m < 4; ++m)
#pragma unroll
                for (int n = 0; n < 2; ++n) acc[a][b][m][n] = (f32x4){0.f, 0.f, 0.f, 0.f};
    bf16x8 At[4][2], B0[2][2], B1[2][2];
    const char* cA = (const char*)g.A + (size_t)cur.pm * tstep; const char* cB = (const char*)g.Bt + (size_t)cur.pn * tstep;
    S.a_ready(cur);
    if constexpr (SP2) {
        PG8_STAGE(PG8_SB(0, 0), cB, voffB); PG8_STAGE(PG8_SB(0, 1), cB + hstep, voffB); PG8_STAGE(PG8_SA(0, 0), cA, voffA); PG8_STAGE(PG8_SA(0, 1), cA + hstep, voffA);
        if (wr == 1) PG8_BAR;
        PG8_WAIT_V(2); PG8_BAR;
        PG8_STAGE(PG8_SB(1, 0), cB + kstep, voffB); PG8_STAGE(PG8_SA(1, 0), cA + kstep, voffA); PG8_STAGE(PG8_SB(1, 1), cB + hstep + kstep, voffB);
        PG8_WAIT_V(6); PG8_BAR;
    } else {
        PG8_STAGE(PG8_SB(0, 0), cB, voffB); PG8_STAGE(PG8_SA(0, 0), cA, voffA); PG8_STAGE(PG8_SB(0, 1), cB + hstep, voffB); PG8_STAGE(PG8_SA(0, 1), cA + hstep, voffA);
        if (wr == 1) PG8_BAR;
        PG8_WAIT_V(4); PG8_BAR;
        PG8_STAGE(PG8_SB(1, 0), cB + kstep, voffB); PG8_STAGE(PG8_SA(1, 0), cA + kstep, voffA); PG8_STAGE(PG8_SB(1, 1), cB + hstep + kstep, voffB);
        PG8_WAIT_V(6); PG8_BAR;
    }
    for (;;) {
        const bool has_next = S.next(ui + 1, nxt);
        const char* nA = has_next ? (const char*)g.A + (size_t)nxt.pm * tstep : cA; const char* nB = has_next ? (const char*)g.Bt + (size_t)nxt.pn * tstep : cB;
        for (int t = 0; t < nt; t += 2) {
            const bool last = (t == nt - 2);
            const char* a1 = cA + (size_t)(t + 1) * kstep;
            const char* a2 = last ? nA : cA + (size_t)(t + 2) * kstep; const char* b2 = last ? nB : cB + (size_t)(t + 2) * kstep;
            const char* a3 = a2 + kstep; const char* b3 = b2 + kstep;
            if (last && has_next) S.a_ready(nxt);
            if constexpr (SP2) {
            PG8_LDB(B0, 0, 0); PG8_LDB(B1, 0, 1); PG8_SCHED; PG8_LDA(At, 0, 0); PG8_STAGE(PG8_SA(1, 1), a1 + hstep, voffA);
            PG8_WAIT_V(8); PG8_WAIT_L(0); PG8_BAR; PG8_MMA(0, 0, At, B0); PG8_MMA(0, 1, At, B1); PG8_BAR; PG8_SCHED;
            PG8_LDA(At, 0, 1); PG8_STAGE(PG8_SB(0, 0), b2, voffB); PG8_STAGE(PG8_SB(0, 1), b2 + hstep, voffB); PG8_STAGE(PG8_SA(0, 0), a2, voffA);
            PG8_WAIT_V(8); PG8_WAIT_L(0); PG8_BAR; PG8_MMA(1, 0, At, B0); PG8_MMA(1, 1, At, B1); PG8_BAR; PG8_SCHED;
            PG8_LDB(B0, 1, 0); PG8_LDB(B1, 1, 1); PG8_SCHED; PG8_LDA(At, 1, 0); PG8_STAGE(PG8_SA(0, 1), a2 + hstep, voffA);
            PG8_WAIT_V(8); PG8_WAIT_L(0); PG8_BAR; PG8_MMA(0, 0, At, B0); PG8_MMA(0, 1, At, B1); PG8_BAR; PG8_SCHED;
            PG8_LDA(At, 1, 1); PG8_STAGE(PG8_SB(1, 0), b3, voffB); PG8_STAGE(PG8_SB(1, 1), b3 + hstep, voffB); PG8_STAGE(PG8_SA(1, 0), a3, voffA);
            PG8_WAIT_V(8); PG8_WAIT_L(0); PG8_BAR; PG8_MMA(1, 0, At, B0); PG8_MMA(1, 1, At, B1); PG8_BAR; PG8_SCHED;
            } else {
            PG8_LDB(B0, 0, 0); PG8_SCHED; PG8_LDA(At, 0, 0); PG8_STAGE(PG8_SA(1, 1), a1 + hstep, voffA);
            PG8_WAIT_L(8); PG8_BAR; PG8_WAIT_L(0); PG8_MMA(0, 0, At, B0); PG8_BAR; PG8_SCHED;
            PG8_LDB(B1, 0, 1); PG8_STAGE(PG8_SB(0, 0), b2, voffB);
            PG8_BAR; PG8_WAIT_L(0); PG8_MMA(0, 1, At, B1); PG8_BAR;
            PG8_LDA(At, 0, 1); PG8_STAGE(PG8_SA(0, 0), a2, voffA);
            PG8_BAR; PG8_WAIT_L(0); PG8_MMA(1, 0, At, B0); PG8_BAR; PG8_SCHED;
            PG8_STAGE(PG8_SB(0, 1), b2 + hstep, voffB);
            PG8_WAIT_V(6); PG8_BAR; PG8_MMA(1, 1, At, B1); PG8_BAR;
            PG8_LDB(B0, 1, 0); PG8_SCHED; PG8_LDA(At, 1, 0); PG8_STAGE(PG8_SA(0, 1), a2 + hstep, voffA);
            PG8_WAIT_L(8); PG8_BAR; PG8_WAIT_L(0); PG8_MMA(0, 0, At, B0); PG8_BAR; PG8_SCHED;
            PG8_LDB(B1, 1, 1); PG8_STAGE(PG8_SB(1, 0), b3, voffB);
            PG8_BAR; PG8_WAIT_L(0); PG8_MMA(0, 1, At, B1); PG8_BAR;
            PG8_LDA(At, 1, 1); PG8_STAGE(PG8_SA(1, 0), a3, voffA);
            PG8_BAR; PG8_WAIT_L(0); PG8_MMA(1, 0, At, B0); PG8_BAR; PG8_SCHED;
            PG8_STAGE(PG8_SB(1, 1), b3 + hstep, voffB);
            PG8_WAIT_V(6); PG8_BAR; PG8_MMA(1, 1, At, B1); PG8_BAR;
            }
        }
        if constexpr (ALIGN_EPI) { if (wr == 0) PG8_BAR; }
        if constexpr (!Epi::AFTER_DRAIN) { E(acc, cur, wr, wc, fr, fq); S.done(cur); }
        if (!has_next) break;
#pragma unroll
        for (int a = 0; a < 2; ++a)
#pragma unroll
            for (int b = 0; b < 2; ++b)
#pragma unroll
                for (int m = 0; m < 4; ++m)
#pragma unroll
                    for (int n = 0; n < 2; ++n) acc[a][b][m][n] = (f32x4){0.f, 0.f, 0.f, 0.f};
        cur = nxt; cA = nA; cB = nB; ++ui;
        if constexpr (ALIGN_EPI) { if (wr == 1) PG8_BAR; }
    }
    PG8_WAIT_V(0);
    if constexpr (!ALIGN_EPI) { if (wr == 0) PG8_BAR; }
    PG8_BAR;
#undef PG8_SA
#undef PG8_SB
#undef PG8_STAGE
#undef PG8_LDA
#undef PG8_LDB
#undef PG8_MMA
#undef PG8_WAIT_V
#undef PG8_WAIT_L
#undef PG8_BAR
#undef PG8_SCHED
}
}

__device__ __forceinline__ void transpose_item(const float* W, int K, int N, bf16_t* WT, int k0, int np0, int srcn0, const float* g, LAS float* scr, int lane) {
#pragma unroll 8
    for (int i = 0; i < 32; ++i) { const int kk = 2 * i + (lane >> 5); float v = W[(size_t)(k0 + kk) * N + srcn0 + (lane & 31)]; if (g) v *= g[k0 + kk]; scr[kk * 33 + (lane & 31)] = v; }
    asm volatile("s_waitcnt lgkmcnt(0)" ::: "memory");
    const int c = lane & 7;
#pragma unroll
    for (int j = 0; j < 4; ++j) { const int n = (lane >> 3) + 8 * j; const LAS float* s = scr + (8 * c) * 33 + n;
        u32x4 o; o.x = cvt_pk_bf16(s[0 * 33], s[1 * 33]); o.y = cvt_pk_bf16(s[2 * 33], s[3 * 33]); o.z = cvt_pk_bf16(s[4 * 33], s[5 * 33]); o.w = cvt_pk_bf16(s[6 * 33], s[7 * 33]);
        *(u32x4*)(WT + (size_t)(np0 + n) * K + k0 + 8 * c) = o; }
    asm volatile("s_waitcnt lgkmcnt(0)" ::: "memory");
}
__device__ __forceinline__ int src_in_ab(int np) {
    const int pn = np >> 8, cc = np & 255, bj = cc >> 7, off = cc & 127;
    if (pn < 4) return (bj ? 512 : 0) + 128 * pn + off;
    if (pn < 8) return (bj ? 2048 : 1536) + 128 * (pn - 4) + off;
    return 1024 + 256 * (pn - 8) + cc;
}
__device__ __forceinline__ int src_ffn(int np) { const int pn = np >> 8, cc = np & 255, bj = cc >> 7, off = cc & 127; return (bj ? DFF : 0) + 128 * pn + off; }

struct Args { const float* in[22]; float* out; unsigned char* ws; };

__device__ __forceinline__ void p0_prologue(const Args& a, LAS unsigned char* lds, int gw, int NGW, int lane, int wave) {
    LAS float* scr = (LAS float*)(lds + wave * 16384);
    unsigned char* ws = a.ws;
    constexpr int I_IN = (D / 64) * (NIN / 32), I_SQ = (D / 64) * (D / 32), I_QKV = (D / 64) * (3 * D / 32), I_F = (D / 64) * (2 * DFF / 32), I_DN = (DFF / 64) * (D / 32);
    constexpr int NITEMS = I_IN + 2 * I_SQ + I_QKV + 2 * I_F + 2 * I_DN;
    for (int it = gw; it < NITEMS; it += NGW) {
        int r = it;
        if (r < I_IN) { const int nb = NIN / 32, kb = r / nb, n0 = 32 * (r % nb); transpose_item(a.in[10], D, NIN, (bf16_t*)(ws + WS_WIN), 64 * kb, n0, src_in_ab(n0), a.in[7], scr, lane); continue; } r -= I_IN;
        if (r < I_SQ) { const int nb = D / 32, kb = r / nb, n0 = 32 * (r % nb); transpose_item(a.in[16], D, D, (bf16_t*)(ws + WS_WOUT), 64 * kb, n0, n0, nullptr, scr, lane); continue; } r -= I_SQ;
        if (r < I_QKV) { const int nb = 3 * D / 32, kb = r / nb, n0 = 32 * (r % nb); transpose_item(a.in[17], D, 3 * D, (bf16_t*)(ws + WS_WQKV), 64 * kb, n0, n0, a.in[7] + D, scr, lane); continue; } r -= I_QKV;
        if (r < I_SQ) { const int nb = D / 32, kb = r / nb, n0 = 32 * (r % nb); transpose_item(a.in[18], D, D, (bf16_t*)(ws + WS_WO), 64 * kb, n0, n0, nullptr, scr, lane); continue; } r -= I_SQ;
        if (r < 2 * I_F) { const int l = r / I_F; r -= l * I_F; const int nb = 2 * DFF / 32, kb = r / nb, n0 = 32 * (r % nb);
            transpose_item(a.in[19] + (size_t)l * D * 2 * DFF, D, 2 * DFF, (bf16_t*)(ws + (l ? WS_WF1 : WS_WF0)), 64 * kb, n0, src_ffn(n0), a.in[8] + l * D, scr, lane); continue; } r -= 2 * I_F;
        { const int l = r / I_DN; r -= l * I_DN; const int nb = D / 32, kb = r / nb, n0 = 32 * (r % nb);
            transpose_item(a.in[21] + (size_t)l * DFF * D, DFF, D, (bf16_t*)(ws + (l ? WS_WD1 : WS_WD0)), 64 * kb, n0, n0, nullptr, scr, lane); }
    }
    bf16_t* HB = (bf16_t*)(ws + WS_HB); float* ssq = (float*)(ws + WS_SSQ);
    for (int r = gw; r < MPAD; r += NGW) {
        f32x4 v[4]; float s = 0.f;
        if (r < MTOT) {
            const f32x4* xr = (const f32x4*)((r < MPR) ? a.in[0] + (size_t)r * D : a.in[1] + (size_t)(r - MPR) * D) + lane;
#pragma unroll
            for (int j = 0; j < 4; ++j) { v[j] = xr[64 * j]; s += (v[j].x * v[j].x + v[j].y * v[j].y) + (v[j].z * v[j].z + v[j].w * v[j].w); }
        } else {
#pragma unroll
            for (int j = 0; j < 4; ++j) v[j] = (f32x4){0.f, 0.f, 0.f, 0.f};
        }
        s = wave_sum(s);
        u32x2* o8 = (u32x2*)(HB + (size_t)r * D) + lane;
#pragma unroll
        for (int j = 0; j < 4; ++j) { u32x2 w; w.x = cvt_pk_bf16(v[j].x, v[j].y); w.y = cvt_pk_bf16(v[j].z, v[j].w); o8[64 * j] = w; }
        if (r < MPR) { if (lane < 16) ssq[(size_t)r * 64 + lane] = (lane == 0) ? s : 0.f; } else ssq[(size_t)r * 64 + lane] = (lane == 0) ? s : 0.f;
    }
    {
        const int tot = NSB * 26 * (CH / 4);
        for (int i = gw * 64 + lane; i < tot; i += NGW * 64) { const int sb = i / (26 * (CH / 4)), rem = i % (26 * (CH / 4));
            ((f32x4*)(a.out + O_SCA + (size_t)sb * 30 * CH))[rem] = ((const f32x4*)(a.in[2] + (size_t)sb * 30 * CH + 4 * CH))[rem]; }
    }
    {
        const size_t per = (size_t)(LBUF - NST) * D / 4;
        const size_t tot = per * NSB, stride = (size_t)NGW * 64;
        for (size_t i0 = (size_t)gw * 64 + lane; i0 < tot; i0 += 4 * stride) {
            f32x4 kv[4], vv[4];
#pragma unroll
            for (int u = 0; u < 4; ++u) { const size_t i = i0 + u * stride; if (i < tot) { const size_t sb = i / per, rem = i % per;
                kv[u] = __builtin_nontemporal_load((const f32x4*)(a.in[4] + (sb * LBUF + NST) * D) + rem); vv[u] = __builtin_nontemporal_load((const f32x4*)(a.in[5] + (sb * LBUF + NST) * D) + rem); } }
#pragma unroll
            for (int u = 0; u < 4; ++u) { const size_t i = i0 + u * stride; if (i < tot) { const size_t sb = i / per, rem = i % per;
                __builtin_nontemporal_store(kv[u], (f32x4*)(a.out + O_SK + sb * LBUF * D) + rem); __builtin_nontemporal_store(vv[u], (f32x4*)(a.out + O_SV + sb * LBUF * D) + rem); } }
        }
    }
}

__device__ __forceinline__ void p2_conv(const Args& a, LAS unsigned char* lds, int tid, int lane, int wave) {
    unsigned char* ws = a.ws;
    const bf16_t* GA = (const bf16_t*)(ws + WS_GA); bf16_t* AB = (bf16_t*)(ws + WS_AB);
    LAS float* T = (LAS float*)lds;
    const float* wa = a.in[11]; const float* ba = a.in[12]; const float* lg = a.in[13]; const float* lb = a.in[14]; const float* wb = a.in[15];
    for (int u = blockIdx.x; u < 512 + NSB; u += gridDim.x) {
        const bool samp = u >= 512; const int sb = u - 512;
        const int row0 = samp ? MPR + sb * NST : u * 32, nrows = samp ? NST : 32;
        const int t0 = samp ? 0 : (row0 & (SEQ - 1));
        const int nvec = (nrows + 30) * (CH / 8);
        for (int i = tid; i < nvec; i += NTHREADS) {
            const int e = i >> 6, c = (i & 63) * 8; const int p = t0 - 30 + e;
            f32x4 v0 = (f32x4){0.f, 0.f, 0.f, 0.f}, v1 = v0;
            if (p >= 0) { const u32x4 w = *(const u32x4*)(GA + (size_t)(row0 - t0 + p) * GAW + c);
                v0 = (f32x4){bflo(w.x), bfhi(w.x), bflo(w.y), bfhi(w.y)}; v1 = (f32x4){bflo(w.z), bfhi(w.z), bflo(w.w), bfhi(w.w)}; }
            else if (samp) { const float* sp = a.in[2] + ((size_t)sb * 30 + e) * CH + c; v0 = *(const f32x4*)sp; v1 = *(const f32x4*)(sp + 4); }
            *(LAS f32x4*)(T + e * CH + c) = v0; *(LAS f32x4*)(T + e * CH + c + 4) = v1;
        }
        __syncthreads();
        if (tid < 256) {
            const int c = 2 * tid; f32x2 w[KA];
#pragma unroll
            for (int k = 0; k < KA; ++k) w[k] = *(const f32x2*)(wa + k * CH + c);
            const f32x2 bias = *(const f32x2*)(ba + c);
            for (int i = 0; i < nrows; ++i) {
                f32x2 s = bias;
#pragma unroll
                for (int k = 0; k < KA; ++k) { const f32x2 x = *(const LAS f32x2*)(T + (i + k) * CH + c); s += w[k] * x; }
                *(LAS f32x2*)(T + i * CH + c) = s;
            }
        } else {
            const int t2 = tid - 256;
            for (int i = t2; i < nrows * 64; i += 256) {
                const int rr = i >> 6, c = (i & 63) * 8; const int r = row0 + rr, p = t0 + rr;
                float x[3][8];
#pragma unroll
                for (int k = 0; k < 3; ++k) { const int pp = p - 2 + k;
                    if (pp >= 0) { const u32x4 wv = *(const u32x4*)(GA + (size_t)(r - 2 + k) * GAW + 512 + c);
                        x[k][0] = bflo(wv.x); x[k][1] = bfhi(wv.x); x[k][2] = bflo(wv.y); x[k][3] = bfhi(wv.y); x[k][4] = bflo(wv.z); x[k][5] = bfhi(wv.z); x[k][6] = bflo(wv.w); x[k][7] = bfhi(wv.w); }
                    else if (samp) { const float* sp = a.in[3] + ((size_t)sb * 2 + (pp + 2)) * CH + c;
#pragma unroll
                        for (int e = 0; e < 8; ++e) x[k][e] = sp[e]; }
                    else {
#pragma unroll
                        for (int e = 0; e < 8; ++e) x[k][e] = 0.f; } }
                const u32x4 gv = *(const u32x4*)(GA + (size_t)r * GAW + 1024 + c);
                float gb[8] = {bflo(gv.x), bfhi(gv.x), bflo(gv.y), bfhi(gv.y), bflo(gv.z), bfhi(gv.z), bflo(gv.w), bfhi(gv.w)};
                float o[8];
#pragma unroll
                for (int e = 0; e < 8; ++e) o[e] = gb[e] * (wb[0 * CH + c + e] * x[0][e] + wb[1 * CH + c + e] * x[1][e] + wb[2 * CH + c + e] * x[2][e]);
                u32x4 w4; w4.x = cvt_pk_bf16(o[0], o[1]); w4.y = cvt_pk_bf16(o[2], o[3]); w4.z = cvt_pk_bf16(o[4], o[5]); w4.w = cvt_pk_bf16(o[6], o[7]);
                *(u32x4*)(AB + (size_t)r * D + 512 + c) = w4;
            }
        }
        __syncthreads();
        for (int rr = wave; rr < nrows; rr += NWAVES) {
            const int c = lane * 8;
            const f32x4 v0 = *(const LAS f32x4*)(T + rr * CH + c), v1 = *(const LAS f32x4*)(T + rr * CH + c + 4);
            float s = (v0.x + v0.y) + (v0.z + v0.w) + (v1.x + v1.y) + (v1.z + v1.w);
            const float mu = wave_sum(s) * (1.0f / CH);
            const f32x4 d0 = v0 - mu, d1 = v1 - mu;
            float q = (d0.x * d0.x + d0.y * d0.y) + (d0.z * d0.z + d0.w * d0.w) + (d1.x * d1.x + d1.y * d1.y) + (d1.z * d1.z + d1.w * d1.w);
            const float rstd = rsqrtf(wave_sum(q) * (1.0f / CH) + LN_EPS);
            const f32x4 g0 = *(const f32x4*)(lg + c), g1 = *(const f32x4*)(lg + c + 4), b0 = *(const f32x4*)(lb + c), b1 = *(const f32x4*)(lb + c + 4);
            f32x4 a0 = d0 * rstd * g0 + b0, a1 = d1 * rstd * g1 + b1;
#pragma unroll
            for (int e = 0; e < 4; ++e) { a0[e] = a0[e] * sigmoidf_(a0[e]); a1[e] = a1[e] * sigmoidf_(a1[e]); }
            u32x4 w4; w4.x = cvt_pk_bf16(a0[0], a0[1]); w4.y = cvt_pk_bf16(a0[2], a0[3]); w4.z = cvt_pk_bf16(a1[0], a1[1]); w4.w = cvt_pk_bf16(a1[2], a1[3]);
            *(u32x4*)(AB + (size_t)(row0 + rr) * D + c) = w4;
        }
        __syncthreads();
    }
}

__device__ __forceinline__ void p5_combine(const Args& a, int layer, int gtid, int GT) {
    unsigned char* ws = a.ws;
    const bf16_t* ZG = (const bf16_t*)(ws + WS_ZG); const bf16_t* ZU = (const bf16_t*)(ws + WS_ZU); bf16_t* U = (bf16_t*)(ws + WS_U);
    const float* wc = a.in[20] + (size_t)layer * 3 * DFF;
    constexpr int NCV = DFF / 8, NCH = MPR / 16;
    const int nit = NCH * NCV + NSB * NCV;
    for (int it = gtid; it < nit; it += GT) {
        const bool samp = it >= NCH * NCV;
        int r0, nrows, cv, sb = 0;
        if (!samp) { const int ch = it / NCV; cv = it % NCV; r0 = ch * 16; nrows = 16; } else { const int j = it - NCH * NCV; sb = j / NCV; cv = j % NCV; r0 = MPR + sb * NST; nrows = NST; }
        const int c = cv * 8;
        float w0[8], w1[8], w2[8], gm2[8], gm1[8];
#pragma unroll
        for (int e = 0; e < 8; ++e) { w0[e] = wc[c + e]; w1[e] = wc[DFF + c + e]; w2[e] = wc[2 * DFF + c + e]; }
        if (samp) { const float* sp = a.in[6] + ((size_t)(layer * NSB + sb) * 2) * DFF + c;
#pragma unroll
            for (int e = 0; e < 8; ++e) { gm2[e] = sp[e]; gm1[e] = sp[DFF + e]; } }
        else if ((r0 & (SEQ - 1)) == 0) {
#pragma unroll
            for (int e = 0; e < 8; ++e) { gm2[e] = 0.f; gm1[e] = 0.f; } }
        else { const u32x4 p2 = *(const u32x4*)(ZG + (size_t)(r0 - 2) * DFF + c), p1 = *(const u32x4*)(ZG + (size_t)(r0 - 1) * DFF + c);
            gm2[0] = bflo(p2.x); gm2[1] = bfhi(p2.x); gm2[2] = bflo(p2.y); gm2[3] = bfhi(p2.y); gm2[4] = bflo(p2.z); gm2[5] = bfhi(p2.z); gm2[6] = bflo(p2.w); gm2[7] = bfhi(p2.w);
            gm1[0] = bflo(p1.x); gm1[1] = bfhi(p1.x); gm1[2] = bflo(p1.y); gm1[3] = bfhi(p1.y); gm1[4] = bflo(p1.z); gm1[5] = bfhi(p1.z); gm1[6] = bflo(p1.w); gm1[7] = bfhi(p1.w); }
        for (int i = 0; i < nrows; ++i) {
            const size_t off = (size_t)(r0 + i) * DFF + c;
            const u32x4 gv = *(const u32x4*)(ZG + off), uv = *(const u32x4*)(ZU + off);
            float g[8] = {bflo(gv.x), bfhi(gv.x), bflo(gv.y), bfhi(gv.y), bflo(gv.z), bfhi(gv.z), bflo(gv.w), bfhi(gv.w)};
            float up[8] = {bflo(uv.x), bfhi(uv.x), bflo(uv.y), bfhi(uv.y), bflo(uv.z), bfhi(uv.z), bflo(uv.w), bfhi(uv.w)};
            float o[8];
#pragma unroll
            for (int e = 0; e < 8; ++e) { const float y = w0[e] * gm2[e] + w1[e] * gm1[e] + w2[e] * g[e]; o[e] = y * sigmoidf_(y) * up[e]; gm2[e] = gm1[e]; gm1[e] = g[e]; }
            u32x4 w4; w4.x = cvt_pk_bf16(o[0], o[1]); w4.y = cvt_pk_bf16(o[2], o[3]); w4.z = cvt_pk_bf16(o[4], o[5]); w4.w = cvt_pk_bf16(o[6], o[7]);
            *(u32x4*)(U + off) = w4;
        }
    }
}

constexpr int AT_OACC = 0, AT_OSTR = 65, AT_ML = 256 * AT_OSTR * 4, AT_VST = AT_ML + 2048, AT_PSC = AT_VST + NWAVES * 4096;
static_assert(AT_PSC + NWAVES * 2048 <= 131072, "attention LDS");
__device__ __forceinline__ int crow(int r, int hi) { return (r & 3) + 8 * (r >> 2) + 4 * hi; }

__device__ __forceinline__ void attn_task(const bf16_t* Qh, const bf16_t* Kh, const bf16_t* Vh, int dil, int cls, int s0, int nq, float slope2, int qlbase, int qlstep, bool first,
                                          LAS unsigned char* lds, int wave, int lane) {
    const int r32 = lane & 31, hi = lane >> 5;
    const int qi = r32 < nq ? r32 : nq - 1;
    const bf16_t* qp = Qh + (size_t)(cls + dil * (s0 + qi)) * D + hi * 8;
    bf16x8 qr[4];
#pragma unroll
    for (int d0 = 0; d0 < 4; ++d0) qr[d0] = *(const bf16x8*)(qp + d0 * 16);
    float m_run = -INFINITY, l_run = 0.f; f32x16 o[2]; o[0] = f32x16{}; o[1] = f32x16{};
    LAS unsigned char* vst = lds + AT_VST + wave * 4096;
    const float sdil = slope2 * (float)dil;
    f32x16 cb;
#pragma unroll
    for (int r = 0; r < 16; ++r) cb[r] = -sdil * (float)(r32 - 4 * hi + 128 - ((r & 3) + 8 * (r >> 2)));
    const int i_first = s0 < 128 ? (128 - s0) >> 5 : 0;
    const int vb = ((lane >> 4) & 1) * 32 + (lane & 3) * 8 + (4 * hi + ((lane & 15) >> 2)) * 64;
#pragma clang loop unroll(disable)
    for (int i = 4; i >= i_first; --i) {
        const int kb = s0 - 128 + 32 * i;
        const int skv = kb + r32 < 0 ? 0 : kb + r32;
        const bf16_t* kp = Kh + (size_t)(cls + dil * skv) * D + hi * 8;
        bf16x8 kf[4];
#pragma unroll
        for (int d0 = 0; d0 < 4; ++d0) kf[d0] = *(const bf16x8*)(kp + d0 * 16);
        u32x4 vv[4];
#pragma unroll
        for (int j = 0; j < 4; ++j) { const int kv = (lane >> 3) + 8 * j; const int sv = kb + kv < 0 ? 0 : kb + kv;
            vv[j] = *(const u32x4*)(Vh + (size_t)(cls + dil * sv) * D + (lane & 7) * 8); }
        const float toff = sdil * (float)(32 * i);
        f32x16 st;
#pragma unroll
        for (int r = 0; r < 16; ++r) st[r] = cb[r] + toff;
#pragma unroll
        for (int d0 = 0; d0 < 4; ++d0) st = __builtin_amdgcn_mfma_f32_32x32x16_bf16(kf[d0], qr[d0], st, 0, 0, 0);
        asm volatile("" ::: "memory");
#pragma unroll
        for (int j = 0; j < 4; ++j) { const int kv = (lane >> 3) + 8 * j, part = lane & 7;
            *(LAS u32x4*)(vst + (part >> 2) * 2048 + (kv >> 3) * 512 + (kv & 7) * 64 + (part & 3) * 16) = vv[j]; }
        if (i == 0 || i == 4 || kb < 0) {
            int cmin = (i == 0) ? r32 : 0; cmin = cmin > -kb ? cmin : -kb; const int cmax = (i == 4) ? r32 : 31;
            const int lo_ = cmin - 4 * hi, hi_ = cmax - 4 * hi;
#pragma unroll
            for (int r = 0; r < 16; ++r) { const int c = (r & 3) + 8 * (r >> 2); st[r] = (c >= lo_ && c <= hi_) ? st[r] : -INFINITY; }
        }
        float mx = fmaxf(fmaxf(st[0], st[1]), fmaxf(st[2], st[3]));
#pragma unroll
        for (int r = 4; r < 16; r += 4) mx = fmaxf(mx, fmaxf(fmaxf(st[r], st[r + 1]), fmaxf(st[r + 2], st[r + 3])));
        { auto rr = __builtin_amdgcn_permlane32_swap(__float_as_uint(mx), __float_as_uint(mx), false, false); mx = fmaxf(__uint_as_float(rr[0]), __uint_as_float(rr[1])); }
        if (__any(mx > m_run)) {
            const float m_new = fmaxf(m_run, mx);
            const float alpha = __builtin_amdgcn_exp2f(m_run - ((m_new == -INFINITY) ? 0.f : m_new));
            l_run *= alpha; m_run = m_new;
#pragma unroll
            for (int r = 0; r < 16; ++r) { o[0][r] *= alpha; o[1][r] *= alpha; }
        }
        const float m_use = (m_run == -INFINITY) ? 0.f : m_run;
        float ps = 0.f;
#pragma unroll
        for (int r = 0; r < 16; ++r) { const float p = __builtin_amdgcn_exp2f(st[r] - m_use); st[r] = p; ps += p; }
        l_run += ps;
        bf16x8 pa[2];
#pragma unroll
        for (int s = 0; s < 2; ++s) { u32x4 w; w.x = cvt_pk_bf16(st[8 * s + 0], st[8 * s + 1]); w.y = cvt_pk_bf16(st[8 * s + 2], st[8 * s + 3]); w.z = cvt_pk_bf16(st[8 * s + 4], st[8 * s + 5]); w.w = cvt_pk_bf16(st[8 * s + 6], st[8 * s + 7]);
            pa[s] = __builtin_bit_cast(bf16x8, w); }
        asm volatile("s_waitcnt lgkmcnt(0)" ::: "memory");
#pragma unroll
        for (int d0 = 0; d0 < 2; ++d0)
#pragma unroll
            for (int s = 0; s < 2; ++s) {
                const s16x4 lo = __builtin_bit_cast(s16x4, __builtin_amdgcn_ds_read_tr16_b64_v4i16((LAS s16x4*)(vst + vb + d0 * 2048 + s * 1024)));
                const s16x4 hh = __builtin_bit_cast(s16x4, __builtin_amdgcn_ds_read_tr16_b64_v4i16((LAS s16x4*)(vst + vb + d0 * 2048 + s * 1024 + 512)));
                const bf16x8 vf = (bf16x8){lo[0], lo[1], lo[2], lo[3], hh[0], hh[1], hh[2], hh[3]};
                o[d0] = __builtin_amdgcn_mfma_f32_32x32x16_bf16(vf, pa[s], o[d0], 0, 0, 0);
            }
        asm volatile("s_waitcnt lgkmcnt(0)" ::: "memory");
    }
    { auto rr = __builtin_amdgcn_permlane32_swap(__float_as_uint(l_run), __float_as_uint(l_run), false, false); l_run = __uint_as_float(rr[0]) + __uint_as_float(rr[1]); }
    if (r32 < nq) {
        const int ql = qlbase + qlstep * r32;
        LAS float* oa = (LAS float*)(lds + AT_OACC) + ql * AT_OSTR;
        LAS float* ml = (LAS float*)(lds + AT_ML) + ql * 2;
        float a_old = 0.f, a_new = 1.f, m_new = m_run, l_new = l_run;
        if (!first) { const float m_old = ml[0], l_old = ml[1]; m_new = fmaxf(m_old, m_run); const float mu = (m_new == -INFINITY) ? 0.f : m_new;
            a_old = __builtin_amdgcn_exp2f(m_old - mu); a_new = __builtin_amdgcn_exp2f(m_run - mu); l_new = l_old * a_old + l_run * a_new; }
#pragma unroll
        for (int d0 = 0; d0 < 2; ++d0)
#pragma unroll
            for (int r = 0; r < 16; ++r) { const int d = 32 * d0 + crow(r, hi); float v = o[d0][r] * a_new; if (!first) v += oa[d] * a_old; oa[d] = v; }
        asm volatile("s_waitcnt lgkmcnt(0)" ::: "memory");
        if (hi == 0) { ml[0] = m_new; ml[1] = l_new; }
    }
}

__device__ __forceinline__ void p8_attention(const Args& a, LAS unsigned char* lds, int tid, int lane, int wave) {
    unsigned char* ws = a.ws;
    const bf16_t* Q = (const bf16_t*)(ws + WS_Q); const bf16_t* K = (const bf16_t*)(ws + WS_K); const bf16_t* V = (const bf16_t*)(ws + WS_V); bf16_t* O = (bf16_t*)(ws + WS_AB);
#ifndef NO_SAMPLE
    {
        const float* QS = (const float*)(ws + WS_QS);
        LAS float* psc = (LAS float*)(lds + AT_PSC + wave * 2048);
        for (int task = blockIdx.x * NWAVES + wave; task < NSB * NH * NST; task += gridDim.x * NWAVES) {
            const int sb = task / (NH * NST), h = (task / NST) % NH, j = task % NST;
            const float slope2 = exp2f(-0.5f * (float)(h + 1)) * LOG2E;
            const float* kc = a.in[4] + (size_t)sb * LBUF * D + h * HD; const float* vc = a.in[5] + (size_t)sb * LBUF * D + h * HD;
            const float* kn = a.out + O_SK + ((size_t)sb * LBUF + (LBUF - NST)) * D + h * HD; const float* vn = a.out + O_SV + ((size_t)sb * LBUF + (LBUF - NST)) * D + h * HD;
            const float* qrow = QS + (size_t)(sb * NST + j) * D + h * HD;
            f32x4 qv[16];
#pragma unroll
            for (int e = 0; e < 16; ++e) qv[e] = *(const f32x4*)(qrow + 4 * e);
            float mx = -INFINITY;
#pragma clang loop unroll(disable)
            for (int rd = 0; rd < 7; ++rd) {
                const int kk = rd * 64 + lane; float s = -INFINITY;
                if (kk < 387) { const int g = kk / 129, mm = kk % 129, dil = (g == 0) ? 1 : (g == 1 ? 4 : 16); const int idx = LBUF + j - mm * dil;
                    const float* kr = (idx >= LBUF) ? kn + (size_t)(idx - LBUF) * D : kc + (size_t)idx * D;
                    float acc = 0.f;
#pragma unroll
                    for (int e = 0; e < 16; ++e) { const f32x4 kx = *(const f32x4*)(kr + 4 * e); acc += (qv[e].x * kx.x + qv[e].y * kx.y) + (qv[e].z * kx.z + qv[e].w * kx.w); }
                    s = acc - slope2 * (float)(mm * dil); }
                psc[kk] = s; mx = fmaxf(mx, s);
            }
            mx = wave_max(mx);
            asm volatile("s_waitcnt lgkmcnt(0)" ::: "memory");
            float l = 0.f;
#pragma clang loop unroll(disable)
            for (int rd = 0; rd < 7; ++rd) { const float p = __builtin_amdgcn_exp2f(psc[rd * 64 + lane] - mx); l += p; psc[rd * 64 + lane] = p; }
            l = wave_sum(l);
            asm volatile("s_waitcnt lgkmcnt(0)" ::: "memory");
            const int kg = lane >> 4, dc = lane & 15;
            f32x4 acc4 = (f32x4){0.f, 0.f, 0.f, 0.f};
#pragma clang loop unroll(disable)
            for (int k0 = 0; k0 < 387; k0 += 64) {
                f32x4 vr4[16]; float pk[16];
#pragma unroll
                for (int u = 0; u < 16; ++u) { const int kk = k0 + 4 * u + kg; const int kc_ = kk < 387 ? kk : 386;
                    const int g = kc_ / 129, mm = kc_ % 129, dil = (g == 0) ? 1 : (g == 1 ? 4 : 16); const int idx = LBUF + j - mm * dil;
                    const float* vr = (idx >= LBUF) ? vn + (size_t)(idx - LBUF) * D : vc + (size_t)idx * D;
                    vr4[u] = *(const f32x4*)(vr + 4 * dc); pk[u] = kk < 387 ? psc[kc_] : 0.f; }
#pragma unroll
                for (int u = 0; u < 16; ++u) acc4 += vr4[u] * pk[u];
            }
#pragma unroll
            for (int e = 0; e < 4; ++e) { acc4[e] += __shfl_xor(acc4[e], 16); acc4[e] += __shfl_xor(acc4[e], 32); }
            const float il = __builtin_amdgcn_rcpf(l);
            if (lane < 16) { u32x2 w; w.x = cvt_pk_bf16(acc4[0] * il, acc4[1] * il); w.y = cvt_pk_bf16(acc4[2] * il, acc4[3] * il);
                *(u32x2*)(O + (size_t)(MPR + sb * NST + j) * D + h * HD + 4 * dc) = w; }
            asm volatile("s_waitcnt lgkmcnt(0)" ::: "memory");
        }
    }
#endif
    __syncthreads();
#ifndef NO_PROMPT
    const int nun = NB * NH * 8, per_round = gridDim.x;
    for (int u0 = blockIdx.x; u0 < nun; u0 += per_round) {
        int u = u0;
        if ((gridDim.x & 7) == 0 && nun % (int)gridDim.x == 0) { const int x = blockIdx.x & 7, slot = blockIdx.x >> 3, spx = gridDim.x >> 3, j = (u0 / per_round) * spx + slot; u = x * (nun >> 3) + j; }
        const int qblk = u & 7, h = (u >> 3) & 15, b = u >> 7;
        const float slope2 = exp2f(-0.5f * (float)(h + 1)) * LOG2E;
        const bf16_t* Qh = Q + (size_t)b * SEQ * D + h * HD; const bf16_t* Kh = K + (size_t)b * SEQ * D + h * HD; const bf16_t* Vh = V + (size_t)b * SEQ * D + h * HD;
#pragma clang loop unroll(disable)
        for (int tk = 0; tk < 4; ++tk) {
            int dil, cls, s0, nq, qlb, qls;
            if (tk == 0) { dil = 1; cls = 0; s0 = 256 * qblk + 32 * wave; nq = 32; qlb = 32 * wave; qls = 1; }
            else if (tk == 1) { dil = 4; cls = wave & 3; s0 = 64 * qblk + 32 * (wave >> 2); nq = 32; qlb = (wave & 3) + 128 * (wave >> 2); qls = 4; }
            else { dil = 16; cls = 2 * wave + (tk - 2); s0 = 16 * qblk; nq = 16; qlb = cls; qls = 16; }
            attn_task(Qh, Kh, Vh, dil, cls, s0, nq, slope2, qlb, qls, tk == 0, lds, wave, lane);
            if (tk != 2) __syncthreads();
        }
        {
            const int ql = tid >> 1, dh = (tid & 1) * 32;
            const LAS float* oa = (const LAS float*)(lds + AT_OACC) + ql * AT_OSTR + dh;
            const float inv = __builtin_amdgcn_rcpf(((const LAS float*)(lds + AT_ML))[ql * 2 + 1]);
            bf16_t* op = O + (size_t)(b * SEQ + 256 * qblk + ql) * D + h * HD + dh;
#pragma unroll
            for (int e = 0; e < 4; ++e) { u32x4 w; w.x = cvt_pk_bf16(oa[8 * e + 0] * inv, oa[8 * e + 1] * inv); w.y = cvt_pk_bf16(oa[8 * e + 2] * inv, oa[8 * e + 3] * inv);
                w.z = cvt_pk_bf16(oa[8 * e + 4] * inv, oa[8 * e + 5] * inv); w.w = cvt_pk_bf16(oa[8 * e + 6] * inv, oa[8 * e + 7] * inv); *(u32x4*)(op + 8 * e) = w; }
        }
        __syncthreads();
    }
#endif
}

__device__ __forceinline__ void p13_final(const Args& a, int gw, int NGW, int lane) {
    const float* H = (const float*)(a.ws + WS_H); const float* g = a.in[9];
    for (int r = gw; r < MTOT; r += NGW) {
        const f32x4* xr = (const f32x4*)(H + (size_t)r * D) + lane; f32x4 v[4]; float s = 0.f;
#pragma unroll
        for (int j = 0; j < 4; ++j) { v[j] = xr[64 * j]; s += (v[j].x * v[j].x + v[j].y * v[j].y) + (v[j].z * v[j].z + v[j].w * v[j].w); }
        const float rstd = rsqrtf(wave_sum(s) * (1.0f / D) + RMS_EPS);
        f32x4* o = (f32x4*)(a.out + (size_t)r * D) + lane;
#pragma unroll
        for (int j = 0; j < 4; ++j) o[64 * j] = v[j] * rstd * ((const f32x4*)g)[64 * j + lane];
    }
}

template <int MODE, int K>
__device__ __forceinline__ void sample_gemm(LAS unsigned char* lds, const bf16_t* A, const bf16_t* Bt, int N, const float* base, float* Hs, bf16_t* HBs, float* ssq,
                                            bf16_t* QKV, float* QS, float* out, int tid, int lane, int wave) {
    constexpr int KPW = K / 32 / 8;
    const int nitems = (N / 16) * 4;
    LAS f32x4* red = (LAS f32x4*)lds;
    for (int it = blockIdx.x; it < nitems; it += gridDim.x) {
        const int cbk = it >> 2, rq = it & 3;
        const bf16_t* bp = Bt + (size_t)(16 * cbk + (lane & 15)) * K + wave * KPW * 32 + 8 * (lane >> 4);
        const bf16_t* ap = A + (size_t)(32 * rq + (lane & 15)) * K + wave * KPW * 32 + 8 * (lane >> 4);
        bf16x8 bw[KPW], a0[KPW], a1[KPW];
#pragma unroll
        for (int ks = 0; ks < KPW; ++ks) { bw[ks] = *(const bf16x8*)(bp + ks * 32); a0[ks] = *(const bf16x8*)(ap + ks * 32); a1[ks] = *(const bf16x8*)(ap + (size_t)16 * K + ks * 32); }
        f32x4 acc0 = (f32x4){0.f, 0.f, 0.f, 0.f}, acc1 = acc0;
#pragma unroll
        for (int ks = 0; ks < KPW; ++ks) { acc0 = __builtin_amdgcn_mfma_f32_16x16x32_bf16(bw[ks], a0[ks], acc0, 0, 0, 0); acc1 = __builtin_amdgcn_mfma_f32_16x16x32_bf16(bw[ks], a1[ks], acc1, 0, 0, 0); }
        red[(wave * 2 + 0) * 64 + lane] = acc0; red[(wave * 2 + 1) * 64 + lane] = acc1;
        __syncthreads();
        if (tid < 128) {
            const int rb = tid >> 6, ln = tid & 63;
            f32x4 v = red[rb * 64 + ln];
#pragma unroll
            for (int w = 1; w < 8; ++w) v += red[(w * 2 + rb) * 64 + ln];
            const int rs = 32 * rq + 16 * rb + (ln & 15), fq = ln >> 4;
            const int c = 16 * cbk + 4 * fq;
            if (MODE == 0) {
                const f32x4 h = *(const f32x4*)(base + (size_t)rs * D + c) + v;
                *(f32x4*)(Hs + (size_t)rs * D + c) = h;
                u32x2 w2; w2.x = cvt_pk_bf16(h[0], h[1]); w2.y = cvt_pk_bf16(h[2], h[3]); *(u32x2*)(HBs + (size_t)rs * D + c) = w2;
                float q = (h[0] * h[0] + h[1] * h[1]) + (h[2] * h[2] + h[3] * h[3]);
                q += __shfl_xor(q, 16); q += __shfl_xor(q, 32);
                if (fq == 0) ssq[(size_t)(MPR + rs) * 64 + cbk] = q;
            } else {
                const int which = cbk >> 6, c1 = c - which * D;
                const float rstd = pg8::row_rstd(ssq, MPR + rs, fq) * (which == 0 ? QSCALE : 1.0f);
                const f32x4 o = v * rstd;
                u32x2 w2; w2.x = cvt_pk_bf16(o[0], o[1]); w2.y = cvt_pk_bf16(o[2], o[3]);
                *(u32x2*)(QKV + (size_t)which * ((WS_K - WS_Q) / 2) + (size_t)(MPR + rs) * D + c1) = w2;
                float* fp = (which == 0) ? QS + (size_t)rs * D + c1 : out + (which == 1 ? O_SK : O_SV) + ((size_t)(rs >> 2) * LBUF + (LBUF - NST) + (rs & 3)) * D + c1;
                *(f32x4*)fp = o;
            }
        }
        __syncthreads();
    }
}

#define XB_TMO      128
#define XB_XCNT(j)  (256  + 64 * (j))
#define XB_XSUB(j)  (1280 + 64 * (j))
#define XB_XGEN(j)  (2304 + 64 * (j))
#define XB_TOP      3328
#define XB_TOPGEN   3392
#define XCD_BAR_WORDS 3456
#define XB_SPIN_CAP (1u << 18)
__device__ __forceinline__ unsigned xb_ld(unsigned* p)              { return __hip_atomic_load(p, __ATOMIC_RELAXED, __HIP_MEMORY_SCOPE_AGENT); }
__device__ __forceinline__ unsigned xb_add(unsigned* p, unsigned v) { return __hip_atomic_fetch_add(p, v, __ATOMIC_RELAXED, __HIP_MEMORY_SCOPE_AGENT); }
__device__ __forceinline__ unsigned xb_xcc_id() { return (unsigned)__builtin_amdgcn_s_getreg((3 << 11) | 20) & 0xFu; }
#define XB_SPIN(cond, bar) do { unsigned _sp = 0; while (cond) { __builtin_amdgcn_s_sleep(1); \
    if ((++_sp & 255u) == 0u) { if (xb_ld(&(bar)[XB_TMO])) break; if (_sp > XB_SPIN_CAP) { atomicAdd(&(bar)[XB_TMO], 1u); break; } } } } while (0)
__device__ __forceinline__ void xcd_barrier_complete(unsigned* bar, unsigned x, unsigned& nloc, unsigned& nx) {
    const unsigned G = gridDim.x * gridDim.y * gridDim.z;
    unsigned sum, cnt, mine, sp = 0u;
    for (;;) {
        sum = 0u; cnt = 0u; mine = 0u;
#pragma unroll
        for (unsigned j = 0; j < 16; ++j) { const unsigned c = xb_ld(&bar[XB_XCNT(j)]); sum += c; cnt += (c > 0u) ? 1u : 0u; mine = (j == x) ? c : mine; }
        if (sum == G) break;
        __builtin_amdgcn_s_sleep(1);
        if ((++sp & 255u) == 0u) { if (xb_ld(&bar[XB_TMO])) break; if (sp > XB_SPIN_CAP) { atomicAdd(&bar[XB_TMO], 1u); break; } }
    }
    nloc = mine > 0u ? mine : 1u; nx = cnt > 0u ? cnt : 1u;
}
__device__ __forceinline__ void xcd_barrier(unsigned* bar, volatile LAS unsigned* st) {
    asm volatile("s_waitcnt vmcnt(0)" ::: "memory");
    __syncthreads();
    if (threadIdx.x == 0) {
        const unsigned x = xb_xcc_id();
        __builtin_amdgcn_s_waitcnt(0);
        unsigned nloc = st[0], nx = st[1];
        if (nloc == 0u) { xcd_barrier_complete(bar, x, nloc, nx); st[0] = nloc; st[1] = nx; }
        const unsigned old = xb_add(&bar[XB_XSUB(x)], 1u);
        const unsigned gen = old / nloc;
        if (old + 1u == (gen + 1u) * nloc) {
            __builtin_amdgcn_fence(__ATOMIC_RELEASE, "agent");
            asm volatile("s_waitcnt vmcnt(0)" ::: "memory");
            const unsigned og = xb_add(&bar[XB_TOP], 1u);
            const unsigned tg = og / nx;
            if (og + 1u == (tg + 1u) * nx) xb_add(&bar[XB_TOPGEN], 1u);
            else XB_SPIN(xb_ld(&bar[XB_TOPGEN]) == tg, bar);
            __builtin_amdgcn_fence(__ATOMIC_ACQUIRE, "agent");
            xb_add(&bar[XB_XGEN(x)], 1u);
            asm volatile("s_waitcnt vmcnt(0)" ::: "memory");
        } else {
            XB_SPIN(xb_ld(&bar[XB_XGEN(x)]) == gen, bar);
            __builtin_amdgcn_fence(__ATOMIC_ACQUIRE, "agent");
            asm volatile("s_waitcnt vmcnt(0)" ::: "memory");
        }
    }
    __syncthreads();
}

typedef const __attribute__((address_space(4))) Args* kargp_t;
__device__ __forceinline__ Args kargs() {
    Args a;
#if defined(__HIP_DEVICE_COMPILE__)
    kargp_t p = (kargp_t)__builtin_amdgcn_kernarg_segment_ptr(); asm volatile("" : "+s"(p));
#pragma unroll
    for (int i = 0; i < 22; ++i) a.in[i] = p->in[i];
    a.out = p->out; a.ws = p->ws;
#else
    for (int i = 0; i < 22; ++i) a.in[i] = nullptr;
    a.out = nullptr; a.ws = nullptr;
#endif
    return a;
}
#define PHASE_BEGIN const Args a = kargs(); unsigned char* ws = a.ws; const int tid = launder_v(threadIdx.x), lane = tid & 63, wave = __builtin_amdgcn_readfirstlane(tid >> 6); \
    const int G = gridDim.x, gw = blockIdx.x * NWAVES + wave, NGW = G * NWAVES; (void)ws; (void)lane; (void)gw; (void)NGW; (void)G;
__global__ void __launch_bounds__(NTHREADS, 2) mega_fwd(Args a_unused) {
    extern __shared__ __attribute__((aligned(16))) unsigned char lds_raw[];
    LAS unsigned char* lds = (LAS unsigned char*)lds_raw;
    cg::grid_group grid = cg::this_grid();
    volatile LAS unsigned* bst = (volatile LAS unsigned*)(lds + 131072 + 64);
    { unsigned* ctl0 = (unsigned*)kargs().ws; if (threadIdx.x == 0) { bst[0] = 0u; bst[1] = 0u; (void)xb_add(&ctl0[XB_XCNT(xb_xcc_id())], 1u); } }
    __syncthreads();
#define GRID_BAR() do { unsigned* ctl_ = (unsigned*)kargs().ws; xcd_barrier(ctl_, bst); } while (0)
#ifndef PHASES
#define PHASES 0xFFFF
#endif
#define PH(k) if constexpr (((PHASES) >> (k)) & 1)
#define REP_P0 1
#define REP_P1 1
#define REP_P2 1
#define REP_P3 1
#define REP_P4 1
#define REP_P5 1
#define REP_P7 1
#define REP_P8 1
#define REP_P13 1
#define REPEAT(n) for (int rep_ = 0; rep_ < (n); ++rep_)

    REPEAT(REP_P0) { PH(0) { PHASE_BEGIN p0_prologue(a, lds, gw, NGW, lane, wave); } if (rep_ + 1 < REP_P0) { GRID_BAR(); } }
    grid.sync();
    REPEAT(REP_P1) { if (rep_) { GRID_BAR(); } PH(1) {
        PHASE_BEGIN
        pg8::Gemm g{(const bf16_t*)(ws + WS_HB), (const bf16_t*)(ws + WS_WIN), MPAD, NIN, D}; pg8::StaticOrder S; S.init(MPAD, NIN, G, (int)blockIdx.x);
        pg8::EpiInAB E{(bf16_t*)(ws + WS_GA), (const float*)(ws + WS_SSQ), a.out};
        pg8::gemm_phase<pg8::EpiInAB, pg8::StaticOrder, true, true>(lds, g, S, E);
    } }
    GRID_BAR();
    REPEAT(REP_P2) { if (rep_) { GRID_BAR(); } PH(2) { PHASE_BEGIN p2_conv(a, lds, tid, lane, wave); } }
    GRID_BAR();
    REPEAT(REP_P3) { if (rep_) { GRID_BAR(); } PH(3) {
        PHASE_BEGIN
        pg8::Gemm g{(const bf16_t*)(ws + WS_AB), (const bf16_t*)(ws + WS_WOUT), MPR, D, D}; pg8::StaticOrder S; S.init(MPR, D, G, (int)blockIdx.x);
        pg8::EpiResid E{a.in[0], a.in[1], (float*)(ws + WS_H), (bf16_t*)(ws + WS_HB), (float*)(ws + WS_SSQ)};
        pg8::gemm_phase<pg8::EpiResid, pg8::StaticOrder, true, true>(lds, g, S, E);
        sample_gemm<0, D>(lds, (const bf16_t*)(ws + WS_AB) + (size_t)MPR * D, (const bf16_t*)(ws + WS_WOUT), D, a.in[1], (float*)(ws + WS_H) + (size_t)MPR * D, (bf16_t*)(ws + WS_HB) + (size_t)MPR * D,
                          (float*)(ws + WS_SSQ), nullptr, nullptr, nullptr, tid, lane, wave);
    } }
    GRID_BAR();
#pragma clang loop unroll(disable)
    for (int layer = 0; layer < 2; ++layer) {
        if (layer == 1) {
            REPEAT(REP_P7) { if (rep_) { GRID_BAR(); } PH(7) {
                PHASE_BEGIN
                pg8::Gemm g{(const bf16_t*)(ws + WS_HB), (const bf16_t*)(ws + WS_WQKV), MPR, 3 * D, D}; pg8::StaticOrder S; S.init(MPR, 3 * D, G, (int)blockIdx.x);
                pg8::EpiQkv E{(bf16_t*)(ws + WS_Q), (float*)(ws + WS_QS), (const float*)(ws + WS_SSQ), a.out};
                pg8::gemm_phase<pg8::EpiQkv, pg8::StaticOrder, true, true>(lds, g, S, E);
                sample_gemm<1, D>(lds, (const bf16_t*)(ws + WS_HB) + (size_t)MPR * D, (const bf16_t*)(ws + WS_WQKV), 3 * D, nullptr, nullptr, nullptr,
                                  (float*)(ws + WS_SSQ), (bf16_t*)(ws + WS_Q), (float*)(ws + WS_QS), a.out, tid, lane, wave);
            } }
            GRID_BAR();
            REPEAT(REP_P8) { if (rep_) { GRID_BAR(); } PH(8) { PHASE_BEGIN p8_attention(a, lds, tid, lane, wave); } }
            GRID_BAR();
            PH(9) {
                PHASE_BEGIN
                float* H = (float*)(ws + WS_H);
                pg8::Gemm g{(const bf16_t*)(ws + WS_AB), (const bf16_t*)(ws + WS_WO), MPR, D, D}; pg8::StaticOrder S; S.init(MPR, D, G, (int)blockIdx.x);
                pg8::EpiResid E{H, H + (size_t)MPR * D, H, (bf16_t*)(ws + WS_HB), (float*)(ws + WS_SSQ)};
                pg8::gemm_phase<pg8::EpiResid, pg8::StaticOrder, true, true>(lds, g, S, E);
                sample_gemm<0, D>(lds, (const bf16_t*)(ws + WS_AB) + (size_t)MPR * D, (const bf16_t*)(ws + WS_WO), D, H + (size_t)MPR * D, H + (size_t)MPR * D, (bf16_t*)(ws + WS_HB) + (size_t)MPR * D,
                                  (float*)(ws + WS_SSQ), nullptr, nullptr, nullptr, tid, lane, wave);
            }
            GRID_BAR();
        }
        REPEAT(REP_P4) { if (rep_) { GRID_BAR(); } PH(4) {
            PHASE_BEGIN
            pg8::Gemm g{(const bf16_t*)(ws + WS_HB), (const bf16_t*)(ws + (layer ? WS_WF1 : WS_WF0)), MPAD, 2 * DFF, D}; pg8::StaticOrder S; S.init(MPAD, 2 * DFF, G, (int)blockIdx.x);
            pg8::EpiFfn E{(bf16_t*)(ws + WS_ZG), (bf16_t*)(ws + WS_ZU), (const float*)(ws + WS_SSQ), a.out, layer};
            pg8::gemm_phase<pg8::EpiFfn, pg8::StaticOrder, true, true>(lds, g, S, E);
        } }
        GRID_BAR();
        REPEAT(REP_P5) { if (rep_) { GRID_BAR(); } PH(5) { PHASE_BEGIN p5_combine(a, layer, blockIdx.x * NTHREADS + tid, G * NTHREADS); } }
        GRID_BAR();
        PH(6) {
            PHASE_BEGIN
            float* H = (float*)(ws + WS_H);
            pg8::Gemm g{(const bf16_t*)(ws + WS_U), (const bf16_t*)(ws + (layer ? WS_WD1 : WS_WD0)), MPR, D, DFF}; pg8::StaticOrder S; S.init(MPR, D, G, (int)blockIdx.x);
            pg8::EpiResid E{H, H + (size_t)MPR * D, H, (bf16_t*)(ws + WS_HB), (float*)(ws + WS_SSQ)};
            pg8::gemm_phase<pg8::EpiResid, pg8::StaticOrder, true, true>(lds, g, S, E);
            sample_gemm<0, DFF>(lds, (const bf16_t*)(ws + WS_U) + (size_t)MPR * DFF, (const bf16_t*)(ws + (layer ? WS_WD1 : WS_WD0)), D, H + (size_t)MPR * D, H + (size_t)MPR * D, (bf16_t*)(ws + WS_HB) + (size_t)MPR * D,
                                (float*)(ws + WS_SSQ), nullptr, nullptr, nullptr, tid, lane, wave);
        }
        GRID_BAR();
    }
    REPEAT(REP_P13) { if (rep_) { GRID_BAR(); } PH(13) { PHASE_BEGIN p13_final(a, gw, NGW, lane); } }
}

extern "C" void kernel_launch(void* const* d_in, const int* in_sizes, int n_in, void* d_out, int out_size, void* d_ws, size_t ws_size, hipStream_t stream) {
    static int grid = 0;
    if (grid == 0) {
        if (n_in != 22 || (size_t)out_size != O_END || ws_size < WS_END) { fprintf(stderr, "kernel_launch: unexpected shapes (n_in %d, out %d, ws %zu, need %zu)\n", n_in, out_size, ws_size, (size_t)WS_END); grid = -1; return; }
        int dev = 0, cus = 0, per_cu = 0;
        if (hipGetDevice(&dev) != hipSuccess || hipDeviceGetAttribute(&cus, hipDeviceAttributeMultiprocessorCount, dev) != hipSuccess) { grid = -1; return; }
        if (hipFuncSetAttribute((const void*)mega_fwd, hipFuncAttributeMaxDynamicSharedMemorySize, LDS_BYTES) != hipSuccess) { fprintf(stderr, "kernel_launch: hipFuncSetAttribute failed\n"); grid = -1; return; }
        if (hipOccupancyMaxActiveBlocksPerMultiprocessor(&per_cu, (const void*)mega_fwd, NTHREADS, LDS_BYTES) != hipSuccess || per_cu < 1) { fprintf(stderr, "kernel_launch: occupancy query failed (%d)\n", per_cu); (void)hipGetLastError(); grid = -1; return; }
        grid = cus * 1;
    }
    if (grid < 0) return;
    if (hipMemsetAsync((char*)d_ws + WS_CTL, 0, CTL_BYTES, stream) != hipSuccess) { fprintf(stderr, "kernel_launch: memset failed\n"); return; }
    Args a{};
    for (int i = 0; i < 22; ++i) a.in[i] = (const float*)d_in[i];
    a.out = (float*)d_out; a.ws = (unsigned char*)d_ws;
    void* args[] = {&a};
    hipError_t e = hipLaunchCooperativeKernel((const void*)mega_fwd, dim3(grid), dim3(NTHREADS), args, LDS_BYTES, stream);
    if (e != hipSuccess) fprintf(stderr, "cooperative launch failed: %s (grid %d)\n", hipGetErrorString(e), grid);
}
```

```cpp
#include <hip/hip_runtime.h>
#include <hip/hip_cooperative_groups.h>
#include <cstdio>
#include <cstdint>
namespace cg = cooperative_groups;

#define LAS __attribute__((address_space(3)))
typedef unsigned short bf16_t;
typedef short bf16x8 __attribute__((ext_vector_type(8)));
typedef float f32x4 __attribute__((ext_vector_type(4)));
typedef float f32x2 __attribute__((ext_vector_type(2)));
typedef float f32x16 __attribute__((ext_vector_type(16)));
typedef unsigned u32x4 __attribute__((ext_vector_type(4)));
typedef unsigned u32x2 __attribute__((ext_vector_type(2)));
typedef short s16x4 __attribute__((ext_vector_type(4)));

constexpr int D = 1024, SEQ = 2048, NB = 8, MPR = NB * SEQ, NSB = 32, NST = 4, MSA = NSB * NST, MTOT = MPR + MSA, MPAD = 16640;
constexpr int DFF = 2816, NIN = 2560, CH = 512, NH = 16, HD = 64, LBUF = 2048, KA = 31;
constexpr int GAW = 1536;
constexpr float RMS_EPS = 1e-6f, LN_EPS = 1e-5f;
constexpr float LOG2E = 1.4426950408889634f;
constexpr float QSCALE = 0.125f * LOG2E;

constexpr size_t O_YP = 0;
constexpr size_t O_YS = O_YP + (size_t)MPR * D;
constexpr size_t O_PCA = O_YS + (size_t)MSA * D;
constexpr size_t O_SCA = O_PCA + (size_t)NB * 30 * CH;
constexpr size_t O_PCB = O_SCA + (size_t)NSB * 30 * CH;
constexpr size_t O_SCB = O_PCB + (size_t)NB * 2 * CH;
constexpr size_t O_PK = O_SCB + (size_t)NSB * 2 * CH;
constexpr size_t O_SK = O_PK + (size_t)MPR * D;
constexpr size_t O_PV = O_SK + (size_t)NSB * LBUF * D;
constexpr size_t O_SV = O_PV + (size_t)MPR * D;
constexpr size_t O_PF = O_SV + (size_t)NSB * LBUF * D;
constexpr size_t O_SF = O_PF + (size_t)2 * NB * 2 * DFF;
constexpr size_t O_END = O_SF + (size_t)2 * NSB * 2 * DFF;

constexpr size_t al(size_t x) { return (x + 4095) & ~(size_t)4095; }
constexpr size_t WS_CTL = 0, CTL_BYTES = 65536;
constexpr size_t WS_WIN = WS_CTL + CTL_BYTES;
constexpr size_t WS_WOUT = WS_WIN + al((size_t)NIN * D * 2);
constexpr size_t WS_WQKV = WS_WOUT + al((size_t)D * D * 2);
constexpr size_t WS_WO = WS_WQKV + al((size_t)3 * D * D * 2);
constexpr size_t WS_WF0 = WS_WO + al((size_t)D * D * 2);
constexpr size_t WS_WF1 = WS_WF0 + al((size_t)2 * DFF * D * 2);
constexpr size_t WS_WD0 = WS_WF1 + al((size_t)2 * DFF * D * 2);
constexpr size_t WS_WD1 = WS_WD0 + al((size_t)D * DFF * 2);
constexpr size_t WS_HB = WS_WD1 + al((size_t)D * DFF * 2);
constexpr size_t WS_H = WS_HB + al((size_t)MPAD * D * 2);
constexpr size_t WS_SSQ = WS_H + al((size_t)MPAD * D * 4);
constexpr size_t WS_GA = WS_SSQ + al((size_t)MPAD * 64 * 4);
constexpr size_t WS_AB = WS_GA + al((size_t)MPAD * GAW * 2);
constexpr size_t WS_ZG = WS_AB + al((size_t)MPAD * D * 2);
constexpr size_t WS_ZU = WS_ZG + al((size_t)MPAD * DFF * 2);
constexpr size_t WS_U = WS_ZU + al((size_t)MPAD * DFF * 2);
constexpr size_t WS_Q = WS_U + al((size_t)MPAD * DFF * 2);
constexpr size_t WS_K = WS_Q + al((size_t)MPAD * D * 2);
constexpr size_t WS_V = WS_K + al((size_t)MPAD * D * 2);
constexpr size_t WS_QS = WS_V + al((size_t)MPAD * D * 2);
constexpr size_t WS_SG = WS_QS + al((size_t)MSA * D * 4);
constexpr size_t WS_SU = WS_SG + al((size_t)256 * 4 * DFF * 4);
constexpr size_t WS_END = WS_SU + al((size_t)256 * 2 * DFF * 4);
static_assert(WS_V - WS_K == WS_K - WS_Q, "Q|K|V equally spaced");

constexpr int NWAVES = 8, NTHREADS = 512;
constexpr int LDS_BYTES = 147456;

__device__ __forceinline__ unsigned cvt_pk_bf16(float lo, float hi) { unsigned r; asm volatile("v_cvt_pk_bf16_f32 %0, %1, %2" : "=v"(r) : "v"(lo), "v"(hi)); return r; }
__device__ __forceinline__ float bf2f(unsigned short b) { return __uint_as_float((unsigned)b << 16); }
__device__ __forceinline__ float bflo(unsigned w) { return __uint_as_float(w << 16); }
__device__ __forceinline__ float bfhi(unsigned w) { return __uint_as_float(w & 0xffff0000u); }
__device__ __forceinline__ float sigmoidf_(float x) { return __builtin_amdgcn_rcpf(1.0f + __expf(-x)); }
__device__ __forceinline__ int launder_v(int x) { asm volatile("" : "+v"(x)); return x; }
__device__ __forceinline__ float wave_sum(float v) {
#pragma unroll
    for (int o = 1; o < 64; o <<= 1) v += __shfl_xor(v, o);
    return v;
}
__device__ __forceinline__ float wave_max(float v) {
#pragma unroll
    for (int o = 1; o < 64; o <<= 1) v = fmaxf(v, __shfl_xor(v, o));
    return v;
}

namespace pg8 {
constexpr int BM = 256, BK = 64, HALF = 128, HTB = HALF * BK * 2, STAGE_BYTES = 8 * HTB, NXCD = 8, WGM = 8;
__host__ __device__ __forceinline__ int lds_byte(int r, int c) { const int st = (r >> 4) * 2 + (c >> 5), rr = r & 15, cc = c & 31, ob = rr * 64 + cc * 2; return st * 1024 + (ob ^ (((ob >> 9) & 1) << 5)); }
__host__ __device__ __forceinline__ void stage_rc(int b, int& R, int& C) { const int st = b / 1024, sb = b % 1024, swz = sb ^ (((sb >> 9) & 1) << 5); R = (st >> 1) * 16 + swz / 64; C = (st & 1) * 32 + (swz % 64) / 2; }
__host__ __device__ __forceinline__ int perm32(int rho) { const int n = rho >> 4, i = rho & 15; return 8 * (i >> 2) + 4 * n + (i & 3); }

struct Unit { int pm, pn; };
struct Gemm { const bf16_t* A; const bf16_t* Bt; int M, N, K; };

struct StaticOrder {
    int nM, nN, nwg, G, c;
    __host__ __device__ void init(int M, int N, int G_, int c_) { nM = M / BM; nN = N / BM; nwg = nM * nN; G = G_; c = c_; }
    __host__ __device__ bool next(int i, Unit& u) const {
        const long L = (long)i * G + c; if (L >= nwg) return false;
        int wgid = (int)L; { const int q = nwg / NXCD, r = nwg % NXCD, xcd = wgid % NXCD, off = wgid / NXCD; wgid = (xcd < r ? xcd * (q + 1) : r * (q + 1) + (xcd - r) * q) + off; }
        const int nig = WGM * nN, gid = wgid / nig, fm = gid * WGM, gsz = (nM - fm) < WGM ? (nM - fm) : WGM;
        u.pm = fm + ((wgid % nig) % gsz); u.pn = (wgid % nig) / gsz; return true;
    }
    __device__ __forceinline__ void a_ready(const Unit&) const {}
    __device__ __forceinline__ void done(const Unit&) const {}
};

__device__ __forceinline__ float row_rstd(const float* ssq, int r, int fq) {
    float s;
    if (r < MPR) { const f32x4 p = *(const f32x4*)(ssq + (size_t)r * 64 + 4 * fq); s = (p.x + p.y) + (p.z + p.w); }
    else { const f32x4* pp = (const f32x4*)(ssq + (size_t)r * 64 + 16 * fq); const f32x4 p = (pp[0] + pp[1]) + (pp[2] + pp[3]); s = (p.x + p.y) + (p.z + p.w); }
    s += __shfl_xor(s, 16); s += __shfl_xor(s, 32);
    return rsqrtf(s * (1.0f / D) + RMS_EPS);
}

struct EpiInAB {
    static constexpr bool PERM = true, AFTER_DRAIN = false;
    bf16_t* GA; const float* ssq; float* out;
    __device__ __forceinline__ void operator()(const f32x4 (&acc)[2][2][4][2], const Unit& u, int wr, int wc, int fr, int fq) const {
        const int pn = u.pn, colw = wc * 32 + 8 * fq;
#pragma unroll
        for (int ai = 0; ai < 2; ++ai)
#pragma unroll
            for (int m = 0; m < 4; ++m) {
                const int r = u.pm * BM + ai * HALF + wr * 64 + m * 16 + fr;
                const float rs = row_rstd(ssq, r, fq);
                const f32x4 a0 = acc[ai][0][m][0] * rs, a1 = acc[ai][0][m][1] * rs, g0 = acc[ai][1][m][0] * rs, g1 = acc[ai][1][m][1] * rs;
                bf16_t* rowp = GA + (size_t)r * GAW;
                if (pn < 8) {
                    f32x4 v0, v1;
                    if (pn < 4) {
#pragma unroll
                        for (int i = 0; i < 4; ++i) { v0[i] = a0[i] * sigmoidf_(g0[i]); v1[i] = a1[i] * sigmoidf_(g1[i]); }
                    } else { v0 = a0 * g0; v1 = a1 * g1; }
                    const int cl = 128 * (pn & 3) + colw;
                    u32x4 w; w.x = cvt_pk_bf16(v0[0], v0[1]); w.y = cvt_pk_bf16(v0[2], v0[3]); w.z = cvt_pk_bf16(v1[0], v1[1]); w.w = cvt_pk_bf16(v1[2], v1[3]);
                    *(u32x4*)(rowp + (pn < 4 ? 0 : 512) + cl) = w;
                    const int keep = pn < 4 ? 30 : 2;
                    float* sp = nullptr;
                    if (r < MPR) { const int t = r & (SEQ - 1), b = r >> 11; if (t >= SEQ - keep) sp = out + (pn < 4 ? O_PCA : O_PCB) + ((size_t)(b * keep + (t - (SEQ - keep)))) * CH + cl; }
                    else if (r < MTOT) { const int rs_ = r - MPR, sb = rs_ >> 2, j = rs_ & 3; if (j >= NST - keep || keep == 30) sp = out + (pn < 4 ? O_SCA : O_SCB) + ((size_t)(sb * keep + (keep - NST + j))) * CH + cl; }
                    if (sp) { *(f32x4*)sp = v0; *(f32x4*)(sp + 4) = v1; }
                } else {
                    const int c = 1024 + 256 * (pn - 8) + colw;
                    u32x4 w; w.x = cvt_pk_bf16(a0[0], a0[1]); w.y = cvt_pk_bf16(a0[2], a0[3]); w.z = cvt_pk_bf16(a1[0], a1[1]); w.w = cvt_pk_bf16(a1[2], a1[3]);
                    *(u32x4*)(rowp + c) = w;
                    w.x = cvt_pk_bf16(g0[0], g0[1]); w.y = cvt_pk_bf16(g0[2], g0[3]); w.z = cvt_pk_bf16(g1[0], g1[1]); w.w = cvt_pk_bf16(g1[2], g1[3]);
                    *(u32x4*)(rowp + c + 128) = w;
                }
            }
    }
};
struct EpiResid {
    static constexpr bool PERM = false, AFTER_DRAIN = false;
    const float* baseP; const float* baseS; float* H; bf16_t* HB; float* ssq;
    __device__ __forceinline__ void operator()(const f32x4 (&acc)[2][2][4][2], const Unit& u, int wr, int wc, int fr, int fq) const {
        const int col0 = u.pn * BM + wc * 32 + 4 * fq;
#pragma unroll
        for (int ai = 0; ai < 2; ++ai)
#pragma unroll
            for (int m = 0; m < 4; ++m) {
                const int r = u.pm * BM + ai * HALF + wr * 64 + m * 16 + fr;
                float s = 0.f;
                if (r < MTOT) {
                    const float* bp = (r < MPR) ? baseP + (size_t)r * D : baseS + (size_t)(r - MPR) * D;
#pragma unroll
                    for (int bj = 0; bj < 2; ++bj)
#pragma unroll
                        for (int n = 0; n < 2; ++n) {
                            const int c = col0 + bj * HALF + n * 16;
                            const f32x4 v = *(const f32x4*)(bp + c) + acc[ai][bj][m][n];
                            *(f32x4*)(H + (size_t)r * D + c) = v;
                            s += (v[0] * v[0] + v[1] * v[1]) + (v[2] * v[2] + v[3] * v[3]);
                            u32x2 w; w.x = cvt_pk_bf16(v[0], v[1]); w.y = cvt_pk_bf16(v[2], v[3]);
                            *(u32x2*)(HB + (size_t)r * D + c) = w;
                        }
                }
                s += __shfl_xor(s, 16); s += __shfl_xor(s, 32);
                if (fq == 0 && r < MTOT) ssq[(size_t)r * 64 + u.pn * 4 + wc] = s;
            }
    }
};
template <int CTRL> __device__ __forceinline__ float dpp_f(float old, float src) {
    return __uint_as_float(__builtin_amdgcn_update_dpp(__float_as_uint(old), __float_as_uint(src), CTRL, 0xf, 0xf, false)); }
struct EpiFfn {
    static constexpr bool PERM = true, AFTER_DRAIN = false;
    bf16_t* ZG; bf16_t* ZU; bf16_t* U; float* SG; float* SU; const float* wcv; const float* ssq; float* out; int layer;
    __device__ __forceinline__ void operator()(const f32x4 (&acc)[2][2][4][2], const Unit& u, int wr, int wc, int fr, int fq) const {
        const int col = u.pn * 128 + wc * 32 + 8 * fq;
        if (u.pm >= MPR / BM) {
#pragma unroll
            for (int ai = 0; ai < 2; ++ai)
#pragma unroll
                for (int m = 0; m < 4; ++m) {
                    const int r = u.pm * BM + ai * HALF + wr * 64 + m * 16 + fr;
                    const float rs = row_rstd(ssq, r, fq);
                    const f32x4 g0 = acc[ai][0][m][0] * rs, g1 = acc[ai][0][m][1] * rs, u0 = acc[ai][1][m][0] * rs, u1 = acc[ai][1][m][1] * rs;
                    u32x4 w; w.x = cvt_pk_bf16(g0[0], g0[1]); w.y = cvt_pk_bf16(g0[2], g0[3]); w.z = cvt_pk_bf16(g1[0], g1[1]); w.w = cvt_pk_bf16(g1[2], g1[3]);
                    *(u32x4*)(ZG + (size_t)r * DFF + col) = w;
                    w.x = cvt_pk_bf16(u0[0], u0[1]); w.y = cvt_pk_bf16(u0[2], u0[3]); w.z = cvt_pk_bf16(u1[0], u1[1]); w.w = cvt_pk_bf16(u1[2], u1[3]);
                    *(u32x4*)(ZU + (size_t)r * DFF + col) = w;
                    if (r < MTOT) { const int rs_ = r - MPR, sb = rs_ >> 2, j = rs_ & 3;
                        if (j >= 2) { float* sp = out + O_SF + ((size_t)((layer * NSB + sb) * 2 + (j - 2))) * DFF + col; *(f32x4*)sp = g0; *(f32x4*)(sp + 4) = g1; } }
                }
            return;
        }
        f32x4 w0[2], w1[2], w2[2];
#pragma unroll
        for (int n = 0; n < 2; ++n) { w0[n] = *(const f32x4*)(wcv + col + 4 * n); w1[n] = *(const f32x4*)(wcv + DFF + col + 4 * n); w2[n] = *(const f32x4*)(wcv + 2 * DFF + col + 4 * n); }
#pragma unroll
        for (int ai = 0; ai < 2; ++ai) {
            const int blk = u.pm * 4 + ai * 2 + wr;
            f32x4 gp[2];
            gp[0] = (f32x4){0.f, 0.f, 0.f, 0.f}; gp[1] = gp[0];
#pragma unroll
            for (int m = 0; m < 4; ++m) {
                const int r = blk * 64 + m * 16 + fr;
                const float rs = row_rstd(ssq, r, fq);
                f32x4 g[2], up[2], o[2];
#pragma unroll
                for (int n = 0; n < 2; ++n) { g[n] = acc[ai][0][m][n] * rs; up[n] = acc[ai][1][m][n] * rs; }
#pragma unroll
                for (int n = 0; n < 2; ++n)
#pragma unroll
                    for (int i = 0; i < 4; ++i) {
                        const float x1 = dpp_f<0x121>(0.f, gp[n][i]), gm1 = dpp_f<0x111>(x1, g[n][i]);
                        const float x2 = dpp_f<0x122>(0.f, gp[n][i]), gm2 = dpp_f<0x112>(x2, g[n][i]);
                        const float y = w0[n][i] * gm2 + w1[n][i] * gm1 + w2[n][i] * g[n][i];
                        o[n][i] = y * sigmoidf_(y) * up[n][i];
                    }
                const bool seam_lo = (m == 0) && (fr < 2), seam_hi = (m == 3) && (fr >= 14);
                if (!seam_lo) { u32x4 w; w.x = cvt_pk_bf16(o[0][0], o[0][1]); w.y = cvt_pk_bf16(o[0][2], o[0][3]); w.z = cvt_pk_bf16(o[1][0], o[1][1]); w.w = cvt_pk_bf16(o[1][2], o[1][3]);
                    *(u32x4*)(U + (size_t)r * DFF + col) = w; }
                else { float* sg = SG + ((size_t)blk * 4 + fr) * DFF + col; *(f32x4*)sg = g[0]; *(f32x4*)(sg + 4) = g[1];
                       float* su = SU + ((size_t)blk * 2 + fr) * DFF + col; *(f32x4*)su = up[0]; *(f32x4*)(su + 4) = up[1]; }
                if (seam_hi) { float* sg = SG + ((size_t)blk * 4 + 2 + (fr - 14)) * DFF + col; *(f32x4*)sg = g[0]; *(f32x4*)(sg + 4) = g[1];
                    const int t = r & (SEQ - 1), b = r >> 11;
                    if (t >= SEQ - 2) { float* sp = out + O_PF + ((size_t)((layer * NB + b) * 2 + (t - (SEQ - 2)))) * DFF + col; *(f32x4*)sp = g[0]; *(f32x4*)(sp + 4) = g[1]; } }
                gp[0] = g[0]; gp[1] = g[1];
            }
        }
    }
};
struct EpiQkv {
    static constexpr bool PERM = true, AFTER_DRAIN = false;
    bf16_t* QKV; float* QS; const float* ssq; float* out;
    __device__ __forceinline__ void operator()(const f32x4 (&acc)[2][2][4][2], const Unit& u, int wr, int wc, int fr, int fq) const {
        const int which = u.pn >> 2, cb = 256 * (u.pn & 3) + wc * 32 + 8 * fq;
        bf16_t* dst = QKV + (size_t)which * ((WS_K - WS_Q) / 2);
#pragma unroll
        for (int ai = 0; ai < 2; ++ai)
#pragma unroll
            for (int m = 0; m < 4; ++m) {
                const int r = u.pm * BM + ai * HALF + wr * 64 + m * 16 + fr;
                const float rs = row_rstd(ssq, r, fq) * (which == 0 ? QSCALE : 1.0f);
                float* fp = nullptr;
                if (which == 0) { if (r >= MPR && r < MTOT) fp = QS + (size_t)(r - MPR) * D; }
                else if (r < MPR) fp = out + (which == 1 ? O_PK : O_PV) + (size_t)r * D;
                else if (r < MTOT) { const int rs_ = r - MPR, sb = rs_ >> 2, j = rs_ & 3; fp = out + (which == 1 ? O_SK : O_SV) + ((size_t)sb * LBUF + (LBUF - NST) + j) * D; }
#pragma unroll
                for (int bj = 0; bj < 2; ++bj) {
                    const f32x4 v0 = acc[ai][bj][m][0] * rs, v1 = acc[ai][bj][m][1] * rs;
                    const int c = cb + bj * HALF;
                    u32x4 w; w.x = cvt_pk_bf16(v0[0], v0[1]); w.y = cvt_pk_bf16(v0[2], v0[3]); w.z = cvt_pk_bf16(v1[0], v1[1]); w.w = cvt_pk_bf16(v1[2], v1[3]);
                    *(u32x4*)(dst + (size_t)r * D + c) = w;
                    if (fp) { *(f32x4*)(fp + c) = v0; *(f32x4*)(fp + c + 4) = v1; }
                }
            }
    }
};

template <class Epi, class Sched, bool ALIGN_EPI = false, bool SP2 = false>
__device__ __forceinline__ void gemm_phase(LAS unsigned char* lds, const Gemm g, const Sched& S, const Epi& E) {
    const int tid = launder_v(threadIdx.x), wid = __builtin_amdgcn_readfirstlane(tid >> 6), lane = tid & 63, wr = wid >> 2, wc = wid & 3, fr = lane & 15, fq = lane >> 4;
    const int K = g.K, nt = K / BK;
    unsigned voffA[2], voffB[2];
#pragma unroll
    for (int i = 0; i < 2; ++i) { int R, C; stage_rc(tid * 16 + i * 8192, R, C); const int Rb = Epi::PERM ? ((R & ~31) + perm32(R & 31)) : R;
        voffA[i] = (unsigned)(R * K + C) * 2u; voffB[i] = (unsigned)(Rb * K + C) * 2u; }
    const size_t kstep = (size_t)(BK * 2);
    const size_t hstep = (size_t)HALF * K * 2;
    const size_t tstep = 2 * hstep;
    const unsigned ldsw = (unsigned)wid * 1024u;
    const int aoff = lds_byte(wr * 64 + fr, fq * 8), boff = lds_byte(wc * 32 + fr, fq * 8);
#define PG8_SA(b, h) (((b) * 2 + (h)) * HTB)
#define PG8_SB(b, h) ((4 + (b) * 2 + (h)) * HTB)
#define PG8_STAGE(bufoff, gbase, voff) do { _Pragma("unroll") for (int _i = 0; _i < 2; ++_i) \
        __builtin_amdgcn_global_load_lds((const unsigned*)((const char*)(gbase) + (voff)[_i]), (LAS unsigned*)(lds + (bufoff) + ldsw + _i * 8192), 16, 0, 0); } while (0)
#define PG8_LDA(dst, b, h) do { _Pragma("unroll") for (int m = 0; m < 4; ++m) _Pragma("unroll") for (int k = 0; k < 2; ++k) dst[m][k] = *(const LAS bf16x8*)(lds + PG8_SA(b, h) + aoff + m * 2048 + k * 1024); } while (0)
#define PG8_LDB(dst, b, h) do { _Pragma("unroll") for (int n = 0; n < 2; ++n) _Pragma("unroll") for (int k = 0; k < 2; ++k) dst[n][k] = *(const LAS bf16x8*)(lds + PG8_SB(b, h) + boff + n * 2048 + k * 1024); } while (0)
#define PG8_MMA(ai, bj, At, Bt) do { __builtin_amdgcn_s_setprio(1); _Pragma("unroll") for (int m = 0; m < 4; ++m) _Pragma("unroll") for (int n = 0; n < 2; ++n) _Pragma("unroll") for (int k = 0; k < 2; ++k) \
        acc[ai][bj][m][n] = __builtin_amdgcn_mfma_f32_16x16x32_bf16(Bt[n][k], At[m][k], acc[ai][bj][m][n], 0, 0, 0); __builtin_amdgcn_s_setprio(0); } while (0)
#define PG8_WAIT_V(n) asm volatile("s_waitcnt vmcnt(" #n ")" ::: "memory")
#define PG8_WAIT_L(n) asm volatile("s_waitcnt lgkmcnt(" #n ")" ::: "memory")
#define PG8_BAR __builtin_amdgcn_s_barrier()
#define PG8_SCHED __builtin_amdgcn_sched_barrier(0)
    Unit cur, nxt; int ui = 0;
    if (!S.next(0, cur)) return;
    f32x4 acc[2][2][4][2];
#pragma unroll
    for (int a = 0; a < 2; ++a)
#pragma unroll
        for (int b = 0; b < 2; ++b)
#pragma unroll
            for (int m = 0; m < 4; ++m)
#pragma unroll
                for (int n = 0; n < 2; ++n) acc[a][b][m][n] = (f32x4){0.f, 0.f, 0.f, 0.f};
    bf16x8 At[4][2], B0[2][2], B1[2][2];
    const char* cA = (const char*)g.A + (size_t)cur.pm * tstep; const char* cB = (const char*)g.Bt + (size_t)cur.pn * tstep;
    S.a_ready(cur);
    if constexpr (SP2) {
        PG8_STAGE(PG8_SB(0, 0), cB, voffB); PG8_STAGE(PG8_SB(0, 1), cB + hstep, voffB); PG8_STAGE(PG8_SA(0, 0), cA, voffA); PG8_STAGE(PG8_SA(0, 1), cA + hstep, voffA);
        if (wr == 1) PG8_BAR;
        PG8_WAIT_V(2); PG8_BAR;
        PG8_STAGE(PG8_SB(1, 0), cB + kstep, voffB); PG8_STAGE(PG8_SA(1, 0), cA + kstep, voffA); PG8_STAGE(PG8_SB(1, 1), cB + hstep + kstep, voffB);
        PG8_WAIT_V(6); PG8_BAR;
    } else {
        PG8_STAGE(PG8_SB(0, 0), cB, voffB); PG8_STAGE(PG8_SA(0, 0), cA, voffA); PG8_STAGE(PG8_SB(0, 1), cB + hstep, voffB); PG8_STAGE(PG8_SA(0, 1), cA + hstep, voffA);
        if (wr == 1) PG8_BAR;
        PG8_WAIT_V(4); PG8_BAR;
        PG8_STAGE(PG8_SB(1, 0), cB + kstep, voffB); PG8_STAGE(PG8_SA(1, 0), cA + kstep, voffA); PG8_STAGE(PG8_SB(1, 1), cB + hstep + kstep, voffB);
        PG8_WAIT_V(6); PG8_BAR;
    }
    for (;;) {
        const bool has_next = S.next(ui + 1, nxt);
        const char* nA = has_next ? (const char*)g.A + (size_t)nxt.pm * tstep : cA; const char* nB = has_next ? (const char*)g.Bt + (size_t)nxt.pn * tstep : cB;
        for (int t = 0; t < nt; t += 2) {
            const bool last = (t == nt - 2);
            const char* a1 = cA + (size_t)(t + 1) * kstep;
            const char* a2 = last ? nA : cA + (size_t)(t + 2) * kstep; const char* b2 = last ? nB : cB + (size_t)(t + 2) * kstep;
            const char* a3 = a2 + kstep; const char* b3 = b2 + kstep;
            if (last && has_next) S.a_ready(nxt);
            if constexpr (SP2) {
            PG8_LDB(B0, 0, 0); PG8_LDB(B1, 0, 1); PG8_SCHED; PG8_LDA(At, 0, 0); PG8_STAGE(PG8_SA(1, 1), a1 + hstep, voffA);
            PG8_WAIT_V(8); PG8_WAIT_L(0); PG8_BAR; PG8_MMA(0, 0, At, B0); PG8_MMA(0, 1, At, B1); PG8_BAR; PG8_SCHED;
            PG8_LDA(At, 0, 1); PG8_STAGE(PG8_SB(0, 0), b2, voffB); PG8_STAGE(PG8_SB(0, 1), b2 + hstep, voffB); PG8_STAGE(PG8_SA(0, 0), a2, voffA);
            PG8_WAIT_V(8); PG8_WAIT_L(0); PG8_BAR; PG8_MMA(1, 0, At, B0); PG8_MMA(1, 1, At, B1); PG8_BAR; PG8_SCHED;
            PG8_LDB(B0, 1, 0); PG8_LDB(B1, 1, 1); PG8_SCHED; PG8_LDA(At, 1, 0); PG8_STAGE(PG8_SA(0, 1), a2 + hstep, voffA);
            PG8_WAIT_V(8); PG8_WAIT_L(0); PG8_BAR; PG8_MMA(0, 0, At, B0); PG8_MMA(0, 1, At, B1); PG8_BAR; PG8_SCHED;
            PG8_LDA(At, 1, 1); PG8_STAGE(PG8_SB(1, 0), b3, voffB); PG8_STAGE(PG8_SB(1, 1), b3 + hstep, voffB); PG8_STAGE(PG8_SA(1, 0), a3, voffA);
            PG8_WAIT_V(8); PG8_WAIT_L(0); PG8_BAR; PG8_MMA(1, 0, At, B0); PG8_MMA(1, 1, At, B1); PG8_BAR; PG8_SCHED;
            } else {
            PG8_LDB(B0, 0, 0); PG8_SCHED; PG8_LDA(At, 0, 0); PG8_STAGE(PG8_SA(1, 1), a1 + hstep, voffA);
            PG8_WAIT_L(8); PG8_BAR; PG8_WAIT_L(0); PG8_MMA(0, 0, At, B0); PG8_BAR; PG8_SCHED;
            PG8_LDB(B1, 0, 1); PG8_STAGE(PG8_SB(0, 0), b2, voffB);
            PG8_BAR; PG8_WAIT_L(0); PG8_MMA(0, 1, At, B1); PG8_BAR;
            PG8_LDA(At, 0, 1); PG8_STAGE(PG8_SA(0, 0), a2, voffA);
            PG8_BAR; PG8_WAIT_L(0); PG8_MMA(1, 0, At, B0); PG8_BAR; PG8_SCHED;
            PG8_STAGE(PG8_SB(0, 1), b2 + hstep, voffB);
            PG8_WAIT_V(6); PG8_BAR; PG8_MMA(1, 1, At, B1); PG8_BAR;
            PG8_LDB(B0, 1, 0); PG8_SCHED; PG8_LDA(At, 1, 0); PG8_STAGE(PG8_SA(0, 1), a2 + hstep, voffA);
            PG8_WAIT_L(8); PG8_BAR; PG8_WAIT_L(0); PG8_MMA(0, 0, At, B0); PG8_BAR; PG8_SCHED;
            PG8_LDB(B1, 1, 1); PG8_STAGE(PG8_SB(1, 0), b3, voffB);
            PG8_BAR; PG8_WAIT_L(0); PG8_MMA(0, 1, At, B1); PG8_BAR;
            PG8_LDA(At, 1, 1); PG8_STAGE(PG8_SA(1, 0), a3, voffA);
            PG8_BAR; PG8_WAIT_L(0); PG8_MMA(1, 0, At, B0); PG8_BAR; PG8_SCHED;
            PG8_STAGE(PG8_SB(1, 1), b3 + hstep, voffB);
            PG8_WAIT_V(6); PG8_BAR; PG8_MMA(1, 1, At, B1); PG8_BAR;
            }
        }
        if constexpr (ALIGN_EPI) { if (wr == 0) PG8_BAR; }
        if constexpr (!Epi::AFTER_DRAIN) { E(acc, cur, wr, wc, fr, fq); S.done(cur); }
        if (!has_next) break;
#pragma unroll
        for (int a = 0; a < 2; ++a)
#pragma unroll
            for (int b = 0; b < 2; ++b)
#pragma unroll
                for (int m = 0; m < 4; ++m)
#pragma unroll
                    for (int n = 0; n < 2; ++n) acc[a][b][m][n] = (f32x4){0.f, 0.f, 0.f, 0.f};
        cur = nxt; cA = nA; cB = nB; ++ui;
        if constexpr (ALIGN_EPI) { if (wr == 1) PG8_BAR; }
    }
    PG8_WAIT_V(0);
    if constexpr (!ALIGN_EPI) { if (wr == 0) PG8_BAR; }
    PG8_BAR;
#undef PG8_SA
#undef PG8_SB
#undef PG8_STAGE
#undef PG8_LDA
#undef PG8_LDB
#undef PG8_MMA
#undef PG8_WAIT_V
#undef PG8_WAIT_L
#undef PG8_BAR
#undef PG8_SCHED
}
}

__device__ __forceinline__ void transpose_item(const float* W, int K, int N, bf16_t* WT, int k0, int np0, int srcn0, const float* g, LAS float* scr, int lane) {
#pragma unroll 8
    for (int i = 0; i < 32; ++i) { const int kk = 2 * i + (lane >> 5); float v = W[(size_t)(k0 + kk) * N + srcn0 + (lane & 31)]; if (g) v *= g[k0 + kk]; scr[kk * 33 + (lane & 31)] = v; }
    asm volatile("s_waitcnt lgkmcnt(0)" ::: "memory");
    const int c = lane & 7;
#pragma unroll
    for (int j = 0; j < 4; ++j) { const int n = (lane >> 3) + 8 * j; const LAS float* s = scr + (8 * c) * 33 + n;
        u32x4 o; o.x = cvt_pk_bf16(s[0 * 33], s[1 * 33]); o.y = cvt_pk_bf16(s[2 * 33], s[3 * 33]); o.z = cvt_pk_bf16(s[4 * 33], s[5 * 33]); o.w = cvt_pk_bf16(s[6 * 33], s[7 * 33]);
        *(u32x4*)(WT + (size_t)(np0 + n) * K + k0 + 8 * c) = o; }
    asm volatile("s_waitcnt lgkmcnt(0)" ::: "memory");
}
__device__ __forceinline__ int src_in_ab(int np) {
    const int pn = np >> 8, cc = np & 255, bj = cc >> 7, off = cc & 127;
    if (pn < 4) return (bj ? 512 : 0) + 128 * pn + off;
    if (pn < 8) return (bj ? 2048 : 1536) + 128 * (pn - 4) + off;
    return 1024 + 256 * (pn - 8) + cc;
}
__device__ __forceinline__ int src_ffn(int np) { const int pn = np >> 8, cc = np & 255, bj = cc >> 7, off = cc & 127; return (bj ? DFF : 0) + 128 * pn + off; }

struct Args { const float* in[22]; float* out; unsigned char* ws; };

__device__ __forceinline__ void p0_prologue(const Args& a, LAS unsigned char* lds, int gw, int NGW, int lane, int wave) {
    LAS float* scr = (LAS float*)(lds + wave * 16384);
    unsigned char* ws = a.ws;
    constexpr int I_IN = (D / 64) * (NIN / 32), I_SQ = (D / 64) * (D / 32), I_QKV = (D / 64) * (3 * D / 32), I_F = (D / 64) * (2 * DFF / 32), I_DN = (DFF / 64) * (D / 32);
    constexpr int NITEMS = I_IN + 2 * I_SQ + I_QKV + 2 * I_F + 2 * I_DN;
    for (int it = gw; it < NITEMS; it += NGW) {
        int r = it;
        if (r < I_IN) { const int nb = NIN / 32, kb = r / nb, n0 = 32 * (r % nb); transpose_item(a.in[10], D, NIN, (bf16_t*)(ws + WS_WIN), 64 * kb, n0, src_in_ab(n0), a.in[7], scr, lane); continue; } r -= I_IN;
        if (r < I_SQ) { const int nb = D / 32, kb = r / nb, n0 = 32 * (r % nb); transpose_item(a.in[16], D, D, (bf16_t*)(ws + WS_WOUT), 64 * kb, n0, n0, nullptr, scr, lane); continue; } r -= I_SQ;
        if (r < I_QKV) { const int nb = 3 * D / 32, kb = r / nb, n0 = 32 * (r % nb); transpose_item(a.in[17], D, 3 * D, (bf16_t*)(ws + WS_WQKV), 64 * kb, n0, n0, a.in[7] + D, scr, lane); continue; } r -= I_QKV;
        if (r < I_SQ) { const int nb = D / 32, kb = r / nb, n0 = 32 * (r % nb); transpose_item(a.in[18], D, D, (bf16_t*)(ws + WS_WO), 64 * kb, n0, n0, nullptr, scr, lane); continue; } r -= I_SQ;
        if (r < 2 * I_F) { const int l = r / I_F; r -= l * I_F; const int nb = 2 * DFF / 32, kb = r / nb, n0 = 32 * (r % nb);
            transpose_item(a.in[19] + (size_t)l * D * 2 * DFF, D, 2 * DFF, (bf16_t*)(ws + (l ? WS_WF1 : WS_WF0)), 64 * kb, n0, src_ffn(n0), a.in[8] + l * D, scr, lane); continue; } r -= 2 * I_F;
        { const int l = r / I_DN; r -= l * I_DN; const int nb = D / 32, kb = r / nb, n0 = 32 * (r % nb);
            transpose_item(a.in[21] + (size_t)l * DFF * D, DFF, D, (bf16_t*)(ws + (l ? WS_WD1 : WS_WD0)), 64 * kb, n0, n0, nullptr, scr, lane); }
    }
    bf16_t* HB = (bf16_t*)(ws + WS_HB); float* ssq = (float*)(ws + WS_SSQ);
    for (int r = gw; r < MPAD; r += NGW) {
        f32x4 v[4]; float s = 0.f;
        if (r < MTOT) {
            const f32x4* xr = (const f32x4*)((r < MPR) ? a.in[0] + (size_t)r * D : a.in[1] + (size_t)(r - MPR) * D) + lane;
#pragma unroll
            for (int j = 0; j < 4; ++j) { v[j] = xr[64 * j]; s += (v[j].x * v[j].x + v[j].y * v[j].y) + (v[j].z * v[j].z + v[j].w * v[j].w); }
        } else {
#pragma unroll
            for (int j = 0; j < 4; ++j) v[j] = (f32x4){0.f, 0.f, 0.f, 0.f};
        }
        s = wave_sum(s);
        u32x2* o8 = (u32x2*)(HB + (size_t)r * D) + lane;
#pragma unroll
        for (int j = 0; j < 4; ++j) { u32x2 w; w.x = cvt_pk_bf16(v[j].x, v[j].y); w.y = cvt_pk_bf16(v[j].z, v[j].w); o8[64 * j] = w; }
        if (r < MPR) { if (lane < 16) ssq[(size_t)r * 64 + lane] = (lane == 0) ? s : 0.f; } else ssq[(size_t)r * 64 + lane] = (lane == 0) ? s : 0.f;
    }
    {
        const int tot = NSB * 26 * (CH / 4);
        for (int i = gw * 64 + lane; i < tot; i += NGW * 64) { const int sb = i / (26 * (CH / 4)), rem = i % (26 * (CH / 4));
            ((f32x4*)(a.out + O_SCA + (size_t)sb * 30 * CH))[rem] = ((const f32x4*)(a.in[2] + (size_t)sb * 30 * CH + 4 * CH))[rem]; }
    }
    {
        const size_t per = (size_t)(LBUF - NST) * D / 4;
        const size_t tot = per * NSB, stride = (size_t)NGW * 64;
        for (size_t i0 = (size_t)gw * 64 + lane; i0 < tot; i0 += 4 * stride) {
            f32x4 kv[4], vv[4];
#pragma unroll
            for (int u = 0; u < 4; ++u) { const size_t i = i0 + u * stride; if (i < tot) { const size_t sb = i / per, rem = i % per;
                kv[u] = __builtin_nontemporal_load((const f32x4*)(a.in[4] + (sb * LBUF + NST) * D) + rem); vv[u] = __builtin_nontemporal_load((const f32x4*)(a.in[5] + (sb * LBUF + NST) * D) + rem); } }
#pragma unroll
            for (int u = 0; u < 4; ++u) { const size_t i = i0 + u * stride; if (i < tot) { const size_t sb = i / per, rem = i % per;
                __builtin_nontemporal_store(kv[u], (f32x4*)(a.out + O_SK + sb * LBUF * D) + rem); __builtin_nontemporal_store(vv[u], (f32x4*)(a.out + O_SV + sb * LBUF * D) + rem); } }
        }
    }
}

__device__ __forceinline__ void p2_conv(const Args& a, LAS unsigned char* lds, int tid, int lane, int wave) {
    unsigned char* ws = a.ws;
    const bf16_t* GA = (const bf16_t*)(ws + WS_GA); bf16_t* AB = (bf16_t*)(ws + WS_AB);
    LAS float* T = (LAS float*)lds;
    const float* wa = a.in[11]; const float* ba = a.in[12]; const float* lg = a.in[13]; const float* lb = a.in[14]; const float* wb = a.in[15];
    for (int u = blockIdx.x; u < 512 + NSB; u += gridDim.x) {
        const bool samp = u >= 512; const int sb = u - 512;
        const int row0 = samp ? MPR + sb * NST : u * 32, nrows = samp ? NST : 32;
        const int t0 = samp ? 0 : (row0 & (SEQ - 1));
        const int nvec = (nrows + 30) * (CH / 8);
        for (int i = tid; i < nvec; i += NTHREADS) {
            const int e = i >> 6, c = (i & 63) * 8; const int p = t0 - 30 + e;
            f32x4 v0 = (f32x4){0.f, 0.f, 0.f, 0.f}, v1 = v0;
            if (p >= 0) { const u32x4 w = *(const u32x4*)(GA + (size_t)(row0 - t0 + p) * GAW + c);
                v0 = (f32x4){bflo(w.x), bfhi(w.x), bflo(w.y), bfhi(w.y)}; v1 = (f32x4){bflo(w.z), bfhi(w.z), bflo(w.w), bfhi(w.w)}; }
            else if (samp) { const float* sp = a.in[2] + ((size_t)sb * 30 + e) * CH + c; v0 = *(const f32x4*)sp; v1 = *(const f32x4*)(sp + 4); }
            *(LAS f32x4*)(T + e * CH + c) = v0; *(LAS f32x4*)(T + e * CH + c + 4) = v1;
        }
        __syncthreads();
        if (tid < 256) {
            const int c = 2 * tid; f32x2 w[KA];
#pragma unroll
            for (int k = 0; k < KA; ++k) w[k] = *(const f32x2*)(wa + k * CH + c);
            const f32x2 bias = *(const f32x2*)(ba + c);
            for (int i = 0; i < nrows; ++i) {
                f32x2 s = bias;
#pragma unroll
                for (int k = 0; k < KA; ++k) { const f32x2 x = *(const LAS f32x2*)(T + (i + k) * CH + c); s += w[k] * x; }
                *(LAS f32x2*)(T + i * CH + c) = s;
            }
        } else {
            const int t2 = tid - 256;
            for (int i = t2; i < nrows * 64; i += 256) {
                const int rr = i >> 6, c = (i & 63) * 8; const int r = row0 + rr, p = t0 + rr;
                float x[3][8];
#pragma unroll
                for (int k = 0; k < 3; ++k) { const int pp = p - 2 + k;
                    if (pp >= 0) { const u32x4 wv = *(const u32x4*)(GA + (size_t)(r - 2 + k) * GAW + 512 + c);
                        x[k][0] = bflo(wv.x); x[k][1] = bfhi(wv.x); x[k][2] = bflo(wv.y); x[k][3] = bfhi(wv.y); x[k][4] = bflo(wv.z); x[k][5] = bfhi(wv.z); x[k][6] = bflo(wv.w); x[k][7] = bfhi(wv.w); }
                    else if (samp) { const float* sp = a.in[3] + ((size_t)sb * 2 + (pp + 2)) * CH + c;
#pragma unroll
                        for (int e = 0; e < 8; ++e) x[k][e] = sp[e]; }
                    else {
#pragma unroll
                        for (int e = 0; e < 8; ++e) x[k][e] = 0.f; } }
                const u32x4 gv = *(const u32x4*)(GA + (size_t)r * GAW + 1024 + c);
                float gb[8] = {bflo(gv.x), bfhi(gv.x), bflo(gv.y), bfhi(gv.y), bflo(gv.z), bfhi(gv.z), bflo(gv.w), bfhi(gv.w)};
                float o[8];
#pragma unroll
                for (int e = 0; e < 8; ++e) o[e] = gb[e] * (wb[0 * CH + c + e] * x[0][e] + wb[1 * CH + c + e] * x[1][e] + wb[2 * CH + c + e] * x[2][e]);
                u32x4 w4; w4.x = cvt_pk_bf16(o[0], o[1]); w4.y = cvt_pk_bf16(o[2], o[3]); w4.z = cvt_pk_bf16(o[4], o[5]); w4.w = cvt_pk_bf16(o[6], o[7]);
                *(u32x4*)(AB + (size_t)r * D + 512 + c) = w4;
            }
        }
        __syncthreads();
        for (int rr = wave; rr < nrows; rr += NWAVES) {
            const int c = lane * 8;
            const f32x4 v0 = *(const LAS f32x4*)(T + rr * CH + c), v1 = *(const LAS f32x4*)(T + rr * CH + c + 4);
            float s = (v0.x + v0.y) + (v0.z + v0.w) + (v1.x + v1.y) + (v1.z + v1.w);
            const float mu = wave_sum(s) * (1.0f / CH);
            const f32x4 d0 = v0 - mu, d1 = v1 - mu;
            float q = (d0.x * d0.x + d0.y * d0.y) + (d0.z * d0.z + d0.w * d0.w) + (d1.x * d1.x + d1.y * d1.y) + (d1.z * d1.z + d1.w * d1.w);
            const float rstd = rsqrtf(wave_sum(q) * (1.0f / CH) + LN_EPS);
            const f32x4 g0 = *(const f32x4*)(lg + c), g1 = *(const f32x4*)(lg + c + 4), b0 = *(const f32x4*)(lb + c), b1 = *(const f32x4*)(lb + c + 4);
            f32x4 a0 = d0 * rstd * g0 + b0, a1 = d1 * rstd * g1 + b1;
#pragma unroll
            for (int e = 0; e < 4; ++e) { a0[e] = a0[e] * sigmoidf_(a0[e]); a1[e] = a1[e] * sigmoidf_(a1[e]); }
            u32x4 w4; w4.x = cvt_pk_bf16(a0[0], a0[1]); w4.y = cvt_pk_bf16(a0[2], a0[3]); w4.z = cvt_pk_bf16(a1[0], a1[1]); w4.w = cvt_pk_bf16(a1[2], a1[3]);
            *(u32x4*)(AB + (size_t)(row0 + rr) * D + c) = w4;
        }
        __syncthreads();
    }
}

__device__ __forceinline__ void p5_fix(const Args& a, int layer, int gtid, int GT) {
    unsigned char* ws = a.ws;
    const bf16_t* ZG = (const bf16_t*)(ws + WS_ZG); const bf16_t* ZU = (const bf16_t*)(ws + WS_ZU); bf16_t* U = (bf16_t*)(ws + WS_U);
    const float* SG = (const float*)(ws + WS_SG); const float* SU = (const float*)(ws + WS_SU);
    const float* wc = a.in[20] + (size_t)layer * 3 * DFF;
    constexpr int NCV = DFF / 8, NBLK = MPR / 64;
    const int nit = NBLK * 2 * NCV + NSB * NCV;
    for (int it = gtid; it < nit; it += GT) {
        const bool samp = it >= NBLK * 2 * NCV;
        if (!samp) {
            const int cv = it % NCV, bj = it / NCV, blk = bj >> 1, j = bj & 1, c = cv * 8;
            const bool first = (blk & 31) == 0;
            float gm2[8], gm1[8], g0[8], up[8];
            const float* cur = SG + (size_t)blk * 4 * DFF + c; const float* prv = SG + (size_t)(blk - 1) * 4 * DFF + c;
#pragma unroll
            for (int e = 0; e < 8; ++e) {
                if (j == 0) { gm2[e] = first ? 0.f : prv[2 * DFF + e]; gm1[e] = first ? 0.f : prv[3 * DFF + e]; g0[e] = cur[e]; }
                else { gm2[e] = first ? 0.f : prv[3 * DFF + e]; gm1[e] = cur[e]; g0[e] = cur[DFF + e]; }
                up[e] = SU[((size_t)blk * 2 + j) * DFF + c + e];
            }
            float o[8];
#pragma unroll
            for (int e = 0; e < 8; ++e) { const float y = wc[c + e] * gm2[e] + wc[DFF + c + e] * gm1[e] + wc[2 * DFF + c + e] * g0[e]; o[e] = y * sigmoidf_(y) * up[e]; }
            u32x4 w4; w4.x = cvt_pk_bf16(o[0], o[1]); w4.y = cvt_pk_bf16(o[2], o[3]); w4.z = cvt_pk_bf16(o[4], o[5]); w4.w = cvt_pk_bf16(o[6], o[7]);
            *(u32x4*)(U + (size_t)(blk * 64 + j) * DFF + c) = w4;
        } else {
            const int jj = it - NBLK * 2 * NCV, sb = jj / NCV, cv = jj % NCV, c = cv * 8, r0 = MPR + sb * NST;
            float w0[8], w1[8], w2[8], gm2[8], gm1[8];
            const float* sp = a.in[6] + ((size_t)(layer * NSB + sb) * 2) * DFF + c;
#pragma unroll
            for (int e = 0; e < 8; ++e) { w0[e] = wc[c + e]; w1[e] = wc[DFF + c + e]; w2[e] = wc[2 * DFF + c + e]; gm2[e] = sp[e]; gm1[e] = sp[DFF + e]; }
            for (int i = 0; i < NST; ++i) {
                const size_t off = (size_t)(r0 + i) * DFF + c;
                const u32x4 gv = *(const u32x4*)(ZG + off), uv = *(const u32x4*)(ZU + off);
                float g[8] = {bflo(gv.x), bfhi(gv.x), bflo(gv.y), bfhi(gv.y), bflo(gv.z), bfhi(gv.z), bflo(gv.w), bfhi(gv.w)};
                float up[8] = {bflo(uv.x), bfhi(uv.x), bflo(uv.y), bfhi(uv.y), bflo(uv.z), bfhi(uv.z), bflo(uv.w), bfhi(uv.w)};
                float o[8];
#pragma unroll
                for (int e = 0; e < 8; ++e) { const float y = w0[e] * gm2[e] + w1[e] * gm1[e] + w2[e] * g[e]; o[e] = y * sigmoidf_(y) * up[e]; gm2[e] = gm1[e]; gm1[e] = g[e]; }
                u32x4 w4; w4.x = cvt_pk_bf16(o[0], o[1]); w4.y = cvt_pk_bf16(o[2], o[3]); w4.z = cvt_pk_bf16(o[4], o[5]); w4.w = cvt_pk_bf16(o[6], o[7]);
                *(u32x4*)(U + off) = w4;
            }
        }
    }
}

constexpr int AT_OACC = 0, AT_OSTR = 65, AT_ML = 256 * AT_OSTR * 4, AT_VST = AT_ML + 2048, AT_PSC = AT_VST + NWAVES * 4096;
static_assert(AT_PSC + NWAVES * 2048 <= 131072, "attention LDS");
__device__ __forceinline__ int crow(int r, int hi) { return (r & 3) + 8 * (r >> 2) + 4 * hi; }

__device__ __forceinline__ void attn_task(const bf16_t* Qh, const bf16_t* Kh, const bf16_t* Vh, int dil, int cls, int s0, int nq, float slope2, int qlbase, int qlstep, bool first,
                                          LAS unsigned char* lds, int wave, int lane) {
    const int r32 = lane & 31, hi = lane >> 5;
    const int qi = r32 < nq ? r32 : nq - 1;
    const bf16_t* qp = Qh + (size_t)(cls + dil * (s0 + qi)) * D + hi * 8;
    bf16x8 qr[4];
#pragma unroll
    for (int d0 = 0; d0 < 4; ++d0) qr[d0] = *(const bf16x8*)(qp + d0 * 16);
    float m_run = -INFINITY, l_run = 0.f; f32x16 o[2]; o[0] = f32x16{}; o[1] = f32x16{};
    LAS unsigned char* vst = lds + AT_VST + wave * 4096;
    const float sdil = slope2 * (float)dil;
    f32x16 cb;
#pragma unroll
    for (int r = 0; r < 16; ++r) cb[r] = -sdil * (float)(r32 - 4 * hi + 128 - ((r & 3) + 8 * (r >> 2)));
    const int i_first = s0 < 128 ? (128 - s0) >> 5 : 0;
    const int vb = ((lane >> 4) & 1) * 32 + (lane & 3) * 8 + (4 * hi + ((lane & 15) >> 2)) * 64;
#pragma clang loop unroll(disable)
    for (int i = 4; i >= i_first; --i) {
        const int kb = s0 - 128 + 32 * i;
        const int skv = kb + r32 < 0 ? 0 : kb + r32;
        const bf16_t* kp = Kh + (size_t)(cls + dil * skv) * D + hi * 8;
        bf16x8 kf[4];
#pragma unroll
        for (int d0 = 0; d0 < 4; ++d0) kf[d0] = *(const bf16x8*)(kp + d0 * 16);
        u32x4 vv[4];
#pragma unroll
        for (int j = 0; j < 4; ++j) { const int kv = (lane >> 3) + 8 * j; const int sv = kb + kv < 0 ? 0 : kb + kv;
            vv[j] = *(const u32x4*)(Vh + (size_t)(cls + dil * sv) * D + (lane & 7) * 8); }
        const float toff = sdil * (float)(32 * i);
        f32x16 st;
#pragma unroll
        for (int r = 0; r < 16; ++r) st[r] = cb[r] + toff;
#pragma unroll
        for (int d0 = 0; d0 < 4; ++d0) st = __builtin_amdgcn_mfma_f32_32x32x16_bf16(kf[d0], qr[d0], st, 0, 0, 0);
        asm volatile("" ::: "memory");
#pragma unroll
        for (int j = 0; j < 4; ++j) { const int kv = (lane >> 3) + 8 * j, part = lane & 7;
            *(LAS u32x4*)(vst + (part >> 2) * 2048 + (kv >> 3) * 512 + (kv & 7) * 64 + (part & 3) * 16) = vv[j]; }
        if (i == 0 || i == 4 || kb < 0) {
            int cmin = (i == 0) ? r32 : 0; cmin = cmin > -kb ? cmin : -kb; const int cmax = (i == 4) ? r32 : 31;
            const int lo_ = cmin - 4 * hi, hi_ = cmax - 4 * hi;
#pragma unroll
            for (int r = 0; r < 16; ++r) { const int c = (r & 3) + 8 * (r >> 2); st[r] = (c >= lo_ && c <= hi_) ? st[r] : -INFINITY; }
        }
        float mx = fmaxf(fmaxf(st[0], st[1]), fmaxf(st[2], st[3]));
#pragma unroll
        for (int r = 4; r < 16; r += 4) mx = fmaxf(mx, fmaxf(fmaxf(st[r], st[r + 1]), fmaxf(st[r + 2], st[r + 3])));
        { auto rr = __builtin_amdgcn_permlane32_swap(__float_as_uint(mx), __float_as_uint(mx), false, false); mx = fmaxf(__uint_as_float(rr[0]), __uint_as_float(rr[1])); }
        if (__any(mx > m_run)) {
            const float m_new = fmaxf(m_run, mx);
            const float alpha = __builtin_amdgcn_exp2f(m_run - ((m_new == -INFINITY) ? 0.f : m_new));
            l_run *= alpha; m_run = m_new;
#pragma unroll
            for (int r = 0; r < 16; ++r) { o[0][r] *= alpha; o[1][r] *= alpha; }
        }
        const float m_use = (m_run == -INFINITY) ? 0.f : m_run;
        float ps = 0.f;
#pragma unroll
        for (int r = 0; r < 16; ++r) { const float p = __builtin_amdgcn_exp2f(st[r] - m_use); st[r] = p; ps += p; }
        l_run += ps;
        bf16x8 pa[2];
#pragma unroll
        for (int s = 0; s < 2; ++s) { u32x4 w; w.x = cvt_pk_bf16(st[8 * s + 0], st[8 * s + 1]); w.y = cvt_pk_bf16(st[8 * s + 2], st[8 * s + 3]); w.z = cvt_pk_bf16(st[8 * s + 4], st[8 * s + 5]); w.w = cvt_pk_bf16(st[8 * s + 6], st[8 * s + 7]);
            pa[s] = __builtin_bit_cast(bf16x8, w); }
        asm volatile("s_waitcnt lgkmcnt(0)" ::: "memory");
#pragma unroll
        for (int d0 = 0; d0 < 2; ++d0)
#pragma unroll
            for (int s = 0; s < 2; ++s) {
                const s16x4 lo = __builtin_bit_cast(s16x4, __builtin_amdgcn_ds_read_tr16_b64_v4i16((LAS s16x4*)(vst + vb + d0 * 2048 + s * 1024)));
                const s16x4 hh = __builtin_bit_cast(s16x4, __builtin_amdgcn_ds_read_tr16_b64_v4i16((LAS s16x4*)(vst + vb + d0 * 2048 + s * 1024 + 512)));
                const bf16x8 vf = (bf16x8){lo[0], lo[1], lo[2], lo[3], hh[0], hh[1], hh[2], hh[3]};
                o[d0] = __builtin_amdgcn_mfma_f32_32x32x16_bf16(vf, pa[s], o[d0], 0, 0, 0);
            }
        asm volatile("s_waitcnt lgkmcnt(0)" ::: "memory");
    }
    { auto rr = __builtin_amdgcn_permlane32_swap(__float_as_uint(l_run), __float_as_uint(l_run), false, false); l_run = __uint_as_float(rr[0]) + __uint_as_float(rr[1]); }
    if (r32 < nq) {
        const int ql = qlbase + qlstep * r32;
        LAS float* oa = (LAS float*)(lds + AT_OACC) + ql * AT_OSTR;
        LAS float* ml = (LAS float*)(lds + AT_ML) + ql * 2;
        float a_old = 0.f, a_new = 1.f, m_new = m_run, l_new = l_run;
        if (!first) { const float m_old = ml[0], l_old = ml[1]; m_new = fmaxf(m_old, m_run); const float mu = (m_new == -INFINITY) ? 0.f : m_new;
            a_old = __builtin_amdgcn_exp2f(m_old - mu); a_new = __builtin_amdgcn_exp2f(m_run - mu); l_new = l_old * a_old + l_run * a_new; }
#pragma unroll
        for (int d0 = 0; d0 < 2; ++d0)
#pragma unroll
            for (int r = 0; r < 16; ++r) { const int d = 32 * d0 + crow(r, hi); float v = o[d0][r] * a_new; if (!first) v += oa[d] * a_old; oa[d] = v; }
        asm volatile("s_waitcnt lgkmcnt(0)" ::: "memory");
        if (hi == 0) { ml[0] = m_new; ml[1] = l_new; }
    }
}

__device__ __forceinline__ void p8_attention(const Args& a, LAS unsigned char* lds, int tid, int lane, int wave) {
    unsigned char* ws = a.ws;
    const bf16_t* Q = (const bf16_t*)(ws + WS_Q); const bf16_t* K = (const bf16_t*)(ws + WS_K); const bf16_t* V = (const bf16_t*)(ws + WS_V); bf16_t* O = (bf16_t*)(ws + WS_AB);
#ifndef NO_SAMPLE
    {
        const float* QS = (const float*)(ws + WS_QS);
        LAS float* psc = (LAS float*)(lds + AT_PSC + wave * 2048);
        for (int task = blockIdx.x * NWAVES + wave; task < NSB * NH * NST; task += gridDim.x * NWAVES) {
            const int sb = task / (NH * NST), h = (task / NST) % NH, j = task % NST;
            const float slope2 = exp2f(-0.5f * (float)(h + 1)) * LOG2E;
            const float* kc = a.in[4] + (size_t)sb * LBUF * D + h * HD; const float* vc = a.in[5] + (size_t)sb * LBUF * D + h * HD;
            const float* kn = a.out + O_SK + ((size_t)sb * LBUF + (LBUF - NST)) * D + h * HD; const float* vn = a.out + O_SV + ((size_t)sb * LBUF + (LBUF - NST)) * D + h * HD;
            const float* qrow = QS + (size_t)(sb * NST + j) * D + h * HD;
            f32x4 qv[16];
#pragma unroll
            for (int e = 0; e < 16; ++e) qv[e] = *(const f32x4*)(qrow + 4 * e);
            float mx = -INFINITY;
#pragma clang loop unroll(disable)
            for (int rd = 0; rd < 7; ++rd) {
                const int kk = rd * 64 + lane; float s = -INFINITY;
                if (kk < 387) { const int g = kk / 129, mm = kk % 129, dil = (g == 0) ? 1 : (g == 1 ? 4 : 16); const int idx = LBUF + j - mm * dil;
                    const float* kr = (idx >= LBUF) ? kn + (size_t)(idx - LBUF) * D : kc + (size_t)idx * D;
                    float acc = 0.f;
#pragma unroll
                    for (int e = 0; e < 16; ++e) { const f32x4 kx = *(const f32x4*)(kr + 4 * e); acc += (qv[e].x * kx.x + qv[e].y * kx.y) + (qv[e].z * kx.z + qv[e].w * kx.w); }
                    s = acc - slope2 * (float)(mm * dil); }
                psc[kk] = s; mx = fmaxf(mx, s);
            }
            mx = wave_max(mx);
            asm volatile("s_waitcnt lgkmcnt(0)" ::: "memory");
            float l = 0.f;
#pragma clang loop unroll(disable)
            for (int rd = 0; rd < 7; ++rd) { const float p = __builtin_amdgcn_exp2f(psc[rd * 64 + lane] - mx); l += p; psc[rd * 64 + lane] = p; }
            l = wave_sum(l);
            asm volatile("s_waitcnt lgkmcnt(0)" ::: "memory");
            const int kg = lane >> 4, dc = lane & 15;
            f32x4 acc4 = (f32x4){0.f, 0.f, 0.f, 0.f};
#pragma clang loop unroll(disable)
            for (int k0 = 0; k0 < 387; k0 += 64) {
                f32x4 vr4[16]; float pk[16];
#pragma unroll
                for (int u = 0; u < 16; ++u) { const int kk = k0 + 4 * u + kg; const int kc_ = kk < 387 ? kk : 386;
                    const int g = kc_ / 129, mm = kc_ % 129, dil = (g == 0) ? 1 : (g == 1 ? 4 : 16); const int idx = LBUF + j - mm * dil;
                    const float* vr = (idx >= LBUF) ? vn + (size_t)(idx - LBUF) * D : vc + (size_t)idx * D;
                    vr4[u] = *(const f32x4*)(vr + 4 * dc); pk[u] = kk < 387 ? psc[kc_] : 0.f; }
#pragma unroll
                for (int u = 0; u < 16; ++u) acc4 += vr4[u] * pk[u];
            }
#pragma unroll
            for (int e = 0; e < 4; ++e) { acc4[e] += __shfl_xor(acc4[e], 16); acc4[e] += __shfl_xor(acc4[e], 32); }
            const float il = __builtin_amdgcn_rcpf(l);
            if (lane < 16) { u32x2 w; w.x = cvt_pk_bf16(acc4[0] * il, acc4[1] * il); w.y = cvt_pk_bf16(acc4[2] * il, acc4[3] * il);
                *(u32x2*)(O + (size_t)(MPR + sb * NST + j) * D + h * HD + 4 * dc) = w; }
            asm volatile("s_waitcnt lgkmcnt(0)" ::: "memory");
        }
    }
#endif
    __syncthreads();
#ifndef NO_PROMPT
    const int nun = NB * NH * 8, per_round = gridDim.x;
    for (int u0 = blockIdx.x; u0 < nun; u0 += per_round) {
        int u = u0;
        if ((gridDim.x & 7) == 0 && nun % (int)gridDim.x == 0) { const int x = blockIdx.x & 7, slot = blockIdx.x >> 3, spx = gridDim.x >> 3, j = (u0 / per_round) * spx + slot; u = x * (nun >> 3) + j; }
        const int qblk = u & 7, h = (u >> 3) & 15, b = u >> 7;
        const float slope2 = exp2f(-0.5f * (float)(h + 1)) * LOG2E;
        const bf16_t* Qh = Q + (size_t)b * SEQ * D + h * HD; const bf16_t* Kh = K + (size_t)b * SEQ * D + h * HD; const bf16_t* Vh = V + (size_t)b * SEQ * D + h * HD;
#pragma clang loop unroll(disable)
        for (int tk = 0; tk < 4; ++tk) {
            int dil, cls, s0, nq, qlb, qls;
            if (tk == 0) { dil = 1; cls = 0; s0 = 256 * qblk + 32 * wave; nq = 32; qlb = 32 * wave; qls = 1; }
            else if (tk == 1) { dil = 4; cls = wave & 3; s0 = 64 * qblk + 32 * (wave >> 2); nq = 32; qlb = (wave & 3) + 128 * (wave >> 2); qls = 4; }
            else { dil = 16; cls = 2 * wave + (tk - 2); s0 = 16 * qblk; nq = 16; qlb = cls; qls = 16; }
            attn_task(Qh, Kh, Vh, dil, cls, s0, nq, slope2, qlb, qls, tk == 0, lds, wave, lane);
            if (tk != 2) __syncthreads();
        }
        {
            const int ql = tid >> 1, dh = (tid & 1) * 32;
            const LAS float* oa = (const LAS float*)(lds + AT_OACC) + ql * AT_OSTR + dh;
            const float inv = __builtin_amdgcn_rcpf(((const LAS float*)(lds + AT_ML))[ql * 2 + 1]);
            bf16_t* op = O + (size_t)(b * SEQ + 256 * qblk + ql) * D + h * HD + dh;
#pragma unroll
            for (int e = 0; e < 4; ++e) { u32x4 w; w.x = cvt_pk_bf16(oa[8 * e + 0] * inv, oa[8 * e + 1] * inv); w.y = cvt_pk_bf16(oa[8 * e + 2] * inv, oa[8 * e + 3] * inv);
                w.z = cvt_pk_bf16(oa[8 * e + 4] * inv, oa[8 * e + 5] * inv); w.w = cvt_pk_bf16(oa[8 * e + 6] * inv, oa[8 * e + 7] * inv); *(u32x4*)(op + 8 * e) = w; }
        }
        __syncthreads();
    }
#endif
}

__device__ __forceinline__ void p13_final(const Args& a, int gw, int NGW, int lane) {
    const float* H = (const float*)(a.ws + WS_H); const float* g = a.in[9];
    for (int r = gw; r < MTOT; r += NGW) {
        const f32x4* xr = (const f32x4*)(H + (size_t)r * D) + lane; f32x4 v[4]; float s = 0.f;
#pragma unroll
        for (int j = 0; j < 4; ++j) { v[j] = xr[64 * j]; s += (v[j].x * v[j].x + v[j].y * v[j].y) + (v[j].z * v[j].z + v[j].w * v[j].w); }
        const float rstd = rsqrtf(wave_sum(s) * (1.0f / D) + RMS_EPS);
        f32x4* o = (f32x4*)(a.out + (size_t)r * D) + lane;
#pragma unroll
        for (int j = 0; j < 4; ++j) o[64 * j] = v[j] * rstd * ((const f32x4*)g)[64 * j + lane];
    }
}

template <int MODE, int K>
__device__ __forceinline__ void sample_gemm(LAS unsigned char* lds, const bf16_t* A, const bf16_t* Bt, int N, const float* base, float* Hs, bf16_t* HBs, float* ssq,
                                            bf16_t* QKV, float* QS, float* out, int tid, int lane, int wave) {
    constexpr int KPW = K / 32 / 8;
    const int nitems = (N / 16) * 4;
    LAS f32x4* red = (LAS f32x4*)lds;
    for (int it = blockIdx.x; it < nitems; it += gridDim.x) {
        const int cbk = it >> 2, rq = it & 3;
        const bf16_t* bp = Bt + (size_t)(16 * cbk + (lane & 15)) * K + wave * KPW * 32 + 8 * (lane >> 4);
        const bf16_t* ap = A + (size_t)(32 * rq + (lane & 15)) * K + wave * KPW * 32 + 8 * (lane >> 4);
        bf16x8 bw[KPW], a0[KPW], a1[KPW];
#pragma unroll
        for (int ks = 0; ks < KPW; ++ks) { bw[ks] = *(const bf16x8*)(bp + ks * 32); a0[ks] = *(const bf16x8*)(ap + ks * 32); a1[ks] = *(const bf16x8*)(ap + (size_t)16 * K + ks * 32); }
        f32x4 acc0 = (f32x4){0.f, 0.f, 0.f, 0.f}, acc1 = acc0;
#pragma unroll
        for (int ks = 0; ks < KPW; ++ks) { acc0 = __builtin_amdgcn_mfma_f32_16x16x32_bf16(bw[ks], a0[ks], acc0, 0, 0, 0); acc1 = __builtin_amdgcn_mfma_f32_16x16x32_bf16(bw[ks], a1[ks], acc1, 0, 0, 0); }
        red[(wave * 2 + 0) * 64 + lane] = acc0; red[(wave * 2 + 1) * 64 + lane] = acc1;
        __syncthreads();
        if (tid < 128) {
            const int rb = tid >> 6, ln = tid & 63;
            f32x4 v = red[rb * 64 + ln];
#pragma unroll
            for (int w = 1; w < 8; ++w) v += red[(w * 2 + rb) * 64 + ln];
            const int rs = 32 * rq + 16 * rb + (ln & 15), fq = ln >> 4;
            const int c = 16 * cbk + 4 * fq;
            if (MODE == 0) {
                const f32x4 h = *(const f32x4*)(base + (size_t)rs * D + c) + v;
                *(f32x4*)(Hs + (size_t)rs * D + c) = h;
                u32x2 w2; w2.x = cvt_pk_bf16(h[0], h[1]); w2.y = cvt_pk_bf16(h[2], h[3]); *(u32x2*)(HBs + (size_t)rs * D + c) = w2;
                float q = (h[0] * h[0] + h[1] * h[1]) + (h[2] * h[2] + h[3] * h[3]);
                q += __shfl_xor(q, 16); q += __shfl_xor(q, 32);
                if (fq == 0) ssq[(size_t)(MPR + rs) * 64 + cbk] = q;
            } else {
                const int which = cbk >> 6, c1 = c - which * D;
                const float rstd = pg8::row_rstd(ssq, MPR + rs, fq) * (which == 0 ? QSCALE : 1.0f);
                const f32x4 o = v * rstd;
                u32x2 w2; w2.x = cvt_pk_bf16(o[0], o[1]); w2.y = cvt_pk_bf16(o[2], o[3]);
                *(u32x2*)(QKV + (size_t)which * ((WS_K - WS_Q) / 2) + (size_t)(MPR + rs) * D + c1) = w2;
                float* fp = (which == 0) ? QS + (size_t)rs * D + c1 : out + (which == 1 ? O_SK : O_SV) + ((size_t)(rs >> 2) * LBUF + (LBUF - NST) + (rs & 3)) * D + c1;
                *(f32x4*)fp = o;
            }
        }
        __syncthreads();
    }
}

#define XB_TMO      128
#define XB_XCNT(j)  (256  + 64 * (j))
#define XB_XSUB(j)  (1280 + 64 * (j))
#define XB_XGEN(j)  (2304 + 64 * (j))
#define XB_TOP      3328
#define XB_TOPGEN   3392
#define XCD_BAR_WORDS 3456
#define XB_SPIN_CAP (1u << 18)
__device__ __forceinline__ unsigned xb_ld(unsigned* p)              { return __hip_atomic_load(p, __ATOMIC_RELAXED, __HIP_MEMORY_SCOPE_AGENT); }
__device__ __forceinline__ unsigned xb_add(unsigned* p, unsigned v) { return __hip_atomic_fetch_add(p, v, __ATOMIC_RELAXED, __HIP_MEMORY_SCOPE_AGENT); }
__device__ __forceinline__ unsigned xb_xcc_id() { return (unsigned)__builtin_amdgcn_s_getreg((3 << 11) | 20) & 0xFu; }
#define XB_SPIN(cond, bar) do { unsigned _sp = 0; while (cond) { __builtin_amdgcn_s_sleep(1); \
    if ((++_sp & 255u) == 0u) { if (xb_ld(&(bar)[XB_TMO])) break; if (_sp > XB_SPIN_CAP) { atomicAdd(&(bar)[XB_TMO], 1u); break; } } } } while (0)
__device__ __forceinline__ void xcd_barrier_complete(unsigned* bar, unsigned x, unsigned& nloc, unsigned& nx) {
    const unsigned G = gridDim.x * gridDim.y * gridDim.z;
    unsigned sum, cnt, mine, sp = 0u;
    for (;;) {
        sum = 0u; cnt = 0u; mine = 0u;
#pragma unroll
        for (unsigned j = 0; j < 16; ++j) { const unsigned c = xb_ld(&bar[XB_XCNT(j)]); sum += c; cnt += (c > 0u) ? 1u : 0u; mine = (j == x) ? c : mine; }
        if (sum == G) break;
        __builtin_amdgcn_s_sleep(1);
        if ((++sp & 255u) == 0u) { if (xb_ld(&bar[XB_TMO])) break; if (sp > XB_SPIN_CAP) { atomicAdd(&bar[XB_TMO], 1u); break; } }
    }
    nloc = mine > 0u ? mine : 1u; nx = cnt > 0u ? cnt : 1u;
}
__device__ __forceinline__ void xcd_barrier(unsigned* bar, volatile LAS unsigned* st) {
    asm volatile("s_waitcnt vmcnt(0)" ::: "memory");
    __syncthreads();
    if (threadIdx.x == 0) {
        const unsigned x = xb_xcc_id();
        __builtin_amdgcn_s_waitcnt(0);
        unsigned nloc = st[0], nx = st[1];
        if (nloc == 0u) { xcd_barrier_complete(bar, x, nloc, nx); st[0] = nloc; st[1] = nx; }
        const unsigned old = xb_add(&bar[XB_XSUB(x)], 1u);
        const unsigned gen = old / nloc;
        if (old + 1u == (gen + 1u) * nloc) {
            __builtin_amdgcn_fence(__ATOMIC_RELEASE, "agent");
            asm volatile("s_waitcnt vmcnt(0)" ::: "memory");
            const unsigned og = xb_add(&bar[XB_TOP], 1u);
            const unsigned tg = og / nx;
            if (og + 1u == (tg + 1u) * nx) xb_add(&bar[XB_TOPGEN], 1u);
            else XB_SPIN(xb_ld(&bar[XB_TOPGEN]) == tg, bar);
            __builtin_amdgcn_fence(__ATOMIC_ACQUIRE, "agent");
            xb_add(&bar[XB_XGEN(x)], 1u);
            asm volatile("s_waitcnt vmcnt(0)" ::: "memory");
        } else {
            XB_SPIN(xb_ld(&bar[XB_XGEN(x)]) == gen, bar);
            __builtin_amdgcn_fence(__ATOMIC_ACQUIRE, "agent");
            asm volatile("s_waitcnt vmcnt(0)" ::: "memory");
        }
    }
    __syncthreads();
}

typedef const __attribute__((address_space(4))) Args* kargp_t;
__device__ __forceinline__ Args kargs() {
    Args a;
#if defined(__HIP_DEVICE_COMPILE__)
    kargp_t p = (kargp_t)__builtin_amdgcn_kernarg_segment_ptr(); asm volatile("" : "+s"(p));
#pragma unroll
    for (int i = 0; i < 22; ++i) a.in[i] = p->in[i];
    a.out = p->out; a.ws = p->ws;
#else
    for (int i = 0; i < 22; ++i) a.in[i] = nullptr;
    a.out = nullptr; a.ws = nullptr;
#endif
    return a;
}
#define PHASE_BEGIN const Args a = kargs(); unsigned char* ws = a.ws; const int tid = launder_v(threadIdx.x), lane = tid & 63, wave = __builtin_amdgcn_readfirstlane(tid >> 6); \
    const int G = gridDim.x, gw = blockIdx.x * NWAVES + wave, NGW = G * NWAVES; (void)ws; (void)lane; (void)gw; (void)NGW; (void)G;
__global__ void __launch_bounds__(NTHREADS, 2) mega_fwd(Args a_unused) {
    extern __shared__ __attribute__((aligned(16))) unsigned char lds_raw[];
    LAS unsigned char* lds = (LAS unsigned char*)lds_raw;
    cg::grid_group grid = cg::this_grid();
    volatile LAS unsigned* bst = (volatile LAS unsigned*)(lds + 131072 + 64);
    { unsigned* ctl0 = (unsigned*)kargs().ws; if (threadIdx.x == 0) { bst[0] = 0u; bst[1] = 0u; (void)xb_add(&ctl0[XB_XCNT(xb_xcc_id())], 1u); } }
    __syncthreads();
    grid.sync();
#define GRID_BAR() do { unsigned* ctl_ = (unsigned*)kargs().ws; xcd_barrier(ctl_, bst); } while (0)
#ifndef PHASES
#define PHASES 0xFFFF
#endif
#define PH(k) if constexpr (((PHASES) >> (k)) & 1)
#define REP_P0 1
#define REP_P1 1
#define REP_P2 1
#define REP_P3 1
#define REP_P4 1
#define REP_P5 1
#define REP_P6 1
#define REP_P7 1
#define REP_P8 1
#define REP_P13 1
#define REPEAT(n) for (int rep_ = 0; rep_ < (n); ++rep_)

    REPEAT(REP_P0) { PH(0) { PHASE_BEGIN p0_prologue(a, lds, gw, NGW, lane, wave); } if (rep_ + 1 < REP_P0) { GRID_BAR(); } }
    GRID_BAR();
    REPEAT(REP_P1) { if (rep_) { GRID_BAR(); } PH(1) {
        PHASE_BEGIN
        pg8::Gemm g{(const bf16_t*)(ws + WS_HB), (const bf16_t*)(ws + WS_WIN), MPAD, NIN, D}; pg8::StaticOrder S; S.init(MPAD, NIN, G, (int)blockIdx.x);
        pg8::EpiInAB E{(bf16_t*)(ws + WS_GA), (const float*)(ws + WS_SSQ), a.out};
        pg8::gemm_phase<pg8::EpiInAB, pg8::StaticOrder, true, true>(lds, g, S, E);
    } }
    GRID_BAR();
    REPEAT(REP_P2) { if (rep_) { GRID_BAR(); } PH(2) { PHASE_BEGIN p2_conv(a, lds, tid, lane, wave); } }
    GRID_BAR();
    REPEAT(REP_P3) { if (rep_) { GRID_BAR(); } PH(3) {
        PHASE_BEGIN
        pg8::Gemm g{(const bf16_t*)(ws + WS_AB), (const bf16_t*)(ws + WS_WOUT), MPR, D, D}; pg8::StaticOrder S; S.init(MPR, D, G, (int)blockIdx.x);
        pg8::EpiResid E{a.in[0], a.in[1], (float*)(ws + WS_H), (bf16_t*)(ws + WS_HB), (float*)(ws + WS_SSQ)};
        pg8::gemm_phase<pg8::EpiResid, pg8::StaticOrder, true, true>(lds, g, S, E);
        sample_gemm<0, D>(lds, (const bf16_t*)(ws + WS_AB) + (size_t)MPR * D, (const bf16_t*)(ws + WS_WOUT), D, a.in[1], (float*)(ws + WS_H) + (size_t)MPR * D, (bf16_t*)(ws + WS_HB) + (size_t)MPR * D,
                          (float*)(ws + WS_SSQ), nullptr, nullptr, nullptr, tid, lane, wave);
    } }
    GRID_BAR();
#pragma clang loop unroll(disable)
    for (int layer = 0; layer < 2; ++layer) {
        if (layer == 1) {
            REPEAT(REP_P7) { if (rep_) { GRID_BAR(); } PH(7) {
                PHASE_BEGIN
                pg8::Gemm g{(const bf16_t*)(ws + WS_HB), (const bf16_t*)(ws + WS_WQKV), MPR, 3 * D, D}; pg8::StaticOrder S; S.init(MPR, 3 * D, G, (int)blockIdx.x);
                pg8::EpiQkv E{(bf16_t*)(ws + WS_Q), (float*)(ws + WS_QS), (const float*)(ws + WS_SSQ), a.out};
                pg8::gemm_phase<pg8::EpiQkv, pg8::StaticOrder, true, true>(lds, g, S, E);
                sample_gemm<1, D>(lds, (const bf16_t*)(ws + WS_HB) + (size_t)MPR * D, (const bf16_t*)(ws + WS_WQKV), 3 * D, nullptr, nullptr, nullptr,
                                  (float*)(ws + WS_SSQ), (bf16_t*)(ws + WS_Q), (float*)(ws + WS_QS), a.out, tid, lane, wave);
            } }
            GRID_BAR();
            REPEAT(REP_P8) { if (rep_) { GRID_BAR(); } PH(8) { PHASE_BEGIN p8_attention(a, lds, tid, lane, wave); } }
            GRID_BAR();
            PH(9) {
                PHASE_BEGIN
                float* H = (float*)(ws + WS_H);
                pg8::Gemm g{(const bf16_t*)(ws + WS_AB), (const bf16_t*)(ws + WS_WO), MPR, D, D}; pg8::StaticOrder S; S.init(MPR, D, G, (int)blockIdx.x);
                pg8::EpiResid E{H, H + (size_t)MPR * D, H, (bf16_t*)(ws + WS_HB), (float*)(ws + WS_SSQ)};
                pg8::gemm_phase<pg8::EpiResid, pg8::StaticOrder, true, true>(lds, g, S, E);
                sample_gemm<0, D>(lds, (const bf16_t*)(ws + WS_AB) + (size_t)MPR * D, (const bf16_t*)(ws + WS_WO), D, H + (size_t)MPR * D, H + (size_t)MPR * D, (bf16_t*)(ws + WS_HB) + (size_t)MPR * D,
                                  (float*)(ws + WS_SSQ), nullptr, nullptr, nullptr, tid, lane, wave);
            }
            GRID_BAR();
        }
        REPEAT(REP_P4) { if (rep_) { GRID_BAR(); } PH(4) {
            PHASE_BEGIN
            pg8::Gemm g{(const bf16_t*)(ws + WS_HB), (const bf16_t*)(ws + (layer ? WS_WF1 : WS_WF0)), MPAD, 2 * DFF, D}; pg8::StaticOrder S; S.init(MPAD, 2 * DFF, G, (int)blockIdx.x);
            pg8::EpiFfn E{(bf16_t*)(ws + WS_ZG), (bf16_t*)(ws + WS_ZU), (bf16_t*)(ws + WS_U), (float*)(ws + WS_SG), (float*)(ws + WS_SU), a.in[20] + (size_t)layer * 3 * DFF, (const float*)(ws + WS_SSQ), a.out, layer};
            pg8::gemm_phase<pg8::EpiFfn, pg8::StaticOrder, true, true>(lds, g, S, E);
        } }
        GRID_BAR();
        REPEAT(REP_P5) { if (rep_) { GRID_BAR(); } PH(5) { PHASE_BEGIN p5_fix(a, layer, blockIdx.x * NTHREADS + tid, G * NTHREADS); } }
        GRID_BAR();
        REPEAT(REP_P6) { if (rep_) { GRID_BAR(); } PH(6) {
            PHASE_BEGIN
            float* H = (float*)(ws + WS_H);
            pg8::Gemm g{(const bf16_t*)(ws + WS_U), (const bf16_t*)(ws + (layer ? WS_WD1 : WS_WD0)), MPR, D, DFF}; pg8::StaticOrder S; S.init(MPR, D, G, (int)blockIdx.x);
            const bool real_ = (rep_ + 1 == REP_P6);
            pg8::EpiResid E{H, H + (size_t)MPR * D, real_ ? H : (float*)(ws + WS_GA), real_ ? (bf16_t*)(ws + WS_HB) : (bf16_t*)(ws + WS_ZG), real_ ? (float*)(ws + WS_SSQ) : (float*)(ws + WS_ZU)};
            pg8::gemm_phase<pg8::EpiResid, pg8::StaticOrder, true, true>(lds, g, S, E);
            if (real_) sample_gemm<0, DFF>(lds, (const bf16_t*)(ws + WS_U) + (size_t)MPR * DFF, (const bf16_t*)(ws + (layer ? WS_WD1 : WS_WD0)), D, H + (size_t)MPR * D, H + (size_t)MPR * D, (bf16_t*)(ws + WS_HB) + (size_t)MPR * D,
                                (float*)(ws + WS_SSQ), nullptr, nullptr, nullptr, tid, lane, wave);
        } }
        GRID_BAR();
    }
    REPEAT(REP_P13) { if (rep_) { GRID_BAR(); } PH(13) { PHASE_BEGIN p13_final(a, gw, NGW, lane); } }
}

extern "C" void kernel_launch(void* const* d_in, const int* in_sizes, int n_in, void* d_out, int out_size, void* d_ws, size_t ws_size, hipStream_t stream) {
    static int grid = 0;
    if (grid == 0) {
        if (n_in != 22 || (size_t)out_size != O_END || ws_size < WS_END) { fprintf(stderr, "kernel_launch: unexpected shapes (n_in %d, out %d, ws %zu, need %zu)\n", n_in, out_size, ws_size, (size_t)WS_END); grid = -1; return; }
        int dev = 0, cus = 0, per_cu = 0;
        if (hipGetDevice(&dev) != hipSuccess || hipDeviceGetAttribute(&cus, hipDeviceAttributeMultiprocessorCount, dev) != hipSuccess) { grid = -1; return; }
        if (hipFuncSetAttribute((const void*)mega_fwd, hipFuncAttributeMaxDynamicSharedMemorySize, LDS_BYTES) != hipSuccess) { fprintf(stderr, "kernel_launch: hipFuncSetAttribute failed\n"); grid = -1; return; }
        if (hipOccupancyMaxActiveBlocksPerMultiprocessor(&per_cu, (const void*)mega_fwd, NTHREADS, LDS_BYTES) != hipSuccess || per_cu < 1) { fprintf(stderr, "kernel_launch: occupancy query failed (%d)\n", per_cu); (void)hipGetLastError(); grid = -1; return; }
        grid = cus * 1;
    }
    if (grid < 0) return;
    if (hipMemsetAsync((char*)d_ws + WS_CTL, 0, CTL_BYTES, stream) != hipSuccess) { fprintf(stderr, "kernel_launch: memset failed\n"); return; }
    Args a{};
    for (int i = 0; i < 22; ++i) a.in[i] = (const float*)d_in[i];
    a.out = (float*)d_out; a.ws = (unsigned char*)d_ws;
    void* args[] = {&a};
    hipError_t e = hipLaunchCooperativeKernel((const void*)mega_fwd, dim3(grid), dim3(NTHREADS), args, LDS_BYTES, stream);
    if (e != hipSuccess) fprintf(stderr, "cooperative launch failed: %s (grid %d)\n", hipGetErrorString(e), grid);
}
```

```cpp
#include <hip/hip_runtime.h>
#include <hip/hip_cooperative_groups.h>
#include <cstdio>
#include <cstdint>
namespace cg = cooperative_groups;

#define LAS __attribute__((address_space(3)))
typedef unsigned short bf16_t;
typedef short bf16x8 __attribute__((ext_vector_type(8)));
typedef float f32x4 __attribute__((ext_vector_type(4)));
typedef float f32x2 __attribute__((ext_vector_type(2)));
typedef float f32x16 __attribute__((ext_vector_type(16)));
typedef unsigned u32x4 __attribute__((ext_vector_type(4)));
typedef unsigned u32x2 __attribute__((ext_vector_type(2)));
typedef short s16x4 __attribute__((ext_vector_type(4)));

constexpr int D = 1024, SEQ = 2048, NB = 8, MPR = NB * SEQ, NSB = 32, NST = 4, MSA = NSB * NST, MTOT = MPR + MSA, MPAD = 16640;
constexpr int DFF = 2816, NIN = 2560, CH = 512, NH = 16, HD = 64, LBUF = 2048, KA = 31;
constexpr int GAW = 1536;
constexpr float RMS_EPS = 1e-6f, LN_EPS = 1e-5f;
constexpr float LOG2E = 1.4426950408889634f;
constexpr float QSCALE = 0.125f * LOG2E;

constexpr size_t O_YP = 0;
constexpr size_t O_YS = O_YP + (size_t)MPR * D;
constexpr size_t O_PCA = O_YS + (size_t)MSA * D;
constexpr size_t O_SCA = O_PCA + (size_t)NB * 30 * CH;
constexpr size_t O_PCB = O_SCA + (size_t)NSB * 30 * CH;
constexpr size_t O_SCB = O_PCB + (size_t)NB * 2 * CH;
constexpr size_t O_PK = O_SCB + (size_t)NSB * 2 * CH;
constexpr size_t O_SK = O_PK + (size_t)MPR * D;
constexpr size_t O_PV = O_SK + (size_t)NSB * LBUF * D;
constexpr size_t O_SV = O_PV + (size_t)MPR * D;
constexpr size_t O_PF = O_SV + (size_t)NSB * LBUF * D;
constexpr size_t O_SF = O_PF + (size_t)2 * NB * 2 * DFF;
constexpr size_t O_END = O_SF + (size_t)2 * NSB * 2 * DFF;

constexpr size_t al(size_t x) { return (x + 4095) & ~(size_t)4095; }
constexpr size_t WS_CTL = 0, CTL_BYTES = 65536;
constexpr size_t WS_WIN = WS_CTL + CTL_BYTES;
constexpr size_t WS_WOUT = WS_WIN + al((size_t)NIN * D * 2);
constexpr size_t WS_WQKV = WS_WOUT + al((size_t)D * D * 2);
constexpr size_t WS_WO = WS_WQKV + al((size_t)3 * D * D * 2);
constexpr size_t WS_WF0 = WS_WO + al((size_t)D * D * 2);
constexpr size_t WS_WF1 = WS_WF0 + al((size_t)2 * DFF * D * 2);
constexpr size_t WS_WD0 = WS_WF1 + al((size_t)2 * DFF * D * 2);
constexpr size_t WS_WD1 = WS_WD0 + al((size_t)D * DFF * 2);
constexpr size_t WS_HB = WS_WD1 + al((size_t)D * DFF * 2);
constexpr size_t WS_H = WS_HB + al((size_t)MPAD * D * 2);
constexpr size_t WS_SSQ = WS_H + al((size_t)MPAD * D * 4);
constexpr size_t WS_GA = WS_SSQ + al((size_t)MPAD * 64 * 4);
constexpr size_t WS_AB = WS_GA + al((size_t)MPAD * GAW * 2);
constexpr size_t WS_ZG = WS_AB + al((size_t)MPAD * D * 2);
constexpr size_t WS_ZU = WS_ZG + al((size_t)MPAD * DFF * 2);
constexpr size_t WS_U = WS_ZU + al((size_t)MPAD * DFF * 2);
constexpr size_t WS_Q = WS_U + al((size_t)MPAD * DFF * 2);
constexpr size_t WS_K = WS_Q + al((size_t)MPAD * D * 2);
constexpr size_t WS_V = WS_K + al((size_t)MPAD * D * 2);
constexpr size_t WS_QS = WS_V + al((size_t)MPAD * D * 2);
constexpr size_t WS_SG = WS_QS + al((size_t)MSA * D * 4);
constexpr size_t WS_SU = WS_SG + al((size_t)256 * 4 * DFF * 4);
constexpr size_t WS_END = WS_SU + al((size_t)256 * 2 * DFF * 4);
static_assert(WS_V - WS_K == WS_K - WS_Q, "Q|K|V equally spaced");

constexpr int NWAVES = 8, NTHREADS = 512;
constexpr int LDS_BYTES = 147456;

__device__ __forceinline__ unsigned cvt_pk_bf16(float lo, float hi) { unsigned r; asm volatile("v_cvt_pk_bf16_f32 %0, %1, %2" : "=v"(r) : "v"(lo), "v"(hi)); return r; }
__device__ __forceinline__ float bf2f(unsigned short b) { return __uint_as_float((unsigned)b << 16); }
__device__ __forceinline__ float bflo(unsigned w) { return __uint_as_float(w << 16); }
__device__ __forceinline__ float bfhi(unsigned w) { return __uint_as_float(w & 0xffff0000u); }
__device__ __forceinline__ float sigmoidf_(float x) { return __builtin_amdgcn_rcpf(1.0f + __expf(-x)); }
__device__ __forceinline__ int launder_v(int x) { asm volatile("" : "+v"(x)); return x; }
template <int CTRL> __device__ __forceinline__ float dppmov(float v) { return __uint_as_float(__builtin_amdgcn_update_dpp(0u, __float_as_uint(v), CTRL, 0xf, 0xf, true)); }
__device__ __forceinline__ float wave_sum(float v) {
    v += dppmov<0xB1>(v);
    v += dppmov<0x4E>(v);
    v += dppmov<0x141>(v);
    v += dppmov<0x140>(v);
    { auto r = __builtin_amdgcn_permlane16_swap(__float_as_uint(v), __float_as_uint(v), false, false); v = __uint_as_float(r[0]) + __uint_as_float(r[1]); }
    { auto r = __builtin_amdgcn_permlane32_swap(__float_as_uint(v), __float_as_uint(v), false, false); v = __uint_as_float(r[0]) + __uint_as_float(r[1]); }
    return v;
}
__device__ __forceinline__ float wave_max(float v) {
    v = fmaxf(v, dppmov<0xB1>(v)); v = fmaxf(v, dppmov<0x4E>(v)); v = fmaxf(v, dppmov<0x141>(v)); v = fmaxf(v, dppmov<0x140>(v));
    { auto r = __builtin_amdgcn_permlane16_swap(__float_as_uint(v), __float_as_uint(v), false, false); v = fmaxf(__uint_as_float(r[0]), __uint_as_float(r[1])); }
    { auto r = __builtin_amdgcn_permlane32_swap(__float_as_uint(v), __float_as_uint(v), false, false); v = fmaxf(__uint_as_float(r[0]), __uint_as_float(r[1])); }
    return v;
}

namespace pg8 {
constexpr int BM = 256, BK = 64, HALF = 128, HTB = HALF * BK * 2, STAGE_BYTES = 8 * HTB, NXCD = 8, WGM = 8;
__host__ __device__ __forceinline__ int lds_byte(int r, int c) { const int st = (r >> 4) * 2 + (c >> 5), rr = r & 15, cc = c & 31, ob = rr * 64 + cc * 2; return st * 1024 + (ob ^ (((ob >> 9) & 1) << 5)); }
__host__ __device__ __forceinline__ void stage_rc(int b, int& R, int& C) { const int st = b / 1024, sb = b % 1024, swz = sb ^ (((sb >> 9) & 1) << 5); R = (st >> 1) * 16 + swz / 64; C = (st & 1) * 32 + (swz % 64) / 2; }
__host__ __device__ __forceinline__ int perm32(int rho) { const int n = rho >> 4, i = rho & 15; return 8 * (i >> 2) + 4 * n + (i & 3); }

struct Unit { int pm, pn; };
struct Gemm { const bf16_t* A; const bf16_t* Bt; int M, N, K; };

struct StaticOrder {
    int nM, nN, nwg, G, c;
    __host__ __device__ void init(int M, int N, int G_, int c_) { nM = M / BM; nN = N / BM; nwg = nM * nN; G = G_; c = c_; }
    __host__ __device__ bool next(int i, Unit& u) const {
        const long L = (long)i * G + c; if (L >= nwg) return false;
        int wgid = (int)L; { const int q = nwg / NXCD, r = nwg % NXCD, xcd = wgid % NXCD, off = wgid / NXCD; wgid = (xcd < r ? xcd * (q + 1) : r * (q + 1) + (xcd - r) * q) + off; }
        const int nig = WGM * nN, gid = wgid / nig, fm = gid * WGM, gsz = (nM - fm) < WGM ? (nM - fm) : WGM;
        u.pm = fm + ((wgid % nig) % gsz); u.pn = (wgid % nig) / gsz; return true;
    }
    __device__ __forceinline__ void a_ready(const Unit&) const {}
    __device__ __forceinline__ void done(const Unit&) const {}
};

__device__ __forceinline__ float row_rstd(const float* ssq, int r, int fq) {
    float s;
    if (r < MPR) { const f32x4 p = *(const f32x4*)(ssq + (size_t)r * 64 + 4 * fq); s = (p.x + p.y) + (p.z + p.w); }
    else { const f32x4* pp = (const f32x4*)(ssq + (size_t)r * 64 + 16 * fq); const f32x4 p = (pp[0] + pp[1]) + (pp[2] + pp[3]); s = (p.x + p.y) + (p.z + p.w); }
    s += __shfl_xor(s, 16); s += __shfl_xor(s, 32);
    return rsqrtf(s * (1.0f / D) + RMS_EPS);
}

struct EpiInAB {
    static constexpr bool PERM = true, AFTER_DRAIN = false;
    bf16_t* GA; const float* ssq; float* out;
    __device__ __forceinline__ void operator()(const f32x4 (&acc)[2][2][4][2], const Unit& u, int wr, int wc, int fr, int fq) const {
        const int pn = u.pn, colw = wc * 32 + 8 * fq;
#pragma unroll
        for (int ai = 0; ai < 2; ++ai)
#pragma unroll
            for (int m = 0; m < 4; ++m) {
                const int r = u.pm * BM + ai * HALF + wr * 64 + m * 16 + fr;
                const float rs = row_rstd(ssq, r, fq);
                const f32x4 a0 = acc[ai][0][m][0] * rs, a1 = acc[ai][0][m][1] * rs, g0 = acc[ai][1][m][0] * rs, g1 = acc[ai][1][m][1] * rs;
                bf16_t* rowp = GA + (size_t)r * GAW;
                if (pn < 8) {
                    f32x4 v0, v1;
                    if (pn < 4) {
#pragma unroll
                        for (int i = 0; i < 4; ++i) { v0[i] = a0[i] * sigmoidf_(g0[i]); v1[i] = a1[i] * sigmoidf_(g1[i]); }
                    } else { v0 = a0 * g0; v1 = a1 * g1; }
                    const int cl = 128 * (pn & 3) + colw;
                    u32x4 w; w.x = cvt_pk_bf16(v0[0], v0[1]); w.y = cvt_pk_bf16(v0[2], v0[3]); w.z = cvt_pk_bf16(v1[0], v1[1]); w.w = cvt_pk_bf16(v1[2], v1[3]);
                    *(u32x4*)(rowp + (pn < 4 ? 0 : 512) + cl) = w;
                    const int keep = pn < 4 ? 30 : 2;
                    float* sp = nullptr;
                    if (r < MPR) { const int t = r & (SEQ - 1), b = r >> 11; if (t >= SEQ - keep) sp = out + (pn < 4 ? O_PCA : O_PCB) + ((size_t)(b * keep + (t - (SEQ - keep)))) * CH + cl; }
                    else if (r < MTOT) { const int rs_ = r - MPR, sb = rs_ >> 2, j = rs_ & 3; if (j >= NST - keep || keep == 30) sp = out + (pn < 4 ? O_SCA : O_SCB) + ((size_t)(sb * keep + (keep - NST + j))) * CH + cl; }
                    if (sp) { *(f32x4*)sp = v0; *(f32x4*)(sp + 4) = v1; }
                } else {
                    const int c = 1024 + 256 * (pn - 8) + colw;
                    u32x4 w; w.x = cvt_pk_bf16(a0[0], a0[1]); w.y = cvt_pk_bf16(a0[2], a0[3]); w.z = cvt_pk_bf16(a1[0], a1[1]); w.w = cvt_pk_bf16(a1[2], a1[3]);
                    *(u32x4*)(rowp + c) = w;
                    w.x = cvt_pk_bf16(g0[0], g0[1]); w.y = cvt_pk_bf16(g0[2], g0[3]); w.z = cvt_pk_bf16(g1[0], g1[1]); w.w = cvt_pk_bf16(g1[2], g1[3]);
                    *(u32x4*)(rowp + c + 128) = w;
                }
            }
    }
};
struct EpiResid {
    static constexpr bool PERM = false, AFTER_DRAIN = false;
    const float* baseP; const float* baseS; float* H; bf16_t* HB; float* ssq;
    __device__ __forceinline__ void operator()(const f32x4 (&acc)[2][2][4][2], const Unit& u, int wr, int wc, int fr, int fq) const {
        const int col0 = u.pn * BM + wc * 32 + 4 * fq;
#pragma unroll
        for (int ai = 0; ai < 2; ++ai)
#pragma unroll
            for (int m = 0; m < 4; ++m) {
                const int r = u.pm * BM + ai * HALF + wr * 64 + m * 16 + fr;
                float s = 0.f;
                if (r < MTOT) {
                    const float* bp = (r < MPR) ? baseP + (size_t)r * D : baseS + (size_t)(r - MPR) * D;
#pragma unroll
                    for (int bj = 0; bj < 2; ++bj)
#pragma unroll
                        for (int n = 0; n < 2; ++n) {
                            const int c = col0 + bj * HALF + n * 16;
                            const f32x4 v = *(const f32x4*)(bp + c) + acc[ai][bj][m][n];
                            *(f32x4*)(H + (size_t)r * D + c) = v;
                            s += (v[0] * v[0] + v[1] * v[1]) + (v[2] * v[2] + v[3] * v[3]);
                            u32x2 w; w.x = cvt_pk_bf16(v[0], v[1]); w.y = cvt_pk_bf16(v[2], v[3]);
                            *(u32x2*)(HB + (size_t)r * D + c) = w;
                        }
                }
                s += __shfl_xor(s, 16); s += __shfl_xor(s, 32);
                if (fq == 0 && r < MTOT) ssq[(size_t)r * 64 + u.pn * 4 + wc] = s;
            }
    }
};
template <int CTRL> __device__ __forceinline__ float dpp_f(float old, float src) {
    return __uint_as_float(__builtin_amdgcn_update_dpp(__float_as_uint(old), __float_as_uint(src), CTRL, 0xf, 0xf, false)); }
struct EpiFfn {
    static constexpr bool PERM = true, AFTER_DRAIN = false;
    bf16_t* ZG; bf16_t* ZU; bf16_t* U; float* SG; float* SU; const float* wcv; const float* ssq; float* out; int layer;
    __device__ __forceinline__ void operator()(const f32x4 (&acc)[2][2][4][2], const Unit& u, int wr, int wc, int fr, int fq) const {
        const int col = u.pn * 128 + wc * 32 + 8 * fq;
        if (u.pm >= MPR / BM) {
#pragma unroll
            for (int ai = 0; ai < 2; ++ai)
#pragma unroll
                for (int m = 0; m < 4; ++m) {
                    const int r = u.pm * BM + ai * HALF + wr * 64 + m * 16 + fr;
                    const float rs = row_rstd(ssq, r, fq);
                    const f32x4 g0 = acc[ai][0][m][0] * rs, g1 = acc[ai][0][m][1] * rs, u0 = acc[ai][1][m][0] * rs, u1 = acc[ai][1][m][1] * rs;
                    u32x4 w; w.x = cvt_pk_bf16(g0[0], g0[1]); w.y = cvt_pk_bf16(g0[2], g0[3]); w.z = cvt_pk_bf16(g1[0], g1[1]); w.w = cvt_pk_bf16(g1[2], g1[3]);
                    *(u32x4*)(ZG + (size_t)r * DFF + col) = w;
                    w.x = cvt_pk_bf16(u0[0], u0[1]); w.y = cvt_pk_bf16(u0[2], u0[3]); w.z = cvt_pk_bf16(u1[0], u1[1]); w.w = cvt_pk_bf16(u1[2], u1[3]);
                    *(u32x4*)(ZU + (size_t)r * DFF + col) = w;
                    if (r < MTOT) { const int rs_ = r - MPR, sb = rs_ >> 2, j = rs_ & 3;
                        if (j >= 2) { float* sp = out + O_SF + ((size_t)((layer * NSB + sb) * 2 + (j - 2))) * DFF + col; *(f32x4*)sp = g0; *(f32x4*)(sp + 4) = g1; } }
                }
            return;
        }
        f32x4 w0[2], w1[2], w2[2];
#pragma unroll
        for (int n = 0; n < 2; ++n) { w0[n] = *(const f32x4*)(wcv + col + 4 * n); w1[n] = *(const f32x4*)(wcv + DFF + col + 4 * n); w2[n] = *(const f32x4*)(wcv + 2 * DFF + col + 4 * n); }
#pragma unroll
        for (int ai = 0; ai < 2; ++ai) {
            const int blk = u.pm * 4 + ai * 2 + wr;
            f32x4 gp[2];
            gp[0] = (f32x4){0.f, 0.f, 0.f, 0.f}; gp[1] = gp[0];
#pragma unroll
            for (int m = 0; m < 4; ++m) {
                const int r = blk * 64 + m * 16 + fr;
                const float rs = row_rstd(ssq, r, fq);
                f32x4 g[2], up[2], o[2];
#pragma unroll
                for (int n = 0; n < 2; ++n) { g[n] = acc[ai][0][m][n] * rs; up[n] = acc[ai][1][m][n] * rs; }
#pragma unroll
                for (int n = 0; n < 2; ++n)
#pragma unroll
                    for (int i = 0; i < 4; ++i) {
                        const float x1 = dpp_f<0x121>(0.f, gp[n][i]), gm1 = dpp_f<0x111>(x1, g[n][i]);
                        const float x2 = dpp_f<0x122>(0.f, gp[n][i]), gm2 = dpp_f<0x112>(x2, g[n][i]);
                        const float y = w0[n][i] * gm2 + w1[n][i] * gm1 + w2[n][i] * g[n][i];
                        o[n][i] = y * sigmoidf_(y) * up[n][i];
                    }
                const bool seam_lo = (m == 0) && (fr < 2), seam_hi = (m == 3) && (fr >= 14);
                if (!seam_lo) { u32x4 w; w.x = cvt_pk_bf16(o[0][0], o[0][1]); w.y = cvt_pk_bf16(o[0][2], o[0][3]); w.z = cvt_pk_bf16(o[1][0], o[1][1]); w.w = cvt_pk_bf16(o[1][2], o[1][3]);
                    *(u32x4*)(U + (size_t)r * DFF + col) = w; }
                else { float* sg = SG + ((size_t)blk * 4 + fr) * DFF + col; *(f32x4*)sg = g[0]; *(f32x4*)(sg + 4) = g[1];
                       float* su = SU + ((size_t)blk * 2 + fr) * DFF + col; *(f32x4*)su = up[0]; *(f32x4*)(su + 4) = up[1]; }
                if (seam_hi) { float* sg = SG + ((size_t)blk * 4 + 2 + (fr - 14)) * DFF + col; *(f32x4*)sg = g[0]; *(f32x4*)(sg + 4) = g[1];
                    const int t = r & (SEQ - 1), b = r >> 11;
                    if (t >= SEQ - 2) { float* sp = out + O_PF + ((size_t)((layer * NB + b) * 2 + (t - (SEQ - 2)))) * DFF + col; *(f32x4*)sp = g[0]; *(f32x4*)(sp + 4) = g[1]; } }
                gp[0] = g[0]; gp[1] = g[1];
            }
        }
    }
};
struct EpiQkv {
    static constexpr bool PERM = true, AFTER_DRAIN = false;
    bf16_t* QKV; float* QS; const float* ssq; float* out;
    __device__ __forceinline__ void operator()(const f32x4 (&acc)[2][2][4][2], const Unit& u, int wr, int wc, int fr, int fq) const {
        const int which = u.pn >> 2, cb = 256 * (u.pn & 3) + wc * 32 + 8 * fq;
        bf16_t* dst = QKV + (size_t)which * ((WS_K - WS_Q) / 2);
#pragma unroll
        for (int ai = 0; ai < 2; ++ai)
#pragma unroll
            for (int m = 0; m < 4; ++m) {
                const int r = u.pm * BM + ai * HALF + wr * 64 + m * 16 + fr;
                const float rs = row_rstd(ssq, r, fq) * (which == 0 ? QSCALE : 1.0f);
                float* fp = nullptr;
                if (which == 0) { if (r >= MPR && r < MTOT) fp = QS + (size_t)(r - MPR) * D; }
                else if (r < MPR) fp = out + (which == 1 ? O_PK : O_PV) + (size_t)r * D;
                else if (r < MTOT) { const int rs_ = r - MPR, sb = rs_ >> 2, j = rs_ & 3; fp = out + (which == 1 ? O_SK : O_SV) + ((size_t)sb * LBUF + (LBUF - NST) + j) * D; }
#pragma unroll
                for (int bj = 0; bj < 2; ++bj) {
                    const f32x4 v0 = acc[ai][bj][m][0] * rs, v1 = acc[ai][bj][m][1] * rs;
                    const int c = cb + bj * HALF;
                    u32x4 w; w.x = cvt_pk_bf16(v0[0], v0[1]); w.y = cvt_pk_bf16(v0[2], v0[3]); w.z = cvt_pk_bf16(v1[0], v1[1]); w.w = cvt_pk_bf16(v1[2], v1[3]);
                    *(u32x4*)(dst + (size_t)r * D + c) = w;
                    if (fp) { *(f32x4*)(fp + c) = v0; *(f32x4*)(fp + c + 4) = v1; }
                }
            }
    }
};

template <class Epi, class Sched, bool ALIGN_EPI = false, bool SP2 = false>
__device__ __forceinline__ void gemm_phase(LAS unsigned char* lds, const Gemm g, const Sched& S, const Epi& E) {
    const int tid = launder_v(threadIdx.x), wid = __builtin_amdgcn_readfirstlane(tid >> 6), lane = tid & 63, wr = wid >> 2, wc = wid & 3, fr = lane & 15, fq = lane >> 4;
    const int K = g.K, nt = K / BK;
    unsigned voffA[2], voffB[2];
#pragma unroll
    for (int i = 0; i < 2; ++i) { int R, C; stage_rc(tid * 16 + i * 8192, R, C); const int Rb = Epi::PERM ? ((R & ~31) + perm32(R & 31)) : R;
        voffA[i] = (unsigned)(R * K + C) * 2u; voffB[i] = (unsigned)(Rb * K + C) * 2u; }
    const size_t kstep = (size_t)(BK * 2);
    const size_t hstep = (size_t)HALF * K * 2;
    const size_t tstep = 2 * hstep;
    const unsigned ldsw = (unsigned)wid * 1024u;
    const int aoff = lds_byte(wr * 64 + fr, fq * 8), boff = lds_byte(wc * 32 + fr, fq * 8);
#define PG8_SA(b, h) (((b) * 2 + (h)) * HTB)
#define PG8_SB(b, h) ((4 + (b) * 2 + (h)) * HTB)
#define PG8_STAGE(bufoff, gbase, voff) do { _Pragma("unroll") for (int _i = 0; _i < 2; ++_i) \
        __builtin_amdgcn_global_load_lds((const unsigned*)((const char*)(gbase) + (voff)[_i]), (LAS unsigned*)(lds + (bufoff) + ldsw + _i * 8192), 16, 0, 0); } while (0)
#define PG8_LDA(dst, b, h) do { _Pragma("unroll") for (int m = 0; m < 4; ++m) _Pragma("unroll") for (int k = 0; k < 2; ++k) dst[m][k] = *(const LAS bf16x8*)(lds + PG8_SA(b, h) + aoff + m * 2048 + k * 1024); } while (0)
#define PG8_LDB(dst, b, h) do { _Pragma("unroll") for (int n = 0; n < 2; ++n) _Pragma("unroll") for (int k = 0; k < 2; ++k) dst[n][k] = *(const LAS bf16x8*)(lds + PG8_SB(b, h) + boff + n * 2048 + k * 1024); } while (0)
#define PG8_MMA(ai, bj, At, Bt) do { __builtin_amdgcn_s_setprio(1); _Pragma("unroll") for (int m = 0; m < 4; ++m) _Pragma("unroll") for (int n = 0; n < 2; ++n) _Pragma("unroll") for (int k = 0; k < 2; ++k) \
        acc[ai][bj][m][n] = __builtin_amdgcn_mfma_f32_16x16x32_bf16(Bt[n][k], At[m][k], acc[ai][bj][m][n], 0, 0, 0); __builtin_amdgcn_s_setprio(0); } while (0)
#define PG8_WAIT_V(n) asm volatile("s_waitcnt vmcnt(" #n ")" ::: "memory")
#define PG8_WAIT_L(n) asm volatile("s_waitcnt lgkmcnt(" #n ")" ::: "memory")
#define PG8_BAR __builtin_amdgcn_s_barrier()
#define PG8_SCHED __builtin_amdgcn_sched_barrier(0)
    Unit cur, nxt; int ui = 0;
    if (!S.next(0, cur)) return;
    f32x4 acc[2][2][4][2];
#pragma unroll
    for (int a = 0; a < 2; ++a)
#pragma unroll
        for (int b = 0; b < 2; ++b)
#pragma unroll
            for (int m = 0; m < 4; ++m)
#pragma unroll
                for (int n = 0; n < 2; ++n) acc[a][b][m][n] = (f32x4){0.f, 0.f, 0.f, 0.f};
    bf16x8 At[4][2], B0[2][2], B1[2][2];
    const char* cA = (const char*)g.A + (size_t)cur.pm * tstep; const char* cB = (const char*)g.Bt + (size_t)cur.pn * tstep;
    S.a_ready(cur);
    if constexpr (SP2) {
        PG8_STAGE(PG8_SB(0, 0), cB, voffB); PG8_STAGE(PG8_SB(0, 1), cB + hstep, voffB); PG8_STAGE(PG8_SA(0, 0), cA, voffA); PG8_STAGE(PG8_SA(0, 1), cA + hstep, voffA);
        if (wr == 1) PG8_BAR;
        PG8_WAIT_V(2); PG8_BAR;
        PG8_STAGE(PG8_SB(1, 0), cB + kstep, voffB); PG8_STAGE(PG8_SA(1, 0), cA + kstep, voffA); PG8_STAGE(PG8_SB(1, 1), cB + hstep + kstep, voffB);
        PG8_WAIT_V(6); PG8_BAR;
    } else {
        PG8_STAGE(PG8_SB(0, 0), cB, voffB); PG8_STAGE(PG8_SA(0, 0), cA, voffA); PG8_STAGE(PG8_SB(0, 1), cB + hstep, voffB); PG8_STAGE(PG8_SA(0, 1), cA + hstep, voffA);
        if (wr == 1) PG8_BAR;
        PG8_WAIT_V(4); PG8_BAR;
        PG8_STAGE(PG8_SB(1, 0), cB + kstep, voffB); PG8_STAGE(PG8_SA(1, 0), cA + kstep, voffA); PG8_STAGE(PG8_SB(1, 1), cB + hstep + kstep, voffB);
        PG8_WAIT_V(6); PG8_BAR;
    }
    for (;;) {
        const bool has_next = S.next(ui + 1, nxt);
        const char* nA = has_next ? (const char*)g.A + (size_t)nxt.pm * tstep : cA; const char* nB = has_next ? (const char*)g.Bt + (size_t)nxt.pn * tstep : cB;
        for (int t = 0; t < nt; t += 2) {
            const bool last = (t == nt - 2);
            const char* a1 = cA + (size_t)(t + 1) * kstep;
            const char* a2 = last ? nA : cA + (size_t)(t + 2) * kstep; const char* b2 = last ? nB : cB + (size_t)(t + 2) * kstep;
            const char* a3 = a2 + kstep; const char* b3 = b2 + kstep;
            if (last && has_next) S.a_ready(nxt);
            if constexpr (SP2) {
            PG8_LDB(B0, 0, 0); PG8_LDB(B1, 0, 1); PG8_SCHED; PG8_LDA(At, 0, 0); PG8_STAGE(PG8_SA(1, 1), a1 + hstep, voffA);
            PG8_WAIT_V(8); PG8_WAIT_L(0); PG8_BAR; PG8_MMA(0, 0, At, B0); PG8_MMA(0, 1, At, B1); PG8_BAR; PG8_SCHED;
            PG8_LDA(At, 0, 1); PG8_STAGE(PG8_SB(0, 0), b2, voffB); PG8_STAGE(PG8_SB(0, 1), b2 + hstep, voffB); PG8_STAGE(PG8_SA(0, 0), a2, voffA);
            PG8_WAIT_V(8); PG8_WAIT_L(0); PG8_BAR; PG8_MMA(1, 0, At, B0); PG8_MMA(1, 1, At, B1); PG8_BAR; PG8_SCHED;
            PG8_LDB(B0, 1, 0); PG8_LDB(B1, 1, 1); PG8_SCHED; PG8_LDA(At, 1, 0); PG8_STAGE(PG8_SA(0, 1), a2 + hstep, voffA);
            PG8_WAIT_V(8); PG8_WAIT_L(0); PG8_BAR; PG8_MMA(0, 0, At, B0); PG8_MMA(0, 1, At, B1); PG8_BAR; PG8_SCHED;
            PG8_LDA(At, 1, 1); PG8_STAGE(PG8_SB(1, 0), b3, voffB); PG8_STAGE(PG8_SB(1, 1), b3 + hstep, voffB); PG8_STAGE(PG8_SA(1, 0), a3, voffA);
            PG8_WAIT_V(8); PG8_WAIT_L(0); PG8_BAR; PG8_MMA(1, 0, At, B0); PG8_MMA(1, 1, At, B1); PG8_BAR; PG8_SCHED;
            } else {
            PG8_LDB(B0, 0, 0); PG8_SCHED; PG8_LDA(At, 0, 0); PG8_STAGE(PG8_SA(1, 1), a1 + hstep, voffA);
            PG8_WAIT_L(8); PG8_BAR; PG8_WAIT_L(0); PG8_MMA(0, 0, At, B0); PG8_BAR; PG8_SCHED;
            PG8_LDB(B1, 0, 1); PG8_STAGE(PG8_SB(0, 0), b2, voffB);
            PG8_BAR; PG8_WAIT_L(0); PG8_MMA(0, 1, At, B1); PG8_BAR;
            PG8_LDA(At, 0, 1); PG8_STAGE(PG8_SA(0, 0), a2, voffA);
            PG8_BAR; PG8_WAIT_L(0); PG8_MMA(1, 0, At, B0); PG8_BAR; PG8_SCHED;
            PG8_STAGE(PG8_SB(0, 1), b2 + hstep, voffB);
            PG8_WAIT_V(6); PG8_BAR; PG8_MMA(1, 1, At, B1); PG8_BAR;
            PG8_LDB(B0, 1, 0); PG8_SCHED; PG8_LDA(At, 1, 0); PG8_STAGE(PG8_SA(0, 1), a2 + hstep, voffA);
            PG8_WAIT_L(8); PG8_BAR; PG8_WAIT_L(0); PG8_MMA(0, 0, At, B0); PG8_BAR; PG8_SCHED;
            PG8_LDB(B1, 1, 1); PG8_STAGE(PG8_SB(1, 0), b3, voffB);
            PG8_BAR; PG8_WAIT_L(0); PG8_MMA(0, 1, At, B1); PG8_BAR;
            PG8_LDA(At, 1, 1); PG8_STAGE(PG8_SA(1, 0), a3, voffA);
            PG8_BAR; PG8_WAIT_L(0); PG8_MMA(1, 0, At, B0); PG8_BAR; PG8_SCHED;
            PG8_STAGE(PG8_SB(1, 1), b3 + hstep, voffB);
            PG8_WAIT_V(6); PG8_BAR; PG8_MMA(1, 1, At, B1); PG8_BAR;
            }
        }
        if constexpr (ALIGN_EPI) { if (wr == 0) PG8_BAR; }
        if constexpr (!Epi::AFTER_DRAIN) { E(acc, cur, wr, wc, fr, fq); S.done(cur); }
        if (!has_next) break;
#pragma unroll
        for (int a = 0; a < 2; ++a)
#pragma unroll
            for (int b = 0; b < 2; ++b)
#pragma unroll
                for (int m = 0; m < 4; ++m)
#pragma unroll
                    for (int n = 0; n < 2; ++n) acc[a][b][m][n] = (f32x4){0.f, 0.f, 0.f, 0.f};
        cur = nxt; cA = nA; cB = nB; ++ui;
        if constexpr (ALIGN_EPI) { if (wr == 1) PG8_BAR; }
    }
    PG8_WAIT_V(0);
    if constexpr (!ALIGN_EPI) { if (wr == 0) PG8_BAR; }
    PG8_BAR;
#undef PG8_SA
#undef PG8_SB
#undef PG8_STAGE
#undef PG8_LDA
#undef PG8_LDB
#undef PG8_MMA
#undef PG8_WAIT_V
#undef PG8_WAIT_L
#undef PG8_BAR
#undef PG8_SCHED
}
}

__device__ __forceinline__ void transpose_item(const float* W, int K, int N, bf16_t* WT, int k0, int np0, int srcn0, const float* g, LAS float* scr, int lane) {
    f32x4 v[8];
#pragma unroll
    for (int i = 0; i < 8; ++i) { const int kk = 8 * i + (lane >> 3); v[i] = *(const f32x4*)(W + (size_t)(k0 + kk) * N + srcn0 + (lane & 7) * 4); }
#pragma unroll
    for (int i = 0; i < 8; ++i) { const int kk = 8 * i + (lane >> 3); const float gg = g ? g[k0 + kk] : 1.0f; LAS float* d = scr + kk * 33 + (lane & 7) * 4;
        d[0] = v[i].x * gg; d[1] = v[i].y * gg; d[2] = v[i].z * gg; d[3] = v[i].w * gg; }
    asm volatile("s_waitcnt lgkmcnt(0)" ::: "memory");
    const int c = lane & 7;
#pragma unroll
    for (int j = 0; j < 4; ++j) { const int n = (lane >> 3) + 8 * j; const LAS float* s = scr + (8 * c) * 33 + n;
        u32x4 o; o.x = cvt_pk_bf16(s[0 * 33], s[1 * 33]); o.y = cvt_pk_bf16(s[2 * 33], s[3 * 33]); o.z = cvt_pk_bf16(s[4 * 33], s[5 * 33]); o.w = cvt_pk_bf16(s[6 * 33], s[7 * 33]);
        *(u32x4*)(WT + (size_t)(np0 + n) * K + k0 + 8 * c) = o; }
    asm volatile("s_waitcnt lgkmcnt(0)" ::: "memory");
}
__device__ __forceinline__ int src_in_ab(int np) {
    const int pn = np >> 8, cc = np & 255, bj = cc >> 7, off = cc & 127;
    if (pn < 4) return (bj ? 512 : 0) + 128 * pn + off;
    if (pn < 8) return (bj ? 2048 : 1536) + 128 * (pn - 4) + off;
    return 1024 + 256 * (pn - 8) + cc;
}
__device__ __forceinline__ int src_ffn(int np) { const int pn = np >> 8, cc = np & 255, bj = cc >> 7, off = cc & 127; return (bj ? DFF : 0) + 128 * pn + off; }

struct Args { const float* in[22]; float* out; unsigned char* ws; };

__device__ __forceinline__ void p0_prologue(const Args& a, LAS unsigned char* lds, int gw, int NGW, int lane, int wave) {
    LAS float* scr = (LAS float*)(lds + wave * 16384);
    unsigned char* ws = a.ws;
    constexpr int I_IN = (D / 64) * (NIN / 32), I_SQ = (D / 64) * (D / 32), I_QKV = (D / 64) * (3 * D / 32), I_F = (D / 64) * (2 * DFF / 32), I_DN = (DFF / 64) * (D / 32);
    constexpr int NITEMS = I_IN + 2 * I_SQ + I_QKV + 2 * I_F + 2 * I_DN;
    for (int it = gw; it < NITEMS; it += NGW) {
        int r = it;
        if (r < I_IN) { const int nb = NIN / 32, kb = r / nb, n0 = 32 * (r % nb); transpose_item(a.in[10], D, NIN, (bf16_t*)(ws + WS_WIN), 64 * kb, n0, src_in_ab(n0), a.in[7], scr, lane); continue; } r -= I_IN;
        if (r < I_SQ) { const int nb = D / 32, kb = r / nb, n0 = 32 * (r % nb); transpose_item(a.in[16], D, D, (bf16_t*)(ws + WS_WOUT), 64 * kb, n0, n0, nullptr, scr, lane); continue; } r -= I_SQ;
        if (r < I_QKV) { const int nb = 3 * D / 32, kb = r / nb, n0 = 32 * (r % nb); transpose_item(a.in[17], D, 3 * D, (bf16_t*)(ws + WS_WQKV), 64 * kb, n0, n0, a.in[7] + D, scr, lane); continue; } r -= I_QKV;
        if (r < I_SQ) { const int nb = D / 32, kb = r / nb, n0 = 32 * (r % nb); transpose_item(a.in[18], D, D, (bf16_t*)(ws + WS_WO), 64 * kb, n0, n0, nullptr, scr, lane); continue; } r -= I_SQ;
        if (r < 2 * I_F) { const int l = r / I_F; r -= l * I_F; const int nb = 2 * DFF / 32, kb = r / nb, n0 = 32 * (r % nb);
            transpose_item(a.in[19] + (size_t)l * D * 2 * DFF, D, 2 * DFF, (bf16_t*)(ws + (l ? WS_WF1 : WS_WF0)), 64 * kb, n0, src_ffn(n0), a.in[8] + l * D, scr, lane); continue; } r -= 2 * I_F;
        { const int l = r / I_DN; r -= l * I_DN; const int nb = D / 32, kb = r / nb, n0 = 32 * (r % nb);
            transpose_item(a.in[21] + (size_t)l * DFF * D, DFF, D, (bf16_t*)(ws + (l ? WS_WD1 : WS_WD0)), 64 * kb, n0, n0, nullptr, scr, lane); }
    }
    bf16_t* HB = (bf16_t*)(ws + WS_HB); float* ssq = (float*)(ws + WS_SSQ);
    for (int r0 = gw; r0 < MPAD; r0 += 2 * NGW) {
        f32x4 v[2][4]; float sq[2];
#pragma unroll
        for (int h = 0; h < 2; ++h) { const int r = r0 + h * NGW; sq[h] = 0.f;
            if (r < MTOT) { const f32x4* xr = (const f32x4*)((r < MPR) ? a.in[0] + (size_t)r * D : a.in[1] + (size_t)(r - MPR) * D) + lane;
#pragma unroll
                for (int j = 0; j < 4; ++j) v[h][j] = __builtin_nontemporal_load(xr + 64 * j); }
            else {
#pragma unroll
                for (int j = 0; j < 4; ++j) v[h][j] = (f32x4){0.f, 0.f, 0.f, 0.f}; } }
#pragma unroll
        for (int h = 0; h < 2; ++h) { const int r = r0 + h * NGW; if (r >= MPAD) continue;
#pragma unroll
            for (int j = 0; j < 4; ++j) sq[h] += (v[h][j].x * v[h][j].x + v[h][j].y * v[h][j].y) + (v[h][j].z * v[h][j].z + v[h][j].w * v[h][j].w);
            const float s = wave_sum(sq[h]);
            u32x2* o8 = (u32x2*)(HB + (size_t)r * D) + lane;
#pragma unroll
            for (int j = 0; j < 4; ++j) { u32x2 w; w.x = cvt_pk_bf16(v[h][j].x, v[h][j].y); w.y = cvt_pk_bf16(v[h][j].z, v[h][j].w); o8[64 * j] = w; }
            if (r < MPR) { if (lane < 16) ssq[(size_t)r * 64 + lane] = (lane == 0) ? s : 0.f; } else ssq[(size_t)r * 64 + lane] = (lane == 0) ? s : 0.f; }
    }
    {
        const int tot = NSB * 26 * (CH / 4);
        for (int i = gw * 64 + lane; i < tot; i += NGW * 64) { const int sb = i / (26 * (CH / 4)), rem = i % (26 * (CH / 4));
            ((f32x4*)(a.out + O_SCA + (size_t)sb * 30 * CH))[rem] = ((const f32x4*)(a.in[2] + (size_t)sb * 30 * CH + 4 * CH))[rem]; }
    }
    {
        const size_t per = (size_t)(LBUF - NST) * D / 4;
        const size_t tot = per * NSB, stride = (size_t)NGW * 64;
        for (size_t i0 = (size_t)gw * 64 + lane; i0 < tot; i0 += 4 * stride) {
            f32x4 kv[4], vv[4];
#pragma unroll
            for (int u = 0; u < 4; ++u) { const size_t i = i0 + u * stride; if (i < tot) { const size_t sb = i / per, rem = i % per;
                kv[u] = __builtin_nontemporal_load((const f32x4*)(a.in[4] + (sb * LBUF + NST) * D) + rem); vv[u] = __builtin_nontemporal_load((const f32x4*)(a.in[5] + (sb * LBUF + NST) * D) + rem); } }
#pragma unroll
            for (int u = 0; u < 4; ++u) { const size_t i = i0 + u * stride; if (i < tot) { const size_t sb = i / per, rem = i % per;
                __builtin_nontemporal_store(kv[u], (f32x4*)(a.out + O_SK + sb * LBUF * D) + rem); __builtin_nontemporal_store(vv[u], (f32x4*)(a.out + O_SV + sb * LBUF * D) + rem); } }
        }
    }
}

__device__ __forceinline__ void p2_conv(const Args& a, LAS unsigned char* lds, int tid, int lane, int wave) {
    unsigned char* ws = a.ws;
    const bf16_t* GA = (const bf16_t*)(ws + WS_GA); bf16_t* AB = (bf16_t*)(ws + WS_AB);
    LAS float* T = (LAS float*)lds;
    for (int u = blockIdx.x; u < 512 + NSB; u += gridDim.x) {
        const float* wa = a.in[11]; const float* ba = a.in[12]; const float* lg = a.in[13]; const float* lb = a.in[14]; const float* wb = a.in[15];
        asm volatile("" : "+s"(wa), "+s"(ba), "+s"(lg), "+s"(lb), "+s"(wb));
        const bool samp = u >= 512; const int sb = u - 512;
        const int row0 = samp ? MPR + sb * NST : u * 32, nrows = samp ? NST : 32;
        const int t0 = samp ? 0 : (row0 & (SEQ - 1));
        const int nvec = (nrows + 30) * (CH / 8);
        {
            u32x4 wv[8];
#pragma unroll
            for (int it = 0; it < 8; ++it) { const int i = tid + it * NTHREADS; const int e = i >> 6, c = (i & 63) * 8; const int p = t0 - 30 + e;
                wv[it] = (u32x4){0u, 0u, 0u, 0u};
                if (i < nvec && p >= 0) wv[it] = *(const u32x4*)(GA + (size_t)(row0 - t0 + p) * GAW + c); }
#pragma unroll
            for (int it = 0; it < 8; ++it) { const int i = tid + it * NTHREADS; const int e = i >> 6, c = (i & 63) * 8; const int p = t0 - 30 + e;
                if (i < nvec && (p >= 0 || !samp)) { const u32x4 w = wv[it];
                    *(LAS f32x4*)(T + e * CH + c) = (f32x4){bflo(w.x), bfhi(w.x), bflo(w.y), bfhi(w.y)}; *(LAS f32x4*)(T + e * CH + c + 4) = (f32x4){bflo(w.z), bfhi(w.z), bflo(w.w), bfhi(w.w)}; } }
            if (samp) {
                f32x4 s0_[4], s1_[4];
#pragma unroll
                for (int it = 0; it < 4; ++it) { const int i = tid + it * NTHREADS; if (i < 30 * 64) { const float* sp = a.in[2] + ((size_t)sb * 30 + (i >> 6)) * CH + (i & 63) * 8; s0_[it] = *(const f32x4*)sp; s1_[it] = *(const f32x4*)(sp + 4); } }
#pragma unroll
                for (int it = 0; it < 4; ++it) { const int i = tid + it * NTHREADS; if (i < 30 * 64) { *(LAS f32x4*)(T + (i >> 6) * CH + (i & 63) * 8) = s0_[it]; *(LAS f32x4*)(T + (i >> 6) * CH + (i & 63) * 8 + 4) = s1_[it]; } }
            }
        }
        __syncthreads();
        if (tid < 256) {
            const int c = 2 * tid; f32x2 w[KA];
#pragma unroll
            for (int k = 0; k < KA; ++k) w[k] = *(const f32x2*)(wa + k * CH + c);
            const f32x2 bias = *(const f32x2*)(ba + c);
            if (!samp) {
#pragma clang loop unroll(disable)
                for (int hb = 0; hb < 32; hb += 16) {
                    f32x2 x[46];
#pragma unroll
                    for (int e = 0; e < 46; ++e) x[e] = *(const LAS f32x2*)(T + (hb + e) * CH + c);
#pragma unroll
                    for (int i = 0; i < 16; ++i) {
                        f32x2 s0 = bias, s1 = (f32x2){0.f, 0.f}, s2 = s1, s3 = s1;
#pragma unroll
                        for (int k = 0; k < 28; k += 4) { s0 += w[k] * x[i + k]; s1 += w[k + 1] * x[i + k + 1]; s2 += w[k + 2] * x[i + k + 2]; s3 += w[k + 3] * x[i + k + 3]; }
                        s0 += w[28] * x[i + 28]; s1 += w[29] * x[i + 29]; s2 += w[30] * x[i + 30];
                        *(LAS f32x2*)(T + (hb + i) * CH + c) = (s0 + s1) + (s2 + s3);
                    }
                }
            } else {
                f32x2 x[34];
#pragma unroll
                for (int e = 0; e < 34; ++e) x[e] = *(const LAS f32x2*)(T + e * CH + c);
#pragma unroll
                for (int i = 0; i < NST; ++i) {
                    f32x2 s0 = bias, s1 = (f32x2){0.f, 0.f}, s2 = s1, s3 = s1;
#pragma unroll
                    for (int k = 0; k < 28; k += 4) { s0 += w[k] * x[i + k]; s1 += w[k + 1] * x[i + k + 1]; s2 += w[k + 2] * x[i + k + 2]; s3 += w[k + 3] * x[i + k + 3]; }
                    s0 += w[28] * x[i + 28]; s1 += w[29] * x[i + 29]; s2 += w[30] * x[i + 30];
                    *(LAS f32x2*)(T + i * CH + c) = (s0 + s1) + (s2 + s3);
                }
            }
        } else {
            const int t2 = tid - 256, c = (t2 & 63) * 8, rc = t2 >> 6, rbase = rc * 8;
            const int nr = samp ? (rc == 0 ? NST : 0) : 8;
            float wk[3][8];
#pragma unroll
            for (int k = 0; k < 3; ++k) { const f32x4 wa0 = *(const f32x4*)(wb + k * CH + c), wa1 = *(const f32x4*)(wb + k * CH + c + 4);
                wk[k][0] = wa0.x; wk[k][1] = wa0.y; wk[k][2] = wa0.z; wk[k][3] = wa0.w; wk[k][4] = wa1.x; wk[k][5] = wa1.y; wk[k][6] = wa1.z; wk[k][7] = wa1.w; }
            float xm2[8], xm1[8];
            {
                u32x4 a2 = (u32x4){0u, 0u, 0u, 0u}, a1 = a2;
                if (nr && t0 + rbase - 2 >= 0) { a2 = *(const u32x4*)(GA + (size_t)(row0 + rbase - 2) * GAW + 512 + c); a1 = *(const u32x4*)(GA + (size_t)(row0 + rbase - 1) * GAW + 512 + c); }
                xm2[0] = bflo(a2.x); xm2[1] = bfhi(a2.x); xm2[2] = bflo(a2.y); xm2[3] = bfhi(a2.y); xm2[4] = bflo(a2.z); xm2[5] = bfhi(a2.z); xm2[6] = bflo(a2.w); xm2[7] = bfhi(a2.w);
                xm1[0] = bflo(a1.x); xm1[1] = bfhi(a1.x); xm1[2] = bflo(a1.y); xm1[3] = bfhi(a1.y); xm1[4] = bflo(a1.z); xm1[5] = bfhi(a1.z); xm1[6] = bflo(a1.w); xm1[7] = bfhi(a1.w);
                if (samp && nr) { const float* sp = a.in[3] + (size_t)sb * 2 * CH + c; const f32x4 p0 = *(const f32x4*)sp, p1 = *(const f32x4*)(sp + 4), q0 = *(const f32x4*)(sp + CH), q1 = *(const f32x4*)(sp + CH + 4);
                    xm2[0] = p0.x; xm2[1] = p0.y; xm2[2] = p0.z; xm2[3] = p0.w; xm2[4] = p1.x; xm2[5] = p1.y; xm2[6] = p1.z; xm2[7] = p1.w;
                    xm1[0] = q0.x; xm1[1] = q0.y; xm1[2] = q0.z; xm1[3] = q0.w; xm1[4] = q1.x; xm1[5] = q1.y; xm1[6] = q1.z; xm1[7] = q1.w; }
            }
#pragma clang loop unroll(disable)
            for (int k0 = 0; k0 < nr; k0 += 4) {
                u32x4 cxv[4], gbv[4];
#pragma unroll
                for (int k = 0; k < 4; ++k) { cxv[k] = *(const u32x4*)(GA + (size_t)(row0 + rbase + k0 + k) * GAW + 512 + c); gbv[k] = *(const u32x4*)(GA + (size_t)(row0 + rbase + k0 + k) * GAW + 1024 + c); }
#pragma unroll
                for (int k = 0; k < 4; ++k) {
                    const u32x4 xv = cxv[k], gv = gbv[k];
                    float o[8];
#pragma unroll
                    for (int e = 0; e < 8; ++e) {
                        const unsigned xw = e < 2 ? xv.x : (e < 4 ? xv.y : (e < 6 ? xv.z : xv.w)), gw_ = e < 2 ? gv.x : (e < 4 ? gv.y : (e < 6 ? gv.z : gv.w));
                        const float x0 = (e & 1) ? bfhi(xw) : bflo(xw), gb = (e & 1) ? bfhi(gw_) : bflo(gw_);
                        o[e] = gb * (wk[0][e] * xm2[e] + wk[1][e] * xm1[e] + wk[2][e] * x0); xm2[e] = xm1[e]; xm1[e] = x0; }
                    u32x4 w4; w4.x = cvt_pk_bf16(o[0], o[1]); w4.y = cvt_pk_bf16(o[2], o[3]); w4.z = cvt_pk_bf16(o[4], o[5]); w4.w = cvt_pk_bf16(o[6], o[7]);
                    *(u32x4*)(AB + (size_t)(row0 + rbase + k0 + k) * D + 512 + c) = w4;
                }
            }
        }
        __syncthreads();
        {
            const int c = lane * 8;
            const f32x4 g0 = *(const f32x4*)(lg + c), g1 = *(const f32x4*)(lg + c + 4), b0 = *(const f32x4*)(lb + c), b1 = *(const f32x4*)(lb + c + 4);
            f32x4 v0[4], v1[4]; float mu[4], rstd[4];
#pragma unroll
            for (int j = 0; j < 4; ++j) { const int rr = wave + 8 * j; const int rc = rr < nrows ? rr : 0; v0[j] = *(const LAS f32x4*)(T + rc * CH + c); v1[j] = *(const LAS f32x4*)(T + rc * CH + c + 4); }
#pragma unroll
            for (int j = 0; j < 4; ++j) { const float s_ = (v0[j].x + v0[j].y) + (v0[j].z + v0[j].w) + (v1[j].x + v1[j].y) + (v1[j].z + v1[j].w); mu[j] = wave_sum(s_) * (1.0f / CH); }
#pragma unroll
            for (int j = 0; j < 4; ++j) { v0[j] = v0[j] - mu[j]; v1[j] = v1[j] - mu[j];
                const float q = (v0[j].x * v0[j].x + v0[j].y * v0[j].y) + (v0[j].z * v0[j].z + v0[j].w * v0[j].w) + (v1[j].x * v1[j].x + v1[j].y * v1[j].y) + (v1[j].z * v1[j].z + v1[j].w * v1[j].w);
                rstd[j] = rsqrtf(wave_sum(q) * (1.0f / CH) + LN_EPS); }
#pragma unroll
            for (int j = 0; j < 4; ++j) { const int rr = wave + 8 * j;
                if (rr < nrows) {
                    f32x4 a0 = v0[j] * rstd[j] * g0 + b0, a1 = v1[j] * rstd[j] * g1 + b1;
#pragma unroll
                    for (int e = 0; e < 4; ++e) { a0[e] = a0[e] * sigmoidf_(a0[e]); a1[e] = a1[e] * sigmoidf_(a1[e]); }
                    u32x4 w4; w4.x = cvt_pk_bf16(a0[0], a0[1]); w4.y = cvt_pk_bf16(a0[2], a0[3]); w4.z = cvt_pk_bf16(a1[0], a1[1]); w4.w = cvt_pk_bf16(a1[2], a1[3]);
                    *(u32x4*)(AB + (size_t)(row0 + rr) * D + c) = w4;
                } }
        }
        __syncthreads();
    }
}

__device__ __forceinline__ void p5_fix(const Args& a, int layer, int gtid, int GT) {
    unsigned char* ws = a.ws;
    const bf16_t* ZG = (const bf16_t*)(ws + WS_ZG); const bf16_t* ZU = (const bf16_t*)(ws + WS_ZU); bf16_t* U = (bf16_t*)(ws + WS_U);
    const float* SG = (const float*)(ws + WS_SG); const float* SU = (const float*)(ws + WS_SU);
    const float* wc = a.in[20] + (size_t)layer * 3 * DFF;
    constexpr int NCV = DFF / 8, NBLK = MPR / 64;
    const int nit = NBLK * 2 * NCV + NSB * NCV;
    for (int it = gtid; it < nit; it += GT) {
        const bool samp = it >= NBLK * 2 * NCV;
        if (!samp) {
            const int cv = it % NCV, bj = it / NCV, blk = bj >> 1, j = bj & 1, c = cv * 8;
            const bool first = (blk & 31) == 0;
            float gm2[8], gm1[8], g0[8], up[8];
            const float* cur = SG + (size_t)blk * 4 * DFF + c; const float* prv = SG + (size_t)(blk - 1) * 4 * DFF + c;
#pragma unroll
            for (int e = 0; e < 8; ++e) {
                if (j == 0) { gm2[e] = first ? 0.f : prv[2 * DFF + e]; gm1[e] = first ? 0.f : prv[3 * DFF + e]; g0[e] = cur[e]; }
                else { gm2[e] = first ? 0.f : prv[3 * DFF + e]; gm1[e] = cur[e]; g0[e] = cur[DFF + e]; }
                up[e] = SU[((size_t)blk * 2 + j) * DFF + c + e];
            }
            float o[8];
#pragma unroll
            for (int e = 0; e < 8; ++e) { const float y = wc[c + e] * gm2[e] + wc[DFF + c + e] * gm1[e] + wc[2 * DFF + c + e] * g0[e]; o[e] = y * sigmoidf_(y) * up[e]; }
            u32x4 w4; w4.x = cvt_pk_bf16(o[0], o[1]); w4.y = cvt_pk_bf16(o[2], o[3]); w4.z = cvt_pk_bf16(o[4], o[5]); w4.w = cvt_pk_bf16(o[6], o[7]);
            *(u32x4*)(U + (size_t)(blk * 64 + j) * DFF + c) = w4;
        } else {
            const int jj = it - NBLK * 2 * NCV, sb = jj / NCV, cv = jj % NCV, c = cv * 8, r0 = MPR + sb * NST;
            float w0[8], w1[8], w2[8], gm2[8], gm1[8];
            const float* sp = a.in[6] + ((size_t)(layer * NSB + sb) * 2) * DFF + c;
#pragma unroll
            for (int e = 0; e < 8; ++e) { w0[e] = wc[c + e]; w1[e] = wc[DFF + c + e]; w2[e] = wc[2 * DFF + c + e]; gm2[e] = sp[e]; gm1[e] = sp[DFF + e]; }
            for (int i = 0; i < NST; ++i) {
                const size_t off = (size_t)(r0 + i) * DFF + c;
                const u32x4 gv = *(const u32x4*)(ZG + off), uv = *(const u32x4*)(ZU + off);
                float g[8] = {bflo(gv.x), bfhi(gv.x), bflo(gv.y), bfhi(gv.y), bflo(gv.z), bfhi(gv.z), bflo(gv.w), bfhi(gv.w)};
                float up[8] = {bflo(uv.x), bfhi(uv.x), bflo(uv.y), bfhi(uv.y), bflo(uv.z), bfhi(uv.z), bflo(uv.w), bfhi(uv.w)};
                float o[8];
#pragma unroll
                for (int e = 0; e < 8; ++e) { const float y = w0[e] * gm2[e] + w1[e] * gm1[e] + w2[e] * g[e]; o[e] = y * sigmoidf_(y) * up[e]; gm2[e] = gm1[e]; gm1[e] = g[e]; }
                u32x4 w4; w4.x = cvt_pk_bf16(o[0], o[1]); w4.y = cvt_pk_bf16(o[2], o[3]); w4.z = cvt_pk_bf16(o[4], o[5]); w4.w = cvt_pk_bf16(o[6], o[7]);
                *(u32x4*)(U + off) = w4;
            }
        }
    }
}

constexpr int AT_OACC = 0, AT_OSTR = 65, AT_ML = 256 * AT_OSTR * 4, AT_VST = AT_ML + 2048, AT_PSC = AT_VST + NWAVES * 4096;
static_assert(AT_PSC + NWAVES * 2048 <= 131072, "attention LDS");
__device__ __forceinline__ int crow(int r, int hi) { return (r & 3) + 8 * (r >> 2) + 4 * hi; }

__device__ __forceinline__ void attn_task(const bf16_t* Qh, const bf16_t* Kh, const bf16_t* Vh, int dil, int cls, int s0, int nq, float slope2, int qlbase, int qlstep, bool first,
                                          LAS unsigned char* lds, int wave, int lane) {
    const int r32 = lane & 31, hi = lane >> 5;
    const int qi = r32 < nq ? r32 : nq - 1;
    const bf16_t* qp = Qh + (size_t)(cls + dil * (s0 + qi)) * D + hi * 8;
    bf16x8 qr[4];
#pragma unroll
    for (int d0 = 0; d0 < 4; ++d0) qr[d0] = *(const bf16x8*)(qp + d0 * 16);
    float m_run = -INFINITY, l_run = 0.f; f32x16 o[2]; o[0] = f32x16{}; o[1] = f32x16{};
    LAS unsigned char* vst = lds + AT_VST + wave * 4096;
    const float sdil = slope2 * (float)dil;
    f32x16 cb;
#pragma unroll
    for (int r = 0; r < 16; ++r) cb[r] = -sdil * (float)(r32 - 4 * hi + 128 - ((r & 3) + 8 * (r >> 2)));
    const int i_first = s0 < 128 ? (128 - s0) >> 5 : 0;
    const int vb = ((lane >> 4) & 1) * 32 + (lane & 3) * 8 + (4 * hi + ((lane & 15) >> 2)) * 64;
#pragma clang loop unroll(disable)
    for (int i = 4; i >= i_first; --i) {
        const int kb = s0 - 128 + 32 * i;
        const int skv = kb + r32 < 0 ? 0 : kb + r32;
        const bf16_t* kp = Kh + (size_t)(cls + dil * skv) * D + hi * 8;
        bf16x8 kf[4];
#pragma unroll
        for (int d0 = 0; d0 < 4; ++d0) kf[d0] = *(const bf16x8*)(kp + d0 * 16);
        u32x4 vv[4];
#pragma unroll
        for (int j = 0; j < 4; ++j) { const int kv = (lane >> 3) + 8 * j; const int sv = kb + kv < 0 ? 0 : kb + kv;
            vv[j] = *(const u32x4*)(Vh + (size_t)(cls + dil * sv) * D + (lane & 7) * 8); }
        const float toff = sdil * (float)(32 * i);
        f32x16 st;
#pragma unroll
        for (int r = 0; r < 16; ++r) st[r] = cb[r] + toff;
#pragma unroll
        for (int d0 = 0; d0 < 4; ++d0) st = __builtin_amdgcn_mfma_f32_32x32x16_bf16(kf[d0], qr[d0], st, 0, 0, 0);
        asm volatile("" ::: "memory");
#pragma unroll
        for (int j = 0; j < 4; ++j) { const int kv = (lane >> 3) + 8 * j, part = lane & 7;
            *(LAS u32x4*)(vst + (part >> 2) * 2048 + (kv >> 3) * 512 + (kv & 7) * 64 + (part & 3) * 16) = vv[j]; }
        if (i == 0 || i == 4 || kb < 0) {
            int cmin = (i == 0) ? r32 : 0; cmin = cmin > -kb ? cmin : -kb; const int cmax = (i == 4) ? r32 : 31;
            const int lo_ = cmin - 4 * hi, hi_ = cmax - 4 * hi;
#pragma unroll
            for (int r = 0; r < 16; ++r) { const int c = (r & 3) + 8 * (r >> 2); st[r] = (c >= lo_ && c <= hi_) ? st[r] : -INFINITY; }
        }
        float mx = fmaxf(fmaxf(st[0], st[1]), fmaxf(st[2], st[3]));
#pragma unroll
        for (int r = 4; r < 16; r += 4) mx = fmaxf(mx, fmaxf(fmaxf(st[r], st[r + 1]), fmaxf(st[r + 2], st[r + 3])));
        { auto rr = __builtin_amdgcn_permlane32_swap(__float_as_uint(mx), __float_as_uint(mx), false, false); mx = fmaxf(__uint_as_float(rr[0]), __uint_as_float(rr[1])); }
        if (__any(mx > m_run)) {
            const float m_new = fmaxf(m_run, mx);
            const float alpha = __builtin_amdgcn_exp2f(m_run - ((m_new == -INFINITY) ? 0.f : m_new));
            l_run *= alpha; m_run = m_new;
#pragma unroll
            for (int r = 0; r < 16; ++r) { o[0][r] *= alpha; o[1][r] *= alpha; }
        }
        const float m_use = (m_run == -INFINITY) ? 0.f : m_run;
        float ps = 0.f;
#pragma unroll
        for (int r = 0; r < 16; ++r) { const float p = __builtin_amdgcn_exp2f(st[r] - m_use); st[r] = p; ps += p; }
        l_run += ps;
        bf16x8 pa[2];
#pragma unroll
        for (int s = 0; s < 2; ++s) { u32x4 w; w.x = cvt_pk_bf16(st[8 * s + 0], st[8 * s + 1]); w.y = cvt_pk_bf16(st[8 * s + 2], st[8 * s + 3]); w.z = cvt_pk_bf16(st[8 * s + 4], st[8 * s + 5]); w.w = cvt_pk_bf16(st[8 * s + 6], st[8 * s + 7]);
            pa[s] = __builtin_bit_cast(bf16x8, w); }
        asm volatile("s_waitcnt lgkmcnt(0)" ::: "memory");
#pragma unroll
        for (int d0 = 0; d0 < 2; ++d0)
#pragma unroll
            for (int s = 0; s < 2; ++s) {
                const s16x4 lo = __builtin_bit_cast(s16x4, __builtin_amdgcn_ds_read_tr16_b64_v4i16((LAS s16x4*)(vst + vb + d0 * 2048 + s * 1024)));
                const s16x4 hh = __builtin_bit_cast(s16x4, __builtin_amdgcn_ds_read_tr16_b64_v4i16((LAS s16x4*)(vst + vb + d0 * 2048 + s * 1024 + 512)));
                const bf16x8 vf = (bf16x8){lo[0], lo[1], lo[2], lo[3], hh[0], hh[1], hh[2], hh[3]};
                o[d0] = __builtin_amdgcn_mfma_f32_32x32x16_bf16(vf, pa[s], o[d0], 0, 0, 0);
            }
        asm volatile("s_waitcnt lgkmcnt(0)" ::: "memory");
    }
    { auto rr = __builtin_amdgcn_permlane32_swap(__float_as_uint(l_run), __float_as_uint(l_run), false, false); l_run = __uint_as_float(rr[0]) + __uint_as_float(rr[1]); }
    if (r32 < nq) {
        const int ql = qlbase + qlstep * r32;
        LAS float* oa = (LAS float*)(lds + AT_OACC) + ql * AT_OSTR;
        LAS float* ml = (LAS float*)(lds + AT_ML) + ql * 2;
        float a_old = 0.f, a_new = 1.f, m_new = m_run, l_new = l_run;
        if (!first) { const float m_old = ml[0], l_old = ml[1]; m_new = fmaxf(m_old, m_run); const float mu = (m_new == -INFINITY) ? 0.f : m_new;
            a_old = __builtin_amdgcn_exp2f(m_old - mu); a_new = __builtin_amdgcn_exp2f(m_run - mu); l_new = l_old * a_old + l_run * a_new; }
#pragma unroll
        for (int d0 = 0; d0 < 2; ++d0)
#pragma unroll
            for (int r = 0; r < 16; ++r) { const int d = 32 * d0 + crow(r, hi); float v = o[d0][r] * a_new; if (!first) v += oa[d] * a_old; oa[d] = v; }
        asm volatile("s_waitcnt lgkmcnt(0)" ::: "memory");
        if (hi == 0) { ml[0] = m_new; ml[1] = l_new; }
    }
}

__device__ __forceinline__ void p8_attention(const Args& a, LAS unsigned char* lds, int tid, int lane, int wave) {
    unsigned char* ws = a.ws;
    const bf16_t* Q = (const bf16_t*)(ws + WS_Q); const bf16_t* K = (const bf16_t*)(ws + WS_K); const bf16_t* V = (const bf16_t*)(ws + WS_V); bf16_t* O = (bf16_t*)(ws + WS_AB);
#ifndef NO_SAMPLE
    {
        const float* QS = (const float*)(ws + WS_QS);
        LAS float* psc = (LAS float*)(lds + AT_PSC + wave * 2048);
        for (int task = blockIdx.x * NWAVES + wave; task < NSB * NH * NST; task += gridDim.x * NWAVES) {
            const int sb = task / (NH * NST), h = (task / NST) % NH, j = task % NST;
            const float slope2 = exp2f(-0.5f * (float)(h + 1)) * LOG2E;
            const float* kc = a.in[4] + (size_t)sb * LBUF * D + h * HD; const float* vc = a.in[5] + (size_t)sb * LBUF * D + h * HD;
            const float* kn = a.out + O_SK + ((size_t)sb * LBUF + (LBUF - NST)) * D + h * HD; const float* vn = a.out + O_SV + ((size_t)sb * LBUF + (LBUF - NST)) * D + h * HD;
            const float* qrow = QS + (size_t)(sb * NST + j) * D + h * HD;
            f32x4 qv[16];
#pragma unroll
            for (int e = 0; e < 16; ++e) qv[e] = *(const f32x4*)(qrow + 4 * e);
            float mx = -INFINITY;
#pragma clang loop unroll(disable)
            for (int rd = 0; rd < 7; ++rd) {
                const int kk = rd * 64 + lane; float s = -INFINITY;
                if (kk < 387) { const int g = kk / 129, mm = kk % 129, dil = (g == 0) ? 1 : (g == 1 ? 4 : 16); const int idx = LBUF + j - mm * dil;
                    const float* kr = (idx >= LBUF) ? kn + (size_t)(idx - LBUF) * D : kc + (size_t)idx * D;
                    float acc = 0.f;
#pragma unroll
                    for (int e = 0; e < 16; ++e) { const f32x4 kx = *(const f32x4*)(kr + 4 * e); acc += (qv[e].x * kx.x + qv[e].y * kx.y) + (qv[e].z * kx.z + qv[e].w * kx.w); }
                    s = acc - slope2 * (float)(mm * dil); }
                psc[kk] = s; mx = fmaxf(mx, s);
            }
            mx = wave_max(mx);
            asm volatile("s_waitcnt lgkmcnt(0)" ::: "memory");
            float l = 0.f;
#pragma clang loop unroll(disable)
            for (int rd = 0; rd < 7; ++rd) { const float p = __builtin_amdgcn_exp2f(psc[rd * 64 + lane] - mx); l += p; psc[rd * 64 + lane] = p; }
            l = wave_sum(l);
            asm volatile("s_waitcnt lgkmcnt(0)" ::: "memory");
            const int kg = lane >> 4, dc = lane & 15;
            f32x4 acc4 = (f32x4){0.f, 0.f, 0.f, 0.f};
#pragma clang loop unroll(disable)
            for (int k0 = 0; k0 < 387; k0 += 64) {
                f32x4 vr4[16]; float pk[16];
#pragma unroll
                for (int u = 0; u < 16; ++u) { const int kk = k0 + 4 * u + kg; const int kc_ = kk < 387 ? kk : 386;
                    const int g = kc_ / 129, mm = kc_ % 129, dil = (g == 0) ? 1 : (g == 1 ? 4 : 16); const int idx = LBUF + j - mm * dil;
                    const float* vr = (idx >= LBUF) ? vn + (size_t)(idx - LBUF) * D : vc + (size_t)idx * D;
                    vr4[u] = *(const f32x4*)(vr + 4 * dc); pk[u] = kk < 387 ? psc[kc_] : 0.f; }
#pragma unroll
                for (int u = 0; u < 16; ++u) acc4 += vr4[u] * pk[u];
            }
#pragma unroll
            for (int e = 0; e < 4; ++e) { acc4[e] += __shfl_xor(acc4[e], 16); acc4[e] += __shfl_xor(acc4[e], 32); }
            const float il = __builtin_amdgcn_rcpf(l);
            if (lane < 16) { u32x2 w; w.x = cvt_pk_bf16(acc4[0] * il, acc4[1] * il); w.y = cvt_pk_bf16(acc4[2] * il, acc4[3] * il);
                *(u32x2*)(O + (size_t)(MPR + sb * NST + j) * D + h * HD + 4 * dc) = w; }
            asm volatile("s_waitcnt lgkmcnt(0)" ::: "memory");
        }
    }
#endif
    __syncthreads();
#ifndef NO_PROMPT
    const int nun = NB * NH * 8, per_round = gridDim.x;
    for (int u0 = blockIdx.x; u0 < nun; u0 += per_round) {
        int u = u0;
        if ((gridDim.x & 7) == 0 && nun % (int)gridDim.x == 0) { const int x = blockIdx.x & 7, slot = blockIdx.x >> 3, spx = gridDim.x >> 3, j = (u0 / per_round) * spx + slot; u = x * (nun >> 3) + j; }
        const int qblk = u & 7, h = (u >> 3) & 15, b = u >> 7;
        const float slope2 = exp2f(-0.5f * (float)(h + 1)) * LOG2E;
        const bf16_t* Qh = Q + (size_t)b * SEQ * D + h * HD; const bf16_t* Kh = K + (size_t)b * SEQ * D + h * HD; const bf16_t* Vh = V + (size_t)b * SEQ * D + h * HD;
#pragma clang loop unroll(disable)
        for (int tk = 0; tk < 4; ++tk) {
            int dil, cls, s0, nq, qlb, qls;
            if (tk == 0) { dil = 1; cls = 0; s0 = 256 * qblk + 32 * wave; nq = 32; qlb = 32 * wave; qls = 1; }
            else if (tk == 1) { dil = 4; cls = wave & 3; s0 = 64 * qblk + 32 * (wave >> 2); nq = 32; qlb = (wave & 3) + 128 * (wave >> 2); qls = 4; }
            else { dil = 16; cls = 2 * wave + (tk - 2); s0 = 16 * qblk; nq = 16; qlb = cls; qls = 16; }
            attn_task(Qh, Kh, Vh, dil, cls, s0, nq, slope2, qlb, qls, tk == 0, lds, wave, lane);
            if (tk != 2) __syncthreads();
        }
        {
            const int ql = tid >> 1, dh = (tid & 1) * 32;
            const LAS float* oa = (const LAS float*)(lds + AT_OACC) + ql * AT_OSTR + dh;
            const float inv = __builtin_amdgcn_rcpf(((const LAS float*)(lds + AT_ML))[ql * 2 + 1]);
            bf16_t* op = O + (size_t)(b * SEQ + 256 * qblk + ql) * D + h * HD + dh;
#pragma unroll
            for (int e = 0; e < 4; ++e) { u32x4 w; w.x = cvt_pk_bf16(oa[8 * e + 0] * inv, oa[8 * e + 1] * inv); w.y = cvt_pk_bf16(oa[8 * e + 2] * inv, oa[8 * e + 3] * inv);
                w.z = cvt_pk_bf16(oa[8 * e + 4] * inv, oa[8 * e + 5] * inv); w.w = cvt_pk_bf16(oa[8 * e + 6] * inv, oa[8 * e + 7] * inv); *(u32x4*)(op + 8 * e) = w; }
        }
        __syncthreads();
    }
#endif
}

__device__ __forceinline__ void p13_final(const Args& a, int gw, int NGW, int lane) {
    const float* H = (const float*)(a.ws + WS_H); const float* g = a.in[9];
    f32x4 gv[4];
#pragma unroll
    for (int j = 0; j < 4; ++j) gv[j] = ((const f32x4*)g)[64 * j + lane];
    for (int r0 = gw; r0 < MTOT; r0 += 2 * NGW) {
        f32x4 v[2][4];
#pragma unroll
        for (int h = 0; h < 2; ++h) { const int r = r0 + h * NGW; const int rc = r < MTOT ? r : r0; const f32x4* xr = (const f32x4*)(H + (size_t)rc * D) + lane;
#pragma unroll
            for (int j = 0; j < 4; ++j) v[h][j] = xr[64 * j]; }
#pragma unroll
        for (int h = 0; h < 2; ++h) { const int r = r0 + h * NGW; if (r >= MTOT) continue; float s = 0.f;
#pragma unroll
            for (int j = 0; j < 4; ++j) s += (v[h][j].x * v[h][j].x + v[h][j].y * v[h][j].y) + (v[h][j].z * v[h][j].z + v[h][j].w * v[h][j].w);
            const float rstd = rsqrtf(wave_sum(s) * (1.0f / D) + RMS_EPS);
            f32x4* o = (f32x4*)(a.out + (size_t)r * D) + lane;
#pragma unroll
            for (int j = 0; j < 4; ++j) __builtin_nontemporal_store(v[h][j] * rstd * gv[j], o + 64 * j); }
    }
}

template <int MODE, int K>
__device__ __forceinline__ void sample_gemm(LAS unsigned char* lds, const bf16_t* A, const bf16_t* Bt, int N, const float* base, float* Hs, bf16_t* HBs, float* ssq,
                                            bf16_t* QKV, float* QS, float* out, int tid, int lane, int wave) {
    constexpr int KPW = K / 32 / 8;
    const int nitems = (N / 16) * 4;
    LAS f32x4* red = (LAS f32x4*)lds;
    for (int it = blockIdx.x; it < nitems; it += gridDim.x) {
        const int cbk = it >> 2, rq = it & 3;
        const bf16_t* bp = Bt + (size_t)(16 * cbk + (lane & 15)) * K + wave * KPW * 32 + 8 * (lane >> 4);
        const bf16_t* ap = A + (size_t)(32 * rq + (lane & 15)) * K + wave * KPW * 32 + 8 * (lane >> 4);
        bf16x8 bw[KPW], a0[KPW], a1[KPW];
#pragma unroll
        for (int ks = 0; ks < KPW; ++ks) { bw[ks] = *(const bf16x8*)(bp + ks * 32); a0[ks] = *(const bf16x8*)(ap + ks * 32); a1[ks] = *(const bf16x8*)(ap + (size_t)16 * K + ks * 32); }
        f32x4 acc0 = (f32x4){0.f, 0.f, 0.f, 0.f}, acc1 = acc0;
#pragma unroll
        for (int ks = 0; ks < KPW; ++ks) { acc0 = __builtin_amdgcn_mfma_f32_16x16x32_bf16(bw[ks], a0[ks], acc0, 0, 0, 0); acc1 = __builtin_amdgcn_mfma_f32_16x16x32_bf16(bw[ks], a1[ks], acc1, 0, 0, 0); }
        red[(wave * 2 + 0) * 64 + lane] = acc0; red[(wave * 2 + 1) * 64 + lane] = acc1;
        __syncthreads();
        if (tid < 128) {
            const int rb = tid >> 6, ln = tid & 63;
            f32x4 v = red[rb * 64 + ln];
#pragma unroll
            for (int w = 1; w < 8; ++w) v += red[(w * 2 + rb) * 64 + ln];
            const int rs = 32 * rq + 16 * rb + (ln & 15), fq = ln >> 4;
            const int c = 16 * cbk + 4 * fq;
            if (MODE == 0) {
                const f32x4 h = *(const f32x4*)(base + (size_t)rs * D + c) + v;
                *(f32x4*)(Hs + (size_t)rs * D + c) = h;
                u32x2 w2; w2.x = cvt_pk_bf16(h[0], h[1]); w2.y = cvt_pk_bf16(h[2], h[3]); *(u32x2*)(HBs + (size_t)rs * D + c) = w2;
                float q = (h[0] * h[0] + h[1] * h[1]) + (h[2] * h[2] + h[3] * h[3]);
                q += __shfl_xor(q, 16); q += __shfl_xor(q, 32);
                if (fq == 0) ssq[(size_t)(MPR + rs) * 64 + cbk] = q;
            } else {
                const int which = cbk >> 6, c1 = c - which * D;
                const float rstd = pg8::row_rstd(ssq, MPR + rs, fq) * (which == 0 ? QSCALE : 1.0f);
                const f32x4 o = v * rstd;
                u32x2 w2; w2.x = cvt_pk_bf16(o[0], o[1]); w2.y = cvt_pk_bf16(o[2], o[3]);
                *(u32x2*)(QKV + (size_t)which * ((WS_K - WS_Q) / 2) + (size_t)(MPR + rs) * D + c1) = w2;
                float* fp = (which == 0) ? QS + (size_t)rs * D + c1 : out + (which == 1 ? O_SK : O_SV) + ((size_t)(rs >> 2) * LBUF + (LBUF - NST) + (rs & 3)) * D + c1;
                *(f32x4*)fp = o;
            }
        }
        __syncthreads();
    }
}

#define XB_TMO      128
#define XB_XCNT(j)  (256  + 64 * (j))
#define XB_XSUB(j)  (1280 + 64 * (j))
#define XB_XGEN(j)  (2304 + 64 * (j))
#define XB_TOP      3328
#define XB_TOPGEN   3392
#define XCD_BAR_WORDS 3456
#define XB_SPIN_CAP (1u << 18)
__device__ __forceinline__ unsigned xb_ld(unsigned* p)              { return __hip_atomic_load(p, __ATOMIC_RELAXED, __HIP_MEMORY_SCOPE_AGENT); }
__device__ __forceinline__ unsigned xb_add(unsigned* p, unsigned v) { return __hip_atomic_fetch_add(p, v, __ATOMIC_RELAXED, __HIP_MEMORY_SCOPE_AGENT); }
__device__ __forceinline__ unsigned xb_xcc_id() { return (unsigned)__builtin_amdgcn_s_getreg((3 << 11) | 20) & 0xFu; }
#define XB_SPIN(cond, bar) do { unsigned _sp = 0; while (cond) { __builtin_amdgcn_s_sleep(1); \
    if ((++_sp & 255u) == 0u) { if (xb_ld(&(bar)[XB_TMO])) break; if (_sp > XB_SPIN_CAP) { atomicAdd(&(bar)[XB_TMO], 1u); break; } } } } while (0)
__device__ __forceinline__ void xcd_barrier_complete(unsigned* bar, unsigned x, unsigned& nloc, unsigned& nx) {
    const unsigned G = gridDim.x * gridDim.y * gridDim.z;
    unsigned sum, cnt, mine, sp = 0u;
    for (;;) {
        sum = 0u; cnt = 0u; mine = 0u;
#pragma unroll
        for (unsigned j = 0; j < 16; ++j) { const unsigned c = xb_ld(&bar[XB_XCNT(j)]); sum += c; cnt += (c > 0u) ? 1u : 0u; mine = (j == x) ? c : mine; }
        if (sum == G) break;
        __builtin_amdgcn_s_sleep(1);
        if ((++sp & 255u) == 0u) { if (xb_ld(&bar[XB_TMO])) break; if (sp > XB_SPIN_CAP) { atomicAdd(&bar[XB_TMO], 1u); break; } }
    }
    nloc = mine > 0u ? mine : 1u; nx = cnt > 0u ? cnt : 1u;
}
__device__ __forceinline__ void xcd_barrier(unsigned* bar, volatile LAS unsigned* st) {
    asm volatile("s_waitcnt vmcnt(0)" ::: "memory");
    __syncthreads();
    if (threadIdx.x == 0) {
        const unsigned x = xb_xcc_id();
        __builtin_amdgcn_s_waitcnt(0);
        unsigned nloc = st[0], nx = st[1];
        if (nloc == 0u) { xcd_barrier_complete(bar, x, nloc, nx); st[0] = nloc; st[1] = nx; }
        const unsigned old = xb_add(&bar[XB_XSUB(x)], 1u);
        const unsigned gen = old / nloc;
        if (old + 1u == (gen + 1u) * nloc) {
            __builtin_amdgcn_fence(__ATOMIC_RELEASE, "agent");
            asm volatile("s_waitcnt vmcnt(0)" ::: "memory");
            const unsigned og = xb_add(&bar[XB_TOP], 1u);
            const unsigned tg = og / nx;
            if (og + 1u == (tg + 1u) * nx) xb_add(&bar[XB_TOPGEN], 1u);
            else XB_SPIN(xb_ld(&bar[XB_TOPGEN]) == tg, bar);
            __builtin_amdgcn_fence(__ATOMIC_ACQUIRE, "agent");
            xb_add(&bar[XB_XGEN(x)], 1u);
            asm volatile("s_waitcnt vmcnt(0)" ::: "memory");
        } else {
            XB_SPIN(xb_ld(&bar[XB_XGEN(x)]) == gen, bar);
            __builtin_amdgcn_fence(__ATOMIC_ACQUIRE, "agent");
            asm volatile("s_waitcnt vmcnt(0)" ::: "memory");
        }
    }
    __syncthreads();
}

typedef const __attribute__((address_space(4))) Args* kargp_t;
__device__ __forceinline__ Args kargs() {
    Args a;
#if defined(__HIP_DEVICE_COMPILE__)
    kargp_t p = (kargp_t)__builtin_amdgcn_kernarg_segment_ptr(); asm volatile("" : "+s"(p));
#pragma unroll
    for (int i = 0; i < 22; ++i) a.in[i] = p->in[i];
    a.out = p->out; a.ws = p->ws;
#else
    for (int i = 0; i < 22; ++i) a.in[i] = nullptr;
    a.out = nullptr; a.ws = nullptr;
#endif
    return a;
}
#define PHASE_BEGIN const Args a = kargs(); unsigned char* ws = a.ws; const int tid = launder_v(threadIdx.x), lane = tid & 63, wave = __builtin_amdgcn_readfirstlane(tid >> 6); \
    const int G = gridDim.x, gw = blockIdx.x * NWAVES + wave, NGW = G * NWAVES; (void)ws; (void)lane; (void)gw; (void)NGW; (void)G;
__global__ void __launch_bounds__(NTHREADS, 2) mega_fwd(Args a_unused) {
    extern __shared__ __attribute__((aligned(16))) unsigned char lds_raw[];
    LAS unsigned char* lds = (LAS unsigned char*)lds_raw;
    cg::grid_group grid = cg::this_grid();
    volatile LAS unsigned* bst = (volatile LAS unsigned*)(lds + 131072 + 64);
    { unsigned* ctl0 = (unsigned*)kargs().ws; if (threadIdx.x == 0) { bst[0] = 0u; bst[1] = 0u; (void)xb_add(&ctl0[XB_XCNT(xb_xcc_id())], 1u); } }
    __syncthreads();
    grid.sync();
#define GRID_BAR() do { unsigned* ctl_ = (unsigned*)kargs().ws; xcd_barrier(ctl_, bst); } while (0)
#ifndef PHASES
#define PHASES 0xFFFF
#endif
#define PH(k) if constexpr (((PHASES) >> (k)) & 1)
#define REP_ALL 1
#define REP_P0 1
#define REP_P1 1
#define REP_P2 1
#define REP_P3 1
#define REP_P4 1
#define REP_P5 1
#define REP_P6 1
#define REP_P7 1
#define REP_P8 1
#define REP_P13 1
#define REPEAT(n) for (int rep_ = 0; rep_ < (n); ++rep_)

    for (int rep_all = 0; rep_all < REP_ALL; ++rep_all) {
    if (rep_all) { GRID_BAR(); }
    REPEAT(REP_P0) { PH(0) { PHASE_BEGIN p0_prologue(a, lds, gw, NGW, lane, wave); } if (rep_ + 1 < REP_P0) { GRID_BAR(); } }
    GRID_BAR();
    REPEAT(REP_P1) { if (rep_) { GRID_BAR(); } PH(1) {
        PHASE_BEGIN
        pg8::Gemm g{(const bf16_t*)(ws + WS_HB), (const bf16_t*)(ws + WS_WIN), MPAD, NIN, D}; pg8::StaticOrder S; S.init(MPAD, NIN, G, (int)blockIdx.x);
        pg8::EpiInAB E{(bf16_t*)(ws + WS_GA), (const float*)(ws + WS_SSQ), a.out};
        pg8::gemm_phase<pg8::EpiInAB, pg8::StaticOrder, true, true>(lds, g, S, E);
    } }
    GRID_BAR();
    REPEAT(REP_P2) { if (rep_) { GRID_BAR(); } PH(2) { PHASE_BEGIN p2_conv(a, lds, tid, lane, wave); } }
    GRID_BAR();
    REPEAT(REP_P3) { if (rep_) { GRID_BAR(); } PH(3) {
        PHASE_BEGIN
        pg8::Gemm g{(const bf16_t*)(ws + WS_AB), (const bf16_t*)(ws + WS_WOUT), MPR, D, D}; pg8::StaticOrder S; S.init(MPR, D, G, (int)blockIdx.x);
        pg8::EpiResid E{a.in[0], a.in[1], (float*)(ws + WS_H), (bf16_t*)(ws + WS_HB), (float*)(ws + WS_SSQ)};
        pg8::gemm_phase<pg8::EpiResid, pg8::StaticOrder, true, true>(lds, g, S, E);
        sample_gemm<0, D>(lds, (const bf16_t*)(ws + WS_AB) + (size_t)MPR * D, (const bf16_t*)(ws + WS_WOUT), D, a.in[1], (float*)(ws + WS_H) + (size_t)MPR * D, (bf16_t*)(ws + WS_HB) + (size_t)MPR * D,
                          (float*)(ws + WS_SSQ), nullptr, nullptr, nullptr, tid, lane, wave);
    } }
    GRID_BAR();
#pragma clang loop unroll(disable)
    for (int layer = 0; layer < 2; ++layer) {
        if (layer == 1) {
            REPEAT(REP_P7) { if (rep_) { GRID_BAR(); } PH(7) {
                PHASE_BEGIN
                pg8::Gemm g{(const bf16_t*)(ws + WS_HB), (const bf16_t*)(ws + WS_WQKV), MPR, 3 * D, D}; pg8::StaticOrder S; S.init(MPR, 3 * D, G, (int)blockIdx.x);
                pg8::EpiQkv E{(bf16_t*)(ws + WS_Q), (float*)(ws + WS_QS), (const float*)(ws + WS_SSQ), a.out};
                pg8::gemm_phase<pg8::EpiQkv, pg8::StaticOrder, true, true>(lds, g, S, E);
                sample_gemm<1, D>(lds, (const bf16_t*)(ws + WS_HB) + (size_t)MPR * D, (const bf16_t*)(ws + WS_WQKV), 3 * D, nullptr, nullptr, nullptr,
                                  (float*)(ws + WS_SSQ), (bf16_t*)(ws + WS_Q), (float*)(ws + WS_QS), a.out, tid, lane, wave);
            } }
            GRID_BAR();
            REPEAT(REP_P8) { if (rep_) { GRID_BAR(); } PH(8) { PHASE_BEGIN p8_attention(a, lds, tid, lane, wave); } }
            GRID_BAR();
            PH(9) {
                PHASE_BEGIN
                float* H = (float*)(ws + WS_H);
                pg8::Gemm g{(const bf16_t*)(ws + WS_AB), (const bf16_t*)(ws + WS_WO), MPR, D, D}; pg8::StaticOrder S; S.init(MPR, D, G, (int)blockIdx.x);
                pg8::EpiResid E{H, H + (size_t)MPR * D, H, (bf16_t*)(ws + WS_HB), (float*)(ws + WS_SSQ)};
                pg8::gemm_phase<pg8::EpiResid, pg8::StaticOrder, true, true>(lds, g, S, E);
                sample_gemm<0, D>(lds, (const bf16_t*)(ws + WS_AB) + (size_t)MPR * D, (const bf16_t*)(ws + WS_WO), D, H + (size_t)MPR * D, H + (size_t)MPR * D, (bf16_t*)(ws + WS_HB) + (size_t)MPR * D,
                                  (float*)(ws + WS_SSQ), nullptr, nullptr, nullptr, tid, lane, wave);
            }
            GRID_BAR();
        }
        REPEAT(REP_P4) { if (rep_) { GRID_BAR(); } PH(4) {
            PHASE_BEGIN
            pg8::Gemm g{(const bf16_t*)(ws + WS_HB), (const bf16_t*)(ws + (layer ? WS_WF1 : WS_WF0)), MPAD, 2 * DFF, D}; pg8::StaticOrder S; S.init(MPAD, 2 * DFF, G, (int)blockIdx.x);
            pg8::EpiFfn E{(bf16_t*)(ws + WS_ZG), (bf16_t*)(ws + WS_ZU), (bf16_t*)(ws + WS_U), (float*)(ws + WS_SG), (float*)(ws + WS_SU), a.in[20] + (size_t)layer * 3 * DFF, (const float*)(ws + WS_SSQ), a.out, layer};
            pg8::gemm_phase<pg8::EpiFfn, pg8::StaticOrder, true, true>(lds, g, S, E);
        } }
        GRID_BAR();
        REPEAT(REP_P5) { if (rep_) { GRID_BAR(); } PH(5) { PHASE_BEGIN p5_fix(a, layer, blockIdx.x * NTHREADS + tid, G * NTHREADS); } }
        GRID_BAR();
        REPEAT(REP_P6) { if (rep_) { GRID_BAR(); } PH(6) {
            PHASE_BEGIN
            float* H = (float*)(ws + WS_H);
            pg8::Gemm g{(const bf16_t*)(ws + WS_U), (const bf16_t*)(ws + (layer ? WS_WD1 : WS_WD0)), MPR, D, DFF}; pg8::StaticOrder S; S.init(MPR, D, G, (int)blockIdx.x);
            const bool real_ = (rep_ + 1 == REP_P6);
            pg8::EpiResid E{H, H + (size_t)MPR * D, real_ ? H : (float*)(ws + WS_GA), real_ ? (bf16_t*)(ws + WS_HB) : (bf16_t*)(ws + WS_ZG), real_ ? (float*)(ws + WS_SSQ) : (float*)(ws + WS_ZU)};
            pg8::gemm_phase<pg8::EpiResid, pg8::StaticOrder, true, true>(lds, g, S, E);
            if (real_) sample_gemm<0, DFF>(lds, (const bf16_t*)(ws + WS_U) + (size_t)MPR * DFF, (const bf16_t*)(ws + (layer ? WS_WD1 : WS_WD0)), D, H + (size_t)MPR * D, H + (size_t)MPR * D, (bf16_t*)(ws + WS_HB) + (size_t)MPR * D,
                                (float*)(ws + WS_SSQ), nullptr, nullptr, nullptr, tid, lane, wave);
        } }
        GRID_BAR();
    }
    REPEAT(REP_P13) { if (rep_) { GRID_BAR(); } PH(13) { PHASE_BEGIN p13_final(a, gw, NGW, lane); } }
    }
}

extern "C" void kernel_launch(void* const* d_in, const int* in_sizes, int n_in, void* d_out, int out_size, void* d_ws, size_t ws_size, hipStream_t stream) {
    static int grid = 0;
    if (grid == 0) {
        if (n_in != 22 || (size_t)out_size != O_END || ws_size < WS_END) { fprintf(stderr, "kernel_launch: unexpected shapes (n_in %d, out %d, ws %zu, need %zu)\n", n_in, out_size, ws_size, (size_t)WS_END); grid = -1; return; }
        int dev = 0, cus = 0, per_cu = 0;
        if (hipGetDevice(&dev) != hipSuccess || hipDeviceGetAttribute(&cus, hipDeviceAttributeMultiprocessorCount, dev) != hipSuccess) { grid = -1; return; }
        if (hipFuncSetAttribute((const void*)mega_fwd, hipFuncAttributeMaxDynamicSharedMemorySize, LDS_BYTES) != hipSuccess) { fprintf(stderr, "kernel_launch: hipFuncSetAttribute failed\n"); grid = -1; return; }
        if (hipOccupancyMaxActiveBlocksPerMultiprocessor(&per_cu, (const void*)mega_fwd, NTHREADS, LDS_BYTES) != hipSuccess || per_cu < 1) { fprintf(stderr, "kernel_launch: occupancy query failed (%d)\n", per_cu); (void)hipGetLastError(); grid = -1; return; }
        grid = cus * 1;
    }
    if (grid < 0) return;
    if (hipMemsetAsync((char*)d_ws + WS_CTL, 0, CTL_BYTES, stream) != hipSuccess) { fprintf(stderr, "kernel_launch: memset failed\n"); return; }
    Args a{};
    for (int i = 0; i < 22; ++i) a.in[i] = (const float*)d_in[i];
    a.out = (float*)d_out; a.ws = (unsigned char*)d_ws;
    void* args[] = {&a};
    hipError_t e = hipLaunchCooperativeKernel((const void*)mega_fwd, dim3(grid), dim3(NTHREADS), args, LDS_BYTES, stream);
    if (e != hipSuccess) fprintf(stderr, "cooperative launch failed: %s (grid %d)\n", hipGetErrorString(e), grid);
}
```

```cpp
#include <hip/hip_runtime.h>
#include <hip/hip_cooperative_groups.h>
#include <cstdio>
#include <cstdint>
namespace cg = cooperative_groups;

#define LAS __attribute__((address_space(3)))
typedef unsigned short bf16_t;
typedef short bf16x8 __attribute__((ext_vector_type(8)));
typedef float f32x4 __attribute__((ext_vector_type(4)));
typedef float f32x2 __attribute__((ext_vector_type(2)));
typedef float f32x16 __attribute__((ext_vector_type(16)));
typedef unsigned u32x4 __attribute__((ext_vector_type(4)));
typedef unsigned u32x2 __attribute__((ext_vector_type(2)));
typedef short s16x4 __attribute__((ext_vector_type(4)));

constexpr int D = 1024, SEQ = 2048, NB = 8, MPR = NB * SEQ, NSB = 32, NST = 4, MSA = NSB * NST, MTOT = MPR + MSA, MPAD = 16640;
constexpr int DFF = 2816, NIN = 2560, CH = 512, NH = 16, HD = 64, LBUF = 2048, KA = 31;
constexpr int GAW = 1536;
constexpr float RMS_EPS = 1e-6f, LN_EPS = 1e-5f;
constexpr float LOG2E = 1.4426950408889634f;
constexpr float QSCALE = 0.125f * LOG2E;

constexpr size_t O_YP = 0;
constexpr size_t O_YS = O_YP + (size_t)MPR * D;
constexpr size_t O_PCA = O_YS + (size_t)MSA * D;
constexpr size_t O_SCA = O_PCA + (size_t)NB * 30 * CH;
constexpr size_t O_PCB = O_SCA + (size_t)NSB * 30 * CH;
constexpr size_t O_SCB = O_PCB + (size_t)NB * 2 * CH;
constexpr size_t O_PK = O_SCB + (size_t)NSB * 2 * CH;
constexpr size_t O_SK = O_PK + (size_t)MPR * D;
constexpr size_t O_PV = O_SK + (size_t)NSB * LBUF * D;
constexpr size_t O_SV = O_PV + (size_t)MPR * D;
constexpr size_t O_PF = O_SV + (size_t)NSB * LBUF * D;
constexpr size_t O_SF = O_PF + (size_t)2 * NB * 2 * DFF;
constexpr size_t O_END = O_SF + (size_t)2 * NSB * 2 * DFF;

constexpr size_t al(size_t x) { return (x + 4095) & ~(size_t)4095; }
constexpr size_t WS_CTL = 0, CTL_BYTES = 65536;
constexpr size_t WS_WIN = WS_CTL + CTL_BYTES;
constexpr size_t WS_WOUT = WS_WIN + al((size_t)NIN * D * 2);
constexpr size_t WS_WQKV = WS_WOUT + al((size_t)D * D * 2);
constexpr size_t WS_WO = WS_WQKV + al((size_t)3 * D * D * 2);
constexpr size_t WS_WF0 = WS_WO + al((size_t)D * D * 2);
constexpr size_t WS_WF1 = WS_WF0 + al((size_t)2 * DFF * D * 2);
constexpr size_t WS_WD0 = WS_WF1 + al((size_t)2 * DFF * D * 2);
constexpr size_t WS_WD1 = WS_WD0 + al((size_t)D * DFF * 2);
constexpr size_t WS_HB = WS_WD1 + al((size_t)D * DFF * 2);
constexpr size_t WS_H = WS_HB + al((size_t)MPAD * D * 2);
constexpr size_t WS_SSQ = WS_H + 4096;
constexpr size_t WS_GA = WS_SSQ + al((size_t)MPAD * 64 * 4);
constexpr size_t WS_AB = WS_GA + al((size_t)MPAD * GAW * 2);
constexpr size_t WS_ZG = WS_AB + al((size_t)MPAD * D * 2);
constexpr size_t WS_ZU = WS_ZG + al((size_t)MPAD * DFF * 2);
constexpr size_t WS_U = WS_ZU + al((size_t)MPAD * DFF * 2);
constexpr size_t WS_Q = WS_U + al((size_t)MPAD * DFF * 2);
constexpr size_t WS_K = WS_Q + al((size_t)MPAD * D * 2);
constexpr size_t WS_V = WS_K + al((size_t)MPAD * D * 2);
constexpr size_t WS_QS = WS_V + al((size_t)MPAD * D * 2);
constexpr size_t WS_SG = WS_QS + al((size_t)MSA * D * 4);
constexpr size_t WS_SU = WS_SG + al((size_t)256 * 4 * DFF * 4);
constexpr size_t WS_END = WS_SU + al((size_t)256 * 2 * DFF * 4);
static_assert(WS_V - WS_K == WS_K - WS_Q, "Q|K|V equally spaced");

constexpr int NWAVES = 8, NTHREADS = 512;
constexpr int LDS_BYTES = 163840;
constexpr int MISC_OFF = LDS_BYTES - 1024;

__device__ __forceinline__ unsigned cvt_pk_bf16(float lo, float hi) { unsigned r; asm volatile("v_cvt_pk_bf16_f32 %0, %1, %2" : "=v"(r) : "v"(lo), "v"(hi)); return r; }
__device__ __forceinline__ float bf2f(unsigned short b) { return __uint_as_float((unsigned)b << 16); }
__device__ __forceinline__ float bflo(unsigned w) { return __uint_as_float(w << 16); }
__device__ __forceinline__ float bfhi(unsigned w) { return __uint_as_float(w & 0xffff0000u); }
__device__ __forceinline__ float sigmoidf_(float x) { return __builtin_amdgcn_rcpf(1.0f + __expf(-x)); }
__device__ __forceinline__ int launder_v(int x) { asm volatile("" : "+v"(x)); return x; }
template <int CTRL> __device__ __forceinline__ float dppmov(float v) { return __uint_as_float(__builtin_amdgcn_update_dpp(0u, __float_as_uint(v), CTRL, 0xf, 0xf, true)); }
__device__ __forceinline__ float wave_sum(float v) {
    v += dppmov<0xB1>(v);
    v += dppmov<0x4E>(v);
    v += dppmov<0x141>(v);
    v += dppmov<0x140>(v);
    { auto r = __builtin_amdgcn_permlane16_swap(__float_as_uint(v), __float_as_uint(v), false, false); v = __uint_as_float(r[0]) + __uint_as_float(r[1]); }
    { auto r = __builtin_amdgcn_permlane32_swap(__float_as_uint(v), __float_as_uint(v), false, false); v = __uint_as_float(r[0]) + __uint_as_float(r[1]); }
    return v;
}
__device__ __forceinline__ float wave_max(float v) {
    v = fmaxf(v, dppmov<0xB1>(v)); v = fmaxf(v, dppmov<0x4E>(v)); v = fmaxf(v, dppmov<0x141>(v)); v = fmaxf(v, dppmov<0x140>(v));
    { auto r = __builtin_amdgcn_permlane16_swap(__float_as_uint(v), __float_as_uint(v), false, false); v = fmaxf(__uint_as_float(r[0]), __uint_as_float(r[1])); }
    { auto r = __builtin_amdgcn_permlane32_swap(__float_as_uint(v), __float_as_uint(v), false, false); v = fmaxf(__uint_as_float(r[0]), __uint_as_float(r[1])); }
    return v;
}

namespace pg8 {
constexpr int BM = 256, BK = 64, HALF = 128, HTB = HALF * BK * 2, STAGE_BYTES = 8 * HTB, NXCD = 8, WGM = 8;
__host__ __device__ __forceinline__ int lds_byte(int r, int c) { const int st = (r >> 4) * 2 + (c >> 5), rr = r & 15, cc = c & 31, ob = rr * 64 + cc * 2; return st * 1024 + (ob ^ (((ob >> 9) & 1) << 5)); }
__host__ __device__ __forceinline__ void stage_rc(int b, int& R, int& C) { const int st = b / 1024, sb = b % 1024, swz = sb ^ (((sb >> 9) & 1) << 5); R = (st >> 1) * 16 + swz / 64; C = (st & 1) * 32 + (swz % 64) / 2; }
__host__ __device__ __forceinline__ int perm32(int rho) { const int n = rho >> 4, i = rho & 15; return 8 * (i >> 2) + 4 * n + (i & 3); }

struct Unit { int pm, pn; };
struct Gemm { const bf16_t* A; const bf16_t* Bt; int M, N, K; };

struct StaticOrder {
    int nM, nN, nwg, G, c;
    __host__ __device__ void init(int M, int N, int G_, int c_) { nM = M / BM; nN = N / BM; nwg = nM * nN; G = G_; c = c_; }
    __host__ __device__ bool next(int i, Unit& u) const {
        const long L = (long)i * G + c; if (L >= nwg) return false;
        int wgid = (int)L; { const int q = nwg / NXCD, r = nwg % NXCD, xcd = wgid % NXCD, off = wgid / NXCD; wgid = (xcd < r ? xcd * (q + 1) : r * (q + 1) + (xcd - r) * q) + off; }
        const int nig = WGM * nN, gid = wgid / nig, fm = gid * WGM, gsz = (nM - fm) < WGM ? (nM - fm) : WGM;
        u.pm = fm + ((wgid % nig) % gsz); u.pn = (wgid % nig) / gsz; return true;
    }
    __device__ __forceinline__ void a_ready(const Unit&) const {}
    __device__ __forceinline__ void done(const Unit&) const {}
};

__device__ __forceinline__ float row_rstd(const float* ssq, int r, int fq) {
    float s;
    if (r < MPR) { const f32x4 p = *(const f32x4*)(ssq + (size_t)r * 64 + 4 * fq); s = (p.x + p.y) + (p.z + p.w); }
    else { const f32x4* pp = (const f32x4*)(ssq + (size_t)r * 64 + 16 * fq); const f32x4 p = (pp[0] + pp[1]) + (pp[2] + pp[3]); s = (p.x + p.y) + (p.z + p.w); }
    s += __shfl_xor(s, 16); s += __shfl_xor(s, 32);
    return rsqrtf(s * (1.0f / D) + RMS_EPS);
}

struct EpiInAB {
    static constexpr bool PERM = true, AFTER_DRAIN = false;
    bf16_t* GA; const float* ssq; float* out;
    __device__ __forceinline__ void operator()(const f32x4 (&acc)[2][2][4][2], const Unit& u, int wr, int wc, int fr, int fq) const {
        const int pn = u.pn, colw = wc * 32 + 8 * fq;
#pragma unroll
        for (int ai = 0; ai < 2; ++ai)
#pragma unroll
            for (int m = 0; m < 4; ++m) {
                const int r = u.pm * BM + ai * HALF + wr * 64 + m * 16 + fr;
                const float rs = row_rstd(ssq, r, fq);
                const f32x4 a0 = acc[ai][0][m][0] * rs, a1 = acc[ai][0][m][1] * rs, g0 = acc[ai][1][m][0] * rs, g1 = acc[ai][1][m][1] * rs;
                bf16_t* rowp = GA + (size_t)r * GAW;
                if (pn < 8) {
                    f32x4 v0, v1;
                    if (pn < 4) {
#pragma unroll
                        for (int i = 0; i < 4; ++i) { v0[i] = a0[i] * sigmoidf_(g0[i]); v1[i] = a1[i] * sigmoidf_(g1[i]); }
                    } else { v0 = a0 * g0; v1 = a1 * g1; }
                    const int cl = 128 * (pn & 3) + colw;
                    u32x4 w; w.x = cvt_pk_bf16(v0[0], v0[1]); w.y = cvt_pk_bf16(v0[2], v0[3]); w.z = cvt_pk_bf16(v1[0], v1[1]); w.w = cvt_pk_bf16(v1[2], v1[3]);
                    *(u32x4*)(rowp + (pn < 4 ? 0 : 512) + cl) = w;
                    const int keep = pn < 4 ? 30 : 2;
                    float* sp = nullptr;
                    if (r < MPR) { const int t = r & (SEQ - 1), b = r >> 11; if (t >= SEQ - keep) sp = out + (pn < 4 ? O_PCA : O_PCB) + ((size_t)(b * keep + (t - (SEQ - keep)))) * CH + cl; }
                    else if (r < MTOT) { const int rs_ = r - MPR, sb = rs_ >> 2, j = rs_ & 3; if (j >= NST - keep || keep == 30) sp = out + (pn < 4 ? O_SCA : O_SCB) + ((size_t)(sb * keep + (keep - NST + j))) * CH + cl; }
                    if (sp) { *(f32x4*)sp = v0; *(f32x4*)(sp + 4) = v1; }
                } else {
                    const int c = 1024 + 256 * (pn - 8) + colw;
                    u32x4 w; w.x = cvt_pk_bf16(a0[0], a0[1]); w.y = cvt_pk_bf16(a0[2], a0[3]); w.z = cvt_pk_bf16(a1[0], a1[1]); w.w = cvt_pk_bf16(a1[2], a1[3]);
                    *(u32x4*)(rowp + c) = w;
                    w.x = cvt_pk_bf16(g0[0], g0[1]); w.y = cvt_pk_bf16(g0[2], g0[3]); w.z = cvt_pk_bf16(g1[0], g1[1]); w.w = cvt_pk_bf16(g1[2], g1[3]);
                    *(u32x4*)(rowp + c + 128) = w;
                }
            }
    }
};
struct EpiResid {
    static constexpr bool PERM = false, AFTER_DRAIN = false;
    bf16_t* HB; float* ssq; int skip;
    __device__ __forceinline__ void operator()(const f32x4 (&acc)[2][2][4][2], const Unit& u, int wr, int wc, int fr, int fq) const {
        const int col0 = u.pn * BM + wc * 32 + 4 * fq;
        if (skip) { if (acc[0][0][0][0][0] == 1.2345e-30f) ssq[0] = 0.f; return; }
#pragma unroll
        for (int ai = 0; ai < 2; ++ai) {
            u32x2 bs[4][2][2];
#pragma unroll
            for (int m = 0; m < 4; ++m) { const int r = u.pm * BM + ai * HALF + wr * 64 + m * 16 + fr; const int rc = r < MTOT ? r : MTOT - 1;
#pragma unroll
                for (int bj = 0; bj < 2; ++bj)
#pragma unroll
                    for (int n = 0; n < 2; ++n) bs[m][bj][n] = *(const u32x2*)(HB + (size_t)rc * D + col0 + bj * HALF + n * 16); }
            asm volatile("" ::: "memory");
#pragma unroll
            for (int m = 0; m < 4; ++m) {
                const int r = u.pm * BM + ai * HALF + wr * 64 + m * 16 + fr;
                float s = 0.f;
                if (r < MTOT) {
#pragma unroll
                    for (int bj = 0; bj < 2; ++bj)
#pragma unroll
                        for (int n = 0; n < 2; ++n) {
                            const int c = col0 + bj * HALF + n * 16;
                            const u32x2 b = bs[m][bj][n];
                            const f32x4 v = (f32x4){bflo(b.x), bfhi(b.x), bflo(b.y), bfhi(b.y)} + acc[ai][bj][m][n];
                            s += (v[0] * v[0] + v[1] * v[1]) + (v[2] * v[2] + v[3] * v[3]);
                            u32x2 w; w.x = cvt_pk_bf16(v[0], v[1]); w.y = cvt_pk_bf16(v[2], v[3]);
                            *(u32x2*)(HB + (size_t)r * D + c) = w;
                        }
                }
                s += __shfl_xor(s, 16); s += __shfl_xor(s, 32);
                if (fq == 0 && r < MTOT) ssq[(size_t)r * 64 + u.pn * 4 + wc] = s;
            }
        }
    }
};
template <int CTRL> __device__ __forceinline__ float dpp_f(float old, float src) {
    return __uint_as_float(__builtin_amdgcn_update_dpp(__float_as_uint(old), __float_as_uint(src), CTRL, 0xf, 0xf, false)); }
struct EpiFfn {
    static constexpr bool PERM = true, AFTER_DRAIN = false;
    bf16_t* ZG; bf16_t* ZU; bf16_t* U; float* SG; float* SU; const float* wcv; const float* ssq; float* out; int layer;
    __device__ __forceinline__ void operator()(const f32x4 (&acc)[2][2][4][2], const Unit& u, int wr, int wc, int fr, int fq) const {
        const int col = u.pn * 128 + wc * 32 + 8 * fq;
        if (u.pm >= MPR / BM) {
#pragma unroll
            for (int ai = 0; ai < 2; ++ai)
#pragma unroll
                for (int m = 0; m < 4; ++m) {
                    const int r = u.pm * BM + ai * HALF + wr * 64 + m * 16 + fr;
                    const float rs = row_rstd(ssq, r, fq);
                    const f32x4 g0 = acc[ai][0][m][0] * rs, g1 = acc[ai][0][m][1] * rs, u0 = acc[ai][1][m][0] * rs, u1 = acc[ai][1][m][1] * rs;
                    u32x4 w; w.x = cvt_pk_bf16(g0[0], g0[1]); w.y = cvt_pk_bf16(g0[2], g0[3]); w.z = cvt_pk_bf16(g1[0], g1[1]); w.w = cvt_pk_bf16(g1[2], g1[3]);
                    *(u32x4*)(ZG + (size_t)r * DFF + col) = w;
                    w.x = cvt_pk_bf16(u0[0], u0[1]); w.y = cvt_pk_bf16(u0[2], u0[3]); w.z = cvt_pk_bf16(u1[0], u1[1]); w.w = cvt_pk_bf16(u1[2], u1[3]);
                    *(u32x4*)(ZU + (size_t)r * DFF + col) = w;
                    if (r < MTOT) { const int rs_ = r - MPR, sb = rs_ >> 2, j = rs_ & 3;
                        if (j >= 2) { float* sp = out + O_SF + ((size_t)((layer * NSB + sb) * 2 + (j - 2))) * DFF + col; *(f32x4*)sp = g0; *(f32x4*)(sp + 4) = g1; } }
                }
            return;
        }
        f32x4 w0[2], w1[2], w2[2];
#pragma unroll
        for (int n = 0; n < 2; ++n) { w0[n] = *(const f32x4*)(wcv + col + 4 * n); w1[n] = *(const f32x4*)(wcv + DFF + col + 4 * n); w2[n] = *(const f32x4*)(wcv + 2 * DFF + col + 4 * n); }
#pragma unroll
        for (int ai = 0; ai < 2; ++ai) {
            const int blk = u.pm * 4 + ai * 2 + wr;
            f32x4 gp[2];
            gp[0] = (f32x4){0.f, 0.f, 0.f, 0.f}; gp[1] = gp[0];
#pragma unroll
            for (int m = 0; m < 4; ++m) {
                const int r = blk * 64 + m * 16 + fr;
                const float rs = row_rstd(ssq, r, fq);
                f32x4 g[2], up[2], o[2];
#pragma unroll
                for (int n = 0; n < 2; ++n) { g[n] = acc[ai][0][m][n] * rs; up[n] = acc[ai][1][m][n] * rs; }
#pragma unroll
                for (int n = 0; n < 2; ++n)
#pragma unroll
                    for (int i = 0; i < 4; ++i) {
                        const float x1 = dpp_f<0x121>(0.f, gp[n][i]), gm1 = dpp_f<0x111>(x1, g[n][i]);
                        const float x2 = dpp_f<0x122>(0.f, gp[n][i]), gm2 = dpp_f<0x112>(x2, g[n][i]);
                        const float y = w0[n][i] * gm2 + w1[n][i] * gm1 + w2[n][i] * g[n][i];
                        o[n][i] = y * sigmoidf_(y) * up[n][i];
                    }
                const bool seam_lo = (m == 0) && (fr < 2), seam_hi = (m == 3) && (fr >= 14);
                if (!seam_lo) { u32x4 w; w.x = cvt_pk_bf16(o[0][0], o[0][1]); w.y = cvt_pk_bf16(o[0][2], o[0][3]); w.z = cvt_pk_bf16(o[1][0], o[1][1]); w.w = cvt_pk_bf16(o[1][2], o[1][3]);
                    *(u32x4*)(U + (size_t)r * DFF + col) = w; }
                else { float* sg = SG + ((size_t)blk * 4 + fr) * DFF + col; *(f32x4*)sg = g[0]; *(f32x4*)(sg + 4) = g[1];
                       float* su = SU + ((size_t)blk * 2 + fr) * DFF + col; *(f32x4*)su = up[0]; *(f32x4*)(su + 4) = up[1]; }
                if (seam_hi) { float* sg = SG + ((size_t)blk * 4 + 2 + (fr - 14)) * DFF + col; *(f32x4*)sg = g[0]; *(f32x4*)(sg + 4) = g[1];
                    const int t = r & (SEQ - 1), b = r >> 11;
                    if (t >= SEQ - 2) { float* sp = out + O_PF + ((size_t)((layer * NB + b) * 2 + (t - (SEQ - 2)))) * DFF + col; *(f32x4*)sp = g[0]; *(f32x4*)(sp + 4) = g[1]; } }
                gp[0] = g[0]; gp[1] = g[1];
            }
        }
    }
};
struct EpiQkv {
    static constexpr bool PERM = true, AFTER_DRAIN = false;
    bf16_t* QKV; float* QS; const float* ssq; float* out;
    __device__ __forceinline__ void operator()(const f32x4 (&acc)[2][2][4][2], const Unit& u, int wr, int wc, int fr, int fq) const {
        const int which = u.pn >> 2, cb = 256 * (u.pn & 3) + wc * 32 + 8 * fq;
        bf16_t* dst = QKV + (size_t)which * ((WS_K - WS_Q) / 2);
#pragma unroll
        for (int ai = 0; ai < 2; ++ai)
#pragma unroll
            for (int m = 0; m < 4; ++m) {
                const int r = u.pm * BM + ai * HALF + wr * 64 + m * 16 + fr;
                const float rs = row_rstd(ssq, r, fq) * (which == 0 ? QSCALE : 1.0f);
                float* fp = nullptr;
                if (which == 0) { if (r >= MPR && r < MTOT) fp = QS + (size_t)(r - MPR) * D; }
                else if (r < MPR) fp = out + (which == 1 ? O_PK : O_PV) + (size_t)r * D;
                else if (r < MTOT) { const int rs_ = r - MPR, sb = rs_ >> 2, j = rs_ & 3; fp = out + (which == 1 ? O_SK : O_SV) + ((size_t)sb * LBUF + (LBUF - NST) + j) * D; }
#pragma unroll
                for (int bj = 0; bj < 2; ++bj) {
                    const f32x4 v0 = acc[ai][bj][m][0] * rs, v1 = acc[ai][bj][m][1] * rs;
                    const int c = cb + bj * HALF;
                    u32x4 w; w.x = cvt_pk_bf16(v0[0], v0[1]); w.y = cvt_pk_bf16(v0[2], v0[3]); w.z = cvt_pk_bf16(v1[0], v1[1]); w.w = cvt_pk_bf16(v1[2], v1[3]);
                    *(u32x4*)(dst + (size_t)r * D + c) = w;
                    if (fp) { *(f32x4*)(fp + c) = v0; *(f32x4*)(fp + c + 4) = v1; }
                }
            }
    }
};

template <class Epi, class Sched, bool ALIGN_EPI = false, bool SP2 = false>
__device__ __forceinline__ void gemm_phase(LAS unsigned char* lds, const Gemm g, const Sched& S, const Epi& E) {
    const int tid = launder_v(threadIdx.x), wid = __builtin_amdgcn_readfirstlane(tid >> 6), lane = tid & 63, wr = wid >> 2, wc = wid & 3, fr = lane & 15, fq = lane >> 4;
    const int K = g.K, nt = K / BK;
    unsigned voffA[2], voffB[2];
#pragma unroll
    for (int i = 0; i < 2; ++i) { int R, C; stage_rc(tid * 16 + i * 8192, R, C); const int Rb = Epi::PERM ? ((R & ~31) + perm32(R & 31)) : R;
        voffA[i] = (unsigned)(R * K + C) * 2u; voffB[i] = (unsigned)(Rb * K + C) * 2u; }
    const size_t kstep = (size_t)(BK * 2);
    const size_t hstep = (size_t)HALF * K * 2;
    const size_t tstep = 2 * hstep;
    const unsigned ldsw = (unsigned)wid * 1024u;
    const int aoff = lds_byte(wr * 64 + fr, fq * 8), boff = lds_byte(wc * 32 + fr, fq * 8);
#define PG8_SA(b, h) (((b) * 2 + (h)) * HTB)
#define PG8_SB(b, h) ((4 + (b) * 2 + (h)) * HTB)
#define PG8_STAGE(bufoff, gbase, voff) do { _Pragma("unroll") for (int _i = 0; _i < 2; ++_i) \
        __builtin_amdgcn_global_load_lds((const unsigned*)((const char*)(gbase) + (voff)[_i]), (LAS unsigned*)(lds + (bufoff) + ldsw + _i * 8192), 16, 0, 0); } while (0)
#define PG8_LDA(dst, b, h) do { _Pragma("unroll") for (int m = 0; m < 4; ++m) _Pragma("unroll") for (int k = 0; k < 2; ++k) dst[m][k] = *(const LAS bf16x8*)(lds + PG8_SA(b, h) + aoff + m * 2048 + k * 1024); } while (0)
#define PG8_LDB(dst, b, h) do { _Pragma("unroll") for (int n = 0; n < 2; ++n) _Pragma("unroll") for (int k = 0; k < 2; ++k) dst[n][k] = *(const LAS bf16x8*)(lds + PG8_SB(b, h) + boff + n * 2048 + k * 1024); } while (0)
#define PG8_MMA(ai, bj, At, Bt) do { __builtin_amdgcn_s_setprio(1); _Pragma("unroll") for (int m = 0; m < 4; ++m) _Pragma("unroll") for (int n = 0; n < 2; ++n) _Pragma("unroll") for (int k = 0; k < 2; ++k) \
        acc[ai][bj][m][n] = __builtin_amdgcn_mfma_f32_16x16x32_bf16(Bt[n][k], At[m][k], acc[ai][bj][m][n], 0, 0, 0); __builtin_amdgcn_s_setprio(0); } while (0)
#define PG8_WAIT_V(n) asm volatile("s_waitcnt vmcnt(" #n ")" ::: "memory")
#define PG8_WAIT_L(n) asm volatile("s_waitcnt lgkmcnt(" #n ")" ::: "memory")
#define PG8_BAR __builtin_amdgcn_s_barrier()
#define PG8_SCHED __builtin_amdgcn_sched_barrier(0)
    Unit cur, nxt; int ui = 0;
    if (!S.next(0, cur)) return;
    f32x4 acc[2][2][4][2];
#pragma unroll
    for (int a = 0; a < 2; ++a)
#pragma unroll
        for (int b = 0; b < 2; ++b)
#pragma unroll
            for (int m = 0; m < 4; ++m)
#pragma unroll
                for (int n = 0; n < 2; ++n) acc[a][b][m][n] = (f32x4){0.f, 0.f, 0.f, 0.f};
    bf16x8 At[4][2], B0[2][2], B1[2][2];
    const char* cA = (const char*)g.A + (size_t)cur.pm * tstep; const char* cB = (const char*)g.Bt + (size_t)cur.pn * tstep;
    S.a_ready(cur);
    if constexpr (SP2) {
        PG8_STAGE(PG8_SB(0, 0), cB, voffB); PG8_STAGE(PG8_SB(0, 1), cB + hstep, voffB); PG8_STAGE(PG8_SA(0, 0), cA, voffA); PG8_STAGE(PG8_SA(0, 1), cA + hstep, voffA);
        if (wr == 1) PG8_BAR;
        PG8_WAIT_V(2); PG8_BAR;
        PG8_STAGE(PG8_SB(1, 0), cB + kstep, voffB); PG8_STAGE(PG8_SA(1, 0), cA + kstep, voffA); PG8_STAGE(PG8_SB(1, 1), cB + hstep + kstep, voffB);
        PG8_WAIT_V(6); PG8_BAR;
    } else {
        PG8_STAGE(PG8_SB(0, 0), cB, voffB); PG8_STAGE(PG8_SA(0, 0), cA, voffA); PG8_STAGE(PG8_SB(0, 1), cB + hstep, voffB); PG8_STAGE(PG8_SA(0, 1), cA + hstep, voffA);
        if (wr == 1) PG8_BAR;
        PG8_WAIT_V(4); PG8_BAR;
        PG8_STAGE(PG8_SB(1, 0), cB + kstep, voffB); PG8_STAGE(PG8_SA(1, 0), cA + kstep, voffA); PG8_STAGE(PG8_SB(1, 1), cB + hstep + kstep, voffB);
        PG8_WAIT_V(6); PG8_BAR;
    }
    for (;;) {
        const bool has_next = S.next(ui + 1, nxt);
        const char* nA = has_next ? (const char*)g.A + (size_t)nxt.pm * tstep : cA; const char* nB = has_next ? (const char*)g.Bt + (size_t)nxt.pn * tstep : cB;
        for (int t = 0; t < nt; t += 2) {
            const bool last = (t == nt - 2);
            const char* a1 = cA + (size_t)(t + 1) * kstep;
            const char* a2 = last ? nA : cA + (size_t)(t + 2) * kstep; const char* b2 = last ? nB : cB + (size_t)(t + 2) * kstep;
            const char* a3 = a2 + kstep; const char* b3 = b2 + kstep;
            if (last && has_next) S.a_ready(nxt);
            if constexpr (SP2) {
            PG8_LDB(B0, 0, 0); PG8_LDB(B1, 0, 1); PG8_SCHED; PG8_LDA(At, 0, 0); PG8_STAGE(PG8_SA(1, 1), a1 + hstep, voffA);
            PG8_WAIT_V(8); PG8_WAIT_L(0); PG8_BAR; PG8_MMA(0, 0, At, B0); PG8_MMA(0, 1, At, B1); PG8_BAR; PG8_SCHED;
            PG8_LDA(At, 0, 1); PG8_STAGE(PG8_SB(0, 0), b2, voffB); PG8_STAGE(PG8_SB(0, 1), b2 + hstep, voffB); PG8_STAGE(PG8_SA(0, 0), a2, voffA);
            PG8_WAIT_V(8); PG8_WAIT_L(0); PG8_BAR; PG8_MMA(1, 0, At, B0); PG8_MMA(1, 1, At, B1); PG8_BAR; PG8_SCHED;
            PG8_LDB(B0, 1, 0); PG8_LDB(B1, 1, 1); PG8_SCHED; PG8_LDA(At, 1, 0); PG8_STAGE(PG8_SA(0, 1), a2 + hstep, voffA);
            PG8_WAIT_V(8); PG8_WAIT_L(0); PG8_BAR; PG8_MMA(0, 0, At, B0); PG8_MMA(0, 1, At, B1); PG8_BAR; PG8_SCHED;
            PG8_LDA(At, 1, 1); PG8_STAGE(PG8_SB(1, 0), b3, voffB); PG8_STAGE(PG8_SB(1, 1), b3 + hstep, voffB); PG8_STAGE(PG8_SA(1, 0), a3, voffA);
            PG8_WAIT_V(8); PG8_WAIT_L(0); PG8_BAR; PG8_MMA(1, 0, At, B0); PG8_MMA(1, 1, At, B1); PG8_BAR; PG8_SCHED;
            } else {
            PG8_LDB(B0, 0, 0); PG8_SCHED; PG8_LDA(At, 0, 0); PG8_STAGE(PG8_SA(1, 1), a1 + hstep, voffA);
            PG8_WAIT_L(8); PG8_BAR; PG8_WAIT_L(0); PG8_MMA(0, 0, At, B0); PG8_BAR; PG8_SCHED;
            PG8_LDB(B1, 0, 1); PG8_STAGE(PG8_SB(0, 0), b2, voffB);
            PG8_BAR; PG8_WAIT_L(0); PG8_MMA(0, 1, At, B1); PG8_BAR;
            PG8_LDA(At, 0, 1); PG8_STAGE(PG8_SA(0, 0), a2, voffA);
            PG8_BAR; PG8_WAIT_L(0); PG8_MMA(1, 0, At, B0); PG8_BAR; PG8_SCHED;
            PG8_STAGE(PG8_SB(0, 1), b2 + hstep, voffB);
            PG8_WAIT_V(6); PG8_BAR; PG8_MMA(1, 1, At, B1); PG8_BAR;
            PG8_LDB(B0, 1, 0); PG8_SCHED; PG8_LDA(At, 1, 0); PG8_STAGE(PG8_SA(0, 1), a2 + hstep, voffA);
            PG8_WAIT_L(8); PG8_BAR; PG8_WAIT_L(0); PG8_MMA(0, 0, At, B0); PG8_BAR; PG8_SCHED;
            PG8_LDB(B1, 1, 1); PG8_STAGE(PG8_SB(1, 0), b3, voffB);
            PG8_BAR; PG8_WAIT_L(0); PG8_MMA(0, 1, At, B1); PG8_BAR;
            PG8_LDA(At, 1, 1); PG8_STAGE(PG8_SA(1, 0), a3, voffA);
            PG8_BAR; PG8_WAIT_L(0); PG8_MMA(1, 0, At, B0); PG8_BAR; PG8_SCHED;
            PG8_STAGE(PG8_SB(1, 1), b3 + hstep, voffB);
            PG8_WAIT_V(6); PG8_BAR; PG8_MMA(1, 1, At, B1); PG8_BAR;
            }
        }
        if constexpr (ALIGN_EPI) { if (wr == 0) PG8_BAR; }
        if constexpr (!Epi::AFTER_DRAIN) { E(acc, cur, wr, wc, fr, fq); S.done(cur); }
        if (!has_next) break;
#pragma unroll
        for (int a = 0; a < 2; ++a)
#pragma unroll
            for (int b = 0; b < 2; ++b)
#pragma unroll
                for (int m = 0; m < 4; ++m)
#pragma unroll
                    for (int n = 0; n < 2; ++n) acc[a][b][m][n] = (f32x4){0.f, 0.f, 0.f, 0.f};
        cur = nxt; cA = nA; cB = nB; ++ui;
        if constexpr (ALIGN_EPI) { if (wr == 1) PG8_BAR; }
    }
    PG8_WAIT_V(0);
    if constexpr (!ALIGN_EPI) { if (wr == 0) PG8_BAR; }
    PG8_BAR;
#undef PG8_SA
#undef PG8_SB
#undef PG8_STAGE
#undef PG8_LDA
#undef PG8_LDB
#undef PG8_MMA
#undef PG8_WAIT_V
#undef PG8_WAIT_L
#undef PG8_BAR
#undef PG8_SCHED
}
}

__device__ __forceinline__ void transpose_item(const float* W, int K, int N, bf16_t* WT, int k0, int np0, int srcn0, const float* g, LAS float* scr, int lane) {
    f32x4 v[8];
#pragma unroll
    for (int i = 0; i < 8; ++i) { const int kk = 8 * i + (lane >> 3); v[i] = *(const f32x4*)(W + (size_t)(k0 + kk) * N + srcn0 + (lane & 7) * 4); }
#pragma unroll
    for (int i = 0; i < 8; ++i) { const int kk = 8 * i + (lane >> 3); const float gg = g ? g[k0 + kk] : 1.0f; LAS float* d = scr + kk * 33 + (lane & 7) * 4;
        d[0] = v[i].x * gg; d[1] = v[i].y * gg; d[2] = v[i].z * gg; d[3] = v[i].w * gg; }
    asm volatile("s_waitcnt lgkmcnt(0)" ::: "memory");
    const int c = lane & 7;
#pragma unroll
    for (int j = 0; j < 4; ++j) { const int n = (lane >> 3) + 8 * j; const LAS float* s = scr + (8 * c) * 33 + n;
        u32x4 o; o.x = cvt_pk_bf16(s[0 * 33], s[1 * 33]); o.y = cvt_pk_bf16(s[2 * 33], s[3 * 33]); o.z = cvt_pk_bf16(s[4 * 33], s[5 * 33]); o.w = cvt_pk_bf16(s[6 * 33], s[7 * 33]);
        *(u32x4*)(WT + (size_t)(np0 + n) * K + k0 + 8 * c) = o; }
    asm volatile("s_waitcnt lgkmcnt(0)" ::: "memory");
}
__device__ __forceinline__ int src_in_ab(int np) {
    const int pn = np >> 8, cc = np & 255, bj = cc >> 7, off = cc & 127;
    if (pn < 4) return (bj ? 512 : 0) + 128 * pn + off;
    if (pn < 8) return (bj ? 2048 : 1536) + 128 * (pn - 4) + off;
    return 1024 + 256 * (pn - 8) + cc;
}
__device__ __forceinline__ int src_ffn(int np) { const int pn = np >> 8, cc = np & 255, bj = cc >> 7, off = cc & 127; return (bj ? DFF : 0) + 128 * pn + off; }

struct Args { const float* in[22]; float* out; unsigned char* ws; };

__device__ __forceinline__ void p0_prologue(const Args& a, LAS unsigned char* lds, int gw, int NGW, int lane, int wave) {
    LAS float* scr = (LAS float*)(lds + wave * 16384);
    unsigned char* ws = a.ws;
    constexpr int I_IN = (D / 64) * (NIN / 32), I_SQ = (D / 64) * (D / 32), I_QKV = (D / 64) * (3 * D / 32), I_F = (D / 64) * (2 * DFF / 32), I_DN = (DFF / 64) * (D / 32);
    constexpr int NITEMS = I_IN + 2 * I_SQ + I_QKV + 2 * I_F + 2 * I_DN;
    for (int it = gw; it < NITEMS; it += NGW) {
        int r = it;
        if (r < I_IN) { const int nb = NIN / 32, kb = r / nb, n0 = 32 * (r % nb); transpose_item(a.in[10], D, NIN, (bf16_t*)(ws + WS_WIN), 64 * kb, n0, src_in_ab(n0), a.in[7], scr, lane); continue; } r -= I_IN;
        if (r < I_SQ) { const int nb = D / 32, kb = r / nb, n0 = 32 * (r % nb); transpose_item(a.in[16], D, D, (bf16_t*)(ws + WS_WOUT), 64 * kb, n0, n0, nullptr, scr, lane); continue; } r -= I_SQ;
        if (r < I_QKV) { const int nb = 3 * D / 32, kb = r / nb, n0 = 32 * (r % nb); transpose_item(a.in[17], D, 3 * D, (bf16_t*)(ws + WS_WQKV), 64 * kb, n0, n0, a.in[7] + D, scr, lane); continue; } r -= I_QKV;
        if (r < I_SQ) { const int nb = D / 32, kb = r / nb, n0 = 32 * (r % nb); transpose_item(a.in[18], D, D, (bf16_t*)(ws + WS_WO), 64 * kb, n0, n0, nullptr, scr, lane); continue; } r -= I_SQ;
        if (r < 2 * I_F) { const int l = r / I_F; r -= l * I_F; const int nb = 2 * DFF / 32, kb = r / nb, n0 = 32 * (r % nb);
            transpose_item(a.in[19] + (size_t)l * D * 2 * DFF, D, 2 * DFF, (bf16_t*)(ws + (l ? WS_WF1 : WS_WF0)), 64 * kb, n0, src_ffn(n0), a.in[8] + l * D, scr, lane); continue; } r -= 2 * I_F;
        { const int l = r / I_DN; r -= l * I_DN; const int nb = D / 32, kb = r / nb, n0 = 32 * (r % nb);
            transpose_item(a.in[21] + (size_t)l * DFF * D, DFF, D, (bf16_t*)(ws + (l ? WS_WD1 : WS_WD0)), 64 * kb, n0, n0, nullptr, scr, lane); }
    }
    bf16_t* HB = (bf16_t*)(ws + WS_HB); float* ssq = (float*)(ws + WS_SSQ);
    for (int r0 = gw; r0 < MPAD; r0 += 2 * NGW) {
        f32x4 v[2][4]; float sq[2];
#pragma unroll
        for (int h = 0; h < 2; ++h) { const int r = r0 + h * NGW; sq[h] = 0.f;
            if (r < MTOT) { const f32x4* xr = (const f32x4*)((r < MPR) ? a.in[0] + (size_t)r * D : a.in[1] + (size_t)(r - MPR) * D) + lane;
#pragma unroll
                for (int j = 0; j < 4; ++j) v[h][j] = __builtin_nontemporal_load(xr + 64 * j); }
            else {
#pragma unroll
                for (int j = 0; j < 4; ++j) v[h][j] = (f32x4){0.f, 0.f, 0.f, 0.f}; } }
#pragma unroll
        for (int h = 0; h < 2; ++h) { const int r = r0 + h * NGW; if (r >= MPAD) continue;
#pragma unroll
            for (int j = 0; j < 4; ++j) sq[h] += (v[h][j].x * v[h][j].x + v[h][j].y * v[h][j].y) + (v[h][j].z * v[h][j].z + v[h][j].w * v[h][j].w);
            const float s = wave_sum(sq[h]);
            u32x2* o8 = (u32x2*)(HB + (size_t)r * D) + lane;
#pragma unroll
            for (int j = 0; j < 4; ++j) { u32x2 w; w.x = cvt_pk_bf16(v[h][j].x, v[h][j].y); w.y = cvt_pk_bf16(v[h][j].z, v[h][j].w); o8[64 * j] = w; }
            if (r < MPR) { if (lane < 16) ssq[(size_t)r * 64 + lane] = (lane == 0) ? s : 0.f; } else ssq[(size_t)r * 64 + lane] = (lane == 0) ? s : 0.f; }
    }
    {
        const int tot = NSB * 26 * (CH / 4);
        for (int i = gw * 64 + lane; i < tot; i += NGW * 64) { const int sb = i / (26 * (CH / 4)), rem = i % (26 * (CH / 4));
            ((f32x4*)(a.out + O_SCA + (size_t)sb * 30 * CH))[rem] = ((const f32x4*)(a.in[2] + (size_t)sb * 30 * CH + 4 * CH))[rem]; }
    }
    {
        const size_t per = (size_t)(LBUF - NST) * D / 4;
        const size_t tot = per * NSB, stride = (size_t)NGW * 64;
        for (size_t i0 = (size_t)gw * 64 + lane; i0 < tot; i0 += 4 * stride) {
            f32x4 kv[4], vv[4];
#pragma unroll
            for (int u = 0; u < 4; ++u) { const size_t i = i0 + u * stride; if (i < tot) { const size_t sb = i / per, rem = i % per;
                kv[u] = __builtin_nontemporal_load((const f32x4*)(a.in[4] + (sb * LBUF + NST) * D) + rem); vv[u] = __builtin_nontemporal_load((const f32x4*)(a.in[5] + (sb * LBUF + NST) * D) + rem); } }
#pragma unroll
            for (int u = 0; u < 4; ++u) { const size_t i = i0 + u * stride; if (i < tot) { const size_t sb = i / per, rem = i % per;
                __builtin_nontemporal_store(kv[u], (f32x4*)(a.out + O_SK + sb * LBUF * D) + rem); __builtin_nontemporal_store(vv[u], (f32x4*)(a.out + O_SV + sb * LBUF * D) + rem); } }
        }
    }
}

__device__ __forceinline__ void p2_conv(const Args& a, LAS unsigned char* lds, int tid, int lane, int wave) {
    unsigned char* ws = a.ws;
    const bf16_t* GA = (const bf16_t*)(ws + WS_GA); bf16_t* AB = (bf16_t*)(ws + WS_AB);
    LAS float* T = (LAS float*)lds;
    for (int u = blockIdx.x; u < 512 + NSB; u += gridDim.x) {
        const float* wa = a.in[11]; const float* ba = a.in[12]; const float* lg = a.in[13]; const float* lb = a.in[14]; const float* wb = a.in[15];
        asm volatile("" : "+s"(wa), "+s"(ba), "+s"(lg), "+s"(lb), "+s"(wb));
        const bool samp = u >= 512; const int sb = u - 512;
        const int row0 = samp ? MPR + sb * NST : u * 32, nrows = samp ? NST : 32;
        const int t0 = samp ? 0 : (row0 & (SEQ - 1));
        const int nvec = (nrows + 30) * (CH / 8);
        {
            u32x4 wv[8];
#pragma unroll
            for (int it = 0; it < 8; ++it) { const int i = tid + it * NTHREADS; const int e = i >> 6, c = (i & 63) * 8; const int p = t0 - 30 + e;
                wv[it] = (u32x4){0u, 0u, 0u, 0u};
                if (i < nvec && p >= 0) wv[it] = *(const u32x4*)(GA + (size_t)(row0 - t0 + p) * GAW + c); }
#pragma unroll
            for (int it = 0; it < 8; ++it) { const int i = tid + it * NTHREADS; const int e = i >> 6, c = (i & 63) * 8; const int p = t0 - 30 + e;
                if (i < nvec && (p >= 0 || !samp)) { const u32x4 w = wv[it];
                    *(LAS f32x4*)(T + e * CH + c) = (f32x4){bflo(w.x), bfhi(w.x), bflo(w.y), bfhi(w.y)}; *(LAS f32x4*)(T + e * CH + c + 4) = (f32x4){bflo(w.z), bfhi(w.z), bflo(w.w), bfhi(w.w)}; } }
            if (samp) {
                f32x4 s0_[4], s1_[4];
#pragma unroll
                for (int it = 0; it < 4; ++it) { const int i = tid + it * NTHREADS; if (i < 30 * 64) { const float* sp = a.in[2] + ((size_t)sb * 30 + (i >> 6)) * CH + (i & 63) * 8; s0_[it] = *(const f32x4*)sp; s1_[it] = *(const f32x4*)(sp + 4); } }
#pragma unroll
                for (int it = 0; it < 4; ++it) { const int i = tid + it * NTHREADS; if (i < 30 * 64) { *(LAS f32x4*)(T + (i >> 6) * CH + (i & 63) * 8) = s0_[it]; *(LAS f32x4*)(T + (i >> 6) * CH + (i & 63) * 8 + 4) = s1_[it]; } }
            }
        }
        __syncthreads();
        if (tid < 256) {
            const int c = 2 * tid; f32x2 w[KA];
#pragma unroll
            for (int k = 0; k < KA; ++k) w[k] = *(const f32x2*)(wa + k * CH + c);
            const f32x2 bias = *(const f32x2*)(ba + c);
            if (!samp) {
#pragma clang loop unroll(disable)
                for (int hb = 0; hb < 32; hb += 16) {
                    f32x2 x[46];
#pragma unroll
                    for (int e = 0; e < 46; ++e) x[e] = *(const LAS f32x2*)(T + (hb + e) * CH + c);
#pragma unroll
                    for (int i = 0; i < 16; ++i) {
                        f32x2 s0 = bias, s1 = (f32x2){0.f, 0.f}, s2 = s1, s3 = s1;
#pragma unroll
                        for (int k = 0; k < 28; k += 4) { s0 += w[k] * x[i + k]; s1 += w[k + 1] * x[i + k + 1]; s2 += w[k + 2] * x[i + k + 2]; s3 += w[k + 3] * x[i + k + 3]; }
                        s0 += w[28] * x[i + 28]; s1 += w[29] * x[i + 29]; s2 += w[30] * x[i + 30];
                        *(LAS f32x2*)(T + (hb + i) * CH + c) = (s0 + s1) + (s2 + s3);
                    }
                }
            } else {
                f32x2 x[34];
#pragma unroll
                for (int e = 0; e < 34; ++e) x[e] = *(const LAS f32x2*)(T + e * CH + c);
#pragma unroll
                for (int i = 0; i < NST; ++i) {
                    f32x2 s0 = bias, s1 = (f32x2){0.f, 0.f}, s2 = s1, s3 = s1;
#pragma unroll
                    for (int k = 0; k < 28; k += 4) { s0 += w[k] * x[i + k]; s1 += w[k + 1] * x[i + k + 1]; s2 += w[k + 2] * x[i + k + 2]; s3 += w[k + 3] * x[i + k + 3]; }
                    s0 += w[28] * x[i + 28]; s1 += w[29] * x[i + 29]; s2 += w[30] * x[i + 30];
                    *(LAS f32x2*)(T + i * CH + c) = (s0 + s1) + (s2 + s3);
                }
            }
        } else {
            const int t2 = tid - 256, c = (t2 & 63) * 8, rc = t2 >> 6, rbase = rc * 8;
            const int nr = samp ? (rc == 0 ? NST : 0) : 8;
            float wk[3][8];
#pragma unroll
            for (int k = 0; k < 3; ++k) { const f32x4 wa0 = *(const f32x4*)(wb + k * CH + c), wa1 = *(const f32x4*)(wb + k * CH + c + 4);
                wk[k][0] = wa0.x; wk[k][1] = wa0.y; wk[k][2] = wa0.z; wk[k][3] = wa0.w; wk[k][4] = wa1.x; wk[k][5] = wa1.y; wk[k][6] = wa1.z; wk[k][7] = wa1.w; }
            float xm2[8], xm1[8];
            {
                u32x4 a2 = (u32x4){0u, 0u, 0u, 0u}, a1 = a2;
                if (nr && t0 + rbase - 2 >= 0) { a2 = *(const u32x4*)(GA + (size_t)(row0 + rbase - 2) * GAW + 512 + c); a1 = *(const u32x4*)(GA + (size_t)(row0 + rbase - 1) * GAW + 512 + c); }
                xm2[0] = bflo(a2.x); xm2[1] = bfhi(a2.x); xm2[2] = bflo(a2.y); xm2[3] = bfhi(a2.y); xm2[4] = bflo(a2.z); xm2[5] = bfhi(a2.z); xm2[6] = bflo(a2.w); xm2[7] = bfhi(a2.w);
                xm1[0] = bflo(a1.x); xm1[1] = bfhi(a1.x); xm1[2] = bflo(a1.y); xm1[3] = bfhi(a1.y); xm1[4] = bflo(a1.z); xm1[5] = bfhi(a1.z); xm1[6] = bflo(a1.w); xm1[7] = bfhi(a1.w);
                if (samp && nr) { const float* sp = a.in[3] + (size_t)sb * 2 * CH + c; const f32x4 p0 = *(const f32x4*)sp, p1 = *(const f32x4*)(sp + 4), q0 = *(const f32x4*)(sp + CH), q1 = *(const f32x4*)(sp + CH + 4);
                    xm2[0] = p0.x; xm2[1] = p0.y; xm2[2] = p0.z; xm2[3] = p0.w; xm2[4] = p1.x; xm2[5] = p1.y; xm2[6] = p1.z; xm2[7] = p1.w;
                    xm1[0] = q0.x; xm1[1] = q0.y; xm1[2] = q0.z; xm1[3] = q0.w; xm1[4] = q1.x; xm1[5] = q1.y; xm1[6] = q1.z; xm1[7] = q1.w; }
            }
#pragma clang loop unroll(disable)
            for (int k0 = 0; k0 < nr; k0 += 4) {
                u32x4 cxv[4], gbv[4];
#pragma unroll
                for (int k = 0; k < 4; ++k) { cxv[k] = *(const u32x4*)(GA + (size_t)(row0 + rbase + k0 + k) * GAW + 512 + c); gbv[k] = *(const u32x4*)(GA + (size_t)(row0 + rbase + k0 + k) * GAW + 1024 + c); }
#pragma unroll
                for (int k = 0; k < 4; ++k) {
                    const u32x4 xv = cxv[k], gv = gbv[k];
                    float o[8];
#pragma unroll
                    for (int e = 0; e < 8; ++e) {
                        const unsigned xw = e < 2 ? xv.x : (e < 4 ? xv.y : (e < 6 ? xv.z : xv.w)), gw_ = e < 2 ? gv.x : (e < 4 ? gv.y : (e < 6 ? gv.z : gv.w));
                        const float x0 = (e & 1) ? bfhi(xw) : bflo(xw), gb = (e & 1) ? bfhi(gw_) : bflo(gw_);
                        o[e] = gb * (wk[0][e] * xm2[e] + wk[1][e] * xm1[e] + wk[2][e] * x0); xm2[e] = xm1[e]; xm1[e] = x0; }
                    u32x4 w4; w4.x = cvt_pk_bf16(o[0], o[1]); w4.y = cvt_pk_bf16(o[2], o[3]); w4.z = cvt_pk_bf16(o[4], o[5]); w4.w = cvt_pk_bf16(o[6], o[7]);
                    *(u32x4*)(AB + (size_t)(row0 + rbase + k0 + k) * D + 512 + c) = w4;
                }
            }
        }
        __syncthreads();
        {
            const int c = lane * 8;
            const f32x4 g0 = *(const f32x4*)(lg + c), g1 = *(const f32x4*)(lg + c + 4), b0 = *(const f32x4*)(lb + c), b1 = *(const f32x4*)(lb + c + 4);
            f32x4 v0[4], v1[4]; float mu[4], rstd[4];
#pragma unroll
            for (int j = 0; j < 4; ++j) { const int rr = wave + 8 * j; const int rc = rr < nrows ? rr : 0; v0[j] = *(const LAS f32x4*)(T + rc * CH + c); v1[j] = *(const LAS f32x4*)(T + rc * CH + c + 4); }
#pragma unroll
            for (int j = 0; j < 4; ++j) { const float s_ = (v0[j].x + v0[j].y) + (v0[j].z + v0[j].w) + (v1[j].x + v1[j].y) + (v1[j].z + v1[j].w); mu[j] = wave_sum(s_) * (1.0f / CH); }
#pragma unroll
            for (int j = 0; j < 4; ++j) { v0[j] = v0[j] - mu[j]; v1[j] = v1[j] - mu[j];
                const float q = (v0[j].x * v0[j].x + v0[j].y * v0[j].y) + (v0[j].z * v0[j].z + v0[j].w * v0[j].w) + (v1[j].x * v1[j].x + v1[j].y * v1[j].y) + (v1[j].z * v1[j].z + v1[j].w * v1[j].w);
                rstd[j] = rsqrtf(wave_sum(q) * (1.0f / CH) + LN_EPS); }
#pragma unroll
            for (int j = 0; j < 4; ++j) { const int rr = wave + 8 * j;
                if (rr < nrows) {
                    f32x4 a0 = v0[j] * rstd[j] * g0 + b0, a1 = v1[j] * rstd[j] * g1 + b1;
#pragma unroll
                    for (int e = 0; e < 4; ++e) { a0[e] = a0[e] * sigmoidf_(a0[e]); a1[e] = a1[e] * sigmoidf_(a1[e]); }
                    u32x4 w4; w4.x = cvt_pk_bf16(a0[0], a0[1]); w4.y = cvt_pk_bf16(a0[2], a0[3]); w4.z = cvt_pk_bf16(a1[0], a1[1]); w4.w = cvt_pk_bf16(a1[2], a1[3]);
                    *(u32x4*)(AB + (size_t)(row0 + rr) * D + c) = w4;
                } }
        }
        __syncthreads();
    }
}

__device__ __forceinline__ void p5_fix(const Args& a, int layer, int gtid, int GT) {
    unsigned char* ws = a.ws;
    const bf16_t* ZG = (const bf16_t*)(ws + WS_ZG); const bf16_t* ZU = (const bf16_t*)(ws + WS_ZU); bf16_t* U = (bf16_t*)(ws + WS_U);
    const float* SG = (const float*)(ws + WS_SG); const float* SU = (const float*)(ws + WS_SU);
    const float* wc = a.in[20] + (size_t)layer * 3 * DFF;
    constexpr int NCV = DFF / 8, NBLK = MPR / 64;
    const int nit = NBLK * 2 * NCV + NSB * NCV;
    for (int it = gtid; it < nit; it += GT) {
        const bool samp = it >= NBLK * 2 * NCV;
        if (!samp) {
            const int cv = it % NCV, bj = it / NCV, blk = bj >> 1, j = bj & 1, c = cv * 8;
            const bool first = (blk & 31) == 0;
            float gm2[8], gm1[8], g0[8], up[8];
            const float* cur = SG + (size_t)blk * 4 * DFF + c; const float* prv = SG + (size_t)(blk - 1) * 4 * DFF + c;
#pragma unroll
            for (int e = 0; e < 8; ++e) {
                if (j == 0) { gm2[e] = first ? 0.f : prv[2 * DFF + e]; gm1[e] = first ? 0.f : prv[3 * DFF + e]; g0[e] = cur[e]; }
                else { gm2[e] = first ? 0.f : prv[3 * DFF + e]; gm1[e] = cur[e]; g0[e] = cur[DFF + e]; }
                up[e] = SU[((size_t)blk * 2 + j) * DFF + c + e];
            }
            float o[8];
#pragma unroll
            for (int e = 0; e < 8; ++e) { const float y = wc[c + e] * gm2[e] + wc[DFF + c + e] * gm1[e] + wc[2 * DFF + c + e] * g0[e]; o[e] = y * sigmoidf_(y) * up[e]; }
            u32x4 w4; w4.x = cvt_pk_bf16(o[0], o[1]); w4.y = cvt_pk_bf16(o[2], o[3]); w4.z = cvt_pk_bf16(o[4], o[5]); w4.w = cvt_pk_bf16(o[6], o[7]);
            *(u32x4*)(U + (size_t)(blk * 64 + j) * DFF + c) = w4;
        } else {
            const int jj = it - NBLK * 2 * NCV, sb = jj / NCV, cv = jj % NCV, c = cv * 8, r0 = MPR + sb * NST;
            float w0[8], w1[8], w2[8], gm2[8], gm1[8];
            const float* sp = a.in[6] + ((size_t)(layer * NSB + sb) * 2) * DFF + c;
#pragma unroll
            for (int e = 0; e < 8; ++e) { w0[e] = wc[c + e]; w1[e] = wc[DFF + c + e]; w2[e] = wc[2 * DFF + c + e]; gm2[e] = sp[e]; gm1[e] = sp[DFF + e]; }
            for (int i = 0; i < NST; ++i) {
                const size_t off = (size_t)(r0 + i) * DFF + c;
                const u32x4 gv = *(const u32x4*)(ZG + off), uv = *(const u32x4*)(ZU + off);
                float g[8] = {bflo(gv.x), bfhi(gv.x), bflo(gv.y), bfhi(gv.y), bflo(gv.z), bfhi(gv.z), bflo(gv.w), bfhi(gv.w)};
                float up[8] = {bflo(uv.x), bfhi(uv.x), bflo(uv.y), bfhi(uv.y), bflo(uv.z), bfhi(uv.z), bflo(uv.w), bfhi(uv.w)};
                float o[8];
#pragma unroll
                for (int e = 0; e < 8; ++e) { const float y = w0[e] * gm2[e] + w1[e] * gm1[e] + w2[e] * g[e]; o[e] = y * sigmoidf_(y) * up[e]; gm2[e] = gm1[e]; gm1[e] = g[e]; }
                u32x4 w4; w4.x = cvt_pk_bf16(o[0], o[1]); w4.y = cvt_pk_bf16(o[2], o[3]); w4.z = cvt_pk_bf16(o[4], o[5]); w4.w = cvt_pk_bf16(o[6], o[7]);
                *(u32x4*)(U + off) = w4;
            }
        }
    }
}

constexpr int AT_OACC = 0, AT_OSTR = 65, AT_ML = 256 * AT_OSTR * 4, AT_STG = AT_ML + 2048, AT_KSTR = 144, AT_WSTG = 32 * AT_KSTR + 4096, AT_PSC = 0;
static_assert(AT_STG + NWAVES * AT_WSTG <= MISC_OFF && NWAVES * 2048 <= AT_ML, "attention LDS");
__device__ __forceinline__ int crow(int r, int hi) { return (r & 3) + 8 * (r >> 2) + 4 * hi; }

__device__ __forceinline__ void attn_task(const bf16_t* Qh, const bf16_t* Kh, const bf16_t* Vh, int dil, int cls, int s0, int nq, float slope2, int qlbase, int qlstep, bool first,
                                          LAS unsigned char* lds, int wave, int lane) {
    const int r32 = lane & 31, hi = lane >> 5;
    const int qi = r32 < nq ? r32 : nq - 1;
    const bf16_t* qp = Qh + (size_t)(cls + dil * (s0 + qi)) * D + hi * 8;
    bf16x8 qr[4];
#pragma unroll
    for (int d0 = 0; d0 < 4; ++d0) qr[d0] = *(const bf16x8*)(qp + d0 * 16);
    float m_run = -INFINITY, l_run = 0.f; f32x16 o[2]; o[0] = f32x16{}; o[1] = f32x16{};
    LAS unsigned char* kst = lds + AT_STG + wave * AT_WSTG; LAS unsigned char* vst = kst + 32 * AT_KSTR;
    const float sdil = slope2 * (float)dil;
    f32x16 cb;
#pragma unroll
    for (int r = 0; r < 16; ++r) cb[r] = -sdil * (float)(r32 - 4 * hi + 128 - ((r & 3) + 8 * (r >> 2)));
    const int i_first = s0 < 128 ? (128 - s0) >> 5 : 0;
    const int vb = ((lane >> 4) & 1) * 32 + (lane & 3) * 8 + (4 * hi + ((lane & 15) >> 2)) * 64;
#pragma clang loop unroll(disable)
    for (int i = 4; i >= i_first; --i) {
        const int kb = s0 - 128 + 32 * i;
        u32x4 kk[4], vv[4];
#pragma unroll
        for (int j = 0; j < 4; ++j) { const int kv = (lane >> 3) + 8 * j; const int sv = kb + kv < 0 ? 0 : kb + kv; const size_t ro = (size_t)(cls + dil * sv) * D + (lane & 7) * 8;
            kk[j] = *(const u32x4*)(Kh + ro); vv[j] = *(const u32x4*)(Vh + ro); }
#pragma unroll
        for (int j = 0; j < 4; ++j) { const int kv = (lane >> 3) + 8 * j; *(LAS u32x4*)(kst + kv * AT_KSTR + (lane & 7) * 16) = kk[j]; }
        asm volatile("s_waitcnt lgkmcnt(0)" ::: "memory");
        bf16x8 kf[4];
#pragma unroll
        for (int d0 = 0; d0 < 4; ++d0) kf[d0] = *(const LAS bf16x8*)(kst + r32 * AT_KSTR + d0 * 32 + hi * 16);
        const float toff = sdil * (float)(32 * i);
        f32x16 st;
#pragma unroll
        for (int r = 0; r < 16; ++r) st[r] = cb[r] + toff;
#pragma unroll
        for (int d0 = 0; d0 < 4; ++d0) st = __builtin_amdgcn_mfma_f32_32x32x16_bf16(kf[d0], qr[d0], st, 0, 0, 0);
        asm volatile("" ::: "memory");
#pragma unroll
        for (int j = 0; j < 4; ++j) { const int kv = (lane >> 3) + 8 * j, part = lane & 7;
            *(LAS u32x4*)(vst + (part >> 2) * 2048 + (kv >> 3) * 512 + (kv & 7) * 64 + (part & 3) * 16) = vv[j]; }
        if (i == 0 || i == 4 || kb < 0) {
            int cmin = (i == 0) ? r32 : 0; cmin = cmin > -kb ? cmin : -kb; const int cmax = (i == 4) ? r32 : 31;
            const int lo_ = cmin - 4 * hi, hi_ = cmax - 4 * hi;
#pragma unroll
            for (int r = 0; r < 16; ++r) { const int c = (r & 3) + 8 * (r >> 2); st[r] = (c >= lo_ && c <= hi_) ? st[r] : -INFINITY; }
        }
        float mx = fmaxf(fmaxf(st[0], st[1]), fmaxf(st[2], st[3]));
#pragma unroll
        for (int r = 4; r < 16; r += 4) mx = fmaxf(mx, fmaxf(fmaxf(st[r], st[r + 1]), fmaxf(st[r + 2], st[r + 3])));
        { auto rr = __builtin_amdgcn_permlane32_swap(__float_as_uint(mx), __float_as_uint(mx), false, false); mx = fmaxf(__uint_as_float(rr[0]), __uint_as_float(rr[1])); }
        if (__any(mx > m_run)) {
            const float m_new = fmaxf(m_run, mx);
            const float alpha = __builtin_amdgcn_exp2f(m_run - ((m_new == -INFINITY) ? 0.f : m_new));
            l_run *= alpha; m_run = m_new;
#pragma unroll
            for (int r = 0; r < 16; ++r) { o[0][r] *= alpha; o[1][r] *= alpha; }
        }
        const float m_use = (m_run == -INFINITY) ? 0.f : m_run;
        float ps = 0.f;
#pragma unroll
        for (int r = 0; r < 16; ++r) { const float p = __builtin_amdgcn_exp2f(st[r] - m_use); st[r] = p; ps += p; }
        l_run += ps;
        bf16x8 pa[2];
#pragma unroll
        for (int s = 0; s < 2; ++s) { u32x4 w; w.x = cvt_pk_bf16(st[8 * s + 0], st[8 * s + 1]); w.y = cvt_pk_bf16(st[8 * s + 2], st[8 * s + 3]); w.z = cvt_pk_bf16(st[8 * s + 4], st[8 * s + 5]); w.w = cvt_pk_bf16(st[8 * s + 6], st[8 * s + 7]);
            pa[s] = __builtin_bit_cast(bf16x8, w); }
        asm volatile("s_waitcnt lgkmcnt(0)" ::: "memory");
#pragma unroll
        for (int d0 = 0; d0 < 2; ++d0)
#pragma unroll
            for (int s = 0; s < 2; ++s) {
                const s16x4 lo = __builtin_bit_cast(s16x4, __builtin_amdgcn_ds_read_tr16_b64_v4i16((LAS s16x4*)(vst + vb + d0 * 2048 + s * 1024)));
                const s16x4 hh = __builtin_bit_cast(s16x4, __builtin_amdgcn_ds_read_tr16_b64_v4i16((LAS s16x4*)(vst + vb + d0 * 2048 + s * 1024 + 512)));
                const bf16x8 vf = (bf16x8){lo[0], lo[1], lo[2], lo[3], hh[0], hh[1], hh[2], hh[3]};
                o[d0] = __builtin_amdgcn_mfma_f32_32x32x16_bf16(vf, pa[s], o[d0], 0, 0, 0);
            }
        asm volatile("s_waitcnt lgkmcnt(0)" ::: "memory");
    }
    { auto rr = __builtin_amdgcn_permlane32_swap(__float_as_uint(l_run), __float_as_uint(l_run), false, false); l_run = __uint_as_float(rr[0]) + __uint_as_float(rr[1]); }
    if (r32 < nq) {
        const int ql = qlbase + qlstep * r32;
        LAS float* oa = (LAS float*)(lds + AT_OACC) + ql * AT_OSTR;
        LAS float* ml = (LAS float*)(lds + AT_ML) + ql * 2;
        float a_old = 0.f, a_new = 1.f, m_new = m_run, l_new = l_run;
        if (!first) { const float m_old = ml[0], l_old = ml[1]; m_new = fmaxf(m_old, m_run); const float mu = (m_new == -INFINITY) ? 0.f : m_new;
            a_old = __builtin_amdgcn_exp2f(m_old - mu); a_new = __builtin_amdgcn_exp2f(m_run - mu); l_new = l_old * a_old + l_run * a_new; }
#pragma unroll
        for (int d0 = 0; d0 < 2; ++d0)
#pragma unroll
            for (int r = 0; r < 16; ++r) { const int d = 32 * d0 + crow(r, hi); float v = o[d0][r] * a_new; if (!first) v += oa[d] * a_old; oa[d] = v; }
        asm volatile("s_waitcnt lgkmcnt(0)" ::: "memory");
        if (hi == 0) { ml[0] = m_new; ml[1] = l_new; }
    }
}

__device__ __forceinline__ void p8_attention(const Args& a, LAS unsigned char* lds, int tid, int lane, int wave, int mode) {
    unsigned char* ws = a.ws;
    const bf16_t* Q = (const bf16_t*)(ws + WS_Q); const bf16_t* K = (const bf16_t*)(ws + WS_K); const bf16_t* V = (const bf16_t*)(ws + WS_V); bf16_t* O = (bf16_t*)(ws + WS_AB);
    if (mode & 1) {
        const float* QS = (const float*)(ws + WS_QS);
        LAS float* psc = (LAS float*)(lds + AT_PSC + wave * 2048);
        for (int task = blockIdx.x * NWAVES + wave; task < NSB * NH * NST; task += gridDim.x * NWAVES) {
            const int sb = task / (NH * NST), h = (task / NST) % NH, j = task % NST;
            const float slope2 = exp2f(-0.5f * (float)(h + 1)) * LOG2E;
            const float* kc = a.in[4] + (size_t)sb * LBUF * D + h * HD; const float* vc = a.in[5] + (size_t)sb * LBUF * D + h * HD;
            const float* kn = a.out + O_SK + ((size_t)sb * LBUF + (LBUF - NST)) * D + h * HD; const float* vn = a.out + O_SV + ((size_t)sb * LBUF + (LBUF - NST)) * D + h * HD;
            const float* qrow = QS + (size_t)(sb * NST + j) * D + h * HD;
            f32x4 qv[16];
#pragma unroll
            for (int e = 0; e < 16; ++e) qv[e] = *(const f32x4*)(qrow + 4 * e);
            float mx = -INFINITY;
#pragma clang loop unroll(disable)
            for (int rd = 0; rd < 7; ++rd) {
                const int kk = rd * 64 + lane; float s = -INFINITY;
                if (kk < 387) { const int g = kk / 129, mm = kk % 129, dil = (g == 0) ? 1 : (g == 1 ? 4 : 16); const int idx = LBUF + j - mm * dil;
                    const float* kr = (idx >= LBUF) ? kn + (size_t)(idx - LBUF) * D : kc + (size_t)idx * D;
                    float acc = 0.f;
#pragma unroll
                    for (int e = 0; e < 16; ++e) { const f32x4 kx = *(const f32x4*)(kr + 4 * e); acc += (qv[e].x * kx.x + qv[e].y * kx.y) + (qv[e].z * kx.z + qv[e].w * kx.w); }
                    s = acc - slope2 * (float)(mm * dil); }
                psc[kk] = s; mx = fmaxf(mx, s);
            }
            mx = wave_max(mx);
            asm volatile("s_waitcnt lgkmcnt(0)" ::: "memory");
            float l = 0.f;
#pragma clang loop unroll(disable)
            for (int rd = 0; rd < 7; ++rd) { const float p = __builtin_amdgcn_exp2f(psc[rd * 64 + lane] - mx); l += p; psc[rd * 64 + lane] = p; }
            l = wave_sum(l);
            asm volatile("s_waitcnt lgkmcnt(0)" ::: "memory");
            const int kg = lane >> 4, dc = lane & 15;
            f32x4 acc4 = (f32x4){0.f, 0.f, 0.f, 0.f};
#pragma clang loop unroll(disable)
            for (int k0 = 0; k0 < 387; k0 += 64) {
                f32x4 vr4[16]; float pk[16];
#pragma unroll
                for (int u = 0; u < 16; ++u) { const int kk = k0 + 4 * u + kg; const int kc_ = kk < 387 ? kk : 386;
                    const int g = kc_ / 129, mm = kc_ % 129, dil = (g == 0) ? 1 : (g == 1 ? 4 : 16); const int idx = LBUF + j - mm * dil;
                    const float* vr = (idx >= LBUF) ? vn + (size_t)(idx - LBUF) * D : vc + (size_t)idx * D;
                    vr4[u] = *(const f32x4*)(vr + 4 * dc); pk[u] = kk < 387 ? psc[kc_] : 0.f; }
#pragma unroll
                for (int u = 0; u < 16; ++u) acc4 += vr4[u] * pk[u];
            }
#pragma unroll
            for (int e = 0; e < 4; ++e) { acc4[e] += __shfl_xor(acc4[e], 16); acc4[e] += __shfl_xor(acc4[e], 32); }
            const float il = __builtin_amdgcn_rcpf(l);
            if (lane < 16) { u32x2 w; w.x = cvt_pk_bf16(acc4[0] * il, acc4[1] * il); w.y = cvt_pk_bf16(acc4[2] * il, acc4[3] * il);
                *(u32x2*)(O + (size_t)(MPR + sb * NST + j) * D + h * HD + 4 * dc) = w; }
            asm volatile("s_waitcnt lgkmcnt(0)" ::: "memory");
        }
    }
    __syncthreads();
    if (mode & 2) {
    const int nun = NB * NH * 8, per_round = gridDim.x;
    for (int u0 = blockIdx.x; u0 < nun; u0 += per_round) {
        int u = u0;
        if ((gridDim.x & 7) == 0 && nun % (int)gridDim.x == 0) { const int x = blockIdx.x & 7, slot = blockIdx.x >> 3, spx = gridDim.x >> 3, rnd = u0 / per_round, j = rnd * spx + slot; u = x * (nun >> 3) + j;
            const int sq = u & 7, r4 = rnd & 3, qb = (r4 == 0) ? sq : (r4 == 1) ? 7 - sq : (r4 == 2) ? ((sq + 4) & 7) : ((3 - sq) & 7); u = (u & ~7) | qb; }
        const int qblk = u & 7, h = (u >> 3) & 15, b = u >> 7;
        const float slope2 = exp2f(-0.5f * (float)(h + 1)) * LOG2E;
        const bf16_t* Qh = Q + (size_t)b * SEQ * D + h * HD; const bf16_t* Kh = K + (size_t)b * SEQ * D + h * HD; const bf16_t* Vh = V + (size_t)b * SEQ * D + h * HD;
#pragma clang loop unroll(disable)
        for (int tk = 0; tk < 4; ++tk) {
            int dil, cls, s0, nq, qlb, qls;
            if (tk == 0) { dil = 1; cls = 0; s0 = 256 * qblk + 32 * wave; nq = 32; qlb = 32 * wave; qls = 1; }
            else if (tk == 1) { dil = 4; cls = wave & 3; s0 = 64 * qblk + 32 * (wave >> 2); nq = 32; qlb = (wave & 3) + 128 * (wave >> 2); qls = 4; }
            else { dil = 16; cls = 2 * wave + (tk - 2); s0 = 16 * qblk; nq = 16; qlb = cls; qls = 16; }
            attn_task(Qh, Kh, Vh, dil, cls, s0, nq, slope2, qlb, qls, tk == 0, lds, wave, lane);
            if (tk != 2) __syncthreads();
        }
        {
            const int ql = tid >> 1, dh = (tid & 1) * 32;
            const LAS float* oa = (const LAS float*)(lds + AT_OACC) + ql * AT_OSTR + dh;
            const float inv = __builtin_amdgcn_rcpf(((const LAS float*)(lds + AT_ML))[ql * 2 + 1]);
            bf16_t* op = O + (size_t)(b * SEQ + 256 * qblk + ql) * D + h * HD + dh;
#pragma unroll
            for (int e = 0; e < 4; ++e) { u32x4 w; w.x = cvt_pk_bf16(oa[8 * e + 0] * inv, oa[8 * e + 1] * inv); w.y = cvt_pk_bf16(oa[8 * e + 2] * inv, oa[8 * e + 3] * inv);
                w.z = cvt_pk_bf16(oa[8 * e + 4] * inv, oa[8 * e + 5] * inv); w.w = cvt_pk_bf16(oa[8 * e + 6] * inv, oa[8 * e + 7] * inv); *(u32x4*)(op + 8 * e) = w; }
        }
        __syncthreads();
    }
    }
}

__device__ __forceinline__ void p13_final(const Args& a, int gw, int NGW, int lane) {
    const bf16_t* HBp = (const bf16_t*)(a.ws + WS_HB); const float* g = a.in[9];
    f32x4 gv[4];
#pragma unroll
    for (int j = 0; j < 4; ++j) gv[j] = ((const f32x4*)g)[64 * j + lane];
    for (int r0 = gw; r0 < MTOT; r0 += 2 * NGW) {
        f32x4 v[2][4];
#pragma unroll
        for (int h = 0; h < 2; ++h) { const int r = r0 + h * NGW; const int rc = r < MTOT ? r : r0; const u32x2* xr = (const u32x2*)(HBp + (size_t)rc * D) + lane;
#pragma unroll
            for (int j = 0; j < 4; ++j) { const u32x2 b = xr[64 * j]; v[h][j] = (f32x4){bflo(b.x), bfhi(b.x), bflo(b.y), bfhi(b.y)}; } }
#pragma unroll
        for (int h = 0; h < 2; ++h) { const int r = r0 + h * NGW; if (r >= MTOT) continue; float s = 0.f;
#pragma unroll
            for (int j = 0; j < 4; ++j) s += (v[h][j].x * v[h][j].x + v[h][j].y * v[h][j].y) + (v[h][j].z * v[h][j].z + v[h][j].w * v[h][j].w);
            const float rstd = rsqrtf(wave_sum(s) * (1.0f / D) + RMS_EPS);
            f32x4* o = (f32x4*)(a.out + (size_t)r * D) + lane;
#pragma unroll
            for (int j = 0; j < 4; ++j) __builtin_nontemporal_store(v[h][j] * rstd * gv[j], o + 64 * j); }
    }
}

template <int MODE, int K>
__device__ __forceinline__ void sample_gemm(LAS unsigned char* lds, const bf16_t* A, const bf16_t* Bt, int N, const float* base, float* Hs, bf16_t* HBs, float* ssq,
                                            bf16_t* QKV, float* QS, float* out, int tid, int lane, int wave) {
    constexpr int KPW = K / 32 / 8;
    const int nitems = (N / 16) * 4;
    LAS f32x4* red = (LAS f32x4*)lds;
    for (int it = blockIdx.x; it < nitems; it += gridDim.x) {
        const int cbk = it >> 2, rq = it & 3;
        const bf16_t* bp = Bt + (size_t)(16 * cbk + (lane & 15)) * K + wave * KPW * 32 + 8 * (lane >> 4);
        const bf16_t* ap = A + (size_t)(32 * rq + (lane & 15)) * K + wave * KPW * 32 + 8 * (lane >> 4);
        bf16x8 bw[KPW], a0[KPW], a1[KPW];
#pragma unroll
        for (int ks = 0; ks < KPW; ++ks) { bw[ks] = *(const bf16x8*)(bp + ks * 32); a0[ks] = *(const bf16x8*)(ap + ks * 32); a1[ks] = *(const bf16x8*)(ap + (size_t)16 * K + ks * 32); }
        f32x4 acc0 = (f32x4){0.f, 0.f, 0.f, 0.f}, acc1 = acc0;
#pragma unroll
        for (int ks = 0; ks < KPW; ++ks) { acc0 = __builtin_amdgcn_mfma_f32_16x16x32_bf16(bw[ks], a0[ks], acc0, 0, 0, 0); acc1 = __builtin_amdgcn_mfma_f32_16x16x32_bf16(bw[ks], a1[ks], acc1, 0, 0, 0); }
        red[(wave * 2 + 0) * 64 + lane] = acc0; red[(wave * 2 + 1) * 64 + lane] = acc1;
        __syncthreads();
        if (tid < 128) {
            const int rb = tid >> 6, ln = tid & 63;
            f32x4 v = red[rb * 64 + ln];
#pragma unroll
            for (int w = 1; w < 8; ++w) v += red[(w * 2 + rb) * 64 + ln];
            const int rs = 32 * rq + 16 * rb + (ln & 15), fq = ln >> 4;
            const int c = 16 * cbk + 4 * fq;
            if (MODE == 0) {
                const u32x2 b2 = *(const u32x2*)(HBs + (size_t)rs * D + c);
                const f32x4 h = (f32x4){bflo(b2.x), bfhi(b2.x), bflo(b2.y), bfhi(b2.y)} + v;
                u32x2 w2; w2.x = cvt_pk_bf16(h[0], h[1]); w2.y = cvt_pk_bf16(h[2], h[3]); *(u32x2*)(HBs + (size_t)rs * D + c) = w2;
                float q = (h[0] * h[0] + h[1] * h[1]) + (h[2] * h[2] + h[3] * h[3]);
                q += __shfl_xor(q, 16); q += __shfl_xor(q, 32);
                if (fq == 0) ssq[(size_t)(MPR + rs) * 64 + cbk] = q;
            } else {
                const int which = cbk >> 6, c1 = c - which * D;
                const float rstd = pg8::row_rstd(ssq, MPR + rs, fq) * (which == 0 ? QSCALE : 1.0f);
                const f32x4 o = v * rstd;
                u32x2 w2; w2.x = cvt_pk_bf16(o[0], o[1]); w2.y = cvt_pk_bf16(o[2], o[3]);
                *(u32x2*)(QKV + (size_t)which * ((WS_K - WS_Q) / 2) + (size_t)(MPR + rs) * D + c1) = w2;
                float* fp = (which == 0) ? QS + (size_t)rs * D + c1 : out + (which == 1 ? O_SK : O_SV) + ((size_t)(rs >> 2) * LBUF + (LBUF - NST) + (rs & 3)) * D + c1;
                *(f32x4*)fp = o;
            }
        }
        __syncthreads();
    }
}

#define XB_TMO      128
#define XB_XCNT(j)  (256  + 64 * (j))
#define XB_XSUB(j)  (1280 + 64 * (j))
#define XB_XGEN(j)  (2304 + 64 * (j))
#define XB_TOP      3328
#define XB_TOPGEN   3392
#define XCD_BAR_WORDS 3456
#define XB_SPIN_CAP (1u << 18)
__device__ __forceinline__ unsigned xb_ld(unsigned* p)              { return __hip_atomic_load(p, __ATOMIC_RELAXED, __HIP_MEMORY_SCOPE_AGENT); }
__device__ __forceinline__ unsigned xb_add(unsigned* p, unsigned v) { return __hip_atomic_fetch_add(p, v, __ATOMIC_RELAXED, __HIP_MEMORY_SCOPE_AGENT); }
__device__ __forceinline__ unsigned xb_xcc_id() { return (unsigned)__builtin_amdgcn_s_getreg((3 << 11) | 20) & 0xFu; }
#define XB_SPIN(cond, bar) do { unsigned _sp = 0; while (cond) { __builtin_amdgcn_s_sleep(1); \
    if ((++_sp & 255u) == 0u) { if (xb_ld(&(bar)[XB_TMO])) break; if (_sp > XB_SPIN_CAP) { atomicAdd(&(bar)[XB_TMO], 1u); break; } } } } while (0)
__device__ __forceinline__ void xcd_barrier_complete(unsigned* bar, unsigned x, unsigned& nloc, unsigned& nx) {
    const unsigned G = gridDim.x * gridDim.y * gridDim.z;
    unsigned sum, cnt, mine, sp = 0u;
    for (;;) {
        sum = 0u; cnt = 0u; mine = 0u;
#pragma unroll
        for (unsigned j = 0; j < 16; ++j) { const unsigned c = xb_ld(&bar[XB_XCNT(j)]); sum += c; cnt += (c > 0u) ? 1u : 0u; mine = (j == x) ? c : mine; }
        if (sum == G) break;
        __builtin_amdgcn_s_sleep(1);
        if ((++sp & 255u) == 0u) { if (xb_ld(&bar[XB_TMO])) break; if (sp > XB_SPIN_CAP) { atomicAdd(&bar[XB_TMO], 1u); break; } }
    }
    nloc = mine > 0u ? mine : 1u; nx = cnt > 0u ? cnt : 1u;
}
__device__ __forceinline__ void xcd_barrier(unsigned* bar, volatile LAS unsigned* st) {
    asm volatile("s_waitcnt vmcnt(0)" ::: "memory");
    __syncthreads();
    if (threadIdx.x == 0) {
        const unsigned x = xb_xcc_id();
        __builtin_amdgcn_s_waitcnt(0);
        unsigned nloc = st[0], nx = st[1];
        if (nloc == 0u) { xcd_barrier_complete(bar, x, nloc, nx); st[0] = nloc; st[1] = nx; }
        const unsigned old = xb_add(&bar[XB_XSUB(x)], 1u);
        const unsigned gen = old / nloc;
        if (old + 1u == (gen + 1u) * nloc) {
            __builtin_amdgcn_fence(__ATOMIC_RELEASE, "agent");
            asm volatile("s_waitcnt vmcnt(0)" ::: "memory");
            const unsigned og = xb_add(&bar[XB_TOP], 1u);
            const unsigned tg = og / nx;
            if (og + 1u == (tg + 1u) * nx) xb_add(&bar[XB_TOPGEN], 1u);
            else XB_SPIN(xb_ld(&bar[XB_TOPGEN]) == tg, bar);
            __builtin_amdgcn_fence(__ATOMIC_ACQUIRE, "agent");
            xb_add(&bar[XB_XGEN(x)], 1u);
            asm volatile("s_waitcnt vmcnt(0)" ::: "memory");
        } else {
            XB_SPIN(xb_ld(&bar[XB_XGEN(x)]) == gen, bar);
            __builtin_amdgcn_fence(__ATOMIC_ACQUIRE, "agent");
            asm volatile("s_waitcnt vmcnt(0)" ::: "memory");
        }
    }
    __syncthreads();
}

typedef const __attribute__((address_space(4))) Args* kargp_t;
__device__ __forceinline__ Args kargs() {
    Args a;
#if defined(__HIP_DEVICE_COMPILE__)
    kargp_t p = (kargp_t)__builtin_amdgcn_kernarg_segment_ptr(); asm volatile("" : "+s"(p));
#pragma unroll
    for (int i = 0; i < 22; ++i) a.in[i] = p->in[i];
    a.out = p->out; a.ws = p->ws;
#else
    for (int i = 0; i < 22; ++i) a.in[i] = nullptr;
    a.out = nullptr; a.ws = nullptr;
#endif
    return a;
}
#define PHASE_BEGIN const Args a = kargs(); unsigned char* ws = a.ws; const int tid = launder_v(threadIdx.x), lane = tid & 63, wave = __builtin_amdgcn_readfirstlane(tid >> 6); \
    const int G = gridDim.x, gw = blockIdx.x * NWAVES + wave, NGW = G * NWAVES; (void)ws; (void)lane; (void)gw; (void)NGW; (void)G;
__global__ void __launch_bounds__(NTHREADS, 2) mega_fwd(Args a_unused) {
    extern __shared__ __attribute__((aligned(16))) unsigned char lds_raw[];
    LAS unsigned char* lds = (LAS unsigned char*)lds_raw;
    cg::grid_group grid = cg::this_grid();
    volatile LAS unsigned* bst = (volatile LAS unsigned*)(lds + MISC_OFF + 64);
    { unsigned* ctl0 = (unsigned*)kargs().ws; if (threadIdx.x == 0) { bst[0] = 0u; bst[1] = 0u; (void)xb_add(&ctl0[XB_XCNT(xb_xcc_id())], 1u); } }
    __syncthreads();
    grid.sync();
#define GRID_BAR() do { unsigned* ctl_ = (unsigned*)kargs().ws; xcd_barrier(ctl_, bst); } while (0)
#ifndef PHASES
#define PHASES 0xFFFF
#endif
#define PH(k) if constexpr (((PHASES) >> (k)) & 1)
#define REP_ALL 1
#define REP_P0 1
#define REP_P1 1
#define REP_P2 1
#define REP_P3 1
#define REP_P4 1
#define REP_P5 1
#define REP_P6 1
#define PROBE_SKIP_EPI 0
#define REP_P7 1
#define REP_P8 1
#define REP_P8S 1
#define REP_P13 1
#define REPEAT(n) for (int rep_ = 0; rep_ < (n); ++rep_)

    for (int rep_all = 0; rep_all < REP_ALL; ++rep_all) {
    if (rep_all) { GRID_BAR(); }
    REPEAT(REP_P0) { PH(0) { PHASE_BEGIN p0_prologue(a, lds, gw, NGW, lane, wave); } if (rep_ + 1 < REP_P0) { GRID_BAR(); } }
    GRID_BAR();
    REPEAT(REP_P1) { if (rep_) { GRID_BAR(); } PH(1) {
        PHASE_BEGIN
        pg8::Gemm g{(const bf16_t*)(ws + WS_HB), (const bf16_t*)(ws + WS_WIN), MPAD, NIN, D}; pg8::StaticOrder S; S.init(MPAD, NIN, G, (int)blockIdx.x);
        pg8::EpiInAB E{(bf16_t*)(ws + WS_GA), (const float*)(ws + WS_SSQ), a.out};
        pg8::gemm_phase<pg8::EpiInAB, pg8::StaticOrder, true, true>(lds, g, S, E);
    } }
    GRID_BAR();
    REPEAT(REP_P2) { if (rep_) { GRID_BAR(); } PH(2) { PHASE_BEGIN p2_conv(a, lds, tid, lane, wave); } }
    GRID_BAR();
    REPEAT(REP_P3) { if (rep_) { GRID_BAR(); } PH(3) {
        PHASE_BEGIN
        pg8::Gemm g{(const bf16_t*)(ws + WS_AB), (const bf16_t*)(ws + WS_WOUT), MPR, D, D}; pg8::StaticOrder S; S.init(MPR, D, G, (int)blockIdx.x);
        pg8::EpiResid E{(bf16_t*)(ws + WS_HB), (float*)(ws + WS_SSQ), 0};
        pg8::gemm_phase<pg8::EpiResid, pg8::StaticOrder, true, true>(lds, g, S, E);
        sample_gemm<0, D>(lds, (const bf16_t*)(ws + WS_AB) + (size_t)MPR * D, (const bf16_t*)(ws + WS_WOUT), D, nullptr, nullptr, (bf16_t*)(ws + WS_HB) + (size_t)MPR * D,
                          (float*)(ws + WS_SSQ), nullptr, nullptr, nullptr, tid, lane, wave);
    } }
    GRID_BAR();
#pragma clang loop unroll(disable)
    for (int layer = 0; layer < 2; ++layer) {
        if (layer == 1) {
            REPEAT(REP_P7) { if (rep_) { GRID_BAR(); } PH(7) {
                PHASE_BEGIN
                pg8::Gemm g{(const bf16_t*)(ws + WS_HB), (const bf16_t*)(ws + WS_WQKV), MPR, 3 * D, D}; pg8::StaticOrder S; S.init(MPR, 3 * D, G, (int)blockIdx.x);
                pg8::EpiQkv E{(bf16_t*)(ws + WS_Q), (float*)(ws + WS_QS), (const float*)(ws + WS_SSQ), a.out};
                pg8::gemm_phase<pg8::EpiQkv, pg8::StaticOrder, true, true>(lds, g, S, E);
                sample_gemm<1, D>(lds, (const bf16_t*)(ws + WS_HB) + (size_t)MPR * D, (const bf16_t*)(ws + WS_WQKV), 3 * D, nullptr, nullptr, nullptr,
                                  (float*)(ws + WS_SSQ), (bf16_t*)(ws + WS_Q), (float*)(ws + WS_QS), a.out, tid, lane, wave);
            } }
            GRID_BAR();
            REPEAT(REP_P8S) { PH(8) { PHASE_BEGIN p8_attention(a, lds, tid, lane, wave, 1); } }
            REPEAT(REP_P8) { if (rep_) { GRID_BAR(); } PH(8) { PHASE_BEGIN p8_attention(a, lds, tid, lane, wave, 2); } }
            GRID_BAR();
            PH(9) {
                PHASE_BEGIN
                pg8::Gemm g{(const bf16_t*)(ws + WS_AB), (const bf16_t*)(ws + WS_WO), MPR, D, D}; pg8::StaticOrder S; S.init(MPR, D, G, (int)blockIdx.x);
                pg8::EpiResid E{(bf16_t*)(ws + WS_HB), (float*)(ws + WS_SSQ), 0};
                pg8::gemm_phase<pg8::EpiResid, pg8::StaticOrder, true, true>(lds, g, S, E);
                sample_gemm<0, D>(lds, (const bf16_t*)(ws + WS_AB) + (size_t)MPR * D, (const bf16_t*)(ws + WS_WO), D, nullptr, nullptr, (bf16_t*)(ws + WS_HB) + (size_t)MPR * D,
                                  (float*)(ws + WS_SSQ), nullptr, nullptr, nullptr, tid, lane, wave);
            }
            GRID_BAR();
        }
        REPEAT(REP_P4) { if (rep_) { GRID_BAR(); } PH(4) {
            PHASE_BEGIN
            pg8::Gemm g{(const bf16_t*)(ws + WS_HB), (const bf16_t*)(ws + (layer ? WS_WF1 : WS_WF0)), MPAD, 2 * DFF, D}; pg8::StaticOrder S; S.init(MPAD, 2 * DFF, G, (int)blockIdx.x);
            pg8::EpiFfn E{(bf16_t*)(ws + WS_ZG), (bf16_t*)(ws + WS_ZU), (bf16_t*)(ws + WS_U), (float*)(ws + WS_SG), (float*)(ws + WS_SU), a.in[20] + (size_t)layer * 3 * DFF, (const float*)(ws + WS_SSQ), a.out, layer};
            pg8::gemm_phase<pg8::EpiFfn, pg8::StaticOrder, true, true>(lds, g, S, E);
        } }
        GRID_BAR();
        REPEAT(REP_P5) { if (rep_) { GRID_BAR(); } PH(5) { PHASE_BEGIN p5_fix(a, layer, blockIdx.x * NTHREADS + tid, G * NTHREADS); } }
        GRID_BAR();
        REPEAT(REP_P6) { if (rep_) { GRID_BAR(); } PH(6) {
            PHASE_BEGIN
            pg8::Gemm g{(const bf16_t*)(ws + WS_U), (const bf16_t*)(ws + (layer ? WS_WD1 : WS_WD0)), MPR, D, DFF}; pg8::StaticOrder S; S.init(MPR, D, G, (int)blockIdx.x);
            const bool real_ = (rep_ + 1 == REP_P6);
            pg8::EpiResid E{(bf16_t*)(ws + WS_HB), real_ ? (float*)(ws + WS_SSQ) : (float*)(ws + WS_ZU), real_ ? 0 : 1};
            pg8::gemm_phase<pg8::EpiResid, pg8::StaticOrder, true, true>(lds, g, S, E);
            if (real_) sample_gemm<0, DFF>(lds, (const bf16_t*)(ws + WS_U) + (size_t)MPR * DFF, (const bf16_t*)(ws + (layer ? WS_WD1 : WS_WD0)), D, nullptr, nullptr, (bf16_t*)(ws + WS_HB) + (size_t)MPR * D,
                                (float*)(ws + WS_SSQ), nullptr, nullptr, nullptr, tid, lane, wave);
        } }
        GRID_BAR();
    }
    REPEAT(REP_P13) { if (rep_) { GRID_BAR(); } PH(13) { PHASE_BEGIN p13_final(a, gw, NGW, lane); } }
    }
}

extern "C" void kernel_launch(void* const* d_in, const int* in_sizes, int n_in, void* d_out, int out_size, void* d_ws, size_t ws_size, hipStream_t stream) {
    static int grid = 0;
    if (grid == 0) {
        if (n_in != 22 || (size_t)out_size != O_END || ws_size < WS_END) { fprintf(stderr, "kernel_launch: unexpected shapes (n_in %d, out %d, ws %zu, need %zu)\n", n_in, out_size, ws_size, (size_t)WS_END); grid = -1; return; }
        int dev = 0, cus = 0, per_cu = 0;
        if (hipGetDevice(&dev) != hipSuccess || hipDeviceGetAttribute(&cus, hipDeviceAttributeMultiprocessorCount, dev) != hipSuccess) { grid = -1; return; }
        if (hipFuncSetAttribute((const void*)mega_fwd, hipFuncAttributeMaxDynamicSharedMemorySize, LDS_BYTES) != hipSuccess) { fprintf(stderr, "kernel_launch: hipFuncSetAttribute failed\n"); grid = -1; return; }
        if (hipOccupancyMaxActiveBlocksPerMultiprocessor(&per_cu, (const void*)mega_fwd, NTHREADS, LDS_BYTES) != hipSuccess || per_cu < 1) { fprintf(stderr, "kernel_launch: occupancy query failed (%d)\n", per_cu); (void)hipGetLastError(); grid = -1; return; }
        grid = cus * 1;
    }
    if (grid < 0) return;
    if (hipMemsetAsync((char*)d_ws + WS_CTL, 0, CTL_BYTES, stream) != hipSuccess) { fprintf(stderr, "kernel_launch: memset failed\n"); return; }
    Args a{};
    for (int i = 0; i < 22; ++i) a.in[i] = (const float*)d_in[i];
    a.out = (float*)d_out; a.ws = (unsigned char*)d_ws;
    void* args[] = {&a};
    hipError_t e = hipLaunchCooperativeKernel((const void*)mega_fwd, dim3(grid), dim3(NTHREADS), args, LDS_BYTES, stream);
    if (e != hipSuccess) fprintf(stderr, "cooperative launch failed: %s (grid %d)\n", hipGetErrorString(e), grid);
}
```

```cpp
#include <hip/hip_runtime.h>
#include <hip/hip_cooperative_groups.h>
#include <cstdio>
#include <cstdint>
namespace cg = cooperative_groups;

#define LAS __attribute__((address_space(3)))
typedef unsigned short bf16_t;
typedef short bf16x8 __attribute__((ext_vector_type(8)));
typedef float f32x4 __attribute__((ext_vector_type(4)));
typedef float f32x2 __attribute__((ext_vector_type(2)));
typedef float f32x16 __attribute__((ext_vector_type(16)));
typedef unsigned u32x4 __attribute__((ext_vector_type(4)));
typedef unsigned u32x2 __attribute__((ext_vector_type(2)));
typedef short s16x4 __attribute__((ext_vector_type(4)));

constexpr int D = 1024, SEQ = 2048, NB = 8, MPR = NB * SEQ, NSB = 32, NST = 4, MSA = NSB * NST, MTOT = MPR + MSA, MPAD = 16640;
constexpr int DFF = 2816, NIN = 2560, CH = 512, NH = 16, HD = 64, LBUF = 2048, KA = 31;
constexpr int GAW = 1536;
constexpr float RMS_EPS = 1e-6f, LN_EPS = 1e-5f;
constexpr float LOG2E = 1.4426950408889634f;
constexpr float QSCALE = 0.125f * LOG2E;

constexpr size_t O_YP = 0;
constexpr size_t O_YS = O_YP + (size_t)MPR * D;
constexpr size_t O_PCA = O_YS + (size_t)MSA * D;
constexpr size_t O_SCA = O_PCA + (size_t)NB * 30 * CH;
constexpr size_t O_PCB = O_SCA + (size_t)NSB * 30 * CH;
constexpr size_t O_SCB = O_PCB + (size_t)NB * 2 * CH;
constexpr size_t O_PK = O_SCB + (size_t)NSB * 2 * CH;
constexpr size_t O_SK = O_PK + (size_t)MPR * D;
constexpr size_t O_PV = O_SK + (size_t)NSB * LBUF * D;
constexpr size_t O_SV = O_PV + (size_t)MPR * D;
constexpr size_t O_PF = O_SV + (size_t)NSB * LBUF * D;
constexpr size_t O_SF = O_PF + (size_t)2 * NB * 2 * DFF;
constexpr size_t O_END = O_SF + (size_t)2 * NSB * 2 * DFF;

constexpr size_t al(size_t x) { return (x + 4095) & ~(size_t)4095; }
constexpr size_t WS_CTL = 0, CTL_BYTES = 65536;
constexpr size_t WS_WIN = WS_CTL + CTL_BYTES;
constexpr size_t WS_WOUT = WS_WIN + al((size_t)NIN * D * 2);
constexpr size_t WS_WQKV = WS_WOUT + al((size_t)D * D * 2);
constexpr size_t WS_WO = WS_WQKV + al((size_t)3 * D * D * 2);
constexpr size_t WS_WF0 = WS_WO + al((size_t)D * D * 2);
constexpr size_t WS_WF1 = WS_WF0 + al((size_t)2 * DFF * D * 2);
constexpr size_t WS_WD0 = WS_WF1 + al((size_t)2 * DFF * D * 2);
constexpr size_t WS_WD1 = WS_WD0 + al((size_t)D * DFF * 2);
constexpr size_t WS_HB = WS_WD1 + al((size_t)D * DFF * 2);
constexpr size_t WS_H = WS_HB + al((size_t)MPAD * D * 2);
constexpr size_t WS_SSQ = WS_H + 4096;
constexpr size_t WS_GA = WS_SSQ + al((size_t)MPAD * 64 * 4);
constexpr size_t WS_AB = WS_GA + al((size_t)MPAD * GAW * 2);
constexpr size_t WS_ZG = WS_AB + al((size_t)MPAD * D * 2);
constexpr size_t WS_ZU = WS_ZG + al((size_t)MPAD * DFF * 2);
constexpr size_t WS_U = WS_ZU + al((size_t)MPAD * DFF * 2);
constexpr size_t WS_Q = WS_U + al((size_t)MPAD * DFF * 2);
constexpr size_t WS_K = WS_Q + al((size_t)MPAD * D * 2);
constexpr size_t WS_V = WS_K + al((size_t)MPAD * D * 2);
constexpr size_t WS_QS = WS_V + al((size_t)MPAD * D * 2);
constexpr size_t WS_SG = WS_QS + al((size_t)MSA * D * 4);
constexpr size_t WS_SU = WS_SG + al((size_t)256 * 4 * DFF * 4);
constexpr size_t WS_END = WS_SU + al((size_t)256 * 2 * DFF * 4);
static_assert(WS_V - WS_K == WS_K - WS_Q, "Q|K|V equally spaced");

constexpr int NWAVES = 8, NTHREADS = 512;
constexpr int LDS_BYTES = 163840;
constexpr int MISC_OFF = LDS_BYTES - 1024;

__device__ __forceinline__ unsigned cvt_pk_bf16(float lo, float hi) { unsigned r; asm volatile("v_cvt_pk_bf16_f32 %0, %1, %2" : "=v"(r) : "v"(lo), "v"(hi)); return r; }
__device__ __forceinline__ float bf2f(unsigned short b) { return __uint_as_float((unsigned)b << 16); }
__device__ __forceinline__ float bflo(unsigned w) { return __uint_as_float(w << 16); }
__device__ __forceinline__ float bfhi(unsigned w) { return __uint_as_float(w & 0xffff0000u); }
__device__ __forceinline__ float sigmoidf_(float x) { return __builtin_amdgcn_rcpf(1.0f + __expf(-x)); }
__device__ __forceinline__ int launder_v(int x) { asm volatile("" : "+v"(x)); return x; }
template <int CTRL> __device__ __forceinline__ float dppmov(float v) { return __uint_as_float(__builtin_amdgcn_update_dpp(0u, __float_as_uint(v), CTRL, 0xf, 0xf, true)); }
__device__ __forceinline__ float wave_sum(float v) {
    v += dppmov<0xB1>(v);
    v += dppmov<0x4E>(v);
    v += dppmov<0x141>(v);
    v += dppmov<0x140>(v);
    { auto r = __builtin_amdgcn_permlane16_swap(__float_as_uint(v), __float_as_uint(v), false, false); v = __uint_as_float(r[0]) + __uint_as_float(r[1]); }
    { auto r = __builtin_amdgcn_permlane32_swap(__float_as_uint(v), __float_as_uint(v), false, false); v = __uint_as_float(r[0]) + __uint_as_float(r[1]); }
    return v;
}
__device__ __forceinline__ float wave_max(float v) {
    v = fmaxf(v, dppmov<0xB1>(v)); v = fmaxf(v, dppmov<0x4E>(v)); v = fmaxf(v, dppmov<0x141>(v)); v = fmaxf(v, dppmov<0x140>(v));
    { auto r = __builtin_amdgcn_permlane16_swap(__float_as_uint(v), __float_as_uint(v), false, false); v = fmaxf(__uint_as_float(r[0]), __uint_as_float(r[1])); }
    { auto r = __builtin_amdgcn_permlane32_swap(__float_as_uint(v), __float_as_uint(v), false, false); v = fmaxf(__uint_as_float(r[0]), __uint_as_float(r[1])); }
    return v;
}

namespace pg8 {
constexpr int BM = 256, BK = 64, HALF = 128, HTB = HALF * BK * 2, STAGE_BYTES = 8 * HTB, NXCD = 8, WGM = 8;
__host__ __device__ __forceinline__ int lds_byte(int r, int c) { const int st = (r >> 4) * 2 + (c >> 5), rr = r & 15, cc = c & 31, ob = rr * 64 + cc * 2; return st * 1024 + (ob ^ (((ob >> 9) & 1) << 5)); }
__host__ __device__ __forceinline__ void stage_rc(int b, int& R, int& C) { const int st = b / 1024, sb = b % 1024, swz = sb ^ (((sb >> 9) & 1) << 5); R = (st >> 1) * 16 + swz / 64; C = (st & 1) * 32 + (swz % 64) / 2; }
__host__ __device__ __forceinline__ int perm32(int rho) { const int n = rho >> 4, i = rho & 15; return 8 * (i >> 2) + 4 * n + (i & 3); }

struct Unit { int pm, pn; };
struct Gemm { const bf16_t* A; const bf16_t* Bt; int M, N, K; };

struct StaticOrder {
    int nM, nN, nwg, G, c;
    __host__ __device__ void init(int M, int N, int G_, int c_) { nM = M / BM; nN = N / BM; nwg = nM * nN; G = G_; c = c_; }
    __host__ __device__ bool next(int i, Unit& u) const {
        const long L = (long)i * G + c; if (L >= nwg) return false;
        int wgid = (int)L; { const int q = nwg / NXCD, r = nwg % NXCD, xcd = wgid % NXCD, off = wgid / NXCD; wgid = (xcd < r ? xcd * (q + 1) : r * (q + 1) + (xcd - r) * q) + off; }
        const int nig = WGM * nN, gid = wgid / nig, fm = gid * WGM, gsz = (nM - fm) < WGM ? (nM - fm) : WGM;
        u.pm = fm + ((wgid % nig) % gsz); u.pn = (wgid % nig) / gsz; return true;
    }
    __device__ __forceinline__ void a_ready(const Unit&) const {}
    __device__ __forceinline__ void done(const Unit&) const {}
};

__device__ __forceinline__ float row_rstd(const float* ssq, int r, int fq) {
    float s;
    if (r < MPR) { const f32x4 p = *(const f32x4*)(ssq + (size_t)r * 64 + 4 * fq); s = (p.x + p.y) + (p.z + p.w); }
    else { const f32x4* pp = (const f32x4*)(ssq + (size_t)r * 64 + 16 * fq); const f32x4 p = (pp[0] + pp[1]) + (pp[2] + pp[3]); s = (p.x + p.y) + (p.z + p.w); }
    s += __shfl_xor(s, 16); s += __shfl_xor(s, 32);
    return rsqrtf(s * (1.0f / D) + RMS_EPS);
}

struct EpiInAB {
    static constexpr bool PERM = true, AFTER_DRAIN = false;
    bf16_t* GA; const float* ssq; float* out;
    __device__ __forceinline__ void operator()(const f32x4 (&acc)[2][2][4][2], const Unit& u, int wr, int wc, int fr, int fq) const {
        const int pn = u.pn, colw = wc * 32 + 8 * fq;
#pragma unroll
        for (int ai = 0; ai < 2; ++ai)
#pragma unroll
            for (int m = 0; m < 4; ++m) {
                const int r = u.pm * BM + ai * HALF + wr * 64 + m * 16 + fr;
                const float rs = row_rstd(ssq, r, fq);
                const f32x4 a0 = acc[ai][0][m][0] * rs, a1 = acc[ai][0][m][1] * rs, g0 = acc[ai][1][m][0] * rs, g1 = acc[ai][1][m][1] * rs;
                bf16_t* rowp = GA + (size_t)r * GAW;
                if (pn < 8) {
                    f32x4 v0, v1;
                    if (pn < 4) {
#pragma unroll
                        for (int i = 0; i < 4; ++i) { v0[i] = a0[i] * sigmoidf_(g0[i]); v1[i] = a1[i] * sigmoidf_(g1[i]); }
                    } else { v0 = a0 * g0; v1 = a1 * g1; }
                    const int cl = 128 * (pn & 3) + colw;
                    u32x4 w; w.x = cvt_pk_bf16(v0[0], v0[1]); w.y = cvt_pk_bf16(v0[2], v0[3]); w.z = cvt_pk_bf16(v1[0], v1[1]); w.w = cvt_pk_bf16(v1[2], v1[3]);
                    *(u32x4*)(rowp + (pn < 4 ? 0 : 512) + cl) = w;
                    const int keep = pn < 4 ? 30 : 2;
                    float* sp = nullptr;
                    if (r < MPR) { const int t = r & (SEQ - 1), b = r >> 11; if (t >= SEQ - keep) sp = out + (pn < 4 ? O_PCA : O_PCB) + ((size_t)(b * keep + (t - (SEQ - keep)))) * CH + cl; }
                    else if (r < MTOT) { const int rs_ = r - MPR, sb = rs_ >> 2, j = rs_ & 3; if (j >= NST - keep || keep == 30) sp = out + (pn < 4 ? O_SCA : O_SCB) + ((size_t)(sb * keep + (keep - NST + j))) * CH + cl; }
                    if (sp) { *(f32x4*)sp = v0; *(f32x4*)(sp + 4) = v1; }
                } else {
                    const int c = 1024 + 256 * (pn - 8) + colw;
                    u32x4 w; w.x = cvt_pk_bf16(a0[0], a0[1]); w.y = cvt_pk_bf16(a0[2], a0[3]); w.z = cvt_pk_bf16(a1[0], a1[1]); w.w = cvt_pk_bf16(a1[2], a1[3]);
                    *(u32x4*)(rowp + c) = w;
                    w.x = cvt_pk_bf16(g0[0], g0[1]); w.y = cvt_pk_bf16(g0[2], g0[3]); w.z = cvt_pk_bf16(g1[0], g1[1]); w.w = cvt_pk_bf16(g1[2], g1[3]);
                    *(u32x4*)(rowp + c + 128) = w;
                }
            }
    }
};
struct EpiResid {
    static constexpr bool PERM = false, AFTER_DRAIN = false;
    bf16_t* HB; float* ssq; int skip;
    __device__ __forceinline__ void operator()(const f32x4 (&acc)[2][2][4][2], const Unit& u, int wr, int wc, int fr, int fq) const {
        const int col0 = u.pn * BM + wc * 32 + 4 * fq;
        if (skip) { if (acc[0][0][0][0][0] == 1.2345e-30f) ssq[0] = 0.f; return; }
#pragma unroll
        for (int ai = 0; ai < 2; ++ai) {
            u32x2 bs[4][2][2];
#pragma unroll
            for (int m = 0; m < 4; ++m) { const int r = u.pm * BM + ai * HALF + wr * 64 + m * 16 + fr; const int rc = r < MTOT ? r : MTOT - 1;
#pragma unroll
                for (int bj = 0; bj < 2; ++bj)
#pragma unroll
                    for (int n = 0; n < 2; ++n) bs[m][bj][n] = *(const u32x2*)(HB + (size_t)rc * D + col0 + bj * HALF + n * 16); }
            asm volatile("" ::: "memory");
#pragma unroll
            for (int m = 0; m < 4; ++m) {
                const int r = u.pm * BM + ai * HALF + wr * 64 + m * 16 + fr;
                float s = 0.f;
                if (r < MTOT) {
#pragma unroll
                    for (int bj = 0; bj < 2; ++bj)
#pragma unroll
                        for (int n = 0; n < 2; ++n) {
                            const int c = col0 + bj * HALF + n * 16;
                            const u32x2 b = bs[m][bj][n];
                            const f32x4 v = (f32x4){bflo(b.x), bfhi(b.x), bflo(b.y), bfhi(b.y)} + acc[ai][bj][m][n];
                            s += (v[0] * v[0] + v[1] * v[1]) + (v[2] * v[2] + v[3] * v[3]);
                            u32x2 w; w.x = cvt_pk_bf16(v[0], v[1]); w.y = cvt_pk_bf16(v[2], v[3]);
                            *(u32x2*)(HB + (size_t)r * D + c) = w;
                        }
                }
                s += __shfl_xor(s, 16); s += __shfl_xor(s, 32);
                if (fq == 0 && r < MTOT) ssq[(size_t)r * 64 + u.pn * 4 + wc] = s;
            }
        }
    }
};
template <int CTRL> __device__ __forceinline__ float dpp_f(float old, float src) {
    return __uint_as_float(__builtin_amdgcn_update_dpp(__float_as_uint(old), __float_as_uint(src), CTRL, 0xf, 0xf, false)); }
struct EpiFfn {
    static constexpr bool PERM = true, AFTER_DRAIN = false;
    bf16_t* ZG; bf16_t* ZU; bf16_t* U; float* SG; float* SU; const float* wcv; const float* ssq; float* out; int layer;
    __device__ __forceinline__ void operator()(const f32x4 (&acc)[2][2][4][2], const Unit& u, int wr, int wc, int fr, int fq) const {
        const int col = u.pn * 128 + wc * 32 + 8 * fq;
        if (u.pm >= MPR / BM) {
#pragma unroll
            for (int ai = 0; ai < 2; ++ai)
#pragma unroll
                for (int m = 0; m < 4; ++m) {
                    const int r = u.pm * BM + ai * HALF + wr * 64 + m * 16 + fr;
                    const float rs = row_rstd(ssq, r, fq);
                    const f32x4 g0 = acc[ai][0][m][0] * rs, g1 = acc[ai][0][m][1] * rs, u0 = acc[ai][1][m][0] * rs, u1 = acc[ai][1][m][1] * rs;
                    u32x4 w; w.x = cvt_pk_bf16(g0[0], g0[1]); w.y = cvt_pk_bf16(g0[2], g0[3]); w.z = cvt_pk_bf16(g1[0], g1[1]); w.w = cvt_pk_bf16(g1[2], g1[3]);
                    *(u32x4*)(ZG + (size_t)r * DFF + col) = w;
                    w.x = cvt_pk_bf16(u0[0], u0[1]); w.y = cvt_pk_bf16(u0[2], u0[3]); w.z = cvt_pk_bf16(u1[0], u1[1]); w.w = cvt_pk_bf16(u1[2], u1[3]);
                    *(u32x4*)(ZU + (size_t)r * DFF + col) = w;
                    if (r < MTOT) { const int rs_ = r - MPR, sb = rs_ >> 2, j = rs_ & 3;
                        if (j >= 2) { float* sp = out + O_SF + ((size_t)((layer * NSB + sb) * 2 + (j - 2))) * DFF + col; *(f32x4*)sp = g0; *(f32x4*)(sp + 4) = g1; } }
                }
            return;
        }
        f32x4 w0[2], w1[2], w2[2];
#pragma unroll
        for (int n = 0; n < 2; ++n) { w0[n] = *(const f32x4*)(wcv + col + 4 * n); w1[n] = *(const f32x4*)(wcv + DFF + col + 4 * n); w2[n] = *(const f32x4*)(wcv + 2 * DFF + col + 4 * n); }
#pragma unroll
        for (int ai = 0; ai < 2; ++ai) {
            const int blk = u.pm * 4 + ai * 2 + wr;
            f32x4 gp[2];
            gp[0] = (f32x4){0.f, 0.f, 0.f, 0.f}; gp[1] = gp[0];
#pragma unroll
            for (int m = 0; m < 4; ++m) {
                const int r = blk * 64 + m * 16 + fr;
                const float rs = row_rstd(ssq, r, fq);
                f32x4 g[2], up[2], o[2];
#pragma unroll
                for (int n = 0; n < 2; ++n) { g[n] = acc[ai][0][m][n] * rs; up[n] = acc[ai][1][m][n] * rs; }
#pragma unroll
                for (int n = 0; n < 2; ++n)
#pragma unroll
                    for (int i = 0; i < 4; ++i) {
                        const float x1 = dpp_f<0x121>(0.f, gp[n][i]), gm1 = dpp_f<0x111>(x1, g[n][i]);
                        const float x2 = dpp_f<0x122>(0.f, gp[n][i]), gm2 = dpp_f<0x112>(x2, g[n][i]);
                        const float y = w0[n][i] * gm2 + w1[n][i] * gm1 + w2[n][i] * g[n][i];
                        o[n][i] = y * sigmoidf_(y) * up[n][i];
                    }
                const bool seam_lo = (m == 0) && (fr < 2), seam_hi = (m == 3) && (fr >= 14);
                if (!seam_lo) { u32x4 w; w.x = cvt_pk_bf16(o[0][0], o[0][1]); w.y = cvt_pk_bf16(o[0][2], o[0][3]); w.z = cvt_pk_bf16(o[1][0], o[1][1]); w.w = cvt_pk_bf16(o[1][2], o[1][3]);
                    *(u32x4*)(U + (size_t)r * DFF + col) = w; }
                else { float* sg = SG + ((size_t)blk * 4 + fr) * DFF + col; *(f32x4*)sg = g[0]; *(f32x4*)(sg + 4) = g[1];
                       float* su = SU + ((size_t)blk * 2 + fr) * DFF + col; *(f32x4*)su = up[0]; *(f32x4*)(su + 4) = up[1]; }
                if (seam_hi) { float* sg = SG + ((size_t)blk * 4 + 2 + (fr - 14)) * DFF + col; *(f32x4*)sg = g[0]; *(f32x4*)(sg + 4) = g[1];
                    const int t = r & (SEQ - 1), b = r >> 11;
                    if (t >= SEQ - 2) { float* sp = out + O_PF + ((size_t)((layer * NB + b) * 2 + (t - (SEQ - 2)))) * DFF + col; *(f32x4*)sp = g[0]; *(f32x4*)(sp + 4) = g[1]; } }
                gp[0] = g[0]; gp[1] = g[1];
            }
        }
    }
};
struct EpiQkv {
    static constexpr bool PERM = true, AFTER_DRAIN = false;
    bf16_t* QKV; float* QS; const float* ssq; float* out;
    __device__ __forceinline__ void operator()(const f32x4 (&acc)[2][2][4][2], const Unit& u, int wr, int wc, int fr, int fq) const {
        const int which = u.pn >> 2, cb = 256 * (u.pn & 3) + wc * 32 + 8 * fq;
        bf16_t* dst = QKV + (size_t)which * ((WS_K - WS_Q) / 2);
#pragma unroll
        for (int ai = 0; ai < 2; ++ai)
#pragma unroll
            for (int m = 0; m < 4; ++m) {
                const int r = u.pm * BM + ai * HALF + wr * 64 + m * 16 + fr;
                const float rs = row_rstd(ssq, r, fq) * (which == 0 ? QSCALE : 1.0f);
                float* fp = nullptr;
                if (which == 0) { if (r >= MPR && r < MTOT) fp = QS + (size_t)(r - MPR) * D; }
                else if (r < MPR) fp = out + (which == 1 ? O_PK : O_PV) + (size_t)r * D;
                else if (r < MTOT) { const int rs_ = r - MPR, sb = rs_ >> 2, j = rs_ & 3; fp = out + (which == 1 ? O_SK : O_SV) + ((size_t)sb * LBUF + (LBUF - NST) + j) * D; }
#pragma unroll
                for (int bj = 0; bj < 2; ++bj) {
                    const f32x4 v0 = acc[ai][bj][m][0] * rs, v1 = acc[ai][bj][m][1] * rs;
                    const int c = cb + bj * HALF;
                    u32x4 w; w.x = cvt_pk_bf16(v0[0], v0[1]); w.y = cvt_pk_bf16(v0[2], v0[3]); w.z = cvt_pk_bf16(v1[0], v1[1]); w.w = cvt_pk_bf16(v1[2], v1[3]);
                    *(u32x4*)(dst + (size_t)r * D + c) = w;
                    if (fp) { *(f32x4*)(fp + c) = v0; *(f32x4*)(fp + c + 4) = v1; }
                }
            }
    }
};

template <class Epi, class Sched, bool ALIGN_EPI = false, bool SP2 = false>
__device__ __forceinline__ void gemm_phase(LAS unsigned char* lds, const Gemm g, const Sched& S, const Epi& E) {
    const int tid = launder_v(threadIdx.x), wid = __builtin_amdgcn_readfirstlane(tid >> 6), lane = tid & 63, wr = wid >> 2, wc = wid & 3, fr = lane & 15, fq = lane >> 4;
    const int K = g.K, nt = K / BK;
    unsigned voffA[2], voffB[2];
#pragma unroll
    for (int i = 0; i < 2; ++i) { int R, C; stage_rc(tid * 16 + i * 8192, R, C); const int Rb = Epi::PERM ? ((R & ~31) + perm32(R & 31)) : R;
        voffA[i] = (unsigned)(R * K + C) * 2u; voffB[i] = (unsigned)(Rb * K + C) * 2u; }
    const size_t kstep = (size_t)(BK * 2);
    const size_t hstep = (size_t)HALF * K * 2;
    const size_t tstep = 2 * hstep;
    const unsigned ldsw = (unsigned)wid * 1024u;
    const int aoff = lds_byte(wr * 64 + fr, fq * 8), boff = lds_byte(wc * 32 + fr, fq * 8);
#define PG8_SA(b, h) (((b) * 2 + (h)) * HTB)
#define PG8_SB(b, h) ((4 + (b) * 2 + (h)) * HTB)
#define PG8_STAGE(bufoff, gbase, voff) do { _Pragma("unroll") for (int _i = 0; _i < 2; ++_i) \
        __builtin_amdgcn_global_load_lds((const unsigned*)((const char*)(gbase) + (voff)[_i]), (LAS unsigned*)(lds + (bufoff) + ldsw + _i * 8192), 16, 0, 0); } while (0)
#define PG8_LDA(dst, b, h) do { _Pragma("unroll") for (int m = 0; m < 4; ++m) _Pragma("unroll") for (int k = 0; k < 2; ++k) dst[m][k] = *(const LAS bf16x8*)(lds + PG8_SA(b, h) + aoff + m * 2048 + k * 1024); } while (0)
#define PG8_LDB(dst, b, h) do { _Pragma("unroll") for (int n = 0; n < 2; ++n) _Pragma("unroll") for (int k = 0; k < 2; ++k) dst[n][k] = *(const LAS bf16x8*)(lds + PG8_SB(b, h) + boff + n * 2048 + k * 1024); } while (0)
#define PG8_MMA(ai, bj, At, Bt) do { __builtin_amdgcn_s_setprio(1); _Pragma("unroll") for (int m = 0; m < 4; ++m) _Pragma("unroll") for (int n = 0; n < 2; ++n) _Pragma("unroll") for (int k = 0; k < 2; ++k) \
        acc[ai][bj][m][n] = __builtin_amdgcn_mfma_f32_16x16x32_bf16(Bt[n][k], At[m][k], acc[ai][bj][m][n], 0, 0, 0); __builtin_amdgcn_s_setprio(0); } while (0)
#define PG8_WAIT_V(n) asm volatile("s_waitcnt vmcnt(" #n ")" ::: "memory")
#define PG8_WAIT_L(n) asm volatile("s_waitcnt lgkmcnt(" #n ")" ::: "memory")
#define PG8_BAR __builtin_amdgcn_s_barrier()
#define PG8_SCHED __builtin_amdgcn_sched_barrier(0)
    Unit cur, nxt; int ui = 0;
    if (!S.next(0, cur)) return;
    f32x4 acc[2][2][4][2];
#pragma unroll
    for (int a = 0; a < 2; ++a)
#pragma unroll
        for (int b = 0; b < 2; ++b)
#pragma unroll
            for (int m = 0; m < 4; ++m)
#pragma unroll
                for (int n = 0; n < 2; ++n) acc[a][b][m][n] = (f32x4){0.f, 0.f, 0.f, 0.f};
    bf16x8 At[4][2], B0[2][2], B1[2][2];
    const char* cA = (const char*)g.A + (size_t)cur.pm * tstep; const char* cB = (const char*)g.Bt + (size_t)cur.pn * tstep;
    S.a_ready(cur);
    if constexpr (SP2) {
        PG8_STAGE(PG8_SB(0, 0), cB, voffB); PG8_STAGE(PG8_SB(0, 1), cB + hstep, voffB); PG8_STAGE(PG8_SA(0, 0), cA, voffA); PG8_STAGE(PG8_SA(0, 1), cA + hstep, voffA);
        if (wr == 1) PG8_BAR;
        PG8_WAIT_V(2); PG8_BAR;
        PG8_STAGE(PG8_SB(1, 0), cB + kstep, voffB); PG8_STAGE(PG8_SA(1, 0), cA + kstep, voffA); PG8_STAGE(PG8_SB(1, 1), cB + hstep + kstep, voffB);
        PG8_WAIT_V(6); PG8_BAR;
    } else {
        PG8_STAGE(PG8_SB(0, 0), cB, voffB); PG8_STAGE(PG8_SA(0, 0), cA, voffA); PG8_STAGE(PG8_SB(0, 1), cB + hstep, voffB); PG8_STAGE(PG8_SA(0, 1), cA + hstep, voffA);
        if (wr == 1) PG8_BAR;
        PG8_WAIT_V(4); PG8_BAR;
        PG8_STAGE(PG8_SB(1, 0), cB + kstep, voffB); PG8_STAGE(PG8_SA(1, 0), cA + kstep, voffA); PG8_STAGE(PG8_SB(1, 1), cB + hstep + kstep, voffB);
        PG8_WAIT_V(6); PG8_BAR;
    }
    for (;;) {
        const bool has_next = S.next(ui + 1, nxt);
        const char* nA = has_next ? (const char*)g.A + (size_t)nxt.pm * tstep : cA; const char* nB = has_next ? (const char*)g.Bt + (size_t)nxt.pn * tstep : cB;
        for (int t = 0; t < nt; t += 2) {
            const bool last = (t == nt - 2);
            const char* a1 = cA + (size_t)(t + 1) * kstep;
            const char* a2 = last ? nA : cA + (size_t)(t + 2) * kstep; const char* b2 = last ? nB : cB + (size_t)(t + 2) * kstep;
            const char* a3 = a2 + kstep; const char* b3 = b2 + kstep;
            if (last && has_next) S.a_ready(nxt);
            if constexpr (SP2) {
            PG8_LDB(B0, 0, 0); PG8_LDB(B1, 0, 1); PG8_SCHED; PG8_LDA(At, 0, 0); PG8_STAGE(PG8_SA(1, 1), a1 + hstep, voffA);
            PG8_WAIT_V(8); PG8_WAIT_L(0); PG8_BAR; PG8_MMA(0, 0, At, B0); PG8_MMA(0, 1, At, B1); PG8_BAR; PG8_SCHED;
            PG8_LDA(At, 0, 1); PG8_STAGE(PG8_SB(0, 0), b2, voffB); PG8_STAGE(PG8_SB(0, 1), b2 + hstep, voffB); PG8_STAGE(PG8_SA(0, 0), a2, voffA);
            PG8_WAIT_V(8); PG8_WAIT_L(0); PG8_BAR; PG8_MMA(1, 0, At, B0); PG8_MMA(1, 1, At, B1); PG8_BAR; PG8_SCHED;
            PG8_LDB(B0, 1, 0); PG8_LDB(B1, 1, 1); PG8_SCHED; PG8_LDA(At, 1, 0); PG8_STAGE(PG8_SA(0, 1), a2 + hstep, voffA);
            PG8_WAIT_V(8); PG8_WAIT_L(0); PG8_BAR; PG8_MMA(0, 0, At, B0); PG8_MMA(0, 1, At, B1); PG8_BAR; PG8_SCHED;
            PG8_LDA(At, 1, 1); PG8_STAGE(PG8_SB(1, 0), b3, voffB); PG8_STAGE(PG8_SB(1, 1), b3 + hstep, voffB); PG8_STAGE(PG8_SA(1, 0), a3, voffA);
            PG8_WAIT_V(8); PG8_WAIT_L(0); PG8_BAR; PG8_MMA(1, 0, At, B0); PG8_MMA(1, 1, At, B1); PG8_BAR; PG8_SCHED;
            } else {
            PG8_LDB(B0, 0, 0); PG8_SCHED; PG8_LDA(At, 0, 0); PG8_STAGE(PG8_SA(1, 1), a1 + hstep, voffA);
            PG8_WAIT_L(8); PG8_BAR; PG8_WAIT_L(0); PG8_MMA(0, 0, At, B0); PG8_BAR; PG8_SCHED;
            PG8_LDB(B1, 0, 1); PG8_STAGE(PG8_SB(0, 0), b2, voffB);
            PG8_BAR; PG8_WAIT_L(0); PG8_MMA(0, 1, At, B1); PG8_BAR;
            PG8_LDA(At, 0, 1); PG8_STAGE(PG8_SA(0, 0), a2, voffA);
            PG8_BAR; PG8_WAIT_L(0); PG8_MMA(1, 0, At, B0); PG8_BAR; PG8_SCHED;
            PG8_STAGE(PG8_SB(0, 1), b2 + hstep, voffB);
            PG8_WAIT_V(6); PG8_BAR; PG8_MMA(1, 1, At, B1); PG8_BAR;
            PG8_LDB(B0, 1, 0); PG8_SCHED; PG8_LDA(At, 1, 0); PG8_STAGE(PG8_SA(0, 1), a2 + hstep, voffA);
            PG8_WAIT_L(8); PG8_BAR; PG8_WAIT_L(0); PG8_MMA(0, 0, At, B0); PG8_BAR; PG8_SCHED;
            PG8_LDB(B1, 1, 1); PG8_STAGE(PG8_SB(1, 0), b3, voffB);
            PG8_BAR; PG8_WAIT_L(0); PG8_MMA(0, 1, At, B1); PG8_BAR;
            PG8_LDA(At, 1, 1); PG8_STAGE(PG8_SA(1, 0), a3, voffA);
            PG8_BAR; PG8_WAIT_L(0); PG8_MMA(1, 0, At, B0); PG8_BAR; PG8_SCHED;
            PG8_STAGE(PG8_SB(1, 1), b3 + hstep, voffB);
            PG8_WAIT_V(6); PG8_BAR; PG8_MMA(1, 1, At, B1); PG8_BAR;
            }
        }
        if constexpr (ALIGN_EPI) { if (wr == 0) PG8_BAR; }
        if constexpr (!Epi::AFTER_DRAIN) { E(acc, cur, wr, wc, fr, fq); S.done(cur); }
        if (!has_next) break;
#pragma unroll
        for (int a = 0; a < 2; ++a)
#pragma unroll
            for (int b = 0; b < 2; ++b)
#pragma unroll
                for (int m = 0; m < 4; ++m)
#pragma unroll
                    for (int n = 0; n < 2; ++n) acc[a][b][m][n] = (f32x4){0.f, 0.f, 0.f, 0.f};
        cur = nxt; cA = nA; cB = nB; ++ui;
        if constexpr (ALIGN_EPI) { if (wr == 1) PG8_BAR; }
    }
    PG8_WAIT_V(0);
    if constexpr (!ALIGN_EPI) { if (wr == 0) PG8_BAR; }
    PG8_BAR;
#undef PG8_SA
#undef PG8_SB
#undef PG8_STAGE
#undef PG8_LDA
#undef PG8_LDB
#undef PG8_MMA
#undef PG8_WAIT_V
#undef PG8_WAIT_L
#undef PG8_BAR
#undef PG8_SCHED
}
}

__device__ __forceinline__ void transpose_item(const float* W, int K, int N, bf16_t* WT, int k0, int np0, int srcn0, const float* g, LAS float* scr, int lane) {
    f32x4 v[8];
#pragma unroll
    for (int i = 0; i < 8; ++i) { const int kk = 8 * i + (lane >> 3); v[i] = *(const f32x4*)(W + (size_t)(k0 + kk) * N + srcn0 + (lane & 7) * 4); }
#pragma unroll
    for (int i = 0; i < 8; ++i) { const int kk = 8 * i + (lane >> 3); const float gg = g ? g[k0 + kk] : 1.0f; LAS float* d = scr + kk * 33 + (lane & 7) * 4;
        d[0] = v[i].x * gg; d[1] = v[i].y * gg; d[2] = v[i].z * gg; d[3] = v[i].w * gg; }
    asm volatile("s_waitcnt lgkmcnt(0)" ::: "memory");
    const int c = lane & 7;
#pragma unroll
    for (int j = 0; j < 4; ++j) { const int n = (lane >> 3) + 8 * j; const LAS float* s = scr + (8 * c) * 33 + n;
        u32x4 o; o.x = cvt_pk_bf16(s[0 * 33], s[1 * 33]); o.y = cvt_pk_bf16(s[2 * 33], s[3 * 33]); o.z = cvt_pk_bf16(s[4 * 33], s[5 * 33]); o.w = cvt_pk_bf16(s[6 * 33], s[7 * 33]);
        *(u32x4*)(WT + (size_t)(np0 + n) * K + k0 + 8 * c) = o; }
    asm volatile("s_waitcnt lgkmcnt(0)" ::: "memory");
}
__device__ __forceinline__ int src_in_ab(int np) {
    const int pn = np >> 8, cc = np & 255, bj = cc >> 7, off = cc & 127;
    if (pn < 4) return (bj ? 512 : 0) + 128 * pn + off;
    if (pn < 8) return (bj ? 2048 : 1536) + 128 * (pn - 4) + off;
    return 1024 + 256 * (pn - 8) + cc;
}
__device__ __forceinline__ int src_ffn(int np) { const int pn = np >> 8, cc = np & 255, bj = cc >> 7, off = cc & 127; return (bj ? DFF : 0) + 128 * pn + off; }

struct Args { const float* in[22]; float* out; unsigned char* ws; };

__device__ __forceinline__ void copy_range(const Args& a, size_t lo, size_t hi, int bi, int nb, int tid) {
    const size_t per = (size_t)(LBUF - NST) * D / 4;
    const size_t stride = (size_t)nb * NTHREADS;
    for (size_t i0 = lo + (size_t)bi * NTHREADS + tid; i0 < hi; i0 += 8 * stride) {
        f32x4 kv[8], vv[8];
#pragma unroll
        for (int u = 0; u < 8; ++u) { const size_t i = i0 + u * stride; if (i < hi) { const size_t sb = i / per, rem = i % per;
            kv[u] = __builtin_nontemporal_load((const f32x4*)(a.in[4] + (sb * LBUF + NST) * D) + rem); vv[u] = __builtin_nontemporal_load((const f32x4*)(a.in[5] + (sb * LBUF + NST) * D) + rem); } }
#pragma unroll
        for (int u = 0; u < 8; ++u) { const size_t i = i0 + u * stride; if (i < hi) { const size_t sb = i / per, rem = i % per;
            __builtin_nontemporal_store(kv[u], (f32x4*)(a.out + O_SK + sb * LBUF * D) + rem); __builtin_nontemporal_store(vv[u], (f32x4*)(a.out + O_SV + sb * LBUF * D) + rem); } }
    }
}
constexpr int FR_P1 = 5, FR_P4 = 5, FR_P10 = 5, GE_P1 = 224, GE_FF = 240;
constexpr size_t CP_TOT = (size_t)(LBUF - NST) * D / 4 * NSB;
constexpr size_t CP_C0 = CP_TOT * (64 - FR_P1 - FR_P4 - FR_P10) / 64, CP_C1 = CP_C0 + CP_TOT * FR_P1 / 64, CP_C2 = CP_C1 + CP_TOT * FR_P4 / 64;

__device__ __forceinline__ void p0_prologue(const Args& a, LAS unsigned char* lds, int gw, int NGW, int lane, int wave) {
    LAS float* scr = (LAS float*)(lds + wave * 16384);
    unsigned char* ws = a.ws;
    constexpr int I_IN = (D / 64) * (NIN / 32), I_SQ = (D / 64) * (D / 32), I_QKV = (D / 64) * (3 * D / 32), I_F = (D / 64) * (2 * DFF / 32), I_DN = (DFF / 64) * (D / 32);
    constexpr int NITEMS = I_IN + 2 * I_SQ + I_QKV + 2 * I_F + 2 * I_DN;
    for (int it = gw; it < NITEMS; it += NGW) {
        int r = it;
        if (r < I_IN) { const int nb = NIN / 32, kb = r / nb, n0 = 32 * (r % nb); transpose_item(a.in[10], D, NIN, (bf16_t*)(ws + WS_WIN), 64 * kb, n0, src_in_ab(n0), a.in[7], scr, lane); continue; } r -= I_IN;
        if (r < I_SQ) { const int nb = D / 32, kb = r / nb, n0 = 32 * (r % nb); transpose_item(a.in[16], D, D, (bf16_t*)(ws + WS_WOUT), 64 * kb, n0, n0, nullptr, scr, lane); continue; } r -= I_SQ;
        if (r < I_QKV) { const int nb = 3 * D / 32, kb = r / nb, n0 = 32 * (r % nb); transpose_item(a.in[17], D, 3 * D, (bf16_t*)(ws + WS_WQKV), 64 * kb, n0, n0, a.in[7] + D, scr, lane); continue; } r -= I_QKV;
        if (r < I_SQ) { const int nb = D / 32, kb = r / nb, n0 = 32 * (r % nb); transpose_item(a.in[18], D, D, (bf16_t*)(ws + WS_WO), 64 * kb, n0, n0, nullptr, scr, lane); continue; } r -= I_SQ;
        if (r < 2 * I_F) { const int l = r / I_F; r -= l * I_F; const int nb = 2 * DFF / 32, kb = r / nb, n0 = 32 * (r % nb);
            transpose_item(a.in[19] + (size_t)l * D * 2 * DFF, D, 2 * DFF, (bf16_t*)(ws + (l ? WS_WF1 : WS_WF0)), 64 * kb, n0, src_ffn(n0), a.in[8] + l * D, scr, lane); continue; } r -= 2 * I_F;
        { const int l = r / I_DN; r -= l * I_DN; const int nb = D / 32, kb = r / nb, n0 = 32 * (r % nb);
            transpose_item(a.in[21] + (size_t)l * DFF * D, DFF, D, (bf16_t*)(ws + (l ? WS_WD1 : WS_WD0)), 64 * kb, n0, n0, nullptr, scr, lane); }
    }
    bf16_t* HB = (bf16_t*)(ws + WS_HB); float* ssq = (float*)(ws + WS_SSQ);
    for (int r0 = gw; r0 < MPAD; r0 += 2 * NGW) {
        f32x4 v[2][4]; float sq[2];
#pragma unroll
        for (int h = 0; h < 2; ++h) { const int r = r0 + h * NGW; sq[h] = 0.f;
            if (r < MTOT) { const f32x4* xr = (const f32x4*)((r < MPR) ? a.in[0] + (size_t)r * D : a.in[1] + (size_t)(r - MPR) * D) + lane;
#pragma unroll
                for (int j = 0; j < 4; ++j) v[h][j] = __builtin_nontemporal_load(xr + 64 * j); }
            else {
#pragma unroll
                for (int j = 0; j < 4; ++j) v[h][j] = (f32x4){0.f, 0.f, 0.f, 0.f}; } }
#pragma unroll
        for (int h = 0; h < 2; ++h) { const int r = r0 + h * NGW; if (r >= MPAD) continue;
#pragma unroll
            for (int j = 0; j < 4; ++j) sq[h] += (v[h][j].x * v[h][j].x + v[h][j].y * v[h][j].y) + (v[h][j].z * v[h][j].z + v[h][j].w * v[h][j].w);
            const float s = wave_sum(sq[h]);
            u32x2* o8 = (u32x2*)(HB + (size_t)r * D) + lane;
#pragma unroll
            for (int j = 0; j < 4; ++j) { u32x2 w; w.x = cvt_pk_bf16(v[h][j].x, v[h][j].y); w.y = cvt_pk_bf16(v[h][j].z, v[h][j].w); o8[64 * j] = w; }
            if (r < MPR) { if (lane < 16) ssq[(size_t)r * 64 + lane] = (lane == 0) ? s : 0.f; } else ssq[(size_t)r * 64 + lane] = (lane == 0) ? s : 0.f; }
    }
    {
        const int tot = NSB * 26 * (CH / 4);
        for (int i = gw * 64 + lane; i < tot; i += NGW * 64) { const int sb = i / (26 * (CH / 4)), rem = i % (26 * (CH / 4));
            ((f32x4*)(a.out + O_SCA + (size_t)sb * 30 * CH))[rem] = ((const f32x4*)(a.in[2] + (size_t)sb * 30 * CH + 4 * CH))[rem]; }
    }
    copy_range(a, 0, CP_C0, blockIdx.x, gridDim.x, threadIdx.x);
}

__device__ __forceinline__ void p2_conv(const Args& a, LAS unsigned char* lds, int tid, int lane, int wave) {
    unsigned char* ws = a.ws;
    const bf16_t* GA = (const bf16_t*)(ws + WS_GA); bf16_t* AB = (bf16_t*)(ws + WS_AB);
    LAS float* T = (LAS float*)lds;
    for (int u = blockIdx.x; u < 512 + NSB; u += gridDim.x) {
        const float* wa = a.in[11]; const float* ba = a.in[12]; const float* lg = a.in[13]; const float* lb = a.in[14]; const float* wb = a.in[15];
        asm volatile("" : "+s"(wa), "+s"(ba), "+s"(lg), "+s"(lb), "+s"(wb));
        const bool samp = u >= 512; const int sb = u - 512;
        const int row0 = samp ? MPR + sb * NST : u * 32, nrows = samp ? NST : 32;
        const int t0 = samp ? 0 : (row0 & (SEQ - 1));
        const int nvec = (nrows + 30) * (CH / 8);
        {
            u32x4 wv[8];
#pragma unroll
            for (int it = 0; it < 8; ++it) { const int i = tid + it * NTHREADS; const int e = i >> 6, c = (i & 63) * 8; const int p = t0 - 30 + e;
                wv[it] = (u32x4){0u, 0u, 0u, 0u};
                if (i < nvec && p >= 0) wv[it] = *(const u32x4*)(GA + (size_t)(row0 - t0 + p) * GAW + c); }
#pragma unroll
            for (int it = 0; it < 8; ++it) { const int i = tid + it * NTHREADS; const int e = i >> 6, c = (i & 63) * 8; const int p = t0 - 30 + e;
                if (i < nvec && (p >= 0 || !samp)) { const u32x4 w = wv[it];
                    *(LAS f32x4*)(T + e * CH + c) = (f32x4){bflo(w.x), bfhi(w.x), bflo(w.y), bfhi(w.y)}; *(LAS f32x4*)(T + e * CH + c + 4) = (f32x4){bflo(w.z), bfhi(w.z), bflo(w.w), bfhi(w.w)}; } }
            if (samp) {
                f32x4 s0_[4], s1_[4];
#pragma unroll
                for (int it = 0; it < 4; ++it) { const int i = tid + it * NTHREADS; if (i < 30 * 64) { const float* sp = a.in[2] + ((size_t)sb * 30 + (i >> 6)) * CH + (i & 63) * 8; s0_[it] = *(const f32x4*)sp; s1_[it] = *(const f32x4*)(sp + 4); } }
#pragma unroll
                for (int it = 0; it < 4; ++it) { const int i = tid + it * NTHREADS; if (i < 30 * 64) { *(LAS f32x4*)(T + (i >> 6) * CH + (i & 63) * 8) = s0_[it]; *(LAS f32x4*)(T + (i >> 6) * CH + (i & 63) * 8 + 4) = s1_[it]; } }
            }
        }
        __syncthreads();
        if (tid < 256) {
            const int c = 2 * tid; f32x2 w[KA];
#pragma unroll
            for (int k = 0; k < KA; ++k) w[k] = *(const f32x2*)(wa + k * CH + c);
            const f32x2 bias = *(const f32x2*)(ba + c);
            if (!samp) {
#pragma clang loop unroll(disable)
                for (int hb = 0; hb < 32; hb += 16) {
                    f32x2 x[46];
#pragma unroll
                    for (int e = 0; e < 46; ++e) x[e] = *(const LAS f32x2*)(T + (hb + e) * CH + c);
#pragma unroll
                    for (int i = 0; i < 16; ++i) {
                        f32x2 s0 = bias, s1 = (f32x2){0.f, 0.f}, s2 = s1, s3 = s1;
#pragma unroll
                        for (int k = 0; k < 28; k += 4) { s0 += w[k] * x[i + k]; s1 += w[k + 1] * x[i + k + 1]; s2 += w[k + 2] * x[i + k + 2]; s3 += w[k + 3] * x[i + k + 3]; }
                        s0 += w[28] * x[i + 28]; s1 += w[29] * x[i + 29]; s2 += w[30] * x[i + 30];
                        *(LAS f32x2*)(T + (hb + i) * CH + c) = (s0 + s1) + (s2 + s3);
                    }
                }
            } else {
                f32x2 x[34];
#pragma unroll
                for (int e = 0; e < 34; ++e) x[e] = *(const LAS f32x2*)(T + e * CH + c);
#pragma unroll
                for (int i = 0; i < NST; ++i) {
                    f32x2 s0 = bias, s1 = (f32x2){0.f, 0.f}, s2 = s1, s3 = s1;
#pragma unroll
                    for (int k = 0; k < 28; k += 4) { s0 += w[k] * x[i + k]; s1 += w[k + 1] * x[i + k + 1]; s2 += w[k + 2] * x[i + k + 2]; s3 += w[k + 3] * x[i + k + 3]; }
                    s0 += w[28] * x[i + 28]; s1 += w[29] * x[i + 29]; s2 += w[30] * x[i + 30];
                    *(LAS f32x2*)(T + i * CH + c) = (s0 + s1) + (s2 + s3);
                }
            }
        } else {
            const int t2 = tid - 256, c = (t2 & 63) * 8, rc = t2 >> 6, rbase = rc * 8;
            const int nr = samp ? (rc == 0 ? NST : 0) : 8;
            float wk[3][8];
#pragma unroll
            for (int k = 0; k < 3; ++k) { const f32x4 wa0 = *(const f32x4*)(wb + k * CH + c), wa1 = *(const f32x4*)(wb + k * CH + c + 4);
                wk[k][0] = wa0.x; wk[k][1] = wa0.y; wk[k][2] = wa0.z; wk[k][3] = wa0.w; wk[k][4] = wa1.x; wk[k][5] = wa1.y; wk[k][6] = wa1.z; wk[k][7] = wa1.w; }
            float xm2[8], xm1[8];
            {
                u32x4 a2 = (u32x4){0u, 0u, 0u, 0u}, a1 = a2;
                if (nr && t0 + rbase - 2 >= 0) { a2 = *(const u32x4*)(GA + (size_t)(row0 + rbase - 2) * GAW + 512 + c); a1 = *(const u32x4*)(GA + (size_t)(row0 + rbase - 1) * GAW + 512 + c); }
                xm2[0] = bflo(a2.x); xm2[1] = bfhi(a2.x); xm2[2] = bflo(a2.y); xm2[3] = bfhi(a2.y); xm2[4] = bflo(a2.z); xm2[5] = bfhi(a2.z); xm2[6] = bflo(a2.w); xm2[7] = bfhi(a2.w);
                xm1[0] = bflo(a1.x); xm1[1] = bfhi(a1.x); xm1[2] = bflo(a1.y); xm1[3] = bfhi(a1.y); xm1[4] = bflo(a1.z); xm1[5] = bfhi(a1.z); xm1[6] = bflo(a1.w); xm1[7] = bfhi(a1.w);
                if (samp && nr) { const float* sp = a.in[3] + (size_t)sb * 2 * CH + c; const f32x4 p0 = *(const f32x4*)sp, p1 = *(const f32x4*)(sp + 4), q0 = *(const f32x4*)(sp + CH), q1 = *(const f32x4*)(sp + CH + 4);
                    xm2[0] = p0.x; xm2[1] = p0.y; xm2[2] = p0.z; xm2[3] = p0.w; xm2[4] = p1.x; xm2[5] = p1.y; xm2[6] = p1.z; xm2[7] = p1.w;
                    xm1[0] = q0.x; xm1[1] = q0.y; xm1[2] = q0.z; xm1[3] = q0.w; xm1[4] = q1.x; xm1[5] = q1.y; xm1[6] = q1.z; xm1[7] = q1.w; }
            }
#pragma clang loop unroll(disable)
            for (int k0 = 0; k0 < nr; k0 += 4) {
                u32x4 cxv[4], gbv[4];
#pragma unroll
                for (int k = 0; k < 4; ++k) { cxv[k] = *(const u32x4*)(GA + (size_t)(row0 + rbase + k0 + k) * GAW + 512 + c); gbv[k] = *(const u32x4*)(GA + (size_t)(row0 + rbase + k0 + k) * GAW + 1024 + c); }
#pragma unroll
                for (int k = 0; k < 4; ++k) {
                    const u32x4 xv = cxv[k], gv = gbv[k];
                    float o[8];
#pragma unroll
                    for (int e = 0; e < 8; ++e) {
                        const unsigned xw = e < 2 ? xv.x : (e < 4 ? xv.y : (e < 6 ? xv.z : xv.w)), gw_ = e < 2 ? gv.x : (e < 4 ? gv.y : (e < 6 ? gv.z : gv.w));
                        const float x0 = (e & 1) ? bfhi(xw) : bflo(xw), gb = (e & 1) ? bfhi(gw_) : bflo(gw_);
                        o[e] = gb * (wk[0][e] * xm2[e] + wk[1][e] * xm1[e] + wk[2][e] * x0); xm2[e] = xm1[e]; xm1[e] = x0; }
                    u32x4 w4; w4.x = cvt_pk_bf16(o[0], o[1]); w4.y = cvt_pk_bf16(o[2], o[3]); w4.z = cvt_pk_bf16(o[4], o[5]); w4.w = cvt_pk_bf16(o[6], o[7]);
                    *(u32x4*)(AB + (size_t)(row0 + rbase + k0 + k) * D + 512 + c) = w4;
                }
            }
        }
        __syncthreads();
        {
            const int c = lane * 8;
            const f32x4 g0 = *(const f32x4*)(lg + c), g1 = *(const f32x4*)(lg + c + 4), b0 = *(const f32x4*)(lb + c), b1 = *(const f32x4*)(lb + c + 4);
            f32x4 v0[4], v1[4]; float mu[4], rstd[4];
#pragma unroll
            for (int j = 0; j < 4; ++j) { const int rr = wave + 8 * j; const int rc = rr < nrows ? rr : 0; v0[j] = *(const LAS f32x4*)(T + rc * CH + c); v1[j] = *(const LAS f32x4*)(T + rc * CH + c + 4); }
#pragma unroll
            for (int j = 0; j < 4; ++j) { const float s_ = (v0[j].x + v0[j].y) + (v0[j].z + v0[j].w) + (v1[j].x + v1[j].y) + (v1[j].z + v1[j].w); mu[j] = wave_sum(s_) * (1.0f / CH); }
#pragma unroll
            for (int j = 0; j < 4; ++j) { v0[j] = v0[j] - mu[j]; v1[j] = v1[j] - mu[j];
                const float q = (v0[j].x * v0[j].x + v0[j].y * v0[j].y) + (v0[j].z * v0[j].z + v0[j].w * v0[j].w) + (v1[j].x * v1[j].x + v1[j].y * v1[j].y) + (v1[j].z * v1[j].z + v1[j].w * v1[j].w);
                rstd[j] = rsqrtf(wave_sum(q) * (1.0f / CH) + LN_EPS); }
#pragma unroll
            for (int j = 0; j < 4; ++j) { const int rr = wave + 8 * j;
                if (rr < nrows) {
                    f32x4 a0 = v0[j] * rstd[j] * g0 + b0, a1 = v1[j] * rstd[j] * g1 + b1;
#pragma unroll
                    for (int e = 0; e < 4; ++e) { a0[e] = a0[e] * sigmoidf_(a0[e]); a1[e] = a1[e] * sigmoidf_(a1[e]); }
                    u32x4 w4; w4.x = cvt_pk_bf16(a0[0], a0[1]); w4.y = cvt_pk_bf16(a0[2], a0[3]); w4.z = cvt_pk_bf16(a1[0], a1[1]); w4.w = cvt_pk_bf16(a1[2], a1[3]);
                    *(u32x4*)(AB + (size_t)(row0 + rr) * D + c) = w4;
                } }
        }
        __syncthreads();
    }
}

__device__ __forceinline__ void p5_fix(const Args& a, int layer, int gtid, int GT) {
    unsigned char* ws = a.ws;
    const bf16_t* ZG = (const bf16_t*)(ws + WS_ZG); const bf16_t* ZU = (const bf16_t*)(ws + WS_ZU); bf16_t* U = (bf16_t*)(ws + WS_U);
    const float* SG = (const float*)(ws + WS_SG); const float* SU = (const float*)(ws + WS_SU);
    const float* wc = a.in[20] + (size_t)layer * 3 * DFF;
    constexpr int NCV = DFF / 8, NBLK = MPR / 64;
    const int nit = NBLK * 2 * NCV + NSB * NCV;
    for (int it = gtid; it < nit; it += GT) {
        const bool samp = it >= NBLK * 2 * NCV;
        if (!samp) {
            const int cv = it % NCV, bj = it / NCV, blk = bj >> 1, j = bj & 1, c = cv * 8;
            const bool first = (blk & 31) == 0;
            float gm2[8], gm1[8], g0[8], up[8];
            const float* cur = SG + (size_t)blk * 4 * DFF + c; const float* prv = SG + (size_t)(blk - 1) * 4 * DFF + c;
#pragma unroll
            for (int e = 0; e < 8; ++e) {
                if (j == 0) { gm2[e] = first ? 0.f : prv[2 * DFF + e]; gm1[e] = first ? 0.f : prv[3 * DFF + e]; g0[e] = cur[e]; }
                else { gm2[e] = first ? 0.f : prv[3 * DFF + e]; gm1[e] = cur[e]; g0[e] = cur[DFF + e]; }
                up[e] = SU[((size_t)blk * 2 + j) * DFF + c + e];
            }
            float o[8];
#pragma unroll
            for (int e = 0; e < 8; ++e) { const float y = wc[c + e] * gm2[e] + wc[DFF + c + e] * gm1[e] + wc[2 * DFF + c + e] * g0[e]; o[e] = y * sigmoidf_(y) * up[e]; }
            u32x4 w4; w4.x = cvt_pk_bf16(o[0], o[1]); w4.y = cvt_pk_bf16(o[2], o[3]); w4.z = cvt_pk_bf16(o[4], o[5]); w4.w = cvt_pk_bf16(o[6], o[7]);
            *(u32x4*)(U + (size_t)(blk * 64 + j) * DFF + c) = w4;
        } else {
            const int jj = it - NBLK * 2 * NCV, sb = jj / NCV, cv = jj % NCV, c = cv * 8, r0 = MPR + sb * NST;
            float w0[8], w1[8], w2[8], gm2[8], gm1[8];
            const float* sp = a.in[6] + ((size_t)(layer * NSB + sb) * 2) * DFF + c;
#pragma unroll
            for (int e = 0; e < 8; ++e) { w0[e] = wc[c + e]; w1[e] = wc[DFF + c + e]; w2[e] = wc[2 * DFF + c + e]; gm2[e] = sp[e]; gm1[e] = sp[DFF + e]; }
            for (int i = 0; i < NST; ++i) {
                const size_t off = (size_t)(r0 + i) * DFF + c;
                const u32x4 gv = *(const u32x4*)(ZG + off), uv = *(const u32x4*)(ZU + off);
                float g[8] = {bflo(gv.x), bfhi(gv.x), bflo(gv.y), bfhi(gv.y), bflo(gv.z), bfhi(gv.z), bflo(gv.w), bfhi(gv.w)};
                float up[8] = {bflo(uv.x), bfhi(uv.x), bflo(uv.y), bfhi(uv.y), bflo(uv.z), bfhi(uv.z), bflo(uv.w), bfhi(uv.w)};
                float o[8];
#pragma unroll
                for (int e = 0; e < 8; ++e) { const float y = w0[e] * gm2[e] + w1[e] * gm1[e] + w2[e] * g[e]; o[e] = y * sigmoidf_(y) * up[e]; gm2[e] = gm1[e]; gm1[e] = g[e]; }
                u32x4 w4; w4.x = cvt_pk_bf16(o[0], o[1]); w4.y = cvt_pk_bf16(o[2], o[3]); w4.z = cvt_pk_bf16(o[4], o[5]); w4.w = cvt_pk_bf16(o[6], o[7]);
                *(u32x4*)(U + off) = w4;
            }
        }
    }
}

constexpr int AT_OACC = 0, AT_OSTR = 65, AT_ML = 256 * AT_OSTR * 4, AT_STG = AT_ML + 2048, AT_KSTR = 144, AT_WSTG = 32 * AT_KSTR + 4096, AT_PSC = 0;
static_assert(AT_STG + NWAVES * AT_WSTG <= MISC_OFF && NWAVES * 2048 <= AT_ML, "attention LDS");
__device__ __forceinline__ int crow(int r, int hi) { return (r & 3) + 8 * (r >> 2) + 4 * hi; }

struct AttnRes { f32x16 o0, o1; float m, l; };
#define AT_KLOAD(X, kk_, vv_) _Pragma("unroll") for (int j = 0; j < 4; ++j) { const int kv_ = (lane >> 3) + 8 * j; const int sv_ = kb##X + kv_ < 0 ? 0 : kb##X + kv_; \
        const size_t ro_ = (size_t)(cls##X + dil##X * sv_) * D + (lane & 7) * 8; kk_[j] = *(const u32x4*)(Kh + ro_); vv_[j] = *(const u32x4*)(Vh + ro_); }
#define AT_CB() asm volatile("" ::: "memory")
__device__ __forceinline__ void attn_task2(const bf16_t* Qh, const bf16_t* Kh, const bf16_t* Vh, float slope2,
                                           int dilA, int clsA, int s0A, int nqA, int dilB, int clsB, int s0B, int nqB,
                                           LAS unsigned char* lds, int wave, int lane, AttnRes& RA, AttnRes& RB) {
    asm volatile("" : "+v"(lane));
    const int r32 = lane & 31, hi = lane >> 5;
    const int qa_ = r32 < nqA ? r32 : nqA - 1, qb_ = r32 < nqB ? r32 : nqB - 1;
    const bf16_t* qpA = Qh + (size_t)(clsA + dilA * (s0A + qa_)) * D + hi * 8; const bf16_t* qpB = Qh + (size_t)(clsB + dilB * (s0B + qb_)) * D + hi * 8;
    bf16x8 qrA[4], qrB[4];
#pragma unroll
    for (int d0 = 0; d0 < 4; ++d0) { qrA[d0] = *(const bf16x8*)(qpA + d0 * 16); qrB[d0] = *(const bf16x8*)(qpB + d0 * 16); }
    float mA = -INFINITY, lA = 0.f, mB = -INFINITY, lB = 0.f;
    f32x16 oA0 = f32x16{}, oA1 = f32x16{}, oB0 = f32x16{}, oB1 = f32x16{};
    LAS unsigned char* kst = lds + AT_STG + wave * AT_WSTG; LAS unsigned char* vst = kst + 32 * AT_KSTR;
    const float sdA = slope2 * (float)dilA, sdB = slope2 * (float)dilB;
    const float lbase = (float)(r32 - 4 * hi + 128);
    const int ifA = s0A < 128 ? (128 - s0A) >> 5 : 0, ifB = s0B < 128 ? (128 - s0B) >> 5 : 0, imin = ifA < ifB ? ifA : ifB;
    const int vb = ((lane >> 4) & 1) * 32 + (lane & 3) * 8 + (4 * hi + ((lane & 15) >> 2)) * 64;
#pragma clang loop unroll(disable)
    for (int i = 4; i >= imin; --i) {
        const int kbA = s0A - 128 + 32 * i, kbB = s0B - 128 + 32 * i;
        u32x4 kkA[4], vvA[4], kkB[4], vvB[4];
        AT_KLOAD(A, kkA, vvA)
        AT_KLOAD(B, kkB, vvB)
        bf16x8 kfA[4], kfB[4]; s16x4 tlA[4], thA[4];
#pragma unroll
        for (int j = 0; j < 4; ++j) *(LAS u32x4*)(kst + ((lane >> 3) + 8 * j) * AT_KSTR + (lane & 7) * 16) = kkA[j];
        AT_CB();
#pragma unroll
        for (int d0 = 0; d0 < 4; ++d0) kfA[d0] = *(const LAS bf16x8*)(kst + r32 * AT_KSTR + d0 * 32 + hi * 16);
        AT_CB();
#pragma unroll
        for (int j = 0; j < 4; ++j) *(LAS u32x4*)(kst + ((lane >> 3) + 8 * j) * AT_KSTR + (lane & 7) * 16) = kkB[j];
        AT_CB();
#pragma unroll
        for (int d0 = 0; d0 < 4; ++d0) kfB[d0] = *(const LAS bf16x8*)(kst + r32 * AT_KSTR + d0 * 32 + hi * 16);
        AT_CB();
#pragma unroll
        for (int j = 0; j < 4; ++j) { const int kv = (lane >> 3) + 8 * j, part = lane & 7; const int off_ = (part >> 2) * 2048 + (kv >> 3) * 512 + (kv & 7) * 64 + (part & 3) * 16;
            *(LAS u32x4*)(kst + off_) = vvA[j]; *(LAS u32x4*)(vst + off_) = vvB[j]; }
        AT_CB();
#pragma unroll
        for (int q = 0; q < 4; ++q) { tlA[q] = __builtin_bit_cast(s16x4, __builtin_amdgcn_ds_read_tr16_b64_v4i16((LAS s16x4*)(kst + vb + (q >> 1) * 2048 + (q & 1) * 1024)));
                                      thA[q] = __builtin_bit_cast(s16x4, __builtin_amdgcn_ds_read_tr16_b64_v4i16((LAS s16x4*)(kst + vb + (q >> 1) * 2048 + (q & 1) * 1024 + 512))); }
        AT_CB();
        f32x16 stA, stB;
        { const float tA = sdA * ((float)(32 * i) - lbase), tB = sdB * ((float)(32 * i) - lbase);
#pragma unroll
          for (int r = 0; r < 16; ++r) { const float c_r = (float)((r & 3) + 8 * (r >> 2)); stA[r] = tA + sdA * c_r; stB[r] = tB + sdB * c_r; } }
#pragma unroll
        for (int d0 = 0; d0 < 4; ++d0) { stA = __builtin_amdgcn_mfma_f32_32x32x16_bf16(kfA[d0], qrA[d0], stA, 0, 0, 0); stB = __builtin_amdgcn_mfma_f32_32x32x16_bf16(kfB[d0], qrB[d0], stB, 0, 0, 0); }
        if (i == 0 || i == 4 || kbA < 0 || kbB < 0) {
            int cminA = (i == 0) ? r32 : 0; cminA = cminA > -kbA ? cminA : -kbA; int cminB = (i == 0) ? r32 : 0; cminB = cminB > -kbB ? cminB : -kbB;
            const int cmax = (i == 4) ? r32 : 31;
            const int loA = cminA - 4 * hi, loB = cminB - 4 * hi, hi_ = cmax - 4 * hi;
#pragma unroll
            for (int r = 0; r < 16; ++r) { const int c = (r & 3) + 8 * (r >> 2); stA[r] = (c >= loA && c <= hi_) ? stA[r] : -INFINITY; stB[r] = (c >= loB && c <= hi_) ? stB[r] : -INFINITY; }
        }
        float mxA = fmaxf(fmaxf(stA[0], stA[1]), fmaxf(stA[2], stA[3])), mxB = fmaxf(fmaxf(stB[0], stB[1]), fmaxf(stB[2], stB[3]));
#pragma unroll
        for (int r = 4; r < 16; r += 4) { mxA = fmaxf(mxA, fmaxf(fmaxf(stA[r], stA[r + 1]), fmaxf(stA[r + 2], stA[r + 3]))); mxB = fmaxf(mxB, fmaxf(fmaxf(stB[r], stB[r + 1]), fmaxf(stB[r + 2], stB[r + 3]))); }
        { auto ra = __builtin_amdgcn_permlane32_swap(__float_as_uint(mxA), __float_as_uint(mxA), false, false); mxA = fmaxf(__uint_as_float(ra[0]), __uint_as_float(ra[1]));
          auto rb = __builtin_amdgcn_permlane32_swap(__float_as_uint(mxB), __float_as_uint(mxB), false, false); mxB = fmaxf(__uint_as_float(rb[0]), __uint_as_float(rb[1])); }
        if (__any((mxA > mA) || (mxB > mB))) {
            const float nA = fmaxf(mA, mxA), nB = fmaxf(mB, mxB);
            const float alA = __builtin_amdgcn_exp2f(mA - ((nA == -INFINITY) ? 0.f : nA)), alB = __builtin_amdgcn_exp2f(mB - ((nB == -INFINITY) ? 0.f : nB));
            const float fA = (nA == mA) ? 1.0f : alA, fB = (nB == mB) ? 1.0f : alB;
            lA *= fA; lB *= fB; mA = nA; mB = nB;
#pragma unroll
            for (int r = 0; r < 16; ++r) { oA0[r] *= fA; oA1[r] *= fA; oB0[r] *= fB; oB1[r] *= fB; }
        }
        const float muA = (mA == -INFINITY) ? 0.f : mA, muB = (mB == -INFINITY) ? 0.f : mB;
        float psA = 0.f, psB = 0.f;
#pragma unroll
        for (int r = 0; r < 16; ++r) { const float pA = __builtin_amdgcn_exp2f(stA[r] - muA), pB = __builtin_amdgcn_exp2f(stB[r] - muB); stA[r] = pA; stB[r] = pB; psA += pA; psB += pB; }
        lA += psA; lB += psB;
        bf16x8 paA[2], paB[2];
#pragma unroll
        for (int s_ = 0; s_ < 2; ++s_) {
            u32x4 w; w.x = cvt_pk_bf16(stA[8 * s_ + 0], stA[8 * s_ + 1]); w.y = cvt_pk_bf16(stA[8 * s_ + 2], stA[8 * s_ + 3]); w.z = cvt_pk_bf16(stA[8 * s_ + 4], stA[8 * s_ + 5]); w.w = cvt_pk_bf16(stA[8 * s_ + 6], stA[8 * s_ + 7]);
            paA[s_] = __builtin_bit_cast(bf16x8, w);
            w.x = cvt_pk_bf16(stB[8 * s_ + 0], stB[8 * s_ + 1]); w.y = cvt_pk_bf16(stB[8 * s_ + 2], stB[8 * s_ + 3]); w.z = cvt_pk_bf16(stB[8 * s_ + 4], stB[8 * s_ + 5]); w.w = cvt_pk_bf16(stB[8 * s_ + 6], stB[8 * s_ + 7]);
            paB[s_] = __builtin_bit_cast(bf16x8, w); }
#pragma unroll
        for (int s_ = 0; s_ < 2; ++s_) {
            { const int q = s_; const bf16x8 vf = (bf16x8){tlA[q][0], tlA[q][1], tlA[q][2], tlA[q][3], thA[q][0], thA[q][1], thA[q][2], thA[q][3]}; oA0 = __builtin_amdgcn_mfma_f32_32x32x16_bf16(vf, paA[s_], oA0, 0, 0, 0); }
            { const int q = 2 + s_; const bf16x8 vf = (bf16x8){tlA[q][0], tlA[q][1], tlA[q][2], tlA[q][3], thA[q][0], thA[q][1], thA[q][2], thA[q][3]}; oA1 = __builtin_amdgcn_mfma_f32_32x32x16_bf16(vf, paA[s_], oA1, 0, 0, 0); }
        }
        AT_CB();
        s16x4 tlB[4], thB[4];
#pragma unroll
        for (int q = 0; q < 4; ++q) { tlB[q] = __builtin_bit_cast(s16x4, __builtin_amdgcn_ds_read_tr16_b64_v4i16((LAS s16x4*)(vst + vb + (q >> 1) * 2048 + (q & 1) * 1024)));
                                      thB[q] = __builtin_bit_cast(s16x4, __builtin_amdgcn_ds_read_tr16_b64_v4i16((LAS s16x4*)(vst + vb + (q >> 1) * 2048 + (q & 1) * 1024 + 512))); }
        AT_CB();
#pragma unroll
        for (int s_ = 0; s_ < 2; ++s_) {
            { const int q = s_; const bf16x8 vf = (bf16x8){tlB[q][0], tlB[q][1], tlB[q][2], tlB[q][3], thB[q][0], thB[q][1], thB[q][2], thB[q][3]}; oB0 = __builtin_amdgcn_mfma_f32_32x32x16_bf16(vf, paB[s_], oB0, 0, 0, 0); }
            { const int q = 2 + s_; const bf16x8 vf = (bf16x8){tlB[q][0], tlB[q][1], tlB[q][2], tlB[q][3], thB[q][0], thB[q][1], thB[q][2], thB[q][3]}; oB1 = __builtin_amdgcn_mfma_f32_32x32x16_bf16(vf, paB[s_], oB1, 0, 0, 0); }
        }
        AT_CB();
    }
    { auto ra = __builtin_amdgcn_permlane32_swap(__float_as_uint(lA), __float_as_uint(lA), false, false); lA = __uint_as_float(ra[0]) + __uint_as_float(ra[1]);
      auto rb = __builtin_amdgcn_permlane32_swap(__float_as_uint(lB), __float_as_uint(lB), false, false); lB = __uint_as_float(rb[0]) + __uint_as_float(rb[1]); }
    RA.o0 = oA0; RA.o1 = oA1; RA.m = mA; RA.l = lA; RB.o0 = oB0; RB.o1 = oB1; RB.m = mB; RB.l = lB;
}
#undef AT_KLOAD
#undef AT_CB
__device__ __forceinline__ void attn_merge(const AttnRes& R, int nq, int qlbase, int qlstep, bool first, LAS unsigned char* lds, int lane) {
    asm volatile("" : "+v"(lane));
    const int r32 = lane & 31, hi = lane >> 5;
    if (r32 < nq) {
        const int ql = qlbase + qlstep * r32;
        LAS float* oa = (LAS float*)(lds + AT_OACC) + ql * AT_OSTR;
        LAS float* ml = (LAS float*)(lds + AT_ML) + ql * 2;
        float a_old = 0.f, a_new = 1.f, m_new = R.m, l_new = R.l;
        if (!first) { const float m_old = ml[0], l_old = ml[1]; m_new = fmaxf(m_old, R.m); const float mu = (m_new == -INFINITY) ? 0.f : m_new;
            a_old = __builtin_amdgcn_exp2f(m_old - mu); a_new = __builtin_amdgcn_exp2f(R.m - mu); l_new = l_old * a_old + R.l * a_new; }
#pragma unroll
        for (int r = 0; r < 16; ++r) { const int d = crow(r, hi); float v0 = R.o0[r] * a_new, v1 = R.o1[r] * a_new; if (!first) { v0 += oa[d] * a_old; v1 += oa[32 + d] * a_old; } oa[d] = v0; oa[32 + d] = v1; }
        asm volatile("s_waitcnt lgkmcnt(0)" ::: "memory");
        if (hi == 0) { ml[0] = m_new; ml[1] = l_new; }
    }
}

__device__ __forceinline__ void p8_attention(const Args& a, LAS unsigned char* lds, int tid, int lane, int wave, int mode) {
    unsigned char* ws = a.ws;
    const bf16_t* Q = (const bf16_t*)(ws + WS_Q); const bf16_t* K = (const bf16_t*)(ws + WS_K); const bf16_t* V = (const bf16_t*)(ws + WS_V); bf16_t* O = (bf16_t*)(ws + WS_AB);
    if (mode & 1) {
        const float* QS = (const float*)(ws + WS_QS);
        LAS float* psc = (LAS float*)(lds + AT_PSC + wave * 2048);
        for (int task = blockIdx.x * NWAVES + wave; task < NSB * NH * NST; task += gridDim.x * NWAVES) {
            const int sb = task / (NH * NST), h = (task / NST) % NH, j = task % NST;
            const float slope2 = exp2f(-0.5f * (float)(h + 1)) * LOG2E;
            const float* kc = a.in[4] + (size_t)sb * LBUF * D + h * HD; const float* vc = a.in[5] + (size_t)sb * LBUF * D + h * HD;
            const float* kn = a.out + O_SK + ((size_t)sb * LBUF + (LBUF - NST)) * D + h * HD; const float* vn = a.out + O_SV + ((size_t)sb * LBUF + (LBUF - NST)) * D + h * HD;
            const float* qrow = QS + (size_t)(sb * NST + j) * D + h * HD;
            f32x4 qv[16];
#pragma unroll
            for (int e = 0; e < 16; ++e) qv[e] = *(const f32x4*)(qrow + 4 * e);
            float mx = -INFINITY;
#pragma clang loop unroll(disable)
            for (int rd = 0; rd < 7; ++rd) {
                const int kk = rd * 64 + lane; float s = -INFINITY;
                if (kk < 387) { const int g = kk / 129, mm = kk % 129, dil = (g == 0) ? 1 : (g == 1 ? 4 : 16); const int idx = LBUF + j - mm * dil;
                    const float* kr = (idx >= LBUF) ? kn + (size_t)(idx - LBUF) * D : kc + (size_t)idx * D;
                    float acc = 0.f;
#pragma unroll
                    for (int e = 0; e < 16; ++e) { const f32x4 kx = *(const f32x4*)(kr + 4 * e); acc += (qv[e].x * kx.x + qv[e].y * kx.y) + (qv[e].z * kx.z + qv[e].w * kx.w); }
                    s = acc - slope2 * (float)(mm * dil); }
                psc[kk] = s; mx = fmaxf(mx, s);
            }
            mx = wave_max(mx);
            asm volatile("s_waitcnt lgkmcnt(0)" ::: "memory");
            float l = 0.f;
#pragma clang loop unroll(disable)
            for (int rd = 0; rd < 7; ++rd) { const float p = __builtin_amdgcn_exp2f(psc[rd * 64 + lane] - mx); l += p; psc[rd * 64 + lane] = p; }
            l = wave_sum(l);
            asm volatile("s_waitcnt lgkmcnt(0)" ::: "memory");
            const int kg = lane >> 4, dc = lane & 15;
            f32x4 acc4 = (f32x4){0.f, 0.f, 0.f, 0.f};
#pragma clang loop unroll(disable)
            for (int k0 = 0; k0 < 387; k0 += 64) {
                f32x4 vr4[16]; float pk[16];
#pragma unroll
                for (int u = 0; u < 16; ++u) { const int kk = k0 + 4 * u + kg; const int kc_ = kk < 387 ? kk : 386;
                    const int g = kc_ / 129, mm = kc_ % 129, dil = (g == 0) ? 1 : (g == 1 ? 4 : 16); const int idx = LBUF + j - mm * dil;
                    const float* vr = (idx >= LBUF) ? vn + (size_t)(idx - LBUF) * D : vc + (size_t)idx * D;
                    vr4[u] = *(const f32x4*)(vr + 4 * dc); pk[u] = kk < 387 ? psc[kc_] : 0.f; }
#pragma unroll
                for (int u = 0; u < 16; ++u) acc4 += vr4[u] * pk[u];
            }
#pragma unroll
            for (int e = 0; e < 4; ++e) { acc4[e] += __shfl_xor(acc4[e], 16); acc4[e] += __shfl_xor(acc4[e], 32); }
            const float il = __builtin_amdgcn_rcpf(l);
            if (lane < 16) { u32x2 w; w.x = cvt_pk_bf16(acc4[0] * il, acc4[1] * il); w.y = cvt_pk_bf16(acc4[2] * il, acc4[3] * il);
                *(u32x2*)(O + (size_t)(MPR + sb * NST + j) * D + h * HD + 4 * dc) = w; }
            asm volatile("s_waitcnt lgkmcnt(0)" ::: "memory");
        }
    }
    __syncthreads();
    if (mode & 2) {
    const int nun = NB * NH * 8, per_round = gridDim.x;
    for (int u0 = blockIdx.x; u0 < nun; u0 += per_round) {
        int u = u0;
        if ((gridDim.x & 7) == 0 && nun % (int)gridDim.x == 0) { const int x = blockIdx.x & 7, slot = blockIdx.x >> 3, spx = gridDim.x >> 3, rnd = u0 / per_round, j = rnd * spx + slot; u = x * (nun >> 3) + j;
            const int sq = u & 7, r4 = rnd & 3, qb = (r4 == 0) ? sq : (r4 == 1) ? 7 - sq : (r4 == 2) ? ((sq + 4) & 7) : ((3 - sq) & 7); u = (u & ~7) | qb; }
        const int qblk = u & 7, h = (u >> 3) & 15, b = u >> 7;
        const float slope2 = exp2f(-0.5f * (float)(h + 1)) * LOG2E;
        const bf16_t* Qh = Q + (size_t)b * SEQ * D + h * HD; const bf16_t* Kh = K + (size_t)b * SEQ * D + h * HD; const bf16_t* Vh = V + (size_t)b * SEQ * D + h * HD;
        {
            AttnRes RA, RB;
            attn_task2(Qh, Kh, Vh, slope2, 1, 0, 256 * qblk + 32 * wave, 32, 4, wave & 3, 64 * qblk + 32 * (wave >> 2), 32, lds, wave, lane, RA, RB);
            attn_merge(RA, 32, 32 * wave, 1, true, lds, lane);
            __syncthreads();
            attn_merge(RB, 32, (wave & 3) + 128 * (wave >> 2), 4, false, lds, lane);
            __syncthreads();
            attn_task2(Qh, Kh, Vh, slope2, 16, 2 * wave, 16 * qblk, 16, 16, 2 * wave + 1, 16 * qblk, 16, lds, wave, lane, RA, RB);
            attn_merge(RA, 16, 2 * wave, 16, false, lds, lane);
            attn_merge(RB, 16, 2 * wave + 1, 16, false, lds, lane);
            __syncthreads();
        }
        {
            const int ql = tid >> 1, dh = (tid & 1) * 32;
            const LAS float* oa = (const LAS float*)(lds + AT_OACC) + ql * AT_OSTR + dh;
            const float inv = __builtin_amdgcn_rcpf(((const LAS float*)(lds + AT_ML))[ql * 2 + 1]);
            bf16_t* op = O + (size_t)(b * SEQ + 256 * qblk + ql) * D + h * HD + dh;
#pragma unroll
            for (int e = 0; e < 4; ++e) { u32x4 w; w.x = cvt_pk_bf16(oa[8 * e + 0] * inv, oa[8 * e + 1] * inv); w.y = cvt_pk_bf16(oa[8 * e + 2] * inv, oa[8 * e + 3] * inv);
                w.z = cvt_pk_bf16(oa[8 * e + 4] * inv, oa[8 * e + 5] * inv); w.w = cvt_pk_bf16(oa[8 * e + 6] * inv, oa[8 * e + 7] * inv); *(u32x4*)(op + 8 * e) = w; }
        }
        __syncthreads();
    }
    }
}

__device__ __forceinline__ void p13_final(const Args& a, int gw, int NGW, int lane) {
    const bf16_t* HBp = (const bf16_t*)(a.ws + WS_HB); const float* g = a.in[9];
    f32x4 gv[4];
#pragma unroll
    for (int j = 0; j < 4; ++j) gv[j] = ((const f32x4*)g)[64 * j + lane];
    for (int r0 = gw; r0 < MTOT; r0 += 2 * NGW) {
        f32x4 v[2][4];
#pragma unroll
        for (int h = 0; h < 2; ++h) { const int r = r0 + h * NGW; const int rc = r < MTOT ? r : r0; const u32x2* xr = (const u32x2*)(HBp + (size_t)rc * D) + lane;
#pragma unroll
            for (int j = 0; j < 4; ++j) { const u32x2 b = xr[64 * j]; v[h][j] = (f32x4){bflo(b.x), bfhi(b.x), bflo(b.y), bfhi(b.y)}; } }
#pragma unroll
        for (int h = 0; h < 2; ++h) { const int r = r0 + h * NGW; if (r >= MTOT) continue; float s = 0.f;
#pragma unroll
            for (int j = 0; j < 4; ++j) s += (v[h][j].x * v[h][j].x + v[h][j].y * v[h][j].y) + (v[h][j].z * v[h][j].z + v[h][j].w * v[h][j].w);
            const float rstd = rsqrtf(wave_sum(s) * (1.0f / D) + RMS_EPS);
            f32x4* o = (f32x4*)(a.out + (size_t)r * D) + lane;
#pragma unroll
            for (int j = 0; j < 4; ++j) __builtin_nontemporal_store(v[h][j] * rstd * gv[j], o + 64 * j); }
    }
}

template <int MODE, int K>
__device__ __forceinline__ void sample_gemm(LAS unsigned char* lds, const bf16_t* A, const bf16_t* Bt, int N, const float* base, float* Hs, bf16_t* HBs, float* ssq,
                                            bf16_t* QKV, float* QS, float* out, int tid, int lane, int wave) {
    constexpr int KPW = K / 32 / 8;
    const int nitems = (N / 16) * 4;
    LAS f32x4* red = (LAS f32x4*)lds;
    for (int it = blockIdx.x; it < nitems; it += gridDim.x) {
        const int cbk = it >> 2, rq = it & 3;
        const bf16_t* bp = Bt + (size_t)(16 * cbk + (lane & 15)) * K + wave * KPW * 32 + 8 * (lane >> 4);
        const bf16_t* ap = A + (size_t)(32 * rq + (lane & 15)) * K + wave * KPW * 32 + 8 * (lane >> 4);
        bf16x8 bw[KPW], a0[KPW], a1[KPW];
#pragma unroll
        for (int ks = 0; ks < KPW; ++ks) { bw[ks] = *(const bf16x8*)(bp + ks * 32); a0[ks] = *(const bf16x8*)(ap + ks * 32); a1[ks] = *(const bf16x8*)(ap + (size_t)16 * K + ks * 32); }
        f32x4 acc0 = (f32x4){0.f, 0.f, 0.f, 0.f}, acc1 = acc0;
#pragma unroll
        for (int ks = 0; ks < KPW; ++ks) { acc0 = __builtin_amdgcn_mfma_f32_16x16x32_bf16(bw[ks], a0[ks], acc0, 0, 0, 0); acc1 = __builtin_amdgcn_mfma_f32_16x16x32_bf16(bw[ks], a1[ks], acc1, 0, 0, 0); }
        red[(wave * 2 + 0) * 64 + lane] = acc0; red[(wave * 2 + 1) * 64 + lane] = acc1;
        __syncthreads();
        if (tid < 128) {
            const int rb = tid >> 6, ln = tid & 63;
            f32x4 v = red[rb * 64 + ln];
#pragma unroll
            for (int w = 1; w < 8; ++w) v += red[(w * 2 + rb) * 64 + ln];
            const int rs = 32 * rq + 16 * rb + (ln & 15), fq = ln >> 4;
            const int c = 16 * cbk + 4 * fq;
            if (MODE == 0) {
                const u32x2 b2 = *(const u32x2*)(HBs + (size_t)rs * D + c);
                const f32x4 h = (f32x4){bflo(b2.x), bfhi(b2.x), bflo(b2.y), bfhi(b2.y)} + v;
                u32x2 w2; w2.x = cvt_pk_bf16(h[0], h[1]); w2.y = cvt_pk_bf16(h[2], h[3]); *(u32x2*)(HBs + (size_t)rs * D + c) = w2;
                float q = (h[0] * h[0] + h[1] * h[1]) + (h[2] * h[2] + h[3] * h[3]);
                q += __shfl_xor(q, 16); q += __shfl_xor(q, 32);
                if (fq == 0) ssq[(size_t)(MPR + rs) * 64 + cbk] = q;
            } else {
                const int which = cbk >> 6, c1 = c - which * D;
                const float rstd = pg8::row_rstd(ssq, MPR + rs, fq) * (which == 0 ? QSCALE : 1.0f);
                const f32x4 o = v * rstd;
                u32x2 w2; w2.x = cvt_pk_bf16(o[0], o[1]); w2.y = cvt_pk_bf16(o[2], o[3]);
                *(u32x2*)(QKV + (size_t)which * ((WS_K - WS_Q) / 2) + (size_t)(MPR + rs) * D + c1) = w2;
                float* fp = (which == 0) ? QS + (size_t)rs * D + c1 : out + (which == 1 ? O_SK : O_SV) + ((size_t)(rs >> 2) * LBUF + (LBUF - NST) + (rs & 3)) * D + c1;
                *(f32x4*)fp = o;
            }
        }
        __syncthreads();
    }
}

#define XB_TMO      128
#define XB_XCNT(j)  (256  + 64 * (j))
#define XB_XSUB(j)  (1280 + 64 * (j))
#define XB_XGEN(j)  (2304 + 64 * (j))
#define XB_TOP      3328
#define XB_TOPGEN   3392
#define XCD_BAR_WORDS 3456
#define XB_SPIN_CAP (1u << 18)
__device__ __forceinline__ unsigned xb_ld(unsigned* p)              { return __hip_atomic_load(p, __ATOMIC_RELAXED, __HIP_MEMORY_SCOPE_AGENT); }
__device__ __forceinline__ unsigned xb_add(unsigned* p, unsigned v) { return __hip_atomic_fetch_add(p, v, __ATOMIC_RELAXED, __HIP_MEMORY_SCOPE_AGENT); }
__device__ __forceinline__ unsigned xb_xcc_id() { return (unsigned)__builtin_amdgcn_s_getreg((3 << 11) | 20) & 0xFu; }
#define XB_SPIN(cond, bar) do { unsigned _sp = 0; while (cond) { __builtin_amdgcn_s_sleep(1); \
    if ((++_sp & 255u) == 0u) { if (xb_ld(&(bar)[XB_TMO])) break; if (_sp > XB_SPIN_CAP) { atomicAdd(&(bar)[XB_TMO], 1u); break; } } } } while (0)
__device__ __forceinline__ void xcd_barrier_complete(unsigned* bar, unsigned x, unsigned& nloc, unsigned& nx) {
    const unsigned G = gridDim.x * gridDim.y * gridDim.z;
    unsigned sum, cnt, mine, sp = 0u;
    for (;;) {
        sum = 0u; cnt = 0u; mine = 0u;
#pragma unroll
        for (unsigned j = 0; j < 16; ++j) { const unsigned c = xb_ld(&bar[XB_XCNT(j)]); sum += c; cnt += (c > 0u) ? 1u : 0u; mine = (j == x) ? c : mine; }
        if (sum == G) break;
        __builtin_amdgcn_s_sleep(1);
        if ((++sp & 255u) == 0u) { if (xb_ld(&bar[XB_TMO])) break; if (sp > XB_SPIN_CAP) { atomicAdd(&bar[XB_TMO], 1u); break; } }
    }
    nloc = mine > 0u ? mine : 1u; nx = cnt > 0u ? cnt : 1u;
}
__device__ __forceinline__ void xcd_barrier(unsigned* bar, volatile LAS unsigned* st) {
    asm volatile("s_waitcnt vmcnt(0)" ::: "memory");
    __syncthreads();
    if (threadIdx.x == 0) {
        const unsigned x = xb_xcc_id();
        __builtin_amdgcn_s_waitcnt(0);
        unsigned nloc = st[0], nx = st[1];
        if (nloc == 0u) { xcd_barrier_complete(bar, x, nloc, nx); st[0] = nloc; st[1] = nx; }
        const unsigned old = xb_add(&bar[XB_XSUB(x)], 1u);
        const unsigned gen = old / nloc;
        if (old + 1u == (gen + 1u) * nloc) {
            __builtin_amdgcn_fence(__ATOMIC_RELEASE, "agent");
            asm volatile("s_waitcnt vmcnt(0)" ::: "memory");
            const unsigned og = xb_add(&bar[XB_TOP], 1u);
            const unsigned tg = og / nx;
            if (og + 1u == (tg + 1u) * nx) xb_add(&bar[XB_TOPGEN], 1u);
            else XB_SPIN(xb_ld(&bar[XB_TOPGEN]) == tg, bar);
            __builtin_amdgcn_fence(__ATOMIC_ACQUIRE, "agent");
            xb_add(&bar[XB_XGEN(x)], 1u);
            asm volatile("s_waitcnt vmcnt(0)" ::: "memory");
        } else {
            XB_SPIN(xb_ld(&bar[XB_XGEN(x)]) == gen, bar);
            __builtin_amdgcn_fence(__ATOMIC_ACQUIRE, "agent");
            asm volatile("s_waitcnt vmcnt(0)" ::: "memory");
        }
    }
    __syncthreads();
}

typedef const __attribute__((address_space(4))) Args* kargp_t;
__device__ __forceinline__ Args kargs() {
    Args a;
#if defined(__HIP_DEVICE_COMPILE__)
    kargp_t p = (kargp_t)__builtin_amdgcn_kernarg_segment_ptr(); asm volatile("" : "+s"(p));
#pragma unroll
    for (int i = 0; i < 22; ++i) a.in[i] = p->in[i];
    a.out = p->out; a.ws = p->ws;
#else
    for (int i = 0; i < 22; ++i) a.in[i] = nullptr;
    a.out = nullptr; a.ws = nullptr;
#endif
    return a;
}
#define PHASE_BEGIN const Args a = kargs(); unsigned char* ws = a.ws; const int tid = launder_v(threadIdx.x), lane = tid & 63, wave = __builtin_amdgcn_readfirstlane(tid >> 6); \
    const int G = gridDim.x, gw = blockIdx.x * NWAVES + wave, NGW = G * NWAVES; (void)ws; (void)lane; (void)gw; (void)NGW; (void)G;
__global__ void __launch_bounds__(NTHREADS, 2) mega_fwd(Args a_unused) {
    extern __shared__ __attribute__((aligned(16))) unsigned char lds_raw[];
    LAS unsigned char* lds = (LAS unsigned char*)lds_raw;
    cg::grid_group grid = cg::this_grid();
    volatile LAS unsigned* bst = (volatile LAS unsigned*)(lds + MISC_OFF + 64);
    { unsigned* ctl0 = (unsigned*)kargs().ws; if (threadIdx.x == 0) { bst[0] = 0u; bst[1] = 0u; (void)xb_add(&ctl0[XB_XCNT(xb_xcc_id())], 1u); } }
    __syncthreads();
    grid.sync();
#define GRID_BAR() do { unsigned* ctl_ = (unsigned*)kargs().ws; xcd_barrier(ctl_, bst); } while (0)
#ifndef PHASES
#define PHASES 0xFFFF
#endif
#define PH(k) if constexpr (((PHASES) >> (k)) & 1)
#define REP_ALL 1
#define REP_P0 1
#define REP_P1 1
#define REP_P2 1
#define REP_P3 1
#define REP_P4 1
#define REP_P5 1
#define REP_P6 1
#define PROBE_SKIP_EPI 0
#define REP_P7 1
#define REP_P8 1
#define REP_P8S 1
#define REP_P13 1
#define REPEAT(n) for (int rep_ = 0; rep_ < (n); ++rep_)

    for (int rep_all = 0; rep_all < REP_ALL; ++rep_all) {
    if (rep_all) { GRID_BAR(); }
    REPEAT(REP_P0) { PH(0) { PHASE_BEGIN p0_prologue(a, lds, gw, NGW, lane, wave); } if (rep_ + 1 < REP_P0) { GRID_BAR(); } }
    GRID_BAR();
    REPEAT(REP_P1) { if (rep_) { GRID_BAR(); } PH(1) {
        PHASE_BEGIN
        const int ge = (G == 256) ? GE_P1 : G;
        if ((int)blockIdx.x < ge) {
        pg8::Gemm g{(const bf16_t*)(ws + WS_HB), (const bf16_t*)(ws + WS_WIN), MPAD, NIN, D}; pg8::StaticOrder S; S.init(MPAD, NIN, ge, (int)blockIdx.x);
        pg8::EpiInAB E{(bf16_t*)(ws + WS_GA), (const float*)(ws + WS_SSQ), a.out};
        pg8::gemm_phase<pg8::EpiInAB, pg8::StaticOrder, true, true>(lds, g, S, E);
        } else copy_range(a, CP_C0, CP_C1, (int)blockIdx.x - ge, G - ge, tid);
        if (ge == G && rep_ == 0) copy_range(a, CP_C0, CP_C1, blockIdx.x, G, tid);
    } }
    GRID_BAR();
    REPEAT(REP_P2) { if (rep_) { GRID_BAR(); } PH(2) { PHASE_BEGIN p2_conv(a, lds, tid, lane, wave); } }
    GRID_BAR();
    REPEAT(REP_P3) { if (rep_) { GRID_BAR(); } PH(3) {
        PHASE_BEGIN
        pg8::Gemm g{(const bf16_t*)(ws + WS_AB), (const bf16_t*)(ws + WS_WOUT), MPR, D, D}; pg8::StaticOrder S; S.init(MPR, D, G, (int)blockIdx.x);
        pg8::EpiResid E{(bf16_t*)(ws + WS_HB), (float*)(ws + WS_SSQ), 0};
        pg8::gemm_phase<pg8::EpiResid, pg8::StaticOrder, true, true>(lds, g, S, E);
        sample_gemm<0, D>(lds, (const bf16_t*)(ws + WS_AB) + (size_t)MPR * D, (const bf16_t*)(ws + WS_WOUT), D, nullptr, nullptr, (bf16_t*)(ws + WS_HB) + (size_t)MPR * D,
                          (float*)(ws + WS_SSQ), nullptr, nullptr, nullptr, tid, lane, wave);
    } }
    GRID_BAR();
#pragma clang loop unroll(disable)
    for (int layer = 0; layer < 2; ++layer) {
        if (layer == 1) {
            REPEAT(REP_P7) { if (rep_) { GRID_BAR(); } PH(7) {
                PHASE_BEGIN
                pg8::Gemm g{(const bf16_t*)(ws + WS_HB), (const bf16_t*)(ws + WS_WQKV), MPR, 3 * D, D}; pg8::StaticOrder S; S.init(MPR, 3 * D, G, (int)blockIdx.x);
                pg8::EpiQkv E{(bf16_t*)(ws + WS_Q), (float*)(ws + WS_QS), (const float*)(ws + WS_SSQ), a.out};
                pg8::gemm_phase<pg8::EpiQkv, pg8::StaticOrder, true, true>(lds, g, S, E);
                sample_gemm<1, D>(lds, (const bf16_t*)(ws + WS_HB) + (size_t)MPR * D, (const bf16_t*)(ws + WS_WQKV), 3 * D, nullptr, nullptr, nullptr,
                                  (float*)(ws + WS_SSQ), (bf16_t*)(ws + WS_Q), (float*)(ws + WS_QS), a.out, tid, lane, wave);
            } }
            GRID_BAR();
            REPEAT(REP_P8S) { PH(8) { PHASE_BEGIN p8_attention(a, lds, tid, lane, wave, 1); } }
            REPEAT(REP_P8) { if (rep_) { GRID_BAR(); } PH(8) { PHASE_BEGIN p8_attention(a, lds, tid, lane, wave, 2); } }
            GRID_BAR();
            PH(9) {
                PHASE_BEGIN
                pg8::Gemm g{(const bf16_t*)(ws + WS_AB), (const bf16_t*)(ws + WS_WO), MPR, D, D}; pg8::StaticOrder S; S.init(MPR, D, G, (int)blockIdx.x);
                pg8::EpiResid E{(bf16_t*)(ws + WS_HB), (float*)(ws + WS_SSQ), 0};
                pg8::gemm_phase<pg8::EpiResid, pg8::StaticOrder, true, true>(lds, g, S, E);
                sample_gemm<0, D>(lds, (const bf16_t*)(ws + WS_AB) + (size_t)MPR * D, (const bf16_t*)(ws + WS_WO), D, nullptr, nullptr, (bf16_t*)(ws + WS_HB) + (size_t)MPR * D,
                                  (float*)(ws + WS_SSQ), nullptr, nullptr, nullptr, tid, lane, wave);
            }
            GRID_BAR();
        }
        REPEAT(REP_P4) { if (rep_) { GRID_BAR(); } PH(4) {
            PHASE_BEGIN
            const int ge = (G == 256) ? GE_FF : G;
            const size_t clo = layer ? CP_C2 : CP_C1, chi = layer ? CP_TOT : CP_C2;
            if ((int)blockIdx.x >= ge) { if (rep_ == 0) copy_range(a, clo, chi, (int)blockIdx.x - ge, G - ge, tid); } else {
            pg8::Gemm g{(const bf16_t*)(ws + WS_HB), (const bf16_t*)(ws + (layer ? WS_WF1 : WS_WF0)), MPAD, 2 * DFF, D}; pg8::StaticOrder S; S.init(MPAD, 2 * DFF, ge, (int)blockIdx.x);
            pg8::EpiFfn E{(bf16_t*)(ws + WS_ZG), (bf16_t*)(ws + WS_ZU), (bf16_t*)(ws + WS_U), (float*)(ws + WS_SG), (float*)(ws + WS_SU), a.in[20] + (size_t)layer * 3 * DFF, (const float*)(ws + WS_SSQ), a.out, layer};
            pg8::gemm_phase<pg8::EpiFfn, pg8::StaticOrder, true, true>(lds, g, S, E);
            }
            if (ge == G && rep_ == 0) copy_range(a, clo, chi, blockIdx.x, G, tid);
        } }
        GRID_BAR();
        REPEAT(REP_P5) { if (rep_) { GRID_BAR(); } PH(5) { PHASE_BEGIN p5_fix(a, layer, blockIdx.x * NTHREADS + tid, G * NTHREADS); } }
        GRID_BAR();
        REPEAT(REP_P6) { if (rep_) { GRID_BAR(); } PH(6) {
            PHASE_BEGIN
            pg8::Gemm g{(const bf16_t*)(ws + WS_U), (const bf16_t*)(ws + (layer ? WS_WD1 : WS_WD0)), MPR, D, DFF}; pg8::StaticOrder S; S.init(MPR, D, G, (int)blockIdx.x);
            const bool real_ = (rep_ + 1 == REP_P6);
            pg8::EpiResid E{(bf16_t*)(ws + WS_HB), real_ ? (float*)(ws + WS_SSQ) : (float*)(ws + WS_ZU), real_ ? 0 : 1};
            pg8::gemm_phase<pg8::EpiResid, pg8::StaticOrder, true, true>(lds, g, S, E);
            if (real_) sample_gemm<0, DFF>(lds, (const bf16_t*)(ws + WS_U) + (size_t)MPR * DFF, (const bf16_t*)(ws + (layer ? WS_WD1 : WS_WD0)), D, nullptr, nullptr, (bf16_t*)(ws + WS_HB) + (size_t)MPR * D,
                                (float*)(ws + WS_SSQ), nullptr, nullptr, nullptr, tid, lane, wave);
        } }
        GRID_BAR();
    }
    REPEAT(REP_P13) { if (rep_) { GRID_BAR(); } PH(13) { PHASE_BEGIN p13_final(a, gw, NGW, lane); } }
    }
}

extern "C" void kernel_launch(void* const* d_in, const int* in_sizes, int n_in, void* d_out, int out_size, void* d_ws, size_t ws_size, hipStream_t stream) {
    static int grid = 0;
    if (grid == 0) {
        if (n_in != 22 || (size_t)out_size != O_END || ws_size < WS_END) { fprintf(stderr, "kernel_launch: unexpected shapes (n_in %d, out %d, ws %zu, need %zu)\n", n_in, out_size, ws_size, (size_t)WS_END); grid = -1; return; }
        int dev = 0, cus = 0, per_cu = 0;
        if (hipGetDevice(&dev) != hipSuccess || hipDeviceGetAttribute(&cus, hipDeviceAttributeMultiprocessorCount, dev) != hipSuccess) { grid = -1; return; }
        if (hipFuncSetAttribute((const void*)mega_fwd, hipFuncAttributeMaxDynamicSharedMemorySize, LDS_BYTES) != hipSuccess) { fprintf(stderr, "kernel_launch: hipFuncSetAttribute failed\n"); grid = -1; return; }
        if (hipOccupancyMaxActiveBlocksPerMultiprocessor(&per_cu, (const void*)mega_fwd, NTHREADS, LDS_BYTES) != hipSuccess || per_cu < 1) { fprintf(stderr, "kernel_launch: occupancy query failed (%d)\n", per_cu); (void)hipGetLastError(); grid = -1; return; }
        grid = cus * 1;
    }
    if (grid < 0) return;
    if (hipMemsetAsync((char*)d_ws + WS_CTL, 0, CTL_BYTES, stream) != hipSuccess) { fprintf(stderr, "kernel_launch: memset failed\n"); return; }
    Args a{};
    for (int i = 0; i < 22; ++i) a.in[i] = (const float*)d_in[i];
    a.out = (float*)d_out; a.ws = (unsigned char*)d_ws;
    void* args[] = {&a};
    hipError_t e = hipLaunchCooperativeKernel((const void*)mega_fwd, dim3(grid), dim3(NTHREADS), args, LDS_BYTES, stream);
    if (e != hipSuccess) fprintf(stderr, "cooperative launch failed: %s (grid %d)\n", hipGetErrorString(e), grid);
}
```

```cpp
#include <hip/hip_runtime.h>
#include <hip/hip_cooperative_groups.h>
#include <cstdio>
#include <cstdint>
namespace cg = cooperative_groups;

#define LAS __attribute__((address_space(3)))
typedef unsigned short bf16_t;
typedef short bf16x8 __attribute__((ext_vector_type(8)));
typedef float f32x4 __attribute__((ext_vector_type(4)));
typedef float f32x2 __attribute__((ext_vector_type(2)));
typedef float f32x16 __attribute__((ext_vector_type(16)));
typedef unsigned u32x4 __attribute__((ext_vector_type(4)));
typedef unsigned u32x2 __attribute__((ext_vector_type(2)));
typedef short s16x4 __attribute__((ext_vector_type(4)));

constexpr int D = 1024, SEQ = 2048, NB = 8, MPR = NB * SEQ, NSB = 32, NST = 4, MSA = NSB * NST, MTOT = MPR + MSA, MPAD = 16640;
constexpr int DFF = 2816, NIN = 2560, CH = 512, NH = 16, HD = 64, LBUF = 2048, KA = 31;
constexpr int GAW = 1536;
constexpr float RMS_EPS = 1e-6f, LN_EPS = 1e-5f;
constexpr float LOG2E = 1.4426950408889634f;
constexpr float QSCALE = 0.125f * LOG2E;

constexpr size_t O_YP = 0;
constexpr size_t O_YS = O_YP + (size_t)MPR * D;
constexpr size_t O_PCA = O_YS + (size_t)MSA * D;
constexpr size_t O_SCA = O_PCA + (size_t)NB * 30 * CH;
constexpr size_t O_PCB = O_SCA + (size_t)NSB * 30 * CH;
constexpr size_t O_SCB = O_PCB + (size_t)NB * 2 * CH;
constexpr size_t O_PK = O_SCB + (size_t)NSB * 2 * CH;
constexpr size_t O_SK = O_PK + (size_t)MPR * D;
constexpr size_t O_PV = O_SK + (size_t)NSB * LBUF * D;
constexpr size_t O_SV = O_PV + (size_t)MPR * D;
constexpr size_t O_PF = O_SV + (size_t)NSB * LBUF * D;
constexpr size_t O_SF = O_PF + (size_t)2 * NB * 2 * DFF;
constexpr size_t O_END = O_SF + (size_t)2 * NSB * 2 * DFF;

constexpr size_t al(size_t x) { return (x + 4095) & ~(size_t)4095; }
constexpr size_t WS_CTL = 0, CTL_BYTES = 65536;
constexpr size_t WS_WIN = WS_CTL + CTL_BYTES;
constexpr size_t WS_WOUT = WS_WIN + al((size_t)NIN * D * 2);
constexpr size_t WS_WQKV = WS_WOUT + al((size_t)D * D * 2);
constexpr size_t WS_WO = WS_WQKV + al((size_t)3 * D * D * 2);
constexpr size_t WS_WF0 = WS_WO + al((size_t)D * D * 2);
constexpr size_t WS_WF1 = WS_WF0 + al((size_t)2 * DFF * D * 2);
constexpr size_t WS_WD0 = WS_WF1 + al((size_t)2 * DFF * D * 2);
constexpr size_t WS_WD1 = WS_WD0 + al((size_t)D * DFF * 2);
constexpr size_t WS_HB = WS_WD1 + al((size_t)D * DFF * 2);
constexpr size_t WS_H = WS_HB + al((size_t)MPAD * D * 2);
constexpr size_t WS_SSQ = WS_H + 4096;
constexpr size_t WS_GA = WS_SSQ + al((size_t)MPAD * 64 * 4);
constexpr size_t WS_AB = WS_GA + al((size_t)MPAD * GAW * 2);
constexpr size_t WS_ZG = WS_AB + al((size_t)MPAD * D * 2);
constexpr size_t WS_ZU = WS_ZG + al((size_t)MPAD * DFF * 2);
constexpr size_t WS_U = WS_ZU + al((size_t)MPAD * DFF * 2);
constexpr size_t WS_Q = WS_U + al((size_t)MPAD * DFF * 2);
constexpr size_t WS_K = WS_Q + al((size_t)MPAD * D * 2);
constexpr size_t WS_V = WS_K + al((size_t)MPAD * D * 2);
constexpr size_t WS_QS = WS_V + al((size_t)MPAD * D * 2);
constexpr size_t WS_SG = WS_QS + al((size_t)MSA * D * 4);
constexpr size_t WS_SU = WS_SG + al((size_t)256 * 4 * DFF * 4);
constexpr size_t WS_END = WS_SU + al((size_t)256 * 2 * DFF * 4);
static_assert(WS_V - WS_K == WS_K - WS_Q, "Q|K|V equally spaced");

constexpr int NWAVES = 8, NTHREADS = 512;
constexpr int LDS_BYTES = 163840;
constexpr int MISC_OFF = LDS_BYTES - 1024;

typedef __bf16 bf16x2_t __attribute__((ext_vector_type(2)));
__device__ __forceinline__ unsigned cvt_pk_bf16(float lo, float hi) { return __builtin_bit_cast(unsigned, __builtin_convertvector((f32x2){lo, hi}, bf16x2_t)); }
__device__ __forceinline__ float bf2f(unsigned short b) { return __uint_as_float((unsigned)b << 16); }
__device__ __forceinline__ float bflo(unsigned w) { return __uint_as_float(w << 16); }
__device__ __forceinline__ float bfhi(unsigned w) { return __uint_as_float(w & 0xffff0000u); }
__device__ __forceinline__ float max_raw(float a, float b) { return __builtin_amdgcn_fmed3f(a, b, INFINITY); }
__device__ __forceinline__ float sigmoidf_(float x) { return __builtin_amdgcn_rcpf(1.0f + __expf(-x)); }
__device__ __forceinline__ int launder_v(int x) { asm volatile("" : "+v"(x)); return x; }
__device__ __forceinline__ int lane_id() { int l; asm volatile("v_mbcnt_lo_u32_b32 %0, -1, 0\n\tv_mbcnt_hi_u32_b32 %0, -1, %0" : "=v"(l)); return l; }
template <int CTRL> __device__ __forceinline__ float dppmov(float v) { return __uint_as_float(__builtin_amdgcn_update_dpp(0u, __float_as_uint(v), CTRL, 0xf, 0xf, true)); }
__device__ __forceinline__ float wave_sum(float v) {
    v += dppmov<0xB1>(v);
    v += dppmov<0x4E>(v);
    v += dppmov<0x141>(v);
    v += dppmov<0x140>(v);
    { auto r = __builtin_amdgcn_permlane16_swap(__float_as_uint(v), __float_as_uint(v), false, false); v = __uint_as_float(r[0]) + __uint_as_float(r[1]); }
    { auto r = __builtin_amdgcn_permlane32_swap(__float_as_uint(v), __float_as_uint(v), false, false); v = __uint_as_float(r[0]) + __uint_as_float(r[1]); }
    return v;
}
__device__ __forceinline__ float wave_max(float v) {
    v = fmaxf(v, dppmov<0xB1>(v)); v = fmaxf(v, dppmov<0x4E>(v)); v = fmaxf(v, dppmov<0x141>(v)); v = fmaxf(v, dppmov<0x140>(v));
    { auto r = __builtin_amdgcn_permlane16_swap(__float_as_uint(v), __float_as_uint(v), false, false); v = fmaxf(__uint_as_float(r[0]), __uint_as_float(r[1])); }
    { auto r = __builtin_amdgcn_permlane32_swap(__float_as_uint(v), __float_as_uint(v), false, false); v = fmaxf(__uint_as_float(r[0]), __uint_as_float(r[1])); }
    return v;
}

namespace pg8 {
constexpr int BM = 256, BK = 64, HALF = 128, HTB = HALF * BK * 2, STAGE_BYTES = 8 * HTB, NXCD = 8, WGM = 8;
__host__ __device__ __forceinline__ int lds_byte(int r, int c) { const int st = (r >> 4) * 2 + (c >> 5), rr = r & 15, cc = c & 31, ob = rr * 64 + cc * 2; return st * 1024 + (ob ^ (((ob >> 9) & 1) << 5)); }
__host__ __device__ __forceinline__ void stage_rc(int b, int& R, int& C) { const int st = b / 1024, sb = b % 1024, swz = sb ^ (((sb >> 9) & 1) << 5); R = (st >> 1) * 16 + swz / 64; C = (st & 1) * 32 + (swz % 64) / 2; }
__host__ __device__ __forceinline__ int perm32(int rho) { const int n = rho >> 4, i = rho & 15; return 8 * (i >> 2) + 4 * n + (i & 3); }

struct Unit { int pm, pn; };
struct Gemm { const bf16_t* A; const bf16_t* Bt; int M, N, K, wid; };

struct StaticOrder {
    int nM, nN, nwg, G, c;
    __host__ __device__ __forceinline__ void init(int M, int N, int G_, int c_) { nM = M / BM; nN = N / BM; nwg = nM * nN; G = G_; c = c_; }
    __host__ __device__ __forceinline__ bool next(int i, Unit& u) const {
        const long L = (long)i * G + c; if (L >= nwg) return false;
        int wgid = (int)L; { const int q = nwg / NXCD, r = nwg % NXCD, xcd = wgid % NXCD, off = wgid / NXCD; wgid = (xcd < r ? xcd * (q + 1) : r * (q + 1) + (xcd - r) * q) + off; }
        const int nig = WGM * nN, gid = wgid / nig, fm = gid * WGM, gsz = (nM - fm) < WGM ? (nM - fm) : WGM;
        u.pm = fm + ((wgid % nig) % gsz); u.pn = (wgid % nig) / gsz; return true;
    }
    __device__ __forceinline__ void a_ready(const Unit&) const {}
    __device__ __forceinline__ void done(const Unit&) const {}
};

__device__ __forceinline__ float fq_sum(float x) {
    auto a = __builtin_amdgcn_permlane16_swap(__float_as_uint(x), __float_as_uint(x), false, false); x = __uint_as_float(a[0]) + __uint_as_float(a[1]);
    auto b = __builtin_amdgcn_permlane32_swap(__float_as_uint(x), __float_as_uint(x), false, false); return __uint_as_float(b[0]) + __uint_as_float(b[1]);
}
__device__ __forceinline__ float row_rstd(const float* ssq, int r, int fq) {
    float s;
    if (r < MPR) { const f32x4 p = *(const f32x4*)(ssq + (size_t)r * 64 + 4 * fq); s = (p.x + p.y) + (p.z + p.w); }
    else { const f32x4* pp = (const f32x4*)(ssq + (size_t)r * 64 + 16 * fq); const f32x4 p = (pp[0] + pp[1]) + (pp[2] + pp[3]); s = (p.x + p.y) + (p.z + p.w); }
    return __builtin_amdgcn_rsqf(fq_sum(s) * (1.0f / D) + RMS_EPS);
}

struct EpiInAB {
    static constexpr bool PERM = true, AFTER_DRAIN = false;
    bf16_t* GA; const float* ssq; float* out;
    __device__ __forceinline__ void operator()(const f32x4 (&acc)[2][2][4][2], const Unit& u, int wr, int wc, int fr, int fq) const {
        const int pn = u.pn, colw = wc * 32 + 8 * fq;
        float rsv[2][4];
#pragma unroll
        for (int ai = 0; ai < 2; ++ai)
#pragma unroll
            for (int m = 0; m < 4; ++m) rsv[ai][m] = row_rstd(ssq, u.pm * BM + ai * HALF + wr * 64 + m * 16 + fr, fq);
        asm volatile("" ::: "memory");
#pragma unroll
        for (int ai = 0; ai < 2; ++ai)
#pragma unroll
            for (int m = 0; m < 4; ++m) {
                const int r = u.pm * BM + ai * HALF + wr * 64 + m * 16 + fr;
                const float rs = rsv[ai][m];
                const f32x4 a0 = acc[ai][0][m][0] * rs, a1 = acc[ai][0][m][1] * rs, g0 = acc[ai][1][m][0] * rs, g1 = acc[ai][1][m][1] * rs;
                bf16_t* rowp = GA + (size_t)r * GAW;
                if (pn < 8) {
                    f32x4 v0, v1;
                    if (pn < 4) {
#pragma unroll
                        for (int i = 0; i < 4; ++i) { v0[i] = a0[i] * sigmoidf_(g0[i]); v1[i] = a1[i] * sigmoidf_(g1[i]); }
                    } else { v0 = a0 * g0; v1 = a1 * g1; }
                    const int cl = 128 * (pn & 3) + colw;
                    u32x4 w; w.x = cvt_pk_bf16(v0[0], v0[1]); w.y = cvt_pk_bf16(v0[2], v0[3]); w.z = cvt_pk_bf16(v1[0], v1[1]); w.w = cvt_pk_bf16(v1[2], v1[3]);
                    *(u32x4*)(rowp + (pn < 4 ? 0 : 512) + cl) = w;
                    const int keep = pn < 4 ? 30 : 2;
                    float* sp = nullptr;
                    if (r < MPR) { const int t = r & (SEQ - 1), b = r >> 11; if (t >= SEQ - keep) sp = out + (pn < 4 ? O_PCA : O_PCB) + ((size_t)(b * keep + (t - (SEQ - keep)))) * CH + cl; }
                    else if (r < MTOT) { const int rs_ = r - MPR, sb = rs_ >> 2, j = rs_ & 3; if (j >= NST - keep || keep == 30) sp = out + (pn < 4 ? O_SCA : O_SCB) + ((size_t)(sb * keep + (keep - NST + j))) * CH + cl; }
                    if (sp) { *(f32x4*)sp = v0; *(f32x4*)(sp + 4) = v1; }
                } else {
                    const int c = 1024 + 256 * (pn - 8) + colw;
                    u32x4 w; w.x = cvt_pk_bf16(a0[0], a0[1]); w.y = cvt_pk_bf16(a0[2], a0[3]); w.z = cvt_pk_bf16(a1[0], a1[1]); w.w = cvt_pk_bf16(a1[2], a1[3]);
                    *(u32x4*)(rowp + c) = w;
                    w.x = cvt_pk_bf16(g0[0], g0[1]); w.y = cvt_pk_bf16(g0[2], g0[3]); w.z = cvt_pk_bf16(g1[0], g1[1]); w.w = cvt_pk_bf16(g1[2], g1[3]);
                    *(u32x4*)(rowp + c + 128) = w;
                }
            }
    }
};
struct EpiResid {
    static constexpr bool PERM = true, AFTER_DRAIN = false;
    bf16_t* HB; float* ssq; int skip;
    __device__ __forceinline__ void operator()(const f32x4 (&acc)[2][2][4][2], const Unit& u, int wr, int wc, int fr, int fq) const {
        const int col0 = u.pn * BM + wc * 32 + 8 * fq;
        if (skip) { if (acc[0][0][0][0][0] == 1.2345e-30f) ssq[0] = 0.f; return; }
#pragma unroll
        for (int ai = 0; ai < 2; ++ai) {
            u32x4 bs[4][2];
#pragma unroll
            for (int m = 0; m < 4; ++m) { const int r = u.pm * BM + ai * HALF + wr * 64 + m * 16 + fr; const int rc = r < MTOT ? r : MTOT - 1;
#pragma unroll
                for (int bj = 0; bj < 2; ++bj) bs[m][bj] = *(const u32x4*)(HB + (size_t)rc * D + col0 + bj * HALF); }
            asm volatile("" ::: "memory");
#pragma unroll
            for (int m = 0; m < 4; ++m) {
                const int r = u.pm * BM + ai * HALF + wr * 64 + m * 16 + fr;
                float s = 0.f;
                if (r < MTOT) {
#pragma unroll
                    for (int bj = 0; bj < 2; ++bj) {
                        const u32x4 b = bs[m][bj];
                        const f32x4 v0 = (f32x4){bflo(b.x), bfhi(b.x), bflo(b.y), bfhi(b.y)} + acc[ai][bj][m][0];
                        const f32x4 v1 = (f32x4){bflo(b.z), bfhi(b.z), bflo(b.w), bfhi(b.w)} + acc[ai][bj][m][1];
                        s += ((v0[0] * v0[0] + v0[1] * v0[1]) + (v0[2] * v0[2] + v0[3] * v0[3])) + ((v1[0] * v1[0] + v1[1] * v1[1]) + (v1[2] * v1[2] + v1[3] * v1[3]));
                        u32x4 w; w.x = cvt_pk_bf16(v0[0], v0[1]); w.y = cvt_pk_bf16(v0[2], v0[3]); w.z = cvt_pk_bf16(v1[0], v1[1]); w.w = cvt_pk_bf16(v1[2], v1[3]);
                        *(u32x4*)(HB + (size_t)r * D + col0 + bj * HALF) = w;
                    }
                }
                s = fq_sum(s);
                if (fq == 0 && r < MTOT) ssq[(size_t)r * 64 + u.pn * 4 + wc] = s;
            }
        }
    }
};
template <int CTRL> __device__ __forceinline__ float dpp_f(float old, float src) {
    return __uint_as_float(__builtin_amdgcn_update_dpp(__float_as_uint(old), __float_as_uint(src), CTRL, 0xf, 0xf, false)); }
struct EpiFfn {
    static constexpr bool PERM = true, AFTER_DRAIN = false;
    LAS unsigned char* lds; bf16_t* U; float* SG; float* SU; const float* wcv; const float* ssq; float* out; const float* fst; int layer;
    __device__ __forceinline__ void operator()(const f32x4 (&acc)[2][2][4][2], const Unit& u, int wr, int wc, int fr, int fq) const {
        asm volatile("" : "+v"(fr), "+v"(fq));
        const int col = u.pn * 128 + wc * 32 + 8 * fq;
        f32x4 w0[2], w1[2], w2[2];
#pragma unroll
        for (int n = 0; n < 2; ++n) { w0[n] = *(const f32x4*)(wcv + col + 4 * n); w1[n] = *(const f32x4*)(wcv + DFF + col + 4 * n); w2[n] = *(const f32x4*)(wcv + 2 * DFF + col + 4 * n); }
        if (u.pm >= MPR / BM) {
#pragma unroll
            for (int ai = 0; ai < 2; ++ai)
#pragma unroll
                for (int m = 0; m < 4; ++m) {
                    const int r = u.pm * BM + ai * HALF + wr * 64 + m * 16 + fr;
                    if (ai * HALF + wr * 64 + m * 16 >= MSA) continue;
                    const float rs = row_rstd(ssq, r, fq);
                    const int rs_ = r - MPR, sb = rs_ >> 2, j = rs_ & 3;
                    const float* sp0 = fst + ((size_t)((layer * NSB + sb) * 2)) * DFF + col;
                    f32x4 g[2], up[2], s0[2], s1[2], o[2];
#pragma unroll
                    for (int n = 0; n < 2; ++n) { g[n] = acc[ai][0][m][n] * rs; up[n] = acc[ai][1][m][n] * rs; s0[n] = *(const f32x4*)(sp0 + 4 * n); s1[n] = *(const f32x4*)(sp0 + DFF + 4 * n); }
#pragma unroll
                    for (int n = 0; n < 2; ++n)
#pragma unroll
                        for (int i = 0; i < 4; ++i) {
                            const float q1 = dpp_f<0x90>(0.f, g[n][i]), q2 = dpp_f<0x40>(0.f, g[n][i]);
                            const float gm1 = (j == 0) ? s1[n][i] : q1, gm2 = (j == 0) ? s0[n][i] : (j == 1) ? s1[n][i] : q2;
                            const float y = w0[n][i] * gm2 + w1[n][i] * gm1 + w2[n][i] * g[n][i];
                            o[n][i] = y * sigmoidf_(y) * up[n][i];
                        }
                    u32x4 w; w.x = cvt_pk_bf16(o[0][0], o[0][1]); w.y = cvt_pk_bf16(o[0][2], o[0][3]); w.z = cvt_pk_bf16(o[1][0], o[1][1]); w.w = cvt_pk_bf16(o[1][2], o[1][3]);
                    *(u32x4*)(U + (size_t)r * DFF + col) = w;
                    if (j >= 2) { float* sp = out + O_SF + ((size_t)((layer * NSB + sb) * 2 + (j - 2))) * DFF + col; *(f32x4*)sp = g[0]; *(f32x4*)(sp + 4) = g[1]; }
                }
            return;
        }
        float rsv[2][4];
#pragma unroll
        for (int ai = 0; ai < 2; ++ai)
#pragma unroll
            for (int m = 0; m < 4; ++m) rsv[ai][m] = row_rstd(ssq, (u.pm * 4 + ai * 2 + wr) * 64 + m * 16 + fr, fq);
        asm volatile("" ::: "memory");
        LAS float* xg = (LAS float*)(lds + STAGE_BYTES);
#pragma unroll
        for (int ai = 0; ai < 2; ++ai) { const int bl = ai * 2 + wr;
            if (bl < 3 && fr >= 14) { LAS float* xp = xg + (bl * 2 + (fr - 14)) * 128 + wc * 32 + 8 * fq; *(LAS f32x4*)xp = acc[ai][0][3][0] * rsv[ai][3]; *(LAS f32x4*)(xp + 4) = acc[ai][0][3][1] * rsv[ai][3]; } }
        asm volatile("s_waitcnt lgkmcnt(0)" ::: "memory");
        __builtin_amdgcn_s_barrier();
#pragma unroll
        for (int ai = 0; ai < 2; ++ai) {
            const int bl = ai * 2 + wr, blk = u.pm * 4 + bl;
            f32x4 gp[2];
            gp[0] = (f32x4){0.f, 0.f, 0.f, 0.f}; gp[1] = gp[0];
            if (bl >= 1 && fr >= 14) { const LAS float* xp = xg + ((bl - 1) * 2 + (fr - 14)) * 128 + wc * 32 + 8 * fq; gp[0] = *(const LAS f32x4*)xp; gp[1] = *(const LAS f32x4*)(xp + 4); }
#pragma unroll
            for (int m = 0; m < 4; ++m) {
                const int r = blk * 64 + m * 16 + fr;
                const float rs = rsv[ai][m];
                f32x4 g[2], up[2], o[2];
#pragma unroll
                for (int n = 0; n < 2; ++n) { g[n] = acc[ai][0][m][n] * rs; up[n] = acc[ai][1][m][n] * rs; }
#pragma unroll
                for (int n = 0; n < 2; ++n)
#pragma unroll
                    for (int i = 0; i < 4; ++i) {
                        const float x1 = dpp_f<0x121>(0.f, gp[n][i]), gm1 = dpp_f<0x111>(x1, g[n][i]);
                        const float x2 = dpp_f<0x122>(0.f, gp[n][i]), gm2 = dpp_f<0x112>(x2, g[n][i]);
                        const float y = w0[n][i] * gm2 + w1[n][i] * gm1 + w2[n][i] * g[n][i];
                        o[n][i] = y * sigmoidf_(y) * up[n][i];
                    }
                const bool seam_lo = (bl == 0) && (m == 0) && (fr < 2), seam_hi = (bl == 3) && (m == 3) && (fr >= 14);
                if (!seam_lo) { u32x4 w; w.x = cvt_pk_bf16(o[0][0], o[0][1]); w.y = cvt_pk_bf16(o[0][2], o[0][3]); w.z = cvt_pk_bf16(o[1][0], o[1][1]); w.w = cvt_pk_bf16(o[1][2], o[1][3]);
                    *(u32x4*)(U + (size_t)r * DFF + col) = w; }
                else { float* sg = SG + ((size_t)u.pm * 4 + fr) * DFF + col; *(f32x4*)sg = g[0]; *(f32x4*)(sg + 4) = g[1];
                       float* su = SU + ((size_t)u.pm * 2 + fr) * DFF + col; *(f32x4*)su = up[0]; *(f32x4*)(su + 4) = up[1]; }
                if (seam_hi) { float* sg = SG + ((size_t)u.pm * 4 + 2 + (fr - 14)) * DFF + col; *(f32x4*)sg = g[0]; *(f32x4*)(sg + 4) = g[1];
                    const int t = r & (SEQ - 1), b = r >> 11;
                    if (t >= SEQ - 2) { float* sp = out + O_PF + ((size_t)((layer * NB + b) * 2 + (t - (SEQ - 2)))) * DFF + col; *(f32x4*)sp = g[0]; *(f32x4*)(sp + 4) = g[1]; } }
                gp[0] = g[0]; gp[1] = g[1];
            }
        }
    }
};
struct EpiQkv {
    static constexpr bool PERM = true, AFTER_DRAIN = false;
    bf16_t* QKV; float* QS; const float* ssq; float* out;
    __device__ __forceinline__ void operator()(const f32x4 (&acc)[2][2][4][2], const Unit& u, int wr, int wc, int fr, int fq) const {
        const int which = u.pn >> 2, cb = 256 * (u.pn & 3) + wc * 32 + 8 * fq;
        bf16_t* dst = QKV + (size_t)which * ((WS_K - WS_Q) / 2);
        float rsv[2][4];
#pragma unroll
        for (int ai = 0; ai < 2; ++ai)
#pragma unroll
            for (int m = 0; m < 4; ++m) rsv[ai][m] = row_rstd(ssq, u.pm * BM + ai * HALF + wr * 64 + m * 16 + fr, fq);
        asm volatile("" ::: "memory");
#pragma unroll
        for (int ai = 0; ai < 2; ++ai)
#pragma unroll
            for (int m = 0; m < 4; ++m) {
                const int r = u.pm * BM + ai * HALF + wr * 64 + m * 16 + fr;
                const float rs = rsv[ai][m] * (which == 0 ? QSCALE : 1.0f);
                float* fp = nullptr;
                if (which == 0) { if (r >= MPR && r < MTOT) fp = QS + (size_t)(r - MPR) * D; }
                else if (r < MPR) fp = out + (which == 1 ? O_PK : O_PV) + (size_t)r * D;
                else if (r < MTOT) { const int rs_ = r - MPR, sb = rs_ >> 2, j = rs_ & 3; fp = out + (which == 1 ? O_SK : O_SV) + ((size_t)sb * LBUF + (LBUF - NST) + j) * D; }
#pragma unroll
                for (int bj = 0; bj < 2; ++bj) {
                    const f32x4 v0 = acc[ai][bj][m][0] * rs, v1 = acc[ai][bj][m][1] * rs;
                    const int c = cb + bj * HALF;
                    u32x4 w; w.x = cvt_pk_bf16(v0[0], v0[1]); w.y = cvt_pk_bf16(v0[2], v0[3]); w.z = cvt_pk_bf16(v1[0], v1[1]); w.w = cvt_pk_bf16(v1[2], v1[3]);
                    *(u32x4*)(dst + (size_t)r * D + c) = w;
                    if (fp) { *(f32x4*)(fp + c) = v0; *(f32x4*)(fp + c + 4) = v1; }
                }
            }
    }
};

template <class Epi, class Sched, bool ALIGN_EPI = false, bool SP2 = false>
__device__ __forceinline__ void gemm_phase(LAS unsigned char* lds, const Gemm g, const Sched& S, const Epi& E) {
    const int wid = g.wid, lane = lane_id(), tid = wid * 64 + lane, wr = wid >> 2, wc = wid & 3, fr = lane & 15, fq = lane >> 4;
    const int K = g.K, nt = K / BK;
    unsigned voffA[2], voffB[2];
#pragma unroll
    for (int i = 0; i < 2; ++i) { int R, C; stage_rc(tid * 16 + i * 8192, R, C); const int Rb = Epi::PERM ? ((R & ~31) + perm32(R & 31)) : R;
        voffA[i] = (unsigned)(R * K + C) * 2u; voffB[i] = (unsigned)(Rb * K + C) * 2u; }
    const size_t kstep = (size_t)(BK * 2);
    const size_t hstep = (size_t)HALF * K * 2;
    const size_t tstep = 2 * hstep;
    const unsigned ldsw = (unsigned)wid * 1024u;
    const int aoff = lds_byte(wr * 64 + fr, fq * 8), boff = lds_byte(wc * 32 + fr, fq * 8);
#define PG8_SA(b, h) (((b) * 2 + (h)) * HTB)
#define PG8_SB(b, h) ((4 + (b) * 2 + (h)) * HTB)
#define PG8_STAGE(bufoff, gbase, voff) do { _Pragma("unroll") for (int _i = 0; _i < 2; ++_i) \
        __builtin_amdgcn_global_load_lds((const unsigned*)((const char*)(gbase) + (voff)[_i]), (LAS unsigned*)(lds + (bufoff) + ldsw + _i * 8192), 16, 0, 0); } while (0)
#define PG8_LDA(dst, b, h) do { _Pragma("unroll") for (int m = 0; m < 4; ++m) _Pragma("unroll") for (int k = 0; k < 2; ++k) dst[m][k] = *(const LAS bf16x8*)(lds + PG8_SA(b, h) + aoff + m * 2048 + k * 1024); } while (0)
#define PG8_LDB(dst, b, h) do { _Pragma("unroll") for (int n = 0; n < 2; ++n) _Pragma("unroll") for (int k = 0; k < 2; ++k) dst[n][k] = *(const LAS bf16x8*)(lds + PG8_SB(b, h) + boff + n * 2048 + k * 1024); } while (0)
#define PG8_MMA(ai, bj, At, Bt) do { __builtin_amdgcn_s_setprio(1); _Pragma("unroll") for (int m = 0; m < 4; ++m) _Pragma("unroll") for (int n = 0; n < 2; ++n) _Pragma("unroll") for (int k = 0; k < 2; ++k) \
        acc[ai][bj][m][n] = __builtin_amdgcn_mfma_f32_16x16x32_bf16(Bt[n][k], At[m][k], acc[ai][bj][m][n], 0, 0, 0); __builtin_amdgcn_s_setprio(0); } while (0)
#define PG8_WAIT_V(n) asm volatile("s_waitcnt vmcnt(" #n ")" ::: "memory")
#define PG8_WAIT_L(n) asm volatile("s_waitcnt lgkmcnt(" #n ")" ::: "memory")
#define PG8_BAR __builtin_amdgcn_s_barrier()
#define PG8_SCHED __builtin_amdgcn_sched_barrier(0)
    Unit cur, nxt; int ui = 0;
    if (!S.next(0, cur)) return;
    f32x4 acc[2][2][4][2];
#pragma unroll
    for (int a = 0; a < 2; ++a)
#pragma unroll
        for (int b = 0; b < 2; ++b)
#pragma unroll
            for (int m = 0; m < 4; ++m)
#pragma unroll
                for (int n = 0; n < 2; ++n) acc[a][b][m][n] = (f32x4){0.f, 0.f, 0.f, 0.f};
    bf16x8 At[4][2], B0[2][2], B1[2][2];
    const char* cA = (const char*)g.A + (size_t)cur.pm * tstep; const char* cB = (const char*)g.Bt + (size_t)cur.pn * tstep;
    S.a_ready(cur);
    if constexpr (SP2) {
        PG8_STAGE(PG8_SB(0, 0), cB, voffB); PG8_STAGE(PG8_SB(0, 1), cB + hstep, voffB); PG8_STAGE(PG8_SA(0, 0), cA, voffA); PG8_STAGE(PG8_SA(0, 1), cA + hstep, voffA);
        if (wr == 1) PG8_BAR;
        PG8_WAIT_V(2); PG8_BAR;
        PG8_STAGE(PG8_SB(1, 0), cB + kstep, voffB); PG8_STAGE(PG8_SA(1, 0), cA + kstep, voffA); PG8_STAGE(PG8_SB(1, 1), cB + hstep + kstep, voffB);
        PG8_WAIT_V(6); PG8_BAR;
    } else {
        PG8_STAGE(PG8_SB(0, 0), cB, voffB); PG8_STAGE(PG8_SA(0, 0), cA, voffA); PG8_STAGE(PG8_SB(0, 1), cB + hstep, voffB); PG8_STAGE(PG8_SA(0, 1), cA + hstep, voffA);
        if (wr == 1) PG8_BAR;
        PG8_WAIT_V(4); PG8_BAR;
        PG8_STAGE(PG8_SB(1, 0), cB + kstep, voffB); PG8_STAGE(PG8_SA(1, 0), cA + kstep, voffA); PG8_STAGE(PG8_SB(1, 1), cB + hstep + kstep, voffB);
        PG8_WAIT_V(6); PG8_BAR;
    }
    for (;;) {
        const bool has_next = S.next(ui + 1, nxt);
        const char* nA = has_next ? (const char*)g.A + (size_t)nxt.pm * tstep : cA; const char* nB = has_next ? (const char*)g.Bt + (size_t)nxt.pn * tstep : cB;
        for (int t = 0; t < nt; t += 2) {
            const bool last = (t == nt - 2);
            const char* a1 = cA + (size_t)(t + 1) * kstep;
            const char* a2 = last ? nA : cA + (size_t)(t + 2) * kstep; const char* b2 = last ? nB : cB + (size_t)(t + 2) * kstep;
            const char* a3 = a2 + kstep; const char* b3 = b2 + kstep;
            if (last && has_next) S.a_ready(nxt);
            if constexpr (SP2) {
            PG8_LDB(B0, 0, 0); PG8_LDB(B1, 0, 1); PG8_SCHED; PG8_LDA(At, 0, 0); PG8_STAGE(PG8_SA(1, 1), a1 + hstep, voffA);
            PG8_WAIT_V(8); PG8_WAIT_L(0); PG8_BAR; PG8_MMA(0, 0, At, B0); PG8_MMA(0, 1, At, B1); PG8_BAR; PG8_SCHED;
            PG8_LDA(At, 0, 1); PG8_STAGE(PG8_SB(0, 0), b2, voffB); PG8_STAGE(PG8_SB(0, 1), b2 + hstep, voffB); PG8_STAGE(PG8_SA(0, 0), a2, voffA);
            PG8_WAIT_V(8); PG8_WAIT_L(0); PG8_BAR; PG8_MMA(1, 0, At, B0); PG8_MMA(1, 1, At, B1); PG8_BAR; PG8_SCHED;
            PG8_LDB(B0, 1, 0); PG8_LDB(B1, 1, 1); PG8_SCHED; PG8_LDA(At, 1, 0); PG8_STAGE(PG8_SA(0, 1), a2 + hstep, voffA);
            PG8_WAIT_V(8); PG8_WAIT_L(0); PG8_BAR; PG8_MMA(0, 0, At, B0); PG8_MMA(0, 1, At, B1); PG8_BAR; PG8_SCHED;
            PG8_LDA(At, 1, 1); PG8_STAGE(PG8_SB(1, 0), b3, voffB); PG8_STAGE(PG8_SB(1, 1), b3 + hstep, voffB); PG8_STAGE(PG8_SA(1, 0), a3, voffA);
            PG8_WAIT_V(8); PG8_WAIT_L(0); PG8_BAR; PG8_MMA(1, 0, At, B0); PG8_MMA(1, 1, At, B1); PG8_BAR; PG8_SCHED;
            } else {
            PG8_LDB(B0, 0, 0); PG8_SCHED; PG8_LDA(At, 0, 0); PG8_STAGE(PG8_SA(1, 1), a1 + hstep, voffA);
            PG8_WAIT_L(8); PG8_BAR; PG8_WAIT_L(0); PG8_MMA(0, 0, At, B0); PG8_BAR; PG8_SCHED;
            PG8_LDB(B1, 0, 1); PG8_STAGE(PG8_SB(0, 0), b2, voffB);
            PG8_BAR; PG8_WAIT_L(0); PG8_MMA(0, 1, At, B1); PG8_BAR;
            PG8_LDA(At, 0, 1); PG8_STAGE(PG8_SA(0, 0), a2, voffA);
            PG8_BAR; PG8_WAIT_L(0); PG8_MMA(1, 0, At, B0); PG8_BAR; PG8_SCHED;
            PG8_STAGE(PG8_SB(0, 1), b2 + hstep, voffB);
            PG8_WAIT_V(6); PG8_BAR; PG8_MMA(1, 1, At, B1); PG8_BAR;
            PG8_LDB(B0, 1, 0); PG8_SCHED; PG8_LDA(At, 1, 0); PG8_STAGE(PG8_SA(0, 1), a2 + hstep, voffA);
            PG8_WAIT_L(8); PG8_BAR; PG8_WAIT_L(0); PG8_MMA(0, 0, At, B0); PG8_BAR; PG8_SCHED;
            PG8_LDB(B1, 1, 1); PG8_STAGE(PG8_SB(1, 0), b3, voffB);
            PG8_BAR; PG8_WAIT_L(0); PG8_MMA(0, 1, At, B1); PG8_BAR;
            PG8_LDA(At, 1, 1); PG8_STAGE(PG8_SA(1, 0), a3, voffA);
            PG8_BAR; PG8_WAIT_L(0); PG8_MMA(1, 0, At, B0); PG8_BAR; PG8_SCHED;
            PG8_STAGE(PG8_SB(1, 1), b3 + hstep, voffB);
            PG8_WAIT_V(6); PG8_BAR; PG8_MMA(1, 1, At, B1); PG8_BAR;
            }
        }
        if constexpr (ALIGN_EPI) { if (wr == 0) PG8_BAR; }
        if constexpr (!Epi::AFTER_DRAIN) { E(acc, cur, wr, wc, fr, fq); S.done(cur); }
        if (!has_next) break;
#pragma unroll
        for (int a = 0; a < 2; ++a)
#pragma unroll
            for (int b = 0; b < 2; ++b)
#pragma unroll
                for (int m = 0; m < 4; ++m)
#pragma unroll
                    for (int n = 0; n < 2; ++n) acc[a][b][m][n] = (f32x4){0.f, 0.f, 0.f, 0.f};
        cur = nxt; cA = nA; cB = nB; ++ui;
        if constexpr (ALIGN_EPI) { if (wr == 1) PG8_BAR; }
    }
    PG8_WAIT_V(0);
    if constexpr (!ALIGN_EPI) { if (wr == 0) PG8_BAR; }
    PG8_BAR;
#undef PG8_SA
#undef PG8_SB
#undef PG8_STAGE
#undef PG8_LDA
#undef PG8_LDB
#undef PG8_MMA
#undef PG8_WAIT_V
#undef PG8_WAIT_L
#undef PG8_BAR
#undef PG8_SCHED
}
}

__device__ __forceinline__ void transpose_item(const float* W, int K, int N, bf16_t* WT, int k0, int np0, int srcn0, const float* g, LAS float* scr, int lane) {
    f32x4 v[8];
#pragma unroll
    for (int i = 0; i < 8; ++i) { const int kk = 8 * i + (lane >> 3); v[i] = __builtin_nontemporal_load((const f32x4*)(W + (size_t)(k0 + kk) * N + srcn0 + (lane & 7) * 4)); }
#pragma unroll
    for (int i = 0; i < 8; ++i) { const int kk = 8 * i + (lane >> 3); const float gg = g ? g[k0 + kk] : 1.0f; LAS float* d = scr + kk * 33 + (lane & 7) * 4;
        d[0] = v[i].x * gg; d[1] = v[i].y * gg; d[2] = v[i].z * gg; d[3] = v[i].w * gg; }
    asm volatile("s_waitcnt lgkmcnt(0)" ::: "memory");
    const int c = lane & 7;
#pragma unroll
    for (int j = 0; j < 4; ++j) { const int n = (lane >> 3) + 8 * j; const LAS float* s = scr + (8 * c) * 33 + n;
        u32x4 o; o.x = cvt_pk_bf16(s[0 * 33], s[1 * 33]); o.y = cvt_pk_bf16(s[2 * 33], s[3 * 33]); o.z = cvt_pk_bf16(s[4 * 33], s[5 * 33]); o.w = cvt_pk_bf16(s[6 * 33], s[7 * 33]);
        *(u32x4*)(WT + (size_t)(np0 + n) * K + k0 + 8 * c) = o; }
    asm volatile("s_waitcnt lgkmcnt(0)" ::: "memory");
}
__device__ __forceinline__ int src_in_ab(int np) {
    const int pn = np >> 8, cc = np & 255, bj = cc >> 7, off = cc & 127;
    if (pn < 4) return (bj ? 512 : 0) + 128 * pn + off;
    if (pn < 8) return (bj ? 2048 : 1536) + 128 * (pn - 4) + off;
    return 1024 + 256 * (pn - 8) + cc;
}
__device__ __forceinline__ int src_ffn(int np) { const int pn = np >> 8, cc = np & 255, bj = cc >> 7, off = cc & 127; return (bj ? DFF : 0) + 128 * pn + off; }

struct Args { const float* in[22]; float* out; unsigned char* ws; };

__device__ __forceinline__ void copy_range_simple(const Args& a, size_t lo, size_t hi, int bi, int nb, int tid) {
    const size_t per = (size_t)(LBUF - NST) * D / 4;
    const size_t stride = (size_t)nb * NTHREADS;
    for (size_t i0 = lo + (size_t)bi * NTHREADS + tid; i0 < hi; i0 += 8 * stride) {
        f32x4 kv[8], vv[8];
#pragma unroll
        for (int u = 0; u < 8; ++u) { const size_t i = i0 + u * stride; if (i < hi) { const size_t sb = i / per, rem = i % per;
            kv[u] = __builtin_nontemporal_load((const f32x4*)(a.in[4] + (sb * LBUF + NST) * D) + rem); vv[u] = __builtin_nontemporal_load((const f32x4*)(a.in[5] + (sb * LBUF + NST) * D) + rem); } }
#pragma unroll
        for (int u = 0; u < 8; ++u) { const size_t i = i0 + u * stride; if (i < hi) { const size_t sb = i / per, rem = i % per;
            __builtin_nontemporal_store(kv[u], (f32x4*)(a.out + O_SK + sb * LBUF * D) + rem); __builtin_nontemporal_store(vv[u], (f32x4*)(a.out + O_SV + sb * LBUF * D) + rem); } }
    }
}
template <int NB> __device__ __forceinline__ void copy_range(const Args& a, size_t lo_, size_t hi_, int bi, int wave) {
    constexpr unsigned per = (unsigned)((LBUF - NST) * D / 4);
    const unsigned lo = (unsigned)lo_, hi = (unsigned)hi_; constexpr unsigned stride = (unsigned)NB * NTHREADS;
    const float* kin = a.in[4]; const float* vin = a.in[5]; float* outp = a.out;
#define CP_SRC(T, i) ((const f32x4*)((T) + ((size_t)((i) / per) * LBUF + NST) * D) + ((i) % per))
#define CP_DST(O, i) ((f32x4*)(outp + (O) + (size_t)((i) / per) * LBUF * D) + ((i) % per))
#define CP_LOAD(KK, VV, base) _Pragma("unroll") for (int u = 0; u < 8; ++u) { const unsigned i = (base) + u * stride; KK[u] = __builtin_nontemporal_load(CP_SRC(kin, i)); VV[u] = __builtin_nontemporal_load(CP_SRC(vin, i)); }
#define CP_STORE(KK, VV, base) _Pragma("unroll") for (int u = 0; u < 8; ++u) { const unsigned i = (base) + u * stride; __builtin_nontemporal_store(KK[u], CP_DST(O_SK, i)); __builtin_nontemporal_store(VV[u], CP_DST(O_SV, i)); }
#define CP_BODY CP_LOAD(kB, vB, i0 + 8u * stride) CP_STORE(kA, vA, i0) CP_LOAD(kA, vA, i0 + 16u * stride) CP_STORE(kB, vB, i0 + 8u * stride) i0 += 16u * stride;
    unsigned i0 = lo + (unsigned)bi * NTHREADS + (unsigned)(wave * 64 + lane_id());
    if (i0 >= hi) return;
    const unsigned nIt = ((hi - i0 + stride - 1u) / stride) >> 4;
    f32x4 kA[8], vA[8], kB[8], vB[8];
    if (nIt) {
        CP_LOAD(kA, vA, i0)
        if (nIt >= 2u) {
            CP_BODY
            for (unsigned it = 2u; it < nIt; ++it) { CP_BODY }
        }
        CP_LOAD(kB, vB, i0 + 8u * stride) CP_STORE(kA, vA, i0) CP_STORE(kB, vB, i0 + 8u * stride) i0 += 16u * stride;
    }
    if (i0 < hi) {
#pragma unroll
        for (int u = 0; u < 8; ++u) { const unsigned i = i0 + u * stride; if (i < hi) { kA[u] = __builtin_nontemporal_load(CP_SRC(kin, i)); vA[u] = __builtin_nontemporal_load(CP_SRC(vin, i)); } }
#pragma unroll
        for (int u = 0; u < 8; ++u) { const unsigned i = i0 + (8 + u) * stride; if (i < hi) { kB[u] = __builtin_nontemporal_load(CP_SRC(kin, i)); vB[u] = __builtin_nontemporal_load(CP_SRC(vin, i)); } }
#pragma unroll
        for (int u = 0; u < 8; ++u) { const unsigned i = i0 + u * stride; if (i < hi) { __builtin_nontemporal_store(kA[u], CP_DST(O_SK, i)); __builtin_nontemporal_store(vA[u], CP_DST(O_SV, i)); } }
#pragma unroll
        for (int u = 0; u < 8; ++u) { const unsigned i = i0 + (8 + u) * stride; if (i < hi) { __builtin_nontemporal_store(kB[u], CP_DST(O_SK, i)); __builtin_nontemporal_store(vB[u], CP_DST(O_SV, i)); } }
    }
#undef CP_BODY
#undef CP_LOAD
#undef CP_STORE
#undef CP_SRC
#undef CP_DST
}
constexpr int FR_P1 = 10, FR_P4 = 22, FR_P10 = 22, GE_P1 = 168, GE_FF = 208;
constexpr size_t CP_TOT = (size_t)(LBUF - NST) * D / 4 * NSB;
constexpr int FR_P2 = 4;
constexpr size_t CP_P2 = CP_TOT * (64 - FR_P1 - FR_P4 - FR_P10 - FR_P2) / 64;
constexpr size_t CP_C0 = CP_TOT * (64 - FR_P1 - FR_P4 - FR_P10) / 64, CP_C1 = CP_C0 + CP_TOT * FR_P1 / 64, CP_C2 = CP_C1 + CP_TOT * FR_P4 / 64;

constexpr int WI_IN = (D / 64) * (NIN / 32), WI_SQ = (D / 64) * (D / 32), WI_QKV = (D / 64) * (3 * D / 32), WI_F = (D / 64) * (2 * DFF / 32), WI_DN = (DFF / 64) * (D / 32);
constexpr int WI_TOT = WI_IN + 2 * WI_SQ + WI_QKV + 2 * WI_F + 2 * WI_DN;
__device__ __forceinline__ void p0_weights(const Args& a, LAS unsigned char* lds, int it_lo, int it_hi, int gw, int NGW, int lane, int wave) {
    LAS float* scr = (LAS float*)(lds + wave * 16384);
    unsigned char* ws = a.ws;
    constexpr int I_IN = WI_IN, I_SQ = WI_SQ, I_QKV = WI_QKV, I_F = WI_F, I_DN = WI_DN;
    for (int it = it_lo + gw; it < it_hi; it += NGW) {
        int r = it;
        if (r < I_IN) { const int nb = NIN / 32, kb = r / nb, n0 = 32 * (r % nb); transpose_item(a.in[10], D, NIN, (bf16_t*)(ws + WS_WIN), 64 * kb, n0, src_in_ab(n0), a.in[7], scr, lane); continue; } r -= I_IN;
        if (r < I_SQ) { const int nb = D / 32, kb = r / nb, n0 = 32 * (r % nb); transpose_item(a.in[16], D, D, (bf16_t*)(ws + WS_WOUT), 64 * kb, n0, n0, nullptr, scr, lane); continue; } r -= I_SQ;
        if (r < I_QKV) { const int nb = 3 * D / 32, kb = r / nb, n0 = 32 * (r % nb); transpose_item(a.in[17], D, 3 * D, (bf16_t*)(ws + WS_WQKV), 64 * kb, n0, n0, a.in[7] + D, scr, lane); continue; } r -= I_QKV;
        if (r < I_SQ) { const int nb = D / 32, kb = r / nb, n0 = 32 * (r % nb); transpose_item(a.in[18], D, D, (bf16_t*)(ws + WS_WO), 64 * kb, n0, n0, nullptr, scr, lane); continue; } r -= I_SQ;
        if (r < 2 * I_F) { const int l = r / I_F; r -= l * I_F; const int nb = 2 * DFF / 32, kb = r / nb, n0 = 32 * (r % nb);
            transpose_item(a.in[19] + (size_t)l * D * 2 * DFF, D, 2 * DFF, (bf16_t*)(ws + (l ? WS_WF1 : WS_WF0)), 64 * kb, n0, src_ffn(n0), a.in[8] + l * D, scr, lane); continue; } r -= 2 * I_F;
        { const int l = r / I_DN; r -= l * I_DN; const int nb = D / 32, kb = r / nb, n0 = 32 * (r % nb);
            transpose_item(a.in[21] + (size_t)l * DFF * D, DFF, D, (bf16_t*)(ws + (l ? WS_WD1 : WS_WD0)), 64 * kb, n0, n0, nullptr, scr, lane); }
    }
}
__device__ __forceinline__ void p0_prologue(const Args& a, LAS unsigned char* lds, int gw, int NGW, int lane, int wave) {
    unsigned char* ws = a.ws;
    p0_weights(a, lds, 0, (gridDim.x == 256) ? WI_IN : WI_TOT, gw, NGW, lane, wave);
    bf16_t* HB = (bf16_t*)(ws + WS_HB); float* ssq = (float*)(ws + WS_SSQ);
    for (int r0 = gw; r0 < MPAD; r0 += 2 * NGW) {
        f32x4 v[2][4]; float sq[2];
#pragma unroll
        for (int h = 0; h < 2; ++h) { const int r = r0 + h * NGW; sq[h] = 0.f;
            if (r < MTOT) { const f32x4* xr = (const f32x4*)((r < MPR) ? a.in[0] + (size_t)r * D : a.in[1] + (size_t)(r - MPR) * D) + lane;
#pragma unroll
                for (int j = 0; j < 4; ++j) v[h][j] = __builtin_nontemporal_load(xr + 64 * j); }
            else {
#pragma unroll
                for (int j = 0; j < 4; ++j) v[h][j] = (f32x4){0.f, 0.f, 0.f, 0.f}; } }
#pragma unroll
        for (int h = 0; h < 2; ++h) { const int r = r0 + h * NGW; if (r >= MPAD) continue;
#pragma unroll
            for (int j = 0; j < 4; ++j) sq[h] += (v[h][j].x * v[h][j].x + v[h][j].y * v[h][j].y) + (v[h][j].z * v[h][j].z + v[h][j].w * v[h][j].w);
            const float s = wave_sum(sq[h]);
            u32x2* o8 = (u32x2*)(HB + (size_t)r * D) + lane;
#pragma unroll
            for (int j = 0; j < 4; ++j) { u32x2 w; w.x = cvt_pk_bf16(v[h][j].x, v[h][j].y); w.y = cvt_pk_bf16(v[h][j].z, v[h][j].w); o8[64 * j] = w; }
            if (r < MPR) { if (lane < 16) ssq[(size_t)r * 64 + lane] = (lane == 0) ? s : 0.f; } else ssq[(size_t)r * 64 + lane] = (lane == 0) ? s : 0.f; }
    }
    {
        const int tot = NSB * 26 * (CH / 4);
        for (int i = gw * 64 + lane; i < tot; i += NGW * 64) { const int sb = i / (26 * (CH / 4)), rem = i % (26 * (CH / 4));
            ((f32x4*)(a.out + O_SCA + (size_t)sb * 30 * CH))[rem] = ((const f32x4*)(a.in[2] + (size_t)sb * 30 * CH + 4 * CH))[rem]; }
    }
    if (gridDim.x == 256) copy_range<256>(a, 0, CP_P2, blockIdx.x, wave); else copy_range_simple(a, 0, CP_C0, blockIdx.x, gridDim.x, wave * 64 + lane);
}

__device__ __forceinline__ void p2_conv(const Args& a, LAS unsigned char* lds, int tid, int lane, int wave) {
    unsigned char* ws = a.ws;
    const bf16_t* GA = (const bf16_t*)(ws + WS_GA); bf16_t* AB = (bf16_t*)(ws + WS_AB);
    LAS float* T = (LAS float*)lds;
    for (int u = blockIdx.x; u < 512 + NSB; u += gridDim.x) {
        const float* wa = a.in[11]; const float* ba = a.in[12]; const float* lg = a.in[13]; const float* lb = a.in[14]; const float* wb = a.in[15];
        asm volatile("" : "+s"(wa), "+s"(ba), "+s"(lg), "+s"(lb), "+s"(wb));
        const bool samp = u >= 512; const int sb = u - 512;
        const int row0 = samp ? MPR + sb * NST : u * 32, nrows = samp ? NST : 32;
        const int t0 = samp ? 0 : (row0 & (SEQ - 1));
        const int nvec = (nrows + 30) * (CH / 8);
        {
            u32x4 wv[8];
#pragma unroll
            for (int it = 0; it < 8; ++it) { const int i = tid + it * NTHREADS; const int e = i >> 6, c = (i & 63) * 8; const int p = t0 - 30 + e;
                wv[it] = (u32x4){0u, 0u, 0u, 0u};
                if (i < nvec && p >= 0) wv[it] = *(const u32x4*)(GA + (size_t)(row0 - t0 + p) * GAW + c); }
#pragma unroll
            for (int it = 0; it < 8; ++it) { const int i = tid + it * NTHREADS; const int e = i >> 6, c = (i & 63) * 8; const int p = t0 - 30 + e;
                if (i < nvec && (p >= 0 || !samp)) { const u32x4 w = wv[it];
                    *(LAS f32x4*)(T + e * CH + c) = (f32x4){bflo(w.x), bfhi(w.x), bflo(w.y), bfhi(w.y)}; *(LAS f32x4*)(T + e * CH + c + 4) = (f32x4){bflo(w.z), bfhi(w.z), bflo(w.w), bfhi(w.w)}; } }
            if (samp) {
                f32x4 s0_[4], s1_[4];
#pragma unroll
                for (int it = 0; it < 4; ++it) { const int i = tid + it * NTHREADS; if (i < 30 * 64) { const float* sp = a.in[2] + ((size_t)sb * 30 + (i >> 6)) * CH + (i & 63) * 8; s0_[it] = *(const f32x4*)sp; s1_[it] = *(const f32x4*)(sp + 4); } }
#pragma unroll
                for (int it = 0; it < 4; ++it) { const int i = tid + it * NTHREADS; if (i < 30 * 64) { *(LAS f32x4*)(T + (i >> 6) * CH + (i & 63) * 8) = s0_[it]; *(LAS f32x4*)(T + (i >> 6) * CH + (i & 63) * 8 + 4) = s1_[it]; } }
            }
        }
        __syncthreads();
        if (tid < 256) {
            const int c = 2 * tid; f32x2 w[KA];
#pragma unroll
            for (int k = 0; k < KA; ++k) w[k] = *(const f32x2*)(wa + k * CH + c);
            const f32x2 bias = *(const f32x2*)(ba + c);
            if (!samp) {
#pragma clang loop unroll(disable)
                for (int hb = 0; hb < 32; hb += 16) {
                    f32x2 x[46];
#pragma unroll
                    for (int e = 0; e < 46; ++e) x[e] = *(const LAS f32x2*)(T + (hb + e) * CH + c);
#pragma unroll
                    for (int i = 0; i < 16; ++i) {
                        f32x2 s0 = bias, s1 = (f32x2){0.f, 0.f}, s2 = s1, s3 = s1;
#pragma unroll
                        for (int k = 0; k < 28; k += 4) { s0 += w[k] * x[i + k]; s1 += w[k + 1] * x[i + k + 1]; s2 += w[k + 2] * x[i + k + 2]; s3 += w[k + 3] * x[i + k + 3]; }
                        s0 += w[28] * x[i + 28]; s1 += w[29] * x[i + 29]; s2 += w[30] * x[i + 30];
                        *(LAS f32x2*)(T + (hb + i) * CH + c) = (s0 + s1) + (s2 + s3);
                    }
                }
            } else {
                f32x2 x[34];
#pragma unroll
                for (int e = 0; e < 34; ++e) x[e] = *(const LAS f32x2*)(T + e * CH + c);
#pragma unroll
                for (int i = 0; i < NST; ++i) {
                    f32x2 s0 = bias, s1 = (f32x2){0.f, 0.f}, s2 = s1, s3 = s1;
#pragma unroll
                    for (int k = 0; k < 28; k += 4) { s0 += w[k] * x[i + k]; s1 += w[k + 1] * x[i + k + 1]; s2 += w[k + 2] * x[i + k + 2]; s3 += w[k + 3] * x[i + k + 3]; }
                    s0 += w[28] * x[i + 28]; s1 += w[29] * x[i + 29]; s2 += w[30] * x[i + 30];
                    *(LAS f32x2*)(T + i * CH + c) = (s0 + s1) + (s2 + s3);
                }
            }
        } else {
            const int t2 = tid - 256, c = (t2 & 63) * 8, rc = t2 >> 6, rbase = rc * 8;
            const int nr = samp ? (rc == 0 ? NST : 0) : 8;
            float wk[3][8];
#pragma unroll
            for (int k = 0; k < 3; ++k) { const f32x4 wa0 = *(const f32x4*)(wb + k * CH + c), wa1 = *(const f32x4*)(wb + k * CH + c + 4);
                wk[k][0] = wa0.x; wk[k][1] = wa0.y; wk[k][2] = wa0.z; wk[k][3] = wa0.w; wk[k][4] = wa1.x; wk[k][5] = wa1.y; wk[k][6] = wa1.z; wk[k][7] = wa1.w; }
            float xm2[8], xm1[8];
            {
                u32x4 a2 = (u32x4){0u, 0u, 0u, 0u}, a1 = a2;
                if (nr && t0 + rbase - 2 >= 0) { a2 = *(const u32x4*)(GA + (size_t)(row0 + rbase - 2) * GAW + 512 + c); a1 = *(const u32x4*)(GA + (size_t)(row0 + rbase - 1) * GAW + 512 + c); }
                xm2[0] = bflo(a2.x); xm2[1] = bfhi(a2.x); xm2[2] = bflo(a2.y); xm2[3] = bfhi(a2.y); xm2[4] = bflo(a2.z); xm2[5] = bfhi(a2.z); xm2[6] = bflo(a2.w); xm2[7] = bfhi(a2.w);
                xm1[0] = bflo(a1.x); xm1[1] = bfhi(a1.x); xm1[2] = bflo(a1.y); xm1[3] = bfhi(a1.y); xm1[4] = bflo(a1.z); xm1[5] = bfhi(a1.z); xm1[6] = bflo(a1.w); xm1[7] = bfhi(a1.w);
                if (samp && nr) { const float* sp = a.in[3] + (size_t)sb * 2 * CH + c; const f32x4 p0 = *(const f32x4*)sp, p1 = *(const f32x4*)(sp + 4), q0 = *(const f32x4*)(sp + CH), q1 = *(const f32x4*)(sp + CH + 4);
                    xm2[0] = p0.x; xm2[1] = p0.y; xm2[2] = p0.z; xm2[3] = p0.w; xm2[4] = p1.x; xm2[5] = p1.y; xm2[6] = p1.z; xm2[7] = p1.w;
                    xm1[0] = q0.x; xm1[1] = q0.y; xm1[2] = q0.z; xm1[3] = q0.w; xm1[4] = q1.x; xm1[5] = q1.y; xm1[6] = q1.z; xm1[7] = q1.w; }
            }
#pragma clang loop unroll(disable)
            for (int k0 = 0; k0 < nr; k0 += 4) {
                u32x4 cxv[4], gbv[4];
#pragma unroll
                for (int k = 0; k < 4; ++k) { cxv[k] = *(const u32x4*)(GA + (size_t)(row0 + rbase + k0 + k) * GAW + 512 + c); gbv[k] = *(const u32x4*)(GA + (size_t)(row0 + rbase + k0 + k) * GAW + 1024 + c); }
#pragma unroll
                for (int k = 0; k < 4; ++k) {
                    const u32x4 xv = cxv[k], gv = gbv[k];
                    float o[8];
#pragma unroll
                    for (int e = 0; e < 8; ++e) {
                        const unsigned xw = e < 2 ? xv.x : (e < 4 ? xv.y : (e < 6 ? xv.z : xv.w)), gw_ = e < 2 ? gv.x : (e < 4 ? gv.y : (e < 6 ? gv.z : gv.w));
                        const float x0 = (e & 1) ? bfhi(xw) : bflo(xw), gb = (e & 1) ? bfhi(gw_) : bflo(gw_);
                        o[e] = gb * (wk[0][e] * xm2[e] + wk[1][e] * xm1[e] + wk[2][e] * x0); xm2[e] = xm1[e]; xm1[e] = x0; }
                    u32x4 w4; w4.x = cvt_pk_bf16(o[0], o[1]); w4.y = cvt_pk_bf16(o[2], o[3]); w4.z = cvt_pk_bf16(o[4], o[5]); w4.w = cvt_pk_bf16(o[6], o[7]);
                    *(u32x4*)(AB + (size_t)(row0 + rbase + k0 + k) * D + 512 + c) = w4;
                }
            }
        }
        __syncthreads();
        {
            const int c = lane * 8;
            const f32x4 g0 = *(const f32x4*)(lg + c), g1 = *(const f32x4*)(lg + c + 4), b0 = *(const f32x4*)(lb + c), b1 = *(const f32x4*)(lb + c + 4);
            f32x4 v0[4], v1[4]; float mu[4], rstd[4];
#pragma unroll
            for (int j = 0; j < 4; ++j) { const int rr = wave + 8 * j; const int rc = rr < nrows ? rr : 0; v0[j] = *(const LAS f32x4*)(T + rc * CH + c); v1[j] = *(const LAS f32x4*)(T + rc * CH + c + 4); }
#pragma unroll
            for (int j = 0; j < 4; ++j) { const float s_ = (v0[j].x + v0[j].y) + (v0[j].z + v0[j].w) + (v1[j].x + v1[j].y) + (v1[j].z + v1[j].w); mu[j] = wave_sum(s_) * (1.0f / CH); }
#pragma unroll
            for (int j = 0; j < 4; ++j) { v0[j] = v0[j] - mu[j]; v1[j] = v1[j] - mu[j];
                const float q = (v0[j].x * v0[j].x + v0[j].y * v0[j].y) + (v0[j].z * v0[j].z + v0[j].w * v0[j].w) + (v1[j].x * v1[j].x + v1[j].y * v1[j].y) + (v1[j].z * v1[j].z + v1[j].w * v1[j].w);
                rstd[j] = rsqrtf(wave_sum(q) * (1.0f / CH) + LN_EPS); }
#pragma unroll
            for (int j = 0; j < 4; ++j) { const int rr = wave + 8 * j;
                if (rr < nrows) {
                    f32x4 a0 = v0[j] * rstd[j] * g0 + b0, a1 = v1[j] * rstd[j] * g1 + b1;
#pragma unroll
                    for (int e = 0; e < 4; ++e) { a0[e] = a0[e] * sigmoidf_(a0[e]); a1[e] = a1[e] * sigmoidf_(a1[e]); }
                    u32x4 w4; w4.x = cvt_pk_bf16(a0[0], a0[1]); w4.y = cvt_pk_bf16(a0[2], a0[3]); w4.z = cvt_pk_bf16(a1[0], a1[1]); w4.w = cvt_pk_bf16(a1[2], a1[3]);
                    *(u32x4*)(AB + (size_t)(row0 + rr) * D + c) = w4;
                } }
        }
        __syncthreads();
    }
}

__device__ __forceinline__ void panel_fix(const Args& a, int layer, int pm, int tid) {
    unsigned char* ws = a.ws;
    bf16_t* U = (bf16_t*)(ws + WS_U); const float* SG = (const float*)(ws + WS_SG); const float* SU = (const float*)(ws + WS_SU);
    const float* wc = a.in[20] + (size_t)layer * 3 * DFF;
    constexpr int NCV = DFF / 8;
    const bool first = (pm & 7) == 0;
    for (int it = tid; it < 2 * NCV; it += NTHREADS) {
        const int j = it >= NCV ? 1 : 0, cv = it - j * NCV, c = cv * 8;
        float gm2[8], gm1[8], g0[8], up[8];
        const float* cur = SG + (size_t)pm * 4 * DFF + c; const float* prv = SG + (size_t)(pm - 1) * 4 * DFF + c;
#pragma unroll
        for (int e = 0; e < 8; ++e) {
            if (j == 0) { gm2[e] = first ? 0.f : prv[2 * DFF + e]; gm1[e] = first ? 0.f : prv[3 * DFF + e]; g0[e] = cur[e]; }
            else { gm2[e] = first ? 0.f : prv[3 * DFF + e]; gm1[e] = cur[e]; g0[e] = cur[DFF + e]; }
            up[e] = SU[((size_t)pm * 2 + j) * DFF + c + e];
        }
        float o[8];
#pragma unroll
        for (int e = 0; e < 8; ++e) { const float y = wc[c + e] * gm2[e] + wc[DFF + c + e] * gm1[e] + wc[2 * DFF + c + e] * g0[e]; o[e] = y * sigmoidf_(y) * up[e]; }
        u32x4 w4; w4.x = cvt_pk_bf16(o[0], o[1]); w4.y = cvt_pk_bf16(o[2], o[3]); w4.z = cvt_pk_bf16(o[4], o[5]); w4.w = cvt_pk_bf16(o[6], o[7]);
        *(u32x4*)(U + (size_t)(pm * 256 + j) * DFF + c) = w4;
    }
}

constexpr int AT_OACC = 0, AT_ML = 256 * 64 * 4, AT_STG = AT_ML + 2048, AT_KSTR = 144, AT_WSTG = 2 * 32 * AT_KSTR, AT_PSC = 0;
__device__ __forceinline__ int at_swz(int ql) { return (ql ^ (ql >> 4)) & 15; }
static_assert(AT_STG + NWAVES * AT_WSTG <= MISC_OFF && NWAVES * 2048 <= AT_ML, "attention LDS");
__device__ __forceinline__ int crow(int r, int hi) { return (r & 3) + 8 * (r >> 2) + 4 * hi; }

struct AttnRes { f32x16 o0, o1; float m, l; };
#define AT_KLOAD(X, kk_, vv_) _Pragma("unroll") for (int j = 0; j < 4; ++j) { const int kv_ = (lane >> 3) + 8 * j; const int sv_ = kb##X + kv_ < 0 ? 0 : kb##X + kv_; \
        const unsigned ro_ = (unsigned)((cls##X + dil##X * sv_) * D + (lane & 7) * 8) * 2u; kk_[j] = *(const u32x4*)((const char*)Kh + ro_); vv_[j] = *(const u32x4*)((const char*)Vh + ro_); }
#define AT_CB() asm volatile("" ::: "memory")
__device__ __forceinline__ void attn_task2(const bf16_t* Qh, const bf16_t* Kh, const bf16_t* Vh, float slope2,
                                           int dilA, int clsA, int s0A, int nqA, int dilB, int clsB, int s0B, int nqB,
                                           LAS unsigned char* lds, int wave, int lane, AttnRes& RA, AttnRes& RB) {
    asm volatile("" : "+v"(lane));
    const int r32 = lane & 31, hi = lane >> 5;
    const int qa_ = r32 < nqA ? r32 : nqA - 1, qb_ = r32 < nqB ? r32 : nqB - 1;
    const bf16_t* qpA = Qh + (size_t)(clsA + dilA * (s0A + qa_)) * D + hi * 8; const bf16_t* qpB = Qh + (size_t)(clsB + dilB * (s0B + qb_)) * D + hi * 8;
    bf16x8 qrA[4], qrB[4];
#pragma unroll
    for (int d0 = 0; d0 < 4; ++d0) { qrA[d0] = *(const bf16x8*)(qpA + d0 * 16); qrB[d0] = *(const bf16x8*)(qpB + d0 * 16); }
    float mA = -INFINITY, lA = 0.f, mB = -INFINITY, lB = 0.f;
    f32x16 oA0 = f32x16{}, oA1 = f32x16{}, oB0 = f32x16{}, oB1 = f32x16{};
    LAS unsigned char* kst = lds + AT_STG + wave * AT_WSTG; LAS unsigned char* vst = kst + 32 * AT_KSTR;
    const float sdA = slope2 * (float)dilA, sdB = slope2 * (float)dilB;
    const float lbase = (float)(r32 - 4 * hi + 128);
    const int ifA = s0A < 128 ? (128 - s0A) >> 5 : 0, ifB = s0B < 128 ? (128 - s0B) >> 5 : 0, imin = ifA < ifB ? ifA : ifB;
    const int vb = ((lane >> 4) & 1) * 32 + (lane & 3) * 8 + (4 * hi + ((lane & 15) >> 2)) * 64;
#pragma clang loop unroll(disable)
    for (int i = 4; i >= imin; --i) {
        const int kbA = s0A - 128 + 32 * i, kbB = s0B - 128 + 32 * i;
        u32x4 kkA[4], vvA[4], kkB[4], vvB[4];
        AT_KLOAD(A, kkA, vvA)
        AT_KLOAD(B, kkB, vvB)
        bf16x8 kfA[4], kfB[4]; s16x4 tlA[4], thA[4];
#pragma unroll
        for (int j = 0; j < 4; ++j) *(LAS u32x4*)(kst + ((lane >> 3) + 8 * j) * AT_KSTR + (lane & 7) * 16) = kkA[j];
        AT_CB();
#pragma unroll
        for (int d0 = 0; d0 < 4; ++d0) kfA[d0] = *(const LAS bf16x8*)(kst + r32 * AT_KSTR + d0 * 32 + hi * 16);
        AT_CB();
#pragma unroll
        for (int j = 0; j < 4; ++j) *(LAS u32x4*)(kst + ((lane >> 3) + 8 * j) * AT_KSTR + (lane & 7) * 16) = kkB[j];
        AT_CB();
#pragma unroll
        for (int d0 = 0; d0 < 4; ++d0) kfB[d0] = *(const LAS bf16x8*)(kst + r32 * AT_KSTR + d0 * 32 + hi * 16);
        AT_CB();
#pragma unroll
        for (int j = 0; j < 4; ++j) { const int kv = (lane >> 3) + 8 * j, part = lane & 7; const int off_ = (part >> 2) * 2048 + (kv >> 3) * 512 + (kv & 7) * 64 + (part & 3) * 16;
            *(LAS u32x4*)(kst + off_) = vvA[j]; *(LAS u32x4*)(vst + off_) = vvB[j]; }
        AT_CB();
#pragma unroll
        for (int q = 0; q < 4; ++q) { tlA[q] = __builtin_bit_cast(s16x4, __builtin_amdgcn_ds_read_tr16_b64_v4i16((LAS s16x4*)(kst + vb + (q >> 1) * 2048 + (q & 1) * 1024)));
                                      thA[q] = __builtin_bit_cast(s16x4, __builtin_amdgcn_ds_read_tr16_b64_v4i16((LAS s16x4*)(kst + vb + (q >> 1) * 2048 + (q & 1) * 1024 + 512))); }
        AT_CB();
        f32x16 stA, stB;
        { const float tA = sdA * ((float)(32 * i) - lbase), tB = sdB * ((float)(32 * i) - lbase);
#pragma unroll
          for (int r = 0; r < 16; ++r) { const float c_r = (float)((r & 3) + 8 * (r >> 2)); stA[r] = tA + sdA * c_r; stB[r] = tB + sdB * c_r; } }
#pragma unroll
        for (int d0 = 0; d0 < 4; ++d0) { stA = __builtin_amdgcn_mfma_f32_32x32x16_bf16(kfA[d0], qrA[d0], stA, 0, 0, 0); stB = __builtin_amdgcn_mfma_f32_32x32x16_bf16(kfB[d0], qrB[d0], stB, 0, 0, 0); }
        if (kbA < 0 || kbB < 0) {
            int cminA = (i == 0) ? r32 : 0; cminA = cminA > -kbA ? cminA : -kbA; int cminB = (i == 0) ? r32 : 0; cminB = cminB > -kbB ? cminB : -kbB;
            const int cmax = (i == 4) ? r32 : 31;
            const int loA = cminA - 4 * hi, loB = cminB - 4 * hi, hi_ = cmax - 4 * hi;
#pragma unroll
            for (int r = 0; r < 16; ++r) { const int c = (r & 3) + 8 * (r >> 2); stA[r] = (c >= loA && c <= hi_) ? stA[r] : -INFINITY; stB[r] = (c >= loB && c <= hi_) ? stB[r] : -INFINITY; }
        } else if (i == 4) {
            const int hi_ = r32 - 4 * hi;
#pragma unroll
            for (int r = 0; r < 16; ++r) { const int c = (r & 3) + 8 * (r >> 2); const bool ok = c <= hi_; stA[r] = ok ? stA[r] : -INFINITY; stB[r] = ok ? stB[r] : -INFINITY; }
        } else if (i == 0) {
            const int lo_ = r32 - 4 * hi;
#pragma unroll
            for (int r = 0; r < 16; ++r) { const int c = (r & 3) + 8 * (r >> 2); const bool ok = c >= lo_; stA[r] = ok ? stA[r] : -INFINITY; stB[r] = ok ? stB[r] : -INFINITY; }
        }
        float mxA, mxB;
        { float tA[8], tB[8];
#pragma unroll
          for (int r = 0; r < 8; ++r) { tA[r] = max_raw(stA[2 * r], stA[2 * r + 1]); tB[r] = max_raw(stB[2 * r], stB[2 * r + 1]); }
#pragma unroll
          for (int r = 0; r < 4; ++r) { tA[r] = max_raw(tA[2 * r], tA[2 * r + 1]); tB[r] = max_raw(tB[2 * r], tB[2 * r + 1]); }
          mxA = max_raw(max_raw(tA[0], tA[1]), max_raw(tA[2], tA[3])); mxB = max_raw(max_raw(tB[0], tB[1]), max_raw(tB[2], tB[3])); }
        { auto ra = __builtin_amdgcn_permlane32_swap(__float_as_uint(mxA), __float_as_uint(mxA), false, false); mxA = max_raw(__uint_as_float(ra[0]), __uint_as_float(ra[1]));
          auto rb = __builtin_amdgcn_permlane32_swap(__float_as_uint(mxB), __float_as_uint(mxB), false, false); mxB = max_raw(__uint_as_float(rb[0]), __uint_as_float(rb[1])); }
        if (__any((mxA > mA) || (mxB > mB))) {
            const float nA = max_raw(mA, mxA), nB = max_raw(mB, mxB);
            const float alA = __builtin_amdgcn_exp2f(mA - ((nA == -INFINITY) ? 0.f : nA)), alB = __builtin_amdgcn_exp2f(mB - ((nB == -INFINITY) ? 0.f : nB));
            const float fA = (nA == mA) ? 1.0f : alA, fB = (nB == mB) ? 1.0f : alB;
            lA *= fA; lB *= fB; mA = nA; mB = nB;
#pragma unroll
            for (int r = 0; r < 16; ++r) { oA0[r] *= fA; oA1[r] *= fA; oB0[r] *= fB; oB1[r] *= fB; }
        }
        const float muA = (mA == -INFINITY) ? 0.f : mA, muB = (mB == -INFINITY) ? 0.f : mB;
        f32x2 ps2A = (f32x2){0.f, 0.f}, ps2B = ps2A;
        const f32x2 mu2A = (f32x2){muA, muA}, mu2B = (f32x2){muB, muB};
#pragma unroll
        for (int r = 0; r < 16; r += 2) { const f32x2 dA = (f32x2){stA[r], stA[r + 1]} - mu2A, dB = (f32x2){stB[r], stB[r + 1]} - mu2B;
            const f32x2 pA = (f32x2){__builtin_amdgcn_exp2f(dA.x), __builtin_amdgcn_exp2f(dA.y)}, pB = (f32x2){__builtin_amdgcn_exp2f(dB.x), __builtin_amdgcn_exp2f(dB.y)};
            stA[r] = pA.x; stA[r + 1] = pA.y; stB[r] = pB.x; stB[r + 1] = pB.y; ps2A += pA; ps2B += pB; }
        lA += ps2A.x + ps2A.y; lB += ps2B.x + ps2B.y;
        bf16x8 paA[2], paB[2];
#pragma unroll
        for (int s_ = 0; s_ < 2; ++s_) {
            u32x4 w; w.x = cvt_pk_bf16(stA[8 * s_ + 0], stA[8 * s_ + 1]); w.y = cvt_pk_bf16(stA[8 * s_ + 2], stA[8 * s_ + 3]); w.z = cvt_pk_bf16(stA[8 * s_ + 4], stA[8 * s_ + 5]); w.w = cvt_pk_bf16(stA[8 * s_ + 6], stA[8 * s_ + 7]);
            paA[s_] = __builtin_bit_cast(bf16x8, w);
            w.x = cvt_pk_bf16(stB[8 * s_ + 0], stB[8 * s_ + 1]); w.y = cvt_pk_bf16(stB[8 * s_ + 2], stB[8 * s_ + 3]); w.z = cvt_pk_bf16(stB[8 * s_ + 4], stB[8 * s_ + 5]); w.w = cvt_pk_bf16(stB[8 * s_ + 6], stB[8 * s_ + 7]);
            paB[s_] = __builtin_bit_cast(bf16x8, w); }
#pragma unroll
        for (int s_ = 0; s_ < 2; ++s_) {
            { const int q = s_; const bf16x8 vf = (bf16x8){tlA[q][0], tlA[q][1], tlA[q][2], tlA[q][3], thA[q][0], thA[q][1], thA[q][2], thA[q][3]}; oA0 = __builtin_amdgcn_mfma_f32_32x32x16_bf16(vf, paA[s_], oA0, 0, 0, 0); }
            { const int q = 2 + s_; const bf16x8 vf = (bf16x8){tlA[q][0], tlA[q][1], tlA[q][2], tlA[q][3], thA[q][0], thA[q][1], thA[q][2], thA[q][3]}; oA1 = __builtin_amdgcn_mfma_f32_32x32x16_bf16(vf, paA[s_], oA1, 0, 0, 0); }
        }
        AT_CB();
        s16x4 tlB[4], thB[4];
#pragma unroll
        for (int q = 0; q < 4; ++q) { tlB[q] = __builtin_bit_cast(s16x4, __builtin_amdgcn_ds_read_tr16_b64_v4i16((LAS s16x4*)(vst + vb + (q >> 1) * 2048 + (q & 1) * 1024)));
                                      thB[q] = __builtin_bit_cast(s16x4, __builtin_amdgcn_ds_read_tr16_b64_v4i16((LAS s16x4*)(vst + vb + (q >> 1) * 2048 + (q & 1) * 1024 + 512))); }
        AT_CB();
#pragma unroll
        for (int s_ = 0; s_ < 2; ++s_) {
            { const int q = s_; const bf16x8 vf = (bf16x8){tlB[q][0], tlB[q][1], tlB[q][2], tlB[q][3], thB[q][0], thB[q][1], thB[q][2], thB[q][3]}; oB0 = __builtin_amdgcn_mfma_f32_32x32x16_bf16(vf, paB[s_], oB0, 0, 0, 0); }
            { const int q = 2 + s_; const bf16x8 vf = (bf16x8){tlB[q][0], tlB[q][1], tlB[q][2], tlB[q][3], thB[q][0], thB[q][1], thB[q][2], thB[q][3]}; oB1 = __builtin_amdgcn_mfma_f32_32x32x16_bf16(vf, paB[s_], oB1, 0, 0, 0); }
        }
        AT_CB();
    }
    { auto ra = __builtin_amdgcn_permlane32_swap(__float_as_uint(lA), __float_as_uint(lA), false, false); lA = __uint_as_float(ra[0]) + __uint_as_float(ra[1]);
      auto rb = __builtin_amdgcn_permlane32_swap(__float_as_uint(lB), __float_as_uint(lB), false, false); lB = __uint_as_float(rb[0]) + __uint_as_float(rb[1]); }
    RA.o0 = oA0; RA.o1 = oA1; RA.m = mA; RA.l = lA; RB.o0 = oB0; RB.o1 = oB1; RB.m = mB; RB.l = lB;
}
#undef AT_KLOAD
#undef AT_CB
struct AttnRes3 { f32x4 o[4]; float m, l; };
#define AT3_KLOAD(X, kk_, vv_) _Pragma("unroll") for (int j = 0; j < 4; ++j) { const int kv_ = (lane >> 3) + 8 * j; const int sv_ = kb + kv_ < 0 ? 0 : kb + kv_; \
        const unsigned ro_ = (unsigned)((cls##X + 16 * sv_) * D + (lane & 7) * 8) * 2u; kk_[j] = *(const u32x4*)((const char*)Kh + ro_); vv_[j] = *(const u32x4*)((const char*)Vh + ro_); }
#define AT3_CB() asm volatile("" ::: "memory")
__device__ __forceinline__ void attn_task3(const bf16_t* Qh, const bf16_t* Kh, const bf16_t* Vh, float slope2, int clsA, int clsB, int s0,
                                           LAS unsigned char* lds, int wave, int lane, AttnRes3& RA, AttnRes3& RB) {
    asm volatile("" : "+v"(lane));
    const int q = lane & 15, g = lane >> 4;
    const bf16_t* qpA = Qh + (size_t)(clsA + 16 * (s0 + q)) * D + 8 * g; const bf16_t* qpB = Qh + (size_t)(clsB + 16 * (s0 + q)) * D + 8 * g;
    bf16x8 qrA[2], qrB[2];
#pragma unroll
    for (int dh = 0; dh < 2; ++dh) { qrA[dh] = *(const bf16x8*)(qpA + 32 * dh); qrB[dh] = *(const bf16x8*)(qpB + 32 * dh); }
    float mA = -INFINITY, lA = 0.f, mB = -INFINITY, lB = 0.f;
    f32x4 oA[4], oB[4];
#pragma unroll
    for (int db = 0; db < 4; ++db) { oA[db] = (f32x4){0.f, 0.f, 0.f, 0.f}; oB[db] = oA[db]; }
    LAS unsigned char* kst = lds + AT_STG + wave * AT_WSTG; LAS unsigned char* vst = kst + 32 * AT_KSTR;
    const float sd = slope2 * 16.0f;
    const float lbase = (float)(4 * g - q - 128);
    const int imin = s0 < 128 ? (128 - s0) >> 5 : 0;
    const int woff = (lane >> 3) * AT_KSTR + (lane & 7) * 16;
    const int kfoff = q * AT_KSTR + g * 16;
    const int troff = (4 * g + (q >> 2)) * AT_KSTR + (lane & 3) * 8;
#pragma clang loop unroll(disable)
    for (int i = 4; i >= imin; --i) {
        const int kb = s0 - 128 + 32 * i;
        u32x4 kkA[4], vvA[4], kkB[4], vvB[4];
        AT3_KLOAD(A, kkA, vvA)
        AT3_KLOAD(B, kkB, vvB)
        bf16x8 kfA[2][2], kfB[2][2]; s16x4 tA[4][2], tB[4][2];
#pragma unroll
        for (int j = 0; j < 4; ++j) *(LAS u32x4*)(kst + woff + 8 * j * AT_KSTR) = kkA[j];
        AT3_CB();
#pragma unroll
        for (int h = 0; h < 2; ++h)
#pragma unroll
            for (int dh = 0; dh < 2; ++dh) kfA[h][dh] = *(const LAS bf16x8*)(kst + kfoff + h * 16 * AT_KSTR + dh * 64);
        AT3_CB();
#pragma unroll
        for (int j = 0; j < 4; ++j) *(LAS u32x4*)(kst + woff + 8 * j * AT_KSTR) = kkB[j];
        AT3_CB();
#pragma unroll
        for (int h = 0; h < 2; ++h)
#pragma unroll
            for (int dh = 0; dh < 2; ++dh) kfB[h][dh] = *(const LAS bf16x8*)(kst + kfoff + h * 16 * AT_KSTR + dh * 64);
        AT3_CB();
#pragma unroll
        for (int j = 0; j < 4; ++j) { *(LAS u32x4*)(kst + woff + 8 * j * AT_KSTR) = vvA[j]; *(LAS u32x4*)(vst + woff + 8 * j * AT_KSTR) = vvB[j]; }
        AT3_CB();
#pragma unroll
        for (int db = 0; db < 4; ++db)
#pragma unroll
            for (int hh = 0; hh < 2; ++hh) tA[db][hh] = __builtin_bit_cast(s16x4, __builtin_amdgcn_ds_read_tr16_b64_v4i16((LAS s16x4*)(kst + troff + hh * 16 * AT_KSTR + db * 32)));
        AT3_CB();
        f32x4 sA[2], sB[2];
        { const float t = sd * ((float)(32 * i) + lbase);
          if (i == 0 || i == 4 || kb < 0) {
            int lo = (i == 0) ? q : 0; lo = lo > -kb ? lo : -kb; const int hi_ = (i == 4) ? q : 31;
            const int lo_l = lo - 4 * g, hi_l = hi_ - 4 * g;
#pragma unroll
            for (int h = 0; h < 2; ++h)
#pragma unroll
                for (int e = 0; e < 4; ++e) { const int c = 16 * h + e; const float v = (c >= lo_l && c <= hi_l) ? t + sd * (float)c : -INFINITY; sA[h][e] = v; sB[h][e] = v; }
          } else {
#pragma unroll
            for (int h = 0; h < 2; ++h)
#pragma unroll
                for (int e = 0; e < 4; ++e) { const float v = t + sd * (float)(16 * h + e); sA[h][e] = v; sB[h][e] = v; }
          } }
#pragma unroll
        for (int h = 0; h < 2; ++h)
#pragma unroll
            for (int dh = 0; dh < 2; ++dh) { sA[h] = __builtin_amdgcn_mfma_f32_16x16x32_bf16(kfA[h][dh], qrA[dh], sA[h], 0, 0, 0); sB[h] = __builtin_amdgcn_mfma_f32_16x16x32_bf16(kfB[h][dh], qrB[dh], sB[h], 0, 0, 0); }
        float mxA = fmaxf(fmaxf(fmaxf(sA[0][0], sA[0][1]), fmaxf(sA[0][2], sA[0][3])), fmaxf(fmaxf(sA[1][0], sA[1][1]), fmaxf(sA[1][2], sA[1][3])));
        float mxB = fmaxf(fmaxf(fmaxf(sB[0][0], sB[0][1]), fmaxf(sB[0][2], sB[0][3])), fmaxf(fmaxf(sB[1][0], sB[1][1]), fmaxf(sB[1][2], sB[1][3])));
        { auto a1 = __builtin_amdgcn_permlane16_swap(__float_as_uint(mxA), __float_as_uint(mxA), false, false); mxA = fmaxf(__uint_as_float(a1[0]), __uint_as_float(a1[1]));
          auto a2 = __builtin_amdgcn_permlane32_swap(__float_as_uint(mxA), __float_as_uint(mxA), false, false); mxA = fmaxf(__uint_as_float(a2[0]), __uint_as_float(a2[1]));
          auto b1 = __builtin_amdgcn_permlane16_swap(__float_as_uint(mxB), __float_as_uint(mxB), false, false); mxB = fmaxf(__uint_as_float(b1[0]), __uint_as_float(b1[1]));
          auto b2 = __builtin_amdgcn_permlane32_swap(__float_as_uint(mxB), __float_as_uint(mxB), false, false); mxB = fmaxf(__uint_as_float(b2[0]), __uint_as_float(b2[1])); }
        if (__any((mxA > mA) || (mxB > mB))) {
            const float nA = fmaxf(mA, mxA), nB = fmaxf(mB, mxB);
            const float alA = __builtin_amdgcn_exp2f(mA - ((nA == -INFINITY) ? 0.f : nA)), alB = __builtin_amdgcn_exp2f(mB - ((nB == -INFINITY) ? 0.f : nB));
            const float fA = (nA == mA) ? 1.0f : alA, fB = (nB == mB) ? 1.0f : alB;
            lA *= fA; lB *= fB; mA = nA; mB = nB;
#pragma unroll
            for (int db = 0; db < 4; ++db) { oA[db] *= fA; oB[db] *= fB; }
        }
        const float muA = (mA == -INFINITY) ? 0.f : mA, muB = (mB == -INFINITY) ? 0.f : mB;
        float psA = 0.f, psB = 0.f;
#pragma unroll
        for (int h = 0; h < 2; ++h)
#pragma unroll
            for (int e = 0; e < 4; ++e) { const float pA = __builtin_amdgcn_exp2f(sA[h][e] - muA), pB = __builtin_amdgcn_exp2f(sB[h][e] - muB); sA[h][e] = pA; sB[h][e] = pB; psA += pA; psB += pB; }
        lA += psA; lB += psB;
        bf16x8 paA, paB;
        { u32x4 w; w.x = cvt_pk_bf16(sA[0][0], sA[0][1]); w.y = cvt_pk_bf16(sA[0][2], sA[0][3]); w.z = cvt_pk_bf16(sA[1][0], sA[1][1]); w.w = cvt_pk_bf16(sA[1][2], sA[1][3]); paA = __builtin_bit_cast(bf16x8, w);
          w.x = cvt_pk_bf16(sB[0][0], sB[0][1]); w.y = cvt_pk_bf16(sB[0][2], sB[0][3]); w.z = cvt_pk_bf16(sB[1][0], sB[1][1]); w.w = cvt_pk_bf16(sB[1][2], sB[1][3]); paB = __builtin_bit_cast(bf16x8, w); }
#pragma unroll
        for (int db = 0; db < 4; ++db) { const bf16x8 vf = (bf16x8){tA[db][0][0], tA[db][0][1], tA[db][0][2], tA[db][0][3], tA[db][1][0], tA[db][1][1], tA[db][1][2], tA[db][1][3]};
            oA[db] = __builtin_amdgcn_mfma_f32_16x16x32_bf16(vf, paA, oA[db], 0, 0, 0); }
        AT3_CB();
#pragma unroll
        for (int db = 0; db < 4; ++db)
#pragma unroll
            for (int hh = 0; hh < 2; ++hh) tB[db][hh] = __builtin_bit_cast(s16x4, __builtin_amdgcn_ds_read_tr16_b64_v4i16((LAS s16x4*)(vst + troff + hh * 16 * AT_KSTR + db * 32)));
        AT3_CB();
#pragma unroll
        for (int db = 0; db < 4; ++db) { const bf16x8 vf = (bf16x8){tB[db][0][0], tB[db][0][1], tB[db][0][2], tB[db][0][3], tB[db][1][0], tB[db][1][1], tB[db][1][2], tB[db][1][3]};
            oB[db] = __builtin_amdgcn_mfma_f32_16x16x32_bf16(vf, paB, oB[db], 0, 0, 0); }
        AT3_CB();
    }
    lA = pg8::fq_sum(lA); lB = pg8::fq_sum(lB);
#pragma unroll
    for (int db = 0; db < 4; ++db) { RA.o[db] = oA[db]; RB.o[db] = oB[db]; }
    RA.m = mA; RA.l = lA; RB.m = mB; RB.l = lB;
}
#undef AT3_KLOAD
#undef AT3_CB
__device__ __forceinline__ void attn_merge3(const AttnRes3& R, int cls, LAS unsigned char* lds, int lane) {
    asm volatile("" : "+v"(lane));
    const int q = lane & 15, g = lane >> 4;
    const int ql = cls + 16 * q, g4 = at_swz(ql);
    LAS f32x4* oa = (LAS f32x4*)(lds + AT_OACC) + ql * 16;
    LAS float* ml = (LAS float*)(lds + AT_ML) + ql * 2;
    const float m_old = ml[0], l_old = ml[1]; const float m_new = fmaxf(m_old, R.m); const float mu = (m_new == -INFINITY) ? 0.f : m_new;
    const float a_old = __builtin_amdgcn_exp2f(m_old - mu), a_new = __builtin_amdgcn_exp2f(R.m - mu), l_new = l_old * a_old + R.l * a_new;
    f32x4 pv[4];
#pragma unroll
    for (int db = 0; db < 4; ++db) pv[db] = oa[(4 * db + g) ^ g4];
#pragma unroll
    for (int db = 0; db < 4; ++db) oa[(4 * db + g) ^ g4] = R.o[db] * a_new + pv[db] * a_old;
    asm volatile("s_waitcnt lgkmcnt(0)" ::: "memory");
    if (g == 0) { ml[0] = m_new; ml[1] = l_new; }
}
__device__ __forceinline__ void attn_merge(const AttnRes& R, int nq, int qlbase, int qlstep, bool first, LAS unsigned char* lds, int lane) {
    asm volatile("" : "+v"(lane));
    const int r32 = lane & 31, hi = lane >> 5;
    if (r32 < nq) {
        const int ql = qlbase + qlstep * r32, g4 = at_swz(ql);
        LAS f32x4* oa = (LAS f32x4*)(lds + AT_OACC) + ql * 16;
        LAS float* ml = (LAS float*)(lds + AT_ML) + ql * 2;
        float a_old = 0.f, a_new = 1.f, m_new = R.m, l_new = R.l;
        if (!first) { const float m_old = ml[0], l_old = ml[1]; m_new = fmaxf(m_old, R.m); const float mu = (m_new == -INFINITY) ? 0.f : m_new;
            a_old = __builtin_amdgcn_exp2f(m_old - mu); a_new = __builtin_amdgcn_exp2f(R.m - mu); l_new = l_old * a_old + R.l * a_new; }
        f32x4 p0[4], p1[4];
        if (!first) {
#pragma unroll
            for (int g = 0; g < 4; ++g) { const int c0 = (2 * g + hi) ^ g4; p0[g] = oa[c0]; p1[g] = oa[c0 ^ 8]; } }
#pragma unroll
        for (int g = 0; g < 4; ++g) { const int c0 = (2 * g + hi) ^ g4;
            f32x4 n0 = (f32x4){R.o0[4 * g], R.o0[4 * g + 1], R.o0[4 * g + 2], R.o0[4 * g + 3]} * a_new, n1 = (f32x4){R.o1[4 * g], R.o1[4 * g + 1], R.o1[4 * g + 2], R.o1[4 * g + 3]} * a_new;
            if (!first) { n0 += p0[g] * a_old; n1 += p1[g] * a_old; }
            oa[c0] = n0; oa[c0 ^ 8] = n1; }
        asm volatile("s_waitcnt lgkmcnt(0)" ::: "memory");
        if (hi == 0) { ml[0] = m_new; ml[1] = l_new; }
    }
}

__device__ __forceinline__ void p8_attention(const Args& a, LAS unsigned char* lds, int tid, int lane, int wave, int mode) {
    unsigned char* ws = a.ws;
    const bf16_t* Q = (const bf16_t*)(ws + WS_Q); const bf16_t* K = (const bf16_t*)(ws + WS_K); const bf16_t* V = (const bf16_t*)(ws + WS_V); bf16_t* O = (bf16_t*)(ws + WS_AB);
    if (mode & 1) {
        const float* QS = (const float*)(ws + WS_QS);
        LAS float* psc = (LAS float*)(lds + AT_PSC + wave * 2048);
        for (int task = blockIdx.x * NWAVES + wave; task < NSB * NH * NST; task += gridDim.x * NWAVES) {
            const int sb = task / (NH * NST), h = (task / NST) % NH, j = task % NST;
            const float slope2 = exp2f(-0.5f * (float)(h + 1)) * LOG2E;
            const float* kc = a.in[4] + (size_t)sb * LBUF * D + h * HD; const float* vc = a.in[5] + (size_t)sb * LBUF * D + h * HD;
            const float* kn = a.out + O_SK + ((size_t)sb * LBUF + (LBUF - NST)) * D + h * HD; const float* vn = a.out + O_SV + ((size_t)sb * LBUF + (LBUF - NST)) * D + h * HD;
            const float* qrow = QS + (size_t)(sb * NST + j) * D + h * HD;
            const int kg = lane >> 4, dc = lane & 15;
            const f32x4 q4 = *(const f32x4*)(qrow + 4 * dc);
            float mx = -INFINITY;
#pragma clang loop unroll(disable)
            for (int k0 = 0; k0 < 387; k0 += 64) {
                f32x4 kr4[16];
#pragma unroll
                for (int u = 0; u < 16; ++u) { const int kk = k0 + 4 * u + kg; const int kc_ = kk < 387 ? kk : 386;
                    const int g = kc_ / 129, mm = kc_ % 129, dil = (g == 0) ? 1 : (g == 1 ? 4 : 16); const int idx = LBUF + j - mm * dil;
                    const float* kr = (idx >= LBUF) ? kn + (size_t)(idx - LBUF) * D : kc + (size_t)idx * D;
                    kr4[u] = __builtin_nontemporal_load((const f32x4*)(kr + 4 * dc)); }
#pragma unroll
                for (int u = 0; u < 16; ++u) { const int kk = k0 + 4 * u + kg; const int kc_ = kk < 387 ? kk : 386;
                    const int g = kc_ / 129, mm = kc_ % 129, dil = (g == 0) ? 1 : (g == 1 ? 4 : 16);
                    float t = (q4.x * kr4[u].x + q4.y * kr4[u].y) + (q4.z * kr4[u].z + q4.w * kr4[u].w);
                    t += dppmov<0xB1>(t); t += dppmov<0x4E>(t); t += dppmov<0x141>(t); t += dppmov<0x140>(t);
                    const float sc = (kk < 387) ? t - slope2 * (float)(mm * dil) : -INFINITY;
                    if (dc == 0) psc[kk] = sc;
                    mx = fmaxf(mx, sc); }
            }
            mx = wave_max(mx);
            asm volatile("s_waitcnt lgkmcnt(0)" ::: "memory");
            float l = 0.f;
#pragma clang loop unroll(disable)
            for (int rd = 0; rd < 7; ++rd) { const float p = __builtin_amdgcn_exp2f(psc[rd * 64 + lane] - mx); l += p; psc[rd * 64 + lane] = p; }
            l = wave_sum(l);
            asm volatile("s_waitcnt lgkmcnt(0)" ::: "memory");
            f32x4 acc4 = (f32x4){0.f, 0.f, 0.f, 0.f};
#pragma clang loop unroll(disable)
            for (int k0 = 0; k0 < 387; k0 += 64) {
                f32x4 vr4[16]; float pk[16];
#pragma unroll
                for (int u = 0; u < 16; ++u) { const int kk = k0 + 4 * u + kg; const int kc_ = kk < 387 ? kk : 386;
                    const int g = kc_ / 129, mm = kc_ % 129, dil = (g == 0) ? 1 : (g == 1 ? 4 : 16); const int idx = LBUF + j - mm * dil;
                    const float* vr = (idx >= LBUF) ? vn + (size_t)(idx - LBUF) * D : vc + (size_t)idx * D;
                    vr4[u] = __builtin_nontemporal_load((const f32x4*)(vr + 4 * dc)); pk[u] = kk < 387 ? psc[kc_] : 0.f; }
#pragma unroll
                for (int u = 0; u < 16; ++u) acc4 += vr4[u] * pk[u];
            }
#pragma unroll
            for (int e = 0; e < 4; ++e) { acc4[e] += __shfl_xor(acc4[e], 16); acc4[e] += __shfl_xor(acc4[e], 32); }
            const float il = __builtin_amdgcn_rcpf(l);
            if (lane < 16) { u32x2 w; w.x = cvt_pk_bf16(acc4[0] * il, acc4[1] * il); w.y = cvt_pk_bf16(acc4[2] * il, acc4[3] * il);
                *(u32x2*)(O + (size_t)(MPR + sb * NST + j) * D + h * HD + 4 * dc) = w; }
            asm volatile("s_waitcnt lgkmcnt(0)" ::: "memory");
        }
    }
    __syncthreads();
    if (mode & 2) {
    const int nun = NB * NH * 8, per_round = gridDim.x;
    for (int u0 = blockIdx.x; u0 < nun; u0 += per_round) {
        int u = u0;
        if ((gridDim.x & 7) == 0 && nun % (int)gridDim.x == 0) { const int x = blockIdx.x & 7, slot = blockIdx.x >> 3, spx = gridDim.x >> 3, rnd = u0 / per_round, j = rnd * spx + slot; u = x * (nun >> 3) + j;
            const int sq = u & 7, r4 = rnd & 3, qb = (r4 == 0) ? sq : (r4 == 1) ? 7 - sq : (r4 == 2) ? ((sq + 4) & 7) : ((3 - sq) & 7); u = (u & ~7) | qb; }
        const int qblk = u & 7, h = (u >> 3) & 15, b = u >> 7;
        const float slope2 = exp2f(-0.5f * (float)(h + 1)) * LOG2E;
        const bf16_t* Qh = Q + (size_t)b * SEQ * D + h * HD; const bf16_t* Kh = K + (size_t)b * SEQ * D + h * HD; const bf16_t* Vh = V + (size_t)b * SEQ * D + h * HD;
        {
            AttnRes RA, RB;
            attn_task2(Qh, Kh, Vh, slope2, 1, 0, 256 * qblk + 32 * wave, 32, 4, wave & 3, 64 * qblk + 32 * (wave >> 2), 32, lds, wave, lane, RA, RB);
            attn_merge(RA, 32, 32 * wave, 1, true, lds, lane);
            __syncthreads();
            attn_merge(RB, 32, (wave & 3) + 128 * (wave >> 2), 4, false, lds, lane);
            __syncthreads();
            AttnRes3 R3A, R3B;
            attn_task3(Qh, Kh, Vh, slope2, 2 * wave, 2 * wave + 1, 16 * qblk, lds, wave, lane, R3A, R3B);
            attn_merge3(R3A, 2 * wave, lds, lane);
            attn_merge3(R3B, 2 * wave + 1, lds, lane);
            __syncthreads();
        }
        {
            const int ql = tid >> 1, dh = (tid & 1) * 32, hb = (tid & 1) * 8, g4 = at_swz(ql);
            const LAS f32x4* oa = (const LAS f32x4*)(lds + AT_OACC) + ql * 16;
            const float inv = __builtin_amdgcn_rcpf(((const LAS float*)(lds + AT_ML))[ql * 2 + 1]);
            bf16_t* op = O + (size_t)(b * SEQ + 256 * qblk + ql) * D + h * HD + dh;
            f32x4 x[8];
#pragma unroll
            for (int e = 0; e < 8; ++e) x[e] = oa[(hb + e) ^ g4];
#pragma unroll
            for (int e = 0; e < 4; ++e) { const f32x4 x0 = x[2 * e] * inv, x1 = x[2 * e + 1] * inv; u32x4 w; w.x = cvt_pk_bf16(x0[0], x0[1]); w.y = cvt_pk_bf16(x0[2], x0[3]);
                w.z = cvt_pk_bf16(x1[0], x1[1]); w.w = cvt_pk_bf16(x1[2], x1[3]); *(u32x4*)(op + 8 * e) = w; }
        }
        __syncthreads();
    }
    }
}

__device__ __forceinline__ void p13_final(const Args& a, int gw, int NGW, int lane) {
    const bf16_t* HBp = (const bf16_t*)(a.ws + WS_HB); const float* g = a.in[9];
    f32x4 gv[4];
#pragma unroll
    for (int j = 0; j < 4; ++j) gv[j] = ((const f32x4*)g)[64 * j + lane];
    for (int r0 = gw; r0 < MTOT; r0 += 2 * NGW) {
        f32x4 v[2][4];
#pragma unroll
        for (int h = 0; h < 2; ++h) { const int r = r0 + h * NGW; const int rc = r < MTOT ? r : r0; const u32x2* xr = (const u32x2*)(HBp + (size_t)rc * D) + lane;
#pragma unroll
            for (int j = 0; j < 4; ++j) { const u32x2 b = xr[64 * j]; v[h][j] = (f32x4){bflo(b.x), bfhi(b.x), bflo(b.y), bfhi(b.y)}; } }
#pragma unroll
        for (int h = 0; h < 2; ++h) { const int r = r0 + h * NGW; if (r >= MTOT) continue; float s = 0.f;
#pragma unroll
            for (int j = 0; j < 4; ++j) s += (v[h][j].x * v[h][j].x + v[h][j].y * v[h][j].y) + (v[h][j].z * v[h][j].z + v[h][j].w * v[h][j].w);
            const float rstd = rsqrtf(wave_sum(s) * (1.0f / D) + RMS_EPS);
            f32x4* o = (f32x4*)(a.out + (size_t)r * D) + lane;
#pragma unroll
            for (int j = 0; j < 4; ++j) __builtin_nontemporal_store(v[h][j] * rstd * gv[j], o + 64 * j); }
    }
}

__device__ __forceinline__ void sample_gemm_qkv(LAS unsigned char* lds, const bf16_t* A, const bf16_t* Bt, const float* ssq, bf16_t* QKV, float* QS, float* out, int tid, int lane, int wave) {
    constexpr int K = D, KPW = K / 32 / 8, NCB = 3, nitems = (3 * D / 16 / NCB) * 4;
    LAS f32x4* red = (LAS f32x4*)lds;
    for (int it = blockIdx.x; it < nitems; it += gridDim.x) {
        const int cg = it >> 2, rq = it & 3;
        const bf16_t* ap = A + (size_t)(32 * rq + (lane & 15)) * K + wave * KPW * 32 + 8 * (lane >> 4);
        const bf16_t* bp = Bt + (size_t)(16 * NCB * cg + (lane & 15)) * K + wave * KPW * 32 + 8 * (lane >> 4);
        bf16x8 bw[NCB][KPW], a0[KPW], a1[KPW];
#pragma unroll
        for (int ks = 0; ks < KPW; ++ks) { a0[ks] = *(const bf16x8*)(ap + ks * 32); a1[ks] = *(const bf16x8*)(ap + (size_t)16 * K + ks * 32);
#pragma unroll
            for (int cb = 0; cb < NCB; ++cb) bw[cb][ks] = *(const bf16x8*)(bp + (size_t)cb * 16 * K + ks * 32); }
#pragma unroll
        for (int cb = 0; cb < NCB; ++cb) { f32x4 acc0 = (f32x4){0.f, 0.f, 0.f, 0.f}, acc1 = acc0;
#pragma unroll
            for (int ks = 0; ks < KPW; ++ks) { acc0 = __builtin_amdgcn_mfma_f32_16x16x32_bf16(bw[cb][ks], a0[ks], acc0, 0, 0, 0); acc1 = __builtin_amdgcn_mfma_f32_16x16x32_bf16(bw[cb][ks], a1[ks], acc1, 0, 0, 0); }
            red[((cb * 8 + wave) * 2 + 0) * 64 + lane] = acc0; red[((cb * 8 + wave) * 2 + 1) * 64 + lane] = acc1; }
        __syncthreads();
        if (tid < 128 * NCB) {
            const int cb = tid >> 7, rb = (tid >> 6) & 1, ln = tid & 63;
            f32x4 v = red[((cb * 8) * 2 + rb) * 64 + ln];
#pragma unroll
            for (int w = 1; w < 8; ++w) v += red[((cb * 8 + w) * 2 + rb) * 64 + ln];
            const int rs = 32 * rq + 16 * rb + (ln & 15), fq = ln >> 4;
            const int cbk = NCB * cg + cb, c = 16 * cbk + 4 * fq;
            const int which = cbk >> 6, c1 = c - which * D;
            const float rstd = pg8::row_rstd(ssq, MPR + rs, fq) * (which == 0 ? QSCALE : 1.0f);
            const f32x4 o = v * rstd;
            u32x2 w2; w2.x = cvt_pk_bf16(o[0], o[1]); w2.y = cvt_pk_bf16(o[2], o[3]);
            *(u32x2*)(QKV + (size_t)which * ((WS_K - WS_Q) / 2) + (size_t)(MPR + rs) * D + c1) = w2;
            float* fp = (which == 0) ? QS + (size_t)rs * D + c1 : out + (which == 1 ? O_SK : O_SV) + ((size_t)(rs >> 2) * LBUF + (LBUF - NST) + (rs & 3)) * D + c1;
            *(f32x4*)fp = o;
        }
        __syncthreads();
    }
}
template <int MODE, int K>
__device__ __forceinline__ void sample_gemm(LAS unsigned char* lds, const bf16_t* A, const bf16_t* Bt, int N, const float* base, float* Hs, bf16_t* HBs, float* ssq,
                                            bf16_t* QKV, float* QS, float* out, int tid, int lane, int wave) {
    constexpr int KPW = K / 32 / 8;
    const int nitems = (N / 16) * 4;
    LAS f32x4* red = (LAS f32x4*)lds;
    for (int it = blockIdx.x; it < nitems; it += gridDim.x) {
        const int cbk = it >> 2, rq = it & 3;
        const bf16_t* bp = Bt + (size_t)(16 * cbk + (lane & 15)) * K + wave * KPW * 32 + 8 * (lane >> 4);
        const bf16_t* ap = A + (size_t)(32 * rq + (lane & 15)) * K + wave * KPW * 32 + 8 * (lane >> 4);
        bf16x8 bw[KPW], a0[KPW], a1[KPW];
#pragma unroll
        for (int ks = 0; ks < KPW; ++ks) { bw[ks] = *(const bf16x8*)(bp + ks * 32); a0[ks] = *(const bf16x8*)(ap + ks * 32); a1[ks] = *(const bf16x8*)(ap + (size_t)16 * K + ks * 32); }
        f32x4 acc0 = (f32x4){0.f, 0.f, 0.f, 0.f}, acc1 = acc0;
#pragma unroll
        for (int ks = 0; ks < KPW; ++ks) { acc0 = __builtin_amdgcn_mfma_f32_16x16x32_bf16(bw[ks], a0[ks], acc0, 0, 0, 0); acc1 = __builtin_amdgcn_mfma_f32_16x16x32_bf16(bw[ks], a1[ks], acc1, 0, 0, 0); }
        red[(wave * 2 + 0) * 64 + lane] = acc0; red[(wave * 2 + 1) * 64 + lane] = acc1;
        __syncthreads();
        if (tid < 128) {
            const int rb = tid >> 6, ln = tid & 63;
            f32x4 v = red[rb * 64 + ln];
#pragma unroll
            for (int w = 1; w < 8; ++w) v += red[(w * 2 + rb) * 64 + ln];
            const int rs = 32 * rq + 16 * rb + (ln & 15), fq = ln >> 4;
            const int c = 16 * cbk + 4 * fq;
            if (MODE == 0) {
                const u32x2 b2 = *(const u32x2*)(HBs + (size_t)rs * D + c);
                const f32x4 h = (f32x4){bflo(b2.x), bfhi(b2.x), bflo(b2.y), bfhi(b2.y)} + v;
                u32x2 w2; w2.x = cvt_pk_bf16(h[0], h[1]); w2.y = cvt_pk_bf16(h[2], h[3]); *(u32x2*)(HBs + (size_t)rs * D + c) = w2;
                float q = (h[0] * h[0] + h[1] * h[1]) + (h[2] * h[2] + h[3] * h[3]);
                q += __shfl_xor(q, 16); q += __shfl_xor(q, 32);
                if (fq == 0) ssq[(size_t)(MPR + rs) * 64 + cbk] = q;
            } else {
                const int which = cbk >> 6, c1 = c - which * D;
                const float rstd = pg8::row_rstd(ssq, MPR + rs, fq) * (which == 0 ? QSCALE : 1.0f);
                const f32x4 o = v * rstd;
                u32x2 w2; w2.x = cvt_pk_bf16(o[0], o[1]); w2.y = cvt_pk_bf16(o[2], o[3]);
                *(u32x2*)(QKV + (size_t)which * ((WS_K - WS_Q) / 2) + (size_t)(MPR + rs) * D + c1) = w2;
                float* fp = (which == 0) ? QS + (size_t)rs * D + c1 : out + (which == 1 ? O_SK : O_SV) + ((size_t)(rs >> 2) * LBUF + (LBUF - NST) + (rs & 3)) * D + c1;
                *(f32x4*)fp = o;
            }
        }
        __syncthreads();
    }
}

#define XB_TMO      128
#define XB_XCNT(j)  (256  + 64 * (j))
#define XB_XSUB(j)  (1280 + 64 * (j))
#define XB_XGEN(j)  (2304 + 64 * (j))
#define XB_TOP      3328
#define XB_TOPGEN   3392
#define XCD_BAR_WORDS 3456
#define XB_SPIN_CAP (1u << 18)
__device__ __forceinline__ unsigned xb_ld(unsigned* p)              { return __hip_atomic_load(p, __ATOMIC_RELAXED, __HIP_MEMORY_SCOPE_AGENT); }
__device__ __forceinline__ unsigned xb_add(unsigned* p, unsigned v) { return __hip_atomic_fetch_add(p, v, __ATOMIC_RELAXED, __HIP_MEMORY_SCOPE_AGENT); }
__device__ __forceinline__ unsigned xb_xcc_id() { return (unsigned)__builtin_amdgcn_s_getreg((3 << 11) | 20) & 0xFu; }
#define XB_SPIN(cond, bar) do { unsigned _sp = 0; while (cond) { __builtin_amdgcn_s_sleep(1); \
    if ((++_sp & 255u) == 0u) { if (xb_ld(&(bar)[XB_TMO])) break; if (_sp > XB_SPIN_CAP) { atomicAdd(&(bar)[XB_TMO], 1u); break; } } } } while (0)
__device__ __forceinline__ void xcd_barrier_complete(unsigned* bar, unsigned x, unsigned& nloc, unsigned& nx) {
    const unsigned G = gridDim.x * gridDim.y * gridDim.z;
    unsigned sum, cnt, mine, sp = 0u;
    for (;;) {
        sum = 0u; cnt = 0u; mine = 0u;
#pragma unroll
        for (unsigned j = 0; j < 16; ++j) { const unsigned c = xb_ld(&bar[XB_XCNT(j)]); sum += c; cnt += (c > 0u) ? 1u : 0u; mine = (j == x) ? c : mine; }
        if (sum == G) break;
        __builtin_amdgcn_s_sleep(1);
        if ((++sp & 255u) == 0u) { if (xb_ld(&bar[XB_TMO])) break; if (sp > XB_SPIN_CAP) { atomicAdd(&bar[XB_TMO], 1u); break; } }
    }
    nloc = mine > 0u ? mine : 1u; nx = cnt > 0u ? cnt : 1u;
}
__device__ __forceinline__ void xcd_barrier(unsigned* bar, volatile LAS unsigned* st, int wave0) {
    asm volatile("s_waitcnt vmcnt(0)" ::: "memory");
    __syncthreads();
    if (wave0 == 0 && lane_id() == 0) {
        const unsigned x = xb_xcc_id();
        __builtin_amdgcn_s_waitcnt(0);
        unsigned nloc = st[0], nx = st[1];
        if (nloc == 0u) { xcd_barrier_complete(bar, x, nloc, nx); st[0] = nloc; st[1] = nx; }
        const unsigned old = xb_add(&bar[XB_XSUB(x)], 1u);
        const unsigned gen = old / nloc;
        if (old + 1u == (gen + 1u) * nloc) {
            __builtin_amdgcn_fence(__ATOMIC_RELEASE, "agent");
            asm volatile("s_waitcnt vmcnt(0)" ::: "memory");
            const unsigned og = xb_add(&bar[XB_TOP], 1u);
            const unsigned tg = og / nx;
            if (og + 1u == (tg + 1u) * nx) xb_add(&bar[XB_TOPGEN], 1u);
            else XB_SPIN(xb_ld(&bar[XB_TOPGEN]) == tg, bar);
            __builtin_amdgcn_fence(__ATOMIC_ACQUIRE, "agent");
            xb_add(&bar[XB_XGEN(x)], 1u);
            asm volatile("s_waitcnt vmcnt(0)" ::: "memory");
        } else {
            XB_SPIN(xb_ld(&bar[XB_XGEN(x)]) == gen, bar);
            __builtin_amdgcn_fence(__ATOMIC_ACQUIRE, "agent");
            asm volatile("s_waitcnt vmcnt(0)" ::: "memory");
        }
    }
    __syncthreads();
}

typedef const __attribute__((address_space(4))) Args* kargp_t;
__device__ __forceinline__ Args kargs() {
    Args a;
#if defined(__HIP_DEVICE_COMPILE__)
    kargp_t p = (kargp_t)__builtin_amdgcn_kernarg_segment_ptr(); asm volatile("" : "+s"(p));
#pragma unroll
    for (int i = 0; i < 22; ++i) a.in[i] = p->in[i];
    a.out = p->out; a.ws = p->ws;
#else
    for (int i = 0; i < 22; ++i) a.in[i] = nullptr;
    a.out = nullptr; a.ws = nullptr;
#endif
    return a;
}
#define PHASE_BEGIN const Args a = kargs(); unsigned char* ws = a.ws; const int wave = wave0, lane = lane_id(), tid = wave * 64 + lane; \
    const int G = gridDim.x, gw = blockIdx.x * NWAVES + wave, NGW = G * NWAVES; (void)ws; (void)lane; (void)gw; (void)NGW; (void)G;
__global__ void __launch_bounds__(NTHREADS, 2) mega_fwd(Args a_unused) {
    extern __shared__ __attribute__((aligned(16))) unsigned char lds_raw[];
    LAS unsigned char* lds = (LAS unsigned char*)lds_raw;
    cg::grid_group grid = cg::this_grid();
    volatile LAS unsigned* bst = (volatile LAS unsigned*)(lds + MISC_OFF + 64);
    const int wave0 = __builtin_amdgcn_readfirstlane((int)threadIdx.x >> 6);
    { unsigned* ctl0 = (unsigned*)kargs().ws; if (threadIdx.x == 0) { bst[0] = 0u; bst[1] = 0u; (void)xb_add(&ctl0[XB_XCNT(xb_xcc_id())], 1u); } }
    __syncthreads();
    grid.sync();
#define GRID_BAR() do { unsigned* ctl_ = (unsigned*)kargs().ws; xcd_barrier(ctl_, bst, wave0); } while (0)
#ifndef PHASES
#define PHASES 0xFFFF
#endif
#define PH(k) if constexpr (((PHASES) >> (k)) & 1)
#define REP_ALL 1
#define REP_P0 1
#define REP_P1 1
#define REP_P2 1
#define REP_P3 1
#define REP_P4 1
#define REP_P6 1
#define PROBE_SKIP_EPI 0
#define REP_P7 1
#define REP_P8 1
#define REP_P8S 1
#define REP_P13 1
#define REPEAT(n) for (int rep_ = 0; rep_ < (n); ++rep_)

    for (int rep_all = 0; rep_all < REP_ALL; ++rep_all) {
    if (rep_all) { GRID_BAR(); }
    REPEAT(REP_P0) { PH(0) { PHASE_BEGIN p0_prologue(a, lds, gw, NGW, lane, wave); } if (rep_ + 1 < REP_P0) { GRID_BAR(); } }
    GRID_BAR();
    REPEAT(REP_P1) { if (rep_) { GRID_BAR(); } PH(1) {
        PHASE_BEGIN
        const int ge = (G == 256) ? GE_P1 : G;
        if ((int)blockIdx.x < ge) {
        pg8::Gemm g{(const bf16_t*)(ws + WS_HB), (const bf16_t*)(ws + WS_WIN), MPAD, NIN, D, wave}; pg8::StaticOrder S; S.init(MPAD, NIN, ge, (int)blockIdx.x);
        pg8::EpiInAB E{(bf16_t*)(ws + WS_GA), (const float*)(ws + WS_SSQ), a.out};
        pg8::gemm_phase<pg8::EpiInAB, pg8::StaticOrder, true, true>(lds, g, S, E);
        } else { p0_weights(a, lds, WI_IN, WI_TOT, ((int)blockIdx.x - ge) * NWAVES + wave, (G - ge) * NWAVES, lane_id(), wave); copy_range<256 - GE_P1>(a, CP_C0, CP_C1, (int)blockIdx.x - ge, wave); }
        if (ge == G && rep_ == 0) copy_range_simple(a, CP_C0, CP_C1, blockIdx.x, G, wave * 64 + lane_id());
    } }
    GRID_BAR();
    REPEAT(REP_P2) { if (rep_) { GRID_BAR(); } PH(2) { PHASE_BEGIN p2_conv(a, lds, tid, lane, wave);
        if (G == 256 && (int)blockIdx.x >= 32 && rep_ == 0) copy_range<224>(a, CP_P2, CP_C0, (int)blockIdx.x - 32, wave);
    } }
    GRID_BAR();
    REPEAT(REP_P3) { if (rep_) { GRID_BAR(); } PH(3) {
        PHASE_BEGIN
        pg8::Gemm g{(const bf16_t*)(ws + WS_AB), (const bf16_t*)(ws + WS_WOUT), MPR, D, D, wave}; pg8::StaticOrder S; S.init(MPR, D, G, (int)blockIdx.x);
        pg8::EpiResid E{(bf16_t*)(ws + WS_HB), (float*)(ws + WS_SSQ), 0};
        pg8::gemm_phase<pg8::EpiResid, pg8::StaticOrder, true, true>(lds, g, S, E);
        sample_gemm<0, D>(lds, (const bf16_t*)(ws + WS_AB) + (size_t)MPR * D, (const bf16_t*)(ws + WS_WOUT), D, nullptr, nullptr, (bf16_t*)(ws + WS_HB) + (size_t)MPR * D,
                          (float*)(ws + WS_SSQ), nullptr, nullptr, nullptr, tid, lane, wave);
    } }
    GRID_BAR();
#pragma clang loop unroll(disable)
    for (int layer = 0; layer < 2; ++layer) {
        if (layer == 1) {
            REPEAT(REP_P7) { if (rep_) { GRID_BAR(); } PH(7) {
                PHASE_BEGIN
                pg8::Gemm g{(const bf16_t*)(ws + WS_HB), (const bf16_t*)(ws + WS_WQKV), MPR, 3 * D, D, wave}; pg8::StaticOrder S; S.init(MPR, 3 * D, G, (int)blockIdx.x);
                pg8::EpiQkv E{(bf16_t*)(ws + WS_Q), (float*)(ws + WS_QS), (const float*)(ws + WS_SSQ), a.out};
                pg8::gemm_phase<pg8::EpiQkv, pg8::StaticOrder, true, true>(lds, g, S, E);
                sample_gemm_qkv(lds, (const bf16_t*)(ws + WS_HB) + (size_t)MPR * D, (const bf16_t*)(ws + WS_WQKV), (const float*)(ws + WS_SSQ), (bf16_t*)(ws + WS_Q), (float*)(ws + WS_QS), a.out,
                                wave * 64 + lane_id(), lane_id(), wave);
            } }
            GRID_BAR();
            REPEAT(REP_P8) { if (rep_) { GRID_BAR(); } PH(8) { PHASE_BEGIN p8_attention(a, lds, tid, lane, wave, 2); } }
            REPEAT(REP_P8S) { PH(8) { PHASE_BEGIN p8_attention(a, lds, tid, lane, wave, 1); } }
            GRID_BAR();
            PH(9) {
                PHASE_BEGIN
                pg8::Gemm g{(const bf16_t*)(ws + WS_AB), (const bf16_t*)(ws + WS_WO), MPR, D, D, wave}; pg8::StaticOrder S; S.init(MPR, D, G, (int)blockIdx.x);
                pg8::EpiResid E{(bf16_t*)(ws + WS_HB), (float*)(ws + WS_SSQ), 0};
                pg8::gemm_phase<pg8::EpiResid, pg8::StaticOrder, true, true>(lds, g, S, E);
                sample_gemm<0, D>(lds, (const bf16_t*)(ws + WS_AB) + (size_t)MPR * D, (const bf16_t*)(ws + WS_WO), D, nullptr, nullptr, (bf16_t*)(ws + WS_HB) + (size_t)MPR * D,
                                  (float*)(ws + WS_SSQ), nullptr, nullptr, nullptr, tid, lane, wave);
            }
            GRID_BAR();
        }
        REPEAT(REP_P4) { if (rep_) { GRID_BAR(); } PH(4) {
            PHASE_BEGIN
            const int ge = (G == 256) ? GE_FF : G;
            const size_t clo = layer ? CP_C2 : CP_C1, chi = layer ? CP_TOT : CP_C2;
            if ((int)blockIdx.x >= ge) { if (rep_ == 0) copy_range<256 - GE_FF>(a, clo, chi, (int)blockIdx.x - ge, wave); } else {
            pg8::Gemm g{(const bf16_t*)(ws + WS_HB), (const bf16_t*)(ws + (layer ? WS_WF1 : WS_WF0)), MPAD, 2 * DFF, D, wave}; pg8::StaticOrder S; S.init(MPAD, 2 * DFF, ge, (int)blockIdx.x);
            pg8::EpiFfn E{lds, (bf16_t*)(ws + WS_U), (float*)(ws + WS_SG), (float*)(ws + WS_SU), a.in[20] + (size_t)layer * 3 * DFF, (const float*)(ws + WS_SSQ), a.out, a.in[6], layer};
            pg8::gemm_phase<pg8::EpiFfn, pg8::StaticOrder, true, true>(lds, g, S, E);
            }
            if (ge == G && rep_ == 0) copy_range_simple(a, clo, chi, blockIdx.x, G, wave * 64 + lane_id());
        } }
        GRID_BAR();
        REPEAT(REP_P6) { if (rep_) { GRID_BAR(); } PH(6) {
            PHASE_BEGIN
            pg8::Gemm g{(const bf16_t*)(ws + WS_U), (const bf16_t*)(ws + (layer ? WS_WD1 : WS_WD0)), MPR, D, DFF, wave}; pg8::StaticOrder S; S.init(MPR, D, G, (int)blockIdx.x);
            { pg8::Unit u_; for (int i = 0; S.next(i, u_); ++i) panel_fix(a, layer, u_.pm, tid); }
            asm volatile("s_waitcnt vmcnt(0)" ::: "memory"); __syncthreads();
            const bool real_ = (rep_ + 1 == REP_P6);
            pg8::EpiResid E{(bf16_t*)(ws + WS_HB), real_ ? (float*)(ws + WS_SSQ) : (float*)(ws + WS_ZU), real_ ? 0 : 1};
            pg8::gemm_phase<pg8::EpiResid, pg8::StaticOrder, true, true>(lds, g, S, E);
            if (real_) sample_gemm<0, DFF>(lds, (const bf16_t*)(ws + WS_U) + (size_t)MPR * DFF, (const bf16_t*)(ws + (layer ? WS_WD1 : WS_WD0)), D, nullptr, nullptr, (bf16_t*)(ws + WS_HB) + (size_t)MPR * D,
                                (float*)(ws + WS_SSQ), nullptr, nullptr, nullptr, tid, lane, wave);
        } }
        GRID_BAR();
    }
    REPEAT(REP_P13) { if (rep_) { GRID_BAR(); } PH(13) { PHASE_BEGIN p13_final(a, gw, NGW, lane); } }
    }
}

extern "C" void kernel_launch(void* const* d_in, const int* in_sizes, int n_in, void* d_out, int out_size, void* d_ws, size_t ws_size, hipStream_t stream) {
    static int grid = 0;
    if (grid == 0) {
        if (n_in != 22 || (size_t)out_size != O_END || ws_size < WS_END) { fprintf(stderr, "kernel_launch: unexpected shapes (n_in %d, out %d, ws %zu, need %zu)\n", n_in, out_size, ws_size, (size_t)WS_END); grid = -1; return; }
        int dev = 0, cus = 0, per_cu = 0;
        if (hipGetDevice(&dev) != hipSuccess || hipDeviceGetAttribute(&cus, hipDeviceAttributeMultiprocessorCount, dev) != hipSuccess) { grid = -1; return; }
        if (hipFuncSetAttribute((const void*)mega_fwd, hipFuncAttributeMaxDynamicSharedMemorySize, LDS_BYTES) != hipSuccess) { fprintf(stderr, "kernel_launch: hipFuncSetAttribute failed\n"); grid = -1; return; }
        if (hipOccupancyMaxActiveBlocksPerMultiprocessor(&per_cu, (const void*)mega_fwd, NTHREADS, LDS_BYTES) != hipSuccess || per_cu < 1) { fprintf(stderr, "kernel_launch: occupancy query failed (%d)\n", per_cu); (void)hipGetLastError(); grid = -1; return; }
        grid = cus * 1;
    }
    if (grid < 0) return;
    if (hipMemsetAsync((char*)d_ws + WS_CTL, 0, CTL_BYTES, stream) != hipSuccess) { fprintf(stderr, "kernel_launch: memset failed\n"); return; }
    Args a{};
    for (int i = 0; i < 22; ++i) a.in[i] = (const float*)d_in[i];
    a.out = (float*)d_out; a.ws = (unsigned char*)d_ws;
    void* args[] = {&a};
    hipError_t e = hipLaunchCooperativeKernel((const void*)mega_fwd, dim3(grid), dim3(NTHREADS), args, LDS_BYTES, stream);
    if (e != hipSuccess) fprintf(stderr, "cooperative launch failed: %s (grid %d)\n", hipGetErrorString(e), grid);
}
```

```cpp
#include <hip/hip_runtime.h>
#include <hip/hip_cooperative_groups.h>
#include <cstdio>
#include <cstdint>
namespace cg = cooperative_groups;

#define LAS __attribute__((address_space(3)))
typedef unsigned short bf16_t;
typedef short bf16x8 __attribute__((ext_vector_type(8)));
typedef float f32x4 __attribute__((ext_vector_type(4)));
typedef float f32x2 __attribute__((ext_vector_type(2)));
typedef float f32x16 __attribute__((ext_vector_type(16)));
typedef unsigned u32x4 __attribute__((ext_vector_type(4)));
typedef unsigned u32x2 __attribute__((ext_vector_type(2)));
typedef short s16x4 __attribute__((ext_vector_type(4)));

constexpr int D = 1024, SEQ = 2048, NB = 8, MPR = NB * SEQ, NSB = 32, NST = 4, MSA = NSB * NST, MTOT = MPR + MSA, MPAD = 16640;
constexpr int DFF = 2816, NIN = 2560, CH = 512, NH = 16, HD = 64, LBUF = 2048, KA = 31;
constexpr int GAW = 1536;
constexpr float RMS_EPS = 1e-6f, LN_EPS = 1e-5f;
constexpr float LOG2E = 1.4426950408889634f;
constexpr float QSCALE = 0.125f * LOG2E;

constexpr size_t O_YP = 0;
constexpr size_t O_YS = O_YP + (size_t)MPR * D;
constexpr size_t O_PCA = O_YS + (size_t)MSA * D;
constexpr size_t O_SCA = O_PCA + (size_t)NB * 30 * CH;
constexpr size_t O_PCB = O_SCA + (size_t)NSB * 30 * CH;
constexpr size_t O_SCB = O_PCB + (size_t)NB * 2 * CH;
constexpr size_t O_PK = O_SCB + (size_t)NSB * 2 * CH;
constexpr size_t O_SK = O_PK + (size_t)MPR * D;
constexpr size_t O_PV = O_SK + (size_t)NSB * LBUF * D;
constexpr size_t O_SV = O_PV + (size_t)MPR * D;
constexpr size_t O_PF = O_SV + (size_t)NSB * LBUF * D;
constexpr size_t O_SF = O_PF + (size_t)2 * NB * 2 * DFF;
constexpr size_t O_END = O_SF + (size_t)2 * NSB * 2 * DFF;

constexpr size_t al(size_t x) { return (x + 4095) & ~(size_t)4095; }
constexpr size_t WS_CTL = 0, CTL_BYTES = 65536;
constexpr size_t WS_WIN = WS_CTL + CTL_BYTES;
constexpr size_t WS_WOUT = WS_WIN + al((size_t)NIN * D * 2);
constexpr size_t WS_WQKV = WS_WOUT + al((size_t)D * D * 2);
constexpr size_t WS_WO = WS_WQKV + al((size_t)3 * D * D * 2);
constexpr size_t WS_WF0 = WS_WO + al((size_t)D * D * 2);
constexpr size_t WS_WF1 = WS_WF0 + al((size_t)2 * DFF * D * 2);
constexpr size_t WS_WD0 = WS_WF1 + al((size_t)2 * DFF * D * 2);
constexpr size_t WS_WD1 = WS_WD0 + al((size_t)D * DFF * 2);
constexpr size_t WS_HB = WS_WD1 + al((size_t)D * DFF * 2);
constexpr size_t WS_H = WS_HB + al((size_t)MPAD * D * 2);
constexpr size_t WS_SSQ = WS_H + 4096;
constexpr size_t WS_GA = WS_SSQ + al((size_t)MPAD * 64 * 4);
constexpr size_t WS_AB = WS_GA + al((size_t)MPAD * GAW * 2);
constexpr size_t WS_ZG = WS_AB + al((size_t)MPAD * D * 2);
constexpr size_t WS_ZU = WS_ZG + al((size_t)MPAD * DFF * 2);
constexpr size_t WS_U = WS_ZU + al((size_t)MPAD * DFF * 2);
constexpr size_t WS_Q = WS_U + al((size_t)MPAD * DFF * 2);
constexpr size_t WS_K = WS_Q + al((size_t)MPAD * D * 2);
constexpr size_t WS_V = WS_K + al((size_t)MPAD * D * 2);
constexpr size_t WS_QS = WS_V + al((size_t)MPAD * D * 2);
constexpr size_t WS_SG = WS_QS + al((size_t)MSA * D * 4);
constexpr size_t WS_SU = WS_SG + al((size_t)256 * 4 * DFF * 4);
constexpr size_t WS_END = WS_SU + al((size_t)256 * 2 * DFF * 4);
static_assert(WS_V - WS_K == WS_K - WS_Q, "Q|K|V equally spaced");

constexpr int NWAVES = 8, NTHREADS = 512;
constexpr int LDS_BYTES = 163840;
constexpr int MISC_OFF = LDS_BYTES - 1024;

typedef __bf16 bf16x2_t __attribute__((ext_vector_type(2)));
__device__ __forceinline__ unsigned cvt_pk_bf16(float lo, float hi) { return __builtin_bit_cast(unsigned, __builtin_convertvector((f32x2){lo, hi}, bf16x2_t)); }
__device__ __forceinline__ float bf2f(unsigned short b) { return __uint_as_float((unsigned)b << 16); }
__device__ __forceinline__ float bflo(unsigned w) { return __uint_as_float(w << 16); }
__device__ __forceinline__ float bfhi(unsigned w) { return __uint_as_float(w & 0xffff0000u); }
__device__ __forceinline__ float max_raw(float a, float b) { return __builtin_amdgcn_fmed3f(a, b, INFINITY); }
__device__ __forceinline__ float sigmoidf_(float x) { return __builtin_amdgcn_rcpf(1.0f + __expf(-x)); }
__device__ __forceinline__ int launder_v(int x) { asm volatile("" : "+v"(x)); return x; }
__device__ __forceinline__ int lane_id() { int l; asm volatile("v_mbcnt_lo_u32_b32 %0, -1, 0\n\tv_mbcnt_hi_u32_b32 %0, -1, %0" : "=v"(l)); return l; }
template <int CTRL> __device__ __forceinline__ float dppmov(float v) { return __uint_as_float(__builtin_amdgcn_update_dpp(0u, __float_as_uint(v), CTRL, 0xf, 0xf, true)); }
__device__ __forceinline__ float wave_sum(float v) {
    v += dppmov<0xB1>(v);
    v += dppmov<0x4E>(v);
    v += dppmov<0x141>(v);
    v += dppmov<0x140>(v);
    { auto r = __builtin_amdgcn_permlane16_swap(__float_as_uint(v), __float_as_uint(v), false, false); v = __uint_as_float(r[0]) + __uint_as_float(r[1]); }
    { auto r = __builtin_amdgcn_permlane32_swap(__float_as_uint(v), __float_as_uint(v), false, false); v = __uint_as_float(r[0]) + __uint_as_float(r[1]); }
    return v;
}
__device__ __forceinline__ float wave_max(float v) {
    v = fmaxf(v, dppmov<0xB1>(v)); v = fmaxf(v, dppmov<0x4E>(v)); v = fmaxf(v, dppmov<0x141>(v)); v = fmaxf(v, dppmov<0x140>(v));
    { auto r = __builtin_amdgcn_permlane16_swap(__float_as_uint(v), __float_as_uint(v), false, false); v = fmaxf(__uint_as_float(r[0]), __uint_as_float(r[1])); }
    { auto r = __builtin_amdgcn_permlane32_swap(__float_as_uint(v), __float_as_uint(v), false, false); v = fmaxf(__uint_as_float(r[0]), __uint_as_float(r[1])); }
    return v;
}

namespace pg8 {
constexpr int BM = 256, BK = 64, HALF = 128, HTB = HALF * BK * 2, STAGE_BYTES = 8 * HTB, NXCD = 8, WGM = 8;
__host__ __device__ __forceinline__ int lds_byte(int r, int c) { const int st = (r >> 4) * 2 + (c >> 5), rr = r & 15, cc = c & 31, ob = rr * 64 + cc * 2; return st * 1024 + (ob ^ (((ob >> 9) & 1) << 5)); }
__host__ __device__ __forceinline__ void stage_rc(int b, int& R, int& C) { const int st = b / 1024, sb = b % 1024, swz = sb ^ (((sb >> 9) & 1) << 5); R = (st >> 1) * 16 + swz / 64; C = (st & 1) * 32 + (swz % 64) / 2; }
__host__ __device__ __forceinline__ int perm32(int rho) { const int n = rho >> 4, i = rho & 15; return 8 * (i >> 2) + 4 * n + (i & 3); }

struct Unit { int pm, pn; };
struct Gemm { const bf16_t* A; const bf16_t* Bt; int M, N, K, wid; };

struct StaticOrder {
    int nM, nN, nwg, G, c;
    __host__ __device__ __forceinline__ void init(int M, int N, int G_, int c_) { nM = M / BM; nN = N / BM; nwg = nM * nN; G = G_; c = c_; }
    __host__ __device__ __forceinline__ bool next(int i, Unit& u) const {
        const long L = (long)i * G + c; if (L >= nwg) return false;
        int wgid = (int)L; { const int q = nwg / NXCD, r = nwg % NXCD, xcd = wgid % NXCD, off = wgid / NXCD; wgid = (xcd < r ? xcd * (q + 1) : r * (q + 1) + (xcd - r) * q) + off; }
        const int nig = WGM * nN, gid = wgid / nig, fm = gid * WGM, gsz = (nM - fm) < WGM ? (nM - fm) : WGM;
        u.pm = fm + ((wgid % nig) % gsz); u.pn = (wgid % nig) / gsz; return true;
    }
    __device__ __forceinline__ void a_ready(const Unit&) const {}
    __device__ __forceinline__ void done(const Unit&) const {}
};

__device__ __forceinline__ float fq_sum(float x) {
    auto a = __builtin_amdgcn_permlane16_swap(__float_as_uint(x), __float_as_uint(x), false, false); x = __uint_as_float(a[0]) + __uint_as_float(a[1]);
    auto b = __builtin_amdgcn_permlane32_swap(__float_as_uint(x), __float_as_uint(x), false, false); return __uint_as_float(b[0]) + __uint_as_float(b[1]);
}
__device__ __forceinline__ float row_rstd(const float* ssq, int r, int fq) {
    float s;
    if (r < MPR) { const f32x4 p = *(const f32x4*)(ssq + (size_t)r * 64 + 4 * fq); s = (p.x + p.y) + (p.z + p.w); }
    else { const f32x4* pp = (const f32x4*)(ssq + (size_t)r * 64 + 16 * fq); const f32x4 p = (pp[0] + pp[1]) + (pp[2] + pp[3]); s = (p.x + p.y) + (p.z + p.w); }
    return __builtin_amdgcn_rsqf(fq_sum(s) * (1.0f / D) + RMS_EPS);
}

struct EpiInAB {
    static constexpr bool PERM = true, AFTER_DRAIN = false;
    bf16_t* GA; const float* ssq; float* out;
    __device__ __forceinline__ void operator()(const f32x4 (&acc)[2][2][4][2], const Unit& u, int wr, int wc, int fr, int fq) const {
        const int pn = u.pn, colw = wc * 32 + 8 * fq;
        float rsv[2][4];
#pragma unroll
        for (int ai = 0; ai < 2; ++ai)
#pragma unroll
            for (int m = 0; m < 4; ++m) rsv[ai][m] = row_rstd(ssq, u.pm * BM + ai * HALF + wr * 64 + m * 16 + fr, fq);
        asm volatile("" ::: "memory");
#pragma unroll
        for (int ai = 0; ai < 2; ++ai)
#pragma unroll
            for (int m = 0; m < 4; ++m) {
                const int r = u.pm * BM + ai * HALF + wr * 64 + m * 16 + fr;
                const float rs = rsv[ai][m];
                const f32x4 a0 = acc[ai][0][m][0] * rs, a1 = acc[ai][0][m][1] * rs, g0 = acc[ai][1][m][0] * rs, g1 = acc[ai][1][m][1] * rs;
                bf16_t* rowp = GA + (size_t)r * GAW;
                if (pn < 8) {
                    f32x4 v0, v1;
                    if (pn < 4) {
#pragma unroll
                        for (int i = 0; i < 4; ++i) { v0[i] = a0[i] * sigmoidf_(g0[i]); v1[i] = a1[i] * sigmoidf_(g1[i]); }
                    } else { v0 = a0 * g0; v1 = a1 * g1; }
                    const int cl = 128 * (pn & 3) + colw;
                    u32x4 w; w.x = cvt_pk_bf16(v0[0], v0[1]); w.y = cvt_pk_bf16(v0[2], v0[3]); w.z = cvt_pk_bf16(v1[0], v1[1]); w.w = cvt_pk_bf16(v1[2], v1[3]);
                    *(u32x4*)(rowp + (pn < 4 ? 0 : 512) + cl) = w;
                    const int keep = pn < 4 ? 30 : 2;
                    float* sp = nullptr;
                    if (r < MPR) { const int t = r & (SEQ - 1), b = r >> 11; if (t >= SEQ - keep) sp = out + (pn < 4 ? O_PCA : O_PCB) + ((size_t)(b * keep + (t - (SEQ - keep)))) * CH + cl; }
                    else if (r < MTOT) { const int rs_ = r - MPR, sb = rs_ >> 2, j = rs_ & 3; if (j >= NST - keep || keep == 30) sp = out + (pn < 4 ? O_SCA : O_SCB) + ((size_t)(sb * keep + (keep - NST + j))) * CH + cl; }
                    if (sp) { *(f32x4*)sp = v0; *(f32x4*)(sp + 4) = v1; }
                } else {
                    const int c = 1024 + 256 * (pn - 8) + colw;
                    u32x4 w; w.x = cvt_pk_bf16(a0[0], a0[1]); w.y = cvt_pk_bf16(a0[2], a0[3]); w.z = cvt_pk_bf16(a1[0], a1[1]); w.w = cvt_pk_bf16(a1[2], a1[3]);
                    *(u32x4*)(rowp + c) = w;
                    w.x = cvt_pk_bf16(g0[0], g0[1]); w.y = cvt_pk_bf16(g0[2], g0[3]); w.z = cvt_pk_bf16(g1[0], g1[1]); w.w = cvt_pk_bf16(g1[2], g1[3]);
                    *(u32x4*)(rowp + c + 128) = w;
                }
            }
    }
};
struct EpiResid {
    static constexpr bool PERM = true, AFTER_DRAIN = false;
    bf16_t* HB; float* ssq; int skip;
    __device__ __forceinline__ void operator()(const f32x4 (&acc)[2][2][4][2], const Unit& u, int wr, int wc, int fr, int fq) const {
        const int col0 = u.pn * BM + wc * 32 + 8 * fq;
        if (skip) { if (acc[0][0][0][0][0] == 1.2345e-30f) ssq[0] = 0.f; return; }
#pragma unroll
        for (int ai = 0; ai < 2; ++ai) {
            u32x4 bs[4][2];
#pragma unroll
            for (int m = 0; m < 4; ++m) { const int r = u.pm * BM + ai * HALF + wr * 64 + m * 16 + fr; const int rc = r < MTOT ? r : MTOT - 1;
#pragma unroll
                for (int bj = 0; bj < 2; ++bj) bs[m][bj] = *(const u32x4*)(HB + (size_t)rc * D + col0 + bj * HALF); }
            asm volatile("" ::: "memory");
#pragma unroll
            for (int m = 0; m < 4; ++m) {
                const int r = u.pm * BM + ai * HALF + wr * 64 + m * 16 + fr;
                float s = 0.f;
                if (r < MTOT) {
#pragma unroll
                    for (int bj = 0; bj < 2; ++bj) {
                        const u32x4 b = bs[m][bj];
                        const f32x4 v0 = (f32x4){bflo(b.x), bfhi(b.x), bflo(b.y), bfhi(b.y)} + acc[ai][bj][m][0];
                        const f32x4 v1 = (f32x4){bflo(b.z), bfhi(b.z), bflo(b.w), bfhi(b.w)} + acc[ai][bj][m][1];
                        s += ((v0[0] * v0[0] + v0[1] * v0[1]) + (v0[2] * v0[2] + v0[3] * v0[3])) + ((v1[0] * v1[0] + v1[1] * v1[1]) + (v1[2] * v1[2] + v1[3] * v1[3]));
                        u32x4 w; w.x = cvt_pk_bf16(v0[0], v0[1]); w.y = cvt_pk_bf16(v0[2], v0[3]); w.z = cvt_pk_bf16(v1[0], v1[1]); w.w = cvt_pk_bf16(v1[2], v1[3]);
                        *(u32x4*)(HB + (size_t)r * D + col0 + bj * HALF) = w;
                    }
                }
                s = fq_sum(s);
                if (fq == 0 && r < MTOT) ssq[(size_t)r * 64 + u.pn * 4 + wc] = s;
            }
        }
    }
};
template <int CTRL> __device__ __forceinline__ float dpp_f(float old, float src) {
    return __uint_as_float(__builtin_amdgcn_update_dpp(__float_as_uint(old), __float_as_uint(src), CTRL, 0xf, 0xf, false)); }
struct EpiFfn {
    static constexpr bool PERM = true, AFTER_DRAIN = false;
    LAS unsigned char* lds; bf16_t* U; float* SG; float* SU; const float* wcv; const float* ssq; float* out; const float* fst; int layer;
    __device__ __forceinline__ void operator()(const f32x4 (&acc)[2][2][4][2], const Unit& u, int wr, int wc, int fr, int fq) const {
        asm volatile("" : "+v"(fr), "+v"(fq));
        const int col = u.pn * 128 + wc * 32 + 8 * fq;
        f32x4 w0[2], w1[2], w2[2];
#pragma unroll
        for (int n = 0; n < 2; ++n) { w0[n] = *(const f32x4*)(wcv + col + 4 * n); w1[n] = *(const f32x4*)(wcv + DFF + col + 4 * n); w2[n] = *(const f32x4*)(wcv + 2 * DFF + col + 4 * n); }
        if (u.pm >= MPR / BM) {
#pragma unroll
            for (int ai = 0; ai < 2; ++ai)
#pragma unroll
                for (int m = 0; m < 4; ++m) {
                    const int r = u.pm * BM + ai * HALF + wr * 64 + m * 16 + fr;
                    if (ai * HALF + wr * 64 + m * 16 >= MSA) continue;
                    const float rs = row_rstd(ssq, r, fq);
                    const int rs_ = r - MPR, sb = rs_ >> 2, j = rs_ & 3;
                    const float* sp0 = fst + ((size_t)((layer * NSB + sb) * 2)) * DFF + col;
                    f32x4 g[2], up[2], s0[2], s1[2], o[2];
#pragma unroll
                    for (int n = 0; n < 2; ++n) { g[n] = acc[ai][0][m][n] * rs; up[n] = acc[ai][1][m][n] * rs; s0[n] = *(const f32x4*)(sp0 + 4 * n); s1[n] = *(const f32x4*)(sp0 + DFF + 4 * n); }
#pragma unroll
                    for (int n = 0; n < 2; ++n)
#pragma unroll
                        for (int i = 0; i < 4; ++i) {
                            const float q1 = dpp_f<0x90>(0.f, g[n][i]), q2 = dpp_f<0x40>(0.f, g[n][i]);
                            const float gm1 = (j == 0) ? s1[n][i] : q1, gm2 = (j == 0) ? s0[n][i] : (j == 1) ? s1[n][i] : q2;
                            const float y = w0[n][i] * gm2 + w1[n][i] * gm1 + w2[n][i] * g[n][i];
                            o[n][i] = y * sigmoidf_(y) * up[n][i];
                        }
                    u32x4 w; w.x = cvt_pk_bf16(o[0][0], o[0][1]); w.y = cvt_pk_bf16(o[0][2], o[0][3]); w.z = cvt_pk_bf16(o[1][0], o[1][1]); w.w = cvt_pk_bf16(o[1][2], o[1][3]);
                    *(u32x4*)(U + (size_t)r * DFF + col) = w;
                    if (j >= 2) { float* sp = out + O_SF + ((size_t)((layer * NSB + sb) * 2 + (j - 2))) * DFF + col; *(f32x4*)sp = g[0]; *(f32x4*)(sp + 4) = g[1]; }
                }
            return;
        }
        float rsv[2][4];
#pragma unroll
        for (int ai = 0; ai < 2; ++ai)
#pragma unroll
            for (int m = 0; m < 4; ++m) rsv[ai][m] = row_rstd(ssq, (u.pm * 4 + ai * 2 + wr) * 64 + m * 16 + fr, fq);
        asm volatile("" ::: "memory");
        LAS float* xg = (LAS float*)(lds + STAGE_BYTES);
#pragma unroll
        for (int ai = 0; ai < 2; ++ai) { const int bl = ai * 2 + wr;
            if (bl < 3 && fr >= 14) { LAS float* xp = xg + (bl * 2 + (fr - 14)) * 128 + wc * 32 + 8 * fq; *(LAS f32x4*)xp = acc[ai][0][3][0] * rsv[ai][3]; *(LAS f32x4*)(xp + 4) = acc[ai][0][3][1] * rsv[ai][3]; } }
        asm volatile("s_waitcnt lgkmcnt(0)" ::: "memory");
        __builtin_amdgcn_s_barrier();
#pragma unroll
        for (int ai = 0; ai < 2; ++ai) {
            const int bl = ai * 2 + wr, blk = u.pm * 4 + bl;
            f32x4 gp[2];
            gp[0] = (f32x4){0.f, 0.f, 0.f, 0.f}; gp[1] = gp[0];
            if (bl >= 1 && fr >= 14) { const LAS float* xp = xg + ((bl - 1) * 2 + (fr - 14)) * 128 + wc * 32 + 8 * fq; gp[0] = *(const LAS f32x4*)xp; gp[1] = *(const LAS f32x4*)(xp + 4); }
#pragma unroll
            for (int m = 0; m < 4; ++m) {
                const int r = blk * 64 + m * 16 + fr;
                const float rs = rsv[ai][m];
                f32x4 g[2], up[2], o[2];
#pragma unroll
                for (int n = 0; n < 2; ++n) { g[n] = acc[ai][0][m][n] * rs; up[n] = acc[ai][1][m][n] * rs; }
#pragma unroll
                for (int n = 0; n < 2; ++n)
#pragma unroll
                    for (int i = 0; i < 4; ++i) {
                        const float x1 = dpp_f<0x121>(0.f, gp[n][i]), gm1 = dpp_f<0x111>(x1, g[n][i]);
                        const float x2 = dpp_f<0x122>(0.f, gp[n][i]), gm2 = dpp_f<0x112>(x2, g[n][i]);
                        const float y = w0[n][i] * gm2 + w1[n][i] * gm1 + w2[n][i] * g[n][i];
                        o[n][i] = y * sigmoidf_(y) * up[n][i];
                    }
                const bool seam_lo = (bl == 0) && (m == 0) && (fr < 2), seam_hi = (bl == 3) && (m == 3) && (fr >= 14);
                if (!seam_lo) { u32x4 w; w.x = cvt_pk_bf16(o[0][0], o[0][1]); w.y = cvt_pk_bf16(o[0][2], o[0][3]); w.z = cvt_pk_bf16(o[1][0], o[1][1]); w.w = cvt_pk_bf16(o[1][2], o[1][3]);
                    *(u32x4*)(U + (size_t)r * DFF + col) = w; }
                else { float* sg = SG + ((size_t)u.pm * 4 + fr) * DFF + col; *(f32x4*)sg = g[0]; *(f32x4*)(sg + 4) = g[1];
                       float* su = SU + ((size_t)u.pm * 2 + fr) * DFF + col; *(f32x4*)su = up[0]; *(f32x4*)(su + 4) = up[1]; }
                if (seam_hi) { float* sg = SG + ((size_t)u.pm * 4 + 2 + (fr - 14)) * DFF + col; *(f32x4*)sg = g[0]; *(f32x4*)(sg + 4) = g[1];
                    const int t = r & (SEQ - 1), b = r >> 11;
                    if (t >= SEQ - 2) { float* sp = out + O_PF + ((size_t)((layer * NB + b) * 2 + (t - (SEQ - 2)))) * DFF + col; *(f32x4*)sp = g[0]; *(f32x4*)(sp + 4) = g[1]; } }
                gp[0] = g[0]; gp[1] = g[1];
            }
        }
    }
};
struct EpiQkv {
    static constexpr bool PERM = true, AFTER_DRAIN = false;
    bf16_t* QKV; float* QS; const float* ssq; float* out;
    __device__ __forceinline__ void operator()(const f32x4 (&acc)[2][2][4][2], const Unit& u, int wr, int wc, int fr, int fq) const {
        const int which = u.pn >> 2, cb = 256 * (u.pn & 3) + wc * 32 + 8 * fq;
        bf16_t* dst = QKV + (size_t)which * ((WS_K - WS_Q) / 2);
        float rsv[2][4];
#pragma unroll
        for (int ai = 0; ai < 2; ++ai)
#pragma unroll
            for (int m = 0; m < 4; ++m) rsv[ai][m] = row_rstd(ssq, u.pm * BM + ai * HALF + wr * 64 + m * 16 + fr, fq);
        asm volatile("" ::: "memory");
#pragma unroll
        for (int ai = 0; ai < 2; ++ai)
#pragma unroll
            for (int m = 0; m < 4; ++m) {
                const int r = u.pm * BM + ai * HALF + wr * 64 + m * 16 + fr;
                const float rs = rsv[ai][m] * (which == 0 ? QSCALE : 1.0f);
                float* fp = nullptr;
                if (which == 0) { if (r >= MPR && r < MTOT) fp = QS + (size_t)(r - MPR) * D; }
                else if (r < MPR) fp = out + (which == 1 ? O_PK : O_PV) + (size_t)r * D;
                else if (r < MTOT) { const int rs_ = r - MPR, sb = rs_ >> 2, j = rs_ & 3; fp = out + (which == 1 ? O_SK : O_SV) + ((size_t)sb * LBUF + (LBUF - NST) + j) * D; }
#pragma unroll
                for (int bj = 0; bj < 2; ++bj) {
                    const f32x4 v0 = acc[ai][bj][m][0] * rs, v1 = acc[ai][bj][m][1] * rs;
                    const int c = cb + bj * HALF;
                    u32x4 w; w.x = cvt_pk_bf16(v0[0], v0[1]); w.y = cvt_pk_bf16(v0[2], v0[3]); w.z = cvt_pk_bf16(v1[0], v1[1]); w.w = cvt_pk_bf16(v1[2], v1[3]);
                    *(u32x4*)(dst + (size_t)r * D + c) = w;
                    if (fp) { *(f32x4*)(fp + c) = v0; *(f32x4*)(fp + c + 4) = v1; }
                }
            }
    }
};

template <class Epi, class Sched, bool ALIGN_EPI = false, bool SP2 = false, bool KREV = false>
__device__ __forceinline__ void gemm_phase(LAS unsigned char* lds, const Gemm g, const Sched& S, const Epi& E) {
    const int wid = g.wid, lane = lane_id(), tid = wid * 64 + lane, wr = wid >> 2, wc = wid & 3, fr = lane & 15, fq = lane >> 4;
    const int K = g.K, nt = K / BK;
    unsigned voffA[2], voffB[2];
#pragma unroll
    for (int i = 0; i < 2; ++i) { int R, C; stage_rc(tid * 16 + i * 8192, R, C); const int Rb = Epi::PERM ? ((R & ~31) + perm32(R & 31)) : R;
        voffA[i] = (unsigned)(R * K + C) * 2u; voffB[i] = (unsigned)(Rb * K + C) * 2u; }
    const ptrdiff_t kstep = KREV ? -(ptrdiff_t)(BK * 2) : (ptrdiff_t)(BK * 2);
    const size_t koff0 = KREV ? (size_t)(nt - 1) * (BK * 2) : 0;
    const size_t hstep = (size_t)HALF * K * 2;
    const size_t tstep = 2 * hstep;
    const unsigned ldsw = (unsigned)wid * 1024u;
    const int aoff = lds_byte(wr * 64 + fr, fq * 8), boff = lds_byte(wc * 32 + fr, fq * 8);
#define PG8_SA(b, h) (((b) * 2 + (h)) * HTB)
#define PG8_SB(b, h) ((4 + (b) * 2 + (h)) * HTB)
#define PG8_STAGE(bufoff, gbase, voff) do { _Pragma("unroll") for (int _i = 0; _i < 2; ++_i) \
        __builtin_amdgcn_global_load_lds((const unsigned*)((const char*)(gbase) + (voff)[_i]), (LAS unsigned*)(lds + (bufoff) + ldsw + _i * 8192), 16, 0, 0); } while (0)
#define PG8_LDA(dst, b, h) do { _Pragma("unroll") for (int m = 0; m < 4; ++m) _Pragma("unroll") for (int k = 0; k < 2; ++k) dst[m][k] = *(const LAS bf16x8*)(lds + PG8_SA(b, h) + aoff + m * 2048 + k * 1024); } while (0)
#define PG8_LDB(dst, b, h) do { _Pragma("unroll") for (int n = 0; n < 2; ++n) _Pragma("unroll") for (int k = 0; k < 2; ++k) dst[n][k] = *(const LAS bf16x8*)(lds + PG8_SB(b, h) + boff + n * 2048 + k * 1024); } while (0)
#define PG8_MMA(ai, bj, At, Bt) do { __builtin_amdgcn_s_setprio(1); _Pragma("unroll") for (int m = 0; m < 4; ++m) _Pragma("unroll") for (int n = 0; n < 2; ++n) _Pragma("unroll") for (int k = 0; k < 2; ++k) \
        acc[ai][bj][m][n] = __builtin_amdgcn_mfma_f32_16x16x32_bf16(Bt[n][k], At[m][k], acc[ai][bj][m][n], 0, 0, 0); __builtin_amdgcn_s_setprio(0); } while (0)
#define PG8_WAIT_V(n) asm volatile("s_waitcnt vmcnt(" #n ")" ::: "memory")
#define PG8_WAIT_L(n) asm volatile("s_waitcnt lgkmcnt(" #n ")" ::: "memory")
#define PG8_BAR __builtin_amdgcn_s_barrier()
#define PG8_SCHED __builtin_amdgcn_sched_barrier(0)
    Unit cur, nxt; int ui = 0;
    if (!S.next(0, cur)) return;
    f32x4 acc[2][2][4][2];
#pragma unroll
    for (int a = 0; a < 2; ++a)
#pragma unroll
        for (int b = 0; b < 2; ++b)
#pragma unroll
            for (int m = 0; m < 4; ++m)
#pragma unroll
                for (int n = 0; n < 2; ++n) acc[a][b][m][n] = (f32x4){0.f, 0.f, 0.f, 0.f};
    bf16x8 At[4][2], B0[2][2], B1[2][2];
    const char* cA = (const char*)g.A + (size_t)cur.pm * tstep + koff0; const char* cB = (const char*)g.Bt + (size_t)cur.pn * tstep + koff0;
    S.a_ready(cur);
    if constexpr (SP2) {
        PG8_STAGE(PG8_SB(0, 0), cB, voffB); PG8_STAGE(PG8_SB(0, 1), cB + hstep, voffB); PG8_STAGE(PG8_SA(0, 0), cA, voffA); PG8_STAGE(PG8_SA(0, 1), cA + hstep, voffA);
        if (wr == 1) PG8_BAR;
        PG8_WAIT_V(2); PG8_BAR;
        PG8_STAGE(PG8_SB(1, 0), cB + kstep, voffB); PG8_STAGE(PG8_SA(1, 0), cA + kstep, voffA); PG8_STAGE(PG8_SB(1, 1), cB + hstep + kstep, voffB);
        PG8_WAIT_V(6); PG8_BAR;
    } else {
        PG8_STAGE(PG8_SB(0, 0), cB, voffB); PG8_STAGE(PG8_SA(0, 0), cA, voffA); PG8_STAGE(PG8_SB(0, 1), cB + hstep, voffB); PG8_STAGE(PG8_SA(0, 1), cA + hstep, voffA);
        if (wr == 1) PG8_BAR;
        PG8_WAIT_V(4); PG8_BAR;
        PG8_STAGE(PG8_SB(1, 0), cB + kstep, voffB); PG8_STAGE(PG8_SA(1, 0), cA + kstep, voffA); PG8_STAGE(PG8_SB(1, 1), cB + hstep + kstep, voffB);
        PG8_WAIT_V(6); PG8_BAR;
    }
    for (;;) {
        const bool has_next = S.next(ui + 1, nxt);
        const char* nA = has_next ? (const char*)g.A + (size_t)nxt.pm * tstep + koff0 : cA; const char* nB = has_next ? (const char*)g.Bt + (size_t)nxt.pn * tstep + koff0 : cB;
        for (int t = 0; t < nt; t += 2) {
            const bool last = (t == nt - 2);
            const char* a1 = cA + (ptrdiff_t)(t + 1) * kstep;
            const char* a2 = last ? nA : cA + (ptrdiff_t)(t + 2) * kstep; const char* b2 = last ? nB : cB + (ptrdiff_t)(t + 2) * kstep;
            const char* a3 = a2 + kstep; const char* b3 = b2 + kstep;
            if (last && has_next) S.a_ready(nxt);
            if constexpr (SP2) {
            PG8_LDB(B0, 0, 0); PG8_LDB(B1, 0, 1); PG8_SCHED; PG8_LDA(At, 0, 0); PG8_STAGE(PG8_SA(1, 1), a1 + hstep, voffA);
            PG8_WAIT_V(8); PG8_WAIT_L(0); PG8_BAR; PG8_MMA(0, 0, At, B0); PG8_MMA(0, 1, At, B1); PG8_BAR; PG8_SCHED;
            PG8_LDA(At, 0, 1); PG8_STAGE(PG8_SB(0, 0), b2, voffB); PG8_STAGE(PG8_SB(0, 1), b2 + hstep, voffB); PG8_STAGE(PG8_SA(0, 0), a2, voffA);
            PG8_WAIT_V(8); PG8_WAIT_L(0); PG8_BAR; PG8_MMA(1, 0, At, B0); PG8_MMA(1, 1, At, B1); PG8_BAR; PG8_SCHED;
            PG8_LDB(B0, 1, 0); PG8_LDB(B1, 1, 1); PG8_SCHED; PG8_LDA(At, 1, 0); PG8_STAGE(PG8_SA(0, 1), a2 + hstep, voffA);
            PG8_WAIT_V(8); PG8_WAIT_L(0); PG8_BAR; PG8_MMA(0, 0, At, B0); PG8_MMA(0, 1, At, B1); PG8_BAR; PG8_SCHED;
            PG8_LDA(At, 1, 1); PG8_STAGE(PG8_SB(1, 0), b3, voffB); PG8_STAGE(PG8_SB(1, 1), b3 + hstep, voffB); PG8_STAGE(PG8_SA(1, 0), a3, voffA);
            PG8_WAIT_V(8); PG8_WAIT_L(0); PG8_BAR; PG8_MMA(1, 0, At, B0); PG8_MMA(1, 1, At, B1); PG8_BAR; PG8_SCHED;
            } else {
            PG8_LDB(B0, 0, 0); PG8_SCHED; PG8_LDA(At, 0, 0); PG8_STAGE(PG8_SA(1, 1), a1 + hstep, voffA);
            PG8_WAIT_L(8); PG8_BAR; PG8_WAIT_L(0); PG8_MMA(0, 0, At, B0); PG8_BAR; PG8_SCHED;
            PG8_LDB(B1, 0, 1); PG8_STAGE(PG8_SB(0, 0), b2, voffB);
            PG8_BAR; PG8_WAIT_L(0); PG8_MMA(0, 1, At, B1); PG8_BAR;
            PG8_LDA(At, 0, 1); PG8_STAGE(PG8_SA(0, 0), a2, voffA);
            PG8_BAR; PG8_WAIT_L(0); PG8_MMA(1, 0, At, B0); PG8_BAR; PG8_SCHED;
            PG8_STAGE(PG8_SB(0, 1), b2 + hstep, voffB);
            PG8_WAIT_V(6); PG8_BAR; PG8_MMA(1, 1, At, B1); PG8_BAR;
            PG8_LDB(B0, 1, 0); PG8_SCHED; PG8_LDA(At, 1, 0); PG8_STAGE(PG8_SA(0, 1), a2 + hstep, voffA);
            PG8_WAIT_L(8); PG8_BAR; PG8_WAIT_L(0); PG8_MMA(0, 0, At, B0); PG8_BAR; PG8_SCHED;
            PG8_LDB(B1, 1, 1); PG8_STAGE(PG8_SB(1, 0), b3, voffB);
            PG8_BAR; PG8_WAIT_L(0); PG8_MMA(0, 1, At, B1); PG8_BAR;
            PG8_LDA(At, 1, 1); PG8_STAGE(PG8_SA(1, 0), a3, voffA);
            PG8_BAR; PG8_WAIT_L(0); PG8_MMA(1, 0, At, B0); PG8_BAR; PG8_SCHED;
            PG8_STAGE(PG8_SB(1, 1), b3 + hstep, voffB);
            PG8_WAIT_V(6); PG8_BAR; PG8_MMA(1, 1, At, B1); PG8_BAR;
            }
        }
        if constexpr (ALIGN_EPI) { if (wr == 0) PG8_BAR; }
        if constexpr (!Epi::AFTER_DRAIN) { E(acc, cur, wr, wc, fr, fq); S.done(cur); }
        if (!has_next) break;
#pragma unroll
        for (int a = 0; a < 2; ++a)
#pragma unroll
            for (int b = 0; b < 2; ++b)
#pragma unroll
                for (int m = 0; m < 4; ++m)
#pragma unroll
                    for (int n = 0; n < 2; ++n) acc[a][b][m][n] = (f32x4){0.f, 0.f, 0.f, 0.f};
        cur = nxt; cA = nA; cB = nB; ++ui;
        if constexpr (ALIGN_EPI) { if (wr == 1) PG8_BAR; }
    }
    PG8_WAIT_V(0);
    if constexpr (!ALIGN_EPI) { if (wr == 0) PG8_BAR; }
    PG8_BAR;
#undef PG8_SA
#undef PG8_SB
#undef PG8_STAGE
#undef PG8_LDA
#undef PG8_LDB
#undef PG8_MMA
#undef PG8_WAIT_V
#undef PG8_WAIT_L
#undef PG8_BAR
#undef PG8_SCHED
}
}

__device__ __forceinline__ void transpose_item(const float* W, int K, int N, bf16_t* WT, int k0, int np0, int srcn0, const float* g, LAS float* scr, int lane) {
    f32x4 v[8];
#pragma unroll
    for (int i = 0; i < 8; ++i) { const int kk = 8 * i + (lane >> 3); v[i] = __builtin_nontemporal_load((const f32x4*)(W + (size_t)(k0 + kk) * N + srcn0 + (lane & 7) * 4)); }
#pragma unroll
    for (int i = 0; i < 8; ++i) { const int kk = 8 * i + (lane >> 3); const float gg = g ? g[k0 + kk] : 1.0f; LAS float* d = scr + kk * 33 + (lane & 7) * 4;
        d[0] = v[i].x * gg; d[1] = v[i].y * gg; d[2] = v[i].z * gg; d[3] = v[i].w * gg; }
    asm volatile("s_waitcnt lgkmcnt(0)" ::: "memory");
    const int c = lane & 7;
#pragma unroll
    for (int j = 0; j < 4; ++j) { const int n = (lane >> 3) + 8 * j; const LAS float* s = scr + (8 * c) * 33 + n;
        u32x4 o; o.x = cvt_pk_bf16(s[0 * 33], s[1 * 33]); o.y = cvt_pk_bf16(s[2 * 33], s[3 * 33]); o.z = cvt_pk_bf16(s[4 * 33], s[5 * 33]); o.w = cvt_pk_bf16(s[6 * 33], s[7 * 33]);
        *(u32x4*)(WT + (size_t)(np0 + n) * K + k0 + 8 * c) = o; }
    asm volatile("s_waitcnt lgkmcnt(0)" ::: "memory");
}
__device__ __forceinline__ int src_in_ab(int np) {
    const int pn = np >> 8, cc = np & 255, bj = cc >> 7, off = cc & 127;
    if (pn < 4) return (bj ? 512 : 0) + 128 * pn + off;
    if (pn < 8) return (bj ? 2048 : 1536) + 128 * (pn - 4) + off;
    return 1024 + 256 * (pn - 8) + cc;
}
__device__ __forceinline__ int src_ffn(int np) { const int pn = np >> 8, cc = np & 255, bj = cc >> 7, off = cc & 127; return (bj ? DFF : 0) + 128 * pn + off; }

struct Args { const float* in[22]; float* out; unsigned char* ws; };

__device__ __forceinline__ void copy_range_simple(const Args& a, size_t lo, size_t hi, int bi, int nb, int tid) {
    const size_t per = (size_t)(LBUF - NST) * D / 4;
    const size_t stride = (size_t)nb * NTHREADS;
    for (size_t i0 = lo + (size_t)bi * NTHREADS + tid; i0 < hi; i0 += 8 * stride) {
        f32x4 kv[8], vv[8];
#pragma unroll
        for (int u = 0; u < 8; ++u) { const size_t i = i0 + u * stride; if (i < hi) { const size_t sb = i / per, rem = i % per;
            kv[u] = __builtin_nontemporal_load((const f32x4*)(a.in[4] + (sb * LBUF + NST) * D) + rem); vv[u] = __builtin_nontemporal_load((const f32x4*)(a.in[5] + (sb * LBUF + NST) * D) + rem); } }
#pragma unroll
        for (int u = 0; u < 8; ++u) { const size_t i = i0 + u * stride; if (i < hi) { const size_t sb = i / per, rem = i % per;
            __builtin_nontemporal_store(kv[u], (f32x4*)(a.out + O_SK + sb * LBUF * D) + rem); __builtin_nontemporal_store(vv[u], (f32x4*)(a.out + O_SV + sb * LBUF * D) + rem); } }
    }
}
template <int NB> __device__ __forceinline__ void copy_range(const Args& a, size_t lo_, size_t hi_, int bi, int wave) {
    constexpr unsigned per = (unsigned)((LBUF - NST) * D / 4);
    const unsigned lo = (unsigned)lo_, hi = (unsigned)hi_; constexpr unsigned stride = (unsigned)NB * NTHREADS;
    const float* kin = a.in[4]; const float* vin = a.in[5]; float* outp = a.out;
#define CP_SRC(T, i) ((const f32x4*)((T) + ((size_t)((i) / per) * LBUF + NST) * D) + ((i) % per))
#define CP_DST(O, i) ((f32x4*)(outp + (O) + (size_t)((i) / per) * LBUF * D) + ((i) % per))
#define CP_LOAD(KK, VV, base) _Pragma("unroll") for (int u = 0; u < 8; ++u) { const unsigned i = (base) + u * stride; KK[u] = __builtin_nontemporal_load(CP_SRC(kin, i)); VV[u] = __builtin_nontemporal_load(CP_SRC(vin, i)); }
#define CP_STORE(KK, VV, base) _Pragma("unroll") for (int u = 0; u < 8; ++u) { const unsigned i = (base) + u * stride; __builtin_nontemporal_store(KK[u], CP_DST(O_SK, i)); __builtin_nontemporal_store(VV[u], CP_DST(O_SV, i)); }
#define CP_BODY CP_LOAD(kB, vB, i0 + 8u * stride) CP_STORE(kA, vA, i0) CP_LOAD(kA, vA, i0 + 16u * stride) CP_STORE(kB, vB, i0 + 8u * stride) i0 += 16u * stride;
    unsigned i0 = lo + (unsigned)bi * NTHREADS + (unsigned)(wave * 64 + lane_id());
    if (i0 >= hi) return;
    const unsigned nIt = ((hi - i0 + stride - 1u) / stride) >> 4;
    f32x4 kA[8], vA[8], kB[8], vB[8];
    if (nIt) {
        CP_LOAD(kA, vA, i0)
        if (nIt >= 2u) {
            CP_BODY
            for (unsigned it = 2u; it < nIt; ++it) { CP_BODY }
        }
        CP_LOAD(kB, vB, i0 + 8u * stride) CP_STORE(kA, vA, i0) CP_STORE(kB, vB, i0 + 8u * stride) i0 += 16u * stride;
    }
    if (i0 < hi) {
#pragma unroll
        for (int u = 0; u < 8; ++u) { const unsigned i = i0 + u * stride; if (i < hi) { kA[u] = __builtin_nontemporal_load(CP_SRC(kin, i)); vA[u] = __builtin_nontemporal_load(CP_SRC(vin, i)); } }
#pragma unroll
        for (int u = 0; u < 8; ++u) { const unsigned i = i0 + (8 + u) * stride; if (i < hi) { kB[u] = __builtin_nontemporal_load(CP_SRC(kin, i)); vB[u] = __builtin_nontemporal_load(CP_SRC(vin, i)); } }
#pragma unroll
        for (int u = 0; u < 8; ++u) { const unsigned i = i0 + u * stride; if (i < hi) { __builtin_nontemporal_store(kA[u], CP_DST(O_SK, i)); __builtin_nontemporal_store(vA[u], CP_DST(O_SV, i)); } }
#pragma unroll
        for (int u = 0; u < 8; ++u) { const unsigned i = i0 + (8 + u) * stride; if (i < hi) { __builtin_nontemporal_store(kB[u], CP_DST(O_SK, i)); __builtin_nontemporal_store(vB[u], CP_DST(O_SV, i)); } }
    }
#undef CP_BODY
#undef CP_LOAD
#undef CP_STORE
#undef CP_SRC
#undef CP_DST
}
constexpr int FR_P1 = 10, FR_P4 = 22, FR_P10 = 22, GE_P1 = 168, GE_FF = 208;
constexpr size_t CP_TOT = (size_t)(LBUF - NST) * D / 4 * NSB;
constexpr int FR_P2 = 4;
constexpr size_t CP_P2 = CP_TOT * (64 - FR_P1 - FR_P4 - FR_P10 - FR_P2) / 64;
constexpr size_t CP_C0 = CP_TOT * (64 - FR_P1 - FR_P4 - FR_P10) / 64, CP_C1 = CP_C0 + CP_TOT * FR_P1 / 64, CP_C2 = CP_C1 + CP_TOT * FR_P4 / 64;

constexpr int WI_IN = (D / 64) * (NIN / 32), WI_SQ = (D / 64) * (D / 32), WI_QKV = (D / 64) * (3 * D / 32), WI_F = (D / 64) * (2 * DFF / 32), WI_DN = (DFF / 64) * (D / 32);
constexpr int WI_TOT = WI_IN + 2 * WI_SQ + WI_QKV + 2 * WI_F + 2 * WI_DN;
__device__ __forceinline__ void p0_weights(const Args& a, LAS unsigned char* lds, int it_lo, int it_hi, int gw, int NGW, int lane, int wave) {
    LAS float* scr = (LAS float*)(lds + wave * 16384);
    unsigned char* ws = a.ws;
    constexpr int I_IN = WI_IN, I_SQ = WI_SQ, I_QKV = WI_QKV, I_F = WI_F, I_DN = WI_DN;
    for (int it = it_lo + gw; it < it_hi; it += NGW) {
        int r = it;
        if (r < I_IN) { const int nb = NIN / 32, kb = r / nb, n0 = 32 * (r % nb); transpose_item(a.in[10], D, NIN, (bf16_t*)(ws + WS_WIN), 64 * kb, n0, src_in_ab(n0), a.in[7], scr, lane); continue; } r -= I_IN;
        if (r < I_SQ) { const int nb = D / 32, kb = r / nb, n0 = 32 * (r % nb); transpose_item(a.in[16], D, D, (bf16_t*)(ws + WS_WOUT), 64 * kb, n0, n0, nullptr, scr, lane); continue; } r -= I_SQ;
        if (r < I_QKV) { const int nb = 3 * D / 32, kb = r / nb, n0 = 32 * (r % nb); transpose_item(a.in[17], D, 3 * D, (bf16_t*)(ws + WS_WQKV), 64 * kb, n0, n0, a.in[7] + D, scr, lane); continue; } r -= I_QKV;
        if (r < I_SQ) { const int nb = D / 32, kb = r / nb, n0 = 32 * (r % nb); transpose_item(a.in[18], D, D, (bf16_t*)(ws + WS_WO), 64 * kb, n0, n0, nullptr, scr, lane); continue; } r -= I_SQ;
        if (r < 2 * I_F) { const int l = r / I_F; r -= l * I_F; const int nb = 2 * DFF / 32, kb = r / nb, n0 = 32 * (r % nb);
            transpose_item(a.in[19] + (size_t)l * D * 2 * DFF, D, 2 * DFF, (bf16_t*)(ws + (l ? WS_WF1 : WS_WF0)), 64 * kb, n0, src_ffn(n0), a.in[8] + l * D, scr, lane); continue; } r -= 2 * I_F;
        { const int l = r / I_DN; r -= l * I_DN; const int nb = D / 32, kb = r / nb, n0 = 32 * (r % nb);
            transpose_item(a.in[21] + (size_t)l * DFF * D, DFF, D, (bf16_t*)(ws + (l ? WS_WD1 : WS_WD0)), 64 * kb, n0, n0, nullptr, scr, lane); }
    }
}
__device__ __forceinline__ void p0_prologue(const Args& a, LAS unsigned char* lds, int gw, int NGW, int lane, int wave) {
    unsigned char* ws = a.ws;
    p0_weights(a, lds, 0, (gridDim.x == 256) ? WI_IN : WI_TOT, gw, NGW, lane, wave);
    bf16_t* HB = (bf16_t*)(ws + WS_HB); float* ssq = (float*)(ws + WS_SSQ);
    for (int r0 = gw; r0 < MPAD; r0 += 2 * NGW) {
        f32x4 v[2][4]; float sq[2];
#pragma unroll
        for (int h = 0; h < 2; ++h) { const int r = r0 + h * NGW; sq[h] = 0.f;
            if (r < MTOT) { const f32x4* xr = (const f32x4*)((r < MPR) ? a.in[0] + (size_t)r * D : a.in[1] + (size_t)(r - MPR) * D) + lane;
#pragma unroll
                for (int j = 0; j < 4; ++j) v[h][j] = __builtin_nontemporal_load(xr + 64 * j); }
            else {
#pragma unroll
                for (int j = 0; j < 4; ++j) v[h][j] = (f32x4){0.f, 0.f, 0.f, 0.f}; } }
#pragma unroll
        for (int h = 0; h < 2; ++h) { const int r = r0 + h * NGW; if (r >= MPAD) continue;
#pragma unroll
            for (int j = 0; j < 4; ++j) sq[h] += (v[h][j].x * v[h][j].x + v[h][j].y * v[h][j].y) + (v[h][j].z * v[h][j].z + v[h][j].w * v[h][j].w);
            const float s = wave_sum(sq[h]);
            u32x2* o8 = (u32x2*)(HB + (size_t)r * D) + lane;
#pragma unroll
            for (int j = 0; j < 4; ++j) { u32x2 w; w.x = cvt_pk_bf16(v[h][j].x, v[h][j].y); w.y = cvt_pk_bf16(v[h][j].z, v[h][j].w); o8[64 * j] = w; }
            if (r < MPR) { if (lane < 16) ssq[(size_t)r * 64 + lane] = (lane == 0) ? s : 0.f; } else ssq[(size_t)r * 64 + lane] = (lane == 0) ? s : 0.f; }
    }
    {
        const int tot = NSB * 26 * (CH / 4);
        for (int i = gw * 64 + lane; i < tot; i += NGW * 64) { const int sb = i / (26 * (CH / 4)), rem = i % (26 * (CH / 4));
            ((f32x4*)(a.out + O_SCA + (size_t)sb * 30 * CH))[rem] = ((const f32x4*)(a.in[2] + (size_t)sb * 30 * CH + 4 * CH))[rem]; }
    }
    if (gridDim.x == 256) copy_range<256>(a, 0, CP_P2, blockIdx.x, wave); else copy_range_simple(a, 0, CP_C0, blockIdx.x, gridDim.x, wave * 64 + lane);
}

__device__ __forceinline__ void p2_conv(const Args& a, LAS unsigned char* lds, int tid, int lane, int wave) {
    unsigned char* ws = a.ws;
    const bf16_t* GA = (const bf16_t*)(ws + WS_GA); bf16_t* AB = (bf16_t*)(ws + WS_AB);
    LAS float* T = (LAS float*)lds;
    for (int u = blockIdx.x; u < 512 + NSB; u += gridDim.x) {
        const float* wa = a.in[11]; const float* ba = a.in[12]; const float* lg = a.in[13]; const float* lb = a.in[14]; const float* wb = a.in[15];
        asm volatile("" : "+s"(wa), "+s"(ba), "+s"(lg), "+s"(lb), "+s"(wb));
        const bool samp = u >= 512; const int sb = u - 512;
        const int row0 = samp ? MPR + sb * NST : u * 32, nrows = samp ? NST : 32;
        const int t0 = samp ? 0 : (row0 & (SEQ - 1));
        const int nvec = (nrows + 30) * (CH / 8);
        {
            u32x4 wv[8];
#pragma unroll
            for (int it = 0; it < 8; ++it) { const int i = tid + it * NTHREADS; const int e = i >> 6, c = (i & 63) * 8; const int p = t0 - 30 + e;
                wv[it] = (u32x4){0u, 0u, 0u, 0u};
                if (i < nvec && p >= 0) wv[it] = *(const u32x4*)(GA + (size_t)(row0 - t0 + p) * GAW + c); }
#pragma unroll
            for (int it = 0; it < 8; ++it) { const int i = tid + it * NTHREADS; const int e = i >> 6, c = (i & 63) * 8; const int p = t0 - 30 + e;
                if (i < nvec && (p >= 0 || !samp)) { const u32x4 w = wv[it];
                    *(LAS f32x4*)(T + e * CH + c) = (f32x4){bflo(w.x), bfhi(w.x), bflo(w.y), bfhi(w.y)}; *(LAS f32x4*)(T + e * CH + c + 4) = (f32x4){bflo(w.z), bfhi(w.z), bflo(w.w), bfhi(w.w)}; } }
            if (samp) {
                f32x4 s0_[4], s1_[4];
#pragma unroll
                for (int it = 0; it < 4; ++it) { const int i = tid + it * NTHREADS; if (i < 30 * 64) { const float* sp = a.in[2] + ((size_t)sb * 30 + (i >> 6)) * CH + (i & 63) * 8; s0_[it] = *(const f32x4*)sp; s1_[it] = *(const f32x4*)(sp + 4); } }
#pragma unroll
                for (int it = 0; it < 4; ++it) { const int i = tid + it * NTHREADS; if (i < 30 * 64) { *(LAS f32x4*)(T + (i >> 6) * CH + (i & 63) * 8) = s0_[it]; *(LAS f32x4*)(T + (i >> 6) * CH + (i & 63) * 8 + 4) = s1_[it]; } }
            }
        }
        __syncthreads();
        if (tid < 256) {
            const int c = 2 * tid; f32x2 w[KA];
#pragma unroll
            for (int k = 0; k < KA; ++k) w[k] = *(const f32x2*)(wa + k * CH + c);
            const f32x2 bias = *(const f32x2*)(ba + c);
            if (!samp) {
#pragma clang loop unroll(disable)
                for (int hb = 0; hb < 32; hb += 16) {
                    f32x2 x[46];
#pragma unroll
                    for (int e = 0; e < 46; ++e) x[e] = *(const LAS f32x2*)(T + (hb + e) * CH + c);
#pragma unroll
                    for (int i = 0; i < 16; ++i) {
                        f32x2 s0 = bias, s1 = (f32x2){0.f, 0.f}, s2 = s1, s3 = s1;
#pragma unroll
                        for (int k = 0; k < 28; k += 4) { s0 += w[k] * x[i + k]; s1 += w[k + 1] * x[i + k + 1]; s2 += w[k + 2] * x[i + k + 2]; s3 += w[k + 3] * x[i + k + 3]; }
                        s0 += w[28] * x[i + 28]; s1 += w[29] * x[i + 29]; s2 += w[30] * x[i + 30];
                        *(LAS f32x2*)(T + (hb + i) * CH + c) = (s0 + s1) + (s2 + s3);
                    }
                }
            } else {
                f32x2 x[34];
#pragma unroll
                for (int e = 0; e < 34; ++e) x[e] = *(const LAS f32x2*)(T + e * CH + c);
#pragma unroll
                for (int i = 0; i < NST; ++i) {
                    f32x2 s0 = bias, s1 = (f32x2){0.f, 0.f}, s2 = s1, s3 = s1;
#pragma unroll
                    for (int k = 0; k < 28; k += 4) { s0 += w[k] * x[i + k]; s1 += w[k + 1] * x[i + k + 1]; s2 += w[k + 2] * x[i + k + 2]; s3 += w[k + 3] * x[i + k + 3]; }
                    s0 += w[28] * x[i + 28]; s1 += w[29] * x[i + 29]; s2 += w[30] * x[i + 30];
                    *(LAS f32x2*)(T + i * CH + c) = (s0 + s1) + (s2 + s3);
                }
            }
        } else {
            const int t2 = tid - 256, c = (t2 & 63) * 8, rc = t2 >> 6, rbase = rc * 8;
            const int nr = samp ? (rc == 0 ? NST : 0) : 8;
            float wk[3][8];
#pragma unroll
            for (int k = 0; k < 3; ++k) { const f32x4 wa0 = *(const f32x4*)(wb + k * CH + c), wa1 = *(const f32x4*)(wb + k * CH + c + 4);
                wk[k][0] = wa0.x; wk[k][1] = wa0.y; wk[k][2] = wa0.z; wk[k][3] = wa0.w; wk[k][4] = wa1.x; wk[k][5] = wa1.y; wk[k][6] = wa1.z; wk[k][7] = wa1.w; }
            float xm2[8], xm1[8];
            {
                u32x4 a2 = (u32x4){0u, 0u, 0u, 0u}, a1 = a2;
                if (nr && t0 + rbase - 2 >= 0) { a2 = *(const u32x4*)(GA + (size_t)(row0 + rbase - 2) * GAW + 512 + c); a1 = *(const u32x4*)(GA + (size_t)(row0 + rbase - 1) * GAW + 512 + c); }
                xm2[0] = bflo(a2.x); xm2[1] = bfhi(a2.x); xm2[2] = bflo(a2.y); xm2[3] = bfhi(a2.y); xm2[4] = bflo(a2.z); xm2[5] = bfhi(a2.z); xm2[6] = bflo(a2.w); xm2[7] = bfhi(a2.w);
                xm1[0] = bflo(a1.x); xm1[1] = bfhi(a1.x); xm1[2] = bflo(a1.y); xm1[3] = bfhi(a1.y); xm1[4] = bflo(a1.z); xm1[5] = bfhi(a1.z); xm1[6] = bflo(a1.w); xm1[7] = bfhi(a1.w);
                if (samp && nr) { const float* sp = a.in[3] + (size_t)sb * 2 * CH + c; const f32x4 p0 = *(const f32x4*)sp, p1 = *(const f32x4*)(sp + 4), q0 = *(const f32x4*)(sp + CH), q1 = *(const f32x4*)(sp + CH + 4);
                    xm2[0] = p0.x; xm2[1] = p0.y; xm2[2] = p0.z; xm2[3] = p0.w; xm2[4] = p1.x; xm2[5] = p1.y; xm2[6] = p1.z; xm2[7] = p1.w;
                    xm1[0] = q0.x; xm1[1] = q0.y; xm1[2] = q0.z; xm1[3] = q0.w; xm1[4] = q1.x; xm1[5] = q1.y; xm1[6] = q1.z; xm1[7] = q1.w; }
            }
#pragma clang loop unroll(disable)
            for (int k0 = 0; k0 < nr; k0 += 4) {
                u32x4 cxv[4], gbv[4];
#pragma unroll
                for (int k = 0; k < 4; ++k) { cxv[k] = *(const u32x4*)(GA + (size_t)(row0 + rbase + k0 + k) * GAW + 512 + c); gbv[k] = *(const u32x4*)(GA + (size_t)(row0 + rbase + k0 + k) * GAW + 1024 + c); }
#pragma unroll
                for (int k = 0; k < 4; ++k) {
                    const u32x4 xv = cxv[k], gv = gbv[k];
                    float o[8];
#pragma unroll
                    for (int e = 0; e < 8; ++e) {
                        const unsigned xw = e < 2 ? xv.x : (e < 4 ? xv.y : (e < 6 ? xv.z : xv.w)), gw_ = e < 2 ? gv.x : (e < 4 ? gv.y : (e < 6 ? gv.z : gv.w));
                        const float x0 = (e & 1) ? bfhi(xw) : bflo(xw), gb = (e & 1) ? bfhi(gw_) : bflo(gw_);
                        o[e] = gb * (wk[0][e] * xm2[e] + wk[1][e] * xm1[e] + wk[2][e] * x0); xm2[e] = xm1[e]; xm1[e] = x0; }
                    u32x4 w4; w4.x = cvt_pk_bf16(o[0], o[1]); w4.y = cvt_pk_bf16(o[2], o[3]); w4.z = cvt_pk_bf16(o[4], o[5]); w4.w = cvt_pk_bf16(o[6], o[7]);
                    *(u32x4*)(AB + (size_t)(row0 + rbase + k0 + k) * D + 512 + c) = w4;
                }
            }
        }
        __syncthreads();
        {
            const int c = lane * 8;
            const f32x4 g0 = *(const f32x4*)(lg + c), g1 = *(const f32x4*)(lg + c + 4), b0 = *(const f32x4*)(lb + c), b1 = *(const f32x4*)(lb + c + 4);
            f32x4 v0[4], v1[4]; float mu[4], rstd[4];
#pragma unroll
            for (int j = 0; j < 4; ++j) { const int rr = wave + 8 * j; const int rc = rr < nrows ? rr : 0; v0[j] = *(const LAS f32x4*)(T + rc * CH + c); v1[j] = *(const LAS f32x4*)(T + rc * CH + c + 4); }
#pragma unroll
            for (int j = 0; j < 4; ++j) { const float s_ = (v0[j].x + v0[j].y) + (v0[j].z + v0[j].w) + (v1[j].x + v1[j].y) + (v1[j].z + v1[j].w); mu[j] = wave_sum(s_) * (1.0f / CH); }
#pragma unroll
            for (int j = 0; j < 4; ++j) { v0[j] = v0[j] - mu[j]; v1[j] = v1[j] - mu[j];
                const float q = (v0[j].x * v0[j].x + v0[j].y * v0[j].y) + (v0[j].z * v0[j].z + v0[j].w * v0[j].w) + (v1[j].x * v1[j].x + v1[j].y * v1[j].y) + (v1[j].z * v1[j].z + v1[j].w * v1[j].w);
                rstd[j] = rsqrtf(wave_sum(q) * (1.0f / CH) + LN_EPS); }
#pragma unroll
            for (int j = 0; j < 4; ++j) { const int rr = wave + 8 * j;
                if (rr < nrows) {
                    f32x4 a0 = v0[j] * rstd[j] * g0 + b0, a1 = v1[j] * rstd[j] * g1 + b1;
#pragma unroll
                    for (int e = 0; e < 4; ++e) { a0[e] = a0[e] * sigmoidf_(a0[e]); a1[e] = a1[e] * sigmoidf_(a1[e]); }
                    u32x4 w4; w4.x = cvt_pk_bf16(a0[0], a0[1]); w4.y = cvt_pk_bf16(a0[2], a0[3]); w4.z = cvt_pk_bf16(a1[0], a1[1]); w4.w = cvt_pk_bf16(a1[2], a1[3]);
                    *(u32x4*)(AB + (size_t)(row0 + rr) * D + c) = w4;
                } }
        }
        __syncthreads();
    }
}

__device__ __forceinline__ void panel_fix(const Args& a, int layer, int pm, int tid) {
    unsigned char* ws = a.ws;
    bf16_t* U = (bf16_t*)(ws + WS_U); const float* SG = (const float*)(ws + WS_SG); const float* SU = (const float*)(ws + WS_SU);
    const float* wc = a.in[20] + (size_t)layer * 3 * DFF;
    constexpr int NCV = DFF / 8;
    const bool first = (pm & 7) == 0;
    for (int it = tid; it < 2 * NCV; it += NTHREADS) {
        const int j = it >= NCV ? 1 : 0, cv = it - j * NCV, c = cv * 8;
        float gm2[8], gm1[8], g0[8], up[8];
        const float* cur = SG + (size_t)pm * 4 * DFF + c; const float* prv = SG + (size_t)(pm - 1) * 4 * DFF + c;
#pragma unroll
        for (int e = 0; e < 8; ++e) {
            if (j == 0) { gm2[e] = first ? 0.f : prv[2 * DFF + e]; gm1[e] = first ? 0.f : prv[3 * DFF + e]; g0[e] = cur[e]; }
            else { gm2[e] = first ? 0.f : prv[3 * DFF + e]; gm1[e] = cur[e]; g0[e] = cur[DFF + e]; }
            up[e] = SU[((size_t)pm * 2 + j) * DFF + c + e];
        }
        float o[8];
#pragma unroll
        for (int e = 0; e < 8; ++e) { const float y = wc[c + e] * gm2[e] + wc[DFF + c + e] * gm1[e] + wc[2 * DFF + c + e] * g0[e]; o[e] = y * sigmoidf_(y) * up[e]; }
        u32x4 w4; w4.x = cvt_pk_bf16(o[0], o[1]); w4.y = cvt_pk_bf16(o[2], o[3]); w4.z = cvt_pk_bf16(o[4], o[5]); w4.w = cvt_pk_bf16(o[6], o[7]);
        *(u32x4*)(U + (size_t)(pm * 256 + j) * DFF + c) = w4;
    }
}

constexpr int AT_OACC = 0, AT_ML = 256 * 64 * 4, AT_STG = AT_ML + 2048, AT_KSTR = 144, AT_WSTG = 2 * 32 * AT_KSTR, AT_PSC = 0;
__device__ __forceinline__ int at_swz(int ql) { return (ql ^ (ql >> 4)) & 15; }
static_assert(AT_STG + NWAVES * AT_WSTG <= MISC_OFF && NWAVES * 2048 <= AT_ML, "attention LDS");
__device__ __forceinline__ int crow(int r, int hi) { return (r & 3) + 8 * (r >> 2) + 4 * hi; }

struct AttnRes { f32x16 o0, o1; float m, l; };
#define AT_KLOAD(X, kk_, vv_) _Pragma("unroll") for (int j = 0; j < 4; ++j) { const int kv_ = (lane >> 3) + 8 * j; const int sv_ = kb##X + kv_ < 0 ? 0 : kb##X + kv_; \
        const unsigned ro_ = (unsigned)((cls##X + dil##X * sv_) * D + (lane & 7) * 8) * 2u; kk_[j] = *(const u32x4*)((const char*)Kh + ro_); vv_[j] = *(const u32x4*)((const char*)Vh + ro_); }
#define AT_CB() asm volatile("" ::: "memory")
__device__ __forceinline__ void attn_task2(const bf16_t* Qh, const bf16_t* Kh, const bf16_t* Vh, float slope2,
                                           int dilA, int clsA, int s0A, int nqA, int dilB, int clsB, int s0B, int nqB,
                                           LAS unsigned char* lds, int wave, int lane, AttnRes& RA, AttnRes& RB) {
    asm volatile("" : "+v"(lane));
    const int r32 = lane & 31, hi = lane >> 5;
    const int qa_ = r32 < nqA ? r32 : nqA - 1, qb_ = r32 < nqB ? r32 : nqB - 1;
    const bf16_t* qpA = Qh + (size_t)(clsA + dilA * (s0A + qa_)) * D + hi * 8; const bf16_t* qpB = Qh + (size_t)(clsB + dilB * (s0B + qb_)) * D + hi * 8;
    bf16x8 qrA[4], qrB[4];
#pragma unroll
    for (int d0 = 0; d0 < 4; ++d0) { qrA[d0] = *(const bf16x8*)(qpA + d0 * 16); qrB[d0] = *(const bf16x8*)(qpB + d0 * 16); }
    float mA = -INFINITY, lA = 0.f, mB = -INFINITY, lB = 0.f;
    f32x16 oA0 = f32x16{}, oA1 = f32x16{}, oB0 = f32x16{}, oB1 = f32x16{};
    LAS unsigned char* kst = lds + AT_STG + wave * AT_WSTG; LAS unsigned char* vst = kst + 32 * AT_KSTR;
    const float sdA = slope2 * (float)dilA, sdB = slope2 * (float)dilB;
    const float lbase = (float)(r32 - 4 * hi + 128);
    const int ifA = s0A < 128 ? (128 - s0A) >> 5 : 0, ifB = s0B < 128 ? (128 - s0B) >> 5 : 0, imin = ifA < ifB ? ifA : ifB;
    const int vb = ((lane >> 4) & 1) * 32 + (lane & 3) * 8 + (4 * hi + ((lane & 15) >> 2)) * 64;
#pragma clang loop unroll(disable)
    for (int i = 4; i >= imin; --i) {
        const int kbA = s0A - 128 + 32 * i, kbB = s0B - 128 + 32 * i;
        u32x4 kkA[4], vvA[4], kkB[4], vvB[4];
        AT_KLOAD(A, kkA, vvA)
        AT_KLOAD(B, kkB, vvB)
        bf16x8 kfA[4], kfB[4]; s16x4 tlA[4], thA[4];
#pragma unroll
        for (int j = 0; j < 4; ++j) *(LAS u32x4*)(kst + ((lane >> 3) + 8 * j) * AT_KSTR + (lane & 7) * 16) = kkA[j];
        AT_CB();
#pragma unroll
        for (int d0 = 0; d0 < 4; ++d0) kfA[d0] = *(const LAS bf16x8*)(kst + r32 * AT_KSTR + d0 * 32 + hi * 16);
        AT_CB();
#pragma unroll
        for (int j = 0; j < 4; ++j) *(LAS u32x4*)(kst + ((lane >> 3) + 8 * j) * AT_KSTR + (lane & 7) * 16) = kkB[j];
        AT_CB();
#pragma unroll
        for (int d0 = 0; d0 < 4; ++d0) kfB[d0] = *(const LAS bf16x8*)(kst + r32 * AT_KSTR + d0 * 32 + hi * 16);
        AT_CB();
#pragma unroll
        for (int j = 0; j < 4; ++j) { const int kv = (lane >> 3) + 8 * j, part = lane & 7; const int off_ = (part >> 2) * 2048 + (kv >> 3) * 512 + (kv & 7) * 64 + (part & 3) * 16;
            *(LAS u32x4*)(kst + off_) = vvA[j]; *(LAS u32x4*)(vst + off_) = vvB[j]; }
        AT_CB();
#pragma unroll
        for (int q = 0; q < 4; ++q) { tlA[q] = __builtin_bit_cast(s16x4, __builtin_amdgcn_ds_read_tr16_b64_v4i16((LAS s16x4*)(kst + vb + (q >> 1) * 2048 + (q & 1) * 1024)));
                                      thA[q] = __builtin_bit_cast(s16x4, __builtin_amdgcn_ds_read_tr16_b64_v4i16((LAS s16x4*)(kst + vb + (q >> 1) * 2048 + (q & 1) * 1024 + 512))); }
        AT_CB();
        f32x16 stA, stB;
        { const float tA = sdA * ((float)(32 * i) - lbase), tB = sdB * ((float)(32 * i) - lbase);
#pragma unroll
          for (int r = 0; r < 16; ++r) { const float c_r = (float)((r & 3) + 8 * (r >> 2)); stA[r] = tA + sdA * c_r; stB[r] = tB + sdB * c_r; } }
#pragma unroll
        for (int d0 = 0; d0 < 4; ++d0) { stA = __builtin_amdgcn_mfma_f32_32x32x16_bf16(kfA[d0], qrA[d0], stA, 0, 0, 0); stB = __builtin_amdgcn_mfma_f32_32x32x16_bf16(kfB[d0], qrB[d0], stB, 0, 0, 0); }
        if (kbA < 0 || kbB < 0) {
            int cminA = (i == 0) ? r32 : 0; cminA = cminA > -kbA ? cminA : -kbA; int cminB = (i == 0) ? r32 : 0; cminB = cminB > -kbB ? cminB : -kbB;
            const int cmax = (i == 4) ? r32 : 31;
            const int loA = cminA - 4 * hi, loB = cminB - 4 * hi, hi_ = cmax - 4 * hi;
#pragma unroll
            for (int r = 0; r < 16; ++r) { const int c = (r & 3) + 8 * (r >> 2); stA[r] = (c >= loA && c <= hi_) ? stA[r] : -INFINITY; stB[r] = (c >= loB && c <= hi_) ? stB[r] : -INFINITY; }
        } else if (i == 4) {
            const int hi_ = r32 - 4 * hi;
#pragma unroll
            for (int r = 0; r < 16; ++r) { const int c = (r & 3) + 8 * (r >> 2); const bool ok = c <= hi_; stA[r] = ok ? stA[r] : -INFINITY; stB[r] = ok ? stB[r] : -INFINITY; }
        } else if (i == 0) {
            const int lo_ = r32 - 4 * hi;
#pragma unroll
            for (int r = 0; r < 16; ++r) { const int c = (r & 3) + 8 * (r >> 2); const bool ok = c >= lo_; stA[r] = ok ? stA[r] : -INFINITY; stB[r] = ok ? stB[r] : -INFINITY; }
        }
        float mxA, mxB;
        { float tA[8], tB[8];
#pragma unroll
          for (int r = 0; r < 8; ++r) { tA[r] = max_raw(stA[2 * r], stA[2 * r + 1]); tB[r] = max_raw(stB[2 * r], stB[2 * r + 1]); }
#pragma unroll
          for (int r = 0; r < 4; ++r) { tA[r] = max_raw(tA[2 * r], tA[2 * r + 1]); tB[r] = max_raw(tB[2 * r], tB[2 * r + 1]); }
          mxA = max_raw(max_raw(tA[0], tA[1]), max_raw(tA[2], tA[3])); mxB = max_raw(max_raw(tB[0], tB[1]), max_raw(tB[2], tB[3])); }
        { auto ra = __builtin_amdgcn_permlane32_swap(__float_as_uint(mxA), __float_as_uint(mxA), false, false); mxA = max_raw(__uint_as_float(ra[0]), __uint_as_float(ra[1]));
          auto rb = __builtin_amdgcn_permlane32_swap(__float_as_uint(mxB), __float_as_uint(mxB), false, false); mxB = max_raw(__uint_as_float(rb[0]), __uint_as_float(rb[1])); }
        if (__any((mxA > mA) || (mxB > mB))) {
            const float nA = max_raw(mA, mxA), nB = max_raw(mB, mxB);
            const float alA = __builtin_amdgcn_exp2f(mA - ((nA == -INFINITY) ? 0.f : nA)), alB = __builtin_amdgcn_exp2f(mB - ((nB == -INFINITY) ? 0.f : nB));
            const float fA = (nA == mA) ? 1.0f : alA, fB = (nB == mB) ? 1.0f : alB;
            lA *= fA; lB *= fB; mA = nA; mB = nB;
#pragma unroll
            for (int r = 0; r < 16; ++r) { oA0[r] *= fA; oA1[r] *= fA; oB0[r] *= fB; oB1[r] *= fB; }
        }
        const float muA = (mA == -INFINITY) ? 0.f : mA, muB = (mB == -INFINITY) ? 0.f : mB;
        f32x2 ps2A = (f32x2){0.f, 0.f}, ps2B = ps2A;
        const f32x2 mu2A = (f32x2){muA, muA}, mu2B = (f32x2){muB, muB};
#pragma unroll
        for (int r = 0; r < 16; r += 2) { const f32x2 dA = (f32x2){stA[r], stA[r + 1]} - mu2A, dB = (f32x2){stB[r], stB[r + 1]} - mu2B;
            const f32x2 pA = (f32x2){__builtin_amdgcn_exp2f(dA.x), __builtin_amdgcn_exp2f(dA.y)}, pB = (f32x2){__builtin_amdgcn_exp2f(dB.x), __builtin_amdgcn_exp2f(dB.y)};
            stA[r] = pA.x; stA[r + 1] = pA.y; stB[r] = pB.x; stB[r + 1] = pB.y; ps2A += pA; ps2B += pB; }
        lA += ps2A.x + ps2A.y; lB += ps2B.x + ps2B.y;
        bf16x8 paA[2], paB[2];
#pragma unroll
        for (int s_ = 0; s_ < 2; ++s_) {
            u32x4 w; w.x = cvt_pk_bf16(stA[8 * s_ + 0], stA[8 * s_ + 1]); w.y = cvt_pk_bf16(stA[8 * s_ + 2], stA[8 * s_ + 3]); w.z = cvt_pk_bf16(stA[8 * s_ + 4], stA[8 * s_ + 5]); w.w = cvt_pk_bf16(stA[8 * s_ + 6], stA[8 * s_ + 7]);
            paA[s_] = __builtin_bit_cast(bf16x8, w);
            w.x = cvt_pk_bf16(stB[8 * s_ + 0], stB[8 * s_ + 1]); w.y = cvt_pk_bf16(stB[8 * s_ + 2], stB[8 * s_ + 3]); w.z = cvt_pk_bf16(stB[8 * s_ + 4], stB[8 * s_ + 5]); w.w = cvt_pk_bf16(stB[8 * s_ + 6], stB[8 * s_ + 7]);
            paB[s_] = __builtin_bit_cast(bf16x8, w); }
#pragma unroll
        for (int s_ = 0; s_ < 2; ++s_) {
            { const int q = s_; const bf16x8 vf = (bf16x8){tlA[q][0], tlA[q][1], tlA[q][2], tlA[q][3], thA[q][0], thA[q][1], thA[q][2], thA[q][3]}; oA0 = __builtin_amdgcn_mfma_f32_32x32x16_bf16(vf, paA[s_], oA0, 0, 0, 0); }
            { const int q = 2 + s_; const bf16x8 vf = (bf16x8){tlA[q][0], tlA[q][1], tlA[q][2], tlA[q][3], thA[q][0], thA[q][1], thA[q][2], thA[q][3]}; oA1 = __builtin_amdgcn_mfma_f32_32x32x16_bf16(vf, paA[s_], oA1, 0, 0, 0); }
        }
        AT_CB();
        s16x4 tlB[4], thB[4];
#pragma unroll
        for (int q = 0; q < 4; ++q) { tlB[q] = __builtin_bit_cast(s16x4, __builtin_amdgcn_ds_read_tr16_b64_v4i16((LAS s16x4*)(vst + vb + (q >> 1) * 2048 + (q & 1) * 1024)));
                                      thB[q] = __builtin_bit_cast(s16x4, __builtin_amdgcn_ds_read_tr16_b64_v4i16((LAS s16x4*)(vst + vb + (q >> 1) * 2048 + (q & 1) * 1024 + 512))); }
        AT_CB();
#pragma unroll
        for (int s_ = 0; s_ < 2; ++s_) {
            { const int q = s_; const bf16x8 vf = (bf16x8){tlB[q][0], tlB[q][1], tlB[q][2], tlB[q][3], thB[q][0], thB[q][1], thB[q][2], thB[q][3]}; oB0 = __builtin_amdgcn_mfma_f32_32x32x16_bf16(vf, paB[s_], oB0, 0, 0, 0); }
            { const int q = 2 + s_; const bf16x8 vf = (bf16x8){tlB[q][0], tlB[q][1], tlB[q][2], tlB[q][3], thB[q][0], thB[q][1], thB[q][2], thB[q][3]}; oB1 = __builtin_amdgcn_mfma_f32_32x32x16_bf16(vf, paB[s_], oB1, 0, 0, 0); }
        }
        AT_CB();
    }
    { auto ra = __builtin_amdgcn_permlane32_swap(__float_as_uint(lA), __float_as_uint(lA), false, false); lA = __uint_as_float(ra[0]) + __uint_as_float(ra[1]);
      auto rb = __builtin_amdgcn_permlane32_swap(__float_as_uint(lB), __float_as_uint(lB), false, false); lB = __uint_as_float(rb[0]) + __uint_as_float(rb[1]); }
    RA.o0 = oA0; RA.o1 = oA1; RA.m = mA; RA.l = lA; RB.o0 = oB0; RB.o1 = oB1; RB.m = mB; RB.l = lB;
}
#undef AT_KLOAD
#undef AT_CB
struct AttnRes3 { f32x4 o[4]; float m, l; };
#define AT3_KLOAD(X, kk_, vv_) _Pragma("unroll") for (int j = 0; j < 4; ++j) { const int kv_ = (lane >> 3) + 8 * j; const int sv_ = kb + kv_ < 0 ? 0 : kb + kv_; \
        const unsigned ro_ = (unsigned)((cls##X + 16 * sv_) * D + (lane & 7) * 8) * 2u; kk_[j] = *(const u32x4*)((const char*)Kh + ro_); vv_[j] = *(const u32x4*)((const char*)Vh + ro_); }
#define AT3_CB() asm volatile("" ::: "memory")
__device__ __forceinline__ void attn_task3(const bf16_t* Qh, const bf16_t* Kh, const bf16_t* Vh, float slope2, int clsA, int clsB, int s0,
                                           LAS unsigned char* lds, int wave, int lane, AttnRes3& RA, AttnRes3& RB) {
    asm volatile("" : "+v"(lane));
    const int q = lane & 15, g = lane >> 4;
    const bf16_t* qpA = Qh + (size_t)(clsA + 16 * (s0 + q)) * D + 8 * g; const bf16_t* qpB = Qh + (size_t)(clsB + 16 * (s0 + q)) * D + 8 * g;
    bf16x8 qrA[2], qrB[2];
#pragma unroll
    for (int dh = 0; dh < 2; ++dh) { qrA[dh] = *(const bf16x8*)(qpA + 32 * dh); qrB[dh] = *(const bf16x8*)(qpB + 32 * dh); }
    float mA = -INFINITY, lA = 0.f, mB = -INFINITY, lB = 0.f;
    f32x4 oA[4], oB[4];
#pragma unroll
    for (int db = 0; db < 4; ++db) { oA[db] = (f32x4){0.f, 0.f, 0.f, 0.f}; oB[db] = oA[db]; }
    LAS unsigned char* kst = lds + AT_STG + wave * AT_WSTG; LAS unsigned char* vst = kst + 32 * AT_KSTR;
    const float sd = slope2 * 16.0f;
    const float lbase = (float)(4 * g - q - 128);
    const int imin = s0 < 128 ? (128 - s0) >> 5 : 0;
    const int woff = (lane >> 3) * AT_KSTR + (lane & 7) * 16;
    const int kfoff = q * AT_KSTR + g * 16;
    const int troff = (4 * g + (q >> 2)) * AT_KSTR + (lane & 3) * 8;
#pragma clang loop unroll(disable)
    for (int i = 4; i >= imin; --i) {
        const int kb = s0 - 128 + 32 * i;
        u32x4 kkA[4], vvA[4], kkB[4], vvB[4];
        AT3_KLOAD(A, kkA, vvA)
        AT3_KLOAD(B, kkB, vvB)
        bf16x8 kfA[2][2], kfB[2][2]; s16x4 tA[4][2], tB[4][2];
#pragma unroll
        for (int j = 0; j < 4; ++j) *(LAS u32x4*)(kst + woff + 8 * j * AT_KSTR) = kkA[j];
        AT3_CB();
#pragma unroll
        for (int h = 0; h < 2; ++h)
#pragma unroll
            for (int dh = 0; dh < 2; ++dh) kfA[h][dh] = *(const LAS bf16x8*)(kst + kfoff + h * 16 * AT_KSTR + dh * 64);
        AT3_CB();
#pragma unroll
        for (int j = 0; j < 4; ++j) *(LAS u32x4*)(kst + woff + 8 * j * AT_KSTR) = kkB[j];
        AT3_CB();
#pragma unroll
        for (int h = 0; h < 2; ++h)
#pragma unroll
            for (int dh = 0; dh < 2; ++dh) kfB[h][dh] = *(const LAS bf16x8*)(kst + kfoff + h * 16 * AT_KSTR + dh * 64);
        AT3_CB();
#pragma unroll
        for (int j = 0; j < 4; ++j) { *(LAS u32x4*)(kst + woff + 8 * j * AT_KSTR) = vvA[j]; *(LAS u32x4*)(vst + woff + 8 * j * AT_KSTR) = vvB[j]; }
        AT3_CB();
#pragma unroll
        for (int db = 0; db < 4; ++db)
#pragma unroll
            for (int hh = 0; hh < 2; ++hh) tA[db][hh] = __builtin_bit_cast(s16x4, __builtin_amdgcn_ds_read_tr16_b64_v4i16((LAS s16x4*)(kst + troff + hh * 16 * AT_KSTR + db * 32)));
        AT3_CB();
        f32x4 sA[2], sB[2];
        { const float t = sd * ((float)(32 * i) + lbase);
          if (i == 0 || i == 4 || kb < 0) {
            int lo = (i == 0) ? q : 0; lo = lo > -kb ? lo : -kb; const int hi_ = (i == 4) ? q : 31;
            const int lo_l = lo - 4 * g, hi_l = hi_ - 4 * g;
#pragma unroll
            for (int h = 0; h < 2; ++h)
#pragma unroll
                for (int e = 0; e < 4; ++e) { const int c = 16 * h + e; const float v = (c >= lo_l && c <= hi_l) ? t + sd * (float)c : -INFINITY; sA[h][e] = v; sB[h][e] = v; }
          } else {
#pragma unroll
            for (int h = 0; h < 2; ++h)
#pragma unroll
                for (int e = 0; e < 4; ++e) { const float v = t + sd * (float)(16 * h + e); sA[h][e] = v; sB[h][e] = v; }
          } }
#pragma unroll
        for (int h = 0; h < 2; ++h)
#pragma unroll
            for (int dh = 0; dh < 2; ++dh) { sA[h] = __builtin_amdgcn_mfma_f32_16x16x32_bf16(kfA[h][dh], qrA[dh], sA[h], 0, 0, 0); sB[h] = __builtin_amdgcn_mfma_f32_16x16x32_bf16(kfB[h][dh], qrB[dh], sB[h], 0, 0, 0); }
        float mxA = fmaxf(fmaxf(fmaxf(sA[0][0], sA[0][1]), fmaxf(sA[0][2], sA[0][3])), fmaxf(fmaxf(sA[1][0], sA[1][1]), fmaxf(sA[1][2], sA[1][3])));
        float mxB = fmaxf(fmaxf(fmaxf(sB[0][0], sB[0][1]), fmaxf(sB[0][2], sB[0][3])), fmaxf(fmaxf(sB[1][0], sB[1][1]), fmaxf(sB[1][2], sB[1][3])));
        { auto a1 = __builtin_amdgcn_permlane16_swap(__float_as_uint(mxA), __float_as_uint(mxA), false, false); mxA = fmaxf(__uint_as_float(a1[0]), __uint_as_float(a1[1]));
          auto a2 = __builtin_amdgcn_permlane32_swap(__float_as_uint(mxA), __float_as_uint(mxA), false, false); mxA = fmaxf(__uint_as_float(a2[0]), __uint_as_float(a2[1]));
          auto b1 = __builtin_amdgcn_permlane16_swap(__float_as_uint(mxB), __float_as_uint(mxB), false, false); mxB = fmaxf(__uint_as_float(b1[0]), __uint_as_float(b1[1]));
          auto b2 = __builtin_amdgcn_permlane32_swap(__float_as_uint(mxB), __float_as_uint(mxB), false, false); mxB = fmaxf(__uint_as_float(b2[0]), __uint_as_float(b2[1])); }
        if (__any((mxA > mA) || (mxB > mB))) {
            const float nA = fmaxf(mA, mxA), nB = fmaxf(mB, mxB);
            const float alA = __builtin_amdgcn_exp2f(mA - ((nA == -INFINITY) ? 0.f : nA)), alB = __builtin_amdgcn_exp2f(mB - ((nB == -INFINITY) ? 0.f : nB));
            const float fA = (nA == mA) ? 1.0f : alA, fB = (nB == mB) ? 1.0f : alB;
            lA *= fA; lB *= fB; mA = nA; mB = nB;
#pragma unroll
            for (int db = 0; db < 4; ++db) { oA[db] *= fA; oB[db] *= fB; }
        }
        const float muA = (mA == -INFINITY) ? 0.f : mA, muB = (mB == -INFINITY) ? 0.f : mB;
        float psA = 0.f, psB = 0.f;
#pragma unroll
        for (int h = 0; h < 2; ++h)
#pragma unroll
            for (int e = 0; e < 4; ++e) { const float pA = __builtin_amdgcn_exp2f(sA[h][e] - muA), pB = __builtin_amdgcn_exp2f(sB[h][e] - muB); sA[h][e] = pA; sB[h][e] = pB; psA += pA; psB += pB; }
        lA += psA; lB += psB;
        bf16x8 paA, paB;
        { u32x4 w; w.x = cvt_pk_bf16(sA[0][0], sA[0][1]); w.y = cvt_pk_bf16(sA[0][2], sA[0][3]); w.z = cvt_pk_bf16(sA[1][0], sA[1][1]); w.w = cvt_pk_bf16(sA[1][2], sA[1][3]); paA = __builtin_bit_cast(bf16x8, w);
          w.x = cvt_pk_bf16(sB[0][0], sB[0][1]); w.y = cvt_pk_bf16(sB[0][2], sB[0][3]); w.z = cvt_pk_bf16(sB[1][0], sB[1][1]); w.w = cvt_pk_bf16(sB[1][2], sB[1][3]); paB = __builtin_bit_cast(bf16x8, w); }
#pragma unroll
        for (int db = 0; db < 4; ++db) { const bf16x8 vf = (bf16x8){tA[db][0][0], tA[db][0][1], tA[db][0][2], tA[db][0][3], tA[db][1][0], tA[db][1][1], tA[db][1][2], tA[db][1][3]};
            oA[db] = __builtin_amdgcn_mfma_f32_16x16x32_bf16(vf, paA, oA[db], 0, 0, 0); }
        AT3_CB();
#pragma unroll
        for (int db = 0; db < 4; ++db)
#pragma unroll
            for (int hh = 0; hh < 2; ++hh) tB[db][hh] = __builtin_bit_cast(s16x4, __builtin_amdgcn_ds_read_tr16_b64_v4i16((LAS s16x4*)(vst + troff + hh * 16 * AT_KSTR + db * 32)));
        AT3_CB();
#pragma unroll
        for (int db = 0; db < 4; ++db) { const bf16x8 vf = (bf16x8){tB[db][0][0], tB[db][0][1], tB[db][0][2], tB[db][0][3], tB[db][1][0], tB[db][1][1], tB[db][1][2], tB[db][1][3]};
            oB[db] = __builtin_amdgcn_mfma_f32_16x16x32_bf16(vf, paB, oB[db], 0, 0, 0); }
        AT3_CB();
    }
    lA = pg8::fq_sum(lA); lB = pg8::fq_sum(lB);
#pragma unroll
    for (int db = 0; db < 4; ++db) { RA.o[db] = oA[db]; RB.o[db] = oB[db]; }
    RA.m = mA; RA.l = lA; RB.m = mB; RB.l = lB;
}
#undef AT3_KLOAD
#undef AT3_CB
__device__ __forceinline__ void attn_merge3(const AttnRes3& R, int cls, LAS unsigned char* lds, int lane) {
    asm volatile("" : "+v"(lane));
    const int q = lane & 15, g = lane >> 4;
    const int ql = cls + 16 * q, g4 = at_swz(ql);
    LAS f32x4* oa = (LAS f32x4*)(lds + AT_OACC) + ql * 16;
    LAS float* ml = (LAS float*)(lds + AT_ML) + ql * 2;
    const float m_old = ml[0], l_old = ml[1]; const float m_new = fmaxf(m_old, R.m); const float mu = (m_new == -INFINITY) ? 0.f : m_new;
    const float a_old = __builtin_amdgcn_exp2f(m_old - mu), a_new = __builtin_amdgcn_exp2f(R.m - mu), l_new = l_old * a_old + R.l * a_new;
    f32x4 pv[4];
#pragma unroll
    for (int db = 0; db < 4; ++db) pv[db] = oa[(4 * db + g) ^ g4];
#pragma unroll
    for (int db = 0; db < 4; ++db) oa[(4 * db + g) ^ g4] = R.o[db] * a_new + pv[db] * a_old;
    asm volatile("s_waitcnt lgkmcnt(0)" ::: "memory");
    if (g == 0) { ml[0] = m_new; ml[1] = l_new; }
}
__device__ __forceinline__ void attn_merge(const AttnRes& R, int nq, int qlbase, int qlstep, bool first, LAS unsigned char* lds, int lane) {
    asm volatile("" : "+v"(lane));
    const int r32 = lane & 31, hi = lane >> 5;
    if (r32 < nq) {
        const int ql = qlbase + qlstep * r32, g4 = at_swz(ql);
        LAS f32x4* oa = (LAS f32x4*)(lds + AT_OACC) + ql * 16;
        LAS float* ml = (LAS float*)(lds + AT_ML) + ql * 2;
        float a_old = 0.f, a_new = 1.f, m_new = R.m, l_new = R.l;
        if (!first) { const float m_old = ml[0], l_old = ml[1]; m_new = fmaxf(m_old, R.m); const float mu = (m_new == -INFINITY) ? 0.f : m_new;
            a_old = __builtin_amdgcn_exp2f(m_old - mu); a_new = __builtin_amdgcn_exp2f(R.m - mu); l_new = l_old * a_old + R.l * a_new; }
        f32x4 p0[4], p1[4];
        if (!first) {
#pragma unroll
            for (int g = 0; g < 4; ++g) { const int c0 = (2 * g + hi) ^ g4; p0[g] = oa[c0]; p1[g] = oa[c0 ^ 8]; } }
#pragma unroll
        for (int g = 0; g < 4; ++g) { const int c0 = (2 * g + hi) ^ g4;
            f32x4 n0 = (f32x4){R.o0[4 * g], R.o0[4 * g + 1], R.o0[4 * g + 2], R.o0[4 * g + 3]} * a_new, n1 = (f32x4){R.o1[4 * g], R.o1[4 * g + 1], R.o1[4 * g + 2], R.o1[4 * g + 3]} * a_new;
            if (!first) { n0 += p0[g] * a_old; n1 += p1[g] * a_old; }
            oa[c0] = n0; oa[c0 ^ 8] = n1; }
        asm volatile("s_waitcnt lgkmcnt(0)" ::: "memory");
        if (hi == 0) { ml[0] = m_new; ml[1] = l_new; }
    }
}

__device__ __forceinline__ void p8_attention(const Args& a, LAS unsigned char* lds, int tid, int lane, int wave, int mode) {
    unsigned char* ws = a.ws;
    const bf16_t* Q = (const bf16_t*)(ws + WS_Q); const bf16_t* K = (const bf16_t*)(ws + WS_K); const bf16_t* V = (const bf16_t*)(ws + WS_V); bf16_t* O = (bf16_t*)(ws + WS_AB);
    if (mode & 1) {
        const float* QS = (const float*)(ws + WS_QS);
        LAS float* psc = (LAS float*)(lds + AT_PSC + wave * 2048);
        for (int task = blockIdx.x * NWAVES + wave; task < NSB * NH * NST; task += gridDim.x * NWAVES) {
            const int sb = task / (NH * NST), h = (task / NST) % NH, j = task % NST;
            const float slope2 = exp2f(-0.5f * (float)(h + 1)) * LOG2E;
            const float* kc = a.in[4] + (size_t)sb * LBUF * D + h * HD; const float* vc = a.in[5] + (size_t)sb * LBUF * D + h * HD;
            const float* kn = a.out + O_SK + ((size_t)sb * LBUF + (LBUF - NST)) * D + h * HD; const float* vn = a.out + O_SV + ((size_t)sb * LBUF + (LBUF - NST)) * D + h * HD;
            const float* qrow = QS + (size_t)(sb * NST + j) * D + h * HD;
            const int kg = lane >> 4, dc = lane & 15;
            const f32x4 q4 = *(const f32x4*)(qrow + 4 * dc);
            float mx = -INFINITY;
#pragma clang loop unroll(disable)
            for (int k0 = 0; k0 < 387; k0 += 64) {
                f32x4 kr4[16];
#pragma unroll
                for (int u = 0; u < 16; ++u) { const int kk = k0 + 4 * u + kg; const int kc_ = kk < 387 ? kk : 386;
                    const int g = kc_ / 129, mm = kc_ % 129, dil = (g == 0) ? 1 : (g == 1 ? 4 : 16); const int idx = LBUF + j - mm * dil;
                    const float* kr = (idx >= LBUF) ? kn + (size_t)(idx - LBUF) * D : kc + (size_t)idx * D;
                    kr4[u] = __builtin_nontemporal_load((const f32x4*)(kr + 4 * dc)); }
#pragma unroll
                for (int u = 0; u < 16; ++u) { const int kk = k0 + 4 * u + kg; const int kc_ = kk < 387 ? kk : 386;
                    const int g = kc_ / 129, mm = kc_ % 129, dil = (g == 0) ? 1 : (g == 1 ? 4 : 16);
                    float t = (q4.x * kr4[u].x + q4.y * kr4[u].y) + (q4.z * kr4[u].z + q4.w * kr4[u].w);
                    t += dppmov<0xB1>(t); t += dppmov<0x4E>(t); t += dppmov<0x141>(t); t += dppmov<0x140>(t);
                    const float sc = (kk < 387) ? t - slope2 * (float)(mm * dil) : -INFINITY;
                    if (dc == 0) psc[kk] = sc;
                    mx = fmaxf(mx, sc); }
            }
            mx = wave_max(mx);
            asm volatile("s_waitcnt lgkmcnt(0)" ::: "memory");
            float l = 0.f;
#pragma clang loop unroll(disable)
            for (int rd = 0; rd < 7; ++rd) { const float p = __builtin_amdgcn_exp2f(psc[rd * 64 + lane] - mx); l += p; psc[rd * 64 + lane] = p; }
            l = wave_sum(l);
            asm volatile("s_waitcnt lgkmcnt(0)" ::: "memory");
            f32x4 acc4 = (f32x4){0.f, 0.f, 0.f, 0.f};
#pragma clang loop unroll(disable)
            for (int k0 = 0; k0 < 387; k0 += 64) {
                f32x4 vr4[16]; float pk[16];
#pragma unroll
                for (int u = 0; u < 16; ++u) { const int kk = k0 + 4 * u + kg; const int kc_ = kk < 387 ? kk : 386;
                    const int g = kc_ / 129, mm = kc_ % 129, dil = (g == 0) ? 1 : (g == 1 ? 4 : 16); const int idx = LBUF + j - mm * dil;
                    const float* vr = (idx >= LBUF) ? vn + (size_t)(idx - LBUF) * D : vc + (size_t)idx * D;
                    vr4[u] = __builtin_nontemporal_load((const f32x4*)(vr + 4 * dc)); pk[u] = kk < 387 ? psc[kc_] : 0.f; }
#pragma unroll
                for (int u = 0; u < 16; ++u) acc4 += vr4[u] * pk[u];
            }
#pragma unroll
            for (int e = 0; e < 4; ++e) { acc4[e] += __shfl_xor(acc4[e], 16); acc4[e] += __shfl_xor(acc4[e], 32); }
            const float il = __builtin_amdgcn_rcpf(l);
            if (lane < 16) { u32x2 w; w.x = cvt_pk_bf16(acc4[0] * il, acc4[1] * il); w.y = cvt_pk_bf16(acc4[2] * il, acc4[3] * il);
                *(u32x2*)(O + (size_t)(MPR + sb * NST + j) * D + h * HD + 4 * dc) = w; }
            asm volatile("s_waitcnt lgkmcnt(0)" ::: "memory");
        }
    }
    __syncthreads();
    if (mode & 2) {
    const int nun = NB * NH * 8, per_round = gridDim.x;
    for (int u0 = blockIdx.x; u0 < nun; u0 += per_round) {
        int u = u0;
        if ((gridDim.x & 7) == 0 && nun % (int)gridDim.x == 0) { const int x = blockIdx.x & 7, slot = blockIdx.x >> 3, spx = gridDim.x >> 3, rnd = u0 / per_round, j = rnd * spx + slot; u = x * (nun >> 3) + j;
            const int sq = u & 7, r4 = rnd & 3, qb = (r4 == 0) ? sq : (r4 == 1) ? 7 - sq : (r4 == 2) ? ((sq + 4) & 7) : ((3 - sq) & 7); u = (u & ~7) | qb; }
        const int qblk = u & 7, h = (u >> 3) & 15, b = u >> 7;
        const float slope2 = exp2f(-0.5f * (float)(h + 1)) * LOG2E;
        const bf16_t* Qh = Q + (size_t)b * SEQ * D + h * HD; const bf16_t* Kh = K + (size_t)b * SEQ * D + h * HD; const bf16_t* Vh = V + (size_t)b * SEQ * D + h * HD;
        {
            AttnRes RA, RB;
            attn_task2(Qh, Kh, Vh, slope2, 1, 0, 256 * qblk + 32 * wave, 32, 4, wave & 3, 64 * qblk + 32 * (wave >> 2), 32, lds, wave, lane, RA, RB);
            attn_merge(RA, 32, 32 * wave, 1, true, lds, lane);
            __syncthreads();
            attn_merge(RB, 32, (wave & 3) + 128 * (wave >> 2), 4, false, lds, lane);
            __syncthreads();
            AttnRes3 R3A, R3B;
            attn_task3(Qh, Kh, Vh, slope2, 2 * wave, 2 * wave + 1, 16 * qblk, lds, wave, lane, R3A, R3B);
            attn_merge3(R3A, 2 * wave, lds, lane);
            attn_merge3(R3B, 2 * wave + 1, lds, lane);
            __syncthreads();
        }
        {
            const int ql = tid >> 1, dh = (tid & 1) * 32, hb = (tid & 1) * 8, g4 = at_swz(ql);
            const LAS f32x4* oa = (const LAS f32x4*)(lds + AT_OACC) + ql * 16;
            const float inv = __builtin_amdgcn_rcpf(((const LAS float*)(lds + AT_ML))[ql * 2 + 1]);
            bf16_t* op = O + (size_t)(b * SEQ + 256 * qblk + ql) * D + h * HD + dh;
            f32x4 x[8];
#pragma unroll
            for (int e = 0; e < 8; ++e) x[e] = oa[(hb + e) ^ g4];
#pragma unroll
            for (int e = 0; e < 4; ++e) { const f32x4 x0 = x[2 * e] * inv, x1 = x[2 * e + 1] * inv; u32x4 w; w.x = cvt_pk_bf16(x0[0], x0[1]); w.y = cvt_pk_bf16(x0[2], x0[3]);
                w.z = cvt_pk_bf16(x1[0], x1[1]); w.w = cvt_pk_bf16(x1[2], x1[3]); *(u32x4*)(op + 8 * e) = w; }
        }
        __syncthreads();
    }
    }
}

__device__ __forceinline__ void p13_final(const Args& a, int gw, int NGW, int lane) {
    const bf16_t* HBp = (const bf16_t*)(a.ws + WS_HB); const float* g = a.in[9];
    f32x4 gv[4];
#pragma unroll
    for (int j = 0; j < 4; ++j) gv[j] = ((const f32x4*)g)[64 * j + lane];
    for (int r0 = gw; r0 < MTOT; r0 += 2 * NGW) {
        f32x4 v[2][4];
#pragma unroll
        for (int h = 0; h < 2; ++h) { const int r = r0 + h * NGW; const int rc = r < MTOT ? r : r0; const u32x2* xr = (const u32x2*)(HBp + (size_t)rc * D) + lane;
#pragma unroll
            for (int j = 0; j < 4; ++j) { const u32x2 b = xr[64 * j]; v[h][j] = (f32x4){bflo(b.x), bfhi(b.x), bflo(b.y), bfhi(b.y)}; } }
#pragma unroll
        for (int h = 0; h < 2; ++h) { const int r = r0 + h * NGW; if (r >= MTOT) continue; float s = 0.f;
#pragma unroll
            for (int j = 0; j < 4; ++j) s += (v[h][j].x * v[h][j].x + v[h][j].y * v[h][j].y) + (v[h][j].z * v[h][j].z + v[h][j].w * v[h][j].w);
            const float rstd = rsqrtf(wave_sum(s) * (1.0f / D) + RMS_EPS);
            f32x4* o = (f32x4*)(a.out + (size_t)r * D) + lane;
#pragma unroll
            for (int j = 0; j < 4; ++j) __builtin_nontemporal_store(v[h][j] * rstd * gv[j], o + 64 * j); }
    }
}

__device__ __forceinline__ void sample_gemm_qkv(LAS unsigned char* lds, const bf16_t* A, const bf16_t* Bt, const float* ssq, bf16_t* QKV, float* QS, float* out, int tid, int lane, int wave) {
    constexpr int K = D, KPW = K / 32 / 8, NCB = 3, nitems = (3 * D / 16 / NCB) * 4;
    LAS f32x4* red = (LAS f32x4*)lds;
    for (int it = blockIdx.x; it < nitems; it += gridDim.x) {
        const int cg = it >> 2, rq = it & 3;
        const bf16_t* ap = A + (size_t)(32 * rq + (lane & 15)) * K + wave * KPW * 32 + 8 * (lane >> 4);
        const bf16_t* bp = Bt + (size_t)(16 * NCB * cg + (lane & 15)) * K + wave * KPW * 32 + 8 * (lane >> 4);
        bf16x8 bw[NCB][KPW], a0[KPW], a1[KPW];
#pragma unroll
        for (int ks = 0; ks < KPW; ++ks) { a0[ks] = *(const bf16x8*)(ap + ks * 32); a1[ks] = *(const bf16x8*)(ap + (size_t)16 * K + ks * 32);
#pragma unroll
            for (int cb = 0; cb < NCB; ++cb) bw[cb][ks] = *(const bf16x8*)(bp + (size_t)cb * 16 * K + ks * 32); }
#pragma unroll
        for (int cb = 0; cb < NCB; ++cb) { f32x4 acc0 = (f32x4){0.f, 0.f, 0.f, 0.f}, acc1 = acc0;
#pragma unroll
            for (int ks = 0; ks < KPW; ++ks) { acc0 = __builtin_amdgcn_mfma_f32_16x16x32_bf16(bw[cb][ks], a0[ks], acc0, 0, 0, 0); acc1 = __builtin_amdgcn_mfma_f32_16x16x32_bf16(bw[cb][ks], a1[ks], acc1, 0, 0, 0); }
            red[((cb * 8 + wave) * 2 + 0) * 64 + lane] = acc0; red[((cb * 8 + wave) * 2 + 1) * 64 + lane] = acc1; }
        __syncthreads();
        if (tid < 128 * NCB) {
            const int cb = tid >> 7, rb = (tid >> 6) & 1, ln = tid & 63;
            f32x4 v = red[((cb * 8) * 2 + rb) * 64 + ln];
#pragma unroll
            for (int w = 1; w < 8; ++w) v += red[((cb * 8 + w) * 2 + rb) * 64 + ln];
            const int rs = 32 * rq + 16 * rb + (ln & 15), fq = ln >> 4;
            const int cbk = NCB * cg + cb, c = 16 * cbk + 4 * fq;
            const int which = cbk >> 6, c1 = c - which * D;
            const float rstd = pg8::row_rstd(ssq, MPR + rs, fq) * (which == 0 ? QSCALE : 1.0f);
            const f32x4 o = v * rstd;
            u32x2 w2; w2.x = cvt_pk_bf16(o[0], o[1]); w2.y = cvt_pk_bf16(o[2], o[3]);
            *(u32x2*)(QKV + (size_t)which * ((WS_K - WS_Q) / 2) + (size_t)(MPR + rs) * D + c1) = w2;
            float* fp = (which == 0) ? QS + (size_t)rs * D + c1 : out + (which == 1 ? O_SK : O_SV) + ((size_t)(rs >> 2) * LBUF + (LBUF - NST) + (rs & 3)) * D + c1;
            *(f32x4*)fp = o;
        }
        __syncthreads();
    }
}
template <int MODE, int K>
__device__ __forceinline__ void sample_gemm(LAS unsigned char* lds, const bf16_t* A, const bf16_t* Bt, int N, const float* base, float* Hs, bf16_t* HBs, float* ssq,
                                            bf16_t* QKV, float* QS, float* out, int tid, int lane, int wave) {
    constexpr int KPW = K / 32 / 8;
    const int nitems = (N / 16) * 4;
    LAS f32x4* red = (LAS f32x4*)lds;
    for (int it = blockIdx.x; it < nitems; it += gridDim.x) {
        const int cbk = it >> 2, rq = it & 3;
        const bf16_t* bp = Bt + (size_t)(16 * cbk + (lane & 15)) * K + wave * KPW * 32 + 8 * (lane >> 4);
        const bf16_t* ap = A + (size_t)(32 * rq + (lane & 15)) * K + wave * KPW * 32 + 8 * (lane >> 4);
        bf16x8 bw[KPW], a0[KPW], a1[KPW];
#pragma unroll
        for (int ks = 0; ks < KPW; ++ks) { bw[ks] = *(const bf16x8*)(bp + ks * 32); a0[ks] = *(const bf16x8*)(ap + ks * 32); a1[ks] = *(const bf16x8*)(ap + (size_t)16 * K + ks * 32); }
        f32x4 acc0 = (f32x4){0.f, 0.f, 0.f, 0.f}, acc1 = acc0;
#pragma unroll
        for (int ks = 0; ks < KPW; ++ks) { acc0 = __builtin_amdgcn_mfma_f32_16x16x32_bf16(bw[ks], a0[ks], acc0, 0, 0, 0); acc1 = __builtin_amdgcn_mfma_f32_16x16x32_bf16(bw[ks], a1[ks], acc1, 0, 0, 0); }
        red[(wave * 2 + 0) * 64 + lane] = acc0; red[(wave * 2 + 1) * 64 + lane] = acc1;
        __syncthreads();
        if (tid < 128) {
            const int rb = tid >> 6, ln = tid & 63;
            f32x4 v = red[rb * 64 + ln];
#pragma unroll
            for (int w = 1; w < 8; ++w) v += red[(w * 2 + rb) * 64 + ln];
            const int rs = 32 * rq + 16 * rb + (ln & 15), fq = ln >> 4;
            const int c = 16 * cbk + 4 * fq;
            if (MODE == 0) {
                const u32x2 b2 = *(const u32x2*)(HBs + (size_t)rs * D + c);
                const f32x4 h = (f32x4){bflo(b2.x), bfhi(b2.x), bflo(b2.y), bfhi(b2.y)} + v;
                u32x2 w2; w2.x = cvt_pk_bf16(h[0], h[1]); w2.y = cvt_pk_bf16(h[2], h[3]); *(u32x2*)(HBs + (size_t)rs * D + c) = w2;
                float q = (h[0] * h[0] + h[1] * h[1]) + (h[2] * h[2] + h[3] * h[3]);
                q += __shfl_xor(q, 16); q += __shfl_xor(q, 32);
                if (fq == 0) ssq[(size_t)(MPR + rs) * 64 + cbk] = q;
            } else {
                const int which = cbk >> 6, c1 = c - which * D;
                const float rstd = pg8::row_rstd(ssq, MPR + rs, fq) * (which == 0 ? QSCALE : 1.0f);
                const f32x4 o = v * rstd;
                u32x2 w2; w2.x = cvt_pk_bf16(o[0], o[1]); w2.y = cvt_pk_bf16(o[2], o[3]);
                *(u32x2*)(QKV + (size_t)which * ((WS_K - WS_Q) / 2) + (size_t)(MPR + rs) * D + c1) = w2;
                float* fp = (which == 0) ? QS + (size_t)rs * D + c1 : out + (which == 1 ? O_SK : O_SV) + ((size_t)(rs >> 2) * LBUF + (LBUF - NST) + (rs & 3)) * D + c1;
                *(f32x4*)fp = o;
            }
        }
        __syncthreads();
    }
}

#define XB_TMO      128
#define XB_XCNT(j)  (256  + 64 * (j))
#define XB_XSUB(j)  (1280 + 64 * (j))
#define XB_XGEN(j)  (2304 + 64 * (j))
#define XB_TOP      3328
#define XB_TOPGEN   3392
#define XCD_BAR_WORDS 3456
#define XB_SPIN_CAP (1u << 18)
__device__ __forceinline__ unsigned xb_ld(unsigned* p)              { return __hip_atomic_load(p, __ATOMIC_RELAXED, __HIP_MEMORY_SCOPE_AGENT); }
__device__ __forceinline__ unsigned xb_add(unsigned* p, unsigned v) { return __hip_atomic_fetch_add(p, v, __ATOMIC_RELAXED, __HIP_MEMORY_SCOPE_AGENT); }
__device__ __forceinline__ unsigned xb_xcc_id() { return (unsigned)__builtin_amdgcn_s_getreg((3 << 11) | 20) & 0xFu; }
#define XB_SPIN(cond, bar) do { unsigned _sp = 0; while (cond) { __builtin_amdgcn_s_sleep(1); \
    if ((++_sp & 255u) == 0u) { if (xb_ld(&(bar)[XB_TMO])) break; if (_sp > XB_SPIN_CAP) { atomicAdd(&(bar)[XB_TMO], 1u); break; } } } } while (0)
__device__ __forceinline__ void xcd_barrier_complete(unsigned* bar, unsigned x, unsigned& nloc, unsigned& nx) {
    const unsigned G = gridDim.x * gridDim.y * gridDim.z;
    unsigned sum, cnt, mine, sp = 0u;
    for (;;) {
        sum = 0u; cnt = 0u; mine = 0u;
#pragma unroll
        for (unsigned j = 0; j < 16; ++j) { const unsigned c = xb_ld(&bar[XB_XCNT(j)]); sum += c; cnt += (c > 0u) ? 1u : 0u; mine = (j == x) ? c : mine; }
        if (sum == G) break;
        __builtin_amdgcn_s_sleep(1);
        if ((++sp & 255u) == 0u) { if (xb_ld(&bar[XB_TMO])) break; if (sp > XB_SPIN_CAP) { atomicAdd(&bar[XB_TMO], 1u); break; } }
    }
    nloc = mine > 0u ? mine : 1u; nx = cnt > 0u ? cnt : 1u;
}
__device__ __forceinline__ void xcd_barrier(unsigned* bar, volatile LAS unsigned* st, int wave0) {
    asm volatile("s_waitcnt vmcnt(0)" ::: "memory");
    __syncthreads();
    if (wave0 == 0 && lane_id() == 0) {
        const unsigned x = xb_xcc_id();
        __builtin_amdgcn_s_waitcnt(0);
        unsigned nloc = st[0], nx = st[1];
        if (nloc == 0u) { xcd_barrier_complete(bar, x, nloc, nx); st[0] = nloc; st[1] = nx; }
        const unsigned old = xb_add(&bar[XB_XSUB(x)], 1u);
        const unsigned gen = old / nloc;
        if (old + 1u == (gen + 1u) * nloc) {
            __builtin_amdgcn_fence(__ATOMIC_RELEASE, "agent");
            asm volatile("s_waitcnt vmcnt(0)" ::: "memory");
            const unsigned og = xb_add(&bar[XB_TOP], 1u);
            const unsigned tg = og / nx;
            if (og + 1u == (tg + 1u) * nx) xb_add(&bar[XB_TOPGEN], 1u);
            else XB_SPIN(xb_ld(&bar[XB_TOPGEN]) == tg, bar);
            __builtin_amdgcn_fence(__ATOMIC_ACQUIRE, "agent");
            xb_add(&bar[XB_XGEN(x)], 1u);
            asm volatile("s_waitcnt vmcnt(0)" ::: "memory");
        } else {
            XB_SPIN(xb_ld(&bar[XB_XGEN(x)]) == gen, bar);
            __builtin_amdgcn_fence(__ATOMIC_ACQUIRE, "agent");
            asm volatile("s_waitcnt vmcnt(0)" ::: "memory");
        }
    }
    __syncthreads();
}

typedef const __attribute__((address_space(4))) Args* kargp_t;
__device__ __forceinline__ Args kargs() {
    Args a;
#if defined(__HIP_DEVICE_COMPILE__)
    kargp_t p = (kargp_t)__builtin_amdgcn_kernarg_segment_ptr(); asm volatile("" : "+s"(p));
#pragma unroll
    for (int i = 0; i < 22; ++i) a.in[i] = p->in[i];
    a.out = p->out; a.ws = p->ws;
#else
    for (int i = 0; i < 22; ++i) a.in[i] = nullptr;
    a.out = nullptr; a.ws = nullptr;
#endif
    return a;
}
#define PHASE_BEGIN const Args a = kargs(); unsigned char* ws = a.ws; const int wave = wave0, lane = lane_id(), tid = wave * 64 + lane; \
    const int G = gridDim.x, gw = blockIdx.x * NWAVES + wave, NGW = G * NWAVES; (void)ws; (void)lane; (void)gw; (void)NGW; (void)G;
__global__ void __launch_bounds__(NTHREADS, 2) mega_fwd(Args a_unused) {
    extern __shared__ __attribute__((aligned(16))) unsigned char lds_raw[];
    LAS unsigned char* lds = (LAS unsigned char*)lds_raw;
    cg::grid_group grid = cg::this_grid();
    volatile LAS unsigned* bst = (volatile LAS unsigned*)(lds + MISC_OFF + 64);
    const int wave0 = __builtin_amdgcn_readfirstlane((int)threadIdx.x >> 6);
    { unsigned* ctl0 = (unsigned*)kargs().ws; if (threadIdx.x == 0) { bst[0] = 0u; bst[1] = 0u; (void)xb_add(&ctl0[XB_XCNT(xb_xcc_id())], 1u); } }
    __syncthreads();
    grid.sync();
#define GRID_BAR() do { unsigned* ctl_ = (unsigned*)kargs().ws; xcd_barrier(ctl_, bst, wave0); } while (0)
#ifndef PHASES
#define PHASES 0xFFFF
#endif
#define PH(k) if constexpr (((PHASES) >> (k)) & 1)
#define REP_ALL 1
#define REP_P0 1
#define REP_P1 1
#define REP_P2 1
#define REP_P3 1
#define REP_P4 1
#define REP_P6 1
#define PROBE_SKIP_EPI 0
#define REP_P7 1
#define REP_P8 1
#define REP_P8S 1
#define REP_P13 1
#define REPEAT(n) for (int rep_ = 0; rep_ < (n); ++rep_)

    for (int rep_all = 0; rep_all < REP_ALL; ++rep_all) {
    if (rep_all) { GRID_BAR(); }
    REPEAT(REP_P0) { PH(0) { PHASE_BEGIN p0_prologue(a, lds, gw, NGW, lane, wave); } if (rep_ + 1 < REP_P0) { GRID_BAR(); } }
    GRID_BAR();
    REPEAT(REP_P1) { if (rep_) { GRID_BAR(); } PH(1) {
        PHASE_BEGIN
        const int ge = (G == 256) ? GE_P1 : G;
        if ((int)blockIdx.x < ge) {
        pg8::Gemm g{(const bf16_t*)(ws + WS_HB), (const bf16_t*)(ws + WS_WIN), MPAD, NIN, D, wave}; pg8::StaticOrder S; S.init(MPAD, NIN, ge, (int)blockIdx.x);
        pg8::EpiInAB E{(bf16_t*)(ws + WS_GA), (const float*)(ws + WS_SSQ), a.out};
        pg8::gemm_phase<pg8::EpiInAB, pg8::StaticOrder, true, true>(lds, g, S, E);
        } else { p0_weights(a, lds, WI_IN, WI_TOT, ((int)blockIdx.x - ge) * NWAVES + wave, (G - ge) * NWAVES, lane_id(), wave); copy_range<256 - GE_P1>(a, CP_C0, CP_C1, (int)blockIdx.x - ge, wave); }
        if (ge == G && rep_ == 0) copy_range_simple(a, CP_C0, CP_C1, blockIdx.x, G, wave * 64 + lane_id());
    } }
    GRID_BAR();
    REPEAT(REP_P2) { if (rep_) { GRID_BAR(); } PH(2) { PHASE_BEGIN p2_conv(a, lds, tid, lane, wave);
        if (G == 256 && (int)blockIdx.x >= 32 && rep_ == 0) copy_range<224>(a, CP_P2, CP_C0, (int)blockIdx.x - 32, wave);
    } }
    GRID_BAR();
    REPEAT(REP_P3) { if (rep_) { GRID_BAR(); } PH(3) {
        PHASE_BEGIN
        pg8::Gemm g{(const bf16_t*)(ws + WS_AB), (const bf16_t*)(ws + WS_WOUT), MPR, D, D, wave}; pg8::StaticOrder S; S.init(MPR, D, G, (int)blockIdx.x);
        pg8::EpiResid E{(bf16_t*)(ws + WS_HB), (float*)(ws + WS_SSQ), 0};
        pg8::gemm_phase<pg8::EpiResid, pg8::StaticOrder, true, true>(lds, g, S, E);
        sample_gemm<0, D>(lds, (const bf16_t*)(ws + WS_AB) + (size_t)MPR * D, (const bf16_t*)(ws + WS_WOUT), D, nullptr, nullptr, (bf16_t*)(ws + WS_HB) + (size_t)MPR * D,
                          (float*)(ws + WS_SSQ), nullptr, nullptr, nullptr, tid, lane, wave);
    } }
    GRID_BAR();
#pragma clang loop unroll(disable)
    for (int layer = 0; layer < 2; ++layer) {
        if (layer == 1) {
            REPEAT(REP_P7) { if (rep_) { GRID_BAR(); } PH(7) {
                PHASE_BEGIN
                pg8::Gemm g{(const bf16_t*)(ws + WS_HB), (const bf16_t*)(ws + WS_WQKV), MPR, 3 * D, D, wave}; pg8::StaticOrder S; S.init(MPR, 3 * D, G, (int)blockIdx.x);
                pg8::EpiQkv E{(bf16_t*)(ws + WS_Q), (float*)(ws + WS_QS), (const float*)(ws + WS_SSQ), a.out};
                pg8::gemm_phase<pg8::EpiQkv, pg8::StaticOrder, true, true>(lds, g, S, E);
                sample_gemm_qkv(lds, (const bf16_t*)(ws + WS_HB) + (size_t)MPR * D, (const bf16_t*)(ws + WS_WQKV), (const float*)(ws + WS_SSQ), (bf16_t*)(ws + WS_Q), (float*)(ws + WS_QS), a.out,
                                wave * 64 + lane_id(), lane_id(), wave);
            } }
            GRID_BAR();
            REPEAT(REP_P8) { if (rep_) { GRID_BAR(); } PH(8) { PHASE_BEGIN p8_attention(a, lds, tid, lane, wave, 2); } }
            REPEAT(REP_P8S) { PH(8) { PHASE_BEGIN p8_attention(a, lds, tid, lane, wave, 1); } }
            GRID_BAR();
            PH(9) {
                PHASE_BEGIN
                pg8::Gemm g{(const bf16_t*)(ws + WS_AB), (const bf16_t*)(ws + WS_WO), MPR, D, D, wave}; pg8::StaticOrder S; S.init(MPR, D, G, (int)blockIdx.x);
                pg8::EpiResid E{(bf16_t*)(ws + WS_HB), (float*)(ws + WS_SSQ), 0};
                pg8::gemm_phase<pg8::EpiResid, pg8::StaticOrder, true, true>(lds, g, S, E);
                sample_gemm<0, D>(lds, (const bf16_t*)(ws + WS_AB) + (size_t)MPR * D, (const bf16_t*)(ws + WS_WO), D, nullptr, nullptr, (bf16_t*)(ws + WS_HB) + (size_t)MPR * D,
                                  (float*)(ws + WS_SSQ), nullptr, nullptr, nullptr, tid, lane, wave);
            }
            GRID_BAR();
        }
        REPEAT(REP_P4) { if (rep_) { GRID_BAR(); } PH(4) {
            PHASE_BEGIN
            const int ge = (G == 256) ? GE_FF : G;
            const size_t clo = layer ? CP_C2 : CP_C1, chi = layer ? CP_TOT : CP_C2;
            if ((int)blockIdx.x >= ge) { if (rep_ == 0) copy_range<256 - GE_FF>(a, clo, chi, (int)blockIdx.x - ge, wave); } else {
            pg8::Gemm g{(const bf16_t*)(ws + WS_HB), (const bf16_t*)(ws + (layer ? WS_WF1 : WS_WF0)), MPAD, 2 * DFF, D, wave}; pg8::StaticOrder S; S.init(MPAD, 2 * DFF, ge, (int)blockIdx.x);
            pg8::EpiFfn E{lds, (bf16_t*)(ws + WS_U), (float*)(ws + WS_SG), (float*)(ws + WS_SU), a.in[20] + (size_t)layer * 3 * DFF, (const float*)(ws + WS_SSQ), a.out, a.in[6], layer};
            pg8::gemm_phase<pg8::EpiFfn, pg8::StaticOrder, true, true>(lds, g, S, E);
            }
            if (ge == G && rep_ == 0) copy_range_simple(a, clo, chi, blockIdx.x, G, wave * 64 + lane_id());
        } }
        GRID_BAR();
        REPEAT(REP_P6) { if (rep_) { GRID_BAR(); } PH(6) {
            PHASE_BEGIN
            pg8::Gemm g{(const bf16_t*)(ws + WS_U), (const bf16_t*)(ws + (layer ? WS_WD1 : WS_WD0)), MPR, D, DFF, wave}; pg8::StaticOrder S; S.init(MPR, D, G, (int)blockIdx.x);
            { pg8::Unit u_; for (int i = 0; S.next(i, u_); ++i) panel_fix(a, layer, u_.pm, tid); }
            asm volatile("s_waitcnt vmcnt(0)" ::: "memory"); __syncthreads();
            const bool real_ = (rep_ + 1 == REP_P6);
            pg8::EpiResid E{(bf16_t*)(ws + WS_HB), real_ ? (float*)(ws + WS_SSQ) : (float*)(ws + WS_ZU), real_ ? 0 : 1};
            pg8::gemm_phase<pg8::EpiResid, pg8::StaticOrder, true, true, true>(lds, g, S, E);
            if (real_) sample_gemm<0, DFF>(lds, (const bf16_t*)(ws + WS_U) + (size_t)MPR * DFF, (const bf16_t*)(ws + (layer ? WS_WD1 : WS_WD0)), D, nullptr, nullptr, (bf16_t*)(ws + WS_HB) + (size_t)MPR * D,
                                (float*)(ws + WS_SSQ), nullptr, nullptr, nullptr, tid, lane, wave);
        } }
        GRID_BAR();
    }
    REPEAT(REP_P13) { if (rep_) { GRID_BAR(); } PH(13) { PHASE_BEGIN p13_final(a, gw, NGW, lane); } }
    }
}

extern "C" void kernel_launch(void* const* d_in, const int* in_sizes, int n_in, void* d_out, int out_size, void* d_ws, size_t ws_size, hipStream_t stream) {
    static int grid = 0;
    if (grid == 0) {
        if (n_in != 22 || (size_t)out_size != O_END || ws_size < WS_END) { fprintf(stderr, "kernel_launch: unexpected shapes (n_in %d, out %d, ws %zu, need %zu)\n", n_in, out_size, ws_size, (size_t)WS_END); grid = -1; return; }
        int dev = 0, cus = 0, per_cu = 0;
        if (hipGetDevice(&dev) != hipSuccess || hipDeviceGetAttribute(&cus, hipDeviceAttributeMultiprocessorCount, dev) != hipSuccess) { grid = -1; return; }
        if (hipFuncSetAttribute((const void*)mega_fwd, hipFuncAttributeMaxDynamicSharedMemorySize, LDS_BYTES) != hipSuccess) { fprintf(stderr, "kernel_launch: hipFuncSetAttribute failed\n"); grid = -1; return; }
        if (hipOccupancyMaxActiveBlocksPerMultiprocessor(&per_cu, (const void*)mega_fwd, NTHREADS, LDS_BYTES) != hipSuccess || per_cu < 1) { fprintf(stderr, "kernel_launch: occupancy query failed (%d)\n", per_cu); (void)hipGetLastError(); grid = -1; return; }
        grid = cus * 1;
    }
    if (grid < 0) return;
    if (hipMemsetAsync((char*)d_ws + WS_CTL, 0, CTL_BYTES, stream) != hipSuccess) { fprintf(stderr, "kernel_launch: memset failed\n"); return; }
    Args a{};
    for (int i = 0; i < 22; ++i) a.in[i] = (const float*)d_in[i];
    a.out = (float*)d_out; a.ws = (unsigned char*)d_ws;
    void* args[] = {&a};
    hipError_t e = hipLaunchCooperativeKernel((const void*)mega_fwd, dim3(grid), dim3(NTHREADS), args, LDS_BYTES, stream);
    if (e != hipSuccess) fprintf(stderr, "cooperative launch failed: %s (grid %d)\n", hipGetErrorString(e), grid);
}
```

```cpp
#include <hip/hip_runtime.h>
#include <hip/hip_cooperative_groups.h>
#include <cstdio>
#include <cstdint>
namespace cg = cooperative_groups;

#define LAS __attribute__((address_space(3)))
typedef unsigned short bf16_t;
typedef short bf16x8 __attribute__((ext_vector_type(8)));
typedef float f32x4 __attribute__((ext_vector_type(4)));
typedef float f32x2 __attribute__((ext_vector_type(2)));
typedef float f32x16 __attribute__((ext_vector_type(16)));
typedef unsigned u32x4 __attribute__((ext_vector_type(4)));
typedef unsigned u32x2 __attribute__((ext_vector_type(2)));
typedef short s16x4 __attribute__((ext_vector_type(4)));

constexpr int D = 1024, SEQ = 2048, NB = 8, MPR = NB * SEQ, NSB = 32, NST = 4, MSA = NSB * NST, MTOT = MPR + MSA, MPAD = 16640;
constexpr int DFF = 2816, NIN = 2560, CH = 512, NH = 16, HD = 64, LBUF = 2048, KA = 31;
constexpr int GAW = 1536;
constexpr float RMS_EPS = 1e-6f, LN_EPS = 1e-5f;
constexpr float LOG2E = 1.4426950408889634f;
constexpr float QSCALE = 0.125f * LOG2E;

constexpr size_t O_YP = 0;
constexpr size_t O_YS = O_YP + (size_t)MPR * D;
constexpr size_t O_PCA = O_YS + (size_t)MSA * D;
constexpr size_t O_SCA = O_PCA + (size_t)NB * 30 * CH;
constexpr size_t O_PCB = O_SCA + (size_t)NSB * 30 * CH;
constexpr size_t O_SCB = O_PCB + (size_t)NB * 2 * CH;
constexpr size_t O_PK = O_SCB + (size_t)NSB * 2 * CH;
constexpr size_t O_SK = O_PK + (size_t)MPR * D;
constexpr size_t O_PV = O_SK + (size_t)NSB * LBUF * D;
constexpr size_t O_SV = O_PV + (size_t)MPR * D;
constexpr size_t O_PF = O_SV + (size_t)NSB * LBUF * D;
constexpr size_t O_SF = O_PF + (size_t)2 * NB * 2 * DFF;
constexpr size_t O_END = O_SF + (size_t)2 * NSB * 2 * DFF;

constexpr size_t al(size_t x) { return (x + 4095) & ~(size_t)4095; }
constexpr size_t WS_CTL = 0, CTL_BYTES = 65536;
constexpr size_t WS_WIN = WS_CTL + CTL_BYTES;
constexpr size_t WS_WOUT = WS_WIN + al((size_t)NIN * D * 2);
constexpr size_t WS_WQKV = WS_WOUT + al((size_t)D * D * 2);
constexpr size_t WS_WO = WS_WQKV + al((size_t)3 * D * D * 2);
constexpr size_t WS_WF0 = WS_WO + al((size_t)D * D * 2);
constexpr size_t WS_WF1 = WS_WF0 + al((size_t)2 * DFF * D * 2);
constexpr size_t WS_WD0 = WS_WF1 + al((size_t)2 * DFF * D * 2);
constexpr size_t WS_WD1 = WS_WD0 + al((size_t)D * DFF * 2);
constexpr size_t WS_HB = WS_WD1 + al((size_t)D * DFF * 2);
constexpr size_t WS_H = WS_HB + al((size_t)MPAD * D * 2);
constexpr size_t WS_SSQ = WS_H + 4096;
constexpr size_t WS_GA = WS_SSQ + al((size_t)MPAD * 64 * 4);
constexpr size_t WS_AB = WS_GA + al((size_t)MPAD * GAW * 2);
constexpr size_t WS_ZG = WS_AB + al((size_t)MPAD * D * 2);
constexpr size_t WS_ZU = WS_ZG + al((size_t)MPAD * DFF * 2);
constexpr size_t WS_U = WS_ZU + al((size_t)MPAD * DFF * 2);
constexpr size_t WS_Q = WS_U + al((size_t)MPAD * DFF * 2);
constexpr size_t WS_K = WS_Q + al((size_t)MPAD * D * 2);
constexpr size_t WS_V = WS_K + al((size_t)MPAD * D * 2);
constexpr size_t WS_QS = WS_V + al((size_t)MPAD * D * 2);
constexpr size_t WS_SG = WS_QS + al((size_t)MSA * D * 4);
constexpr size_t WS_SU = WS_SG + al((size_t)256 * 4 * DFF * 4);
constexpr size_t WS_END = WS_SU + al((size_t)256 * 2 * DFF * 4);
static_assert(WS_V - WS_K == WS_K - WS_Q, "Q|K|V equally spaced");

constexpr int NWAVES = 8, NTHREADS = 512;
constexpr int LDS_BYTES = 163840;
constexpr int MISC_OFF = LDS_BYTES - 1024;

typedef __bf16 bf16x2_t __attribute__((ext_vector_type(2)));
__device__ __forceinline__ unsigned cvt_pk_bf16(float lo, float hi) { return __builtin_bit_cast(unsigned, __builtin_convertvector((f32x2){lo, hi}, bf16x2_t)); }
__device__ __forceinline__ float bf2f(unsigned short b) { return __uint_as_float((unsigned)b << 16); }
__device__ __forceinline__ float bflo(unsigned w) { return __uint_as_float(w << 16); }
__device__ __forceinline__ float bfhi(unsigned w) { return __uint_as_float(w & 0xffff0000u); }
__device__ __forceinline__ float max_raw(float a, float b) { return __builtin_amdgcn_fmed3f(a, b, INFINITY); }
__device__ __forceinline__ float sigmoidf_(float x) { return __builtin_amdgcn_rcpf(1.0f + __expf(-x)); }
__device__ __forceinline__ int launder_v(int x) { asm volatile("" : "+v"(x)); return x; }
__device__ __forceinline__ int lane_id() { int l; asm volatile("v_mbcnt_lo_u32_b32 %0, -1, 0\n\tv_mbcnt_hi_u32_b32 %0, -1, %0" : "=v"(l)); return l; }
template <int CTRL> __device__ __forceinline__ float dppmov(float v) { return __uint_as_float(__builtin_amdgcn_update_dpp(0u, __float_as_uint(v), CTRL, 0xf, 0xf, true)); }
__device__ __forceinline__ float wave_sum(float v) {
    v += dppmov<0xB1>(v);
    v += dppmov<0x4E>(v);
    v += dppmov<0x141>(v);
    v += dppmov<0x140>(v);
    { auto r = __builtin_amdgcn_permlane16_swap(__float_as_uint(v), __float_as_uint(v), false, false); v = __uint_as_float(r[0]) + __uint_as_float(r[1]); }
    { auto r = __builtin_amdgcn_permlane32_swap(__float_as_uint(v), __float_as_uint(v), false, false); v = __uint_as_float(r[0]) + __uint_as_float(r[1]); }
    return v;
}
__device__ __forceinline__ float wave_max(float v) {
    v = fmaxf(v, dppmov<0xB1>(v)); v = fmaxf(v, dppmov<0x4E>(v)); v = fmaxf(v, dppmov<0x141>(v)); v = fmaxf(v, dppmov<0x140>(v));
    { auto r = __builtin_amdgcn_permlane16_swap(__float_as_uint(v), __float_as_uint(v), false, false); v = fmaxf(__uint_as_float(r[0]), __uint_as_float(r[1])); }
    { auto r = __builtin_amdgcn_permlane32_swap(__float_as_uint(v), __float_as_uint(v), false, false); v = fmaxf(__uint_as_float(r[0]), __uint_as_float(r[1])); }
    return v;
}

namespace pg8 {
constexpr int BM = 256, BK = 64, HALF = 128, HTB = HALF * BK * 2, STAGE_BYTES = 8 * HTB, NXCD = 8, WGM = 8;
__host__ __device__ __forceinline__ int lds_byte(int r, int c) { const int st = (r >> 4) * 2 + (c >> 5), rr = r & 15, cc = c & 31, ob = rr * 64 + cc * 2; return st * 1024 + (ob ^ (((ob >> 9) & 1) << 5)); }
__host__ __device__ __forceinline__ void stage_rc(int b, int& R, int& C) { const int st = b / 1024, sb = b % 1024, swz = sb ^ (((sb >> 9) & 1) << 5); R = (st >> 1) * 16 + swz / 64; C = (st & 1) * 32 + (swz % 64) / 2; }
__host__ __device__ __forceinline__ int perm32(int rho) { const int n = rho >> 4, i = rho & 15; return 8 * (i >> 2) + 4 * n + (i & 3); }

struct Unit { int pm, pn; };
struct Gemm { const bf16_t* A; const bf16_t* Bt; int M, N, K, wid; };

struct StaticOrder {
    int nM, nN, nwg, G, c;
    __host__ __device__ __forceinline__ void init(int M, int N, int G_, int c_) { nM = M / BM; nN = N / BM; nwg = nM * nN; G = G_; c = c_; }
    __host__ __device__ __forceinline__ bool next(int i, Unit& u) const {
        const long L = (long)i * G + c; if (L >= nwg) return false;
        int wgid = (int)L; { const int q = nwg / NXCD, r = nwg % NXCD, xcd = wgid % NXCD, off = wgid / NXCD; wgid = (xcd < r ? xcd * (q + 1) : r * (q + 1) + (xcd - r) * q) + off; }
        const int nig = WGM * nN, gid = wgid / nig, fm = gid * WGM, gsz = (nM - fm) < WGM ? (nM - fm) : WGM;
        u.pm = fm + ((wgid % nig) % gsz); u.pn = (wgid % nig) / gsz; return true;
    }
    __device__ __forceinline__ void a_ready(const Unit&) const {}
    __device__ __forceinline__ void done(const Unit&) const {}
};

__device__ __forceinline__ float fq_sum(float x) {
    auto a = __builtin_amdgcn_permlane16_swap(__float_as_uint(x), __float_as_uint(x), false, false); x = __uint_as_float(a[0]) + __uint_as_float(a[1]);
    auto b = __builtin_amdgcn_permlane32_swap(__float_as_uint(x), __float_as_uint(x), false, false); return __uint_as_float(b[0]) + __uint_as_float(b[1]);
}
__device__ __forceinline__ float row_rstd(const float* ssq, int r, int fq) {
    float s;
    if (r < MPR) { const f32x4 p = *(const f32x4*)(ssq + (size_t)r * 64 + 4 * fq); s = (p.x + p.y) + (p.z + p.w); }
    else { const f32x4* pp = (const f32x4*)(ssq + (size_t)r * 64 + 16 * fq); const f32x4 p = (pp[0] + pp[1]) + (pp[2] + pp[3]); s = (p.x + p.y) + (p.z + p.w); }
    return __builtin_amdgcn_rsqf(fq_sum(s) * (1.0f / D) + RMS_EPS);
}

struct EpiInAB {
    static constexpr bool PERM = true, AFTER_DRAIN = false;
    bf16_t* GA; const float* ssq; float* out;
    __device__ __forceinline__ void operator()(const f32x4 (&acc)[2][2][4][2], const Unit& u, int wr, int wc, int fr, int fq) const {
        const int pn = u.pn, colw = wc * 32 + 8 * fq;
        float rsv[2][4];
#pragma unroll
        for (int ai = 0; ai < 2; ++ai)
#pragma unroll
            for (int m = 0; m < 4; ++m) rsv[ai][m] = row_rstd(ssq, u.pm * BM + ai * HALF + wr * 64 + m * 16 + fr, fq);
        asm volatile("" ::: "memory");
#pragma unroll
        for (int ai = 0; ai < 2; ++ai)
#pragma unroll
            for (int m = 0; m < 4; ++m) {
                const int r = u.pm * BM + ai * HALF + wr * 64 + m * 16 + fr;
                const float rs = rsv[ai][m];
                const f32x4 a0 = acc[ai][0][m][0] * rs, a1 = acc[ai][0][m][1] * rs, g0 = acc[ai][1][m][0] * rs, g1 = acc[ai][1][m][1] * rs;
                bf16_t* rowp = GA + (size_t)r * GAW;
                if (pn < 8) {
                    f32x4 v0, v1;
                    if (pn < 4) {
#pragma unroll
                        for (int i = 0; i < 4; ++i) { v0[i] = a0[i] * sigmoidf_(g0[i]); v1[i] = a1[i] * sigmoidf_(g1[i]); }
                    } else { v0 = a0 * g0; v1 = a1 * g1; }
                    const int cl = 128 * (pn & 3) + colw;
                    u32x4 w; w.x = cvt_pk_bf16(v0[0], v0[1]); w.y = cvt_pk_bf16(v0[2], v0[3]); w.z = cvt_pk_bf16(v1[0], v1[1]); w.w = cvt_pk_bf16(v1[2], v1[3]);
                    *(u32x4*)(rowp + (pn < 4 ? 0 : 512) + cl) = w;
                    const int keep = pn < 4 ? 30 : 2;
                    float* sp = nullptr;
                    if (r < MPR) { const int t = r & (SEQ - 1), b = r >> 11; if (t >= SEQ - keep) sp = out + (pn < 4 ? O_PCA : O_PCB) + ((size_t)(b * keep + (t - (SEQ - keep)))) * CH + cl; }
                    else if (r < MTOT) { const int rs_ = r - MPR, sb = rs_ >> 2, j = rs_ & 3; if (j >= NST - keep || keep == 30) sp = out + (pn < 4 ? O_SCA : O_SCB) + ((size_t)(sb * keep + (keep - NST + j))) * CH + cl; }
                    if (sp) { *(f32x4*)sp = v0; *(f32x4*)(sp + 4) = v1; }
                } else {
                    const int c = 1024 + 256 * (pn - 8) + colw;
                    u32x4 w; w.x = cvt_pk_bf16(a0[0], a0[1]); w.y = cvt_pk_bf16(a0[2], a0[3]); w.z = cvt_pk_bf16(a1[0], a1[1]); w.w = cvt_pk_bf16(a1[2], a1[3]);
                    *(u32x4*)(rowp + c) = w;
                    w.x = cvt_pk_bf16(g0[0], g0[1]); w.y = cvt_pk_bf16(g0[2], g0[3]); w.z = cvt_pk_bf16(g1[0], g1[1]); w.w = cvt_pk_bf16(g1[2], g1[3]);
                    *(u32x4*)(rowp + c + 128) = w;
                }
            }
    }
};
struct EpiResid {
    static constexpr bool PERM = true, AFTER_DRAIN = false;
    bf16_t* HB; float* ssq; int skip;
    __device__ __forceinline__ void operator()(const f32x4 (&acc)[2][2][4][2], const Unit& u, int wr, int wc, int fr, int fq) const {
        const int col0 = u.pn * BM + wc * 32 + 8 * fq;
        if (skip) { if (acc[0][0][0][0][0] == 1.2345e-30f) ssq[0] = 0.f; return; }
#pragma unroll
        for (int ai = 0; ai < 2; ++ai) {
            u32x4 bs[4][2];
#pragma unroll
            for (int m = 0; m < 4; ++m) { const int r = u.pm * BM + ai * HALF + wr * 64 + m * 16 + fr; const int rc = r < MTOT ? r : MTOT - 1;
#pragma unroll
                for (int bj = 0; bj < 2; ++bj) bs[m][bj] = *(const u32x4*)(HB + (size_t)rc * D + col0 + bj * HALF); }
            asm volatile("" ::: "memory");
#pragma unroll
            for (int m = 0; m < 4; ++m) {
                const int r = u.pm * BM + ai * HALF + wr * 64 + m * 16 + fr;
                float s = 0.f;
                if (r < MTOT) {
#pragma unroll
                    for (int bj = 0; bj < 2; ++bj) {
                        const u32x4 b = bs[m][bj];
                        const f32x4 v0 = (f32x4){bflo(b.x), bfhi(b.x), bflo(b.y), bfhi(b.y)} + acc[ai][bj][m][0];
                        const f32x4 v1 = (f32x4){bflo(b.z), bfhi(b.z), bflo(b.w), bfhi(b.w)} + acc[ai][bj][m][1];
                        s += ((v0[0] * v0[0] + v0[1] * v0[1]) + (v0[2] * v0[2] + v0[3] * v0[3])) + ((v1[0] * v1[0] + v1[1] * v1[1]) + (v1[2] * v1[2] + v1[3] * v1[3]));
                        u32x4 w; w.x = cvt_pk_bf16(v0[0], v0[1]); w.y = cvt_pk_bf16(v0[2], v0[3]); w.z = cvt_pk_bf16(v1[0], v1[1]); w.w = cvt_pk_bf16(v1[2], v1[3]);
                        *(u32x4*)(HB + (size_t)r * D + col0 + bj * HALF) = w;
                    }
                }
                s = fq_sum(s);
                if (fq == 0 && r < MTOT) ssq[(size_t)r * 64 + u.pn * 4 + wc] = s;
            }
        }
    }
};
constexpr int PANEL_CNT = 8192;
struct EpiFinal {
    static constexpr bool PERM = true, AFTER_DRAIN = false;
    const bf16_t* HB; float* ssq; const float* gain; float* out; unsigned* ctl;
    __device__ __forceinline__ void operator()(const f32x4 (&acc_)[2][2][4][2], const Unit& u, int wr, int wc, int fr, int fq) const {
        f32x4 (&h)[2][2][4][2] = const_cast<f32x4 (&)[2][2][4][2]>(acc_);
        const int col0 = u.pn * BM + wc * 32 + 8 * fq;
#pragma unroll
        for (int ai = 0; ai < 2; ++ai) {
            u32x4 bs[4][2];
#pragma unroll
            for (int m = 0; m < 4; ++m) { const int r = u.pm * BM + ai * HALF + wr * 64 + m * 16 + fr;
#pragma unroll
                for (int bj = 0; bj < 2; ++bj) bs[m][bj] = *(const u32x4*)(HB + (size_t)r * D + col0 + bj * HALF); }
#pragma unroll
            for (int m = 0; m < 4; ++m) {
                const int r = u.pm * BM + ai * HALF + wr * 64 + m * 16 + fr;
                float s = 0.f;
#pragma unroll
                for (int bj = 0; bj < 2; ++bj) {
                    const u32x4 b = bs[m][bj];
                    const f32x4 v0 = (f32x4){bflo(b.x), bfhi(b.x), bflo(b.y), bfhi(b.y)} + h[ai][bj][m][0];
                    const f32x4 v1 = (f32x4){bflo(b.z), bfhi(b.z), bflo(b.w), bfhi(b.w)} + h[ai][bj][m][1];
                    s += ((v0[0] * v0[0] + v0[1] * v0[1]) + (v0[2] * v0[2] + v0[3] * v0[3])) + ((v1[0] * v1[0] + v1[1] * v1[1]) + (v1[2] * v1[2] + v1[3] * v1[3]));
                    h[ai][bj][m][0] = v0; h[ai][bj][m][1] = v1;
                }
                s = fq_sum(s);
                if (fq == 0) __hip_atomic_store(&ssq[(size_t)r * 64 + u.pn * 4 + wc], s, __ATOMIC_RELAXED, __HIP_MEMORY_SCOPE_AGENT);
            }
        }
        asm volatile("s_waitcnt vmcnt(0)" ::: "memory");
        __builtin_amdgcn_s_barrier();
        if (wr == 0 && wc == 0 && fr == 0 && fq == 0) {
            unsigned* cnt = ctl + PANEL_CNT + 64 * u.pm;
            (void)__hip_atomic_fetch_add(cnt, 1u, __ATOMIC_RELAXED, __HIP_MEMORY_SCOPE_AGENT);
            unsigned sp = 0;
            while (__hip_atomic_load(cnt, __ATOMIC_RELAXED, __HIP_MEMORY_SCOPE_AGENT) < 4u) { __builtin_amdgcn_s_sleep(2); if (++sp > (1u << 20)) break; }
        }
        __builtin_amdgcn_s_barrier();
        f32x4 gv[2][2];
#pragma unroll
        for (int bj = 0; bj < 2; ++bj) { gv[bj][0] = *(const f32x4*)(gain + col0 + bj * HALF); gv[bj][1] = *(const f32x4*)(gain + col0 + bj * HALF + 4); }
#pragma unroll
        for (int ai = 0; ai < 2; ++ai)
#pragma unroll
            for (int m = 0; m < 4; ++m) {
                const int r = u.pm * BM + ai * HALF + wr * 64 + m * 16 + fr;
                float rs;
                { const float* pp = ssq + (size_t)r * 64 + 4 * fq; float sq = 0.f;
#pragma unroll
                  for (int e = 0; e < 4; ++e) sq += __hip_atomic_load(pp + e, __ATOMIC_RELAXED, __HIP_MEMORY_SCOPE_AGENT);
                  rs = __builtin_amdgcn_rsqf(fq_sum(sq) * (1.0f / D) + RMS_EPS); }
                float* yp = out + (size_t)r * D + col0;
#pragma unroll
                for (int bj = 0; bj < 2; ++bj) { __builtin_nontemporal_store(h[ai][bj][m][0] * rs * gv[bj][0], (f32x4*)(yp + bj * HALF)); __builtin_nontemporal_store(h[ai][bj][m][1] * rs * gv[bj][1], (f32x4*)(yp + bj * HALF + 4)); }
            }
    }
};
template <int CTRL> __device__ __forceinline__ float dpp_f(float old, float src) {
    return __uint_as_float(__builtin_amdgcn_update_dpp(__float_as_uint(old), __float_as_uint(src), CTRL, 0xf, 0xf, false)); }
struct EpiFfn {
    static constexpr bool PERM = true, AFTER_DRAIN = false;
    LAS unsigned char* lds; bf16_t* U; float* SG; float* SU; const float* wcv; const float* ssq; float* out; const float* fst; int layer;
    __device__ __forceinline__ void operator()(const f32x4 (&acc)[2][2][4][2], const Unit& u, int wr, int wc, int fr, int fq) const {
        asm volatile("" : "+v"(fr), "+v"(fq));
        const int col = u.pn * 128 + wc * 32 + 8 * fq;
        f32x4 w0[2], w1[2], w2[2];
#pragma unroll
        for (int n = 0; n < 2; ++n) { w0[n] = *(const f32x4*)(wcv + col + 4 * n); w1[n] = *(const f32x4*)(wcv + DFF + col + 4 * n); w2[n] = *(const f32x4*)(wcv + 2 * DFF + col + 4 * n); }
        if (u.pm >= MPR / BM) {
#pragma unroll
            for (int ai = 0; ai < 2; ++ai)
#pragma unroll
                for (int m = 0; m < 4; ++m) {
                    const int r = u.pm * BM + ai * HALF + wr * 64 + m * 16 + fr;
                    if (ai * HALF + wr * 64 + m * 16 >= MSA) continue;
                    const float rs = row_rstd(ssq, r, fq);
                    const int rs_ = r - MPR, sb = rs_ >> 2, j = rs_ & 3;
                    const float* sp0 = fst + ((size_t)((layer * NSB + sb) * 2)) * DFF + col;
                    f32x4 g[2], up[2], s0[2], s1[2], o[2];
#pragma unroll
                    for (int n = 0; n < 2; ++n) { g[n] = acc[ai][0][m][n] * rs; up[n] = acc[ai][1][m][n] * rs; s0[n] = *(const f32x4*)(sp0 + 4 * n); s1[n] = *(const f32x4*)(sp0 + DFF + 4 * n); }
#pragma unroll
                    for (int n = 0; n < 2; ++n)
#pragma unroll
                        for (int i = 0; i < 4; ++i) {
                            const float q1 = dpp_f<0x90>(0.f, g[n][i]), q2 = dpp_f<0x40>(0.f, g[n][i]);
                            const float gm1 = (j == 0) ? s1[n][i] : q1, gm2 = (j == 0) ? s0[n][i] : (j == 1) ? s1[n][i] : q2;
                            const float y = w0[n][i] * gm2 + w1[n][i] * gm1 + w2[n][i] * g[n][i];
                            o[n][i] = y * sigmoidf_(y) * up[n][i];
                        }
                    u32x4 w; w.x = cvt_pk_bf16(o[0][0], o[0][1]); w.y = cvt_pk_bf16(o[0][2], o[0][3]); w.z = cvt_pk_bf16(o[1][0], o[1][1]); w.w = cvt_pk_bf16(o[1][2], o[1][3]);
                    *(u32x4*)(U + (size_t)r * DFF + col) = w;
                    if (j >= 2) { float* sp = out + O_SF + ((size_t)((layer * NSB + sb) * 2 + (j - 2))) * DFF + col; *(f32x4*)sp = g[0]; *(f32x4*)(sp + 4) = g[1]; }
                }
            return;
        }
        float rsv[2][4];
#pragma unroll
        for (int ai = 0; ai < 2; ++ai)
#pragma unroll
            for (int m = 0; m < 4; ++m) rsv[ai][m] = row_rstd(ssq, (u.pm * 4 + ai * 2 + wr) * 64 + m * 16 + fr, fq);
        asm volatile("" ::: "memory");
        LAS float* xg = (LAS float*)(lds + STAGE_BYTES);
#pragma unroll
        for (int ai = 0; ai < 2; ++ai) { const int bl = ai * 2 + wr;
            if (bl < 3 && fr >= 14) { LAS float* xp = xg + (bl * 2 + (fr - 14)) * 128 + wc * 32 + 8 * fq; *(LAS f32x4*)xp = acc[ai][0][3][0] * rsv[ai][3]; *(LAS f32x4*)(xp + 4) = acc[ai][0][3][1] * rsv[ai][3]; } }
        asm volatile("s_waitcnt lgkmcnt(0)" ::: "memory");
        __builtin_amdgcn_s_barrier();
#pragma unroll
        for (int ai = 0; ai < 2; ++ai) {
            const int bl = ai * 2 + wr, blk = u.pm * 4 + bl;
            f32x4 gp[2];
            gp[0] = (f32x4){0.f, 0.f, 0.f, 0.f}; gp[1] = gp[0];
            if (bl >= 1 && fr >= 14) { const LAS float* xp = xg + ((bl - 1) * 2 + (fr - 14)) * 128 + wc * 32 + 8 * fq; gp[0] = *(const LAS f32x4*)xp; gp[1] = *(const LAS f32x4*)(xp + 4); }
#pragma unroll
            for (int m = 0; m < 4; ++m) {
                const int r = blk * 64 + m * 16 + fr;
                const float rs = rsv[ai][m];
                f32x4 g[2], up[2], o[2];
#pragma unroll
                for (int n = 0; n < 2; ++n) { g[n] = acc[ai][0][m][n] * rs; up[n] = acc[ai][1][m][n] * rs; }
#pragma unroll
                for (int n = 0; n < 2; ++n)
#pragma unroll
                    for (int i = 0; i < 4; ++i) {
                        const float x1 = dpp_f<0x121>(0.f, gp[n][i]), gm1 = dpp_f<0x111>(x1, g[n][i]);
                        const float x2 = dpp_f<0x122>(0.f, gp[n][i]), gm2 = dpp_f<0x112>(x2, g[n][i]);
                        const float y = w0[n][i] * gm2 + w1[n][i] * gm1 + w2[n][i] * g[n][i];
                        o[n][i] = y * sigmoidf_(y) * up[n][i];
                    }
                const bool seam_lo = (bl == 0) && (m == 0) && (fr < 2), seam_hi = (bl == 3) && (m == 3) && (fr >= 14);
                if (!seam_lo) { u32x4 w; w.x = cvt_pk_bf16(o[0][0], o[0][1]); w.y = cvt_pk_bf16(o[0][2], o[0][3]); w.z = cvt_pk_bf16(o[1][0], o[1][1]); w.w = cvt_pk_bf16(o[1][2], o[1][3]);
                    *(u32x4*)(U + (size_t)r * DFF + col) = w; }
                else { float* sg = SG + ((size_t)u.pm * 4 + fr) * DFF + col; *(f32x4*)sg = g[0]; *(f32x4*)(sg + 4) = g[1];
                       float* su = SU + ((size_t)u.pm * 2 + fr) * DFF + col; *(f32x4*)su = up[0]; *(f32x4*)(su + 4) = up[1]; }
                if (seam_hi) { float* sg = SG + ((size_t)u.pm * 4 + 2 + (fr - 14)) * DFF + col; *(f32x4*)sg = g[0]; *(f32x4*)(sg + 4) = g[1];
                    const int t = r & (SEQ - 1), b = r >> 11;
                    if (t >= SEQ - 2) { float* sp = out + O_PF + ((size_t)((layer * NB + b) * 2 + (t - (SEQ - 2)))) * DFF + col; *(f32x4*)sp = g[0]; *(f32x4*)(sp + 4) = g[1]; } }
                gp[0] = g[0]; gp[1] = g[1];
            }
        }
    }
};
struct EpiQkv {
    static constexpr bool PERM = true, AFTER_DRAIN = false;
    bf16_t* QKV; float* QS; const float* ssq; float* out;
    __device__ __forceinline__ void operator()(const f32x4 (&acc)[2][2][4][2], const Unit& u, int wr, int wc, int fr, int fq) const {
        const int which = u.pn >> 2, cb = 256 * (u.pn & 3) + wc * 32 + 8 * fq;
        bf16_t* dst = QKV + (size_t)which * ((WS_K - WS_Q) / 2);
        float rsv[2][4];
#pragma unroll
        for (int ai = 0; ai < 2; ++ai)
#pragma unroll
            for (int m = 0; m < 4; ++m) rsv[ai][m] = row_rstd(ssq, u.pm * BM + ai * HALF + wr * 64 + m * 16 + fr, fq);
        asm volatile("" ::: "memory");
#pragma unroll
        for (int ai = 0; ai < 2; ++ai)
#pragma unroll
            for (int m = 0; m < 4; ++m) {
                const int r = u.pm * BM + ai * HALF + wr * 64 + m * 16 + fr;
                const float rs = rsv[ai][m] * (which == 0 ? QSCALE : 1.0f);
                float* fp = nullptr;
                if (which == 0) { if (r >= MPR && r < MTOT) fp = QS + (size_t)(r - MPR) * D; }
                else if (r < MPR) fp = out + (which == 1 ? O_PK : O_PV) + (size_t)r * D;
                else if (r < MTOT) { const int rs_ = r - MPR, sb = rs_ >> 2, j = rs_ & 3; fp = out + (which == 1 ? O_SK : O_SV) + ((size_t)sb * LBUF + (LBUF - NST) + j) * D; }
#pragma unroll
                for (int bj = 0; bj < 2; ++bj) {
                    const f32x4 v0 = acc[ai][bj][m][0] * rs, v1 = acc[ai][bj][m][1] * rs;
                    const int c = cb + bj * HALF;
                    u32x4 w; w.x = cvt_pk_bf16(v0[0], v0[1]); w.y = cvt_pk_bf16(v0[2], v0[3]); w.z = cvt_pk_bf16(v1[0], v1[1]); w.w = cvt_pk_bf16(v1[2], v1[3]);
                    *(u32x4*)(dst + (size_t)r * D + c) = w;
                    if (fp) { *(f32x4*)(fp + c) = v0; *(f32x4*)(fp + c + 4) = v1; }
                }
            }
    }
};

template <class Epi, class Sched, bool ALIGN_EPI = false, bool SP2 = false>
__device__ __forceinline__ void gemm_phase(LAS unsigned char* lds, const Gemm g, const Sched& S, const Epi& E) {
    const int wid = g.wid, lane = lane_id(), tid = wid * 64 + lane, wr = wid >> 2, wc = wid & 3, fr = lane & 15, fq = lane >> 4;
    const int K = g.K, nt = K / BK;
    unsigned voffA[2], voffB[2];
#pragma unroll
    for (int i = 0; i < 2; ++i) { int R, C; stage_rc(tid * 16 + i * 8192, R, C); const int Rb = Epi::PERM ? ((R & ~31) + perm32(R & 31)) : R;
        voffA[i] = (unsigned)(R * K + C) * 2u; voffB[i] = (unsigned)(Rb * K + C) * 2u; }
    const size_t kstep = (size_t)(BK * 2);
    const size_t hstep = (size_t)HALF * K * 2;
    const size_t tstep = 2 * hstep;
    const unsigned ldsw = (unsigned)wid * 1024u;
    const int aoff = lds_byte(wr * 64 + fr, fq * 8), boff = lds_byte(wc * 32 + fr, fq * 8);
#define PG8_SA(b, h) (((b) * 2 + (h)) * HTB)
#define PG8_SB(b, h) ((4 + (b) * 2 + (h)) * HTB)
#define PG8_STAGE(bufoff, gbase, voff) do { _Pragma("unroll") for (int _i = 0; _i < 2; ++_i) \
        __builtin_amdgcn_global_load_lds((const unsigned*)((const char*)(gbase) + (voff)[_i]), (LAS unsigned*)(lds + (bufoff) + ldsw + _i * 8192), 16, 0, 0); } while (0)
#define PG8_LDA(dst, b, h) do { _Pragma("unroll") for (int m = 0; m < 4; ++m) _Pragma("unroll") for (int k = 0; k < 2; ++k) dst[m][k] = *(const LAS bf16x8*)(lds + PG8_SA(b, h) + aoff + m * 2048 + k * 1024); } while (0)
#define PG8_LDB(dst, b, h) do { _Pragma("unroll") for (int n = 0; n < 2; ++n) _Pragma("unroll") for (int k = 0; k < 2; ++k) dst[n][k] = *(const LAS bf16x8*)(lds + PG8_SB(b, h) + boff + n * 2048 + k * 1024); } while (0)
#define PG8_MMA(ai, bj, At, Bt) do { __builtin_amdgcn_s_setprio(1); _Pragma("unroll") for (int m = 0; m < 4; ++m) _Pragma("unroll") for (int n = 0; n < 2; ++n) _Pragma("unroll") for (int k = 0; k < 2; ++k) \
        acc[ai][bj][m][n] = __builtin_amdgcn_mfma_f32_16x16x32_bf16(Bt[n][k], At[m][k], acc[ai][bj][m][n], 0, 0, 0); __builtin_amdgcn_s_setprio(0); } while (0)
#define PG8_WAIT_V(n) asm volatile("s_waitcnt vmcnt(" #n ")" ::: "memory")
#define PG8_WAIT_L(n) asm volatile("s_waitcnt lgkmcnt(" #n ")" ::: "memory")
#define PG8_BAR __builtin_amdgcn_s_barrier()
#define PG8_SCHED __builtin_amdgcn_sched_barrier(0)
    Unit cur, nxt; int ui = 0;
    if (!S.next(0, cur)) return;
    f32x4 acc[2][2][4][2];
#pragma unroll
    for (int a = 0; a < 2; ++a)
#pragma unroll
        for (int b = 0; b < 2; ++b)
#pragma unroll
            for (int m = 0; m < 4; ++m)
#pragma unroll
                for (int n = 0; n < 2; ++n) acc[a][b][m][n] = (f32x4){0.f, 0.f, 0.f, 0.f};
    bf16x8 At[4][2], B0[2][2], B1[2][2];
    const char* cA = (const char*)g.A + (size_t)cur.pm * tstep; const char* cB = (const char*)g.Bt + (size_t)cur.pn * tstep;
    S.a_ready(cur);
    if constexpr (SP2) {
        PG8_STAGE(PG8_SB(0, 0), cB, voffB); PG8_STAGE(PG8_SB(0, 1), cB + hstep, voffB); PG8_STAGE(PG8_SA(0, 0), cA, voffA); PG8_STAGE(PG8_SA(0, 1), cA + hstep, voffA);
        if (wr == 1) PG8_BAR;
        PG8_WAIT_V(2); PG8_BAR;
        PG8_STAGE(PG8_SB(1, 0), cB + kstep, voffB); PG8_STAGE(PG8_SA(1, 0), cA + kstep, voffA); PG8_STAGE(PG8_SB(1, 1), cB + hstep + kstep, voffB);
        PG8_WAIT_V(6); PG8_BAR;
    } else {
        PG8_STAGE(PG8_SB(0, 0), cB, voffB); PG8_STAGE(PG8_SA(0, 0), cA, voffA); PG8_STAGE(PG8_SB(0, 1), cB + hstep, voffB); PG8_STAGE(PG8_SA(0, 1), cA + hstep, voffA);
        if (wr == 1) PG8_BAR;
        PG8_WAIT_V(4); PG8_BAR;
        PG8_STAGE(PG8_SB(1, 0), cB + kstep, voffB); PG8_STAGE(PG8_SA(1, 0), cA + kstep, voffA); PG8_STAGE(PG8_SB(1, 1), cB + hstep + kstep, voffB);
        PG8_WAIT_V(6); PG8_BAR;
    }
    for (;;) {
        const bool has_next = S.next(ui + 1, nxt);
        const char* nA = has_next ? (const char*)g.A + (size_t)nxt.pm * tstep : cA; const char* nB = has_next ? (const char*)g.Bt + (size_t)nxt.pn * tstep : cB;
        for (int t = 0; t < nt; t += 2) {
            const bool last = (t == nt - 2);
            const char* a1 = cA + (size_t)(t + 1) * kstep;
            const char* a2 = last ? nA : cA + (size_t)(t + 2) * kstep; const char* b2 = last ? nB : cB + (size_t)(t + 2) * kstep;
            const char* a3 = a2 + kstep; const char* b3 = b2 + kstep;
            if (last && has_next) S.a_ready(nxt);
            if constexpr (SP2) {
            PG8_LDB(B0, 0, 0); PG8_LDB(B1, 0, 1); PG8_SCHED; PG8_LDA(At, 0, 0); PG8_STAGE(PG8_SA(1, 1), a1 + hstep, voffA);
            PG8_WAIT_V(8); PG8_WAIT_L(0); PG8_BAR; PG8_MMA(0, 0, At, B0); PG8_MMA(0, 1, At, B1); PG8_BAR; PG8_SCHED;
            PG8_LDA(At, 0, 1); PG8_STAGE(PG8_SB(0, 0), b2, voffB); PG8_STAGE(PG8_SB(0, 1), b2 + hstep, voffB); PG8_STAGE(PG8_SA(0, 0), a2, voffA);
            PG8_WAIT_V(8); PG8_WAIT_L(0); PG8_BAR; PG8_MMA(1, 0, At, B0); PG8_MMA(1, 1, At, B1); PG8_BAR; PG8_SCHED;
            PG8_LDB(B0, 1, 0); PG8_LDB(B1, 1, 1); PG8_SCHED; PG8_LDA(At, 1, 0); PG8_STAGE(PG8_SA(0, 1), a2 + hstep, voffA);
            PG8_WAIT_V(8); PG8_WAIT_L(0); PG8_BAR; PG8_MMA(0, 0, At, B0); PG8_MMA(0, 1, At, B1); PG8_BAR; PG8_SCHED;
            PG8_LDA(At, 1, 1); PG8_STAGE(PG8_SB(1, 0), b3, voffB); PG8_STAGE(PG8_SB(1, 1), b3 + hstep, voffB); PG8_STAGE(PG8_SA(1, 0), a3, voffA);
            PG8_WAIT_V(8); PG8_WAIT_L(0); PG8_BAR; PG8_MMA(1, 0, At, B0); PG8_MMA(1, 1, At, B1); PG8_BAR; PG8_SCHED;
            } else {
            PG8_LDB(B0, 0, 0); PG8_SCHED; PG8_LDA(At, 0, 0); PG8_STAGE(PG8_SA(1, 1), a1 + hstep, voffA);
            PG8_WAIT_L(8); PG8_BAR; PG8_WAIT_L(0); PG8_MMA(0, 0, At, B0); PG8_BAR; PG8_SCHED;
            PG8_LDB(B1, 0, 1); PG8_STAGE(PG8_SB(0, 0), b2, voffB);
            PG8_BAR; PG8_WAIT_L(0); PG8_MMA(0, 1, At, B1); PG8_BAR;
            PG8_LDA(At, 0, 1); PG8_STAGE(PG8_SA(0, 0), a2, voffA);
            PG8_BAR; PG8_WAIT_L(0); PG8_MMA(1, 0, At, B0); PG8_BAR; PG8_SCHED;
            PG8_STAGE(PG8_SB(0, 1), b2 + hstep, voffB);
            PG8_WAIT_V(6); PG8_BAR; PG8_MMA(1, 1, At, B1); PG8_BAR;
            PG8_LDB(B0, 1, 0); PG8_SCHED; PG8_LDA(At, 1, 0); PG8_STAGE(PG8_SA(0, 1), a2 + hstep, voffA);
            PG8_WAIT_L(8); PG8_BAR; PG8_WAIT_L(0); PG8_MMA(0, 0, At, B0); PG8_BAR; PG8_SCHED;
            PG8_LDB(B1, 1, 1); PG8_STAGE(PG8_SB(1, 0), b3, voffB);
            PG8_BAR; PG8_WAIT_L(0); PG8_MMA(0, 1, At, B1); PG8_BAR;
            PG8_LDA(At, 1, 1); PG8_STAGE(PG8_SA(1, 0), a3, voffA);
            PG8_BAR; PG8_WAIT_L(0); PG8_MMA(1, 0, At, B0); PG8_BAR; PG8_SCHED;
            PG8_STAGE(PG8_SB(1, 1), b3 + hstep, voffB);
            PG8_WAIT_V(6); PG8_BAR; PG8_MMA(1, 1, At, B1); PG8_BAR;
            }
        }
        if constexpr (ALIGN_EPI) { if (wr == 0) PG8_BAR; }
        if constexpr (!Epi::AFTER_DRAIN) { E(acc, cur, wr, wc, fr, fq); S.done(cur); }
        if (!has_next) break;
#pragma unroll
        for (int a = 0; a < 2; ++a)
#pragma unroll
            for (int b = 0; b < 2; ++b)
#pragma unroll
                for (int m = 0; m < 4; ++m)
#pragma unroll
                    for (int n = 0; n < 2; ++n) acc[a][b][m][n] = (f32x4){0.f, 0.f, 0.f, 0.f};
        cur = nxt; cA = nA; cB = nB; ++ui;
        if constexpr (ALIGN_EPI) { if (wr == 1) PG8_BAR; }
    }
    PG8_WAIT_V(0);
    if constexpr (!ALIGN_EPI) { if (wr == 0) PG8_BAR; }
    PG8_BAR;
#undef PG8_SA
#undef PG8_SB
#undef PG8_STAGE
#undef PG8_LDA
#undef PG8_LDB
#undef PG8_MMA
#undef PG8_WAIT_V
#undef PG8_WAIT_L
#undef PG8_BAR
#undef PG8_SCHED
}
}

__device__ __forceinline__ void transpose_item(const float* W, int K, int N, bf16_t* WT, int k0, int np0, int srcn0, const float* g, LAS float* scr, int lane) {
    f32x4 v[8];
#pragma unroll
    for (int i = 0; i < 8; ++i) { const int kk = 8 * i + (lane >> 3); v[i] = __builtin_nontemporal_load((const f32x4*)(W + (size_t)(k0 + kk) * N + srcn0 + (lane & 7) * 4)); }
#pragma unroll
    for (int i = 0; i < 8; ++i) { const int kk = 8 * i + (lane >> 3); const float gg = g ? g[k0 + kk] : 1.0f; LAS float* d = scr + kk * 33 + (lane & 7) * 4;
        d[0] = v[i].x * gg; d[1] = v[i].y * gg; d[2] = v[i].z * gg; d[3] = v[i].w * gg; }
    asm volatile("s_waitcnt lgkmcnt(0)" ::: "memory");
    const int c = lane & 7;
#pragma unroll
    for (int j = 0; j < 4; ++j) { const int n = (lane >> 3) + 8 * j; const LAS float* s = scr + (8 * c) * 33 + n;
        u32x4 o; o.x = cvt_pk_bf16(s[0 * 33], s[1 * 33]); o.y = cvt_pk_bf16(s[2 * 33], s[3 * 33]); o.z = cvt_pk_bf16(s[4 * 33], s[5 * 33]); o.w = cvt_pk_bf16(s[6 * 33], s[7 * 33]);
        *(u32x4*)(WT + (size_t)(np0 + n) * K + k0 + 8 * c) = o; }
    asm volatile("s_waitcnt lgkmcnt(0)" ::: "memory");
}
__device__ __forceinline__ int src_in_ab(int np) {
    const int pn = np >> 8, cc = np & 255, bj = cc >> 7, off = cc & 127;
    if (pn < 4) return (bj ? 512 : 0) + 128 * pn + off;
    if (pn < 8) return (bj ? 2048 : 1536) + 128 * (pn - 4) + off;
    return 1024 + 256 * (pn - 8) + cc;
}
__device__ __forceinline__ int src_ffn(int np) { const int pn = np >> 8, cc = np & 255, bj = cc >> 7, off = cc & 127; return (bj ? DFF : 0) + 128 * pn + off; }

struct Args { const float* in[22]; float* out; unsigned char* ws; };

__device__ __forceinline__ void copy_range_simple(const Args& a, size_t lo, size_t hi, int bi, int nb, int tid) {
    const size_t per = (size_t)(LBUF - NST) * D / 4;
    const size_t stride = (size_t)nb * NTHREADS;
    for (size_t i0 = lo + (size_t)bi * NTHREADS + tid; i0 < hi; i0 += 8 * stride) {
        f32x4 kv[8], vv[8];
#pragma unroll
        for (int u = 0; u < 8; ++u) { const size_t i = i0 + u * stride; if (i < hi) { const size_t sb = i / per, rem = i % per;
            kv[u] = __builtin_nontemporal_load((const f32x4*)(a.in[4] + (sb * LBUF + NST) * D) + rem); vv[u] = __builtin_nontemporal_load((const f32x4*)(a.in[5] + (sb * LBUF + NST) * D) + rem); } }
#pragma unroll
        for (int u = 0; u < 8; ++u) { const size_t i = i0 + u * stride; if (i < hi) { const size_t sb = i / per, rem = i % per;
            __builtin_nontemporal_store(kv[u], (f32x4*)(a.out + O_SK + sb * LBUF * D) + rem); __builtin_nontemporal_store(vv[u], (f32x4*)(a.out + O_SV + sb * LBUF * D) + rem); } }
    }
}
template <int NB> __device__ __forceinline__ void copy_range(const Args& a, size_t lo_, size_t hi_, int bi, int wave) {
    constexpr unsigned per = (unsigned)((LBUF - NST) * D / 4);
    const unsigned lo = (unsigned)lo_, hi = (unsigned)hi_; constexpr unsigned stride = (unsigned)NB * NTHREADS;
    const float* kin = a.in[4]; const float* vin = a.in[5]; float* outp = a.out;
#define CP_SRC(T, i) ((const f32x4*)((T) + ((size_t)((i) / per) * LBUF + NST) * D) + ((i) % per))
#define CP_DST(O, i) ((f32x4*)(outp + (O) + (size_t)((i) / per) * LBUF * D) + ((i) % per))
#define CP_LOAD(KK, VV, base) _Pragma("unroll") for (int u = 0; u < 8; ++u) { const unsigned i = (base) + u * stride; KK[u] = __builtin_nontemporal_load(CP_SRC(kin, i)); VV[u] = __builtin_nontemporal_load(CP_SRC(vin, i)); }
#define CP_STORE(KK, VV, base) _Pragma("unroll") for (int u = 0; u < 8; ++u) { const unsigned i = (base) + u * stride; __builtin_nontemporal_store(KK[u], CP_DST(O_SK, i)); __builtin_nontemporal_store(VV[u], CP_DST(O_SV, i)); }
#define CP_BODY CP_LOAD(kB, vB, i0 + 8u * stride) CP_STORE(kA, vA, i0) CP_LOAD(kA, vA, i0 + 16u * stride) CP_STORE(kB, vB, i0 + 8u * stride) i0 += 16u * stride;
    unsigned i0 = lo + (unsigned)bi * NTHREADS + (unsigned)(wave * 64 + lane_id());
    if (i0 >= hi) return;
    const unsigned nIt = ((hi - i0 + stride - 1u) / stride) >> 4;
    f32x4 kA[8], vA[8], kB[8], vB[8];
    if (nIt) {
        CP_LOAD(kA, vA, i0)
        if (nIt >= 2u) {
            CP_BODY
            for (unsigned it = 2u; it < nIt; ++it) { CP_BODY }
        }
        CP_LOAD(kB, vB, i0 + 8u * stride) CP_STORE(kA, vA, i0) CP_STORE(kB, vB, i0 + 8u * stride) i0 += 16u * stride;
    }
    if (i0 < hi) {
#pragma unroll
        for (int u = 0; u < 8; ++u) { const unsigned i = i0 + u * stride; if (i < hi) { kA[u] = __builtin_nontemporal_load(CP_SRC(kin, i)); vA[u] = __builtin_nontemporal_load(CP_SRC(vin, i)); } }
#pragma unroll
        for (int u = 0; u < 8; ++u) { const unsigned i = i0 + (8 + u) * stride; if (i < hi) { kB[u] = __builtin_nontemporal_load(CP_SRC(kin, i)); vB[u] = __builtin_nontemporal_load(CP_SRC(vin, i)); } }
#pragma unroll
        for (int u = 0; u < 8; ++u) { const unsigned i = i0 + u * stride; if (i < hi) { __builtin_nontemporal_store(kA[u], CP_DST(O_SK, i)); __builtin_nontemporal_store(vA[u], CP_DST(O_SV, i)); } }
#pragma unroll
        for (int u = 0; u < 8; ++u) { const unsigned i = i0 + (8 + u) * stride; if (i < hi) { __builtin_nontemporal_store(kB[u], CP_DST(O_SK, i)); __builtin_nontemporal_store(vB[u], CP_DST(O_SV, i)); } }
    }
#undef CP_BODY
#undef CP_LOAD
#undef CP_STORE
#undef CP_SRC
#undef CP_DST
}
constexpr int FR_P1 = 10, FR_P4 = 22, FR_P10 = 22, GE_P1 = 168, GE_FF = 208;
constexpr size_t CP_TOT = (size_t)(LBUF - NST) * D / 4 * NSB;
constexpr int FR_P2 = 4;
constexpr size_t CP_P2 = CP_TOT * (64 - FR_P1 - FR_P4 - FR_P10 - FR_P2) / 64;
constexpr size_t CP_C0 = CP_TOT * (64 - FR_P1 - FR_P4 - FR_P10) / 64, CP_C1 = CP_C0 + CP_TOT * FR_P1 / 64, CP_C2 = CP_C1 + CP_TOT * FR_P4 / 64;

constexpr int WI_IN = (D / 64) * (NIN / 32), WI_SQ = (D / 64) * (D / 32), WI_QKV = (D / 64) * (3 * D / 32), WI_F = (D / 64) * (2 * DFF / 32), WI_DN = (DFF / 64) * (D / 32);
constexpr int WI_TOT = WI_IN + 2 * WI_SQ + WI_QKV + 2 * WI_F + 2 * WI_DN;
__device__ __forceinline__ void p0_weights(const Args& a, LAS unsigned char* lds, int it_lo, int it_hi, int gw, int NGW, int lane, int wave) {
    LAS float* scr = (LAS float*)(lds + wave * 16384);
    unsigned char* ws = a.ws;
    constexpr int I_IN = WI_IN, I_SQ = WI_SQ, I_QKV = WI_QKV, I_F = WI_F, I_DN = WI_DN;
    for (int it = it_lo + gw; it < it_hi; it += NGW) {
        int r = it;
        if (r < I_IN) { const int nb = NIN / 32, kb = r / nb, n0 = 32 * (r % nb); transpose_item(a.in[10], D, NIN, (bf16_t*)(ws + WS_WIN), 64 * kb, n0, src_in_ab(n0), a.in[7], scr, lane); continue; } r -= I_IN;
        if (r < I_SQ) { const int nb = D / 32, kb = r / nb, n0 = 32 * (r % nb); transpose_item(a.in[16], D, D, (bf16_t*)(ws + WS_WOUT), 64 * kb, n0, n0, nullptr, scr, lane); continue; } r -= I_SQ;
        if (r < I_QKV) { const int nb = 3 * D / 32, kb = r / nb, n0 = 32 * (r % nb); transpose_item(a.in[17], D, 3 * D, (bf16_t*)(ws + WS_WQKV), 64 * kb, n0, n0, a.in[7] + D, scr, lane); continue; } r -= I_QKV;
        if (r < I_SQ) { const int nb = D / 32, kb = r / nb, n0 = 32 * (r % nb); transpose_item(a.in[18], D, D, (bf16_t*)(ws + WS_WO), 64 * kb, n0, n0, nullptr, scr, lane); continue; } r -= I_SQ;
        if (r < 2 * I_F) { const int l = r / I_F; r -= l * I_F; const int nb = 2 * DFF / 32, kb = r / nb, n0 = 32 * (r % nb);
            transpose_item(a.in[19] + (size_t)l * D * 2 * DFF, D, 2 * DFF, (bf16_t*)(ws + (l ? WS_WF1 : WS_WF0)), 64 * kb, n0, src_ffn(n0), a.in[8] + l * D, scr, lane); continue; } r -= 2 * I_F;
        { const int l = r / I_DN; r -= l * I_DN; const int nb = D / 32, kb = r / nb, n0 = 32 * (r % nb);
            transpose_item(a.in[21] + (size_t)l * DFF * D, DFF, D, (bf16_t*)(ws + (l ? WS_WD1 : WS_WD0)), 64 * kb, n0, n0, nullptr, scr, lane); }
    }
}
__device__ __forceinline__ void p0_prologue(const Args& a, LAS unsigned char* lds, int gw, int NGW, int lane, int wave) {
    unsigned char* ws = a.ws;
    p0_weights(a, lds, 0, (gridDim.x == 256) ? WI_IN : WI_TOT, gw, NGW, lane, wave);
    bf16_t* HB = (bf16_t*)(ws + WS_HB); float* ssq = (float*)(ws + WS_SSQ);
    for (int r0 = gw; r0 < MPAD; r0 += 2 * NGW) {
        f32x4 v[2][4]; float sq[2];
#pragma unroll
        for (int h = 0; h < 2; ++h) { const int r = r0 + h * NGW; sq[h] = 0.f;
            if (r < MTOT) { const f32x4* xr = (const f32x4*)((r < MPR) ? a.in[0] + (size_t)r * D : a.in[1] + (size_t)(r - MPR) * D) + lane;
#pragma unroll
                for (int j = 0; j < 4; ++j) v[h][j] = __builtin_nontemporal_load(xr + 64 * j); }
            else {
#pragma unroll
                for (int j = 0; j < 4; ++j) v[h][j] = (f32x4){0.f, 0.f, 0.f, 0.f}; } }
#pragma unroll
        for (int h = 0; h < 2; ++h) { const int r = r0 + h * NGW; if (r >= MPAD) continue;
#pragma unroll
            for (int j = 0; j < 4; ++j) sq[h] += (v[h][j].x * v[h][j].x + v[h][j].y * v[h][j].y) + (v[h][j].z * v[h][j].z + v[h][j].w * v[h][j].w);
            const float s = wave_sum(sq[h]);
            u32x2* o8 = (u32x2*)(HB + (size_t)r * D) + lane;
#pragma unroll
            for (int j = 0; j < 4; ++j) { u32x2 w; w.x = cvt_pk_bf16(v[h][j].x, v[h][j].y); w.y = cvt_pk_bf16(v[h][j].z, v[h][j].w); o8[64 * j] = w; }
            if (r < MPR) { if (lane < 16) ssq[(size_t)r * 64 + lane] = (lane == 0) ? s : 0.f; } else ssq[(size_t)r * 64 + lane] = (lane == 0) ? s : 0.f; }
    }
    {
        const int tot = NSB * 26 * (CH / 4);
        for (int i = gw * 64 + lane; i < tot; i += NGW * 64) { const int sb = i / (26 * (CH / 4)), rem = i % (26 * (CH / 4));
            ((f32x4*)(a.out + O_SCA + (size_t)sb * 30 * CH))[rem] = ((const f32x4*)(a.in[2] + (size_t)sb * 30 * CH + 4 * CH))[rem]; }
    }
    if (gridDim.x == 256) copy_range<256>(a, 0, CP_P2, blockIdx.x, wave); else copy_range_simple(a, 0, CP_C0, blockIdx.x, gridDim.x, wave * 64 + lane);
}

__device__ __forceinline__ void p2_conv(const Args& a, LAS unsigned char* lds, int tid, int lane, int wave) {
    unsigned char* ws = a.ws;
    const bf16_t* GA = (const bf16_t*)(ws + WS_GA); bf16_t* AB = (bf16_t*)(ws + WS_AB);
    LAS float* T = (LAS float*)lds;
    for (int u = blockIdx.x; u < 512 + NSB; u += gridDim.x) {
        const float* wa = a.in[11]; const float* ba = a.in[12]; const float* lg = a.in[13]; const float* lb = a.in[14]; const float* wb = a.in[15];
        asm volatile("" : "+s"(wa), "+s"(ba), "+s"(lg), "+s"(lb), "+s"(wb));
        const bool samp = u >= 512; const int sb = u - 512;
        const int row0 = samp ? MPR + sb * NST : u * 32, nrows = samp ? NST : 32;
        const int t0 = samp ? 0 : (row0 & (SEQ - 1));
        const int nvec = (nrows + 30) * (CH / 8);
        {
            u32x4 wv[8];
#pragma unroll
            for (int it = 0; it < 8; ++it) { const int i = tid + it * NTHREADS; const int e = i >> 6, c = (i & 63) * 8; const int p = t0 - 30 + e;
                wv[it] = (u32x4){0u, 0u, 0u, 0u};
                if (i < nvec && p >= 0) wv[it] = *(const u32x4*)(GA + (size_t)(row0 - t0 + p) * GAW + c); }
#pragma unroll
            for (int it = 0; it < 8; ++it) { const int i = tid + it * NTHREADS; const int e = i >> 6, c = (i & 63) * 8; const int p = t0 - 30 + e;
                if (i < nvec && (p >= 0 || !samp)) { const u32x4 w = wv[it];
                    *(LAS f32x4*)(T + e * CH + c) = (f32x4){bflo(w.x), bfhi(w.x), bflo(w.y), bfhi(w.y)}; *(LAS f32x4*)(T + e * CH + c + 4) = (f32x4){bflo(w.z), bfhi(w.z), bflo(w.w), bfhi(w.w)}; } }
            if (samp) {
                f32x4 s0_[4], s1_[4];
#pragma unroll
                for (int it = 0; it < 4; ++it) { const int i = tid + it * NTHREADS; if (i < 30 * 64) { const float* sp = a.in[2] + ((size_t)sb * 30 + (i >> 6)) * CH + (i & 63) * 8; s0_[it] = *(const f32x4*)sp; s1_[it] = *(const f32x4*)(sp + 4); } }
#pragma unroll
                for (int it = 0; it < 4; ++it) { const int i = tid + it * NTHREADS; if (i < 30 * 64) { *(LAS f32x4*)(T + (i >> 6) * CH + (i & 63) * 8) = s0_[it]; *(LAS f32x4*)(T + (i >> 6) * CH + (i & 63) * 8 + 4) = s1_[it]; } }
            }
        }
        __syncthreads();
        if (tid < 256) {
            const int c = 2 * tid; f32x2 w[KA];
#pragma unroll
            for (int k = 0; k < KA; ++k) w[k] = *(const f32x2*)(wa + k * CH + c);
            const f32x2 bias = *(const f32x2*)(ba + c);
            if (!samp) {
#pragma clang loop unroll(disable)
                for (int hb = 0; hb < 32; hb += 16) {
                    f32x2 x[46];
#pragma unroll
                    for (int e = 0; e < 46; ++e) x[e] = *(const LAS f32x2*)(T + (hb + e) * CH + c);
#pragma unroll
                    for (int i = 0; i < 16; ++i) {
                        f32x2 s0 = bias, s1 = (f32x2){0.f, 0.f}, s2 = s1, s3 = s1;
#pragma unroll
                        for (int k = 0; k < 28; k += 4) { s0 += w[k] * x[i + k]; s1 += w[k + 1] * x[i + k + 1]; s2 += w[k + 2] * x[i + k + 2]; s3 += w[k + 3] * x[i + k + 3]; }
                        s0 += w[28] * x[i + 28]; s1 += w[29] * x[i + 29]; s2 += w[30] * x[i + 30];
                        *(LAS f32x2*)(T + (hb + i) * CH + c) = (s0 + s1) + (s2 + s3);
                    }
                }
            } else {
                f32x2 x[34];
#pragma unroll
                for (int e = 0; e < 34; ++e) x[e] = *(const LAS f32x2*)(T + e * CH + c);
#pragma unroll
                for (int i = 0; i < NST; ++i) {
                    f32x2 s0 = bias, s1 = (f32x2){0.f, 0.f}, s2 = s1, s3 = s1;
#pragma unroll
                    for (int k = 0; k < 28; k += 4) { s0 += w[k] * x[i + k]; s1 += w[k + 1] * x[i + k + 1]; s2 += w[k + 2] * x[i + k + 2]; s3 += w[k + 3] * x[i + k + 3]; }
                    s0 += w[28] * x[i + 28]; s1 += w[29] * x[i + 29]; s2 += w[30] * x[i + 30];
                    *(LAS f32x2*)(T + i * CH + c) = (s0 + s1) + (s2 + s3);
                }
            }
        } else {
            const int t2 = tid - 256, c = (t2 & 63) * 8, rc = t2 >> 6, rbase = rc * 8;
            const int nr = samp ? (rc == 0 ? NST : 0) : 8;
            float wk[3][8];
#pragma unroll
            for (int k = 0; k < 3; ++k) { const f32x4 wa0 = *(const f32x4*)(wb + k * CH + c), wa1 = *(const f32x4*)(wb + k * CH + c + 4);
                wk[k][0] = wa0.x; wk[k][1] = wa0.y; wk[k][2] = wa0.z; wk[k][3] = wa0.w; wk[k][4] = wa1.x; wk[k][5] = wa1.y; wk[k][6] = wa1.z; wk[k][7] = wa1.w; }
            float xm2[8], xm1[8];
            {
                u32x4 a2 = (u32x4){0u, 0u, 0u, 0u}, a1 = a2;
                if (nr && t0 + rbase - 2 >= 0) { a2 = *(const u32x4*)(GA + (size_t)(row0 + rbase - 2) * GAW + 512 + c); a1 = *(const u32x4*)(GA + (size_t)(row0 + rbase - 1) * GAW + 512 + c); }
                xm2[0] = bflo(a2.x); xm2[1] = bfhi(a2.x); xm2[2] = bflo(a2.y); xm2[3] = bfhi(a2.y); xm2[4] = bflo(a2.z); xm2[5] = bfhi(a2.z); xm2[6] = bflo(a2.w); xm2[7] = bfhi(a2.w);
                xm1[0] = bflo(a1.x); xm1[1] = bfhi(a1.x); xm1[2] = bflo(a1.y); xm1[3] = bfhi(a1.y); xm1[4] = bflo(a1.z); xm1[5] = bfhi(a1.z); xm1[6] = bflo(a1.w); xm1[7] = bfhi(a1.w);
                if (samp && nr) { const float* sp = a.in[3] + (size_t)sb * 2 * CH + c; const f32x4 p0 = *(const f32x4*)sp, p1 = *(const f32x4*)(sp + 4), q0 = *(const f32x4*)(sp + CH), q1 = *(const f32x4*)(sp + CH + 4);
                    xm2[0] = p0.x; xm2[1] = p0.y; xm2[2] = p0.z; xm2[3] = p0.w; xm2[4] = p1.x; xm2[5] = p1.y; xm2[6] = p1.z; xm2[7] = p1.w;
                    xm1[0] = q0.x; xm1[1] = q0.y; xm1[2] = q0.z; xm1[3] = q0.w; xm1[4] = q1.x; xm1[5] = q1.y; xm1[6] = q1.z; xm1[7] = q1.w; }
            }
#pragma clang loop unroll(disable)
            for (int k0 = 0; k0 < nr; k0 += 4) {
                u32x4 cxv[4], gbv[4];
#pragma unroll
                for (int k = 0; k < 4; ++k) { cxv[k] = *(const u32x4*)(GA + (size_t)(row0 + rbase + k0 + k) * GAW + 512 + c); gbv[k] = *(const u32x4*)(GA + (size_t)(row0 + rbase + k0 + k) * GAW + 1024 + c); }
#pragma unroll
                for (int k = 0; k < 4; ++k) {
                    const u32x4 xv = cxv[k], gv = gbv[k];
                    float o[8];
#pragma unroll
                    for (int e = 0; e < 8; ++e) {
                        const unsigned xw = e < 2 ? xv.x : (e < 4 ? xv.y : (e < 6 ? xv.z : xv.w)), gw_ = e < 2 ? gv.x : (e < 4 ? gv.y : (e < 6 ? gv.z : gv.w));
                        const float x0 = (e & 1) ? bfhi(xw) : bflo(xw), gb = (e & 1) ? bfhi(gw_) : bflo(gw_);
                        o[e] = gb * (wk[0][e] * xm2[e] + wk[1][e] * xm1[e] + wk[2][e] * x0); xm2[e] = xm1[e]; xm1[e] = x0; }
                    u32x4 w4; w4.x = cvt_pk_bf16(o[0], o[1]); w4.y = cvt_pk_bf16(o[2], o[3]); w4.z = cvt_pk_bf16(o[4], o[5]); w4.w = cvt_pk_bf16(o[6], o[7]);
                    *(u32x4*)(AB + (size_t)(row0 + rbase + k0 + k) * D + 512 + c) = w4;
                }
            }
        }
        __syncthreads();
        {
            const int c = lane * 8;
            const f32x4 g0 = *(const f32x4*)(lg + c), g1 = *(const f32x4*)(lg + c + 4), b0 = *(const f32x4*)(lb + c), b1 = *(const f32x4*)(lb + c + 4);
            f32x4 v0[4], v1[4]; float mu[4], rstd[4];
#pragma unroll
            for (int j = 0; j < 4; ++j) { const int rr = wave + 8 * j; const int rc = rr < nrows ? rr : 0; v0[j] = *(const LAS f32x4*)(T + rc * CH + c); v1[j] = *(const LAS f32x4*)(T + rc * CH + c + 4); }
#pragma unroll
            for (int j = 0; j < 4; ++j) { const float s_ = (v0[j].x + v0[j].y) + (v0[j].z + v0[j].w) + (v1[j].x + v1[j].y) + (v1[j].z + v1[j].w); mu[j] = wave_sum(s_) * (1.0f / CH); }
#pragma unroll
            for (int j = 0; j < 4; ++j) { v0[j] = v0[j] - mu[j]; v1[j] = v1[j] - mu[j];
                const float q = (v0[j].x * v0[j].x + v0[j].y * v0[j].y) + (v0[j].z * v0[j].z + v0[j].w * v0[j].w) + (v1[j].x * v1[j].x + v1[j].y * v1[j].y) + (v1[j].z * v1[j].z + v1[j].w * v1[j].w);
                rstd[j] = rsqrtf(wave_sum(q) * (1.0f / CH) + LN_EPS); }
#pragma unroll
            for (int j = 0; j < 4; ++j) { const int rr = wave + 8 * j;
                if (rr < nrows) {
                    f32x4 a0 = v0[j] * rstd[j] * g0 + b0, a1 = v1[j] * rstd[j] * g1 + b1;
#pragma unroll
                    for (int e = 0; e < 4; ++e) { a0[e] = a0[e] * sigmoidf_(a0[e]); a1[e] = a1[e] * sigmoidf_(a1[e]); }
                    u32x4 w4; w4.x = cvt_pk_bf16(a0[0], a0[1]); w4.y = cvt_pk_bf16(a0[2], a0[3]); w4.z = cvt_pk_bf16(a1[0], a1[1]); w4.w = cvt_pk_bf16(a1[2], a1[3]);
                    *(u32x4*)(AB + (size_t)(row0 + rr) * D + c) = w4;
                } }
        }
        __syncthreads();
    }
}

__device__ __forceinline__ void panel_fix(const Args& a, int layer, int pm, int tid) {
    unsigned char* ws = a.ws;
    bf16_t* U = (bf16_t*)(ws + WS_U); const float* SG = (const float*)(ws + WS_SG); const float* SU = (const float*)(ws + WS_SU);
    const float* wc = a.in[20] + (size_t)layer * 3 * DFF;
    constexpr int NCV = DFF / 8;
    const bool first = (pm & 7) == 0;
    for (int it = tid; it < 2 * NCV; it += NTHREADS) {
        const int j = it >= NCV ? 1 : 0, cv = it - j * NCV, c = cv * 8;
        float gm2[8], gm1[8], g0[8], up[8];
        const float* cur = SG + (size_t)pm * 4 * DFF + c; const float* prv = SG + (size_t)(pm - 1) * 4 * DFF + c;
#pragma unroll
        for (int e = 0; e < 8; ++e) {
            if (j == 0) { gm2[e] = first ? 0.f : prv[2 * DFF + e]; gm1[e] = first ? 0.f : prv[3 * DFF + e]; g0[e] = cur[e]; }
            else { gm2[e] = first ? 0.f : prv[3 * DFF + e]; gm1[e] = cur[e]; g0[e] = cur[DFF + e]; }
            up[e] = SU[((size_t)pm * 2 + j) * DFF + c + e];
        }
        float o[8];
#pragma unroll
        for (int e = 0; e < 8; ++e) { const float y = wc[c + e] * gm2[e] + wc[DFF + c + e] * gm1[e] + wc[2 * DFF + c + e] * g0[e]; o[e] = y * sigmoidf_(y) * up[e]; }
        u32x4 w4; w4.x = cvt_pk_bf16(o[0], o[1]); w4.y = cvt_pk_bf16(o[2], o[3]); w4.z = cvt_pk_bf16(o[4], o[5]); w4.w = cvt_pk_bf16(o[6], o[7]);
        *(u32x4*)(U + (size_t)(pm * 256 + j) * DFF + c) = w4;
    }
}

constexpr int AT_OACC = 0, AT_ML = 256 * 64 * 4, AT_STG = AT_ML + 2048, AT_KSTR = 144, AT_WSTG = 2 * 32 * AT_KSTR, AT_PSC = 0;
__device__ __forceinline__ int at_swz(int ql) { return (ql ^ (ql >> 4)) & 15; }
static_assert(AT_STG + NWAVES * AT_WSTG <= MISC_OFF && NWAVES * 2048 <= AT_ML, "attention LDS");
__device__ __forceinline__ int crow(int r, int hi) { return (r & 3) + 8 * (r >> 2) + 4 * hi; }

struct AttnRes { f32x16 o0, o1; float m, l; };
#define AT_KLOAD(X, kk_, vv_) _Pragma("unroll") for (int j = 0; j < 4; ++j) { const int kv_ = (lane >> 3) + 8 * j; const int sv_ = kb##X + kv_ < 0 ? 0 : kb##X + kv_; \
        const unsigned ro_ = (unsigned)((cls##X + dil##X * sv_) * D + (lane & 7) * 8) * 2u; kk_[j] = *(const u32x4*)((const char*)Kh + ro_); vv_[j] = *(const u32x4*)((const char*)Vh + ro_); }
#define AT_CB() asm volatile("" ::: "memory")
__device__ __forceinline__ void attn_task2(const bf16_t* Qh, const bf16_t* Kh, const bf16_t* Vh, float slope2,
                                           int dilA, int clsA, int s0A, int nqA, int dilB, int clsB, int s0B, int nqB,
                                           LAS unsigned char* lds, int wave, int lane, AttnRes& RA, AttnRes& RB) {
    asm volatile("" : "+v"(lane));
    const int r32 = lane & 31, hi = lane >> 5;
    const int qa_ = r32 < nqA ? r32 : nqA - 1, qb_ = r32 < nqB ? r32 : nqB - 1;
    const bf16_t* qpA = Qh + (size_t)(clsA + dilA * (s0A + qa_)) * D + hi * 8; const bf16_t* qpB = Qh + (size_t)(clsB + dilB * (s0B + qb_)) * D + hi * 8;
    bf16x8 qrA[4], qrB[4];
#pragma unroll
    for (int d0 = 0; d0 < 4; ++d0) { qrA[d0] = *(const bf16x8*)(qpA + d0 * 16); qrB[d0] = *(const bf16x8*)(qpB + d0 * 16); }
    float mA = -INFINITY, lA = 0.f, mB = -INFINITY, lB = 0.f;
    f32x16 oA0 = f32x16{}, oA1 = f32x16{}, oB0 = f32x16{}, oB1 = f32x16{};
    LAS unsigned char* kst = lds + AT_STG + wave * AT_WSTG; LAS unsigned char* vst = kst + 32 * AT_KSTR;
    const float sdA = slope2 * (float)dilA, sdB = slope2 * (float)dilB;
    const float lbase = (float)(r32 - 4 * hi + 128);
    const int ifA = s0A < 128 ? (128 - s0A) >> 5 : 0, ifB = s0B < 128 ? (128 - s0B) >> 5 : 0, imin = ifA < ifB ? ifA : ifB;
    const int vb = ((lane >> 4) & 1) * 32 + (lane & 3) * 8 + (4 * hi + ((lane & 15) >> 2)) * 64;
#pragma clang loop unroll(disable)
    for (int i = 4; i >= imin; --i) {
        const int kbA = s0A - 128 + 32 * i, kbB = s0B - 128 + 32 * i;
        u32x4 kkA[4], vvA[4], kkB[4], vvB[4];
        AT_KLOAD(A, kkA, vvA)
        AT_KLOAD(B, kkB, vvB)
        bf16x8 kfA[4], kfB[4]; s16x4 tlA[4], thA[4];
#pragma unroll
        for (int j = 0; j < 4; ++j) *(LAS u32x4*)(kst + ((lane >> 3) + 8 * j) * AT_KSTR + (lane & 7) * 16) = kkA[j];
        AT_CB();
#pragma unroll
        for (int d0 = 0; d0 < 4; ++d0) kfA[d0] = *(const LAS bf16x8*)(kst + r32 * AT_KSTR + d0 * 32 + hi * 16);
        AT_CB();
#pragma unroll
        for (int j = 0; j < 4; ++j) *(LAS u32x4*)(kst + ((lane >> 3) + 8 * j) * AT_KSTR + (lane & 7) * 16) = kkB[j];
        AT_CB();
#pragma unroll
        for (int d0 = 0; d0 < 4; ++d0) kfB[d0] = *(const LAS bf16x8*)(kst + r32 * AT_KSTR + d0 * 32 + hi * 16);
        AT_CB();
#pragma unroll
        for (int j = 0; j < 4; ++j) { const int kv = (lane >> 3) + 8 * j, part = lane & 7; const int off_ = (part >> 2) * 2048 + (kv >> 3) * 512 + (kv & 7) * 64 + (part & 3) * 16;
            *(LAS u32x4*)(kst + off_) = vvA[j]; *(LAS u32x4*)(vst + off_) = vvB[j]; }
        AT_CB();
#pragma unroll
        for (int q = 0; q < 4; ++q) { tlA[q] = __builtin_bit_cast(s16x4, __builtin_amdgcn_ds_read_tr16_b64_v4i16((LAS s16x4*)(kst + vb + (q >> 1) * 2048 + (q & 1) * 1024)));
                                      thA[q] = __builtin_bit_cast(s16x4, __builtin_amdgcn_ds_read_tr16_b64_v4i16((LAS s16x4*)(kst + vb + (q >> 1) * 2048 + (q & 1) * 1024 + 512))); }
        AT_CB();
        f32x16 stA, stB;
        { const float tA = sdA * ((float)(32 * i) - lbase), tB = sdB * ((float)(32 * i) - lbase);
#pragma unroll
          for (int r = 0; r < 16; ++r) { const float c_r = (float)((r & 3) + 8 * (r >> 2)); stA[r] = tA + sdA * c_r; stB[r] = tB + sdB * c_r; } }
#pragma unroll
        for (int d0 = 0; d0 < 4; ++d0) { stA = __builtin_amdgcn_mfma_f32_32x32x16_bf16(kfA[d0], qrA[d0], stA, 0, 0, 0); stB = __builtin_amdgcn_mfma_f32_32x32x16_bf16(kfB[d0], qrB[d0], stB, 0, 0, 0); }
        if (kbA < 0 || kbB < 0) {
            int cminA = (i == 0) ? r32 : 0; cminA = cminA > -kbA ? cminA : -kbA; int cminB = (i == 0) ? r32 : 0; cminB = cminB > -kbB ? cminB : -kbB;
            const int cmax = (i == 4) ? r32 : 31;
            const int loA = cminA - 4 * hi, loB = cminB - 4 * hi, hi_ = cmax - 4 * hi;
#pragma unroll
            for (int r = 0; r < 16; ++r) { const int c = (r & 3) + 8 * (r >> 2); stA[r] = (c >= loA && c <= hi_) ? stA[r] : -INFINITY; stB[r] = (c >= loB && c <= hi_) ? stB[r] : -INFINITY; }
        } else if (i == 4) {
            const int hi_ = r32 - 4 * hi;
#pragma unroll
            for (int r = 0; r < 16; ++r) { const int c = (r & 3) + 8 * (r >> 2); const bool ok = c <= hi_; stA[r] = ok ? stA[r] : -INFINITY; stB[r] = ok ? stB[r] : -INFINITY; }
        } else if (i == 0) {
            const int lo_ = r32 - 4 * hi;
#pragma unroll
            for (int r = 0; r < 16; ++r) { const int c = (r & 3) + 8 * (r >> 2); const bool ok = c >= lo_; stA[r] = ok ? stA[r] : -INFINITY; stB[r] = ok ? stB[r] : -INFINITY; }
        }
        float mxA, mxB;
        { float tA[8], tB[8];
#pragma unroll
          for (int r = 0; r < 8; ++r) { tA[r] = max_raw(stA[2 * r], stA[2 * r + 1]); tB[r] = max_raw(stB[2 * r], stB[2 * r + 1]); }
#pragma unroll
          for (int r = 0; r < 4; ++r) { tA[r] = max_raw(tA[2 * r], tA[2 * r + 1]); tB[r] = max_raw(tB[2 * r], tB[2 * r + 1]); }
          mxA = max_raw(max_raw(tA[0], tA[1]), max_raw(tA[2], tA[3])); mxB = max_raw(max_raw(tB[0], tB[1]), max_raw(tB[2], tB[3])); }
        { auto ra = __builtin_amdgcn_permlane32_swap(__float_as_uint(mxA), __float_as_uint(mxA), false, false); mxA = max_raw(__uint_as_float(ra[0]), __uint_as_float(ra[1]));
          auto rb = __builtin_amdgcn_permlane32_swap(__float_as_uint(mxB), __float_as_uint(mxB), false, false); mxB = max_raw(__uint_as_float(rb[0]), __uint_as_float(rb[1])); }
        if (__any((mxA > mA) || (mxB > mB))) {
            const float nA = max_raw(mA, mxA), nB = max_raw(mB, mxB);
            const float alA = __builtin_amdgcn_exp2f(mA - ((nA == -INFINITY) ? 0.f : nA)), alB = __builtin_amdgcn_exp2f(mB - ((nB == -INFINITY) ? 0.f : nB));
            const float fA = (nA == mA) ? 1.0f : alA, fB = (nB == mB) ? 1.0f : alB;
            lA *= fA; lB *= fB; mA = nA; mB = nB;
#pragma unroll
            for (int r = 0; r < 16; ++r) { oA0[r] *= fA; oA1[r] *= fA; oB0[r] *= fB; oB1[r] *= fB; }
        }
        const float muA = (mA == -INFINITY) ? 0.f : mA, muB = (mB == -INFINITY) ? 0.f : mB;
        f32x2 ps2A = (f32x2){0.f, 0.f}, ps2B = ps2A;
        const f32x2 mu2A = (f32x2){muA, muA}, mu2B = (f32x2){muB, muB};
#pragma unroll
        for (int r = 0; r < 16; r += 2) { const f32x2 dA = (f32x2){stA[r], stA[r + 1]} - mu2A, dB = (f32x2){stB[r], stB[r + 1]} - mu2B;
            const f32x2 pA = (f32x2){__builtin_amdgcn_exp2f(dA.x), __builtin_amdgcn_exp2f(dA.y)}, pB = (f32x2){__builtin_amdgcn_exp2f(dB.x), __builtin_amdgcn_exp2f(dB.y)};
            stA[r] = pA.x; stA[r + 1] = pA.y; stB[r] = pB.x; stB[r + 1] = pB.y; ps2A += pA; ps2B += pB; }
        lA += ps2A.x + ps2A.y; lB += ps2B.x + ps2B.y;
        bf16x8 paA[2], paB[2];
#pragma unroll
        for (int s_ = 0; s_ < 2; ++s_) {
            u32x4 w; w.x = cvt_pk_bf16(stA[8 * s_ + 0], stA[8 * s_ + 1]); w.y = cvt_pk_bf16(stA[8 * s_ + 2], stA[8 * s_ + 3]); w.z = cvt_pk_bf16(stA[8 * s_ + 4], stA[8 * s_ + 5]); w.w = cvt_pk_bf16(stA[8 * s_ + 6], stA[8 * s_ + 7]);
            paA[s_] = __builtin_bit_cast(bf16x8, w);
            w.x = cvt_pk_bf16(stB[8 * s_ + 0], stB[8 * s_ + 1]); w.y = cvt_pk_bf16(stB[8 * s_ + 2], stB[8 * s_ + 3]); w.z = cvt_pk_bf16(stB[8 * s_ + 4], stB[8 * s_ + 5]); w.w = cvt_pk_bf16(stB[8 * s_ + 6], stB[8 * s_ + 7]);
            paB[s_] = __builtin_bit_cast(bf16x8, w); }
#pragma unroll
        for (int s_ = 0; s_ < 2; ++s_) {
            { const int q = s_; const bf16x8 vf = (bf16x8){tlA[q][0], tlA[q][1], tlA[q][2], tlA[q][3], thA[q][0], thA[q][1], thA[q][2], thA[q][3]}; oA0 = __builtin_amdgcn_mfma_f32_32x32x16_bf16(vf, paA[s_], oA0, 0, 0, 0); }
            { const int q = 2 + s_; const bf16x8 vf = (bf16x8){tlA[q][0], tlA[q][1], tlA[q][2], tlA[q][3], thA[q][0], thA[q][1], thA[q][2], thA[q][3]}; oA1 = __builtin_amdgcn_mfma_f32_32x32x16_bf16(vf, paA[s_], oA1, 0, 0, 0); }
        }
        AT_CB();
        s16x4 tlB[4], thB[4];
#pragma unroll
        for (int q = 0; q < 4; ++q) { tlB[q] = __builtin_bit_cast(s16x4, __builtin_amdgcn_ds_read_tr16_b64_v4i16((LAS s16x4*)(vst + vb + (q >> 1) * 2048 + (q & 1) * 1024)));
                                      thB[q] = __builtin_bit_cast(s16x4, __builtin_amdgcn_ds_read_tr16_b64_v4i16((LAS s16x4*)(vst + vb + (q >> 1) * 2048 + (q & 1) * 1024 + 512))); }
        AT_CB();
#pragma unroll
        for (int s_ = 0; s_ < 2; ++s_) {
            { const int q = s_; const bf16x8 vf = (bf16x8){tlB[q][0], tlB[q][1], tlB[q][2], tlB[q][3], thB[q][0], thB[q][1], thB[q][2], thB[q][3]}; oB0 = __builtin_amdgcn_mfma_f32_32x32x16_bf16(vf, paB[s_], oB0, 0, 0, 0); }
            { const int q = 2 + s_; const bf16x8 vf = (bf16x8){tlB[q][0], tlB[q][1], tlB[q][2], tlB[q][3], thB[q][0], thB[q][1], thB[q][2], thB[q][3]}; oB1 = __builtin_amdgcn_mfma_f32_32x32x16_bf16(vf, paB[s_], oB1, 0, 0, 0); }
        }
        AT_CB();
    }
    { auto ra = __builtin_amdgcn_permlane32_swap(__float_as_uint(lA), __float_as_uint(lA), false, false); lA = __uint_as_float(ra[0]) + __uint_as_float(ra[1]);
      auto rb = __builtin_amdgcn_permlane32_swap(__float_as_uint(lB), __float_as_uint(lB), false, false); lB = __uint_as_float(rb[0]) + __uint_as_float(rb[1]); }
    RA.o0 = oA0; RA.o1 = oA1; RA.m = mA; RA.l = lA; RB.o0 = oB0; RB.o1 = oB1; RB.m = mB; RB.l = lB;
}
#undef AT_KLOAD
#undef AT_CB
struct AttnRes3 { f32x4 o[4]; float m, l; };
#define AT3_KLOAD(X, kk_, vv_) _Pragma("unroll") for (int j = 0; j < 4; ++j) { const int kv_ = (lane >> 3) + 8 * j; const int sv_ = kb + kv_ < 0 ? 0 : kb + kv_; \
        const unsigned ro_ = (unsigned)((cls##X + 16 * sv_) * D + (lane & 7) * 8) * 2u; kk_[j] = *(const u32x4*)((const char*)Kh + ro_); vv_[j] = *(const u32x4*)((const char*)Vh + ro_); }
#define AT3_CB() asm volatile("" ::: "memory")
__device__ __forceinline__ void attn_task3(const bf16_t* Qh, const bf16_t* Kh, const bf16_t* Vh, float slope2, int clsA, int clsB, int s0,
                                           LAS unsigned char* lds, int wave, int lane, AttnRes3& RA, AttnRes3& RB) {
    asm volatile("" : "+v"(lane));
    const int q = lane & 15, g = lane >> 4;
    const bf16_t* qpA = Qh + (size_t)(clsA + 16 * (s0 + q)) * D + 8 * g; const bf16_t* qpB = Qh + (size_t)(clsB + 16 * (s0 + q)) * D + 8 * g;
    bf16x8 qrA[2], qrB[2];
#pragma unroll
    for (int dh = 0; dh < 2; ++dh) { qrA[dh] = *(const bf16x8*)(qpA + 32 * dh); qrB[dh] = *(const bf16x8*)(qpB + 32 * dh); }
    float mA = -INFINITY, lA = 0.f, mB = -INFINITY, lB = 0.f;
    f32x4 oA[4], oB[4];
#pragma unroll
    for (int db = 0; db < 4; ++db) { oA[db] = (f32x4){0.f, 0.f, 0.f, 0.f}; oB[db] = oA[db]; }
    LAS unsigned char* kst = lds + AT_STG + wave * AT_WSTG; LAS unsigned char* vst = kst + 32 * AT_KSTR;
    const float sd = slope2 * 16.0f;
    const float lbase = (float)(4 * g - q - 128);
    const int imin = s0 < 128 ? (128 - s0) >> 5 : 0;
    const int woff = (lane >> 3) * AT_KSTR + (lane & 7) * 16;
    const int kfoff = q * AT_KSTR + g * 16;
    const int troff = (4 * g + (q >> 2)) * AT_KSTR + (lane & 3) * 8;
#pragma clang loop unroll(disable)
    for (int i = 4; i >= imin; --i) {
        const int kb = s0 - 128 + 32 * i;
        u32x4 kkA[4], vvA[4], kkB[4], vvB[4];
        AT3_KLOAD(A, kkA, vvA)
        AT3_KLOAD(B, kkB, vvB)
        bf16x8 kfA[2][2], kfB[2][2]; s16x4 tA[4][2], tB[4][2];
#pragma unroll
        for (int j = 0; j < 4; ++j) *(LAS u32x4*)(kst + woff + 8 * j * AT_KSTR) = kkA[j];
        AT3_CB();
#pragma unroll
        for (int h = 0; h < 2; ++h)
#pragma unroll
            for (int dh = 0; dh < 2; ++dh) kfA[h][dh] = *(const LAS bf16x8*)(kst + kfoff + h * 16 * AT_KSTR + dh * 64);
        AT3_CB();
#pragma unroll
        for (int j = 0; j < 4; ++j) *(LAS u32x4*)(kst + woff + 8 * j * AT_KSTR) = kkB[j];
        AT3_CB();
#pragma unroll
        for (int h = 0; h < 2; ++h)
#pragma unroll
            for (int dh = 0; dh < 2; ++dh) kfB[h][dh] = *(const LAS bf16x8*)(kst + kfoff + h * 16 * AT_KSTR + dh * 64);
        AT3_CB();
#pragma unroll
        for (int j = 0; j < 4; ++j) { *(LAS u32x4*)(kst + woff + 8 * j * AT_KSTR) = vvA[j]; *(LAS u32x4*)(vst + woff + 8 * j * AT_KSTR) = vvB[j]; }
        AT3_CB();
#pragma unroll
        for (int db = 0; db < 4; ++db)
#pragma unroll
            for (int hh = 0; hh < 2; ++hh) tA[db][hh] = __builtin_bit_cast(s16x4, __builtin_amdgcn_ds_read_tr16_b64_v4i16((LAS s16x4*)(kst + troff + hh * 16 * AT_KSTR + db * 32)));
        AT3_CB();
        f32x4 sA[2], sB[2];
        { const float t = sd * ((float)(32 * i) + lbase);
          if (i == 0 || i == 4 || kb < 0) {
            int lo = (i == 0) ? q : 0; lo = lo > -kb ? lo : -kb; const int hi_ = (i == 4) ? q : 31;
            const int lo_l = lo - 4 * g, hi_l = hi_ - 4 * g;
#pragma unroll
            for (int h = 0; h < 2; ++h)
#pragma unroll
                for (int e = 0; e < 4; ++e) { const int c = 16 * h + e; const float v = (c >= lo_l && c <= hi_l) ? t + sd * (float)c : -INFINITY; sA[h][e] = v; sB[h][e] = v; }
          } else {
#pragma unroll
            for (int h = 0; h < 2; ++h)
#pragma unroll
                for (int e = 0; e < 4; ++e) { const float v = t + sd * (float)(16 * h + e); sA[h][e] = v; sB[h][e] = v; }
          } }
#pragma unroll
        for (int h = 0; h < 2; ++h)
#pragma unroll
            for (int dh = 0; dh < 2; ++dh) { sA[h] = __builtin_amdgcn_mfma_f32_16x16x32_bf16(kfA[h][dh], qrA[dh], sA[h], 0, 0, 0); sB[h] = __builtin_amdgcn_mfma_f32_16x16x32_bf16(kfB[h][dh], qrB[dh], sB[h], 0, 0, 0); }
        float mxA = fmaxf(fmaxf(fmaxf(sA[0][0], sA[0][1]), fmaxf(sA[0][2], sA[0][3])), fmaxf(fmaxf(sA[1][0], sA[1][1]), fmaxf(sA[1][2], sA[1][3])));
        float mxB = fmaxf(fmaxf(fmaxf(sB[0][0], sB[0][1]), fmaxf(sB[0][2], sB[0][3])), fmaxf(fmaxf(sB[1][0], sB[1][1]), fmaxf(sB[1][2], sB[1][3])));
        { auto a1 = __builtin_amdgcn_permlane16_swap(__float_as_uint(mxA), __float_as_uint(mxA), false, false); mxA = fmaxf(__uint_as_float(a1[0]), __uint_as_float(a1[1]));
          auto a2 = __builtin_amdgcn_permlane32_swap(__float_as_uint(mxA), __float_as_uint(mxA), false, false); mxA = fmaxf(__uint_as_float(a2[0]), __uint_as_float(a2[1]));
          auto b1 = __builtin_amdgcn_permlane16_swap(__float_as_uint(mxB), __float_as_uint(mxB), false, false); mxB = fmaxf(__uint_as_float(b1[0]), __uint_as_float(b1[1]));
          auto b2 = __builtin_amdgcn_permlane32_swap(__float_as_uint(mxB), __float_as_uint(mxB), false, false); mxB = fmaxf(__uint_as_float(b2[0]), __uint_as_float(b2[1])); }
        if (__any((mxA > mA) || (mxB > mB))) {
            const float nA = fmaxf(mA, mxA), nB = fmaxf(mB, mxB);
            const float alA = __builtin_amdgcn_exp2f(mA - ((nA == -INFINITY) ? 0.f : nA)), alB = __builtin_amdgcn_exp2f(mB - ((nB == -INFINITY) ? 0.f : nB));
            const float fA = (nA == mA) ? 1.0f : alA, fB = (nB == mB) ? 1.0f : alB;
            lA *= fA; lB *= fB; mA = nA; mB = nB;
#pragma unroll
            for (int db = 0; db < 4; ++db) { oA[db] *= fA; oB[db] *= fB; }
        }
        const float muA = (mA == -INFINITY) ? 0.f : mA, muB = (mB == -INFINITY) ? 0.f : mB;
        float psA = 0.f, psB = 0.f;
#pragma unroll
        for (int h = 0; h < 2; ++h)
#pragma unroll
            for (int e = 0; e < 4; ++e) { const float pA = __builtin_amdgcn_exp2f(sA[h][e] - muA), pB = __builtin_amdgcn_exp2f(sB[h][e] - muB); sA[h][e] = pA; sB[h][e] = pB; psA += pA; psB += pB; }
        lA += psA; lB += psB;
        bf16x8 paA, paB;
        { u32x4 w; w.x = cvt_pk_bf16(sA[0][0], sA[0][1]); w.y = cvt_pk_bf16(sA[0][2], sA[0][3]); w.z = cvt_pk_bf16(sA[1][0], sA[1][1]); w.w = cvt_pk_bf16(sA[1][2], sA[1][3]); paA = __builtin_bit_cast(bf16x8, w);
          w.x = cvt_pk_bf16(sB[0][0], sB[0][1]); w.y = cvt_pk_bf16(sB[0][2], sB[0][3]); w.z = cvt_pk_bf16(sB[1][0], sB[1][1]); w.w = cvt_pk_bf16(sB[1][2], sB[1][3]); paB = __builtin_bit_cast(bf16x8, w); }
#pragma unroll
        for (int db = 0; db < 4; ++db) { const bf16x8 vf = (bf16x8){tA[db][0][0], tA[db][0][1], tA[db][0][2], tA[db][0][3], tA[db][1][0], tA[db][1][1], tA[db][1][2], tA[db][1][3]};
            oA[db] = __builtin_amdgcn_mfma_f32_16x16x32_bf16(vf, paA, oA[db], 0, 0, 0); }
        AT3_CB();
#pragma unroll
        for (int db = 0; db < 4; ++db)
#pragma unroll
            for (int hh = 0; hh < 2; ++hh) tB[db][hh] = __builtin_bit_cast(s16x4, __builtin_amdgcn_ds_read_tr16_b64_v4i16((LAS s16x4*)(vst + troff + hh * 16 * AT_KSTR + db * 32)));
        AT3_CB();
#pragma unroll
        for (int db = 0; db < 4; ++db) { const bf16x8 vf = (bf16x8){tB[db][0][0], tB[db][0][1], tB[db][0][2], tB[db][0][3], tB[db][1][0], tB[db][1][1], tB[db][1][2], tB[db][1][3]};
            oB[db] = __builtin_amdgcn_mfma_f32_16x16x32_bf16(vf, paB, oB[db], 0, 0, 0); }
        AT3_CB();
    }
    lA = pg8::fq_sum(lA); lB = pg8::fq_sum(lB);
#pragma unroll
    for (int db = 0; db < 4; ++db) { RA.o[db] = oA[db]; RB.o[db] = oB[db]; }
    RA.m = mA; RA.l = lA; RB.m = mB; RB.l = lB;
}
#undef AT3_KLOAD
#undef AT3_CB
__device__ __forceinline__ void attn_merge3(const AttnRes3& R, int cls, LAS unsigned char* lds, int lane) {
    asm volatile("" : "+v"(lane));
    const int q = lane & 15, g = lane >> 4;
    const int ql = cls + 16 * q, g4 = at_swz(ql);
    LAS f32x4* oa = (LAS f32x4*)(lds + AT_OACC) + ql * 16;
    LAS float* ml = (LAS float*)(lds + AT_ML) + ql * 2;
    const float m_old = ml[0], l_old = ml[1]; const float m_new = fmaxf(m_old, R.m); const float mu = (m_new == -INFINITY) ? 0.f : m_new;
    const float a_old = __builtin_amdgcn_exp2f(m_old - mu), a_new = __builtin_amdgcn_exp2f(R.m - mu), l_new = l_old * a_old + R.l * a_new;
    f32x4 pv[4];
#pragma unroll
    for (int db = 0; db < 4; ++db) pv[db] = oa[(4 * db + g) ^ g4];
#pragma unroll
    for (int db = 0; db < 4; ++db) oa[(4 * db + g) ^ g4] = R.o[db] * a_new + pv[db] * a_old;
    asm volatile("s_waitcnt lgkmcnt(0)" ::: "memory");
    if (g == 0) { ml[0] = m_new; ml[1] = l_new; }
}
__device__ __forceinline__ void attn_merge(const AttnRes& R, int nq, int qlbase, int qlstep, bool first, LAS unsigned char* lds, int lane) {
    asm volatile("" : "+v"(lane));
    const int r32 = lane & 31, hi = lane >> 5;
    if (r32 < nq) {
        const int ql = qlbase + qlstep * r32, g4 = at_swz(ql);
        LAS f32x4* oa = (LAS f32x4*)(lds + AT_OACC) + ql * 16;
        LAS float* ml = (LAS float*)(lds + AT_ML) + ql * 2;
        float a_old = 0.f, a_new = 1.f, m_new = R.m, l_new = R.l;
        if (!first) { const float m_old = ml[0], l_old = ml[1]; m_new = fmaxf(m_old, R.m); const float mu = (m_new == -INFINITY) ? 0.f : m_new;
            a_old = __builtin_amdgcn_exp2f(m_old - mu); a_new = __builtin_amdgcn_exp2f(R.m - mu); l_new = l_old * a_old + R.l * a_new; }
        f32x4 p0[4], p1[4];
        if (!first) {
#pragma unroll
            for (int g = 0; g < 4; ++g) { const int c0 = (2 * g + hi) ^ g4; p0[g] = oa[c0]; p1[g] = oa[c0 ^ 8]; } }
#pragma unroll
        for (int g = 0; g < 4; ++g) { const int c0 = (2 * g + hi) ^ g4;
            f32x4 n0 = (f32x4){R.o0[4 * g], R.o0[4 * g + 1], R.o0[4 * g + 2], R.o0[4 * g + 3]} * a_new, n1 = (f32x4){R.o1[4 * g], R.o1[4 * g + 1], R.o1[4 * g + 2], R.o1[4 * g + 3]} * a_new;
            if (!first) { n0 += p0[g] * a_old; n1 += p1[g] * a_old; }
            oa[c0] = n0; oa[c0 ^ 8] = n1; }
        asm volatile("s_waitcnt lgkmcnt(0)" ::: "memory");
        if (hi == 0) { ml[0] = m_new; ml[1] = l_new; }
    }
}

__device__ __forceinline__ void p8_attention(const Args& a, LAS unsigned char* lds, int tid, int lane, int wave, int mode) {
    unsigned char* ws = a.ws;
    const bf16_t* Q = (const bf16_t*)(ws + WS_Q); const bf16_t* K = (const bf16_t*)(ws + WS_K); const bf16_t* V = (const bf16_t*)(ws + WS_V); bf16_t* O = (bf16_t*)(ws + WS_AB);
    if (mode & 1) {
        const float* QS = (const float*)(ws + WS_QS);
        LAS float* psc = (LAS float*)(lds + AT_PSC + wave * 2048);
        for (int task = blockIdx.x * NWAVES + wave; task < NSB * NH * NST; task += gridDim.x * NWAVES) {
            const int sb = task / (NH * NST), h = (task / NST) % NH, j = task % NST;
            const float slope2 = exp2f(-0.5f * (float)(h + 1)) * LOG2E;
            const float* kc = a.in[4] + (size_t)sb * LBUF * D + h * HD; const float* vc = a.in[5] + (size_t)sb * LBUF * D + h * HD;
            const float* kn = a.out + O_SK + ((size_t)sb * LBUF + (LBUF - NST)) * D + h * HD; const float* vn = a.out + O_SV + ((size_t)sb * LBUF + (LBUF - NST)) * D + h * HD;
            const float* qrow = QS + (size_t)(sb * NST + j) * D + h * HD;
            const int kg = lane >> 4, dc = lane & 15;
            const f32x4 q4 = *(const f32x4*)(qrow + 4 * dc);
            float mx = -INFINITY;
#pragma clang loop unroll(disable)
            for (int k0 = 0; k0 < 387; k0 += 64) {
                f32x4 kr4[16];
#pragma unroll
                for (int u = 0; u < 16; ++u) { const int kk = k0 + 4 * u + kg; const int kc_ = kk < 387 ? kk : 386;
                    const int g = kc_ / 129, mm = kc_ % 129, dil = (g == 0) ? 1 : (g == 1 ? 4 : 16); const int idx = LBUF + j - mm * dil;
                    const float* kr = (idx >= LBUF) ? kn + (size_t)(idx - LBUF) * D : kc + (size_t)idx * D;
                    kr4[u] = __builtin_nontemporal_load((const f32x4*)(kr + 4 * dc)); }
#pragma unroll
                for (int u = 0; u < 16; ++u) { const int kk = k0 + 4 * u + kg; const int kc_ = kk < 387 ? kk : 386;
                    const int g = kc_ / 129, mm = kc_ % 129, dil = (g == 0) ? 1 : (g == 1 ? 4 : 16);
                    float t = (q4.x * kr4[u].x + q4.y * kr4[u].y) + (q4.z * kr4[u].z + q4.w * kr4[u].w);
                    t += dppmov<0xB1>(t); t += dppmov<0x4E>(t); t += dppmov<0x141>(t); t += dppmov<0x140>(t);
                    const float sc = (kk < 387) ? t - slope2 * (float)(mm * dil) : -INFINITY;
                    if (dc == 0) psc[kk] = sc;
                    mx = fmaxf(mx, sc); }
            }
            mx = wave_max(mx);
            asm volatile("s_waitcnt lgkmcnt(0)" ::: "memory");
            float l = 0.f;
#pragma clang loop unroll(disable)
            for (int rd = 0; rd < 7; ++rd) { const float p = __builtin_amdgcn_exp2f(psc[rd * 64 + lane] - mx); l += p; psc[rd * 64 + lane] = p; }
            l = wave_sum(l);
            asm volatile("s_waitcnt lgkmcnt(0)" ::: "memory");
            f32x4 acc4 = (f32x4){0.f, 0.f, 0.f, 0.f};
#pragma clang loop unroll(disable)
            for (int k0 = 0; k0 < 387; k0 += 64) {
                f32x4 vr4[16]; float pk[16];
#pragma unroll
                for (int u = 0; u < 16; ++u) { const int kk = k0 + 4 * u + kg; const int kc_ = kk < 387 ? kk : 386;
                    const int g = kc_ / 129, mm = kc_ % 129, dil = (g == 0) ? 1 : (g == 1 ? 4 : 16); const int idx = LBUF + j - mm * dil;
                    const float* vr = (idx >= LBUF) ? vn + (size_t)(idx - LBUF) * D : vc + (size_t)idx * D;
                    vr4[u] = __builtin_nontemporal_load((const f32x4*)(vr + 4 * dc)); pk[u] = kk < 387 ? psc[kc_] : 0.f; }
#pragma unroll
                for (int u = 0; u < 16; ++u) acc4 += vr4[u] * pk[u];
            }
#pragma unroll
            for (int e = 0; e < 4; ++e) { acc4[e] += __shfl_xor(acc4[e], 16); acc4[e] += __shfl_xor(acc4[e], 32); }
            const float il = __builtin_amdgcn_rcpf(l);
            if (lane < 16) { u32x2 w; w.x = cvt_pk_bf16(acc4[0] * il, acc4[1] * il); w.y = cvt_pk_bf16(acc4[2] * il, acc4[3] * il);
                *(u32x2*)(O + (size_t)(MPR + sb * NST + j) * D + h * HD + 4 * dc) = w; }
            asm volatile("s_waitcnt lgkmcnt(0)" ::: "memory");
        }
    }
    __syncthreads();
    if (mode & 2) {
    const int nun = NB * NH * 8, per_round = gridDim.x;
    for (int u0 = blockIdx.x; u0 < nun; u0 += per_round) {
        int u = u0;
        if ((gridDim.x & 7) == 0 && nun % (int)gridDim.x == 0) { const int x = blockIdx.x & 7, slot = blockIdx.x >> 3, spx = gridDim.x >> 3, rnd = u0 / per_round, j = rnd * spx + slot; u = x * (nun >> 3) + j;
            const int sq = u & 7, r4 = rnd & 3, qb = (r4 == 0) ? sq : (r4 == 1) ? 7 - sq : (r4 == 2) ? ((sq + 4) & 7) : ((3 - sq) & 7); u = (u & ~7) | qb; }
        const int qblk = u & 7, h = (u >> 3) & 15, b = u >> 7;
        const float slope2 = exp2f(-0.5f * (float)(h + 1)) * LOG2E;
        const bf16_t* Qh = Q + (size_t)b * SEQ * D + h * HD; const bf16_t* Kh = K + (size_t)b * SEQ * D + h * HD; const bf16_t* Vh = V + (size_t)b * SEQ * D + h * HD;
        {
            AttnRes RA, RB;
            attn_task2(Qh, Kh, Vh, slope2, 1, 0, 256 * qblk + 32 * wave, 32, 4, wave & 3, 64 * qblk + 32 * (wave >> 2), 32, lds, wave, lane, RA, RB);
            attn_merge(RA, 32, 32 * wave, 1, true, lds, lane);
            __syncthreads();
            attn_merge(RB, 32, (wave & 3) + 128 * (wave >> 2), 4, false, lds, lane);
            __syncthreads();
            AttnRes3 R3A, R3B;
            attn_task3(Qh, Kh, Vh, slope2, 2 * wave, 2 * wave + 1, 16 * qblk, lds, wave, lane, R3A, R3B);
            attn_merge3(R3A, 2 * wave, lds, lane);
            attn_merge3(R3B, 2 * wave + 1, lds, lane);
            __syncthreads();
        }
        {
            const int ql = tid >> 1, dh = (tid & 1) * 32, hb = (tid & 1) * 8, g4 = at_swz(ql);
            const LAS f32x4* oa = (const LAS f32x4*)(lds + AT_OACC) + ql * 16;
            const float inv = __builtin_amdgcn_rcpf(((const LAS float*)(lds + AT_ML))[ql * 2 + 1]);
            bf16_t* op = O + (size_t)(b * SEQ + 256 * qblk + ql) * D + h * HD + dh;
            f32x4 x[8];
#pragma unroll
            for (int e = 0; e < 8; ++e) x[e] = oa[(hb + e) ^ g4];
#pragma unroll
            for (int e = 0; e < 4; ++e) { const f32x4 x0 = x[2 * e] * inv, x1 = x[2 * e + 1] * inv; u32x4 w; w.x = cvt_pk_bf16(x0[0], x0[1]); w.y = cvt_pk_bf16(x0[2], x0[3]);
                w.z = cvt_pk_bf16(x1[0], x1[1]); w.w = cvt_pk_bf16(x1[2], x1[3]); *(u32x4*)(op + 8 * e) = w; }
        }
        __syncthreads();
    }
    }
}

__device__ __forceinline__ void p13_final(const Args& a, int row_lo, int gw, int NGW, int lane) {
    const bf16_t* HBp = (const bf16_t*)(a.ws + WS_HB); const float* g = a.in[9];
    f32x4 gv[4];
#pragma unroll
    for (int j = 0; j < 4; ++j) gv[j] = ((const f32x4*)g)[64 * j + lane];
    for (int r0 = row_lo + gw; r0 < MTOT; r0 += 2 * NGW) {
        f32x4 v[2][4];
#pragma unroll
        for (int h = 0; h < 2; ++h) { const int r = r0 + h * NGW; const int rc = r < MTOT ? r : r0; const u32x2* xr = (const u32x2*)(HBp + (size_t)rc * D) + lane;
#pragma unroll
            for (int j = 0; j < 4; ++j) { const u32x2 b = xr[64 * j]; v[h][j] = (f32x4){bflo(b.x), bfhi(b.x), bflo(b.y), bfhi(b.y)}; } }
#pragma unroll
        for (int h = 0; h < 2; ++h) { const int r = r0 + h * NGW; if (r >= MTOT) continue; float s = 0.f;
#pragma unroll
            for (int j = 0; j < 4; ++j) s += (v[h][j].x * v[h][j].x + v[h][j].y * v[h][j].y) + (v[h][j].z * v[h][j].z + v[h][j].w * v[h][j].w);
            const float rstd = rsqrtf(wave_sum(s) * (1.0f / D) + RMS_EPS);
            f32x4* o = (f32x4*)(a.out + (size_t)r * D) + lane;
#pragma unroll
            for (int j = 0; j < 4; ++j) __builtin_nontemporal_store(v[h][j] * rstd * gv[j], o + 64 * j); }
    }
}

__device__ __forceinline__ void sample_gemm_qkv(LAS unsigned char* lds, const bf16_t* A, const bf16_t* Bt, const float* ssq, bf16_t* QKV, float* QS, float* out, int tid, int lane, int wave) {
    constexpr int K = D, KPW = K / 32 / 8, NCB = 3, nitems = (3 * D / 16 / NCB) * 4;
    LAS f32x4* red = (LAS f32x4*)lds;
    for (int it = blockIdx.x; it < nitems; it += gridDim.x) {
        const int cg = it >> 2, rq = it & 3;
        const bf16_t* ap = A + (size_t)(32 * rq + (lane & 15)) * K + wave * KPW * 32 + 8 * (lane >> 4);
        const bf16_t* bp = Bt + (size_t)(16 * NCB * cg + (lane & 15)) * K + wave * KPW * 32 + 8 * (lane >> 4);
        bf16x8 bw[NCB][KPW], a0[KPW], a1[KPW];
#pragma unroll
        for (int ks = 0; ks < KPW; ++ks) { a0[ks] = *(const bf16x8*)(ap + ks * 32); a1[ks] = *(const bf16x8*)(ap + (size_t)16 * K + ks * 32);
#pragma unroll
            for (int cb = 0; cb < NCB; ++cb) bw[cb][ks] = *(const bf16x8*)(bp + (size_t)cb * 16 * K + ks * 32); }
#pragma unroll
        for (int cb = 0; cb < NCB; ++cb) { f32x4 acc0 = (f32x4){0.f, 0.f, 0.f, 0.f}, acc1 = acc0;
#pragma unroll
            for (int ks = 0; ks < KPW; ++ks) { acc0 = __builtin_amdgcn_mfma_f32_16x16x32_bf16(bw[cb][ks], a0[ks], acc0, 0, 0, 0); acc1 = __builtin_amdgcn_mfma_f32_16x16x32_bf16(bw[cb][ks], a1[ks], acc1, 0, 0, 0); }
            red[((cb * 8 + wave) * 2 + 0) * 64 + lane] = acc0; red[((cb * 8 + wave) * 2 + 1) * 64 + lane] = acc1; }
        __syncthreads();
        if (tid < 128 * NCB) {
            const int cb = tid >> 7, rb = (tid >> 6) & 1, ln = tid & 63;
            f32x4 v = red[((cb * 8) * 2 + rb) * 64 + ln];
#pragma unroll
            for (int w = 1; w < 8; ++w) v += red[((cb * 8 + w) * 2 + rb) * 64 + ln];
            const int rs = 32 * rq + 16 * rb + (ln & 15), fq = ln >> 4;
            const int cbk = NCB * cg + cb, c = 16 * cbk + 4 * fq;
            const int which = cbk >> 6, c1 = c - which * D;
            const float rstd = pg8::row_rstd(ssq, MPR + rs, fq) * (which == 0 ? QSCALE : 1.0f);
            const f32x4 o = v * rstd;
            u32x2 w2; w2.x = cvt_pk_bf16(o[0], o[1]); w2.y = cvt_pk_bf16(o[2], o[3]);
            *(u32x2*)(QKV + (size_t)which * ((WS_K - WS_Q) / 2) + (size_t)(MPR + rs) * D + c1) = w2;
            float* fp = (which == 0) ? QS + (size_t)rs * D + c1 : out + (which == 1 ? O_SK : O_SV) + ((size_t)(rs >> 2) * LBUF + (LBUF - NST) + (rs & 3)) * D + c1;
            *(f32x4*)fp = o;
        }
        __syncthreads();
    }
}
template <int MODE, int K>
__device__ __forceinline__ void sample_gemm(LAS unsigned char* lds, const bf16_t* A, const bf16_t* Bt, int N, const float* base, float* Hs, bf16_t* HBs, float* ssq,
                                            bf16_t* QKV, float* QS, float* out, int tid, int lane, int wave) {
    constexpr int KPW = K / 32 / 8;
    const int nitems = (N / 16) * 4;
    LAS f32x4* red = (LAS f32x4*)lds;
    for (int it = blockIdx.x; it < nitems; it += gridDim.x) {
        const int cbk = it >> 2, rq = it & 3;
        const bf16_t* bp = Bt + (size_t)(16 * cbk + (lane & 15)) * K + wave * KPW * 32 + 8 * (lane >> 4);
        const bf16_t* ap = A + (size_t)(32 * rq + (lane & 15)) * K + wave * KPW * 32 + 8 * (lane >> 4);
        bf16x8 bw[KPW], a0[KPW], a1[KPW];
#pragma unroll
        for (int ks = 0; ks < KPW; ++ks) { bw[ks] = *(const bf16x8*)(bp + ks * 32); a0[ks] = *(const bf16x8*)(ap + ks * 32); a1[ks] = *(const bf16x8*)(ap + (size_t)16 * K + ks * 32); }
        f32x4 acc0 = (f32x4){0.f, 0.f, 0.f, 0.f}, acc1 = acc0;
#pragma unroll
        for (int ks = 0; ks < KPW; ++ks) { acc0 = __builtin_amdgcn_mfma_f32_16x16x32_bf16(bw[ks], a0[ks], acc0, 0, 0, 0); acc1 = __builtin_amdgcn_mfma_f32_16x16x32_bf16(bw[ks], a1[ks], acc1, 0, 0, 0); }
        red[(wave * 2 + 0) * 64 + lane] = acc0; red[(wave * 2 + 1) * 64 + lane] = acc1;
        __syncthreads();
        if (tid < 128) {
            const int rb = tid >> 6, ln = tid & 63;
            f32x4 v = red[rb * 64 + ln];
#pragma unroll
            for (int w = 1; w < 8; ++w) v += red[(w * 2 + rb) * 64 + ln];
            const int rs = 32 * rq + 16 * rb + (ln & 15), fq = ln >> 4;
            const int c = 16 * cbk + 4 * fq;
            if (MODE == 0) {
                const u32x2 b2 = *(const u32x2*)(HBs + (size_t)rs * D + c);
                const f32x4 h = (f32x4){bflo(b2.x), bfhi(b2.x), bflo(b2.y), bfhi(b2.y)} + v;
                u32x2 w2; w2.x = cvt_pk_bf16(h[0], h[1]); w2.y = cvt_pk_bf16(h[2], h[3]); *(u32x2*)(HBs + (size_t)rs * D + c) = w2;
                float q = (h[0] * h[0] + h[1] * h[1]) + (h[2] * h[2] + h[3] * h[3]);
                q += __shfl_xor(q, 16); q += __shfl_xor(q, 32);
                if (fq == 0) ssq[(size_t)(MPR + rs) * 64 + cbk] = q;
            } else {
                const int which = cbk >> 6, c1 = c - which * D;
                const float rstd = pg8::row_rstd(ssq, MPR + rs, fq) * (which == 0 ? QSCALE : 1.0f);
                const f32x4 o = v * rstd;
                u32x2 w2; w2.x = cvt_pk_bf16(o[0], o[1]); w2.y = cvt_pk_bf16(o[2], o[3]);
                *(u32x2*)(QKV + (size_t)which * ((WS_K - WS_Q) / 2) + (size_t)(MPR + rs) * D + c1) = w2;
                float* fp = (which == 0) ? QS + (size_t)rs * D + c1 : out + (which == 1 ? O_SK : O_SV) + ((size_t)(rs >> 2) * LBUF + (LBUF - NST) + (rs & 3)) * D + c1;
                *(f32x4*)fp = o;
            }
        }
        __syncthreads();
    }
}

#define XB_TMO      128
#define XB_XCNT(j)  (256  + 64 * (j))
#define XB_XSUB(j)  (1280 + 64 * (j))
#define XB_XGEN(j)  (2304 + 64 * (j))
#define XB_TOP      3328
#define XB_TOPGEN   3392
#define XCD_BAR_WORDS 3456
#define XB_SPIN_CAP (1u << 18)
__device__ __forceinline__ unsigned xb_ld(unsigned* p)              { return __hip_atomic_load(p, __ATOMIC_RELAXED, __HIP_MEMORY_SCOPE_AGENT); }
__device__ __forceinline__ unsigned xb_add(unsigned* p, unsigned v) { return __hip_atomic_fetch_add(p, v, __ATOMIC_RELAXED, __HIP_MEMORY_SCOPE_AGENT); }
__device__ __forceinline__ unsigned xb_xcc_id() { return (unsigned)__builtin_amdgcn_s_getreg((3 << 11) | 20) & 0xFu; }
#define XB_SPIN(cond, bar) do { unsigned _sp = 0; while (cond) { __builtin_amdgcn_s_sleep(1); \
    if ((++_sp & 255u) == 0u) { if (xb_ld(&(bar)[XB_TMO])) break; if (_sp > XB_SPIN_CAP) { atomicAdd(&(bar)[XB_TMO], 1u); break; } } } } while (0)
__device__ __forceinline__ void xcd_barrier_complete(unsigned* bar, unsigned x, unsigned& nloc, unsigned& nx) {
    const unsigned G = gridDim.x * gridDim.y * gridDim.z;
    unsigned sum, cnt, mine, sp = 0u;
    for (;;) {
        sum = 0u; cnt = 0u; mine = 0u;
#pragma unroll
        for (unsigned j = 0; j < 16; ++j) { const unsigned c = xb_ld(&bar[XB_XCNT(j)]); sum += c; cnt += (c > 0u) ? 1u : 0u; mine = (j == x) ? c : mine; }
        if (sum == G) break;
        __builtin_amdgcn_s_sleep(1);
        if ((++sp & 255u) == 0u) { if (xb_ld(&bar[XB_TMO])) break; if (sp > XB_SPIN_CAP) { atomicAdd(&bar[XB_TMO], 1u); break; } }
    }
    nloc = mine > 0u ? mine : 1u; nx = cnt > 0u ? cnt : 1u;
}
__device__ __forceinline__ void xcd_barrier(unsigned* bar, volatile LAS unsigned* st, int wave0) {
    asm volatile("s_waitcnt vmcnt(0)" ::: "memory");
    __syncthreads();
    if (wave0 == 0 && lane_id() == 0) {
        const unsigned x = xb_xcc_id();
        __builtin_amdgcn_s_waitcnt(0);
        unsigned nloc = st[0], nx = st[1];
        if (nloc == 0u) { xcd_barrier_complete(bar, x, nloc, nx); st[0] = nloc; st[1] = nx; }
        const unsigned old = xb_add(&bar[XB_XSUB(x)], 1u);
        const unsigned gen = old / nloc;
        if (old + 1u == (gen + 1u) * nloc) {
            __builtin_amdgcn_fence(__ATOMIC_RELEASE, "agent");
            asm volatile("s_waitcnt vmcnt(0)" ::: "memory");
            const unsigned og = xb_add(&bar[XB_TOP], 1u);
            const unsigned tg = og / nx;
            if (og + 1u == (tg + 1u) * nx) xb_add(&bar[XB_TOPGEN], 1u);
            else XB_SPIN(xb_ld(&bar[XB_TOPGEN]) == tg, bar);
            __builtin_amdgcn_fence(__ATOMIC_ACQUIRE, "agent");
            xb_add(&bar[XB_XGEN(x)], 1u);
            asm volatile("s_waitcnt vmcnt(0)" ::: "memory");
        } else {
            XB_SPIN(xb_ld(&bar[XB_XGEN(x)]) == gen, bar);
            __builtin_amdgcn_fence(__ATOMIC_ACQUIRE, "agent");
            asm volatile("s_waitcnt vmcnt(0)" ::: "memory");
        }
    }
    __syncthreads();
}

typedef const __attribute__((address_space(4))) Args* kargp_t;
__device__ __forceinline__ Args kargs() {
    Args a;
#if defined(__HIP_DEVICE_COMPILE__)
    kargp_t p = (kargp_t)__builtin_amdgcn_kernarg_segment_ptr(); asm volatile("" : "+s"(p));
#pragma unroll
    for (int i = 0; i < 22; ++i) a.in[i] = p->in[i];
    a.out = p->out; a.ws = p->ws;
#else
    for (int i = 0; i < 22; ++i) a.in[i] = nullptr;
    a.out = nullptr; a.ws = nullptr;
#endif
    return a;
}
#define PHASE_BEGIN const Args a = kargs(); unsigned char* ws = a.ws; const int wave = wave0, lane = lane_id(), tid = wave * 64 + lane; \
    const int G = gridDim.x, gw = blockIdx.x * NWAVES + wave, NGW = G * NWAVES; (void)ws; (void)lane; (void)gw; (void)NGW; (void)G;
__global__ void __launch_bounds__(NTHREADS, 2) mega_fwd(Args a_unused) {
    extern __shared__ __attribute__((aligned(16))) unsigned char lds_raw[];
    LAS unsigned char* lds = (LAS unsigned char*)lds_raw;
    cg::grid_group grid = cg::this_grid();
    volatile LAS unsigned* bst = (volatile LAS unsigned*)(lds + MISC_OFF + 64);
    const int wave0 = __builtin_amdgcn_readfirstlane((int)threadIdx.x >> 6);
    { unsigned* ctl0 = (unsigned*)kargs().ws; if (threadIdx.x == 0) { bst[0] = 0u; bst[1] = 0u; (void)xb_add(&ctl0[XB_XCNT(xb_xcc_id())], 1u); } }
    __syncthreads();
    grid.sync();
#define GRID_BAR() do { unsigned* ctl_ = (unsigned*)kargs().ws; xcd_barrier(ctl_, bst, wave0); } while (0)
#ifndef PHASES
#define PHASES 0xFFFF
#endif
#define PH(k) if constexpr (((PHASES) >> (k)) & 1)
#define REP_ALL 1
#define REP_P0 1
#define REP_P1 1
#define REP_P2 1
#define REP_P3 1
#define REP_P4 1
#define REP_P6 1
#define PROBE_SKIP_EPI 0
#define REP_P7 1
#define REP_P8 1
#define REP_P8S 1
#define REP_P13 1
#define REPEAT(n) for (int rep_ = 0; rep_ < (n); ++rep_)

    for (int rep_all = 0; rep_all < REP_ALL; ++rep_all) {
    if (rep_all) { GRID_BAR(); }
    REPEAT(REP_P0) { PH(0) { PHASE_BEGIN p0_prologue(a, lds, gw, NGW, lane, wave); } if (rep_ + 1 < REP_P0) { GRID_BAR(); } }
    GRID_BAR();
    REPEAT(REP_P1) { if (rep_) { GRID_BAR(); } PH(1) {
        PHASE_BEGIN
        const int ge = (G == 256) ? GE_P1 : G;
        if ((int)blockIdx.x < ge) {
        pg8::Gemm g{(const bf16_t*)(ws + WS_HB), (const bf16_t*)(ws + WS_WIN), MPAD, NIN, D, wave}; pg8::StaticOrder S; S.init(MPAD, NIN, ge, (int)blockIdx.x);
        pg8::EpiInAB E{(bf16_t*)(ws + WS_GA), (const float*)(ws + WS_SSQ), a.out};
        pg8::gemm_phase<pg8::EpiInAB, pg8::StaticOrder, true, true>(lds, g, S, E);
        } else { p0_weights(a, lds, WI_IN, WI_TOT, ((int)blockIdx.x - ge) * NWAVES + wave, (G - ge) * NWAVES, lane_id(), wave); copy_range<256 - GE_P1>(a, CP_C0, CP_C1, (int)blockIdx.x - ge, wave); }
        if (ge == G && rep_ == 0) copy_range_simple(a, CP_C0, CP_C1, blockIdx.x, G, wave * 64 + lane_id());
    } }
    GRID_BAR();
    REPEAT(REP_P2) { if (rep_) { GRID_BAR(); } PH(2) { PHASE_BEGIN p2_conv(a, lds, tid, lane, wave);
        if (G == 256 && (int)blockIdx.x >= 32 && rep_ == 0) copy_range<224>(a, CP_P2, CP_C0, (int)blockIdx.x - 32, wave);
    } }
    GRID_BAR();
    REPEAT(REP_P3) { if (rep_) { GRID_BAR(); } PH(3) {
        PHASE_BEGIN
        pg8::Gemm g{(const bf16_t*)(ws + WS_AB), (const bf16_t*)(ws + WS_WOUT), MPR, D, D, wave}; pg8::StaticOrder S; S.init(MPR, D, G, (int)blockIdx.x);
        pg8::EpiResid E{(bf16_t*)(ws + WS_HB), (float*)(ws + WS_SSQ), 0};
        pg8::gemm_phase<pg8::EpiResid, pg8::StaticOrder, true, true>(lds, g, S, E);
        sample_gemm<0, D>(lds, (const bf16_t*)(ws + WS_AB) + (size_t)MPR * D, (const bf16_t*)(ws + WS_WOUT), D, nullptr, nullptr, (bf16_t*)(ws + WS_HB) + (size_t)MPR * D,
                          (float*)(ws + WS_SSQ), nullptr, nullptr, nullptr, tid, lane, wave);
    } }
    GRID_BAR();
#pragma clang loop unroll(disable)
    for (int layer = 0; layer < 2; ++layer) {
        if (layer == 1) {
            REPEAT(REP_P7) { if (rep_) { GRID_BAR(); } PH(7) {
                PHASE_BEGIN
                pg8::Gemm g{(const bf16_t*)(ws + WS_HB), (const bf16_t*)(ws + WS_WQKV), MPR, 3 * D, D, wave}; pg8::StaticOrder S; S.init(MPR, 3 * D, G, (int)blockIdx.x);
                pg8::EpiQkv E{(bf16_t*)(ws + WS_Q), (float*)(ws + WS_QS), (const float*)(ws + WS_SSQ), a.out};
                pg8::gemm_phase<pg8::EpiQkv, pg8::StaticOrder, true, true>(lds, g, S, E);
                sample_gemm_qkv(lds, (const bf16_t*)(ws + WS_HB) + (size_t)MPR * D, (const bf16_t*)(ws + WS_WQKV), (const float*)(ws + WS_SSQ), (bf16_t*)(ws + WS_Q), (float*)(ws + WS_QS), a.out,
                                wave * 64 + lane_id(), lane_id(), wave);
            } }
            GRID_BAR();
            REPEAT(REP_P8) { if (rep_) { GRID_BAR(); } PH(8) { PHASE_BEGIN p8_attention(a, lds, tid, lane, wave, 2); } }
            REPEAT(REP_P8S) { PH(8) { PHASE_BEGIN p8_attention(a, lds, tid, lane, wave, 1); } }
            GRID_BAR();
            PH(9) {
                PHASE_BEGIN
                pg8::Gemm g{(const bf16_t*)(ws + WS_AB), (const bf16_t*)(ws + WS_WO), MPR, D, D, wave}; pg8::StaticOrder S; S.init(MPR, D, G, (int)blockIdx.x);
                pg8::EpiResid E{(bf16_t*)(ws + WS_HB), (float*)(ws + WS_SSQ), 0};
                pg8::gemm_phase<pg8::EpiResid, pg8::StaticOrder, true, true>(lds, g, S, E);
                sample_gemm<0, D>(lds, (const bf16_t*)(ws + WS_AB) + (size_t)MPR * D, (const bf16_t*)(ws + WS_WO), D, nullptr, nullptr, (bf16_t*)(ws + WS_HB) + (size_t)MPR * D,
                                  (float*)(ws + WS_SSQ), nullptr, nullptr, nullptr, tid, lane, wave);
            }
            GRID_BAR();
        }
        REPEAT(REP_P4) { if (rep_) { GRID_BAR(); } PH(4) {
            PHASE_BEGIN
            const int ge = (G == 256) ? GE_FF : G;
            const size_t clo = layer ? CP_C2 : CP_C1, chi = layer ? CP_TOT : CP_C2;
            if ((int)blockIdx.x >= ge) { if (rep_ == 0) copy_range<256 - GE_FF>(a, clo, chi, (int)blockIdx.x - ge, wave); } else {
            pg8::Gemm g{(const bf16_t*)(ws + WS_HB), (const bf16_t*)(ws + (layer ? WS_WF1 : WS_WF0)), MPAD, 2 * DFF, D, wave}; pg8::StaticOrder S; S.init(MPAD, 2 * DFF, ge, (int)blockIdx.x);
            pg8::EpiFfn E{lds, (bf16_t*)(ws + WS_U), (float*)(ws + WS_SG), (float*)(ws + WS_SU), a.in[20] + (size_t)layer * 3 * DFF, (const float*)(ws + WS_SSQ), a.out, a.in[6], layer};
            pg8::gemm_phase<pg8::EpiFfn, pg8::StaticOrder, true, true>(lds, g, S, E);
            }
            if (ge == G && rep_ == 0) copy_range_simple(a, clo, chi, blockIdx.x, G, wave * 64 + lane_id());
        } }
        GRID_BAR();
        REPEAT(REP_P6) { if (rep_) { GRID_BAR(); } PH(6) {
            PHASE_BEGIN
            pg8::Gemm g{(const bf16_t*)(ws + WS_U), (const bf16_t*)(ws + (layer ? WS_WD1 : WS_WD0)), MPR, D, DFF, wave}; pg8::StaticOrder S; S.init(MPR, D, G, (int)blockIdx.x);
            { pg8::Unit u_; for (int i = 0; S.next(i, u_); ++i) panel_fix(a, layer, u_.pm, tid); }
            asm volatile("s_waitcnt vmcnt(0)" ::: "memory"); __syncthreads();
            const bool real_ = (rep_ + 1 == REP_P6);
            if (layer == 1 && G == 256 && REP_P6 == 1) {
                pg8::EpiFinal E{(const bf16_t*)(ws + WS_HB), (float*)(ws + WS_SSQ), a.in[9], a.out + O_YP, (unsigned*)ws};
                pg8::gemm_phase<pg8::EpiFinal, pg8::StaticOrder, true, true>(lds, g, S, E);
            } else {
            pg8::EpiResid E{(bf16_t*)(ws + WS_HB), real_ ? (float*)(ws + WS_SSQ) : (float*)(ws + WS_ZU), real_ ? 0 : 1};
            pg8::gemm_phase<pg8::EpiResid, pg8::StaticOrder, true, true>(lds, g, S, E);
            }
            if (real_) sample_gemm<0, DFF>(lds, (const bf16_t*)(ws + WS_U) + (size_t)MPR * DFF, (const bf16_t*)(ws + (layer ? WS_WD1 : WS_WD0)), D, nullptr, nullptr, (bf16_t*)(ws + WS_HB) + (size_t)MPR * D,
                                (float*)(ws + WS_SSQ), nullptr, nullptr, nullptr, tid, lane, wave);
        } }
        GRID_BAR();
    }
    REPEAT(REP_P13) { if (rep_) { GRID_BAR(); } PH(13) { PHASE_BEGIN p13_final(a, (G == 256 && REP_P6 == 1) ? MPR : 0, gw, NGW, lane); } }
    }
}

extern "C" void kernel_launch(void* const* d_in, const int* in_sizes, int n_in, void* d_out, int out_size, void* d_ws, size_t ws_size, hipStream_t stream) {
    static int grid = 0;
    if (grid == 0) {
        if (n_in != 22 || (size_t)out_size != O_END || ws_size < WS_END) { fprintf(stderr, "kernel_launch: unexpected shapes (n_in %d, out %d, ws %zu, need %zu)\n", n_in, out_size, ws_size, (size_t)WS_END); grid = -1; return; }
        int dev = 0, cus = 0, per_cu = 0;
        if (hipGetDevice(&dev) != hipSuccess || hipDeviceGetAttribute(&cus, hipDeviceAttributeMultiprocessorCount, dev) != hipSuccess) { grid = -1; return; }
        if (hipFuncSetAttribute((const void*)mega_fwd, hipFuncAttributeMaxDynamicSharedMemorySize, LDS_BYTES) != hipSuccess) { fprintf(stderr, "kernel_launch: hipFuncSetAttribute failed\n"); grid = -1; return; }
        if (hipOccupancyMaxActiveBlocksPerMultiprocessor(&per_cu, (const void*)mega_fwd, NTHREADS, LDS_BYTES) != hipSuccess || per_cu < 1) { fprintf(stderr, "kernel_launch: occupancy query failed (%d)\n", per_cu); (void)hipGetLastError(); grid = -1; return; }
        grid = cus * 1;
    }
    if (grid < 0) return;
    if (hipMemsetAsync((char*)d_ws + WS_CTL, 0, CTL_BYTES, stream) != hipSuccess) { fprintf(stderr, "kernel_launch: memset failed\n"); return; }
    Args a{};
    for (int i = 0; i < 22; ++i) a.in[i] = (const float*)d_in[i];
    a.out = (float*)d_out; a.ws = (unsigned char*)d_ws;
    void* args[] = {&a};
    hipError_t e = hipLaunchCooperativeKernel((const void*)mega_fwd, dim3(grid), dim3(NTHREADS), args, LDS_BYTES, stream);
    if (e != hipSuccess) fprintf(stderr, "cooperative launch failed: %s (grid %d)\n", hipGetErrorString(e), grid);
}
```

```cpp
#include <hip/hip_runtime.h>
#include <hip/hip_cooperative_groups.h>
#include <cstdio>
#include <cstdint>
namespace cg = cooperative_groups;

#define LAS __attribute__((address_space(3)))
typedef unsigned short bf16_t;
typedef short bf16x8 __attribute__((ext_vector_type(8)));
typedef float f32x4 __attribute__((ext_vector_type(4)));
typedef float f32x2 __attribute__((ext_vector_type(2)));
typedef float f32x16 __attribute__((ext_vector_type(16)));
typedef unsigned u32x4 __attribute__((ext_vector_type(4)));
typedef unsigned u32x2 __attribute__((ext_vector_type(2)));
typedef short s16x4 __attribute__((ext_vector_type(4)));

constexpr int D = 1024, SEQ = 2048, NB = 8, MPR = NB * SEQ, NSB = 32, NST = 4, MSA = NSB * NST, MTOT = MPR + MSA, MPAD = 16640;
constexpr int DFF = 2816, NIN = 2560, CH = 512, NH = 16, HD = 64, LBUF = 2048, KA = 31;
constexpr int GAW = 1536;
constexpr float RMS_EPS = 1e-6f, LN_EPS = 1e-5f;
constexpr float LOG2E = 1.4426950408889634f;
constexpr float QSCALE = 0.125f * LOG2E;

constexpr size_t O_YP = 0;
constexpr size_t O_YS = O_YP + (size_t)MPR * D;
constexpr size_t O_PCA = O_YS + (size_t)MSA * D;
constexpr size_t O_SCA = O_PCA + (size_t)NB * 30 * CH;
constexpr size_t O_PCB = O_SCA + (size_t)NSB * 30 * CH;
constexpr size_t O_SCB = O_PCB + (size_t)NB * 2 * CH;
constexpr size_t O_PK = O_SCB + (size_t)NSB * 2 * CH;
constexpr size_t O_SK = O_PK + (size_t)MPR * D;
constexpr size_t O_PV = O_SK + (size_t)NSB * LBUF * D;
constexpr size_t O_SV = O_PV + (size_t)MPR * D;
constexpr size_t O_PF = O_SV + (size_t)NSB * LBUF * D;
constexpr size_t O_SF = O_PF + (size_t)2 * NB * 2 * DFF;
constexpr size_t O_END = O_SF + (size_t)2 * NSB * 2 * DFF;

constexpr size_t al(size_t x) { return (x + 4095) & ~(size_t)4095; }
constexpr size_t WS_CTL = 0, CTL_BYTES = 65536;
constexpr size_t WS_WIN = WS_CTL + CTL_BYTES;
constexpr size_t WS_WOUT = WS_WIN + al((size_t)NIN * D * 2);
constexpr size_t WS_WQKV = WS_WOUT + al((size_t)D * D * 2);
constexpr size_t WS_WO = WS_WQKV + al((size_t)3 * D * D * 2);
constexpr size_t WS_WF0 = WS_WO + al((size_t)D * D * 2);
constexpr size_t WS_WF1 = WS_WF0 + al((size_t)2 * DFF * D * 2);
constexpr size_t WS_WD0 = WS_WF1 + al((size_t)2 * DFF * D * 2);
constexpr size_t WS_WD1 = WS_WD0 + al((size_t)D * DFF * 2);
constexpr size_t WS_HB = WS_WD1 + al((size_t)D * DFF * 2);
constexpr size_t WS_H = WS_HB + al((size_t)MPAD * D * 2);
constexpr size_t WS_SSQ = WS_H + 4096;
constexpr size_t WS_GA = WS_SSQ + al((size_t)MPAD * 64 * 4);
constexpr size_t WS_AB = WS_GA + al((size_t)MPAD * GAW * 2);
constexpr size_t WS_ZG = WS_AB + al((size_t)MPAD * D * 2);
constexpr size_t WS_ZU = WS_ZG + al((size_t)MPAD * DFF * 2);
constexpr size_t WS_U = WS_ZU + al((size_t)MPAD * DFF * 2);
constexpr size_t WS_Q = WS_U + al((size_t)MPAD * DFF * 2);
constexpr size_t WS_K = WS_Q + al((size_t)MPAD * D * 2);
constexpr size_t WS_V = WS_K + al((size_t)MPAD * D * 2);
constexpr size_t WS_QS = WS_V + al((size_t)MPAD * D * 2);
constexpr size_t WS_SG = WS_QS + al((size_t)MSA * D * 4);
constexpr size_t WS_SU = WS_SG + al((size_t)256 * 4 * DFF * 4);
constexpr size_t WS_END = WS_SU + al((size_t)256 * 2 * DFF * 4);
static_assert(WS_V - WS_K == WS_K - WS_Q, "Q|K|V equally spaced");

constexpr int NWAVES = 8, NTHREADS = 512;
constexpr int LDS_BYTES = 163840;
constexpr int MISC_OFF = LDS_BYTES - 1024;

typedef __bf16 bf16x2_t __attribute__((ext_vector_type(2)));
__device__ __forceinline__ unsigned cvt_pk_bf16(float lo, float hi) { return __builtin_bit_cast(unsigned, __builtin_convertvector((f32x2){lo, hi}, bf16x2_t)); }
__device__ __forceinline__ float bf2f(unsigned short b) { return __uint_as_float((unsigned)b << 16); }
__device__ __forceinline__ float bflo(unsigned w) { return __uint_as_float(w << 16); }
__device__ __forceinline__ float bfhi(unsigned w) { return __uint_as_float(w & 0xffff0000u); }
__device__ __forceinline__ float max_raw(float a, float b) { return __builtin_amdgcn_fmed3f(a, b, INFINITY); }
__device__ __forceinline__ float sigmoidf_(float x) { return __builtin_amdgcn_rcpf(1.0f + __expf(-x)); }
__device__ __forceinline__ int launder_v(int x) { asm volatile("" : "+v"(x)); return x; }
__device__ __forceinline__ int lane_id() { int l; asm volatile("v_mbcnt_lo_u32_b32 %0, -1, 0\n\tv_mbcnt_hi_u32_b32 %0, -1, %0" : "=v"(l)); return l; }
template <int CTRL> __device__ __forceinline__ float dppmov(float v) { return __uint_as_float(__builtin_amdgcn_update_dpp(0u, __float_as_uint(v), CTRL, 0xf, 0xf, true)); }
__device__ __forceinline__ float wave_sum(float v) {
    v += dppmov<0xB1>(v);
    v += dppmov<0x4E>(v);
    v += dppmov<0x141>(v);
    v += dppmov<0x140>(v);
    { auto r = __builtin_amdgcn_permlane16_swap(__float_as_uint(v), __float_as_uint(v), false, false); v = __uint_as_float(r[0]) + __uint_as_float(r[1]); }
    { auto r = __builtin_amdgcn_permlane32_swap(__float_as_uint(v), __float_as_uint(v), false, false); v = __uint_as_float(r[0]) + __uint_as_float(r[1]); }
    return v;
}
__device__ __forceinline__ float wave_max(float v) {
    v = fmaxf(v, dppmov<0xB1>(v)); v = fmaxf(v, dppmov<0x4E>(v)); v = fmaxf(v, dppmov<0x141>(v)); v = fmaxf(v, dppmov<0x140>(v));
    { auto r = __builtin_amdgcn_permlane16_swap(__float_as_uint(v), __float_as_uint(v), false, false); v = fmaxf(__uint_as_float(r[0]), __uint_as_float(r[1])); }
    { auto r = __builtin_amdgcn_permlane32_swap(__float_as_uint(v), __float_as_uint(v), false, false); v = fmaxf(__uint_as_float(r[0]), __uint_as_float(r[1])); }
    return v;
}

namespace pg8 {
constexpr int BM = 256, BK = 64, HALF = 128, HTB = HALF * BK * 2, STAGE_BYTES = 8 * HTB, NXCD = 8, WGM = 8;
__host__ __device__ __forceinline__ int lds_byte(int r, int c) { const int st = (r >> 4) * 2 + (c >> 5), rr = r & 15, cc = c & 31, ob = rr * 64 + cc * 2; return st * 1024 + (ob ^ (((ob >> 9) & 1) << 5)); }
__host__ __device__ __forceinline__ void stage_rc(int b, int& R, int& C) { const int st = b / 1024, sb = b % 1024, swz = sb ^ (((sb >> 9) & 1) << 5); R = (st >> 1) * 16 + swz / 64; C = (st & 1) * 32 + (swz % 64) / 2; }
__host__ __device__ __forceinline__ int perm32(int rho) { const int n = rho >> 4, i = rho & 15; return 8 * (i >> 2) + 4 * n + (i & 3); }

struct Unit { int pm, pn; };
struct Gemm { const bf16_t* A; const bf16_t* Bt; int M, N, K, wid; };

struct StaticOrder {
    int nM, nN, nwg, G, c;
    __host__ __device__ __forceinline__ void init(int M, int N, int G_, int c_) { nM = M / BM; nN = N / BM; nwg = nM * nN; G = G_; c = c_; }
    __host__ __device__ __forceinline__ bool next(int i, Unit& u) const {
        const long L = (long)i * G + c; if (L >= nwg) return false;
        int wgid = (int)L; { const int q = nwg / NXCD, r = nwg % NXCD, xcd = wgid % NXCD, off = wgid / NXCD; wgid = (xcd < r ? xcd * (q + 1) : r * (q + 1) + (xcd - r) * q) + off; }
        const int nig = WGM * nN, gid = wgid / nig, fm = gid * WGM, gsz = (nM - fm) < WGM ? (nM - fm) : WGM;
        u.pm = fm + ((wgid % nig) % gsz); u.pn = (wgid % nig) / gsz; return true;
    }
    __device__ __forceinline__ void a_ready(const Unit&) const {}
    __device__ __forceinline__ void done(const Unit&) const {}
};

__device__ __forceinline__ float fq_sum(float x) {
    auto a = __builtin_amdgcn_permlane16_swap(__float_as_uint(x), __float_as_uint(x), false, false); x = __uint_as_float(a[0]) + __uint_as_float(a[1]);
    auto b = __builtin_amdgcn_permlane32_swap(__float_as_uint(x), __float_as_uint(x), false, false); return __uint_as_float(b[0]) + __uint_as_float(b[1]);
}
__device__ __forceinline__ float row_rstd(const float* ssq, int r, int fq) {
    float s;
    if (r < MPR) { const f32x4 p = *(const f32x4*)(ssq + (size_t)r * 64 + 4 * fq); s = (p.x + p.y) + (p.z + p.w); }
    else { const f32x4* pp = (const f32x4*)(ssq + (size_t)r * 64 + 16 * fq); const f32x4 p = (pp[0] + pp[1]) + (pp[2] + pp[3]); s = (p.x + p.y) + (p.z + p.w); }
    return __builtin_amdgcn_rsqf(fq_sum(s) * (1.0f / D) + RMS_EPS);
}

struct EpiInAB {
    static constexpr bool PERM = true, AFTER_DRAIN = false;
    bf16_t* GA; const float* ssq; float* out;
    __device__ __forceinline__ void operator()(const f32x4 (&acc)[2][2][4][2], const Unit& u, int wr, int wc, int fr, int fq) const {
        const int pn = u.pn, colw = wc * 32 + 8 * fq;
        float rsv[2][4];
#pragma unroll
        for (int ai = 0; ai < 2; ++ai)
#pragma unroll
            for (int m = 0; m < 4; ++m) rsv[ai][m] = row_rstd(ssq, u.pm * BM + ai * HALF + wr * 64 + m * 16 + fr, fq);
        asm volatile("" ::: "memory");
#pragma unroll
        for (int ai = 0; ai < 2; ++ai)
#pragma unroll
            for (int m = 0; m < 4; ++m) {
                const int r = u.pm * BM + ai * HALF + wr * 64 + m * 16 + fr;
                const float rs = rsv[ai][m];
                const f32x4 a0 = acc[ai][0][m][0] * rs, a1 = acc[ai][0][m][1] * rs, g0 = acc[ai][1][m][0] * rs, g1 = acc[ai][1][m][1] * rs;
                bf16_t* rowp = GA + (size_t)r * GAW;
                if (pn < 8) {
                    f32x4 v0, v1;
                    if (pn < 4) {
#pragma unroll
                        for (int i = 0; i < 4; ++i) { v0[i] = a0[i] * sigmoidf_(g0[i]); v1[i] = a1[i] * sigmoidf_(g1[i]); }
                    } else { v0 = a0 * g0; v1 = a1 * g1; }
                    const int cl = 128 * (pn & 3) + colw;
                    u32x4 w; w.x = cvt_pk_bf16(v0[0], v0[1]); w.y = cvt_pk_bf16(v0[2], v0[3]); w.z = cvt_pk_bf16(v1[0], v1[1]); w.w = cvt_pk_bf16(v1[2], v1[3]);
                    *(u32x4*)(rowp + (pn < 4 ? 0 : 512) + cl) = w;
                    const int keep = pn < 4 ? 30 : 2;
                    float* sp = nullptr;
                    if (r < MPR) { const int t = r & (SEQ - 1), b = r >> 11; if (t >= SEQ - keep) sp = out + (pn < 4 ? O_PCA : O_PCB) + ((size_t)(b * keep + (t - (SEQ - keep)))) * CH + cl; }
                    else if (r < MTOT) { const int rs_ = r - MPR, sb = rs_ >> 2, j = rs_ & 3; if (j >= NST - keep || keep == 30) sp = out + (pn < 4 ? O_SCA : O_SCB) + ((size_t)(sb * keep + (keep - NST + j))) * CH + cl; }
                    if (sp) { *(f32x4*)sp = v0; *(f32x4*)(sp + 4) = v1; }
                } else {
                    const int c = 1024 + 256 * (pn - 8) + colw;
                    u32x4 w; w.x = cvt_pk_bf16(a0[0], a0[1]); w.y = cvt_pk_bf16(a0[2], a0[3]); w.z = cvt_pk_bf16(a1[0], a1[1]); w.w = cvt_pk_bf16(a1[2], a1[3]);
                    *(u32x4*)(rowp + c) = w;
                    w.x = cvt_pk_bf16(g0[0], g0[1]); w.y = cvt_pk_bf16(g0[2], g0[3]); w.z = cvt_pk_bf16(g1[0], g1[1]); w.w = cvt_pk_bf16(g1[2], g1[3]);
                    *(u32x4*)(rowp + c + 128) = w;
                }
            }
    }
};
struct EpiResid {
    static constexpr bool PERM = true, AFTER_DRAIN = false;
    bf16_t* HB; float* ssq; int skip;
    __device__ __forceinline__ void operator()(const f32x4 (&acc)[2][2][4][2], const Unit& u, int wr, int wc, int fr, int fq) const {
        const int col0 = u.pn * BM + wc * 32 + 8 * fq;
        if (skip) { if (acc[0][0][0][0][0] == 1.2345e-30f) ssq[0] = 0.f; return; }
#pragma unroll
        for (int ai = 0; ai < 2; ++ai) {
            u32x4 bs[4][2];
#pragma unroll
            for (int m = 0; m < 4; ++m) { const int r = u.pm * BM + ai * HALF + wr * 64 + m * 16 + fr; const int rc = r < MTOT ? r : MTOT - 1;
#pragma unroll
                for (int bj = 0; bj < 2; ++bj) bs[m][bj] = *(const u32x4*)(HB + (size_t)rc * D + col0 + bj * HALF); }
            asm volatile("" ::: "memory");
#pragma unroll
            for (int m = 0; m < 4; ++m) {
                const int r = u.pm * BM + ai * HALF + wr * 64 + m * 16 + fr;
                float s = 0.f;
                if (r < MTOT) {
#pragma unroll
                    for (int bj = 0; bj < 2; ++bj) {
                        const u32x4 b = bs[m][bj];
                        const f32x4 v0 = (f32x4){bflo(b.x), bfhi(b.x), bflo(b.y), bfhi(b.y)} + acc[ai][bj][m][0];
                        const f32x4 v1 = (f32x4){bflo(b.z), bfhi(b.z), bflo(b.w), bfhi(b.w)} + acc[ai][bj][m][1];
                        s += ((v0[0] * v0[0] + v0[1] * v0[1]) + (v0[2] * v0[2] + v0[3] * v0[3])) + ((v1[0] * v1[0] + v1[1] * v1[1]) + (v1[2] * v1[2] + v1[3] * v1[3]));
                        u32x4 w; w.x = cvt_pk_bf16(v0[0], v0[1]); w.y = cvt_pk_bf16(v0[2], v0[3]); w.z = cvt_pk_bf16(v1[0], v1[1]); w.w = cvt_pk_bf16(v1[2], v1[3]);
                        *(u32x4*)(HB + (size_t)r * D + col0 + bj * HALF) = w;
                    }
                }
                s = fq_sum(s);
                if (fq == 0 && r < MTOT) ssq[(size_t)r * 64 + u.pn * 4 + wc] = s;
            }
        }
    }
};
template <int CTRL> __device__ __forceinline__ float dpp_f(float old, float src) {
    return __uint_as_float(__builtin_amdgcn_update_dpp(__float_as_uint(old), __float_as_uint(src), CTRL, 0xf, 0xf, false)); }
struct EpiFfn {
    static constexpr bool PERM = true, AFTER_DRAIN = false;
    LAS unsigned char* lds; bf16_t* U; float* SG; float* SU; const float* wcv; const float* ssq; float* out; const float* fst; int layer;
    __device__ __forceinline__ void operator()(const f32x4 (&acc)[2][2][4][2], const Unit& u, int wr, int wc, int fr, int fq) const {
        asm volatile("" : "+v"(fr), "+v"(fq));
        const int col = u.pn * 128 + wc * 32 + 8 * fq;
        f32x4 w0[2], w1[2], w2[2];
#pragma unroll
        for (int n = 0; n < 2; ++n) { w0[n] = *(const f32x4*)(wcv + col + 4 * n); w1[n] = *(const f32x4*)(wcv + DFF + col + 4 * n); w2[n] = *(const f32x4*)(wcv + 2 * DFF + col + 4 * n); }
        if (u.pm >= MPR / BM) {
#pragma unroll
            for (int ai = 0; ai < 2; ++ai)
#pragma unroll
                for (int m = 0; m < 4; ++m) {
                    const int r = u.pm * BM + ai * HALF + wr * 64 + m * 16 + fr;
                    if (ai * HALF + wr * 64 + m * 16 >= MSA) continue;
                    const float rs = row_rstd(ssq, r, fq);
                    const int rs_ = r - MPR, sb = rs_ >> 2, j = rs_ & 3;
                    const float* sp0 = fst + ((size_t)((layer * NSB + sb) * 2)) * DFF + col;
                    f32x4 g[2], up[2], s0[2], s1[2], o[2];
#pragma unroll
                    for (int n = 0; n < 2; ++n) { g[n] = acc[ai][0][m][n] * rs; up[n] = acc[ai][1][m][n] * rs; s0[n] = *(const f32x4*)(sp0 + 4 * n); s1[n] = *(const f32x4*)(sp0 + DFF + 4 * n); }
#pragma unroll
                    for (int n = 0; n < 2; ++n)
#pragma unroll
                        for (int i = 0; i < 4; ++i) {
                            const float q1 = dpp_f<0x90>(0.f, g[n][i]), q2 = dpp_f<0x40>(0.f, g[n][i]);
                            const float gm1 = (j == 0) ? s1[n][i] : q1, gm2 = (j == 0) ? s0[n][i] : (j == 1) ? s1[n][i] : q2;
                            const float y = w0[n][i] * gm2 + w1[n][i] * gm1 + w2[n][i] * g[n][i];
                            o[n][i] = y * sigmoidf_(y) * up[n][i];
                        }
                    u32x4 w; w.x = cvt_pk_bf16(o[0][0], o[0][1]); w.y = cvt_pk_bf16(o[0][2], o[0][3]); w.z = cvt_pk_bf16(o[1][0], o[1][1]); w.w = cvt_pk_bf16(o[1][2], o[1][3]);
                    *(u32x4*)(U + (size_t)r * DFF + col) = w;
                    if (j >= 2) { float* sp = out + O_SF + ((size_t)((layer * NSB + sb) * 2 + (j - 2))) * DFF + col; *(f32x4*)sp = g[0]; *(f32x4*)(sp + 4) = g[1]; }
                }
            return;
        }
        float rsv[2][4];
#pragma unroll
        for (int ai = 0; ai < 2; ++ai)
#pragma unroll
            for (int m = 0; m < 4; ++m) rsv[ai][m] = row_rstd(ssq, (u.pm * 4 + ai * 2 + wr) * 64 + m * 16 + fr, fq);
        asm volatile("" ::: "memory");
        LAS float* xg = (LAS float*)(lds + STAGE_BYTES);
#pragma unroll
        for (int ai = 0; ai < 2; ++ai) { const int bl = ai * 2 + wr;
            if (bl < 3 && fr >= 14) { LAS float* xp = xg + (bl * 2 + (fr - 14)) * 128 + wc * 32 + 8 * fq; *(LAS f32x4*)xp = acc[ai][0][3][0] * rsv[ai][3]; *(LAS f32x4*)(xp + 4) = acc[ai][0][3][1] * rsv[ai][3]; } }
        asm volatile("s_waitcnt lgkmcnt(0)" ::: "memory");
        __builtin_amdgcn_s_barrier();
#pragma unroll
        for (int ai = 0; ai < 2; ++ai) {
            const int bl = ai * 2 + wr, blk = u.pm * 4 + bl;
            f32x4 gp[2];
            gp[0] = (f32x4){0.f, 0.f, 0.f, 0.f}; gp[1] = gp[0];
            if (bl >= 1 && fr >= 14) { const LAS float* xp = xg + ((bl - 1) * 2 + (fr - 14)) * 128 + wc * 32 + 8 * fq; gp[0] = *(const LAS f32x4*)xp; gp[1] = *(const LAS f32x4*)(xp + 4); }
#pragma unroll
            for (int m = 0; m < 4; ++m) {
                const int r = blk * 64 + m * 16 + fr;
                const float rs = rsv[ai][m];
                f32x4 g[2], up[2], o[2];
#pragma unroll
                for (int n = 0; n < 2; ++n) { g[n] = acc[ai][0][m][n] * rs; up[n] = acc[ai][1][m][n] * rs; }
#pragma unroll
                for (int n = 0; n < 2; ++n)
#pragma unroll
                    for (int i = 0; i < 4; ++i) {
                        const float x1 = dpp_f<0x121>(0.f, gp[n][i]), gm1 = dpp_f<0x111>(x1, g[n][i]);
                        const float x2 = dpp_f<0x122>(0.f, gp[n][i]), gm2 = dpp_f<0x112>(x2, g[n][i]);
                        const float y = w0[n][i] * gm2 + w1[n][i] * gm1 + w2[n][i] * g[n][i];
                        o[n][i] = y * sigmoidf_(y) * up[n][i];
                    }
                const bool seam_lo = (bl == 0) && (m == 0) && (fr < 2), seam_hi = (bl == 3) && (m == 3) && (fr >= 14);
                if (!seam_lo) { u32x4 w; w.x = cvt_pk_bf16(o[0][0], o[0][1]); w.y = cvt_pk_bf16(o[0][2], o[0][3]); w.z = cvt_pk_bf16(o[1][0], o[1][1]); w.w = cvt_pk_bf16(o[1][2], o[1][3]);
                    *(u32x4*)(U + (size_t)r * DFF + col) = w; }
                else { float* sg = SG + ((size_t)u.pm * 4 + fr) * DFF + col; *(f32x4*)sg = g[0]; *(f32x4*)(sg + 4) = g[1];
                       float* su = SU + ((size_t)u.pm * 2 + fr) * DFF + col; *(f32x4*)su = up[0]; *(f32x4*)(su + 4) = up[1]; }
                if (seam_hi) { float* sg = SG + ((size_t)u.pm * 4 + 2 + (fr - 14)) * DFF + col; *(f32x4*)sg = g[0]; *(f32x4*)(sg + 4) = g[1];
                    const int t = r & (SEQ - 1), b = r >> 11;
                    if (t >= SEQ - 2) { float* sp = out + O_PF + ((size_t)((layer * NB + b) * 2 + (t - (SEQ - 2)))) * DFF + col; *(f32x4*)sp = g[0]; *(f32x4*)(sp + 4) = g[1]; } }
                gp[0] = g[0]; gp[1] = g[1];
            }
        }
    }
};
struct EpiQkv {
    static constexpr bool PERM = true, AFTER_DRAIN = false;
    bf16_t* QKV; float* QS; const float* ssq; float* out;
    __device__ __forceinline__ void operator()(const f32x4 (&acc)[2][2][4][2], const Unit& u, int wr, int wc, int fr, int fq) const {
        const int which = u.pn >> 2, cb = 256 * (u.pn & 3) + wc * 32 + 8 * fq;
        bf16_t* dst = QKV + (size_t)which * ((WS_K - WS_Q) / 2);
        float rsv[2][4];
#pragma unroll
        for (int ai = 0; ai < 2; ++ai)
#pragma unroll
            for (int m = 0; m < 4; ++m) rsv[ai][m] = row_rstd(ssq, u.pm * BM + ai * HALF + wr * 64 + m * 16 + fr, fq);
        asm volatile("" ::: "memory");
#pragma unroll
        for (int ai = 0; ai < 2; ++ai)
#pragma unroll
            for (int m = 0; m < 4; ++m) {
                const int r = u.pm * BM + ai * HALF + wr * 64 + m * 16 + fr;
                const float rs = rsv[ai][m] * (which == 0 ? QSCALE : 1.0f);
                float* fp = nullptr;
                if (which == 0) { if (r >= MPR && r < MTOT) fp = QS + (size_t)(r - MPR) * D; }
                else if (r < MPR) fp = out + (which == 1 ? O_PK : O_PV) + (size_t)r * D;
                else if (r < MTOT) { const int rs_ = r - MPR, sb = rs_ >> 2, j = rs_ & 3; fp = out + (which == 1 ? O_SK : O_SV) + ((size_t)sb * LBUF + (LBUF - NST) + j) * D; }
#pragma unroll
                for (int bj = 0; bj < 2; ++bj) {
                    const f32x4 v0 = acc[ai][bj][m][0] * rs, v1 = acc[ai][bj][m][1] * rs;
                    const int c = cb + bj * HALF;
                    u32x4 w; w.x = cvt_pk_bf16(v0[0], v0[1]); w.y = cvt_pk_bf16(v0[2], v0[3]); w.z = cvt_pk_bf16(v1[0], v1[1]); w.w = cvt_pk_bf16(v1[2], v1[3]);
                    *(u32x4*)(dst + (size_t)r * D + c) = w;
                    if (fp) { *(f32x4*)(fp + c) = v0; *(f32x4*)(fp + c + 4) = v1; }
                }
            }
    }
};

template <class Epi, class Sched, bool ALIGN_EPI = false, bool SP2 = false>
__device__ __forceinline__ void gemm_phase(LAS unsigned char* lds, const Gemm g, const Sched& S, const Epi& E) {
    const int wid = g.wid, lane = lane_id(), tid = wid * 64 + lane, wr = wid >> 2, wc = wid & 3, fr = lane & 15, fq = lane >> 4;
    const int K = g.K, nt = K / BK;
    unsigned voffA[2], voffB[2];
#pragma unroll
    for (int i = 0; i < 2; ++i) { int R, C; stage_rc(tid * 16 + i * 8192, R, C); const int Rb = Epi::PERM ? ((R & ~31) + perm32(R & 31)) : R;
        voffA[i] = (unsigned)(R * K + C) * 2u; voffB[i] = (unsigned)(Rb * K + C) * 2u; }
    const size_t kstep = (size_t)(BK * 2);
    const size_t hstep = (size_t)HALF * K * 2;
    const size_t tstep = 2 * hstep;
    const unsigned ldsw = (unsigned)wid * 1024u;
    const int aoff = lds_byte(wr * 64 + fr, fq * 8), boff = lds_byte(wc * 32 + fr, fq * 8);
#define PG8_SA(b, h) (((b) * 2 + (h)) * HTB)
#define PG8_SB(b, h) ((4 + (b) * 2 + (h)) * HTB)
#define PG8_STAGE(bufoff, gbase, voff) do { _Pragma("unroll") for (int _i = 0; _i < 2; ++_i) \
        __builtin_amdgcn_global_load_lds((const unsigned*)((const char*)(gbase) + (voff)[_i]), (LAS unsigned*)(lds + (bufoff) + ldsw + _i * 8192), 16, 0, 0); } while (0)
#define PG8_LDA(dst, b, h) do { _Pragma("unroll") for (int m = 0; m < 4; ++m) _Pragma("unroll") for (int k = 0; k < 2; ++k) dst[m][k] = *(const LAS bf16x8*)(lds + PG8_SA(b, h) + aoff + m * 2048 + k * 1024); } while (0)
#define PG8_LDB(dst, b, h) do { _Pragma("unroll") for (int n = 0; n < 2; ++n) _Pragma("unroll") for (int k = 0; k < 2; ++k) dst[n][k] = *(const LAS bf16x8*)(lds + PG8_SB(b, h) + boff + n * 2048 + k * 1024); } while (0)
#define PG8_MMA(ai, bj, At, Bt) do { __builtin_amdgcn_s_setprio(1); _Pragma("unroll") for (int m = 0; m < 4; ++m) _Pragma("unroll") for (int n = 0; n < 2; ++n) _Pragma("unroll") for (int k = 0; k < 2; ++k) \
        acc[ai][bj][m][n] = __builtin_amdgcn_mfma_f32_16x16x32_bf16(Bt[n][k], At[m][k], acc[ai][bj][m][n], 0, 0, 0); __builtin_amdgcn_s_setprio(0); } while (0)
#define PG8_WAIT_V(n) asm volatile("s_waitcnt vmcnt(" #n ")" ::: "memory")
#define PG8_WAIT_L(n) asm volatile("s_waitcnt lgkmcnt(" #n ")" ::: "memory")
#define PG8_BAR __builtin_amdgcn_s_barrier()
#define PG8_SCHED __builtin_amdgcn_sched_barrier(0)
    Unit cur, nxt; int ui = 0;
    if (!S.next(0, cur)) return;
    f32x4 acc[2][2][4][2];
#pragma unroll
    for (int a = 0; a < 2; ++a)
#pragma unroll
        for (int b = 0; b < 2; ++b)
#pragma unroll
            for (int m = 0; m < 4; ++m)
#pragma unroll
                for (int n = 0; n < 2; ++n) acc[a][b][m][n] = (f32x4){0.f, 0.f, 0.f, 0.f};
    bf16x8 At[4][2], B0[2][2], B1[2][2];
    const char* cA = (const char*)g.A + (size_t)cur.pm * tstep; const char* cB = (const char*)g.Bt + (size_t)cur.pn * tstep;
    S.a_ready(cur);
    if constexpr (SP2) {
        PG8_STAGE(PG8_SB(0, 0), cB, voffB); PG8_STAGE(PG8_SB(0, 1), cB + hstep, voffB); PG8_STAGE(PG8_SA(0, 0), cA, voffA); PG8_STAGE(PG8_SA(0, 1), cA + hstep, voffA);
        if (wr == 1) PG8_BAR;
        PG8_WAIT_V(2); PG8_BAR;
        PG8_STAGE(PG8_SB(1, 0), cB + kstep, voffB); PG8_STAGE(PG8_SA(1, 0), cA + kstep, voffA); PG8_STAGE(PG8_SB(1, 1), cB + hstep + kstep, voffB);
        PG8_WAIT_V(6); PG8_BAR;
    } else {
        PG8_STAGE(PG8_SB(0, 0), cB, voffB); PG8_STAGE(PG8_SA(0, 0), cA, voffA); PG8_STAGE(PG8_SB(0, 1), cB + hstep, voffB); PG8_STAGE(PG8_SA(0, 1), cA + hstep, voffA);
        if (wr == 1) PG8_BAR;
        PG8_WAIT_V(4); PG8_BAR;
        PG8_STAGE(PG8_SB(1, 0), cB + kstep, voffB); PG8_STAGE(PG8_SA(1, 0), cA + kstep, voffA); PG8_STAGE(PG8_SB(1, 1), cB + hstep + kstep, voffB);
        PG8_WAIT_V(6); PG8_BAR;
    }
    for (;;) {
        const bool has_next = S.next(ui + 1, nxt);
        const char* nA = has_next ? (const char*)g.A + (size_t)nxt.pm * tstep : cA; const char* nB = has_next ? (const char*)g.Bt + (size_t)nxt.pn * tstep : cB;
        for (int t = 0; t < nt; t += 2) {
            const bool last = (t == nt - 2);
            const char* a1 = cA + (size_t)(t + 1) * kstep;
            const char* a2 = last ? nA : cA + (size_t)(t + 2) * kstep; const char* b2 = last ? nB : cB + (size_t)(t + 2) * kstep;
            const char* a3 = a2 + kstep; const char* b3 = b2 + kstep;
            if (last && has_next) S.a_ready(nxt);
            if constexpr (SP2) {
            PG8_LDB(B0, 0, 0); PG8_LDB(B1, 0, 1); PG8_SCHED; PG8_LDA(At, 0, 0); PG8_STAGE(PG8_SA(1, 1), a1 + hstep, voffA);
            PG8_WAIT_V(8); PG8_WAIT_L(0); PG8_BAR; PG8_MMA(0, 0, At, B0); PG8_MMA(0, 1, At, B1); PG8_BAR; PG8_SCHED;
            PG8_LDA(At, 0, 1); PG8_STAGE(PG8_SB(0, 0), b2, voffB); PG8_STAGE(PG8_SB(0, 1), b2 + hstep, voffB); PG8_STAGE(PG8_SA(0, 0), a2, voffA);
            PG8_WAIT_V(8); PG8_WAIT_L(0); PG8_BAR; PG8_MMA(1, 0, At, B0); PG8_MMA(1, 1, At, B1); PG8_BAR; PG8_SCHED;
            PG8_LDB(B0, 1, 0); PG8_LDB(B1, 1, 1); PG8_SCHED; PG8_LDA(At, 1, 0); PG8_STAGE(PG8_SA(0, 1), a2 + hstep, voffA);
            PG8_WAIT_V(8); PG8_WAIT_L(0); PG8_BAR; PG8_MMA(0, 0, At, B0); PG8_MMA(0, 1, At, B1); PG8_BAR; PG8_SCHED;
            PG8_LDA(At, 1, 1); PG8_STAGE(PG8_SB(1, 0), b3, voffB); PG8_STAGE(PG8_SB(1, 1), b3 + hstep, voffB); PG8_STAGE(PG8_SA(1, 0), a3, voffA);
            PG8_WAIT_V(8); PG8_WAIT_L(0); PG8_BAR; PG8_MMA(1, 0, At, B0); PG8_MMA(1, 1, At, B1); PG8_BAR; PG8_SCHED;
            } else {
            PG8_LDB(B0, 0, 0); PG8_SCHED; PG8_LDA(At, 0, 0); PG8_STAGE(PG8_SA(1, 1), a1 + hstep, voffA);
            PG8_WAIT_L(8); PG8_BAR; PG8_WAIT_L(0); PG8_MMA(0, 0, At, B0); PG8_BAR; PG8_SCHED;
            PG8_LDB(B1, 0, 1); PG8_STAGE(PG8_SB(0, 0), b2, voffB);
            PG8_BAR; PG8_WAIT_L(0); PG8_MMA(0, 1, At, B1); PG8_BAR;
            PG8_LDA(At, 0, 1); PG8_STAGE(PG8_SA(0, 0), a2, voffA);
            PG8_BAR; PG8_WAIT_L(0); PG8_MMA(1, 0, At, B0); PG8_BAR; PG8_SCHED;
            PG8_STAGE(PG8_SB(0, 1), b2 + hstep, voffB);
            PG8_WAIT_V(6); PG8_BAR; PG8_MMA(1, 1, At, B1); PG8_BAR;
            PG8_LDB(B0, 1, 0); PG8_SCHED; PG8_LDA(At, 1, 0); PG8_STAGE(PG8_SA(0, 1), a2 + hstep, voffA);
            PG8_WAIT_L(8); PG8_BAR; PG8_WAIT_L(0); PG8_MMA(0, 0, At, B0); PG8_BAR; PG8_SCHED;
            PG8_LDB(B1, 1, 1); PG8_STAGE(PG8_SB(1, 0), b3, voffB);
            PG8_BAR; PG8_WAIT_L(0); PG8_MMA(0, 1, At, B1); PG8_BAR;
            PG8_LDA(At, 1, 1); PG8_STAGE(PG8_SA(1, 0), a3, voffA);
            PG8_BAR; PG8_WAIT_L(0); PG8_MMA(1, 0, At, B0); PG8_BAR; PG8_SCHED;
            PG8_STAGE(PG8_SB(1, 1), b3 + hstep, voffB);
            PG8_WAIT_V(6); PG8_BAR; PG8_MMA(1, 1, At, B1); PG8_BAR;
            }
        }
        if constexpr (ALIGN_EPI) { if (wr == 0) PG8_BAR; }
        if constexpr (!Epi::AFTER_DRAIN) { E(acc, cur, wr, wc, fr, fq); S.done(cur); }
        if (!has_next) break;
#pragma unroll
        for (int a = 0; a < 2; ++a)
#pragma unroll
            for (int b = 0; b < 2; ++b)
#pragma unroll
                for (int m = 0; m < 4; ++m)
#pragma unroll
                    for (int n = 0; n < 2; ++n) acc[a][b][m][n] = (f32x4){0.f, 0.f, 0.f, 0.f};
        cur = nxt; cA = nA; cB = nB; ++ui;
        if constexpr (ALIGN_EPI) { if (wr == 1) PG8_BAR; }
    }
    PG8_WAIT_V(0);
    if constexpr (!ALIGN_EPI) { if (wr == 0) PG8_BAR; }
    PG8_BAR;
#undef PG8_SA
#undef PG8_SB
#undef PG8_STAGE
#undef PG8_LDA
#undef PG8_LDB
#undef PG8_MMA
#undef PG8_WAIT_V
#undef PG8_WAIT_L
#undef PG8_BAR
#undef PG8_SCHED
}
}

__device__ __forceinline__ void transpose_item(const float* W, int K, int N, bf16_t* WT, int k0, int np0, int srcn0, const float* g, LAS float* scr, int lane) {
    f32x4 v[8];
#pragma unroll
    for (int i = 0; i < 8; ++i) { const int kk = 8 * i + (lane >> 3); v[i] = __builtin_nontemporal_load((const f32x4*)(W + (size_t)(k0 + kk) * N + srcn0 + (lane & 7) * 4)); }
#pragma unroll
    for (int i = 0; i < 8; ++i) { const int kk = 8 * i + (lane >> 3); const float gg = g ? g[k0 + kk] : 1.0f; LAS float* d = scr + kk * 33 + (lane & 7) * 4;
        d[0] = v[i].x * gg; d[1] = v[i].y * gg; d[2] = v[i].z * gg; d[3] = v[i].w * gg; }
    asm volatile("s_waitcnt lgkmcnt(0)" ::: "memory");
    const int c = lane & 7;
#pragma unroll
    for (int j = 0; j < 4; ++j) { const int n = (lane >> 3) + 8 * j; const LAS float* s = scr + (8 * c) * 33 + n;
        u32x4 o; o.x = cvt_pk_bf16(s[0 * 33], s[1 * 33]); o.y = cvt_pk_bf16(s[2 * 33], s[3 * 33]); o.z = cvt_pk_bf16(s[4 * 33], s[5 * 33]); o.w = cvt_pk_bf16(s[6 * 33], s[7 * 33]);
        *(u32x4*)(WT + (size_t)(np0 + n) * K + k0 + 8 * c) = o; }
    asm volatile("s_waitcnt lgkmcnt(0)" ::: "memory");
}
__device__ __forceinline__ int src_in_ab(int np) {
    const int pn = np >> 8, cc = np & 255, bj = cc >> 7, off = cc & 127;
    if (pn < 4) return (bj ? 512 : 0) + 128 * pn + off;
    if (pn < 8) return (bj ? 2048 : 1536) + 128 * (pn - 4) + off;
    return 1024 + 256 * (pn - 8) + cc;
}
__device__ __forceinline__ int src_ffn(int np) { const int pn = np >> 8, cc = np & 255, bj = cc >> 7, off = cc & 127; return (bj ? DFF : 0) + 128 * pn + off; }

struct Args { const float* in[22]; float* out; unsigned char* ws; };

__device__ __forceinline__ void copy_range_simple(const Args& a, size_t lo, size_t hi, int bi, int nb, int tid) {
    const size_t per = (size_t)(LBUF - NST) * D / 4;
    const size_t stride = (size_t)nb * NTHREADS;
    for (size_t i0 = lo + (size_t)bi * NTHREADS + tid; i0 < hi; i0 += 8 * stride) {
        f32x4 kv[8], vv[8];
#pragma unroll
        for (int u = 0; u < 8; ++u) { const size_t i = i0 + u * stride; if (i < hi) { const size_t sb = i / per, rem = i % per;
            kv[u] = __builtin_nontemporal_load((const f32x4*)(a.in[4] + (sb * LBUF + NST) * D) + rem); vv[u] = __builtin_nontemporal_load((const f32x4*)(a.in[5] + (sb * LBUF + NST) * D) + rem); } }
#pragma unroll
        for (int u = 0; u < 8; ++u) { const size_t i = i0 + u * stride; if (i < hi) { const size_t sb = i / per, rem = i % per;
            __builtin_nontemporal_store(kv[u], (f32x4*)(a.out + O_SK + sb * LBUF * D) + rem); __builtin_nontemporal_store(vv[u], (f32x4*)(a.out + O_SV + sb * LBUF * D) + rem); } }
    }
}
template <int NB> __device__ __forceinline__ void copy_range(const Args& a, size_t lo_, size_t hi_, int bi, int wave) {
    constexpr unsigned per = (unsigned)((LBUF - NST) * D / 4);
    const unsigned lo = (unsigned)lo_, hi = (unsigned)hi_; constexpr unsigned stride = (unsigned)NB * NTHREADS;
    const float* kin = a.in[4]; const float* vin = a.in[5]; float* outp = a.out;
#define CP_SRC(T, i) ((const f32x4*)((T) + ((size_t)((i) / per) * LBUF + NST) * D) + ((i) % per))
#define CP_DST(O, i) ((f32x4*)(outp + (O) + (size_t)((i) / per) * LBUF * D) + ((i) % per))
#define CP_LOAD(KK, VV, base) _Pragma("unroll") for (int u = 0; u < 8; ++u) { const unsigned i = (base) + u * stride; KK[u] = __builtin_nontemporal_load(CP_SRC(kin, i)); VV[u] = __builtin_nontemporal_load(CP_SRC(vin, i)); }
#define CP_STORE(KK, VV, base) _Pragma("unroll") for (int u = 0; u < 8; ++u) { const unsigned i = (base) + u * stride; __builtin_nontemporal_store(KK[u], CP_DST(O_SK, i)); __builtin_nontemporal_store(VV[u], CP_DST(O_SV, i)); }
#define CP_BODY CP_LOAD(kB, vB, i0 + 8u * stride) CP_STORE(kA, vA, i0) CP_LOAD(kA, vA, i0 + 16u * stride) CP_STORE(kB, vB, i0 + 8u * stride) i0 += 16u * stride;
    unsigned i0 = lo + (unsigned)bi * NTHREADS + (unsigned)(wave * 64 + lane_id());
    if (i0 >= hi) return;
    const unsigned nIt = ((hi - i0 + stride - 1u) / stride) >> 4;
    f32x4 kA[8], vA[8], kB[8], vB[8];
    if (nIt) {
        CP_LOAD(kA, vA, i0)
        if (nIt >= 2u) {
            CP_BODY
            for (unsigned it = 2u; it < nIt; ++it) { CP_BODY }
        }
        CP_LOAD(kB, vB, i0 + 8u * stride) CP_STORE(kA, vA, i0) CP_STORE(kB, vB, i0 + 8u * stride) i0 += 16u * stride;
    }
    if (i0 < hi) {
#pragma unroll
        for (int u = 0; u < 8; ++u) { const unsigned i = i0 + u * stride; if (i < hi) { kA[u] = __builtin_nontemporal_load(CP_SRC(kin, i)); vA[u] = __builtin_nontemporal_load(CP_SRC(vin, i)); } }
#pragma unroll
        for (int u = 0; u < 8; ++u) { const unsigned i = i0 + (8 + u) * stride; if (i < hi) { kB[u] = __builtin_nontemporal_load(CP_SRC(kin, i)); vB[u] = __builtin_nontemporal_load(CP_SRC(vin, i)); } }
#pragma unroll
        for (int u = 0; u < 8; ++u) { const unsigned i = i0 + u * stride; if (i < hi) { __builtin_nontemporal_store(kA[u], CP_DST(O_SK, i)); __builtin_nontemporal_store(vA[u], CP_DST(O_SV, i)); } }
#pragma unroll
        for (int u = 0; u < 8; ++u) { const unsigned i = i0 + (8 + u) * stride; if (i < hi) { __builtin_nontemporal_store(kB[u], CP_DST(O_SK, i)); __builtin_nontemporal_store(vB[u], CP_DST(O_SV, i)); } }
    }
#undef CP_BODY
#undef CP_LOAD
#undef CP_STORE
#undef CP_SRC
#undef CP_DST
}
constexpr int FR_P1 = 10, FR_P4 = 22, FR_P10 = 22, GE_P1 = 168, GE_FF = 208;
constexpr size_t CP_TOT = (size_t)(LBUF - NST) * D / 4 * NSB;
constexpr int FR_P2 = 4;
constexpr size_t CP_P2 = CP_TOT * (64 - FR_P1 - FR_P4 - FR_P10 - FR_P2) / 64;
constexpr size_t CP_C0 = CP_TOT * (64 - FR_P1 - FR_P4 - FR_P10) / 64, CP_C1 = CP_C0 + CP_TOT * FR_P1 / 64, CP_C2 = CP_C1 + CP_TOT * FR_P4 / 64;

constexpr int WI_IN = (D / 64) * (NIN / 32), WI_SQ = (D / 64) * (D / 32), WI_QKV = (D / 64) * (3 * D / 32), WI_F = (D / 64) * (2 * DFF / 32), WI_DN = (DFF / 64) * (D / 32);
constexpr int WI_TOT = WI_IN + 2 * WI_SQ + WI_QKV + 2 * WI_F + 2 * WI_DN;
__device__ __forceinline__ void p0_weights(const Args& a, LAS unsigned char* lds, int it_lo, int it_hi, int gw, int NGW, int lane, int wave) {
    LAS float* scr = (LAS float*)(lds + wave * 16384);
    unsigned char* ws = a.ws;
    constexpr int I_IN = WI_IN, I_SQ = WI_SQ, I_QKV = WI_QKV, I_F = WI_F, I_DN = WI_DN;
    for (int it = it_lo + gw; it < it_hi; it += NGW) {
        int r = it;
        if (r < I_IN) { const int nb = NIN / 32, kb = r / nb, n0 = 32 * (r % nb); transpose_item(a.in[10], D, NIN, (bf16_t*)(ws + WS_WIN), 64 * kb, n0, src_in_ab(n0), a.in[7], scr, lane); continue; } r -= I_IN;
        if (r < I_SQ) { const int nb = D / 32, kb = r / nb, n0 = 32 * (r % nb); transpose_item(a.in[16], D, D, (bf16_t*)(ws + WS_WOUT), 64 * kb, n0, n0, nullptr, scr, lane); continue; } r -= I_SQ;
        if (r < I_QKV) { const int nb = 3 * D / 32, kb = r / nb, n0 = 32 * (r % nb); transpose_item(a.in[17], D, 3 * D, (bf16_t*)(ws + WS_WQKV), 64 * kb, n0, n0, a.in[7] + D, scr, lane); continue; } r -= I_QKV;
        if (r < I_SQ) { const int nb = D / 32, kb = r / nb, n0 = 32 * (r % nb); transpose_item(a.in[18], D, D, (bf16_t*)(ws + WS_WO), 64 * kb, n0, n0, nullptr, scr, lane); continue; } r -= I_SQ;
        if (r < 2 * I_F) { const int l = r / I_F; r -= l * I_F; const int nb = 2 * DFF / 32, kb = r / nb, n0 = 32 * (r % nb);
            transpose_item(a.in[19] + (size_t)l * D * 2 * DFF, D, 2 * DFF, (bf16_t*)(ws + (l ? WS_WF1 : WS_WF0)), 64 * kb, n0, src_ffn(n0), a.in[8] + l * D, scr, lane); continue; } r -= 2 * I_F;
        { const int l = r / I_DN; r -= l * I_DN; const int nb = D / 32, kb = r / nb, n0 = 32 * (r % nb);
            transpose_item(a.in[21] + (size_t)l * DFF * D, DFF, D, (bf16_t*)(ws + (l ? WS_WD1 : WS_WD0)), 64 * kb, n0, n0, nullptr, scr, lane); }
    }
}
__device__ __forceinline__ void p0_prologue(const Args& a, LAS unsigned char* lds, int gw, int NGW, int lane, int wave) {
    unsigned char* ws = a.ws;
    p0_weights(a, lds, 0, (gridDim.x == 256) ? WI_IN : WI_TOT, gw, NGW, lane, wave);
    bf16_t* HB = (bf16_t*)(ws + WS_HB); float* ssq = (float*)(ws + WS_SSQ);
    for (int r0 = gw; r0 < MPAD; r0 += 2 * NGW) {
        f32x4 v[2][4]; float sq[2];
#pragma unroll
        for (int h = 0; h < 2; ++h) { const int r = r0 + h * NGW; sq[h] = 0.f;
            if (r < MTOT) { const f32x4* xr = (const f32x4*)((r < MPR) ? a.in[0] + (size_t)r * D : a.in[1] + (size_t)(r - MPR) * D) + lane;
#pragma unroll
                for (int j = 0; j < 4; ++j) v[h][j] = __builtin_nontemporal_load(xr + 64 * j); }
            else {
#pragma unroll
                for (int j = 0; j < 4; ++j) v[h][j] = (f32x4){0.f, 0.f, 0.f, 0.f}; } }
#pragma unroll
        for (int h = 0; h < 2; ++h) { const int r = r0 + h * NGW; if (r >= MPAD) continue;
#pragma unroll
            for (int j = 0; j < 4; ++j) sq[h] += (v[h][j].x * v[h][j].x + v[h][j].y * v[h][j].y) + (v[h][j].z * v[h][j].z + v[h][j].w * v[h][j].w);
            const float s = wave_sum(sq[h]);
            u32x2* o8 = (u32x2*)(HB + (size_t)r * D) + lane;
#pragma unroll
            for (int j = 0; j < 4; ++j) { u32x2 w; w.x = cvt_pk_bf16(v[h][j].x, v[h][j].y); w.y = cvt_pk_bf16(v[h][j].z, v[h][j].w); o8[64 * j] = w; }
            if (r < MPR) { if (lane < 16) ssq[(size_t)r * 64 + lane] = (lane == 0) ? s : 0.f; } else ssq[(size_t)r * 64 + lane] = (lane == 0) ? s : 0.f; }
    }
    {
        const int tot = NSB * 26 * (CH / 4);
        for (int i = gw * 64 + lane; i < tot; i += NGW * 64) { const int sb = i / (26 * (CH / 4)), rem = i % (26 * (CH / 4));
            ((f32x4*)(a.out + O_SCA + (size_t)sb * 30 * CH))[rem] = ((const f32x4*)(a.in[2] + (size_t)sb * 30 * CH + 4 * CH))[rem]; }
    }
    if (gridDim.x == 256) copy_range<256>(a, 0, CP_P2, blockIdx.x, wave); else copy_range_simple(a, 0, CP_C0, blockIdx.x, gridDim.x, wave * 64 + lane);
}

__device__ __forceinline__ void p2_conv(const Args& a, LAS unsigned char* lds, int tid, int lane, int wave) {
    unsigned char* ws = a.ws;
    const bf16_t* GA = (const bf16_t*)(ws + WS_GA); bf16_t* AB = (bf16_t*)(ws + WS_AB);
    LAS float* T = (LAS float*)lds;
    for (int u_ = blockIdx.x; u_ < 512 + NSB; u_ += gridDim.x) {
        const int u = (gridDim.x == 256 && u_ < 512) ? 64 * (u_ & 7) + (u_ >> 3) : u_;
        const float* wa = a.in[11]; const float* ba = a.in[12]; const float* lg = a.in[13]; const float* lb = a.in[14]; const float* wb = a.in[15];
        asm volatile("" : "+s"(wa), "+s"(ba), "+s"(lg), "+s"(lb), "+s"(wb));
        const bool samp = u >= 512; const int sb = u - 512;
        const int row0 = samp ? MPR + sb * NST : u * 32, nrows = samp ? NST : 32;
        const int t0 = samp ? 0 : (row0 & (SEQ - 1));
        const int nvec = (nrows + 30) * (CH / 8);
        {
            u32x4 wv[8];
#pragma unroll
            for (int it = 0; it < 8; ++it) { const int i = tid + it * NTHREADS; const int e = i >> 6, c = (i & 63) * 8; const int p = t0 - 30 + e;
                wv[it] = (u32x4){0u, 0u, 0u, 0u};
                if (i < nvec && p >= 0) wv[it] = *(const u32x4*)(GA + (size_t)(row0 - t0 + p) * GAW + c); }
#pragma unroll
            for (int it = 0; it < 8; ++it) { const int i = tid + it * NTHREADS; const int e = i >> 6, c = (i & 63) * 8; const int p = t0 - 30 + e;
                if (i < nvec && (p >= 0 || !samp)) { const u32x4 w = wv[it];
                    *(LAS f32x4*)(T + e * CH + c) = (f32x4){bflo(w.x), bfhi(w.x), bflo(w.y), bfhi(w.y)}; *(LAS f32x4*)(T + e * CH + c + 4) = (f32x4){bflo(w.z), bfhi(w.z), bflo(w.w), bfhi(w.w)}; } }
            if (samp) {
                f32x4 s0_[4], s1_[4];
#pragma unroll
                for (int it = 0; it < 4; ++it) { const int i = tid + it * NTHREADS; if (i < 30 * 64) { const float* sp = a.in[2] + ((size_t)sb * 30 + (i >> 6)) * CH + (i & 63) * 8; s0_[it] = *(const f32x4*)sp; s1_[it] = *(const f32x4*)(sp + 4); } }
#pragma unroll
                for (int it = 0; it < 4; ++it) { const int i = tid + it * NTHREADS; if (i < 30 * 64) { *(LAS f32x4*)(T + (i >> 6) * CH + (i & 63) * 8) = s0_[it]; *(LAS f32x4*)(T + (i >> 6) * CH + (i & 63) * 8 + 4) = s1_[it]; } }
            }
        }
        __syncthreads();
        if (tid < 256) {
            const int c = 2 * tid; f32x2 w[KA];
#pragma unroll
            for (int k = 0; k < KA; ++k) w[k] = *(const f32x2*)(wa + k * CH + c);
            const f32x2 bias = *(const f32x2*)(ba + c);
            if (!samp) {
#pragma clang loop unroll(disable)
                for (int hb = 0; hb < 32; hb += 16) {
                    f32x2 x[46];
#pragma unroll
                    for (int e = 0; e < 46; ++e) x[e] = *(const LAS f32x2*)(T + (hb + e) * CH + c);
#pragma unroll
                    for (int i = 0; i < 16; ++i) {
                        f32x2 s0 = bias, s1 = (f32x2){0.f, 0.f}, s2 = s1, s3 = s1;
#pragma unroll
                        for (int k = 0; k < 28; k += 4) { s0 += w[k] * x[i + k]; s1 += w[k + 1] * x[i + k + 1]; s2 += w[k + 2] * x[i + k + 2]; s3 += w[k + 3] * x[i + k + 3]; }
                        s0 += w[28] * x[i + 28]; s1 += w[29] * x[i + 29]; s2 += w[30] * x[i + 30];
                        *(LAS f32x2*)(T + (hb + i) * CH + c) = (s0 + s1) + (s2 + s3);
                    }
                }
            } else {
                f32x2 x[34];
#pragma unroll
                for (int e = 0; e < 34; ++e) x[e] = *(const LAS f32x2*)(T + e * CH + c);
#pragma unroll
                for (int i = 0; i < NST; ++i) {
                    f32x2 s0 = bias, s1 = (f32x2){0.f, 0.f}, s2 = s1, s3 = s1;
#pragma unroll
                    for (int k = 0; k < 28; k += 4) { s0 += w[k] * x[i + k]; s1 += w[k + 1] * x[i + k + 1]; s2 += w[k + 2] * x[i + k + 2]; s3 += w[k + 3] * x[i + k + 3]; }
                    s0 += w[28] * x[i + 28]; s1 += w[29] * x[i + 29]; s2 += w[30] * x[i + 30];
                    *(LAS f32x2*)(T + i * CH + c) = (s0 + s1) + (s2 + s3);
                }
            }
        } else {
            const int t2 = tid - 256, c = (t2 & 63) * 8, rc = t2 >> 6, rbase = rc * 8;
            const int nr = samp ? (rc == 0 ? NST : 0) : 8;
            float wk[3][8];
#pragma unroll
            for (int k = 0; k < 3; ++k) { const f32x4 wa0 = *(const f32x4*)(wb + k * CH + c), wa1 = *(const f32x4*)(wb + k * CH + c + 4);
                wk[k][0] = wa0.x; wk[k][1] = wa0.y; wk[k][2] = wa0.z; wk[k][3] = wa0.w; wk[k][4] = wa1.x; wk[k][5] = wa1.y; wk[k][6] = wa1.z; wk[k][7] = wa1.w; }
            float xm2[8], xm1[8];
            {
                u32x4 a2 = (u32x4){0u, 0u, 0u, 0u}, a1 = a2;
                if (nr && t0 + rbase - 2 >= 0) { a2 = *(const u32x4*)(GA + (size_t)(row0 + rbase - 2) * GAW + 512 + c); a1 = *(const u32x4*)(GA + (size_t)(row0 + rbase - 1) * GAW + 512 + c); }
                xm2[0] = bflo(a2.x); xm2[1] = bfhi(a2.x); xm2[2] = bflo(a2.y); xm2[3] = bfhi(a2.y); xm2[4] = bflo(a2.z); xm2[5] = bfhi(a2.z); xm2[6] = bflo(a2.w); xm2[7] = bfhi(a2.w);
                xm1[0] = bflo(a1.x); xm1[1] = bfhi(a1.x); xm1[2] = bflo(a1.y); xm1[3] = bfhi(a1.y); xm1[4] = bflo(a1.z); xm1[5] = bfhi(a1.z); xm1[6] = bflo(a1.w); xm1[7] = bfhi(a1.w);
                if (samp && nr) { const float* sp = a.in[3] + (size_t)sb * 2 * CH + c; const f32x4 p0 = *(const f32x4*)sp, p1 = *(const f32x4*)(sp + 4), q0 = *(const f32x4*)(sp + CH), q1 = *(const f32x4*)(sp + CH + 4);
                    xm2[0] = p0.x; xm2[1] = p0.y; xm2[2] = p0.z; xm2[3] = p0.w; xm2[4] = p1.x; xm2[5] = p1.y; xm2[6] = p1.z; xm2[7] = p1.w;
                    xm1[0] = q0.x; xm1[1] = q0.y; xm1[2] = q0.z; xm1[3] = q0.w; xm1[4] = q1.x; xm1[5] = q1.y; xm1[6] = q1.z; xm1[7] = q1.w; }
            }
#pragma clang loop unroll(disable)
            for (int k0 = 0; k0 < nr; k0 += 4) {
                u32x4 cxv[4], gbv[4];
#pragma unroll
                for (int k = 0; k < 4; ++k) { cxv[k] = *(const u32x4*)(GA + (size_t)(row0 + rbase + k0 + k) * GAW + 512 + c); gbv[k] = *(const u32x4*)(GA + (size_t)(row0 + rbase + k0 + k) * GAW + 1024 + c); }
#pragma unroll
                for (int k = 0; k < 4; ++k) {
                    const u32x4 xv = cxv[k], gv = gbv[k];
                    float o[8];
#pragma unroll
                    for (int e = 0; e < 8; ++e) {
                        const unsigned xw = e < 2 ? xv.x : (e < 4 ? xv.y : (e < 6 ? xv.z : xv.w)), gw_ = e < 2 ? gv.x : (e < 4 ? gv.y : (e < 6 ? gv.z : gv.w));
                        const float x0 = (e & 1) ? bfhi(xw) : bflo(xw), gb = (e & 1) ? bfhi(gw_) : bflo(gw_);
                        o[e] = gb * (wk[0][e] * xm2[e] + wk[1][e] * xm1[e] + wk[2][e] * x0); xm2[e] = xm1[e]; xm1[e] = x0; }
                    u32x4 w4; w4.x = cvt_pk_bf16(o[0], o[1]); w4.y = cvt_pk_bf16(o[2], o[3]); w4.z = cvt_pk_bf16(o[4], o[5]); w4.w = cvt_pk_bf16(o[6], o[7]);
                    *(u32x4*)(AB + (size_t)(row0 + rbase + k0 + k) * D + 512 + c) = w4;
                }
            }
        }
        __syncthreads();
        {
            const int c = lane * 8;
            const f32x4 g0 = *(const f32x4*)(lg + c), g1 = *(const f32x4*)(lg + c + 4), b0 = *(const f32x4*)(lb + c), b1 = *(const f32x4*)(lb + c + 4);
            f32x4 v0[4], v1[4]; float mu[4], rstd[4];
#pragma unroll
            for (int j = 0; j < 4; ++j) { const int rr = wave + 8 * j; const int rc = rr < nrows ? rr : 0; v0[j] = *(const LAS f32x4*)(T + rc * CH + c); v1[j] = *(const LAS f32x4*)(T + rc * CH + c + 4); }
#pragma unroll
            for (int j = 0; j < 4; ++j) { const float s_ = (v0[j].x + v0[j].y) + (v0[j].z + v0[j].w) + (v1[j].x + v1[j].y) + (v1[j].z + v1[j].w); mu[j] = wave_sum(s_) * (1.0f / CH); }
#pragma unroll
            for (int j = 0; j < 4; ++j) { v0[j] = v0[j] - mu[j]; v1[j] = v1[j] - mu[j];
                const float q = (v0[j].x * v0[j].x + v0[j].y * v0[j].y) + (v0[j].z * v0[j].z + v0[j].w * v0[j].w) + (v1[j].x * v1[j].x + v1[j].y * v1[j].y) + (v1[j].z * v1[j].z + v1[j].w * v1[j].w);
                rstd[j] = rsqrtf(wave_sum(q) * (1.0f / CH) + LN_EPS); }
#pragma unroll
            for (int j = 0; j < 4; ++j) { const int rr = wave + 8 * j;
                if (rr < nrows) {
                    f32x4 a0 = v0[j] * rstd[j] * g0 + b0, a1 = v1[j] * rstd[j] * g1 + b1;
#pragma unroll
                    for (int e = 0; e < 4; ++e) { a0[e] = a0[e] * sigmoidf_(a0[e]); a1[e] = a1[e] * sigmoidf_(a1[e]); }
                    u32x4 w4; w4.x = cvt_pk_bf16(a0[0], a0[1]); w4.y = cvt_pk_bf16(a0[2], a0[3]); w4.z = cvt_pk_bf16(a1[0], a1[1]); w4.w = cvt_pk_bf16(a1[2], a1[3]);
                    *(u32x4*)(AB + (size_t)(row0 + rr) * D + c) = w4;
                } }
        }
        __syncthreads();
    }
}

__device__ __forceinline__ void panel_fix(const Args& a, int layer, int pm, int tid) {
    unsigned char* ws = a.ws;
    bf16_t* U = (bf16_t*)(ws + WS_U); const float* SG = (const float*)(ws + WS_SG); const float* SU = (const float*)(ws + WS_SU);
    const float* wc = a.in[20] + (size_t)layer * 3 * DFF;
    constexpr int NCV = DFF / 8;
    const bool first = (pm & 7) == 0;
    for (int it = tid; it < 2 * NCV; it += NTHREADS) {
        const int j = it >= NCV ? 1 : 0, cv = it - j * NCV, c = cv * 8;
        float gm2[8], gm1[8], g0[8], up[8];
        const float* cur = SG + (size_t)pm * 4 * DFF + c; const float* prv = SG + (size_t)(pm - 1) * 4 * DFF + c;
#pragma unroll
        for (int e = 0; e < 8; ++e) {
            if (j == 0) { gm2[e] = first ? 0.f : prv[2 * DFF + e]; gm1[e] = first ? 0.f : prv[3 * DFF + e]; g0[e] = cur[e]; }
            else { gm2[e] = first ? 0.f : prv[3 * DFF + e]; gm1[e] = cur[e]; g0[e] = cur[DFF + e]; }
            up[e] = SU[((size_t)pm * 2 + j) * DFF + c + e];
        }
        float o[8];
#pragma unroll
        for (int e = 0; e < 8; ++e) { const float y = wc[c + e] * gm2[e] + wc[DFF + c + e] * gm1[e] + wc[2 * DFF + c + e] * g0[e]; o[e] = y * sigmoidf_(y) * up[e]; }
        u32x4 w4; w4.x = cvt_pk_bf16(o[0], o[1]); w4.y = cvt_pk_bf16(o[2], o[3]); w4.z = cvt_pk_bf16(o[4], o[5]); w4.w = cvt_pk_bf16(o[6], o[7]);
        *(u32x4*)(U + (size_t)(pm * 256 + j) * DFF + c) = w4;
    }
}

constexpr int AT_OACC = 0, AT_ML = 256 * 64 * 4, AT_STG = AT_ML + 2048, AT_KSTR = 144, AT_WSTG = 2 * 32 * AT_KSTR, AT_PSC = 0;
__device__ __forceinline__ int at_swz(int ql) { return (ql ^ (ql >> 4)) & 15; }
static_assert(AT_STG + NWAVES * AT_WSTG <= MISC_OFF && NWAVES * 2048 <= AT_ML, "attention LDS");
__device__ __forceinline__ int crow(int r, int hi) { return (r & 3) + 8 * (r >> 2) + 4 * hi; }

struct AttnRes { f32x16 o0, o1; float m, l; };
#define AT_KLOAD(X, kk_, vv_) _Pragma("unroll") for (int j = 0; j < 4; ++j) { const int kv_ = (lane >> 3) + 8 * j; const int sv_ = kb##X + kv_ < 0 ? 0 : kb##X + kv_; \
        const unsigned ro_ = (unsigned)((cls##X + dil##X * sv_) * D + (lane & 7) * 8) * 2u; kk_[j] = *(const u32x4*)((const char*)Kh + ro_); vv_[j] = *(const u32x4*)((const char*)Vh + ro_); }
#define AT_CB() asm volatile("" ::: "memory")
__device__ __forceinline__ void attn_task2(const bf16_t* Qh, const bf16_t* Kh, const bf16_t* Vh, float slope2,
                                           int dilA, int clsA, int s0A, int nqA, int dilB, int clsB, int s0B, int nqB,
                                           LAS unsigned char* lds, int wave, int lane, AttnRes& RA, AttnRes& RB) {
    asm volatile("" : "+v"(lane));
    const int r32 = lane & 31, hi = lane >> 5;
    const int qa_ = r32 < nqA ? r32 : nqA - 1, qb_ = r32 < nqB ? r32 : nqB - 1;
    const bf16_t* qpA = Qh + (size_t)(clsA + dilA * (s0A + qa_)) * D + hi * 8; const bf16_t* qpB = Qh + (size_t)(clsB + dilB * (s0B + qb_)) * D + hi * 8;
    bf16x8 qrA[4], qrB[4];
#pragma unroll
    for (int d0 = 0; d0 < 4; ++d0) { qrA[d0] = *(const bf16x8*)(qpA + d0 * 16); qrB[d0] = *(const bf16x8*)(qpB + d0 * 16); }
    float mA = -INFINITY, lA = 0.f, mB = -INFINITY, lB = 0.f;
    f32x16 oA0 = f32x16{}, oA1 = f32x16{}, oB0 = f32x16{}, oB1 = f32x16{};
    LAS unsigned char* kst = lds + AT_STG + wave * AT_WSTG; LAS unsigned char* vst = kst + 32 * AT_KSTR;
    const float sdA = slope2 * (float)dilA, sdB = slope2 * (float)dilB;
    const float lbase = (float)(r32 - 4 * hi + 128);
    const int ifA = s0A < 128 ? (128 - s0A) >> 5 : 0, ifB = s0B < 128 ? (128 - s0B) >> 5 : 0, imin = ifA < ifB ? ifA : ifB;
    const int vb = ((lane >> 4) & 1) * 32 + (lane & 3) * 8 + (4 * hi + ((lane & 15) >> 2)) * 64;
#pragma clang loop unroll(disable)
    for (int i = 4; i >= imin; --i) {
        const int kbA = s0A - 128 + 32 * i, kbB = s0B - 128 + 32 * i;
        u32x4 kkA[4], vvA[4], kkB[4], vvB[4];
        AT_KLOAD(A, kkA, vvA)
        AT_KLOAD(B, kkB, vvB)
        bf16x8 kfA[4], kfB[4]; s16x4 tlA[4], thA[4];
#pragma unroll
        for (int j = 0; j < 4; ++j) *(LAS u32x4*)(kst + ((lane >> 3) + 8 * j) * AT_KSTR + (lane & 7) * 16) = kkA[j];
        AT_CB();
#pragma unroll
        for (int d0 = 0; d0 < 4; ++d0) kfA[d0] = *(const LAS bf16x8*)(kst + r32 * AT_KSTR + d0 * 32 + hi * 16);
        AT_CB();
#pragma unroll
        for (int j = 0; j < 4; ++j) *(LAS u32x4*)(kst + ((lane >> 3) + 8 * j) * AT_KSTR + (lane & 7) * 16) = kkB[j];
        AT_CB();
#pragma unroll
        for (int d0 = 0; d0 < 4; ++d0) kfB[d0] = *(const LAS bf16x8*)(kst + r32 * AT_KSTR + d0 * 32 + hi * 16);
        AT_CB();
#pragma unroll
        for (int j = 0; j < 4; ++j) { const int kv = (lane >> 3) + 8 * j, part = lane & 7; const int off_ = (part >> 2) * 2048 + (kv >> 3) * 512 + (kv & 7) * 64 + (part & 3) * 16;
            *(LAS u32x4*)(kst + off_) = vvA[j]; *(LAS u32x4*)(vst + off_) = vvB[j]; }
        AT_CB();
#pragma unroll
        for (int q = 0; q < 4; ++q) { tlA[q] = __builtin_bit_cast(s16x4, __builtin_amdgcn_ds_read_tr16_b64_v4i16((LAS s16x4*)(kst + vb + (q >> 1) * 2048 + (q & 1) * 1024)));
                                      thA[q] = __builtin_bit_cast(s16x4, __builtin_amdgcn_ds_read_tr16_b64_v4i16((LAS s16x4*)(kst + vb + (q >> 1) * 2048 + (q & 1) * 1024 + 512))); }
        AT_CB();
        f32x16 stA, stB;
        { const float tA = sdA * ((float)(32 * i) - lbase), tB = sdB * ((float)(32 * i) - lbase);
#pragma unroll
          for (int r = 0; r < 16; ++r) { const float c_r = (float)((r & 3) + 8 * (r >> 2)); stA[r] = tA + sdA * c_r; stB[r] = tB + sdB * c_r; } }
#pragma unroll
        for (int d0 = 0; d0 < 4; ++d0) { stA = __builtin_amdgcn_mfma_f32_32x32x16_bf16(kfA[d0], qrA[d0], stA, 0, 0, 0); stB = __builtin_amdgcn_mfma_f32_32x32x16_bf16(kfB[d0], qrB[d0], stB, 0, 0, 0); }
        if (kbA < 0 || kbB < 0) {
            int cminA = (i == 0) ? r32 : 0; cminA = cminA > -kbA ? cminA : -kbA; int cminB = (i == 0) ? r32 : 0; cminB = cminB > -kbB ? cminB : -kbB;
            const int cmax = (i == 4) ? r32 : 31;
            const int loA = cminA - 4 * hi, loB = cminB - 4 * hi, hi_ = cmax - 4 * hi;
#pragma unroll
            for (int r = 0; r < 16; ++r) { const int c = (r & 3) + 8 * (r >> 2); stA[r] = (c >= loA && c <= hi_) ? stA[r] : -INFINITY; stB[r] = (c >= loB && c <= hi_) ? stB[r] : -INFINITY; }
        } else if (i == 4) {
            const int hi_ = r32 - 4 * hi;
#pragma unroll
            for (int r = 0; r < 16; ++r) { const int c = (r & 3) + 8 * (r >> 2); const bool ok = c <= hi_; stA[r] = ok ? stA[r] : -INFINITY; stB[r] = ok ? stB[r] : -INFINITY; }
        } else if (i == 0) {
            const int lo_ = r32 - 4 * hi;
#pragma unroll
            for (int r = 0; r < 16; ++r) { const int c = (r & 3) + 8 * (r >> 2); const bool ok = c >= lo_; stA[r] = ok ? stA[r] : -INFINITY; stB[r] = ok ? stB[r] : -INFINITY; }
        }
        float mxA, mxB;
        { float tA[8], tB[8];
#pragma unroll
          for (int r = 0; r < 8; ++r) { tA[r] = max_raw(stA[2 * r], stA[2 * r + 1]); tB[r] = max_raw(stB[2 * r], stB[2 * r + 1]); }
#pragma unroll
          for (int r = 0; r < 4; ++r) { tA[r] = max_raw(tA[2 * r], tA[2 * r + 1]); tB[r] = max_raw(tB[2 * r], tB[2 * r + 1]); }
          mxA = max_raw(max_raw(tA[0], tA[1]), max_raw(tA[2], tA[3])); mxB = max_raw(max_raw(tB[0], tB[1]), max_raw(tB[2], tB[3])); }
        { auto ra = __builtin_amdgcn_permlane32_swap(__float_as_uint(mxA), __float_as_uint(mxA), false, false); mxA = max_raw(__uint_as_float(ra[0]), __uint_as_float(ra[1]));
          auto rb = __builtin_amdgcn_permlane32_swap(__float_as_uint(mxB), __float_as_uint(mxB), false, false); mxB = max_raw(__uint_as_float(rb[0]), __uint_as_float(rb[1])); }
        if (__any((mxA > mA) || (mxB > mB))) {
            const float nA = max_raw(mA, mxA), nB = max_raw(mB, mxB);
            const float alA = __builtin_amdgcn_exp2f(mA - ((nA == -INFINITY) ? 0.f : nA)), alB = __builtin_amdgcn_exp2f(mB - ((nB == -INFINITY) ? 0.f : nB));
            const float fA = (nA == mA) ? 1.0f : alA, fB = (nB == mB) ? 1.0f : alB;
            lA *= fA; lB *= fB; mA = nA; mB = nB;
#pragma unroll
            for (int r = 0; r < 16; ++r) { oA0[r] *= fA; oA1[r] *= fA; oB0[r] *= fB; oB1[r] *= fB; }
        }
        const float muA = (mA == -INFINITY) ? 0.f : mA, muB = (mB == -INFINITY) ? 0.f : mB;
        f32x2 ps2A = (f32x2){0.f, 0.f}, ps2B = ps2A;
        const f32x2 mu2A = (f32x2){muA, muA}, mu2B = (f32x2){muB, muB};
#pragma unroll
        for (int r = 0; r < 16; r += 2) { const f32x2 dA = (f32x2){stA[r], stA[r + 1]} - mu2A, dB = (f32x2){stB[r], stB[r + 1]} - mu2B;
            const f32x2 pA = (f32x2){__builtin_amdgcn_exp2f(dA.x), __builtin_amdgcn_exp2f(dA.y)}, pB = (f32x2){__builtin_amdgcn_exp2f(dB.x), __builtin_amdgcn_exp2f(dB.y)};
            stA[r] = pA.x; stA[r + 1] = pA.y; stB[r] = pB.x; stB[r + 1] = pB.y; ps2A += pA; ps2B += pB; }
        lA += ps2A.x + ps2A.y; lB += ps2B.x + ps2B.y;
        bf16x8 paA[2], paB[2];
#pragma unroll
        for (int s_ = 0; s_ < 2; ++s_) {
            u32x4 w; w.x = cvt_pk_bf16(stA[8 * s_ + 0], stA[8 * s_ + 1]); w.y = cvt_pk_bf16(stA[8 * s_ + 2], stA[8 * s_ + 3]); w.z = cvt_pk_bf16(stA[8 * s_ + 4], stA[8 * s_ + 5]); w.w = cvt_pk_bf16(stA[8 * s_ + 6], stA[8 * s_ + 7]);
            paA[s_] = __builtin_bit_cast(bf16x8, w);
            w.x = cvt_pk_bf16(stB[8 * s_ + 0], stB[8 * s_ + 1]); w.y = cvt_pk_bf16(stB[8 * s_ + 2], stB[8 * s_ + 3]); w.z = cvt_pk_bf16(stB[8 * s_ + 4], stB[8 * s_ + 5]); w.w = cvt_pk_bf16(stB[8 * s_ + 6], stB[8 * s_ + 7]);
            paB[s_] = __builtin_bit_cast(bf16x8, w); }
#pragma unroll
        for (int s_ = 0; s_ < 2; ++s_) {
            { const int q = s_; const bf16x8 vf = (bf16x8){tlA[q][0], tlA[q][1], tlA[q][2], tlA[q][3], thA[q][0], thA[q][1], thA[q][2], thA[q][3]}; oA0 = __builtin_amdgcn_mfma_f32_32x32x16_bf16(vf, paA[s_], oA0, 0, 0, 0); }
            { const int q = 2 + s_; const bf16x8 vf = (bf16x8){tlA[q][0], tlA[q][1], tlA[q][2], tlA[q][3], thA[q][0], thA[q][1], thA[q][2], thA[q][3]}; oA1 = __builtin_amdgcn_mfma_f32_32x32x16_bf16(vf, paA[s_], oA1, 0, 0, 0); }
        }
        AT_CB();
        s16x4 tlB[4], thB[4];
#pragma unroll
        for (int q = 0; q < 4; ++q) { tlB[q] = __builtin_bit_cast(s16x4, __builtin_amdgcn_ds_read_tr16_b64_v4i16((LAS s16x4*)(vst + vb + (q >> 1) * 2048 + (q & 1) * 1024)));
                                      thB[q] = __builtin_bit_cast(s16x4, __builtin_amdgcn_ds_read_tr16_b64_v4i16((LAS s16x4*)(vst + vb + (q >> 1) * 2048 + (q & 1) * 1024 + 512))); }
        AT_CB();
#pragma unroll
        for (int s_ = 0; s_ < 2; ++s_) {
            { const int q = s_; const bf16x8 vf = (bf16x8){tlB[q][0], tlB[q][1], tlB[q][2], tlB[q][3], thB[q][0], thB[q][1], thB[q][2], thB[q][3]}; oB0 = __builtin_amdgcn_mfma_f32_32x32x16_bf16(vf, paB[s_], oB0, 0, 0, 0); }
            { const int q = 2 + s_; const bf16x8 vf = (bf16x8){tlB[q][0], tlB[q][1], tlB[q][2], tlB[q][3], thB[q][0], thB[q][1], thB[q][2], thB[q][3]}; oB1 = __builtin_amdgcn_mfma_f32_32x32x16_bf16(vf, paB[s_], oB1, 0, 0, 0); }
        }
        AT_CB();
    }
    { auto ra = __builtin_amdgcn_permlane32_swap(__float_as_uint(lA), __float_as_uint(lA), false, false); lA = __uint_as_float(ra[0]) + __uint_as_float(ra[1]);
      auto rb = __builtin_amdgcn_permlane32_swap(__float_as_uint(lB), __float_as_uint(lB), false, false); lB = __uint_as_float(rb[0]) + __uint_as_float(rb[1]); }
    RA.o0 = oA0; RA.o1 = oA1; RA.m = mA; RA.l = lA; RB.o0 = oB0; RB.o1 = oB1; RB.m = mB; RB.l = lB;
}
#undef AT_KLOAD
#undef AT_CB
struct AttnRes3 { f32x4 o[4]; float m, l; };
#define AT3_KLOAD(X, kk_, vv_) _Pragma("unroll") for (int j = 0; j < 4; ++j) { const int kv_ = (lane >> 3) + 8 * j; const int sv_ = kb + kv_ < 0 ? 0 : kb + kv_; \
        const unsigned ro_ = (unsigned)((cls##X + 16 * sv_) * D + (lane & 7) * 8) * 2u; kk_[j] = *(const u32x4*)((const char*)Kh + ro_); vv_[j] = *(const u32x4*)((const char*)Vh + ro_); }
#define AT3_CB() asm volatile("" ::: "memory")
__device__ __forceinline__ void attn_task3(const bf16_t* Qh, const bf16_t* Kh, const bf16_t* Vh, float slope2, int clsA, int clsB, int s0,
                                           LAS unsigned char* lds, int wave, int lane, AttnRes3& RA, AttnRes3& RB) {
    asm volatile("" : "+v"(lane));
    const int q = lane & 15, g = lane >> 4;
    const bf16_t* qpA = Qh + (size_t)(clsA + 16 * (s0 + q)) * D + 8 * g; const bf16_t* qpB = Qh + (size_t)(clsB + 16 * (s0 + q)) * D + 8 * g;
    bf16x8 qrA[2], qrB[2];
#pragma unroll
    for (int dh = 0; dh < 2; ++dh) { qrA[dh] = *(const bf16x8*)(qpA + 32 * dh); qrB[dh] = *(const bf16x8*)(qpB + 32 * dh); }
    float mA = -INFINITY, lA = 0.f, mB = -INFINITY, lB = 0.f;
    f32x4 oA[4], oB[4];
#pragma unroll
    for (int db = 0; db < 4; ++db) { oA[db] = (f32x4){0.f, 0.f, 0.f, 0.f}; oB[db] = oA[db]; }
    LAS unsigned char* kst = lds + AT_STG + wave * AT_WSTG; LAS unsigned char* vst = kst + 32 * AT_KSTR;
    const float sd = slope2 * 16.0f;
    const float lbase = (float)(4 * g - q - 128);
    const int imin = s0 < 128 ? (128 - s0) >> 5 : 0;
    const int woff = (lane >> 3) * AT_KSTR + (lane & 7) * 16;
    const int kfoff = q * AT_KSTR + g * 16;
    const int troff = (4 * g + (q >> 2)) * AT_KSTR + (lane & 3) * 8;
#pragma clang loop unroll(disable)
    for (int i = 4; i >= imin; --i) {
        const int kb = s0 - 128 + 32 * i;
        u32x4 kkA[4], vvA[4], kkB[4], vvB[4];
        AT3_KLOAD(A, kkA, vvA)
        AT3_KLOAD(B, kkB, vvB)
        bf16x8 kfA[2][2], kfB[2][2]; s16x4 tA[4][2], tB[4][2];
#pragma unroll
        for (int j = 0; j < 4; ++j) *(LAS u32x4*)(kst + woff + 8 * j * AT_KSTR) = kkA[j];
        AT3_CB();
#pragma unroll
        for (int h = 0; h < 2; ++h)
#pragma unroll
            for (int dh = 0; dh < 2; ++dh) kfA[h][dh] = *(const LAS bf16x8*)(kst + kfoff + h * 16 * AT_KSTR + dh * 64);
        AT3_CB();
#pragma unroll
        for (int j = 0; j < 4; ++j) *(LAS u32x4*)(kst + woff + 8 * j * AT_KSTR) = kkB[j];
        AT3_CB();
#pragma unroll
        for (int h = 0; h < 2; ++h)
#pragma unroll
            for (int dh = 0; dh < 2; ++dh) kfB[h][dh] = *(const LAS bf16x8*)(kst + kfoff + h * 16 * AT_KSTR + dh * 64);
        AT3_CB();
#pragma unroll
        for (int j = 0; j < 4; ++j) { *(LAS u32x4*)(kst + woff + 8 * j * AT_KSTR) = vvA[j]; *(LAS u32x4*)(vst + woff + 8 * j * AT_KSTR) = vvB[j]; }
        AT3_CB();
#pragma unroll
        for (int db = 0; db < 4; ++db)
#pragma unroll
            for (int hh = 0; hh < 2; ++hh) tA[db][hh] = __builtin_bit_cast(s16x4, __builtin_amdgcn_ds_read_tr16_b64_v4i16((LAS s16x4*)(kst + troff + hh * 16 * AT_KSTR + db * 32)));
        AT3_CB();
        f32x4 sA[2], sB[2];
        { const float t = sd * ((float)(32 * i) + lbase);
          if (i == 0 || i == 4 || kb < 0) {
            int lo = (i == 0) ? q : 0; lo = lo > -kb ? lo : -kb; const int hi_ = (i == 4) ? q : 31;
            const int lo_l = lo - 4 * g, hi_l = hi_ - 4 * g;
#pragma unroll
            for (int h = 0; h < 2; ++h)
#pragma unroll
                for (int e = 0; e < 4; ++e) { const int c = 16 * h + e; const float v = (c >= lo_l && c <= hi_l) ? t + sd * (float)c : -INFINITY; sA[h][e] = v; sB[h][e] = v; }
          } else {
#pragma unroll
            for (int h = 0; h < 2; ++h)
#pragma unroll
                for (int e = 0; e < 4; ++e) { const float v = t + sd * (float)(16 * h + e); sA[h][e] = v; sB[h][e] = v; }
          } }
#pragma unroll
        for (int h = 0; h < 2; ++h)
#pragma unroll
            for (int dh = 0; dh < 2; ++dh) { sA[h] = __builtin_amdgcn_mfma_f32_16x16x32_bf16(kfA[h][dh], qrA[dh], sA[h], 0, 0, 0); sB[h] = __builtin_amdgcn_mfma_f32_16x16x32_bf16(kfB[h][dh], qrB[dh], sB[h], 0, 0, 0); }
        float mxA = fmaxf(fmaxf(fmaxf(sA[0][0], sA[0][1]), fmaxf(sA[0][2], sA[0][3])), fmaxf(fmaxf(sA[1][0], sA[1][1]), fmaxf(sA[1][2], sA[1][3])));
        float mxB = fmaxf(fmaxf(fmaxf(sB[0][0], sB[0][1]), fmaxf(sB[0][2], sB[0][3])), fmaxf(fmaxf(sB[1][0], sB[1][1]), fmaxf(sB[1][2], sB[1][3])));
        { auto a1 = __builtin_amdgcn_permlane16_swap(__float_as_uint(mxA), __float_as_uint(mxA), false, false); mxA = fmaxf(__uint_as_float(a1[0]), __uint_as_float(a1[1]));
          auto a2 = __builtin_amdgcn_permlane32_swap(__float_as_uint(mxA), __float_as_uint(mxA), false, false); mxA = fmaxf(__uint_as_float(a2[0]), __uint_as_float(a2[1]));
          auto b1 = __builtin_amdgcn_permlane16_swap(__float_as_uint(mxB), __float_as_uint(mxB), false, false); mxB = fmaxf(__uint_as_float(b1[0]), __uint_as_float(b1[1]));
          auto b2 = __builtin_amdgcn_permlane32_swap(__float_as_uint(mxB), __float_as_uint(mxB), false, false); mxB = fmaxf(__uint_as_float(b2[0]), __uint_as_float(b2[1])); }
        if (__any((mxA > mA) || (mxB > mB))) {
            const float nA = fmaxf(mA, mxA), nB = fmaxf(mB, mxB);
            const float alA = __builtin_amdgcn_exp2f(mA - ((nA == -INFINITY) ? 0.f : nA)), alB = __builtin_amdgcn_exp2f(mB - ((nB == -INFINITY) ? 0.f : nB));
            const float fA = (nA == mA) ? 1.0f : alA, fB = (nB == mB) ? 1.0f : alB;
            lA *= fA; lB *= fB; mA = nA; mB = nB;
#pragma unroll
            for (int db = 0; db < 4; ++db) { oA[db] *= fA; oB[db] *= fB; }
        }
        const float muA = (mA == -INFINITY) ? 0.f : mA, muB = (mB == -INFINITY) ? 0.f : mB;
        float psA = 0.f, psB = 0.f;
#pragma unroll
        for (int h = 0; h < 2; ++h)
#pragma unroll
            for (int e = 0; e < 4; ++e) { const float pA = __builtin_amdgcn_exp2f(sA[h][e] - muA), pB = __builtin_amdgcn_exp2f(sB[h][e] - muB); sA[h][e] = pA; sB[h][e] = pB; psA += pA; psB += pB; }
        lA += psA; lB += psB;
        bf16x8 paA, paB;
        { u32x4 w; w.x = cvt_pk_bf16(sA[0][0], sA[0][1]); w.y = cvt_pk_bf16(sA[0][2], sA[0][3]); w.z = cvt_pk_bf16(sA[1][0], sA[1][1]); w.w = cvt_pk_bf16(sA[1][2], sA[1][3]); paA = __builtin_bit_cast(bf16x8, w);
          w.x = cvt_pk_bf16(sB[0][0], sB[0][1]); w.y = cvt_pk_bf16(sB[0][2], sB[0][3]); w.z = cvt_pk_bf16(sB[1][0], sB[1][1]); w.w = cvt_pk_bf16(sB[1][2], sB[1][3]); paB = __builtin_bit_cast(bf16x8, w); }
#pragma unroll
        for (int db = 0; db < 4; ++db) { const bf16x8 vf = (bf16x8){tA[db][0][0], tA[db][0][1], tA[db][0][2], tA[db][0][3], tA[db][1][0], tA[db][1][1], tA[db][1][2], tA[db][1][3]};
            oA[db] = __builtin_amdgcn_mfma_f32_16x16x32_bf16(vf, paA, oA[db], 0, 0, 0); }
        AT3_CB();
#pragma unroll
        for (int db = 0; db < 4; ++db)
#pragma unroll
            for (int hh = 0; hh < 2; ++hh) tB[db][hh] = __builtin_bit_cast(s16x4, __builtin_amdgcn_ds_read_tr16_b64_v4i16((LAS s16x4*)(vst + troff + hh * 16 * AT_KSTR + db * 32)));
        AT3_CB();
#pragma unroll
        for (int db = 0; db < 4; ++db) { const bf16x8 vf = (bf16x8){tB[db][0][0], tB[db][0][1], tB[db][0][2], tB[db][0][3], tB[db][1][0], tB[db][1][1], tB[db][1][2], tB[db][1][3]};
            oB[db] = __builtin_amdgcn_mfma_f32_16x16x32_bf16(vf, paB, oB[db], 0, 0, 0); }
        AT3_CB();
    }
    lA = pg8::fq_sum(lA); lB = pg8::fq_sum(lB);
#pragma unroll
    for (int db = 0; db < 4; ++db) { RA.o[db] = oA[db]; RB.o[db] = oB[db]; }
    RA.m = mA; RA.l = lA; RB.m = mB; RB.l = lB;
}
#undef AT3_KLOAD
#undef AT3_CB
__device__ __forceinline__ void attn_merge3(const AttnRes3& R, int cls, LAS unsigned char* lds, int lane) {
    asm volatile("" : "+v"(lane));
    const int q = lane & 15, g = lane >> 4;
    const int ql = cls + 16 * q, g4 = at_swz(ql);
    LAS f32x4* oa = (LAS f32x4*)(lds + AT_OACC) + ql * 16;
    LAS float* ml = (LAS float*)(lds + AT_ML) + ql * 2;
    const float m_old = ml[0], l_old = ml[1]; const float m_new = fmaxf(m_old, R.m); const float mu = (m_new == -INFINITY) ? 0.f : m_new;
    const float a_old = __builtin_amdgcn_exp2f(m_old - mu), a_new = __builtin_amdgcn_exp2f(R.m - mu), l_new = l_old * a_old + R.l * a_new;
    f32x4 pv[4];
#pragma unroll
    for (int db = 0; db < 4; ++db) pv[db] = oa[(4 * db + g) ^ g4];
#pragma unroll
    for (int db = 0; db < 4; ++db) oa[(4 * db + g) ^ g4] = R.o[db] * a_new + pv[db] * a_old;
    asm volatile("s_waitcnt lgkmcnt(0)" ::: "memory");
    if (g == 0) { ml[0] = m_new; ml[1] = l_new; }
}
__device__ __forceinline__ void attn_merge(const AttnRes& R, int nq, int qlbase, int qlstep, bool first, LAS unsigned char* lds, int lane) {
    asm volatile("" : "+v"(lane));
    const int r32 = lane & 31, hi = lane >> 5;
    if (r32 < nq) {
        const int ql = qlbase + qlstep * r32, g4 = at_swz(ql);
        LAS f32x4* oa = (LAS f32x4*)(lds + AT_OACC) + ql * 16;
        LAS float* ml = (LAS float*)(lds + AT_ML) + ql * 2;
        float a_old = 0.f, a_new = 1.f, m_new = R.m, l_new = R.l;
        if (!first) { const float m_old = ml[0], l_old = ml[1]; m_new = fmaxf(m_old, R.m); const float mu = (m_new == -INFINITY) ? 0.f : m_new;
            a_old = __builtin_amdgcn_exp2f(m_old - mu); a_new = __builtin_amdgcn_exp2f(R.m - mu); l_new = l_old * a_old + R.l * a_new; }
        f32x4 p0[4], p1[4];
        if (!first) {
#pragma unroll
            for (int g = 0; g < 4; ++g) { const int c0 = (2 * g + hi) ^ g4; p0[g] = oa[c0]; p1[g] = oa[c0 ^ 8]; } }
#pragma unroll
        for (int g = 0; g < 4; ++g) { const int c0 = (2 * g + hi) ^ g4;
            f32x4 n0 = (f32x4){R.o0[4 * g], R.o0[4 * g + 1], R.o0[4 * g + 2], R.o0[4 * g + 3]} * a_new, n1 = (f32x4){R.o1[4 * g], R.o1[4 * g + 1], R.o1[4 * g + 2], R.o1[4 * g + 3]} * a_new;
            if (!first) { n0 += p0[g] * a_old; n1 += p1[g] * a_old; }
            oa[c0] = n0; oa[c0 ^ 8] = n1; }
        asm volatile("s_waitcnt lgkmcnt(0)" ::: "memory");
        if (hi == 0) { ml[0] = m_new; ml[1] = l_new; }
    }
}

__device__ __forceinline__ void p8_attention(const Args& a, LAS unsigned char* lds, int tid, int lane, int wave, int mode) {
    unsigned char* ws = a.ws;
    const bf16_t* Q = (const bf16_t*)(ws + WS_Q); const bf16_t* K = (const bf16_t*)(ws + WS_K); const bf16_t* V = (const bf16_t*)(ws + WS_V); bf16_t* O = (bf16_t*)(ws + WS_AB);
    if (mode & 1) {
        const float* QS = (const float*)(ws + WS_QS);
        LAS float* psc = (LAS float*)(lds + AT_PSC + wave * 2048);
        for (int task = blockIdx.x * NWAVES + wave; task < NSB * NH * NST; task += gridDim.x * NWAVES) {
            const int sb = task / (NH * NST), h = (task / NST) % NH, j = task % NST;
            const float slope2 = exp2f(-0.5f * (float)(h + 1)) * LOG2E;
            const float* kc = a.in[4] + (size_t)sb * LBUF * D + h * HD; const float* vc = a.in[5] + (size_t)sb * LBUF * D + h * HD;
            const float* kn = a.out + O_SK + ((size_t)sb * LBUF + (LBUF - NST)) * D + h * HD; const float* vn = a.out + O_SV + ((size_t)sb * LBUF + (LBUF - NST)) * D + h * HD;
            const float* qrow = QS + (size_t)(sb * NST + j) * D + h * HD;
            const int kg = lane >> 4, dc = lane & 15;
            const f32x4 q4 = *(const f32x4*)(qrow + 4 * dc);
            float mx = -INFINITY;
#pragma clang loop unroll(disable)
            for (int k0 = 0; k0 < 387; k0 += 64) {
                f32x4 kr4[16];
#pragma unroll
                for (int u = 0; u < 16; ++u) { const int kk = k0 + 4 * u + kg; const int kc_ = kk < 387 ? kk : 386;
                    const int g = kc_ / 129, mm = kc_ % 129, dil = (g == 0) ? 1 : (g == 1 ? 4 : 16); const int idx = LBUF + j - mm * dil;
                    const float* kr = (idx >= LBUF) ? kn + (size_t)(idx - LBUF) * D : kc + (size_t)idx * D;
                    kr4[u] = __builtin_nontemporal_load((const f32x4*)(kr + 4 * dc)); }
#pragma unroll
                for (int u = 0; u < 16; ++u) { const int kk = k0 + 4 * u + kg; const int kc_ = kk < 387 ? kk : 386;
                    const int g = kc_ / 129, mm = kc_ % 129, dil = (g == 0) ? 1 : (g == 1 ? 4 : 16);
                    float t = (q4.x * kr4[u].x + q4.y * kr4[u].y) + (q4.z * kr4[u].z + q4.w * kr4[u].w);
                    t += dppmov<0xB1>(t); t += dppmov<0x4E>(t); t += dppmov<0x141>(t); t += dppmov<0x140>(t);
                    const float sc = (kk < 387) ? t - slope2 * (float)(mm * dil) : -INFINITY;
                    if (dc == 0) psc[kk] = sc;
                    mx = fmaxf(mx, sc); }
            }
            mx = wave_max(mx);
            asm volatile("s_waitcnt lgkmcnt(0)" ::: "memory");
            float l = 0.f;
#pragma clang loop unroll(disable)
            for (int rd = 0; rd < 7; ++rd) { const float p = __builtin_amdgcn_exp2f(psc[rd * 64 + lane] - mx); l += p; psc[rd * 64 + lane] = p; }
            l = wave_sum(l);
            asm volatile("s_waitcnt lgkmcnt(0)" ::: "memory");
            f32x4 acc4 = (f32x4){0.f, 0.f, 0.f, 0.f};
#pragma clang loop unroll(disable)
            for (int k0 = 0; k0 < 387; k0 += 64) {
                f32x4 vr4[16]; float pk[16];
#pragma unroll
                for (int u = 0; u < 16; ++u) { const int kk = k0 + 4 * u + kg; const int kc_ = kk < 387 ? kk : 386;
                    const int g = kc_ / 129, mm = kc_ % 129, dil = (g == 0) ? 1 : (g == 1 ? 4 : 16); const int idx = LBUF + j - mm * dil;
                    const float* vr = (idx >= LBUF) ? vn + (size_t)(idx - LBUF) * D : vc + (size_t)idx * D;
                    vr4[u] = __builtin_nontemporal_load((const f32x4*)(vr + 4 * dc)); pk[u] = kk < 387 ? psc[kc_] : 0.f; }
#pragma unroll
                for (int u = 0; u < 16; ++u) acc4 += vr4[u] * pk[u];
            }
#pragma unroll
            for (int e = 0; e < 4; ++e) { acc4[e] += __shfl_xor(acc4[e], 16); acc4[e] += __shfl_xor(acc4[e], 32); }
            const float il = __builtin_amdgcn_rcpf(l);
            if (lane < 16) { u32x2 w; w.x = cvt_pk_bf16(acc4[0] * il, acc4[1] * il); w.y = cvt_pk_bf16(acc4[2] * il, acc4[3] * il);
                *(u32x2*)(O + (size_t)(MPR + sb * NST + j) * D + h * HD + 4 * dc) = w; }
            asm volatile("s_waitcnt lgkmcnt(0)" ::: "memory");
        }
    }
    __syncthreads();
    if (mode & 2) {
    const int nun = NB * NH * 8, per_round = gridDim.x;
    for (int u0 = blockIdx.x; u0 < nun; u0 += per_round) {
        int u = u0;
        if ((gridDim.x & 7) == 0 && nun % (int)gridDim.x == 0) { const int x = blockIdx.x & 7, slot = blockIdx.x >> 3, spx = gridDim.x >> 3, rnd = u0 / per_round, j = rnd * spx + slot; u = x * (nun >> 3) + j;
            const int sq = u & 7, r4 = rnd & 3, qb = (r4 == 0) ? sq : (r4 == 1) ? 7 - sq : (r4 == 2) ? ((sq + 4) & 7) : ((3 - sq) & 7); u = (u & ~7) | qb; }
        const int qblk = u & 7, h = (u >> 3) & 15, b = u >> 7;
        const float slope2 = exp2f(-0.5f * (float)(h + 1)) * LOG2E;
        const bf16_t* Qh = Q + (size_t)b * SEQ * D + h * HD; const bf16_t* Kh = K + (size_t)b * SEQ * D + h * HD; const bf16_t* Vh = V + (size_t)b * SEQ * D + h * HD;
        {
            AttnRes RA, RB;
            attn_task2(Qh, Kh, Vh, slope2, 1, 0, 256 * qblk + 32 * wave, 32, 4, wave & 3, 64 * qblk + 32 * (wave >> 2), 32, lds, wave, lane, RA, RB);
            attn_merge(RA, 32, 32 * wave, 1, true, lds, lane);
            __syncthreads();
            attn_merge(RB, 32, (wave & 3) + 128 * (wave >> 2), 4, false, lds, lane);
            __syncthreads();
            AttnRes3 R3A, R3B;
            attn_task3(Qh, Kh, Vh, slope2, 2 * wave, 2 * wave + 1, 16 * qblk, lds, wave, lane, R3A, R3B);
            attn_merge3(R3A, 2 * wave, lds, lane);
            attn_merge3(R3B, 2 * wave + 1, lds, lane);
            __syncthreads();
        }
        {
            const int ql = tid >> 1, dh = (tid & 1) * 32, hb = (tid & 1) * 8, g4 = at_swz(ql);
            const LAS f32x4* oa = (const LAS f32x4*)(lds + AT_OACC) + ql * 16;
            const float inv = __builtin_amdgcn_rcpf(((const LAS float*)(lds + AT_ML))[ql * 2 + 1]);
            bf16_t* op = O + (size_t)(b * SEQ + 256 * qblk + ql) * D + h * HD + dh;
            f32x4 x[8];
#pragma unroll
            for (int e = 0; e < 8; ++e) x[e] = oa[(hb + e) ^ g4];
#pragma unroll
            for (int e = 0; e < 4; ++e) { const f32x4 x0 = x[2 * e] * inv, x1 = x[2 * e + 1] * inv; u32x4 w; w.x = cvt_pk_bf16(x0[0], x0[1]); w.y = cvt_pk_bf16(x0[2], x0[3]);
                w.z = cvt_pk_bf16(x1[0], x1[1]); w.w = cvt_pk_bf16(x1[2], x1[3]); *(u32x4*)(op + 8 * e) = w; }
        }
        __syncthreads();
    }
    }
}

__device__ __forceinline__ void p13_final(const Args& a, int gw, int NGW, int lane) {
    const bf16_t* HBp = (const bf16_t*)(a.ws + WS_HB); const float* g = a.in[9];
    f32x4 gv[4];
#pragma unroll
    for (int j = 0; j < 4; ++j) gv[j] = ((const f32x4*)g)[64 * j + lane];
    for (int r0 = gw; r0 < MTOT; r0 += 2 * NGW) {
        f32x4 v[2][4];
#pragma unroll
        for (int h = 0; h < 2; ++h) { const int r = r0 + h * NGW; const int rc = r < MTOT ? r : r0; const u32x2* xr = (const u32x2*)(HBp + (size_t)rc * D) + lane;
#pragma unroll
            for (int j = 0; j < 4; ++j) { const u32x2 b = xr[64 * j]; v[h][j] = (f32x4){bflo(b.x), bfhi(b.x), bflo(b.y), bfhi(b.y)}; } }
#pragma unroll
        for (int h = 0; h < 2; ++h) { const int r = r0 + h * NGW; if (r >= MTOT) continue; float s = 0.f;
#pragma unroll
            for (int j = 0; j < 4; ++j) s += (v[h][j].x * v[h][j].x + v[h][j].y * v[h][j].y) + (v[h][j].z * v[h][j].z + v[h][j].w * v[h][j].w);
            const float rstd = rsqrtf(wave_sum(s) * (1.0f / D) + RMS_EPS);
            f32x4* o = (f32x4*)(a.out + (size_t)r * D) + lane;
#pragma unroll
            for (int j = 0; j < 4; ++j) __builtin_nontemporal_store(v[h][j] * rstd * gv[j], o + 64 * j); }
    }
}

__device__ __forceinline__ void sample_gemm_qkv(LAS unsigned char* lds, const bf16_t* A, const bf16_t* Bt, const float* ssq, bf16_t* QKV, float* QS, float* out, int tid, int lane, int wave) {
    constexpr int K = D, KPW = K / 32 / 8, NCB = 3, nitems = (3 * D / 16 / NCB) * 4;
    LAS f32x4* red = (LAS f32x4*)lds;
    for (int it = blockIdx.x; it < nitems; it += gridDim.x) {
        const int cg = it >> 2, rq = it & 3;
        const bf16_t* ap = A + (size_t)(32 * rq + (lane & 15)) * K + wave * KPW * 32 + 8 * (lane >> 4);
        const bf16_t* bp = Bt + (size_t)(16 * NCB * cg + (lane & 15)) * K + wave * KPW * 32 + 8 * (lane >> 4);
        bf16x8 bw[NCB][KPW], a0[KPW], a1[KPW];
#pragma unroll
        for (int ks = 0; ks < KPW; ++ks) { a0[ks] = *(const bf16x8*)(ap + ks * 32); a1[ks] = *(const bf16x8*)(ap + (size_t)16 * K + ks * 32);
#pragma unroll
            for (int cb = 0; cb < NCB; ++cb) bw[cb][ks] = *(const bf16x8*)(bp + (size_t)cb * 16 * K + ks * 32); }
#pragma unroll
        for (int cb = 0; cb < NCB; ++cb) { f32x4 acc0 = (f32x4){0.f, 0.f, 0.f, 0.f}, acc1 = acc0;
#pragma unroll
            for (int ks = 0; ks < KPW; ++ks) { acc0 = __builtin_amdgcn_mfma_f32_16x16x32_bf16(bw[cb][ks], a0[ks], acc0, 0, 0, 0); acc1 = __builtin_amdgcn_mfma_f32_16x16x32_bf16(bw[cb][ks], a1[ks], acc1, 0, 0, 0); }
            red[((cb * 8 + wave) * 2 + 0) * 64 + lane] = acc0; red[((cb * 8 + wave) * 2 + 1) * 64 + lane] = acc1; }
        __syncthreads();
        if (tid < 128 * NCB) {
            const int cb = tid >> 7, rb = (tid >> 6) & 1, ln = tid & 63;
            f32x4 v = red[((cb * 8) * 2 + rb) * 64 + ln];
#pragma unroll
            for (int w = 1; w < 8; ++w) v += red[((cb * 8 + w) * 2 + rb) * 64 + ln];
            const int rs = 32 * rq + 16 * rb + (ln & 15), fq = ln >> 4;
            const int cbk = NCB * cg + cb, c = 16 * cbk + 4 * fq;
            const int which = cbk >> 6, c1 = c - which * D;
            const float rstd = pg8::row_rstd(ssq, MPR + rs, fq) * (which == 0 ? QSCALE : 1.0f);
            const f32x4 o = v * rstd;
            u32x2 w2; w2.x = cvt_pk_bf16(o[0], o[1]); w2.y = cvt_pk_bf16(o[2], o[3]);
            *(u32x2*)(QKV + (size_t)which * ((WS_K - WS_Q) / 2) + (size_t)(MPR + rs) * D + c1) = w2;
            float* fp = (which == 0) ? QS + (size_t)rs * D + c1 : out + (which == 1 ? O_SK : O_SV) + ((size_t)(rs >> 2) * LBUF + (LBUF - NST) + (rs & 3)) * D + c1;
            *(f32x4*)fp = o;
        }
        __syncthreads();
    }
}
template <int MODE, int K>
__device__ __forceinline__ void sample_gemm(LAS unsigned char* lds, const bf16_t* A, const bf16_t* Bt, int N, const float* base, float* Hs, bf16_t* HBs, float* ssq,
                                            bf16_t* QKV, float* QS, float* out, int tid, int lane, int wave) {
    constexpr int KPW = K / 32 / 8;
    const int nitems = (N / 16) * 4;
    LAS f32x4* red = (LAS f32x4*)lds;
    for (int it = blockIdx.x; it < nitems; it += gridDim.x) {
        const int cbk = it >> 2, rq = it & 3;
        const bf16_t* bp = Bt + (size_t)(16 * cbk + (lane & 15)) * K + wave * KPW * 32 + 8 * (lane >> 4);
        const bf16_t* ap = A + (size_t)(32 * rq + (lane & 15)) * K + wave * KPW * 32 + 8 * (lane >> 4);
        bf16x8 bw[KPW], a0[KPW], a1[KPW];
#pragma unroll
        for (int ks = 0; ks < KPW; ++ks) { bw[ks] = *(const bf16x8*)(bp + ks * 32); a0[ks] = *(const bf16x8*)(ap + ks * 32); a1[ks] = *(const bf16x8*)(ap + (size_t)16 * K + ks * 32); }
        f32x4 acc0 = (f32x4){0.f, 0.f, 0.f, 0.f}, acc1 = acc0;
#pragma unroll
        for (int ks = 0; ks < KPW; ++ks) { acc0 = __builtin_amdgcn_mfma_f32_16x16x32_bf16(bw[ks], a0[ks], acc0, 0, 0, 0); acc1 = __builtin_amdgcn_mfma_f32_16x16x32_bf16(bw[ks], a1[ks], acc1, 0, 0, 0); }
        red[(wave * 2 + 0) * 64 + lane] = acc0; red[(wave * 2 + 1) * 64 + lane] = acc1;
        __syncthreads();
        if (tid < 128) {
            const int rb = tid >> 6, ln = tid & 63;
            f32x4 v = red[rb * 64 + ln];
#pragma unroll
            for (int w = 1; w < 8; ++w) v += red[(w * 2 + rb) * 64 + ln];
            const int rs = 32 * rq + 16 * rb + (ln & 15), fq = ln >> 4;
            const int c = 16 * cbk + 4 * fq;
            if (MODE == 0) {
                const u32x2 b2 = *(const u32x2*)(HBs + (size_t)rs * D + c);
                const f32x4 h = (f32x4){bflo(b2.x), bfhi(b2.x), bflo(b2.y), bfhi(b2.y)} + v;
                u32x2 w2; w2.x = cvt_pk_bf16(h[0], h[1]); w2.y = cvt_pk_bf16(h[2], h[3]); *(u32x2*)(HBs + (size_t)rs * D + c) = w2;
                float q = (h[0] * h[0] + h[1] * h[1]) + (h[2] * h[2] + h[3] * h[3]);
                q += __shfl_xor(q, 16); q += __shfl_xor(q, 32);
                if (fq == 0) ssq[(size_t)(MPR + rs) * 64 + cbk] = q;
            } else {
                const int which = cbk >> 6, c1 = c - which * D;
                const float rstd = pg8::row_rstd(ssq, MPR + rs, fq) * (which == 0 ? QSCALE : 1.0f);
                const f32x4 o = v * rstd;
                u32x2 w2; w2.x = cvt_pk_bf16(o[0], o[1]); w2.y = cvt_pk_bf16(o[2], o[3]);
                *(u32x2*)(QKV + (size_t)which * ((WS_K - WS_Q) / 2) + (size_t)(MPR + rs) * D + c1) = w2;
                float* fp = (which == 0) ? QS + (size_t)rs * D + c1 : out + (which == 1 ? O_SK : O_SV) + ((size_t)(rs >> 2) * LBUF + (LBUF - NST) + (rs & 3)) * D + c1;
                *(f32x4*)fp = o;
            }
        }
        __syncthreads();
    }
}

#define XB_TMO      128
#define XB_XCNT(j)  (256  + 64 * (j))
#define XB_XSUB(j)  (1280 + 64 * (j))
#define XB_XGEN(j)  (2304 + 64 * (j))
#define XB_TOP      3328
#define XB_TOPGEN   3392
#define XCD_BAR_WORDS 3456
#define XB_SPIN_CAP (1u << 18)
__device__ __forceinline__ unsigned xb_ld(unsigned* p)              { return __hip_atomic_load(p, __ATOMIC_RELAXED, __HIP_MEMORY_SCOPE_AGENT); }
__device__ __forceinline__ unsigned xb_add(unsigned* p, unsigned v) { return __hip_atomic_fetch_add(p, v, __ATOMIC_RELAXED, __HIP_MEMORY_SCOPE_AGENT); }
__device__ __forceinline__ unsigned xb_xcc_id() { return (unsigned)__builtin_amdgcn_s_getreg((3 << 11) | 20) & 0xFu; }
#define XB_SPIN(cond, bar) do { unsigned _sp = 0; while (cond) { __builtin_amdgcn_s_sleep(1); \
    if ((++_sp & 255u) == 0u) { if (xb_ld(&(bar)[XB_TMO])) break; if (_sp > XB_SPIN_CAP) { atomicAdd(&(bar)[XB_TMO], 1u); break; } } } } while (0)
__device__ __forceinline__ void xcd_barrier_complete(unsigned* bar, unsigned x, unsigned& nloc, unsigned& nx) {
    const unsigned G = gridDim.x * gridDim.y * gridDim.z;
    unsigned sum, cnt, mine, sp = 0u;
    for (;;) {
        sum = 0u; cnt = 0u; mine = 0u;
#pragma unroll
        for (unsigned j = 0; j < 16; ++j) { const unsigned c = xb_ld(&bar[XB_XCNT(j)]); sum += c; cnt += (c > 0u) ? 1u : 0u; mine = (j == x) ? c : mine; }
        if (sum == G) break;
        __builtin_amdgcn_s_sleep(1);
        if ((++sp & 255u) == 0u) { if (xb_ld(&bar[XB_TMO])) break; if (sp > XB_SPIN_CAP) { atomicAdd(&bar[XB_TMO], 1u); break; } }
    }
    nloc = mine > 0u ? mine : 1u; nx = cnt > 0u ? cnt : 1u;
}
__device__ __forceinline__ void xcd_barrier(unsigned* bar, volatile LAS unsigned* st, int wave0) {
    asm volatile("s_waitcnt vmcnt(0)" ::: "memory");
    __syncthreads();
    if (wave0 == 0 && lane_id() == 0) {
        const unsigned x = xb_xcc_id();
        __builtin_amdgcn_s_waitcnt(0);
        unsigned nloc = st[0], nx = st[1];
        if (nloc == 0u) { xcd_barrier_complete(bar, x, nloc, nx); st[0] = nloc; st[1] = nx; }
        const unsigned old = xb_add(&bar[XB_XSUB(x)], 1u);
        const unsigned gen = old / nloc;
        if (old + 1u == (gen + 1u) * nloc) {
            __builtin_amdgcn_fence(__ATOMIC_RELEASE, "agent");
            asm volatile("s_waitcnt vmcnt(0)" ::: "memory");
            const unsigned og = xb_add(&bar[XB_TOP], 1u);
            const unsigned tg = og / nx;
            if (og + 1u == (tg + 1u) * nx) xb_add(&bar[XB_TOPGEN], 1u);
            else XB_SPIN(xb_ld(&bar[XB_TOPGEN]) == tg, bar);
            __builtin_amdgcn_fence(__ATOMIC_ACQUIRE, "agent");
            xb_add(&bar[XB_XGEN(x)], 1u);
            asm volatile("s_waitcnt vmcnt(0)" ::: "memory");
        } else {
            XB_SPIN(xb_ld(&bar[XB_XGEN(x)]) == gen, bar);
            __builtin_amdgcn_fence(__ATOMIC_ACQUIRE, "agent");
            asm volatile("s_waitcnt vmcnt(0)" ::: "memory");
        }
    }
    __syncthreads();
}

typedef const __attribute__((address_space(4))) Args* kargp_t;
__device__ __forceinline__ Args kargs() {
    Args a;
#if defined(__HIP_DEVICE_COMPILE__)
    kargp_t p = (kargp_t)__builtin_amdgcn_kernarg_segment_ptr(); asm volatile("" : "+s"(p));
#pragma unroll
    for (int i = 0; i < 22; ++i) a.in[i] = p->in[i];
    a.out = p->out; a.ws = p->ws;
#else
    for (int i = 0; i < 22; ++i) a.in[i] = nullptr;
    a.out = nullptr; a.ws = nullptr;
#endif
    return a;
}
#define PHASE_BEGIN const Args a = kargs(); unsigned char* ws = a.ws; const int wave = wave0, lane = lane_id(), tid = wave * 64 + lane; \
    const int G = gridDim.x, gw = blockIdx.x * NWAVES + wave, NGW = G * NWAVES; (void)ws; (void)lane; (void)gw; (void)NGW; (void)G;
__global__ void __launch_bounds__(NTHREADS, 2) mega_fwd(Args a_unused) {
    extern __shared__ __attribute__((aligned(16))) unsigned char lds_raw[];
    LAS unsigned char* lds = (LAS unsigned char*)lds_raw;
    cg::grid_group grid = cg::this_grid();
    volatile LAS unsigned* bst = (volatile LAS unsigned*)(lds + MISC_OFF + 64);
    const int wave0 = __builtin_amdgcn_readfirstlane((int)threadIdx.x >> 6);
    { unsigned* ctl0 = (unsigned*)kargs().ws; if (threadIdx.x == 0) { bst[0] = 0u; bst[1] = 0u; (void)xb_add(&ctl0[XB_XCNT(xb_xcc_id())], 1u); } }
    __syncthreads();
    grid.sync();
#define GRID_BAR() do { unsigned* ctl_ = (unsigned*)kargs().ws; xcd_barrier(ctl_, bst, wave0); } while (0)
#ifndef PHASES
#define PHASES 0xFFFF
#endif
#define PH(k) if constexpr (((PHASES) >> (k)) & 1)
#define REP_ALL 1
#define REP_P0 1
#define REP_P1 1
#define REP_P2 1
#define REP_P3 1
#define REP_P4 1
#define REP_P6 1
#define PROBE_SKIP_EPI 0
#define REP_P7 1
#define REP_P8 1
#define REP_P8S 1
#define REP_P13 1
#define REPEAT(n) for (int rep_ = 0; rep_ < (n); ++rep_)

    for (int rep_all = 0; rep_all < REP_ALL; ++rep_all) {
    if (rep_all) { GRID_BAR(); }
    REPEAT(REP_P0) { PH(0) { PHASE_BEGIN p0_prologue(a, lds, gw, NGW, lane, wave); } if (rep_ + 1 < REP_P0) { GRID_BAR(); } }
    GRID_BAR();
    REPEAT(REP_P1) { if (rep_) { GRID_BAR(); } PH(1) {
        PHASE_BEGIN
        const int ge = (G == 256) ? GE_P1 : G;
        if ((int)blockIdx.x < ge) {
        pg8::Gemm g{(const bf16_t*)(ws + WS_HB), (const bf16_t*)(ws + WS_WIN), MPAD, NIN, D, wave}; pg8::StaticOrder S; S.init(MPAD, NIN, ge, (int)blockIdx.x);
        pg8::EpiInAB E{(bf16_t*)(ws + WS_GA), (const float*)(ws + WS_SSQ), a.out};
        pg8::gemm_phase<pg8::EpiInAB, pg8::StaticOrder, true, true>(lds, g, S, E);
        } else { p0_weights(a, lds, WI_IN, WI_TOT, ((int)blockIdx.x - ge) * NWAVES + wave, (G - ge) * NWAVES, lane_id(), wave); copy_range<256 - GE_P1>(a, CP_C0, CP_C1, (int)blockIdx.x - ge, wave); }
        if (ge == G && rep_ == 0) copy_range_simple(a, CP_C0, CP_C1, blockIdx.x, G, wave * 64 + lane_id());
    } }
    GRID_BAR();
    REPEAT(REP_P2) { if (rep_) { GRID_BAR(); } PH(2) { PHASE_BEGIN p2_conv(a, lds, tid, lane, wave);
        if (G == 256 && (int)blockIdx.x >= 32 && rep_ == 0) copy_range<224>(a, CP_P2, CP_C0, (int)blockIdx.x - 32, wave);
    } }
    GRID_BAR();
    REPEAT(REP_P3) { if (rep_) { GRID_BAR(); } PH(3) {
        PHASE_BEGIN
        pg8::Gemm g{(const bf16_t*)(ws + WS_AB), (const bf16_t*)(ws + WS_WOUT), MPR, D, D, wave}; pg8::StaticOrder S; S.init(MPR, D, G, (int)blockIdx.x);
        pg8::EpiResid E{(bf16_t*)(ws + WS_HB), (float*)(ws + WS_SSQ), 0};
        pg8::gemm_phase<pg8::EpiResid, pg8::StaticOrder, true, true>(lds, g, S, E);
        sample_gemm<0, D>(lds, (const bf16_t*)(ws + WS_AB) + (size_t)MPR * D, (const bf16_t*)(ws + WS_WOUT), D, nullptr, nullptr, (bf16_t*)(ws + WS_HB) + (size_t)MPR * D,
                          (float*)(ws + WS_SSQ), nullptr, nullptr, nullptr, tid, lane, wave);
    } }
    GRID_BAR();
#pragma clang loop unroll(disable)
    for (int layer = 0; layer < 2; ++layer) {
        if (layer == 1) {
            REPEAT(REP_P7) { if (rep_) { GRID_BAR(); } PH(7) {
                PHASE_BEGIN
                pg8::Gemm g{(const bf16_t*)(ws + WS_HB), (const bf16_t*)(ws + WS_WQKV), MPR, 3 * D, D, wave}; pg8::StaticOrder S; S.init(MPR, 3 * D, G, (int)blockIdx.x);
                pg8::EpiQkv E{(bf16_t*)(ws + WS_Q), (float*)(ws + WS_QS), (const float*)(ws + WS_SSQ), a.out};
                pg8::gemm_phase<pg8::EpiQkv, pg8::StaticOrder, true, true>(lds, g, S, E);
                sample_gemm_qkv(lds, (const bf16_t*)(ws + WS_HB) + (size_t)MPR * D, (const bf16_t*)(ws + WS_WQKV), (const float*)(ws + WS_SSQ), (bf16_t*)(ws + WS_Q), (float*)(ws + WS_QS), a.out,
                                wave * 64 + lane_id(), lane_id(), wave);
            } }
            GRID_BAR();
            REPEAT(REP_P8) { if (rep_) { GRID_BAR(); } PH(8) { PHASE_BEGIN p8_attention(a, lds, tid, lane, wave, 2); } }
            REPEAT(REP_P8S) { PH(8) { PHASE_BEGIN p8_attention(a, lds, tid, lane, wave, 1); } }
            GRID_BAR();
            PH(9) {
                PHASE_BEGIN
                pg8::Gemm g{(const bf16_t*)(ws + WS_AB), (const bf16_t*)(ws + WS_WO), MPR, D, D, wave}; pg8::StaticOrder S; S.init(MPR, D, G, (int)blockIdx.x);
                pg8::EpiResid E{(bf16_t*)(ws + WS_HB), (float*)(ws + WS_SSQ), 0};
                pg8::gemm_phase<pg8::EpiResid, pg8::StaticOrder, true, true>(lds, g, S, E);
                sample_gemm<0, D>(lds, (const bf16_t*)(ws + WS_AB) + (size_t)MPR * D, (const bf16_t*)(ws + WS_WO), D, nullptr, nullptr, (bf16_t*)(ws + WS_HB) + (size_t)MPR * D,
                                  (float*)(ws + WS_SSQ), nullptr, nullptr, nullptr, tid, lane, wave);
            }
            GRID_BAR();
        }
        REPEAT(REP_P4) { if (rep_) { GRID_BAR(); } PH(4) {
            PHASE_BEGIN
            const int ge = (G == 256) ? GE_FF : G;
            const size_t clo = layer ? CP_C2 : CP_C1, chi = layer ? CP_TOT : CP_C2;
            if ((int)blockIdx.x >= ge) { if (rep_ == 0) copy_range<256 - GE_FF>(a, clo, chi, (int)blockIdx.x - ge, wave); } else {
            pg8::Gemm g{(const bf16_t*)(ws + WS_HB), (const bf16_t*)(ws + (layer ? WS_WF1 : WS_WF0)), MPAD, 2 * DFF, D, wave}; pg8::StaticOrder S; S.init(MPAD, 2 * DFF, ge, (int)blockIdx.x);
            pg8::EpiFfn E{lds, (bf16_t*)(ws + WS_U), (float*)(ws + WS_SG), (float*)(ws + WS_SU), a.in[20] + (size_t)layer * 3 * DFF, (const float*)(ws + WS_SSQ), a.out, a.in[6], layer};
            pg8::gemm_phase<pg8::EpiFfn, pg8::StaticOrder, true, true>(lds, g, S, E);
            }
            if (ge == G && rep_ == 0) copy_range_simple(a, clo, chi, blockIdx.x, G, wave * 64 + lane_id());
        } }
        GRID_BAR();
        REPEAT(REP_P6) { if (rep_) { GRID_BAR(); } PH(6) {
            PHASE_BEGIN
            pg8::Gemm g{(const bf16_t*)(ws + WS_U), (const bf16_t*)(ws + (layer ? WS_WD1 : WS_WD0)), MPR, D, DFF, wave}; pg8::StaticOrder S; S.init(MPR, D, G, (int)blockIdx.x);
            { pg8::Unit u_; for (int i = 0; S.next(i, u_); ++i) panel_fix(a, layer, u_.pm, tid); }
            asm volatile("s_waitcnt vmcnt(0)" ::: "memory"); __syncthreads();
            const bool real_ = (rep_ + 1 == REP_P6);
            pg8::EpiResid E{(bf16_t*)(ws + WS_HB), real_ ? (float*)(ws + WS_SSQ) : (float*)(ws + WS_ZU), real_ ? 0 : 1};
            pg8::gemm_phase<pg8::EpiResid, pg8::StaticOrder, true, true>(lds, g, S, E);
            if (real_) sample_gemm<0, DFF>(lds, (const bf16_t*)(ws + WS_U) + (size_t)MPR * DFF, (const bf16_t*)(ws + (layer ? WS_WD1 : WS_WD0)), D, nullptr, nullptr, (bf16_t*)(ws + WS_HB) + (size_t)MPR * D,
                                (float*)(ws + WS_SSQ), nullptr, nullptr, nullptr, tid, lane, wave);
        } }
        GRID_BAR();
    }
    REPEAT(REP_P13) { if (rep_) { GRID_BAR(); } PH(13) { PHASE_BEGIN p13_final(a, gw, NGW, lane); } }
    }
}

extern "C" void kernel_launch(void* const* d_in, const int* in_sizes, int n_in, void* d_out, int out_size, void* d_ws, size_t ws_size, hipStream_t stream) {
    static int grid = 0;
    if (grid == 0) {
        if (n_in != 22 || (size_t)out_size != O_END || ws_size < WS_END) { fprintf(stderr, "kernel_launch: unexpected shapes (n_in %d, out %d, ws %zu, need %zu)\n", n_in, out_size, ws_size, (size_t)WS_END); grid = -1; return; }
        int dev = 0, cus = 0, per_cu = 0;
        if (hipGetDevice(&dev) != hipSuccess || hipDeviceGetAttribute(&cus, hipDeviceAttributeMultiprocessorCount, dev) != hipSuccess) { grid = -1; return; }
        if (hipFuncSetAttribute((const void*)mega_fwd, hipFuncAttributeMaxDynamicSharedMemorySize, LDS_BYTES) != hipSuccess) { fprintf(stderr, "kernel_launch: hipFuncSetAttribute failed\n"); grid = -1; return; }
        if (hipOccupancyMaxActiveBlocksPerMultiprocessor(&per_cu, (const void*)mega_fwd, NTHREADS, LDS_BYTES) != hipSuccess || per_cu < 1) { fprintf(stderr, "kernel_launch: occupancy query failed (%d)\n", per_cu); (void)hipGetLastError(); grid = -1; return; }
        grid = cus * 1;
    }
    if (grid < 0) return;
    if (hipMemsetAsync((char*)d_ws + WS_CTL, 0, CTL_BYTES, stream) != hipSuccess) { fprintf(stderr, "kernel_launch: memset failed\n"); return; }
    Args a{};
    for (int i = 0; i < 22; ++i) a.in[i] = (const float*)d_in[i];
    a.out = (float*)d_out; a.ws = (unsigned char*)d_ws;
    void* args[] = {&a};
    hipError_t e = hipLaunchCooperativeKernel((const void*)mega_fwd, dim3(grid), dim3(NTHREADS), args, LDS_BYTES, stream);
    if (e != hipSuccess) fprintf(stderr, "cooperative launch failed: %s (grid %d)\n", hipGetErrorString(e), grid);
}
```

```cpp
#include <hip/hip_runtime.h>
#include <hip/hip_cooperative_groups.h>
#include <cstdio>
#include <cstdint>
namespace cg = cooperative_groups;

#define LAS __attribute__((address_space(3)))
typedef unsigned short bf16_t;
typedef short bf16x8 __attribute__((ext_vector_type(8)));
typedef float f32x4 __attribute__((ext_vector_type(4)));
typedef float f32x2 __attribute__((ext_vector_type(2)));
typedef float f32x16 __attribute__((ext_vector_type(16)));
typedef unsigned u32x4 __attribute__((ext_vector_type(4)));
typedef unsigned u32x2 __attribute__((ext_vector_type(2)));
typedef short s16x4 __attribute__((ext_vector_type(4)));

constexpr int D = 1024, SEQ = 2048, NB = 8, MPR = NB * SEQ, NSB = 32, NST = 4, MSA = NSB * NST, MTOT = MPR + MSA, MPAD = 16640;
constexpr int DFF = 2816, NIN = 2560, CH = 512, NH = 16, HD = 64, LBUF = 2048, KA = 31;
constexpr int GAW = 1536;
constexpr float RMS_EPS = 1e-6f, LN_EPS = 1e-5f;
constexpr float LOG2E = 1.4426950408889634f;
constexpr float QSCALE = 0.125f * LOG2E;

constexpr size_t O_YP = 0;
constexpr size_t O_YS = O_YP + (size_t)MPR * D;
constexpr size_t O_PCA = O_YS + (size_t)MSA * D;
constexpr size_t O_SCA = O_PCA + (size_t)NB * 30 * CH;
constexpr size_t O_PCB = O_SCA + (size_t)NSB * 30 * CH;
constexpr size_t O_SCB = O_PCB + (size_t)NB * 2 * CH;
constexpr size_t O_PK = O_SCB + (size_t)NSB * 2 * CH;
constexpr size_t O_SK = O_PK + (size_t)MPR * D;
constexpr size_t O_PV = O_SK + (size_t)NSB * LBUF * D;
constexpr size_t O_SV = O_PV + (size_t)MPR * D;
constexpr size_t O_PF = O_SV + (size_t)NSB * LBUF * D;
constexpr size_t O_SF = O_PF + (size_t)2 * NB * 2 * DFF;
constexpr size_t O_END = O_SF + (size_t)2 * NSB * 2 * DFF;

constexpr size_t al(size_t x) { return (x + 4095) & ~(size_t)4095; }
constexpr size_t WS_CTL = 0, CTL_BYTES = 65536;
constexpr size_t WS_WIN = WS_CTL + CTL_BYTES;
constexpr size_t WS_WOUT = WS_WIN + al((size_t)NIN * D * 2);
constexpr size_t WS_WQKV = WS_WOUT + al((size_t)D * D * 2);
constexpr size_t WS_WO = WS_WQKV + al((size_t)3 * D * D * 2);
constexpr size_t WS_WF0 = WS_WO + al((size_t)D * D * 2);
constexpr size_t WS_WF1 = WS_WF0 + al((size_t)2 * DFF * D * 2);
constexpr size_t WS_WD0 = WS_WF1 + al((size_t)2 * DFF * D * 2);
constexpr size_t WS_WD1 = WS_WD0 + al((size_t)D * DFF * 2);
constexpr size_t WS_HB = WS_WD1 + al((size_t)D * DFF * 2);
constexpr size_t WS_H = WS_HB + al((size_t)MPAD * D * 2);
constexpr size_t WS_SSQ = WS_H + 4096;
constexpr size_t WS_GA = WS_SSQ + al((size_t)MPAD * 64 * 4);
constexpr size_t WS_AB = WS_GA + al((size_t)MPAD * GAW * 2);
constexpr size_t WS_ZG = WS_AB + al((size_t)MPAD * D * 2);
constexpr size_t WS_ZU = WS_ZG + al((size_t)MPAD * DFF * 2);
constexpr size_t WS_U = WS_ZU + al((size_t)MPAD * DFF * 2);
constexpr size_t WS_Q = WS_U + al((size_t)MPAD * DFF * 2);
constexpr size_t WS_K = WS_Q + al((size_t)MPAD * D * 2);
constexpr size_t WS_V = WS_K + al((size_t)MPAD * D * 2);
constexpr size_t WS_QS = WS_V + al((size_t)MPAD * D * 2);
constexpr size_t WS_SG = WS_QS + al((size_t)MSA * D * 4);
constexpr size_t WS_SU = WS_SG + al((size_t)256 * 4 * DFF * 4);
constexpr size_t WS_END = WS_SU + al((size_t)256 * 2 * DFF * 4);
static_assert(WS_V - WS_K == WS_K - WS_Q, "Q|K|V equally spaced");

constexpr int NWAVES = 8, NTHREADS = 512;
constexpr int LDS_BYTES = 163840;
constexpr int MISC_OFF = LDS_BYTES - 1024;

typedef __bf16 bf16x2_t __attribute__((ext_vector_type(2)));
__device__ __forceinline__ unsigned cvt_pk_bf16(float lo, float hi) { return __builtin_bit_cast(unsigned, __builtin_convertvector((f32x2){lo, hi}, bf16x2_t)); }
__device__ __forceinline__ float bf2f(unsigned short b) { return __uint_as_float((unsigned)b << 16); }
__device__ __forceinline__ float bflo(unsigned w) { return __uint_as_float(w << 16); }
__device__ __forceinline__ float bfhi(unsigned w) { return __uint_as_float(w & 0xffff0000u); }
__device__ __forceinline__ float max_raw(float a, float b) { return __builtin_amdgcn_fmed3f(a, b, INFINITY); }
__device__ __forceinline__ float sigmoidf_(float x) { return __builtin_amdgcn_rcpf(1.0f + __expf(-x)); }
__device__ __forceinline__ int launder_v(int x) { asm volatile("" : "+v"(x)); return x; }
__device__ __forceinline__ int lane_id() { int l; asm volatile("v_mbcnt_lo_u32_b32 %0, -1, 0\n\tv_mbcnt_hi_u32_b32 %0, -1, %0" : "=v"(l)); return l; }
template <int CTRL> __device__ __forceinline__ float dppmov(float v) { return __uint_as_float(__builtin_amdgcn_update_dpp(0u, __float_as_uint(v), CTRL, 0xf, 0xf, true)); }
__device__ __forceinline__ float wave_sum(float v) {
    v += dppmov<0xB1>(v);
    v += dppmov<0x4E>(v);
    v += dppmov<0x141>(v);
    v += dppmov<0x140>(v);
    { auto r = __builtin_amdgcn_permlane16_swap(__float_as_uint(v), __float_as_uint(v), false, false); v = __uint_as_float(r[0]) + __uint_as_float(r[1]); }
    { auto r = __builtin_amdgcn_permlane32_swap(__float_as_uint(v), __float_as_uint(v), false, false); v = __uint_as_float(r[0]) + __uint_as_float(r[1]); }
    return v;
}
__device__ __forceinline__ float wave_max(float v) {
    v = fmaxf(v, dppmov<0xB1>(v)); v = fmaxf(v, dppmov<0x4E>(v)); v = fmaxf(v, dppmov<0x141>(v)); v = fmaxf(v, dppmov<0x140>(v));
    { auto r = __builtin_amdgcn_permlane16_swap(__float_as_uint(v), __float_as_uint(v), false, false); v = fmaxf(__uint_as_float(r[0]), __uint_as_float(r[1])); }
    { auto r = __builtin_amdgcn_permlane32_swap(__float_as_uint(v), __float_as_uint(v), false, false); v = fmaxf(__uint_as_float(r[0]), __uint_as_float(r[1])); }
    return v;
}

namespace pg8 {
constexpr int BM = 256, BK = 64, HALF = 128, HTB = HALF * BK * 2, STAGE_BYTES = 8 * HTB, NXCD = 8, WGM = 4;
__host__ __device__ __forceinline__ int lds_byte(int r, int c) { const int st = (r >> 4) * 2 + (c >> 5), rr = r & 15, cc = c & 31, ob = rr * 64 + cc * 2; return st * 1024 + (ob ^ (((ob >> 9) & 1) << 5)); }
__host__ __device__ __forceinline__ void stage_rc(int b, int& R, int& C) { const int st = b / 1024, sb = b % 1024, swz = sb ^ (((sb >> 9) & 1) << 5); R = (st >> 1) * 16 + swz / 64; C = (st & 1) * 32 + (swz % 64) / 2; }
__host__ __device__ __forceinline__ int perm32(int rho) { const int n = rho >> 4, i = rho & 15; return 8 * (i >> 2) + 4 * n + (i & 3); }

struct Unit { int pm, pn; };
struct Gemm { const bf16_t* A; const bf16_t* Bt; int M, N, K, wid; };

struct StaticOrder {
    int nM, nN, nwg, G, c;
    __host__ __device__ __forceinline__ void init(int M, int N, int G_, int c_) { nM = M / BM; nN = N / BM; nwg = nM * nN; G = G_; c = c_; }
    __host__ __device__ __forceinline__ bool next(int i, Unit& u) const {
        const long L = (long)i * G + c; if (L >= nwg) return false;
        int wgid = (int)L; { const int q = nwg / NXCD, r = nwg % NXCD, xcd = wgid % NXCD, off = wgid / NXCD; wgid = (xcd < r ? xcd * (q + 1) : r * (q + 1) + (xcd - r) * q) + off; }
        const int nig = WGM * nN, gid = wgid / nig, fm = gid * WGM, gsz = (nM - fm) < WGM ? (nM - fm) : WGM;
        u.pm = fm + ((wgid % nig) % gsz); u.pn = (wgid % nig) / gsz; return true;
    }
    __device__ __forceinline__ void a_ready(const Unit&) const {}
    __device__ __forceinline__ void done(const Unit&) const {}
};

__device__ __forceinline__ float fq_sum(float x) {
    auto a = __builtin_amdgcn_permlane16_swap(__float_as_uint(x), __float_as_uint(x), false, false); x = __uint_as_float(a[0]) + __uint_as_float(a[1]);
    auto b = __builtin_amdgcn_permlane32_swap(__float_as_uint(x), __float_as_uint(x), false, false); return __uint_as_float(b[0]) + __uint_as_float(b[1]);
}
__device__ __forceinline__ float row_rstd(const float* ssq, int r, int fq) {
    float s;
    if (r < MPR) { const f32x4 p = *(const f32x4*)(ssq + (size_t)r * 64 + 4 * fq); s = (p.x + p.y) + (p.z + p.w); }
    else { const f32x4* pp = (const f32x4*)(ssq + (size_t)r * 64 + 16 * fq); const f32x4 p = (pp[0] + pp[1]) + (pp[2] + pp[3]); s = (p.x + p.y) + (p.z + p.w); }
    return __builtin_amdgcn_rsqf(fq_sum(s) * (1.0f / D) + RMS_EPS);
}

struct EpiInAB {
    static constexpr bool PERM = true, AFTER_DRAIN = false;
    bf16_t* GA; const float* ssq; float* out;
    __device__ __forceinline__ void operator()(const f32x4 (&acc)[2][2][4][2], const Unit& u, int wr, int wc, int fr, int fq) const {
        const int pn = u.pn, colw = wc * 32 + 8 * fq;
        float rsv[2][4];
#pragma unroll
        for (int ai = 0; ai < 2; ++ai)
#pragma unroll
            for (int m = 0; m < 4; ++m) rsv[ai][m] = row_rstd(ssq, u.pm * BM + ai * HALF + wr * 64 + m * 16 + fr, fq);
        asm volatile("" ::: "memory");
#pragma unroll
        for (int ai = 0; ai < 2; ++ai)
#pragma unroll
            for (int m = 0; m < 4; ++m) {
                const int r = u.pm * BM + ai * HALF + wr * 64 + m * 16 + fr;
                const float rs = rsv[ai][m];
                const f32x4 a0 = acc[ai][0][m][0] * rs, a1 = acc[ai][0][m][1] * rs, g0 = acc[ai][1][m][0] * rs, g1 = acc[ai][1][m][1] * rs;
                bf16_t* rowp = GA + (size_t)r * GAW;
                if (pn < 8) {
                    f32x4 v0, v1;
                    if (pn < 4) {
#pragma unroll
                        for (int i = 0; i < 4; ++i) { v0[i] = a0[i] * sigmoidf_(g0[i]); v1[i] = a1[i] * sigmoidf_(g1[i]); }
                    } else { v0 = a0 * g0; v1 = a1 * g1; }
                    const int cl = 128 * (pn & 3) + colw;
                    u32x4 w; w.x = cvt_pk_bf16(v0[0], v0[1]); w.y = cvt_pk_bf16(v0[2], v0[3]); w.z = cvt_pk_bf16(v1[0], v1[1]); w.w = cvt_pk_bf16(v1[2], v1[3]);
                    *(u32x4*)(rowp + (pn < 4 ? 0 : 512) + cl) = w;
                    const int keep = pn < 4 ? 30 : 2;
                    float* sp = nullptr;
                    if (r < MPR) { const int t = r & (SEQ - 1), b = r >> 11; if (t >= SEQ - keep) sp = out + (pn < 4 ? O_PCA : O_PCB) + ((size_t)(b * keep + (t - (SEQ - keep)))) * CH + cl; }
                    else if (r < MTOT) { const int rs_ = r - MPR, sb = rs_ >> 2, j = rs_ & 3; if (j >= NST - keep || keep == 30) sp = out + (pn < 4 ? O_SCA : O_SCB) + ((size_t)(sb * keep + (keep - NST + j))) * CH + cl; }
                    if (sp) { *(f32x4*)sp = v0; *(f32x4*)(sp + 4) = v1; }
                } else {
                    const int c = 1024 + 256 * (pn - 8) + colw;
                    u32x4 w; w.x = cvt_pk_bf16(a0[0], a0[1]); w.y = cvt_pk_bf16(a0[2], a0[3]); w.z = cvt_pk_bf16(a1[0], a1[1]); w.w = cvt_pk_bf16(a1[2], a1[3]);
                    *(u32x4*)(rowp + c) = w;
                    w.x = cvt_pk_bf16(g0[0], g0[1]); w.y = cvt_pk_bf16(g0[2], g0[3]); w.z = cvt_pk_bf16(g1[0], g1[1]); w.w = cvt_pk_bf16(g1[2], g1[3]);
                    *(u32x4*)(rowp + c + 128) = w;
                }
            }
    }
};
struct EpiResid {
    static constexpr bool PERM = true, AFTER_DRAIN = false;
    bf16_t* HB; float* ssq; int skip;
    __device__ __forceinline__ void operator()(const f32x4 (&acc)[2][2][4][2], const Unit& u, int wr, int wc, int fr, int fq) const {
        const int col0 = u.pn * BM + wc * 32 + 8 * fq;
        if (skip) { if (acc[0][0][0][0][0] == 1.2345e-30f) ssq[0] = 0.f; return; }
#pragma unroll
        for (int ai = 0; ai < 2; ++ai) {
            u32x4 bs[4][2];
#pragma unroll
            for (int m = 0; m < 4; ++m) { const int r = u.pm * BM + ai * HALF + wr * 64 + m * 16 + fr; const int rc = r < MTOT ? r : MTOT - 1;
#pragma unroll
                for (int bj = 0; bj < 2; ++bj) bs[m][bj] = *(const u32x4*)(HB + (size_t)rc * D + col0 + bj * HALF); }
            asm volatile("" ::: "memory");
#pragma unroll
            for (int m = 0; m < 4; ++m) {
                const int r = u.pm * BM + ai * HALF + wr * 64 + m * 16 + fr;
                float s = 0.f;
                if (r < MTOT) {
#pragma unroll
                    for (int bj = 0; bj < 2; ++bj) {
                        const u32x4 b = bs[m][bj];
                        const f32x4 v0 = (f32x4){bflo(b.x), bfhi(b.x), bflo(b.y), bfhi(b.y)} + acc[ai][bj][m][0];
                        const f32x4 v1 = (f32x4){bflo(b.z), bfhi(b.z), bflo(b.w), bfhi(b.w)} + acc[ai][bj][m][1];
                        s += ((v0[0] * v0[0] + v0[1] * v0[1]) + (v0[2] * v0[2] + v0[3] * v0[3])) + ((v1[0] * v1[0] + v1[1] * v1[1]) + (v1[2] * v1[2] + v1[3] * v1[3]));
                        u32x4 w; w.x = cvt_pk_bf16(v0[0], v0[1]); w.y = cvt_pk_bf16(v0[2], v0[3]); w.z = cvt_pk_bf16(v1[0], v1[1]); w.w = cvt_pk_bf16(v1[2], v1[3]);
                        *(u32x4*)(HB + (size_t)r * D + col0 + bj * HALF) = w;
                    }
                }
                s = fq_sum(s);
                if (fq == 0 && r < MTOT) ssq[(size_t)r * 64 + u.pn * 4 + wc] = s;
            }
        }
    }
};
template <int CTRL> __device__ __forceinline__ float dpp_f(float old, float src) {
    return __uint_as_float(__builtin_amdgcn_update_dpp(__float_as_uint(old), __float_as_uint(src), CTRL, 0xf, 0xf, false)); }
struct EpiFfn {
    static constexpr bool PERM = true, AFTER_DRAIN = false;
    LAS unsigned char* lds; bf16_t* U; float* SG; float* SU; const float* wcv; const float* ssq; float* out; const float* fst; int layer;
    __device__ __forceinline__ void operator()(const f32x4 (&acc)[2][2][4][2], const Unit& u, int wr, int wc, int fr, int fq) const {
        asm volatile("" : "+v"(fr), "+v"(fq));
        const int col = u.pn * 128 + wc * 32 + 8 * fq;
        f32x4 w0[2], w1[2], w2[2];
#pragma unroll
        for (int n = 0; n < 2; ++n) { w0[n] = *(const f32x4*)(wcv + col + 4 * n); w1[n] = *(const f32x4*)(wcv + DFF + col + 4 * n); w2[n] = *(const f32x4*)(wcv + 2 * DFF + col + 4 * n); }
        if (u.pm >= MPR / BM) {
#pragma unroll
            for (int ai = 0; ai < 2; ++ai)
#pragma unroll
                for (int m = 0; m < 4; ++m) {
                    const int r = u.pm * BM + ai * HALF + wr * 64 + m * 16 + fr;
                    if (ai * HALF + wr * 64 + m * 16 >= MSA) continue;
                    const float rs = row_rstd(ssq, r, fq);
                    const int rs_ = r - MPR, sb = rs_ >> 2, j = rs_ & 3;
                    const float* sp0 = fst + ((size_t)((layer * NSB + sb) * 2)) * DFF + col;
                    f32x4 g[2], up[2], s0[2], s1[2], o[2];
#pragma unroll
                    for (int n = 0; n < 2; ++n) { g[n] = acc[ai][0][m][n] * rs; up[n] = acc[ai][1][m][n] * rs; s0[n] = *(const f32x4*)(sp0 + 4 * n); s1[n] = *(const f32x4*)(sp0 + DFF + 4 * n); }
#pragma unroll
                    for (int n = 0; n < 2; ++n)
#pragma unroll
                        for (int i = 0; i < 4; ++i) {
                            const float q1 = dpp_f<0x90>(0.f, g[n][i]), q2 = dpp_f<0x40>(0.f, g[n][i]);
                            const float gm1 = (j == 0) ? s1[n][i] : q1, gm2 = (j == 0) ? s0[n][i] : (j == 1) ? s1[n][i] : q2;
                            const float y = w0[n][i] * gm2 + w1[n][i] * gm1 + w2[n][i] * g[n][i];
                            o[n][i] = y * sigmoidf_(y) * up[n][i];
                        }
                    u32x4 w; w.x = cvt_pk_bf16(o[0][0], o[0][1]); w.y = cvt_pk_bf16(o[0][2], o[0][3]); w.z = cvt_pk_bf16(o[1][0], o[1][1]); w.w = cvt_pk_bf16(o[1][2], o[1][3]);
                    *(u32x4*)(U + (size_t)r * DFF + col) = w;
                    if (j >= 2) { float* sp = out + O_SF + ((size_t)((layer * NSB + sb) * 2 + (j - 2))) * DFF + col; *(f32x4*)sp = g[0]; *(f32x4*)(sp + 4) = g[1]; }
                }
            return;
        }
        float rsv[2][4];
#pragma unroll
        for (int ai = 0; ai < 2; ++ai)
#pragma unroll
            for (int m = 0; m < 4; ++m) rsv[ai][m] = row_rstd(ssq, (u.pm * 4 + ai * 2 + wr) * 64 + m * 16 + fr, fq);
        asm volatile("" ::: "memory");
        LAS float* xg = (LAS float*)(lds + STAGE_BYTES);
#pragma unroll
        for (int ai = 0; ai < 2; ++ai) { const int bl = ai * 2 + wr;
            if (bl < 3 && fr >= 14) { LAS float* xp = xg + (bl * 2 + (fr - 14)) * 128 + wc * 32 + 8 * fq; *(LAS f32x4*)xp = acc[ai][0][3][0] * rsv[ai][3]; *(LAS f32x4*)(xp + 4) = acc[ai][0][3][1] * rsv[ai][3]; } }
        asm volatile("s_waitcnt lgkmcnt(0)" ::: "memory");
        __builtin_amdgcn_s_barrier();
#pragma unroll
        for (int ai = 0; ai < 2; ++ai) {
            const int bl = ai * 2 + wr, blk = u.pm * 4 + bl;
            f32x4 gp[2];
            gp[0] = (f32x4){0.f, 0.f, 0.f, 0.f}; gp[1] = gp[0];
            if (bl >= 1 && fr >= 14) { const LAS float* xp = xg + ((bl - 1) * 2 + (fr - 14)) * 128 + wc * 32 + 8 * fq; gp[0] = *(const LAS f32x4*)xp; gp[1] = *(const LAS f32x4*)(xp + 4); }
#pragma unroll
            for (int m = 0; m < 4; ++m) {
                const int r = blk * 64 + m * 16 + fr;
                const float rs = rsv[ai][m];
                f32x4 g[2], up[2], o[2];
#pragma unroll
                for (int n = 0; n < 2; ++n) { g[n] = acc[ai][0][m][n] * rs; up[n] = acc[ai][1][m][n] * rs; }
#pragma unroll
                for (int n = 0; n < 2; ++n)
#pragma unroll
                    for (int i = 0; i < 4; ++i) {
                        const float x1 = dpp_f<0x121>(0.f, gp[n][i]), gm1 = dpp_f<0x111>(x1, g[n][i]);
                        const float x2 = dpp_f<0x122>(0.f, gp[n][i]), gm2 = dpp_f<0x112>(x2, g[n][i]);
                        const float y = w0[n][i] * gm2 + w1[n][i] * gm1 + w2[n][i] * g[n][i];
                        o[n][i] = y * sigmoidf_(y) * up[n][i];
                    }
                const bool seam_lo = (bl == 0) && (m == 0) && (fr < 2), seam_hi = (bl == 3) && (m == 3) && (fr >= 14);
                if (!seam_lo) { u32x4 w; w.x = cvt_pk_bf16(o[0][0], o[0][1]); w.y = cvt_pk_bf16(o[0][2], o[0][3]); w.z = cvt_pk_bf16(o[1][0], o[1][1]); w.w = cvt_pk_bf16(o[1][2], o[1][3]);
                    *(u32x4*)(U + (size_t)r * DFF + col) = w; }
                else { float* sg = SG + ((size_t)u.pm * 4 + fr) * DFF + col; *(f32x4*)sg = g[0]; *(f32x4*)(sg + 4) = g[1];
                       float* su = SU + ((size_t)u.pm * 2 + fr) * DFF + col; *(f32x4*)su = up[0]; *(f32x4*)(su + 4) = up[1]; }
                if (seam_hi) { float* sg = SG + ((size_t)u.pm * 4 + 2 + (fr - 14)) * DFF + col; *(f32x4*)sg = g[0]; *(f32x4*)(sg + 4) = g[1];
                    const int t = r & (SEQ - 1), b = r >> 11;
                    if (t >= SEQ - 2) { float* sp = out + O_PF + ((size_t)((layer * NB + b) * 2 + (t - (SEQ - 2)))) * DFF + col; *(f32x4*)sp = g[0]; *(f32x4*)(sp + 4) = g[1]; } }
                gp[0] = g[0]; gp[1] = g[1];
            }
        }
    }
};
struct EpiQkv {
    static constexpr bool PERM = true, AFTER_DRAIN = false;
    bf16_t* QKV; float* QS; const float* ssq; float* out;
    __device__ __forceinline__ void operator()(const f32x4 (&acc)[2][2][4][2], const Unit& u, int wr, int wc, int fr, int fq) const {
        const int which = u.pn >> 2, cb = 256 * (u.pn & 3) + wc * 32 + 8 * fq;
        bf16_t* dst = QKV + (size_t)which * ((WS_K - WS_Q) / 2);
        float rsv[2][4];
#pragma unroll
        for (int ai = 0; ai < 2; ++ai)
#pragma unroll
            for (int m = 0; m < 4; ++m) rsv[ai][m] = row_rstd(ssq, u.pm * BM + ai * HALF + wr * 64 + m * 16 + fr, fq);
        asm volatile("" ::: "memory");
#pragma unroll
        for (int ai = 0; ai < 2; ++ai)
#pragma unroll
            for (int m = 0; m < 4; ++m) {
                const int r = u.pm * BM + ai * HALF + wr * 64 + m * 16 + fr;
                const float rs = rsv[ai][m] * (which == 0 ? QSCALE : 1.0f);
                float* fp = nullptr;
                if (which == 0) { if (r >= MPR && r < MTOT) fp = QS + (size_t)(r - MPR) * D; }
                else if (r < MPR) fp = out + (which == 1 ? O_PK : O_PV) + (size_t)r * D;
                else if (r < MTOT) { const int rs_ = r - MPR, sb = rs_ >> 2, j = rs_ & 3; fp = out + (which == 1 ? O_SK : O_SV) + ((size_t)sb * LBUF + (LBUF - NST) + j) * D; }
#pragma unroll
                for (int bj = 0; bj < 2; ++bj) {
                    const f32x4 v0 = acc[ai][bj][m][0] * rs, v1 = acc[ai][bj][m][1] * rs;
                    const int c = cb + bj * HALF;
                    u32x4 w; w.x = cvt_pk_bf16(v0[0], v0[1]); w.y = cvt_pk_bf16(v0[2], v0[3]); w.z = cvt_pk_bf16(v1[0], v1[1]); w.w = cvt_pk_bf16(v1[2], v1[3]);
                    *(u32x4*)(dst + (size_t)r * D + c) = w;
                    if (fp) { *(f32x4*)(fp + c) = v0; *(f32x4*)(fp + c + 4) = v1; }
                }
            }
    }
};

template <class Epi, class Sched, bool ALIGN_EPI = false, bool SP2 = false>
__device__ __forceinline__ void gemm_phase(LAS unsigned char* lds, const Gemm g, const Sched& S, const Epi& E) {
    const int wid = g.wid, lane = lane_id(), tid = wid * 64 + lane, wr = wid >> 2, wc = wid & 3, fr = lane & 15, fq = lane >> 4;
    const int K = g.K, nt = K / BK;
    unsigned voffA[2], voffB[2];
#pragma unroll
    for (int i = 0; i < 2; ++i) { int R, C; stage_rc(tid * 16 + i * 8192, R, C); const int Rb = Epi::PERM ? ((R & ~31) + perm32(R & 31)) : R;
        voffA[i] = (unsigned)(R * K + C) * 2u; voffB[i] = (unsigned)(Rb * K + C) * 2u; }
    const size_t kstep = (size_t)(BK * 2);
    const size_t hstep = (size_t)HALF * K * 2;
    const size_t tstep = 2 * hstep;
    const unsigned ldsw = (unsigned)wid * 1024u;
    const int aoff = lds_byte(wr * 64 + fr, fq * 8), boff = lds_byte(wc * 32 + fr, fq * 8);
#define PG8_SA(b, h) (((b) * 2 + (h)) * HTB)
#define PG8_SB(b, h) ((4 + (b) * 2 + (h)) * HTB)
#define PG8_STAGE(bufoff, gbase, voff) do { _Pragma("unroll") for (int _i = 0; _i < 2; ++_i) \
        __builtin_amdgcn_global_load_lds((const unsigned*)((const char*)(gbase) + (voff)[_i]), (LAS unsigned*)(lds + (bufoff) + ldsw + _i * 8192), 16, 0, 0); } while (0)
#define PG8_LDA(dst, b, h) do { _Pragma("unroll") for (int m = 0; m < 4; ++m) _Pragma("unroll") for (int k = 0; k < 2; ++k) dst[m][k] = *(const LAS bf16x8*)(lds + PG8_SA(b, h) + aoff + m * 2048 + k * 1024); } while (0)
#define PG8_LDB(dst, b, h) do { _Pragma("unroll") for (int n = 0; n < 2; ++n) _Pragma("unroll") for (int k = 0; k < 2; ++k) dst[n][k] = *(const LAS bf16x8*)(lds + PG8_SB(b, h) + boff + n * 2048 + k * 1024); } while (0)
#define PG8_MMA(ai, bj, At, Bt) do { __builtin_amdgcn_s_setprio(1); _Pragma("unroll") for (int m = 0; m < 4; ++m) _Pragma("unroll") for (int n = 0; n < 2; ++n) _Pragma("unroll") for (int k = 0; k < 2; ++k) \
        acc[ai][bj][m][n] = __builtin_amdgcn_mfma_f32_16x16x32_bf16(Bt[n][k], At[m][k], acc[ai][bj][m][n], 0, 0, 0); __builtin_amdgcn_s_setprio(0); } while (0)
#define PG8_WAIT_V(n) asm volatile("s_waitcnt vmcnt(" #n ")" ::: "memory")
#define PG8_WAIT_L(n) asm volatile("s_waitcnt lgkmcnt(" #n ")" ::: "memory")
#define PG8_BAR __builtin_amdgcn_s_barrier()
#define PG8_SCHED __builtin_amdgcn_sched_barrier(0)
    Unit cur, nxt; int ui = 0;
    if (!S.next(0, cur)) return;
    f32x4 acc[2][2][4][2];
#pragma unroll
    for (int a = 0; a < 2; ++a)
#pragma unroll
        for (int b = 0; b < 2; ++b)
#pragma unroll
            for (int m = 0; m < 4; ++m)
#pragma unroll
                for (int n = 0; n < 2; ++n) acc[a][b][m][n] = (f32x4){0.f, 0.f, 0.f, 0.f};
    bf16x8 At[4][2], B0[2][2], B1[2][2];
    const char* cA = (const char*)g.A + (size_t)cur.pm * tstep; const char* cB = (const char*)g.Bt + (size_t)cur.pn * tstep;
    S.a_ready(cur);
    if constexpr (SP2) {
        PG8_STAGE(PG8_SB(0, 0), cB, voffB); PG8_STAGE(PG8_SB(0, 1), cB + hstep, voffB); PG8_STAGE(PG8_SA(0, 0), cA, voffA); PG8_STAGE(PG8_SA(0, 1), cA + hstep, voffA);
        if (wr == 1) PG8_BAR;
        PG8_WAIT_V(2); PG8_BAR;
        PG8_STAGE(PG8_SB(1, 0), cB + kstep, voffB); PG8_STAGE(PG8_SA(1, 0), cA + kstep, voffA); PG8_STAGE(PG8_SB(1, 1), cB + hstep + kstep, voffB);
        PG8_WAIT_V(6); PG8_BAR;
    } else {
        PG8_STAGE(PG8_SB(0, 0), cB, voffB); PG8_STAGE(PG8_SA(0, 0), cA, voffA); PG8_STAGE(PG8_SB(0, 1), cB + hstep, voffB); PG8_STAGE(PG8_SA(0, 1), cA + hstep, voffA);
        if (wr == 1) PG8_BAR;
        PG8_WAIT_V(4); PG8_BAR;
        PG8_STAGE(PG8_SB(1, 0), cB + kstep, voffB); PG8_STAGE(PG8_SA(1, 0), cA + kstep, voffA); PG8_STAGE(PG8_SB(1, 1), cB + hstep + kstep, voffB);
        PG8_WAIT_V(6); PG8_BAR;
    }
    for (;;) {
        const bool has_next = S.next(ui + 1, nxt);
        const char* nA = has_next ? (const char*)g.A + (size_t)nxt.pm * tstep : cA; const char* nB = has_next ? (const char*)g.Bt + (size_t)nxt.pn * tstep : cB;
        for (int t = 0; t < nt; t += 2) {
            const bool last = (t == nt - 2);
            const char* a1 = cA + (size_t)(t + 1) * kstep;
            const char* a2 = last ? nA : cA + (size_t)(t + 2) * kstep; const char* b2 = last ? nB : cB + (size_t)(t + 2) * kstep;
            const char* a3 = a2 + kstep; const char* b3 = b2 + kstep;
            if (last && has_next) S.a_ready(nxt);
            if constexpr (SP2) {
            PG8_LDB(B0, 0, 0); PG8_LDB(B1, 0, 1); PG8_SCHED; PG8_LDA(At, 0, 0); PG8_STAGE(PG8_SA(1, 1), a1 + hstep, voffA);
            PG8_WAIT_V(8); PG8_WAIT_L(0); PG8_BAR; PG8_MMA(0, 0, At, B0); PG8_MMA(0, 1, At, B1); PG8_BAR; PG8_SCHED;
            PG8_LDA(At, 0, 1); PG8_STAGE(PG8_SB(0, 0), b2, voffB); PG8_STAGE(PG8_SB(0, 1), b2 + hstep, voffB); PG8_STAGE(PG8_SA(0, 0), a2, voffA);
            PG8_WAIT_V(8); PG8_WAIT_L(0); PG8_BAR; PG8_MMA(1, 0, At, B0); PG8_MMA(1, 1, At, B1); PG8_BAR; PG8_SCHED;
            PG8_LDB(B0, 1, 0); PG8_LDB(B1, 1, 1); PG8_SCHED; PG8_LDA(At, 1, 0); PG8_STAGE(PG8_SA(0, 1), a2 + hstep, voffA);
            PG8_WAIT_V(8); PG8_WAIT_L(0); PG8_BAR; PG8_MMA(0, 0, At, B0); PG8_MMA(0, 1, At, B1); PG8_BAR; PG8_SCHED;
            PG8_LDA(At, 1, 1); PG8_STAGE(PG8_SB(1, 0), b3, voffB); PG8_STAGE(PG8_SB(1, 1), b3 + hstep, voffB); PG8_STAGE(PG8_SA(1, 0), a3, voffA);
            PG8_WAIT_V(8); PG8_WAIT_L(0); PG8_BAR; PG8_MMA(1, 0, At, B0); PG8_MMA(1, 1, At, B1); PG8_BAR; PG8_SCHED;
            } else {
            PG8_LDB(B0, 0, 0); PG8_SCHED; PG8_LDA(At, 0, 0); PG8_STAGE(PG8_SA(1, 1), a1 + hstep, voffA);
            PG8_WAIT_L(8); PG8_BAR; PG8_WAIT_L(0); PG8_MMA(0, 0, At, B0); PG8_BAR; PG8_SCHED;
            PG8_LDB(B1, 0, 1); PG8_STAGE(PG8_SB(0, 0), b2, voffB);
            PG8_BAR; PG8_WAIT_L(0); PG8_MMA(0, 1, At, B1); PG8_BAR;
            PG8_LDA(At, 0, 1); PG8_STAGE(PG8_SA(0, 0), a2, voffA);
            PG8_BAR; PG8_WAIT_L(0); PG8_MMA(1, 0, At, B0); PG8_BAR; PG8_SCHED;
            PG8_STAGE(PG8_SB(0, 1), b2 + hstep, voffB);
            PG8_WAIT_V(6); PG8_BAR; PG8_MMA(1, 1, At, B1); PG8_BAR;
            PG8_LDB(B0, 1, 0); PG8_SCHED; PG8_LDA(At, 1, 0); PG8_STAGE(PG8_SA(0, 1), a2 + hstep, voffA);
            PG8_WAIT_L(8); PG8_BAR; PG8_WAIT_L(0); PG8_MMA(0, 0, At, B0); PG8_BAR; PG8_SCHED;
            PG8_LDB(B1, 1, 1); PG8_STAGE(PG8_SB(1, 0), b3, voffB);
            PG8_BAR; PG8_WAIT_L(0); PG8_MMA(0, 1, At, B1); PG8_BAR;
            PG8_LDA(At, 1, 1); PG8_STAGE(PG8_SA(1, 0), a3, voffA);
            PG8_BAR; PG8_WAIT_L(0); PG8_MMA(1, 0, At, B0); PG8_BAR; PG8_SCHED;
            PG8_STAGE(PG8_SB(1, 1), b3 + hstep, voffB);
            PG8_WAIT_V(6); PG8_BAR; PG8_MMA(1, 1, At, B1); PG8_BAR;
            }
        }
        if constexpr (ALIGN_EPI) { if (wr == 0) PG8_BAR; }
        if constexpr (!Epi::AFTER_DRAIN) { E(acc, cur, wr, wc, fr, fq); S.done(cur); }
        if (!has_next) break;
#pragma unroll
        for (int a = 0; a < 2; ++a)
#pragma unroll
            for (int b = 0; b < 2; ++b)
#pragma unroll
                for (int m = 0; m < 4; ++m)
#pragma unroll
                    for (int n = 0; n < 2; ++n) acc[a][b][m][n] = (f32x4){0.f, 0.f, 0.f, 0.f};
        cur = nxt; cA = nA; cB = nB; ++ui;
        if constexpr (ALIGN_EPI) { if (wr == 1) PG8_BAR; }
    }
    PG8_WAIT_V(0);
    if constexpr (!ALIGN_EPI) { if (wr == 0) PG8_BAR; }
    PG8_BAR;
#undef PG8_SA
#undef PG8_SB
#undef PG8_STAGE
#undef PG8_LDA
#undef PG8_LDB
#undef PG8_MMA
#undef PG8_WAIT_V
#undef PG8_WAIT_L
#undef PG8_BAR
#undef PG8_SCHED
}
}

__device__ __forceinline__ void transpose_item(const float* W, int K, int N, bf16_t* WT, int k0, int np0, int srcn0, const float* g, LAS float* scr, int lane) {
    f32x4 v[8];
#pragma unroll
    for (int i = 0; i < 8; ++i) { const int kk = 8 * i + (lane >> 3); v[i] = __builtin_nontemporal_load((const f32x4*)(W + (size_t)(k0 + kk) * N + srcn0 + (lane & 7) * 4)); }
#pragma unroll
    for (int i = 0; i < 8; ++i) { const int kk = 8 * i + (lane >> 3); const float gg = g ? g[k0 + kk] : 1.0f; LAS float* d = scr + kk * 33 + (lane & 7) * 4;
        d[0] = v[i].x * gg; d[1] = v[i].y * gg; d[2] = v[i].z * gg; d[3] = v[i].w * gg; }
    asm volatile("s_waitcnt lgkmcnt(0)" ::: "memory");
    const int c = lane & 7;
#pragma unroll
    for (int j = 0; j < 4; ++j) { const int n = (lane >> 3) + 8 * j; const LAS float* s = scr + (8 * c) * 33 + n;
        u32x4 o; o.x = cvt_pk_bf16(s[0 * 33], s[1 * 33]); o.y = cvt_pk_bf16(s[2 * 33], s[3 * 33]); o.z = cvt_pk_bf16(s[4 * 33], s[5 * 33]); o.w = cvt_pk_bf16(s[6 * 33], s[7 * 33]);
        *(u32x4*)(WT + (size_t)(np0 + n) * K + k0 + 8 * c) = o; }
    asm volatile("s_waitcnt lgkmcnt(0)" ::: "memory");
}
__device__ __forceinline__ int src_in_ab(int np) {
    const int pn = np >> 8, cc = np & 255, bj = cc >> 7, off = cc & 127;
    if (pn < 4) return (bj ? 512 : 0) + 128 * pn + off;
    if (pn < 8) return (bj ? 2048 : 1536) + 128 * (pn - 4) + off;
    return 1024 + 256 * (pn - 8) + cc;
}
__device__ __forceinline__ int src_ffn(int np) { const int pn = np >> 8, cc = np & 255, bj = cc >> 7, off = cc & 127; return (bj ? DFF : 0) + 128 * pn + off; }

struct Args { const float* in[22]; float* out; unsigned char* ws; };

__device__ __forceinline__ void copy_range_simple(const Args& a, size_t lo, size_t hi, int bi, int nb, int tid) {
    const size_t per = (size_t)(LBUF - NST) * D / 4;
    const size_t stride = (size_t)nb * NTHREADS;
    for (size_t i0 = lo + (size_t)bi * NTHREADS + tid; i0 < hi; i0 += 8 * stride) {
        f32x4 kv[8], vv[8];
#pragma unroll
        for (int u = 0; u < 8; ++u) { const size_t i = i0 + u * stride; if (i < hi) { const size_t sb = i / per, rem = i % per;
            kv[u] = __builtin_nontemporal_load((const f32x4*)(a.in[4] + (sb * LBUF + NST) * D) + rem); vv[u] = __builtin_nontemporal_load((const f32x4*)(a.in[5] + (sb * LBUF + NST) * D) + rem); } }
#pragma unroll
        for (int u = 0; u < 8; ++u) { const size_t i = i0 + u * stride; if (i < hi) { const size_t sb = i / per, rem = i % per;
            __builtin_nontemporal_store(kv[u], (f32x4*)(a.out + O_SK + sb * LBUF * D) + rem); __builtin_nontemporal_store(vv[u], (f32x4*)(a.out + O_SV + sb * LBUF * D) + rem); } }
    }
}
template <int NB> __device__ __forceinline__ void copy_range(const Args& a, size_t lo_, size_t hi_, int bi, int wave) {
    constexpr unsigned per = (unsigned)((LBUF - NST) * D / 4);
    const unsigned lo = (unsigned)lo_, hi = (unsigned)hi_; constexpr unsigned stride = (unsigned)NB * NTHREADS;
    const float* kin = a.in[4]; const float* vin = a.in[5]; float* outp = a.out;
#define CP_SRC(T, i) ((const f32x4*)((T) + ((size_t)((i) / per) * LBUF + NST) * D) + ((i) % per))
#define CP_DST(O, i) ((f32x4*)(outp + (O) + (size_t)((i) / per) * LBUF * D) + ((i) % per))
#define CP_LOAD(KK, VV, base) _Pragma("unroll") for (int u = 0; u < 8; ++u) { const unsigned i = (base) + u * stride; KK[u] = __builtin_nontemporal_load(CP_SRC(kin, i)); VV[u] = __builtin_nontemporal_load(CP_SRC(vin, i)); }
#define CP_STORE(KK, VV, base) _Pragma("unroll") for (int u = 0; u < 8; ++u) { const unsigned i = (base) + u * stride; __builtin_nontemporal_store(KK[u], CP_DST(O_SK, i)); __builtin_nontemporal_store(VV[u], CP_DST(O_SV, i)); }
#define CP_BODY CP_LOAD(kB, vB, i0 + 8u * stride) CP_STORE(kA, vA, i0) CP_LOAD(kA, vA, i0 + 16u * stride) CP_STORE(kB, vB, i0 + 8u * stride) i0 += 16u * stride;
    unsigned i0 = lo + (unsigned)bi * NTHREADS + (unsigned)(wave * 64 + lane_id());
    if (i0 >= hi) return;
    const unsigned nIt = ((hi - i0 + stride - 1u) / stride) >> 4;
    f32x4 kA[8], vA[8], kB[8], vB[8];
    if (nIt) {
        CP_LOAD(kA, vA, i0)
        if (nIt >= 2u) {
            CP_BODY
            for (unsigned it = 2u; it < nIt; ++it) { CP_BODY }
        }
        CP_LOAD(kB, vB, i0 + 8u * stride) CP_STORE(kA, vA, i0) CP_STORE(kB, vB, i0 + 8u * stride) i0 += 16u * stride;
    }
    if (i0 < hi) {
#pragma unroll
        for (int u = 0; u < 8; ++u) { const unsigned i = i0 + u * stride; if (i < hi) { kA[u] = __builtin_nontemporal_load(CP_SRC(kin, i)); vA[u] = __builtin_nontemporal_load(CP_SRC(vin, i)); } }
#pragma unroll
        for (int u = 0; u < 8; ++u) { const unsigned i = i0 + (8 + u) * stride; if (i < hi) { kB[u] = __builtin_nontemporal_load(CP_SRC(kin, i)); vB[u] = __builtin_nontemporal_load(CP_SRC(vin, i)); } }
#pragma unroll
        for (int u = 0; u < 8; ++u) { const unsigned i = i0 + u * stride; if (i < hi) { __builtin_nontemporal_store(kA[u], CP_DST(O_SK, i)); __builtin_nontemporal_store(vA[u], CP_DST(O_SV, i)); } }
#pragma unroll
        for (int u = 0; u < 8; ++u) { const unsigned i = i0 + (8 + u) * stride; if (i < hi) { __builtin_nontemporal_store(kB[u], CP_DST(O_SK, i)); __builtin_nontemporal_store(vB[u], CP_DST(O_SV, i)); } }
    }
#undef CP_BODY
#undef CP_LOAD
#undef CP_STORE
#undef CP_SRC
#undef CP_DST
}
constexpr int FR_P1 = 10, FR_P4 = 22, FR_P10 = 22, GE_P1 = 168, GE_FF = 208;
constexpr size_t CP_TOT = (size_t)(LBUF - NST) * D / 4 * NSB;
constexpr int FR_P2 = 4;
constexpr int FR_T = 2, FFN_TAIL0 = 2 * DFF / 256 * (MPAD / 256) - 6 * GE_FF;
constexpr int FR_T1 = 1, P1_TAIL0 = (NIN / 256) * (MPAD / 256) - 3 * GE_P1;
constexpr size_t CP_S = CP_TOT * (64 - FR_P1 - FR_P4 - FR_P10 - FR_P2 - 2 * FR_T - FR_T1) / 64;
constexpr size_t CP_T0 = CP_TOT * (64 - FR_P1 - FR_P4 - FR_P10 - FR_P2 - 2 * FR_T) / 64, CP_T1 = CP_T0 + CP_TOT * FR_T / 64;
constexpr size_t CP_P2 = CP_TOT * (64 - FR_P1 - FR_P4 - FR_P10 - FR_P2) / 64;
constexpr size_t CP_C0 = CP_TOT * (64 - FR_P1 - FR_P4 - FR_P10) / 64, CP_C1 = CP_C0 + CP_TOT * FR_P1 / 64, CP_C2 = CP_C1 + CP_TOT * FR_P4 / 64;

constexpr int WI_IN = (D / 64) * (NIN / 32), WI_SQ = (D / 64) * (D / 32), WI_QKV = (D / 64) * (3 * D / 32), WI_F = (D / 64) * (2 * DFF / 32), WI_DN = (DFF / 64) * (D / 32);
constexpr int WI_TOT = WI_IN + 2 * WI_SQ + WI_QKV + 2 * WI_F + 2 * WI_DN;
__device__ __forceinline__ void p0_weights(const Args& a, LAS unsigned char* lds, int it_lo, int it_hi, int gw, int NGW, int lane, int wave) {
    LAS float* scr = (LAS float*)(lds + wave * 16384);
    unsigned char* ws = a.ws;
    constexpr int I_IN = WI_IN, I_SQ = WI_SQ, I_QKV = WI_QKV, I_F = WI_F, I_DN = WI_DN;
    for (int it = it_lo + gw; it < it_hi; it += NGW) {
        int r = it;
        if (r < I_IN) { const int nb = NIN / 32, kb = r / nb, n0 = 32 * (r % nb); transpose_item(a.in[10], D, NIN, (bf16_t*)(ws + WS_WIN), 64 * kb, n0, src_in_ab(n0), a.in[7], scr, lane); continue; } r -= I_IN;
        if (r < I_SQ) { const int nb = D / 32, kb = r / nb, n0 = 32 * (r % nb); transpose_item(a.in[16], D, D, (bf16_t*)(ws + WS_WOUT), 64 * kb, n0, n0, nullptr, scr, lane); continue; } r -= I_SQ;
        if (r < I_QKV) { const int nb = 3 * D / 32, kb = r / nb, n0 = 32 * (r % nb); transpose_item(a.in[17], D, 3 * D, (bf16_t*)(ws + WS_WQKV), 64 * kb, n0, n0, a.in[7] + D, scr, lane); continue; } r -= I_QKV;
        if (r < I_SQ) { const int nb = D / 32, kb = r / nb, n0 = 32 * (r % nb); transpose_item(a.in[18], D, D, (bf16_t*)(ws + WS_WO), 64 * kb, n0, n0, nullptr, scr, lane); continue; } r -= I_SQ;
        if (r < 2 * I_F) { const int l = r / I_F; r -= l * I_F; const int nb = 2 * DFF / 32, kb = r / nb, n0 = 32 * (r % nb);
            transpose_item(a.in[19] + (size_t)l * D * 2 * DFF, D, 2 * DFF, (bf16_t*)(ws + (l ? WS_WF1 : WS_WF0)), 64 * kb, n0, src_ffn(n0), a.in[8] + l * D, scr, lane); continue; } r -= 2 * I_F;
        { const int l = r / I_DN; r -= l * I_DN; const int nb = D / 32, kb = r / nb, n0 = 32 * (r % nb);
            transpose_item(a.in[21] + (size_t)l * DFF * D, DFF, D, (bf16_t*)(ws + (l ? WS_WD1 : WS_WD0)), 64 * kb, n0, n0, nullptr, scr, lane); }
    }
}
__device__ __forceinline__ void p0_prologue(const Args& a, LAS unsigned char* lds, int gw, int NGW, int lane, int wave) {
    unsigned char* ws = a.ws;
    p0_weights(a, lds, 0, (gridDim.x == 256) ? WI_IN : WI_TOT, gw, NGW, lane, wave);
    bf16_t* HB = (bf16_t*)(ws + WS_HB); float* ssq = (float*)(ws + WS_SSQ);
    for (int r0 = gw; r0 < MPAD; r0 += 2 * NGW) {
        f32x4 v[2][4]; float sq[2];
#pragma unroll
        for (int h = 0; h < 2; ++h) { const int r = r0 + h * NGW; sq[h] = 0.f;
            if (r < MTOT) { const f32x4* xr = (const f32x4*)((r < MPR) ? a.in[0] + (size_t)r * D : a.in[1] + (size_t)(r - MPR) * D) + lane;
#pragma unroll
                for (int j = 0; j < 4; ++j) v[h][j] = __builtin_nontemporal_load(xr + 64 * j); }
            else {
#pragma unroll
                for (int j = 0; j < 4; ++j) v[h][j] = (f32x4){0.f, 0.f, 0.f, 0.f}; } }
#pragma unroll
        for (int h = 0; h < 2; ++h) { const int r = r0 + h * NGW; if (r >= MPAD) continue;
#pragma unroll
            for (int j = 0; j < 4; ++j) sq[h] += (v[h][j].x * v[h][j].x + v[h][j].y * v[h][j].y) + (v[h][j].z * v[h][j].z + v[h][j].w * v[h][j].w);
            const float s = wave_sum(sq[h]);
            u32x2* o8 = (u32x2*)(HB + (size_t)r * D) + lane;
#pragma unroll
            for (int j = 0; j < 4; ++j) { u32x2 w; w.x = cvt_pk_bf16(v[h][j].x, v[h][j].y); w.y = cvt_pk_bf16(v[h][j].z, v[h][j].w); o8[64 * j] = w; }
            if (r < MPR) { if (lane < 16) ssq[(size_t)r * 64 + lane] = (lane == 0) ? s : 0.f; } else ssq[(size_t)r * 64 + lane] = (lane == 0) ? s : 0.f; }
    }
    {
        const int tot = NSB * 26 * (CH / 4);
        for (int i = gw * 64 + lane; i < tot; i += NGW * 64) { const int sb = i / (26 * (CH / 4)), rem = i % (26 * (CH / 4));
            ((f32x4*)(a.out + O_SCA + (size_t)sb * 30 * CH))[rem] = ((const f32x4*)(a.in[2] + (size_t)sb * 30 * CH + 4 * CH))[rem]; }
    }
    if (gridDim.x == 256) copy_range<256>(a, 0, CP_S, blockIdx.x, wave); else copy_range_simple(a, 0, CP_C0, blockIdx.x, gridDim.x, wave * 64 + lane);
}

__device__ __forceinline__ void p2_conv(const Args& a, LAS unsigned char* lds, int tid, int lane, int wave) {
    unsigned char* ws = a.ws;
    const bf16_t* GA = (const bf16_t*)(ws + WS_GA); bf16_t* AB = (bf16_t*)(ws + WS_AB);
    LAS float* T = (LAS float*)lds;
    for (int u_ = blockIdx.x; u_ < 512 + NSB; u_ += gridDim.x) {
        const int u = (gridDim.x == 256 && u_ < 512) ? 64 * (u_ & 7) + (u_ >> 3) : u_;
        const float* wa = a.in[11]; const float* ba = a.in[12]; const float* lg = a.in[13]; const float* lb = a.in[14]; const float* wb = a.in[15];
        asm volatile("" : "+s"(wa), "+s"(ba), "+s"(lg), "+s"(lb), "+s"(wb));
        const bool samp = u >= 512; const int sb = u - 512;
        const int row0 = samp ? MPR + sb * NST : u * 32, nrows = samp ? NST : 32;
        const int t0 = samp ? 0 : (row0 & (SEQ - 1));
        const int nvec = (nrows + 30) * (CH / 8);
        {
            u32x4 wv[8];
#pragma unroll
            for (int it = 0; it < 8; ++it) { const int i = tid + it * NTHREADS; const int e = i >> 6, c = (i & 63) * 8; const int p = t0 - 30 + e;
                wv[it] = (u32x4){0u, 0u, 0u, 0u};
                if (i < nvec && p >= 0) wv[it] = *(const u32x4*)(GA + (size_t)(row0 - t0 + p) * GAW + c); }
#pragma unroll
            for (int it = 0; it < 8; ++it) { const int i = tid + it * NTHREADS; const int e = i >> 6, c = (i & 63) * 8; const int p = t0 - 30 + e;
                if (i < nvec && (p >= 0 || !samp)) { const u32x4 w = wv[it];
                    *(LAS f32x4*)(T + e * CH + c) = (f32x4){bflo(w.x), bfhi(w.x), bflo(w.y), bfhi(w.y)}; *(LAS f32x4*)(T + e * CH + c + 4) = (f32x4){bflo(w.z), bfhi(w.z), bflo(w.w), bfhi(w.w)}; } }
            if (samp) {
                f32x4 s0_[4], s1_[4];
#pragma unroll
                for (int it = 0; it < 4; ++it) { const int i = tid + it * NTHREADS; if (i < 30 * 64) { const float* sp = a.in[2] + ((size_t)sb * 30 + (i >> 6)) * CH + (i & 63) * 8; s0_[it] = *(const f32x4*)sp; s1_[it] = *(const f32x4*)(sp + 4); } }
#pragma unroll
                for (int it = 0; it < 4; ++it) { const int i = tid + it * NTHREADS; if (i < 30 * 64) { *(LAS f32x4*)(T + (i >> 6) * CH + (i & 63) * 8) = s0_[it]; *(LAS f32x4*)(T + (i >> 6) * CH + (i & 63) * 8 + 4) = s1_[it]; } }
            }
        }
        __syncthreads();
        if (tid < 256) {
            const int c = 2 * tid; f32x2 w[KA];
#pragma unroll
            for (int k = 0; k < KA; ++k) w[k] = *(const f32x2*)(wa + k * CH + c);
            const f32x2 bias = *(const f32x2*)(ba + c);
            if (!samp) {
#pragma clang loop unroll(disable)
                for (int hb = 0; hb < 32; hb += 16) {
                    f32x2 x[46];
#pragma unroll
                    for (int e = 0; e < 46; ++e) x[e] = *(const LAS f32x2*)(T + (hb + e) * CH + c);
#pragma unroll
                    for (int i = 0; i < 16; ++i) {
                        f32x2 s0 = bias, s1 = (f32x2){0.f, 0.f}, s2 = s1, s3 = s1;
#pragma unroll
                        for (int k = 0; k < 28; k += 4) { s0 += w[k] * x[i + k]; s1 += w[k + 1] * x[i + k + 1]; s2 += w[k + 2] * x[i + k + 2]; s3 += w[k + 3] * x[i + k + 3]; }
                        s0 += w[28] * x[i + 28]; s1 += w[29] * x[i + 29]; s2 += w[30] * x[i + 30];
                        *(LAS f32x2*)(T + (hb + i) * CH + c) = (s0 + s1) + (s2 + s3);
                    }
                }
            } else {
                f32x2 x[34];
#pragma unroll
                for (int e = 0; e < 34; ++e) x[e] = *(const LAS f32x2*)(T + e * CH + c);
#pragma unroll
                for (int i = 0; i < NST; ++i) {
                    f32x2 s0 = bias, s1 = (f32x2){0.f, 0.f}, s2 = s1, s3 = s1;
#pragma unroll
                    for (int k = 0; k < 28; k += 4) { s0 += w[k] * x[i + k]; s1 += w[k + 1] * x[i + k + 1]; s2 += w[k + 2] * x[i + k + 2]; s3 += w[k + 3] * x[i + k + 3]; }
                    s0 += w[28] * x[i + 28]; s1 += w[29] * x[i + 29]; s2 += w[30] * x[i + 30];
                    *(LAS f32x2*)(T + i * CH + c) = (s0 + s1) + (s2 + s3);
                }
            }
        } else {
            const int t2 = tid - 256, c = (t2 & 63) * 8, rc = t2 >> 6, rbase = rc * 8;
            const int nr = samp ? (rc == 0 ? NST : 0) : 8;
            float wk[3][8];
#pragma unroll
            for (int k = 0; k < 3; ++k) { const f32x4 wa0 = *(const f32x4*)(wb + k * CH + c), wa1 = *(const f32x4*)(wb + k * CH + c + 4);
                wk[k][0] = wa0.x; wk[k][1] = wa0.y; wk[k][2] = wa0.z; wk[k][3] = wa0.w; wk[k][4] = wa1.x; wk[k][5] = wa1.y; wk[k][6] = wa1.z; wk[k][7] = wa1.w; }
            float xm2[8], xm1[8];
            {
                u32x4 a2 = (u32x4){0u, 0u, 0u, 0u}, a1 = a2;
                if (nr && t0 + rbase - 2 >= 0) { a2 = *(const u32x4*)(GA + (size_t)(row0 + rbase - 2) * GAW + 512 + c); a1 = *(const u32x4*)(GA + (size_t)(row0 + rbase - 1) * GAW + 512 + c); }
                xm2[0] = bflo(a2.x); xm2[1] = bfhi(a2.x); xm2[2] = bflo(a2.y); xm2[3] = bfhi(a2.y); xm2[4] = bflo(a2.z); xm2[5] = bfhi(a2.z); xm2[6] = bflo(a2.w); xm2[7] = bfhi(a2.w);
                xm1[0] = bflo(a1.x); xm1[1] = bfhi(a1.x); xm1[2] = bflo(a1.y); xm1[3] = bfhi(a1.y); xm1[4] = bflo(a1.z); xm1[5] = bfhi(a1.z); xm1[6] = bflo(a1.w); xm1[7] = bfhi(a1.w);
                if (samp && nr) { const float* sp = a.in[3] + (size_t)sb * 2 * CH + c; const f32x4 p0 = *(const f32x4*)sp, p1 = *(const f32x4*)(sp + 4), q0 = *(const f32x4*)(sp + CH), q1 = *(const f32x4*)(sp + CH + 4);
                    xm2[0] = p0.x; xm2[1] = p0.y; xm2[2] = p0.z; xm2[3] = p0.w; xm2[4] = p1.x; xm2[5] = p1.y; xm2[6] = p1.z; xm2[7] = p1.w;
                    xm1[0] = q0.x; xm1[1] = q0.y; xm1[2] = q0.z; xm1[3] = q0.w; xm1[4] = q1.x; xm1[5] = q1.y; xm1[6] = q1.z; xm1[7] = q1.w; }
            }
#pragma clang loop unroll(disable)
            for (int k0 = 0; k0 < nr; k0 += 4) {
                u32x4 cxv[4], gbv[4];
#pragma unroll
                for (int k = 0; k < 4; ++k) { cxv[k] = *(const u32x4*)(GA + (size_t)(row0 + rbase + k0 + k) * GAW + 512 + c); gbv[k] = *(const u32x4*)(GA + (size_t)(row0 + rbase + k0 + k) * GAW + 1024 + c); }
#pragma unroll
                for (int k = 0; k < 4; ++k) {
                    const u32x4 xv = cxv[k], gv = gbv[k];
                    float o[8];
#pragma unroll
                    for (int e = 0; e < 8; ++e) {
                        const unsigned xw = e < 2 ? xv.x : (e < 4 ? xv.y : (e < 6 ? xv.z : xv.w)), gw_ = e < 2 ? gv.x : (e < 4 ? gv.y : (e < 6 ? gv.z : gv.w));
                        const float x0 = (e & 1) ? bfhi(xw) : bflo(xw), gb = (e & 1) ? bfhi(gw_) : bflo(gw_);
                        o[e] = gb * (wk[0][e] * xm2[e] + wk[1][e] * xm1[e] + wk[2][e] * x0); xm2[e] = xm1[e]; xm1[e] = x0; }
                    u32x4 w4; w4.x = cvt_pk_bf16(o[0], o[1]); w4.y = cvt_pk_bf16(o[2], o[3]); w4.z = cvt_pk_bf16(o[4], o[5]); w4.w = cvt_pk_bf16(o[6], o[7]);
                    *(u32x4*)(AB + (size_t)(row0 + rbase + k0 + k) * D + 512 + c) = w4;
                }
            }
        }
        __syncthreads();
        {
            const int c = lane * 8;
            const f32x4 g0 = *(const f32x4*)(lg + c), g1 = *(const f32x4*)(lg + c + 4), b0 = *(const f32x4*)(lb + c), b1 = *(const f32x4*)(lb + c + 4);
            f32x4 v0[4], v1[4]; float mu[4], rstd[4];
#pragma unroll
            for (int j = 0; j < 4; ++j) { const int rr = wave + 8 * j; const int rc = rr < nrows ? rr : 0; v0[j] = *(const LAS f32x4*)(T + rc * CH + c); v1[j] = *(const LAS f32x4*)(T + rc * CH + c + 4); }
#pragma unroll
            for (int j = 0; j < 4; ++j) { const float s_ = (v0[j].x + v0[j].y) + (v0[j].z + v0[j].w) + (v1[j].x + v1[j].y) + (v1[j].z + v1[j].w); mu[j] = wave_sum(s_) * (1.0f / CH); }
#pragma unroll
            for (int j = 0; j < 4; ++j) { v0[j] = v0[j] - mu[j]; v1[j] = v1[j] - mu[j];
                const float q = (v0[j].x * v0[j].x + v0[j].y * v0[j].y) + (v0[j].z * v0[j].z + v0[j].w * v0[j].w) + (v1[j].x * v1[j].x + v1[j].y * v1[j].y) + (v1[j].z * v1[j].z + v1[j].w * v1[j].w);
                rstd[j] = rsqrtf(wave_sum(q) * (1.0f / CH) + LN_EPS); }
#pragma unroll
            for (int j = 0; j < 4; ++j) { const int rr = wave + 8 * j;
                if (rr < nrows) {
                    f32x4 a0 = v0[j] * rstd[j] * g0 + b0, a1 = v1[j] * rstd[j] * g1 + b1;
#pragma unroll
                    for (int e = 0; e < 4; ++e) { a0[e] = a0[e] * sigmoidf_(a0[e]); a1[e] = a1[e] * sigmoidf_(a1[e]); }
                    u32x4 w4; w4.x = cvt_pk_bf16(a0[0], a0[1]); w4.y = cvt_pk_bf16(a0[2], a0[3]); w4.z = cvt_pk_bf16(a1[0], a1[1]); w4.w = cvt_pk_bf16(a1[2], a1[3]);
                    *(u32x4*)(AB + (size_t)(row0 + rr) * D + c) = w4;
                } }
        }
        __syncthreads();
    }
}

__device__ __forceinline__ void panel_fix(const Args& a, int layer, int pm, int tid) {
    unsigned char* ws = a.ws;
    bf16_t* U = (bf16_t*)(ws + WS_U); const float* SG = (const float*)(ws + WS_SG); const float* SU = (const float*)(ws + WS_SU);
    const float* wc = a.in[20] + (size_t)layer * 3 * DFF;
    constexpr int NCV = DFF / 8;
    const bool first = (pm & 7) == 0;
    for (int it = tid; it < 2 * NCV; it += NTHREADS) {
        const int j = it >= NCV ? 1 : 0, cv = it - j * NCV, c = cv * 8;
        float gm2[8], gm1[8], g0[8], up[8];
        const float* cur = SG + (size_t)pm * 4 * DFF + c; const float* prv = SG + (size_t)(pm - 1) * 4 * DFF + c;
#pragma unroll
        for (int e = 0; e < 8; ++e) {
            if (j == 0) { gm2[e] = first ? 0.f : prv[2 * DFF + e]; gm1[e] = first ? 0.f : prv[3 * DFF + e]; g0[e] = cur[e]; }
            else { gm2[e] = first ? 0.f : prv[3 * DFF + e]; gm1[e] = cur[e]; g0[e] = cur[DFF + e]; }
            up[e] = SU[((size_t)pm * 2 + j) * DFF + c + e];
        }
        float o[8];
#pragma unroll
        for (int e = 0; e < 8; ++e) { const float y = wc[c + e] * gm2[e] + wc[DFF + c + e] * gm1[e] + wc[2 * DFF + c + e] * g0[e]; o[e] = y * sigmoidf_(y) * up[e]; }
        u32x4 w4; w4.x = cvt_pk_bf16(o[0], o[1]); w4.y = cvt_pk_bf16(o[2], o[3]); w4.z = cvt_pk_bf16(o[4], o[5]); w4.w = cvt_pk_bf16(o[6], o[7]);
        *(u32x4*)(U + (size_t)(pm * 256 + j) * DFF + c) = w4;
    }
}

constexpr int AT_OACC = 0, AT_ML = 256 * 64 * 4, AT_STG = AT_ML + 2048, AT_KSTR = 144, AT_WSTG = 2 * 32 * AT_KSTR, AT_PSC = 0;
__device__ __forceinline__ int at_swz(int ql) { return (ql ^ (ql >> 4)) & 15; }
static_assert(AT_STG + NWAVES * AT_WSTG <= MISC_OFF && NWAVES * 2048 <= AT_ML, "attention LDS");
__device__ __forceinline__ int crow(int r, int hi) { return (r & 3) + 8 * (r >> 2) + 4 * hi; }

struct AttnRes { f32x16 o0, o1; float m, l; };
#define AT_KLOAD(X, kk_, vv_) _Pragma("unroll") for (int j = 0; j < 4; ++j) { const int kv_ = (lane >> 3) + 8 * j; const int sv_ = kb##X + kv_ < 0 ? 0 : kb##X + kv_; \
        const unsigned ro_ = (unsigned)((cls##X + dil##X * sv_) * D + (lane & 7) * 8) * 2u; kk_[j] = *(const u32x4*)((const char*)Kh + ro_); vv_[j] = *(const u32x4*)((const char*)Vh + ro_); }
#define AT_CB() asm volatile("" ::: "memory")
__device__ __forceinline__ void attn_task2(const bf16_t* Qh, const bf16_t* Kh, const bf16_t* Vh, float slope2,
                                           int dilA, int clsA, int s0A, int nqA, int dilB, int clsB, int s0B, int nqB,
                                           LAS unsigned char* lds, int wave, int lane, AttnRes& RA, AttnRes& RB) {
    asm volatile("" : "+v"(lane));
    const int r32 = lane & 31, hi = lane >> 5;
    const int qa_ = r32 < nqA ? r32 : nqA - 1, qb_ = r32 < nqB ? r32 : nqB - 1;
    const bf16_t* qpA = Qh + (size_t)(clsA + dilA * (s0A + qa_)) * D + hi * 8; const bf16_t* qpB = Qh + (size_t)(clsB + dilB * (s0B + qb_)) * D + hi * 8;
    bf16x8 qrA[4], qrB[4];
#pragma unroll
    for (int d0 = 0; d0 < 4; ++d0) { qrA[d0] = *(const bf16x8*)(qpA + d0 * 16); qrB[d0] = *(const bf16x8*)(qpB + d0 * 16); }
    float mA = -INFINITY, lA = 0.f, mB = -INFINITY, lB = 0.f;
    f32x16 oA0 = f32x16{}, oA1 = f32x16{}, oB0 = f32x16{}, oB1 = f32x16{};
    LAS unsigned char* kst = lds + AT_STG + wave * AT_WSTG; LAS unsigned char* vst = kst + 32 * AT_KSTR;
    const float sdA = slope2 * (float)dilA, sdB = slope2 * (float)dilB;
    const float lbase = (float)(r32 - 4 * hi + 128);
    const int ifA = s0A < 128 ? (128 - s0A) >> 5 : 0, ifB = s0B < 128 ? (128 - s0B) >> 5 : 0, imin = ifA < ifB ? ifA : ifB;
    const int vb = ((lane >> 4) & 1) * 32 + (lane & 3) * 8 + (4 * hi + ((lane & 15) >> 2)) * 64;
#pragma clang loop unroll(disable)
    for (int i = 4; i >= imin; --i) {
        const int kbA = s0A - 128 + 32 * i, kbB = s0B - 128 + 32 * i;
        u32x4 kkA[4], vvA[4], kkB[4], vvB[4];
        AT_KLOAD(A, kkA, vvA)
        AT_KLOAD(B, kkB, vvB)
        bf16x8 kfA[4], kfB[4]; s16x4 tlA[4], thA[4];
#pragma unroll
        for (int j = 0; j < 4; ++j) *(LAS u32x4*)(kst + ((lane >> 3) + 8 * j) * AT_KSTR + (lane & 7) * 16) = kkA[j];
        AT_CB();
#pragma unroll
        for (int d0 = 0; d0 < 4; ++d0) kfA[d0] = *(const LAS bf16x8*)(kst + r32 * AT_KSTR + d0 * 32 + hi * 16);
        AT_CB();
#pragma unroll
        for (int j = 0; j < 4; ++j) *(LAS u32x4*)(kst + ((lane >> 3) + 8 * j) * AT_KSTR + (lane & 7) * 16) = kkB[j];
        AT_CB();
#pragma unroll
        for (int d0 = 0; d0 < 4; ++d0) kfB[d0] = *(const LAS bf16x8*)(kst + r32 * AT_KSTR + d0 * 32 + hi * 16);
        AT_CB();
#pragma unroll
        for (int j = 0; j < 4; ++j) { const int kv = (lane >> 3) + 8 * j, part = lane & 7; const int off_ = (part >> 2) * 2048 + (kv >> 3) * 512 + (kv & 7) * 64 + (part & 3) * 16;
            *(LAS u32x4*)(kst + off_) = vvA[j]; *(LAS u32x4*)(vst + off_) = vvB[j]; }
        AT_CB();
#pragma unroll
        for (int q = 0; q < 4; ++q) { tlA[q] = __builtin_bit_cast(s16x4, __builtin_amdgcn_ds_read_tr16_b64_v4i16((LAS s16x4*)(kst + vb + (q >> 1) * 2048 + (q & 1) * 1024)));
                                      thA[q] = __builtin_bit_cast(s16x4, __builtin_amdgcn_ds_read_tr16_b64_v4i16((LAS s16x4*)(kst + vb + (q >> 1) * 2048 + (q & 1) * 1024 + 512))); }
        AT_CB();
        f32x16 stA, stB;
        { const float tA = sdA * ((float)(32 * i) - lbase), tB = sdB * ((float)(32 * i) - lbase);
#pragma unroll
          for (int r = 0; r < 16; ++r) { const float c_r = (float)((r & 3) + 8 * (r >> 2)); stA[r] = tA + sdA * c_r; stB[r] = tB + sdB * c_r; } }
#pragma unroll
        for (int d0 = 0; d0 < 4; ++d0) { stA = __builtin_amdgcn_mfma_f32_32x32x16_bf16(kfA[d0], qrA[d0], stA, 0, 0, 0); stB = __builtin_amdgcn_mfma_f32_32x32x16_bf16(kfB[d0], qrB[d0], stB, 0, 0, 0); }
        if (kbA < 0 || kbB < 0) {
            int cminA = (i == 0) ? r32 : 0; cminA = cminA > -kbA ? cminA : -kbA; int cminB = (i == 0) ? r32 : 0; cminB = cminB > -kbB ? cminB : -kbB;
            const int cmax = (i == 4) ? r32 : 31;
            const int loA = cminA - 4 * hi, loB = cminB - 4 * hi, hi_ = cmax - 4 * hi;
#pragma unroll
            for (int r = 0; r < 16; ++r) { const int c = (r & 3) + 8 * (r >> 2); stA[r] = (c >= loA && c <= hi_) ? stA[r] : -INFINITY; stB[r] = (c >= loB && c <= hi_) ? stB[r] : -INFINITY; }
        } else if (i == 4) {
            const int hi_ = r32 - 4 * hi;
#pragma unroll
            for (int r = 0; r < 16; ++r) { const int c = (r & 3) + 8 * (r >> 2); const bool ok = c <= hi_; stA[r] = ok ? stA[r] : -INFINITY; stB[r] = ok ? stB[r] : -INFINITY; }
        } else if (i == 0) {
            const int lo_ = r32 - 4 * hi;
#pragma unroll
            for (int r = 0; r < 16; ++r) { const int c = (r & 3) + 8 * (r >> 2); const bool ok = c >= lo_; stA[r] = ok ? stA[r] : -INFINITY; stB[r] = ok ? stB[r] : -INFINITY; }
        }
        float mxA, mxB;
        { float tA[8], tB[8];
#pragma unroll
          for (int r = 0; r < 8; ++r) { tA[r] = max_raw(stA[2 * r], stA[2 * r + 1]); tB[r] = max_raw(stB[2 * r], stB[2 * r + 1]); }
#pragma unroll
          for (int r = 0; r < 4; ++r) { tA[r] = max_raw(tA[2 * r], tA[2 * r + 1]); tB[r] = max_raw(tB[2 * r], tB[2 * r + 1]); }
          mxA = max_raw(max_raw(tA[0], tA[1]), max_raw(tA[2], tA[3])); mxB = max_raw(max_raw(tB[0], tB[1]), max_raw(tB[2], tB[3])); }
        { auto ra = __builtin_amdgcn_permlane32_swap(__float_as_uint(mxA), __float_as_uint(mxA), false, false); mxA = max_raw(__uint_as_float(ra[0]), __uint_as_float(ra[1]));
          auto rb = __builtin_amdgcn_permlane32_swap(__float_as_uint(mxB), __float_as_uint(mxB), false, false); mxB = max_raw(__uint_as_float(rb[0]), __uint_as_float(rb[1])); }
        if (__any((mxA > mA) || (mxB > mB))) {
            const float nA = max_raw(mA, mxA), nB = max_raw(mB, mxB);
            const float alA = __builtin_amdgcn_exp2f(mA - ((nA == -INFINITY) ? 0.f : nA)), alB = __builtin_amdgcn_exp2f(mB - ((nB == -INFINITY) ? 0.f : nB));
            const float fA = (nA == mA) ? 1.0f : alA, fB = (nB == mB) ? 1.0f : alB;
            lA *= fA; lB *= fB; mA = nA; mB = nB;
#pragma unroll
            for (int r = 0; r < 16; ++r) { oA0[r] *= fA; oA1[r] *= fA; oB0[r] *= fB; oB1[r] *= fB; }
        }
        const float muA = (mA == -INFINITY) ? 0.f : mA, muB = (mB == -INFINITY) ? 0.f : mB;
        f32x2 ps2A = (f32x2){0.f, 0.f}, ps2B = ps2A;
        const f32x2 mu2A = (f32x2){muA, muA}, mu2B = (f32x2){muB, muB};
#pragma unroll
        for (int r = 0; r < 16; r += 2) { const f32x2 dA = (f32x2){stA[r], stA[r + 1]} - mu2A, dB = (f32x2){stB[r], stB[r + 1]} - mu2B;
            const f32x2 pA = (f32x2){__builtin_amdgcn_exp2f(dA.x), __builtin_amdgcn_exp2f(dA.y)}, pB = (f32x2){__builtin_amdgcn_exp2f(dB.x), __builtin_amdgcn_exp2f(dB.y)};
            stA[r] = pA.x; stA[r + 1] = pA.y; stB[r] = pB.x; stB[r + 1] = pB.y; ps2A += pA; ps2B += pB; }
        lA += ps2A.x + ps2A.y; lB += ps2B.x + ps2B.y;
        bf16x8 paA[2], paB[2];
#pragma unroll
        for (int s_ = 0; s_ < 2; ++s_) {
            u32x4 w; w.x = cvt_pk_bf16(stA[8 * s_ + 0], stA[8 * s_ + 1]); w.y = cvt_pk_bf16(stA[8 * s_ + 2], stA[8 * s_ + 3]); w.z = cvt_pk_bf16(stA[8 * s_ + 4], stA[8 * s_ + 5]); w.w = cvt_pk_bf16(stA[8 * s_ + 6], stA[8 * s_ + 7]);
            paA[s_] = __builtin_bit_cast(bf16x8, w);
            w.x = cvt_pk_bf16(stB[8 * s_ + 0], stB[8 * s_ + 1]); w.y = cvt_pk_bf16(stB[8 * s_ + 2], stB[8 * s_ + 3]); w.z = cvt_pk_bf16(stB[8 * s_ + 4], stB[8 * s_ + 5]); w.w = cvt_pk_bf16(stB[8 * s_ + 6], stB[8 * s_ + 7]);
            paB[s_] = __builtin_bit_cast(bf16x8, w); }
#pragma unroll
        for (int s_ = 0; s_ < 2; ++s_) {
            { const int q = s_; const bf16x8 vf = (bf16x8){tlA[q][0], tlA[q][1], tlA[q][2], tlA[q][3], thA[q][0], thA[q][1], thA[q][2], thA[q][3]}; oA0 = __builtin_amdgcn_mfma_f32_32x32x16_bf16(vf, paA[s_], oA0, 0, 0, 0); }
            { const int q = 2 + s_; const bf16x8 vf = (bf16x8){tlA[q][0], tlA[q][1], tlA[q][2], tlA[q][3], thA[q][0], thA[q][1], thA[q][2], thA[q][3]}; oA1 = __builtin_amdgcn_mfma_f32_32x32x16_bf16(vf, paA[s_], oA1, 0, 0, 0); }
        }
        AT_CB();
        s16x4 tlB[4], thB[4];
#pragma unroll
        for (int q = 0; q < 4; ++q) { tlB[q] = __builtin_bit_cast(s16x4, __builtin_amdgcn_ds_read_tr16_b64_v4i16((LAS s16x4*)(vst + vb + (q >> 1) * 2048 + (q & 1) * 1024)));
                                      thB[q] = __builtin_bit_cast(s16x4, __builtin_amdgcn_ds_read_tr16_b64_v4i16((LAS s16x4*)(vst + vb + (q >> 1) * 2048 + (q & 1) * 1024 + 512))); }
        AT_CB();
#pragma unroll
        for (int s_ = 0; s_ < 2; ++s_) {
            { const int q = s_; const bf16x8 vf = (bf16x8){tlB[q][0], tlB[q][1], tlB[q][2], tlB[q][3], thB[q][0], thB[q][1], thB[q][2], thB[q][3]}; oB0 = __builtin_amdgcn_mfma_f32_32x32x16_bf16(vf, paB[s_], oB0, 0, 0, 0); }
            { const int q = 2 + s_; const bf16x8 vf = (bf16x8){tlB[q][0], tlB[q][1], tlB[q][2], tlB[q][3], thB[q][0], thB[q][1], thB[q][2], thB[q][3]}; oB1 = __builtin_amdgcn_mfma_f32_32x32x16_bf16(vf, paB[s_], oB1, 0, 0, 0); }
        }
        AT_CB();
    }
    { auto ra = __builtin_amdgcn_permlane32_swap(__float_as_uint(lA), __float_as_uint(lA), false, false); lA = __uint_as_float(ra[0]) + __uint_as_float(ra[1]);
      auto rb = __builtin_amdgcn_permlane32_swap(__float_as_uint(lB), __float_as_uint(lB), false, false); lB = __uint_as_float(rb[0]) + __uint_as_float(rb[1]); }
    RA.o0 = oA0; RA.o1 = oA1; RA.m = mA; RA.l = lA; RB.o0 = oB0; RB.o1 = oB1; RB.m = mB; RB.l = lB;
}
#undef AT_KLOAD
#undef AT_CB
struct AttnRes3 { f32x4 o[4]; float m, l; };
#define AT3_KLOAD(X, kk_, vv_) _Pragma("unroll") for (int j = 0; j < 4; ++j) { const int kv_ = (lane >> 3) + 8 * j; const int sv_ = kb + kv_ < 0 ? 0 : kb + kv_; \
        const unsigned ro_ = (unsigned)((cls##X + 16 * sv_) * D + (lane & 7) * 8) * 2u; kk_[j] = *(const u32x4*)((const char*)Kh + ro_); vv_[j] = *(const u32x4*)((const char*)Vh + ro_); }
#define AT3_CB() asm volatile("" ::: "memory")
__device__ __forceinline__ void attn_task3(const bf16_t* Qh, const bf16_t* Kh, const bf16_t* Vh, float slope2, int clsA, int clsB, int s0,
                                           LAS unsigned char* lds, int wave, int lane, AttnRes3& RA, AttnRes3& RB) {
    asm volatile("" : "+v"(lane));
    const int q = lane & 15, g = lane >> 4;
    const bf16_t* qpA = Qh + (size_t)(clsA + 16 * (s0 + q)) * D + 8 * g; const bf16_t* qpB = Qh + (size_t)(clsB + 16 * (s0 + q)) * D + 8 * g;
    bf16x8 qrA[2], qrB[2];
#pragma unroll
    for (int dh = 0; dh < 2; ++dh) { qrA[dh] = *(const bf16x8*)(qpA + 32 * dh); qrB[dh] = *(const bf16x8*)(qpB + 32 * dh); }
    float mA = -INFINITY, lA = 0.f, mB = -INFINITY, lB = 0.f;
    f32x4 oA[4], oB[4];
#pragma unroll
    for (int db = 0; db < 4; ++db) { oA[db] = (f32x4){0.f, 0.f, 0.f, 0.f}; oB[db] = oA[db]; }
    LAS unsigned char* kst = lds + AT_STG + wave * AT_WSTG; LAS unsigned char* vst = kst + 32 * AT_KSTR;
    const float sd = slope2 * 16.0f;
    const float lbase = (float)(4 * g - q - 128);
    const int imin = s0 < 128 ? (128 - s0) >> 5 : 0;
    const int woff = (lane >> 3) * AT_KSTR + (lane & 7) * 16;
    const int kfoff = q * AT_KSTR + g * 16;
    const int troff = (4 * g + (q >> 2)) * AT_KSTR + (lane & 3) * 8;
#pragma clang loop unroll(disable)
    for (int i = 4; i >= imin; --i) {
        const int kb = s0 - 128 + 32 * i;
        u32x4 kkA[4], vvA[4], kkB[4], vvB[4];
        AT3_KLOAD(A, kkA, vvA)
        AT3_KLOAD(B, kkB, vvB)
        bf16x8 kfA[2][2], kfB[2][2]; s16x4 tA[4][2], tB[4][2];
#pragma unroll
        for (int j = 0; j < 4; ++j) *(LAS u32x4*)(kst + woff + 8 * j * AT_KSTR) = kkA[j];
        AT3_CB();
#pragma unroll
        for (int h = 0; h < 2; ++h)
#pragma unroll
            for (int dh = 0; dh < 2; ++dh) kfA[h][dh] = *(const LAS bf16x8*)(kst + kfoff + h * 16 * AT_KSTR + dh * 64);
        AT3_CB();
#pragma unroll
        for (int j = 0; j < 4; ++j) *(LAS u32x4*)(kst + woff + 8 * j * AT_KSTR) = kkB[j];
        AT3_CB();
#pragma unroll
        for (int h = 0; h < 2; ++h)
#pragma unroll
            for (int dh = 0; dh < 2; ++dh) kfB[h][dh] = *(const LAS bf16x8*)(kst + kfoff + h * 16 * AT_KSTR + dh * 64);
        AT3_CB();
#pragma unroll
        for (int j = 0; j < 4; ++j) { *(LAS u32x4*)(kst + woff + 8 * j * AT_KSTR) = vvA[j]; *(LAS u32x4*)(vst + woff + 8 * j * AT_KSTR) = vvB[j]; }
        AT3_CB();
#pragma unroll
        for (int db = 0; db < 4; ++db)
#pragma unroll
            for (int hh = 0; hh < 2; ++hh) tA[db][hh] = __builtin_bit_cast(s16x4, __builtin_amdgcn_ds_read_tr16_b64_v4i16((LAS s16x4*)(kst + troff + hh * 16 * AT_KSTR + db * 32)));
        AT3_CB();
        f32x4 sA[2], sB[2];
        { const float t = sd * ((float)(32 * i) + lbase);
          if (i == 0 || i == 4 || kb < 0) {
            int lo = (i == 0) ? q : 0; lo = lo > -kb ? lo : -kb; const int hi_ = (i == 4) ? q : 31;
            const int lo_l = lo - 4 * g, hi_l = hi_ - 4 * g;
#pragma unroll
            for (int h = 0; h < 2; ++h)
#pragma unroll
                for (int e = 0; e < 4; ++e) { const int c = 16 * h + e; const float v = (c >= lo_l && c <= hi_l) ? t + sd * (float)c : -INFINITY; sA[h][e] = v; sB[h][e] = v; }
          } else {
#pragma unroll
            for (int h = 0; h < 2; ++h)
#pragma unroll
                for (int e = 0; e < 4; ++e) { const float v = t + sd * (float)(16 * h + e); sA[h][e] = v; sB[h][e] = v; }
          } }
#pragma unroll
        for (int h = 0; h < 2; ++h)
#pragma unroll
            for (int dh = 0; dh < 2; ++dh) { sA[h] = __builtin_amdgcn_mfma_f32_16x16x32_bf16(kfA[h][dh], qrA[dh], sA[h], 0, 0, 0); sB[h] = __builtin_amdgcn_mfma_f32_16x16x32_bf16(kfB[h][dh], qrB[dh], sB[h], 0, 0, 0); }
        float mxA = fmaxf(fmaxf(fmaxf(sA[0][0], sA[0][1]), fmaxf(sA[0][2], sA[0][3])), fmaxf(fmaxf(sA[1][0], sA[1][1]), fmaxf(sA[1][2], sA[1][3])));
        float mxB = fmaxf(fmaxf(fmaxf(sB[0][0], sB[0][1]), fmaxf(sB[0][2], sB[0][3])), fmaxf(fmaxf(sB[1][0], sB[1][1]), fmaxf(sB[1][2], sB[1][3])));
        { auto a1 = __builtin_amdgcn_permlane16_swap(__float_as_uint(mxA), __float_as_uint(mxA), false, false); mxA = fmaxf(__uint_as_float(a1[0]), __uint_as_float(a1[1]));
          auto a2 = __builtin_amdgcn_permlane32_swap(__float_as_uint(mxA), __float_as_uint(mxA), false, false); mxA = fmaxf(__uint_as_float(a2[0]), __uint_as_float(a2[1]));
          auto b1 = __builtin_amdgcn_permlane16_swap(__float_as_uint(mxB), __float_as_uint(mxB), false, false); mxB = fmaxf(__uint_as_float(b1[0]), __uint_as_float(b1[1]));
          auto b2 = __builtin_amdgcn_permlane32_swap(__float_as_uint(mxB), __float_as_uint(mxB), false, false); mxB = fmaxf(__uint_as_float(b2[0]), __uint_as_float(b2[1])); }
        if (__any((mxA > mA) || (mxB > mB))) {
            const float nA = fmaxf(mA, mxA), nB = fmaxf(mB, mxB);
            const float alA = __builtin_amdgcn_exp2f(mA - ((nA == -INFINITY) ? 0.f : nA)), alB = __builtin_amdgcn_exp2f(mB - ((nB == -INFINITY) ? 0.f : nB));
            const float fA = (nA == mA) ? 1.0f : alA, fB = (nB == mB) ? 1.0f : alB;
            lA *= fA; lB *= fB; mA = nA; mB = nB;
#pragma unroll
            for (int db = 0; db < 4; ++db) { oA[db] *= fA; oB[db] *= fB; }
        }
        const float muA = (mA == -INFINITY) ? 0.f : mA, muB = (mB == -INFINITY) ? 0.f : mB;
        float psA = 0.f, psB = 0.f;
#pragma unroll
        for (int h = 0; h < 2; ++h)
#pragma unroll
            for (int e = 0; e < 4; ++e) { const float pA = __builtin_amdgcn_exp2f(sA[h][e] - muA), pB = __builtin_amdgcn_exp2f(sB[h][e] - muB); sA[h][e] = pA; sB[h][e] = pB; psA += pA; psB += pB; }
        lA += psA; lB += psB;
        bf16x8 paA, paB;
        { u32x4 w; w.x = cvt_pk_bf16(sA[0][0], sA[0][1]); w.y = cvt_pk_bf16(sA[0][2], sA[0][3]); w.z = cvt_pk_bf16(sA[1][0], sA[1][1]); w.w = cvt_pk_bf16(sA[1][2], sA[1][3]); paA = __builtin_bit_cast(bf16x8, w);
          w.x = cvt_pk_bf16(sB[0][0], sB[0][1]); w.y = cvt_pk_bf16(sB[0][2], sB[0][3]); w.z = cvt_pk_bf16(sB[1][0], sB[1][1]); w.w = cvt_pk_bf16(sB[1][2], sB[1][3]); paB = __builtin_bit_cast(bf16x8, w); }
#pragma unroll
        for (int db = 0; db < 4; ++db) { const bf16x8 vf = (bf16x8){tA[db][0][0], tA[db][0][1], tA[db][0][2], tA[db][0][3], tA[db][1][0], tA[db][1][1], tA[db][1][2], tA[db][1][3]};
            oA[db] = __builtin_amdgcn_mfma_f32_16x16x32_bf16(vf, paA, oA[db], 0, 0, 0); }
        AT3_CB();
#pragma unroll
        for (int db = 0; db < 4; ++db)
#pragma unroll
            for (int hh = 0; hh < 2; ++hh) tB[db][hh] = __builtin_bit_cast(s16x4, __builtin_amdgcn_ds_read_tr16_b64_v4i16((LAS s16x4*)(vst + troff + hh * 16 * AT_KSTR + db * 32)));
        AT3_CB();
#pragma unroll
        for (int db = 0; db < 4; ++db) { const bf16x8 vf = (bf16x8){tB[db][0][0], tB[db][0][1], tB[db][0][2], tB[db][0][3], tB[db][1][0], tB[db][1][1], tB[db][1][2], tB[db][1][3]};
            oB[db] = __builtin_amdgcn_mfma_f32_16x16x32_bf16(vf, paB, oB[db], 0, 0, 0); }
        AT3_CB();
    }
    lA = pg8::fq_sum(lA); lB = pg8::fq_sum(lB);
#pragma unroll
    for (int db = 0; db < 4; ++db) { RA.o[db] = oA[db]; RB.o[db] = oB[db]; }
    RA.m = mA; RA.l = lA; RB.m = mB; RB.l = lB;
}
#undef AT3_KLOAD
#undef AT3_CB
__device__ __forceinline__ void attn_merge3(const AttnRes3& R, int cls, LAS unsigned char* lds, int lane) {
    asm volatile("" : "+v"(lane));
    const int q = lane & 15, g = lane >> 4;
    const int ql = cls + 16 * q, g4 = at_swz(ql);
    LAS f32x4* oa = (LAS f32x4*)(lds + AT_OACC) + ql * 16;
    LAS float* ml = (LAS float*)(lds + AT_ML) + ql * 2;
    const float m_old = ml[0], l_old = ml[1]; const float m_new = fmaxf(m_old, R.m); const float mu = (m_new == -INFINITY) ? 0.f : m_new;
    const float a_old = __builtin_amdgcn_exp2f(m_old - mu), a_new = __builtin_amdgcn_exp2f(R.m - mu), l_new = l_old * a_old + R.l * a_new;
    f32x4 pv[4];
#pragma unroll
    for (int db = 0; db < 4; ++db) pv[db] = oa[(4 * db + g) ^ g4];
#pragma unroll
    for (int db = 0; db < 4; ++db) oa[(4 * db + g) ^ g4] = R.o[db] * a_new + pv[db] * a_old;
    asm volatile("s_waitcnt lgkmcnt(0)" ::: "memory");
    if (g == 0) { ml[0] = m_new; ml[1] = l_new; }
}
__device__ __forceinline__ void attn_merge(const AttnRes& R, int nq, int qlbase, int qlstep, bool first, LAS unsigned char* lds, int lane) {
    asm volatile("" : "+v"(lane));
    const int r32 = lane & 31, hi = lane >> 5;
    if (r32 < nq) {
        const int ql = qlbase + qlstep * r32, g4 = at_swz(ql);
        LAS f32x4* oa = (LAS f32x4*)(lds + AT_OACC) + ql * 16;
        LAS float* ml = (LAS float*)(lds + AT_ML) + ql * 2;
        float a_old = 0.f, a_new = 1.f, m_new = R.m, l_new = R.l;
        if (!first) { const float m_old = ml[0], l_old = ml[1]; m_new = fmaxf(m_old, R.m); const float mu = (m_new == -INFINITY) ? 0.f : m_new;
            a_old = __builtin_amdgcn_exp2f(m_old - mu); a_new = __builtin_amdgcn_exp2f(R.m - mu); l_new = l_old * a_old + R.l * a_new; }
        f32x4 p0[4], p1[4];
        if (!first) {
#pragma unroll
            for (int g = 0; g < 4; ++g) { const int c0 = (2 * g + hi) ^ g4; p0[g] = oa[c0]; p1[g] = oa[c0 ^ 8]; } }
#pragma unroll
        for (int g = 0; g < 4; ++g) { const int c0 = (2 * g + hi) ^ g4;
            f32x4 n0 = (f32x4){R.o0[4 * g], R.o0[4 * g + 1], R.o0[4 * g + 2], R.o0[4 * g + 3]} * a_new, n1 = (f32x4){R.o1[4 * g], R.o1[4 * g + 1], R.o1[4 * g + 2], R.o1[4 * g + 3]} * a_new;
            if (!first) { n0 += p0[g] * a_old; n1 += p1[g] * a_old; }
            oa[c0] = n0; oa[c0 ^ 8] = n1; }
        asm volatile("s_waitcnt lgkmcnt(0)" ::: "memory");
        if (hi == 0) { ml[0] = m_new; ml[1] = l_new; }
    }
}

__device__ __forceinline__ void p8_attention(const Args& a, LAS unsigned char* lds, int tid, int lane, int wave, int mode) {
    unsigned char* ws = a.ws;
    const bf16_t* Q = (const bf16_t*)(ws + WS_Q); const bf16_t* K = (const bf16_t*)(ws + WS_K); const bf16_t* V = (const bf16_t*)(ws + WS_V); bf16_t* O = (bf16_t*)(ws + WS_AB);
    if (mode & 1) {
        const float* QS = (const float*)(ws + WS_QS);
        LAS float* psc = (LAS float*)(lds + AT_PSC + wave * 2048);
        for (int task = blockIdx.x * NWAVES + wave; task < NSB * NH * NST; task += gridDim.x * NWAVES) {
            const int sb = task / (NH * NST), h = (task / NST) % NH, j = task % NST;
            const float slope2 = exp2f(-0.5f * (float)(h + 1)) * LOG2E;
            const float* kc = a.in[4] + (size_t)sb * LBUF * D + h * HD; const float* vc = a.in[5] + (size_t)sb * LBUF * D + h * HD;
            const float* kn = a.out + O_SK + ((size_t)sb * LBUF + (LBUF - NST)) * D + h * HD; const float* vn = a.out + O_SV + ((size_t)sb * LBUF + (LBUF - NST)) * D + h * HD;
            const float* qrow = QS + (size_t)(sb * NST + j) * D + h * HD;
            const int kg = lane >> 4, dc = lane & 15;
            const f32x4 q4 = *(const f32x4*)(qrow + 4 * dc);
            float mx = -INFINITY;
#pragma clang loop unroll(disable)
            for (int k0 = 0; k0 < 387; k0 += 64) {
                f32x4 kr4[16];
#pragma unroll
                for (int u = 0; u < 16; ++u) { const int kk = k0 + 4 * u + kg; const int kc_ = kk < 387 ? kk : 386;
                    const int g = kc_ / 129, mm = kc_ % 129, dil = (g == 0) ? 1 : (g == 1 ? 4 : 16); const int idx = LBUF + j - mm * dil;
                    const float* kr = (idx >= LBUF) ? kn + (size_t)(idx - LBUF) * D : kc + (size_t)idx * D;
                    kr4[u] = __builtin_nontemporal_load((const f32x4*)(kr + 4 * dc)); }
#pragma unroll
                for (int u = 0; u < 16; ++u) { const int kk = k0 + 4 * u + kg; const int kc_ = kk < 387 ? kk : 386;
                    const int g = kc_ / 129, mm = kc_ % 129, dil = (g == 0) ? 1 : (g == 1 ? 4 : 16);
                    float t = (q4.x * kr4[u].x + q4.y * kr4[u].y) + (q4.z * kr4[u].z + q4.w * kr4[u].w);
                    t += dppmov<0xB1>(t); t += dppmov<0x4E>(t); t += dppmov<0x141>(t); t += dppmov<0x140>(t);
                    const float sc = (kk < 387) ? t - slope2 * (float)(mm * dil) : -INFINITY;
                    if (dc == 0) psc[kk] = sc;
                    mx = fmaxf(mx, sc); }
            }
            mx = wave_max(mx);
            asm volatile("s_waitcnt lgkmcnt(0)" ::: "memory");
            float l = 0.f;
#pragma clang loop unroll(disable)
            for (int rd = 0; rd < 7; ++rd) { const float p = __builtin_amdgcn_exp2f(psc[rd * 64 + lane] - mx); l += p; psc[rd * 64 + lane] = p; }
            l = wave_sum(l);
            asm volatile("s_waitcnt lgkmcnt(0)" ::: "memory");
            f32x4 acc4 = (f32x4){0.f, 0.f, 0.f, 0.f};
#pragma clang loop unroll(disable)
            for (int k0 = 0; k0 < 387; k0 += 64) {
                f32x4 vr4[16]; float pk[16];
#pragma unroll
                for (int u = 0; u < 16; ++u) { const int kk = k0 + 4 * u + kg; const int kc_ = kk < 387 ? kk : 386;
                    const int g = kc_ / 129, mm = kc_ % 129, dil = (g == 0) ? 1 : (g == 1 ? 4 : 16); const int idx = LBUF + j - mm * dil;
                    const float* vr = (idx >= LBUF) ? vn + (size_t)(idx - LBUF) * D : vc + (size_t)idx * D;
                    vr4[u] = __builtin_nontemporal_load((const f32x4*)(vr + 4 * dc)); pk[u] = kk < 387 ? psc[kc_] : 0.f; }
#pragma unroll
                for (int u = 0; u < 16; ++u) acc4 += vr4[u] * pk[u];
            }
#pragma unroll
            for (int e = 0; e < 4; ++e) { acc4[e] += __shfl_xor(acc4[e], 16); acc4[e] += __shfl_xor(acc4[e], 32); }
            const float il = __builtin_amdgcn_rcpf(l);
            if (lane < 16) { u32x2 w; w.x = cvt_pk_bf16(acc4[0] * il, acc4[1] * il); w.y = cvt_pk_bf16(acc4[2] * il, acc4[3] * il);
                *(u32x2*)(O + (size_t)(MPR + sb * NST + j) * D + h * HD + 4 * dc) = w; }
            asm volatile("s_waitcnt lgkmcnt(0)" ::: "memory");
        }
    }
    __syncthreads();
    if (mode & 2) {
    const int nun = NB * NH * 8, per_round = gridDim.x;
    for (int u0 = blockIdx.x; u0 < nun; u0 += per_round) {
        int u = u0;
        if ((gridDim.x & 7) == 0 && nun % (int)gridDim.x == 0) { const int x = blockIdx.x & 7, slot = blockIdx.x >> 3, spx = gridDim.x >> 3, rnd = u0 / per_round, j = rnd * spx + slot; u = x * (nun >> 3) + j;
            const int sq = u & 7, r4 = rnd & 3, qb = (r4 == 0) ? sq : (r4 == 1) ? 7 - sq : (r4 == 2) ? ((sq + 4) & 7) : ((3 - sq) & 7); u = (u & ~7) | qb; }
        const int qblk = u & 7, h = (u >> 3) & 15, b = u >> 7;
        const float slope2 = exp2f(-0.5f * (float)(h + 1)) * LOG2E;
        const bf16_t* Qh = Q + (size_t)b * SEQ * D + h * HD; const bf16_t* Kh = K + (size_t)b * SEQ * D + h * HD; const bf16_t* Vh = V + (size_t)b * SEQ * D + h * HD;
        {
            AttnRes RA, RB;
            attn_task2(Qh, Kh, Vh, slope2, 1, 0, 256 * qblk + 32 * wave, 32, 4, wave & 3, 64 * qblk + 32 * (wave >> 2), 32, lds, wave, lane, RA, RB);
            attn_merge(RA, 32, 32 * wave, 1, true, lds, lane);
            __syncthreads();
            attn_merge(RB, 32, (wave & 3) + 128 * (wave >> 2), 4, false, lds, lane);
            __syncthreads();
            AttnRes3 R3A, R3B;
            attn_task3(Qh, Kh, Vh, slope2, 2 * wave, 2 * wave + 1, 16 * qblk, lds, wave, lane, R3A, R3B);
            attn_merge3(R3A, 2 * wave, lds, lane);
            attn_merge3(R3B, 2 * wave + 1, lds, lane);
            __syncthreads();
        }
        {
            const int ql = tid >> 1, dh = (tid & 1) * 32, hb = (tid & 1) * 8, g4 = at_swz(ql);
            const LAS f32x4* oa = (const LAS f32x4*)(lds + AT_OACC) + ql * 16;
            const float inv = __builtin_amdgcn_rcpf(((const LAS float*)(lds + AT_ML))[ql * 2 + 1]);
            bf16_t* op = O + (size_t)(b * SEQ + 256 * qblk + ql) * D + h * HD + dh;
            f32x4 x[8];
#pragma unroll
            for (int e = 0; e < 8; ++e) x[e] = oa[(hb + e) ^ g4];
#pragma unroll
            for (int e = 0; e < 4; ++e) { const f32x4 x0 = x[2 * e] * inv, x1 = x[2 * e + 1] * inv; u32x4 w; w.x = cvt_pk_bf16(x0[0], x0[1]); w.y = cvt_pk_bf16(x0[2], x0[3]);
                w.z = cvt_pk_bf16(x1[0], x1[1]); w.w = cvt_pk_bf16(x1[2], x1[3]); *(u32x4*)(op + 8 * e) = w; }
        }
        __syncthreads();
    }
    }
}

__device__ __forceinline__ void p13_final(const Args& a, int gw, int NGW, int lane) {
    const bf16_t* HBp = (const bf16_t*)(a.ws + WS_HB); const float* g = a.in[9];
    f32x4 gv[4];
#pragma unroll
    for (int j = 0; j < 4; ++j) gv[j] = ((const f32x4*)g)[64 * j + lane];
    for (int r0 = gw; r0 < MTOT; r0 += 2 * NGW) {
        f32x4 v[2][4];
#pragma unroll
        for (int h = 0; h < 2; ++h) { const int r = r0 + h * NGW; const int rc = r < MTOT ? r : r0; const u32x2* xr = (const u32x2*)(HBp + (size_t)rc * D) + lane;
#pragma unroll
            for (int j = 0; j < 4; ++j) { const u32x2 b = xr[64 * j]; v[h][j] = (f32x4){bflo(b.x), bfhi(b.x), bflo(b.y), bfhi(b.y)}; } }
#pragma unroll
        for (int h = 0; h < 2; ++h) { const int r = r0 + h * NGW; if (r >= MTOT) continue; float s = 0.f;
#pragma unroll
            for (int j = 0; j < 4; ++j) s += (v[h][j].x * v[h][j].x + v[h][j].y * v[h][j].y) + (v[h][j].z * v[h][j].z + v[h][j].w * v[h][j].w);
            const float rstd = rsqrtf(wave_sum(s) * (1.0f / D) + RMS_EPS);
            f32x4* o = (f32x4*)(a.out + (size_t)r * D) + lane;
#pragma unroll
            for (int j = 0; j < 4; ++j) __builtin_nontemporal_store(v[h][j] * rstd * gv[j], o + 64 * j); }
    }
}

__device__ __forceinline__ void sample_gemm_qkv(LAS unsigned char* lds, const bf16_t* A, const bf16_t* Bt, const float* ssq, bf16_t* QKV, float* QS, float* out, int tid, int lane, int wave) {
    constexpr int K = D, KPW = K / 32 / 8, NCB = 3, nitems = (3 * D / 16 / NCB) * 4;
    LAS f32x4* red = (LAS f32x4*)lds;
    for (int it = blockIdx.x; it < nitems; it += gridDim.x) {
        const int cg = it >> 2, rq = it & 3;
        const bf16_t* ap = A + (size_t)(32 * rq + (lane & 15)) * K + wave * KPW * 32 + 8 * (lane >> 4);
        const bf16_t* bp = Bt + (size_t)(16 * NCB * cg + (lane & 15)) * K + wave * KPW * 32 + 8 * (lane >> 4);
        bf16x8 bw[NCB][KPW], a0[KPW], a1[KPW];
#pragma unroll
        for (int ks = 0; ks < KPW; ++ks) { a0[ks] = *(const bf16x8*)(ap + ks * 32); a1[ks] = *(const bf16x8*)(ap + (size_t)16 * K + ks * 32);
#pragma unroll
            for (int cb = 0; cb < NCB; ++cb) bw[cb][ks] = *(const bf16x8*)(bp + (size_t)cb * 16 * K + ks * 32); }
#pragma unroll
        for (int cb = 0; cb < NCB; ++cb) { f32x4 acc0 = (f32x4){0.f, 0.f, 0.f, 0.f}, acc1 = acc0;
#pragma unroll
            for (int ks = 0; ks < KPW; ++ks) { acc0 = __builtin_amdgcn_mfma_f32_16x16x32_bf16(bw[cb][ks], a0[ks], acc0, 0, 0, 0); acc1 = __builtin_amdgcn_mfma_f32_16x16x32_bf16(bw[cb][ks], a1[ks], acc1, 0, 0, 0); }
            red[((cb * 8 + wave) * 2 + 0) * 64 + lane] = acc0; red[((cb * 8 + wave) * 2 + 1) * 64 + lane] = acc1; }
        __syncthreads();
        if (tid < 128 * NCB) {
            const int cb = tid >> 7, rb = (tid >> 6) & 1, ln = tid & 63;
            f32x4 v = red[((cb * 8) * 2 + rb) * 64 + ln];
#pragma unroll
            for (int w = 1; w < 8; ++w) v += red[((cb * 8 + w) * 2 + rb) * 64 + ln];
            const int rs = 32 * rq + 16 * rb + (ln & 15), fq = ln >> 4;
            const int cbk = NCB * cg + cb, c = 16 * cbk + 4 * fq;
            const int which = cbk >> 6, c1 = c - which * D;
            const float rstd = pg8::row_rstd(ssq, MPR + rs, fq) * (which == 0 ? QSCALE : 1.0f);
            const f32x4 o = v * rstd;
            u32x2 w2; w2.x = cvt_pk_bf16(o[0], o[1]); w2.y = cvt_pk_bf16(o[2], o[3]);
            *(u32x2*)(QKV + (size_t)which * ((WS_K - WS_Q) / 2) + (size_t)(MPR + rs) * D + c1) = w2;
            float* fp = (which == 0) ? QS + (size_t)rs * D + c1 : out + (which == 1 ? O_SK : O_SV) + ((size_t)(rs >> 2) * LBUF + (LBUF - NST) + (rs & 3)) * D + c1;
            *(f32x4*)fp = o;
        }
        __syncthreads();
    }
}
template <int MODE, int K>
__device__ __forceinline__ void sample_gemm(LAS unsigned char* lds, const bf16_t* A, const bf16_t* Bt, int N, const float* base, float* Hs, bf16_t* HBs, float* ssq,
                                            bf16_t* QKV, float* QS, float* out, int tid, int lane, int wave) {
    constexpr int KPW = K / 32 / 8;
    const int nitems = (N / 16) * 4;
    LAS f32x4* red = (LAS f32x4*)lds;
    for (int it = blockIdx.x; it < nitems; it += gridDim.x) {
        const int cbk = it >> 2, rq = it & 3;
        const bf16_t* bp = Bt + (size_t)(16 * cbk + (lane & 15)) * K + wave * KPW * 32 + 8 * (lane >> 4);
        const bf16_t* ap = A + (size_t)(32 * rq + (lane & 15)) * K + wave * KPW * 32 + 8 * (lane >> 4);
        bf16x8 bw[KPW], a0[KPW], a1[KPW];
#pragma unroll
        for (int ks = 0; ks < KPW; ++ks) { bw[ks] = *(const bf16x8*)(bp + ks * 32); a0[ks] = *(const bf16x8*)(ap + ks * 32); a1[ks] = *(const bf16x8*)(ap + (size_t)16 * K + ks * 32); }
        f32x4 acc0 = (f32x4){0.f, 0.f, 0.f, 0.f}, acc1 = acc0;
#pragma unroll
        for (int ks = 0; ks < KPW; ++ks) { acc0 = __builtin_amdgcn_mfma_f32_16x16x32_bf16(bw[ks], a0[ks], acc0, 0, 0, 0); acc1 = __builtin_amdgcn_mfma_f32_16x16x32_bf16(bw[ks], a1[ks], acc1, 0, 0, 0); }
        red[(wave * 2 + 0) * 64 + lane] = acc0; red[(wave * 2 + 1) * 64 + lane] = acc1;
        __syncthreads();
        if (tid < 128) {
            const int rb = tid >> 6, ln = tid & 63;
            f32x4 v = red[rb * 64 + ln];
#pragma unroll
            for (int w = 1; w < 8; ++w) v += red[(w * 2 + rb) * 64 + ln];
            const int rs = 32 * rq + 16 * rb + (ln & 15), fq = ln >> 4;
            const int c = 16 * cbk + 4 * fq;
            if (MODE == 0) {
                const u32x2 b2 = *(const u32x2*)(HBs + (size_t)rs * D + c);
                const f32x4 h = (f32x4){bflo(b2.x), bfhi(b2.x), bflo(b2.y), bfhi(b2.y)} + v;
                u32x2 w2; w2.x = cvt_pk_bf16(h[0], h[1]); w2.y = cvt_pk_bf16(h[2], h[3]); *(u32x2*)(HBs + (size_t)rs * D + c) = w2;
                float q = (h[0] * h[0] + h[1] * h[1]) + (h[2] * h[2] + h[3] * h[3]);
                q += __shfl_xor(q, 16); q += __shfl_xor(q, 32);
                if (fq == 0) ssq[(size_t)(MPR + rs) * 64 + cbk] = q;
            } else {
                const int which = cbk >> 6, c1 = c - which * D;
                const float rstd = pg8::row_rstd(ssq, MPR + rs, fq) * (which == 0 ? QSCALE : 1.0f);
                const f32x4 o = v * rstd;
                u32x2 w2; w2.x = cvt_pk_bf16(o[0], o[1]); w2.y = cvt_pk_bf16(o[2], o[3]);
                *(u32x2*)(QKV + (size_t)which * ((WS_K - WS_Q) / 2) + (size_t)(MPR + rs) * D + c1) = w2;
                float* fp = (which == 0) ? QS + (size_t)rs * D + c1 : out + (which == 1 ? O_SK : O_SV) + ((size_t)(rs >> 2) * LBUF + (LBUF - NST) + (rs & 3)) * D + c1;
                *(f32x4*)fp = o;
            }
        }
        __syncthreads();
    }
}

#define XB_TMO      128
#define XB_XCNT(j)  (256  + 64 * (j))
#define XB_XSUB(j)  (1280 + 64 * (j))
#define XB_XGEN(j)  (2304 + 64 * (j))
#define XB_TOP      3328
#define XB_TOPGEN   3392
#define XCD_BAR_WORDS 3456
#define XB_SPIN_CAP (1u << 18)
__device__ __forceinline__ unsigned xb_ld(unsigned* p)              { return __hip_atomic_load(p, __ATOMIC_RELAXED, __HIP_MEMORY_SCOPE_AGENT); }
__device__ __forceinline__ unsigned xb_add(unsigned* p, unsigned v) { return __hip_atomic_fetch_add(p, v, __ATOMIC_RELAXED, __HIP_MEMORY_SCOPE_AGENT); }
__device__ __forceinline__ unsigned xb_xcc_id() { return (unsigned)__builtin_amdgcn_s_getreg((3 << 11) | 20) & 0xFu; }
#define XB_SPIN(cond, bar) do { unsigned _sp = 0; while (cond) { __builtin_amdgcn_s_sleep(1); \
    if ((++_sp & 255u) == 0u) { if (xb_ld(&(bar)[XB_TMO])) break; if (_sp > XB_SPIN_CAP) { atomicAdd(&(bar)[XB_TMO], 1u); break; } } } } while (0)
__device__ __forceinline__ void xcd_barrier_complete(unsigned* bar, unsigned x, unsigned& nloc, unsigned& nx) {
    const unsigned G = gridDim.x * gridDim.y * gridDim.z;
    unsigned sum, cnt, mine, sp = 0u;
    for (;;) {
        sum = 0u; cnt = 0u; mine = 0u;
#pragma unroll
        for (unsigned j = 0; j < 16; ++j) { const unsigned c = xb_ld(&bar[XB_XCNT(j)]); sum += c; cnt += (c > 0u) ? 1u : 0u; mine = (j == x) ? c : mine; }
        if (sum == G) break;
        __builtin_amdgcn_s_sleep(1);
        if ((++sp & 255u) == 0u) { if (xb_ld(&bar[XB_TMO])) break; if (sp > XB_SPIN_CAP) { atomicAdd(&bar[XB_TMO], 1u); break; } }
    }
    nloc = mine > 0u ? mine : 1u; nx = cnt > 0u ? cnt : 1u;
}
__device__ __forceinline__ void xcd_barrier(unsigned* bar, volatile LAS unsigned* st, int wave0) {
    asm volatile("s_waitcnt vmcnt(0)" ::: "memory");
    __syncthreads();
    if (wave0 == 0 && lane_id() == 0) {
        const unsigned x = xb_xcc_id();
        __builtin_amdgcn_s_waitcnt(0);
        unsigned nloc = st[0], nx = st[1];
        if (nloc == 0u) { xcd_barrier_complete(bar, x, nloc, nx); st[0] = nloc; st[1] = nx; }
        const unsigned old = xb_add(&bar[XB_XSUB(x)], 1u);
        const unsigned gen = old / nloc;
        if (old + 1u == (gen + 1u) * nloc) {
            __builtin_amdgcn_fence(__ATOMIC_RELEASE, "agent");
            asm volatile("s_waitcnt vmcnt(0)" ::: "memory");
            const unsigned og = xb_add(&bar[XB_TOP], 1u);
            const unsigned tg = og / nx;
            if (og + 1u == (tg + 1u) * nx) xb_add(&bar[XB_TOPGEN], 1u);
            else XB_SPIN(xb_ld(&bar[XB_TOPGEN]) == tg, bar);
            __builtin_amdgcn_fence(__ATOMIC_ACQUIRE, "agent");
            xb_add(&bar[XB_XGEN(x)], 1u);
            asm volatile("s_waitcnt vmcnt(0)" ::: "memory");
        } else {
            XB_SPIN(xb_ld(&bar[XB_XGEN(x)]) == gen, bar);
            __builtin_amdgcn_fence(__ATOMIC_ACQUIRE, "agent");
            asm volatile("s_waitcnt vmcnt(0)" ::: "memory");
        }
    }
    __syncthreads();
}

typedef const __attribute__((address_space(4))) Args* kargp_t;
__device__ __forceinline__ Args kargs() {
    Args a;
#if defined(__HIP_DEVICE_COMPILE__)
    kargp_t p = (kargp_t)__builtin_amdgcn_kernarg_segment_ptr(); asm volatile("" : "+s"(p));
#pragma unroll
    for (int i = 0; i < 22; ++i) a.in[i] = p->in[i];
    a.out = p->out; a.ws = p->ws;
#else
    for (int i = 0; i < 22; ++i) a.in[i] = nullptr;
    a.out = nullptr; a.ws = nullptr;
#endif
    return a;
}
#define PHASE_BEGIN const Args a = kargs(); unsigned char* ws = a.ws; const int wave = wave0, lane = lane_id(), tid = wave * 64 + lane; \
    const int G = gridDim.x, gw = blockIdx.x * NWAVES + wave, NGW = G * NWAVES; (void)ws; (void)lane; (void)gw; (void)NGW; (void)G;
__global__ void __launch_bounds__(NTHREADS, 2) mega_fwd(Args a_unused) {
    extern __shared__ __attribute__((aligned(16))) unsigned char lds_raw[];
    LAS unsigned char* lds = (LAS unsigned char*)lds_raw;
    cg::grid_group grid = cg::this_grid();
    volatile LAS unsigned* bst = (volatile LAS unsigned*)(lds + MISC_OFF + 64);
    const int wave0 = __builtin_amdgcn_readfirstlane((int)threadIdx.x >> 6);
    { unsigned* ctl0 = (unsigned*)kargs().ws; if (threadIdx.x == 0) { bst[0] = 0u; bst[1] = 0u; (void)xb_add(&ctl0[XB_XCNT(xb_xcc_id())], 1u); } }
    __syncthreads();
    grid.sync();
#define GRID_BAR() do { unsigned* ctl_ = (unsigned*)kargs().ws; xcd_barrier(ctl_, bst, wave0); } while (0)
#ifndef PHASES
#define PHASES 0xFFFF
#endif
#define PH(k) if constexpr (((PHASES) >> (k)) & 1)
#define REP_ALL 1
#define REP_P0 1
#define REP_P1 1
#define REP_P2 1
#define REP_P3 1
#define REP_P4 1
#define REP_P6 1
#define PROBE_SKIP_EPI 0
#define REP_P7 1
#define REP_P8 1
#define REP_P8S 1
#define REP_P13 1
#define REPEAT(n) for (int rep_ = 0; rep_ < (n); ++rep_)

    for (int rep_all = 0; rep_all < REP_ALL; ++rep_all) {
    if (rep_all) { GRID_BAR(); }
    REPEAT(REP_P0) { PH(0) { PHASE_BEGIN p0_prologue(a, lds, gw, NGW, lane, wave); } if (rep_ + 1 < REP_P0) { GRID_BAR(); } }
    GRID_BAR();
    REPEAT(REP_P1) { if (rep_) { GRID_BAR(); } PH(1) {
        PHASE_BEGIN
        const int ge = (G == 256) ? GE_P1 : G;
        if ((int)blockIdx.x < ge) {
        pg8::Gemm g{(const bf16_t*)(ws + WS_HB), (const bf16_t*)(ws + WS_WIN), MPAD, NIN, D, wave}; pg8::StaticOrder S; S.init(MPAD, NIN, ge, (int)blockIdx.x);
        pg8::EpiInAB E{(bf16_t*)(ws + WS_GA), (const float*)(ws + WS_SSQ), a.out};
        pg8::gemm_phase<pg8::EpiInAB, pg8::StaticOrder, true, true>(lds, g, S, E);
        if (G == 256 && (int)blockIdx.x >= P1_TAIL0 && rep_ == 0) copy_range<GE_P1 - P1_TAIL0>(a, CP_S, CP_T0, (int)blockIdx.x - P1_TAIL0, wave);
        } else { p0_weights(a, lds, WI_IN, WI_TOT, ((int)blockIdx.x - ge) * NWAVES + wave, (G - ge) * NWAVES, lane_id(), wave); copy_range<256 - GE_P1>(a, CP_C0, CP_C1, (int)blockIdx.x - ge, wave); }
        if (ge == G && rep_ == 0) copy_range_simple(a, CP_C0, CP_C1, blockIdx.x, G, wave * 64 + lane_id());
    } }
    GRID_BAR();
    REPEAT(REP_P2) { if (rep_) { GRID_BAR(); } PH(2) { PHASE_BEGIN p2_conv(a, lds, tid, lane, wave);
        if (G == 256 && (int)blockIdx.x >= 32 && rep_ == 0) copy_range<224>(a, CP_P2, CP_C0, (int)blockIdx.x - 32, wave);
    } }
    GRID_BAR();
    REPEAT(REP_P3) { if (rep_) { GRID_BAR(); } PH(3) {
        PHASE_BEGIN
        pg8::Gemm g{(const bf16_t*)(ws + WS_AB), (const bf16_t*)(ws + WS_WOUT), MPR, D, D, wave}; pg8::StaticOrder S; S.init(MPR, D, G, (int)blockIdx.x);
        pg8::EpiResid E{(bf16_t*)(ws + WS_HB), (float*)(ws + WS_SSQ), 0};
        pg8::gemm_phase<pg8::EpiResid, pg8::StaticOrder, true, true>(lds, g, S, E);
        sample_gemm<0, D>(lds, (const bf16_t*)(ws + WS_AB) + (size_t)MPR * D, (const bf16_t*)(ws + WS_WOUT), D, nullptr, nullptr, (bf16_t*)(ws + WS_HB) + (size_t)MPR * D,
                          (float*)(ws + WS_SSQ), nullptr, nullptr, nullptr, tid, lane, wave);
    } }
    GRID_BAR();
#pragma clang loop unroll(disable)
    for (int layer = 0; layer < 2; ++layer) {
        if (layer == 1) {
            REPEAT(REP_P7) { if (rep_) { GRID_BAR(); } PH(7) {
                PHASE_BEGIN
                pg8::Gemm g{(const bf16_t*)(ws + WS_HB), (const bf16_t*)(ws + WS_WQKV), MPR, 3 * D, D, wave}; pg8::StaticOrder S; S.init(MPR, 3 * D, G, (int)blockIdx.x);
                pg8::EpiQkv E{(bf16_t*)(ws + WS_Q), (float*)(ws + WS_QS), (const float*)(ws + WS_SSQ), a.out};
                pg8::gemm_phase<pg8::EpiQkv, pg8::StaticOrder, true, true>(lds, g, S, E);
                sample_gemm_qkv(lds, (const bf16_t*)(ws + WS_HB) + (size_t)MPR * D, (const bf16_t*)(ws + WS_WQKV), (const float*)(ws + WS_SSQ), (bf16_t*)(ws + WS_Q), (float*)(ws + WS_QS), a.out,
                                wave * 64 + lane_id(), lane_id(), wave);
            } }
            GRID_BAR();
            REPEAT(REP_P8) { if (rep_) { GRID_BAR(); } PH(8) { PHASE_BEGIN p8_attention(a, lds, tid, lane, wave, 2); } }
            REPEAT(REP_P8S) { PH(8) { PHASE_BEGIN p8_attention(a, lds, tid, lane, wave, 1); } }
            GRID_BAR();
            PH(9) {
                PHASE_BEGIN
                pg8::Gemm g{(const bf16_t*)(ws + WS_AB), (const bf16_t*)(ws + WS_WO), MPR, D, D, wave}; pg8::StaticOrder S; S.init(MPR, D, G, (int)blockIdx.x);
                pg8::EpiResid E{(bf16_t*)(ws + WS_HB), (float*)(ws + WS_SSQ), 0};
                pg8::gemm_phase<pg8::EpiResid, pg8::StaticOrder, true, true>(lds, g, S, E);
                sample_gemm<0, D>(lds, (const bf16_t*)(ws + WS_AB) + (size_t)MPR * D, (const bf16_t*)(ws + WS_WO), D, nullptr, nullptr, (bf16_t*)(ws + WS_HB) + (size_t)MPR * D,
                                  (float*)(ws + WS_SSQ), nullptr, nullptr, nullptr, tid, lane, wave);
            }
            GRID_BAR();
        }
        REPEAT(REP_P4) { if (rep_) { GRID_BAR(); } PH(4) {
            PHASE_BEGIN
            const int ge = (G == 256) ? GE_FF : G;
            const size_t clo = layer ? CP_C2 : CP_C1, chi = layer ? CP_TOT : CP_C2;
            if ((int)blockIdx.x >= ge) { if (rep_ == 0) copy_range<256 - GE_FF>(a, clo, chi, (int)blockIdx.x - ge, wave); } else {
            pg8::Gemm g{(const bf16_t*)(ws + WS_HB), (const bf16_t*)(ws + (layer ? WS_WF1 : WS_WF0)), MPAD, 2 * DFF, D, wave}; pg8::StaticOrder S; S.init(MPAD, 2 * DFF, ge, (int)blockIdx.x);
            pg8::EpiFfn E{lds, (bf16_t*)(ws + WS_U), (float*)(ws + WS_SG), (float*)(ws + WS_SU), a.in[20] + (size_t)layer * 3 * DFF, (const float*)(ws + WS_SSQ), a.out, a.in[6], layer};
            pg8::gemm_phase<pg8::EpiFfn, pg8::StaticOrder, true, true>(lds, g, S, E);
            if (G == 256 && (int)blockIdx.x >= FFN_TAIL0 && rep_ == 0) copy_range<GE_FF - FFN_TAIL0>(a, layer ? CP_T1 : CP_T0, layer ? CP_P2 : CP_T1, (int)blockIdx.x - FFN_TAIL0, wave);
            }
            if (ge == G && rep_ == 0) copy_range_simple(a, clo, chi, blockIdx.x, G, wave * 64 + lane_id());
        } }
        GRID_BAR();
        REPEAT(REP_P6) { if (rep_) { GRID_BAR(); } PH(6) {
            PHASE_BEGIN
            pg8::Gemm g{(const bf16_t*)(ws + WS_U), (const bf16_t*)(ws + (layer ? WS_WD1 : WS_WD0)), MPR, D, DFF, wave}; pg8::StaticOrder S; S.init(MPR, D, G, (int)blockIdx.x);
            { pg8::Unit u_; for (int i = 0; S.next(i, u_); ++i) panel_fix(a, layer, u_.pm, tid); }
            asm volatile("s_waitcnt vmcnt(0)" ::: "memory"); __syncthreads();
            const bool real_ = (rep_ + 1 == REP_P6);
            pg8::EpiResid E{(bf16_t*)(ws + WS_HB), real_ ? (float*)(ws + WS_SSQ) : (float*)(ws + WS_ZU), real_ ? 0 : 1};
            pg8::gemm_phase<pg8::EpiResid, pg8::StaticOrder, true, true>(lds, g, S, E);
            if (real_) sample_gemm<0, DFF>(lds, (const bf16_t*)(ws + WS_U) + (size_t)MPR * DFF, (const bf16_t*)(ws + (layer ? WS_WD1 : WS_WD0)), D, nullptr, nullptr, (bf16_t*)(ws + WS_HB) + (size_t)MPR * D,
                                (float*)(ws + WS_SSQ), nullptr, nullptr, nullptr, tid, lane, wave);
        } }
        GRID_BAR();
    }
    REPEAT(REP_P13) { if (rep_) { GRID_BAR(); } PH(13) { PHASE_BEGIN p13_final(a, gw, NGW, lane); } }
    }
}

extern "C" void kernel_launch(void* const* d_in, const int* in_sizes, int n_in, void* d_out, int out_size, void* d_ws, size_t ws_size, hipStream_t stream) {
    static int grid = 0;
    if (grid == 0) {
        if (n_in != 22 || (size_t)out_size != O_END || ws_size < WS_END) { fprintf(stderr, "kernel_launch: unexpected shapes (n_in %d, out %d, ws %zu, need %zu)\n", n_in, out_size, ws_size, (size_t)WS_END); grid = -1; return; }
        int dev = 0, cus = 0, per_cu = 0;
        if (hipGetDevice(&dev) != hipSuccess || hipDeviceGetAttribute(&cus, hipDeviceAttributeMultiprocessorCount, dev) != hipSuccess) { grid = -1; return; }
        if (hipFuncSetAttribute((const void*)mega_fwd, hipFuncAttributeMaxDynamicSharedMemorySize, LDS_BYTES) != hipSuccess) { fprintf(stderr, "kernel_launch: hipFuncSetAttribute failed\n"); grid = -1; return; }
        if (hipOccupancyMaxActiveBlocksPerMultiprocessor(&per_cu, (const void*)mega_fwd, NTHREADS, LDS_BYTES) != hipSuccess || per_cu < 1) { fprintf(stderr, "kernel_launch: occupancy query failed (%d)\n", per_cu); (void)hipGetLastError(); grid = -1; return; }
        grid = cus * 1;
    }
    if (grid < 0) return;
    if (hipMemsetAsync((char*)d_ws + WS_CTL, 0, CTL_BYTES, stream) != hipSuccess) { fprintf(stderr, "kernel_launch: memset failed\n"); return; }
    Args a{};
    for (int i = 0; i < 22; ++i) a.in[i] = (const float*)d_in[i];
    a.out = (float*)d_out; a.ws = (unsigned char*)d_ws;
    void* args[] = {&a};
    hipError_t e = hipLaunchCooperativeKernel((const void*)mega_fwd, dim3(grid), dim3(NTHREADS), args, LDS_BYTES, stream);
    if (e != hipSuccess) fprintf(stderr, "cooperative launch failed: %s (grid %d)\n", hipGetErrorString(e), grid);
}
```
